# Optimizing an MI355X kernel written in HIP

```python
import jax, jax.numpy as jnp
from jax import lax
import numpy as np


D_MODEL = 1024
BATCH = 16
SEQ = 2048
DEPTH = 1

CTX_LEN = 256
GRID_W = 64
D_MIX = D_MODEL
POOL_WIDTH = D_MIX // 4
POOL_WINDOWS = (2, 4, 8, 16)
POOL_GROUP = POOL_WIDTH // len(POOL_WINDOWS)
ATTN_WIDTH = D_MIX - POOL_WIDTH
HEAD_DIM = 64
N_HEADS = ATTN_WIDTH // HEAD_DIM
N_KV_HEADS = 4
GQA_GROUP = N_HEADS // N_KV_HEADS
KV_WIDTH = N_KV_HEADS * HEAD_DIM
PROJ_WIDTH = POOL_WIDTH + ATTN_WIDTH + 2 * KV_WIDTH
Q_BLOCK = 128
ROPE_THETA = 10000.0
AXIS_DIM = HEAD_DIM // 2
N_EXPERTS = 64
TOP_K = 8
N_GROUPS = 8
TOPK_GROUPS = 4
EXPERT_FF = 256
SHARED_FF = 256
ROUTED_SCALE = 2.5
EXPERT_BLOCK = 256
ALPHA = (2.0 * DEPTH) ** 0.25
BETA = (8.0 * DEPTH) ** -0.25
LN_EPS = 1e-5
RMS_EPS = 1e-6

kernel_name = 'hybrid_pool_gqa_moe_dit_layer'


def layer_norm(x, g, b):
    xf = x.astype(jnp.float32)
    mu = jnp.mean(xf, axis=-1, keepdims=True)
    var = jnp.mean(jnp.square(xf - mu), axis=-1, keepdims=True)
    return ((xf - mu) * lax.rsqrt(var + LN_EPS) * g + b).astype(x.dtype)


def head_rms_norm(x, g):
    xf = x.astype(jnp.float32)
    return (xf * lax.rsqrt(jnp.mean(jnp.square(xf), axis=-1, keepdims=True) + RMS_EPS) * g).astype(x.dtype)


def axial_rope_tables(rows):
    inv_freq = ROPE_THETA ** (-jnp.arange(0, AXIS_DIM, 2, dtype=jnp.float32) / AXIS_DIM)
    row = jnp.repeat(jnp.arange(rows, dtype=jnp.float32), GRID_W)
    col = jnp.tile(jnp.arange(GRID_W, dtype=jnp.float32), rows)
    ang = jnp.concatenate([row[:, None] * inv_freq, col[:, None] * inv_freq], axis=-1)
    return jnp.cos(ang), jnp.sin(ang)


def apply_rope(x, cos, sin):
    shape = x.shape
    xf = x.astype(jnp.float32).reshape(shape[:-1] + (HEAD_DIM // 2, 2))
    bshape = (1, shape[1]) + (1,) * (x.ndim - 3) + (HEAD_DIM // 2,)
    c = cos.reshape(bshape)
    s = sin.reshape(bshape)
    x0, x1 = xf[..., 0], xf[..., 1]
    out = jnp.stack([x0 * c - x1 * s, x0 * s + x1 * c], axis=-1)
    return out.reshape(shape).astype(x.dtype)


def split_projection(p):
    B_, L, _ = p.shape
    o1 = POOL_WIDTH
    o2 = o1 + ATTN_WIDTH
    o3 = o2 + KV_WIDTH
    u = p[..., :o1]
    q = p[..., o1:o2].reshape(B_, L, N_KV_HEADS, GQA_GROUP, HEAD_DIM)
    k = p[..., o2:o3].reshape(B_, L, N_KV_HEADS, HEAD_DIM)
    v = p[..., o3:].reshape(B_, L, N_KV_HEADS, HEAD_DIM)
    return u, q, k, v


def pool_mixer(u, pool_w, pool_scale):
    B_, L, _ = u.shape
    uf = u.astype(jnp.float32)
    cs = jnp.concatenate([jnp.zeros((B_, 1, POOL_WIDTH), jnp.float32), jnp.cumsum(uf, axis=1)], axis=1)
    t = jnp.arange(L)
    parts = []
    for gi, win in enumerate(POOL_WINDOWS):
        lo = jnp.clip(t - win // 2, 0, L)
        hi = jnp.clip(t + win - win // 2, 0, L)
        sl = slice(gi * POOL_GROUP, (gi + 1) * POOL_GROUP)
        window_mean = (cs[:, hi, sl] - cs[:, lo, sl]) / (hi - lo).astype(jnp.float32)[None, :, None]
        parts.append(window_mean - uf[:, :, sl])
    d = jnp.stack(parts, axis=2).astype(u.dtype)
    y = jnp.einsum('blgc,gcd->blgd', d, pool_w).reshape(B_, L, POOL_WIDTH)
    return y * pool_scale


def attend(q, k, v):
    s = jnp.einsum('bqhgd,bkhd->bhgqk', q, k, preferred_element_type=jnp.float32) * (HEAD_DIM ** -0.5)
    p = jax.nn.softmax(s, axis=-1).astype(v.dtype)
    return jnp.einsum('bhgqk,bkhd->bqhgd', p, v)


def attend_latent_blocks(q, k_all, v_all):
    B_, L = q.shape[:2]
    nb = L // Q_BLOCK
    qb = jnp.moveaxis(q.reshape((B_, nb, Q_BLOCK) + q.shape[2:]), 1, 0)
    o = lax.map(lambda qblk: attend(qblk, k_all, v_all), qb)
    return jnp.moveaxis(o, 0, 1).reshape(B_, L, ATTN_WIDTH)


def moe_ffn(h, w_router, router_bias, w_gate, w_up, w_down, ws_gate, ws_up, ws_down):
    B_, L, D = h.shape
    xt = h.reshape(-1, D)
    T = xt.shape[0]
    scores = jax.nn.sigmoid(jnp.dot(xt.astype(jnp.float32), w_router.astype(jnp.float32)))
    sel = scores + router_bias.astype(jnp.float32)
    grp = sel.reshape(T, N_GROUPS, N_EXPERTS // N_GROUPS)
    grp_score = lax.top_k(grp, 2)[0].sum(-1)
    _, top_groups = lax.top_k(grp_score, TOPK_GROUPS)
    group_mask = jnp.any(top_groups[:, :, None] == jnp.arange(N_GROUPS)[None, None, :], axis=1)
    expert_mask = jnp.repeat(group_mask, N_EXPERTS // N_GROUPS, axis=1)
    sel = jnp.where(expert_mask, sel, -jnp.inf)
    _, idx = lax.top_k(sel, TOP_K)
    wts = jnp.take_along_axis(scores, idx, axis=1)
    wts = wts / jnp.sum(wts, axis=-1, keepdims=True) * ROUTED_SCALE
    A = T * TOP_K
    e_flat = idx.reshape(-1)
    order = jnp.argsort(e_flat)
    e_sorted = e_flat[order]
    tok_sorted = (order // TOP_K).astype(jnp.int32)
    w_sorted = wts.reshape(-1)[order]
    counts = jnp.bincount(e_flat, length=N_EXPERTS)
    start = jnp.cumsum(counts) - counts
    padded = ((counts + EXPERT_BLOCK - 1) // EXPERT_BLOCK) * EXPERT_BLOCK
    pad_end = jnp.cumsum(padded)
    pad_start = pad_end - padded
    dest = pad_start[e_sorted] + (jnp.arange(A) - start[e_sorted])
    P = A + N_EXPERTS * EXPERT_BLOCK
    n_blocks = P // EXPERT_BLOCK
    row_tok = jnp.full((P,), T, jnp.int32).at[dest].set(tok_sorted)
    row_w = jnp.zeros((P,), jnp.float32).at[dest].set(w_sorted)
    block_expert = jnp.minimum(jnp.searchsorted(pad_end, jnp.arange(n_blocks) * EXPERT_BLOCK, side='right'), N_EXPERTS - 1)
    xpad = jnp.concatenate([xt, jnp.zeros((1, D), xt.dtype)], axis=0)

    def expert_block(out, blk):
        tok, wr, e = blk
        rows = xpad[tok]
        y = (jax.nn.silu(rows @ w_gate[e]) * (rows @ w_up[e])) @ w_down[e]
        return out.at[tok].add((y * wr[:, None]).astype(out.dtype)), None

    routed, _ = lax.scan(expert_block, jnp.zeros((T + 1, D), xt.dtype),
                         (row_tok.reshape(n_blocks, EXPERT_BLOCK), row_w.reshape(n_blocks, EXPERT_BLOCK), block_expert))
    shared = (jax.nn.silu(xt @ ws_gate) * (xt @ ws_up)) @ ws_down
    return (routed[:T] + shared).reshape(B_, L, D)


def setup_inputs(seed: int = 0) -> dict:
    key = jax.random.key(seed)
    ks = jax.random.split(key, 26)

    def nrm(k, shape, scale):
        return scale * jax.random.normal(k, shape, jnp.float32)

    Dm = D_MODEL
    return {
        'x': nrm(ks[0], (BATCH, SEQ, Dm), 1.0),
        'c': nrm(ks[1], (BATCH, Dm), 1.0),
        'ctx': nrm(ks[2], (BATCH, CTX_LEN, Dm), 1.0),
        'c_ctx': nrm(ks[3], (Dm,), 1.0),
        'w_mod': nrm(ks[4], (DEPTH, Dm, 6 * Dm), 0.5 * Dm ** -0.5),
        'b_mod': nrm(ks[5], (DEPTH, 6 * Dm), 0.02),
        'w_in': nrm(ks[6], (DEPTH, Dm, PROJ_WIDTH), Dm ** -0.5),
        'q_norm': 1.0 + nrm(ks[7], (DEPTH, HEAD_DIM), 0.05),
        'k_norm': 1.0 + nrm(ks[8], (DEPTH, HEAD_DIM), 0.05),
        'pool_w': nrm(ks[9], (DEPTH, len(POOL_WINDOWS), POOL_GROUP, POOL_GROUP), POOL_GROUP ** -0.5),
        'pool_scale': 1.0 + nrm(ks[10], (DEPTH, POOL_WIDTH), 0.05),
        'w_out': nrm(ks[11], (DEPTH, D_MIX, Dm), BETA * D_MIX ** -0.5),
        'ln1_g': 1.0 + nrm(ks[12], (DEPTH, Dm), 0.05),
        'ln1_b': nrm(ks[13], (DEPTH, Dm), 0.02),
        'w_router': nrm(ks[14], (DEPTH, Dm, N_EXPERTS), Dm ** -0.5),
        'router_bias': nrm(ks[15], (DEPTH, N_EXPERTS), 0.01),
        'w_gate': nrm(ks[16], (DEPTH, N_EXPERTS, Dm, EXPERT_FF), Dm ** -0.5),
        'w_up': nrm(ks[17], (DEPTH, N_EXPERTS, Dm, EXPERT_FF), Dm ** -0.5),
        'w_down': nrm(ks[18], (DEPTH, N_EXPERTS, EXPERT_FF, Dm), BETA * EXPERT_FF ** -0.5),
        'ws_gate': nrm(ks[19], (DEPTH, Dm, SHARED_FF), Dm ** -0.5),
        'ws_up': nrm(ks[20], (DEPTH, Dm, SHARED_FF), Dm ** -0.5),
        'ws_down': nrm(ks[21], (DEPTH, SHARED_FF, Dm), BETA * SHARED_FF ** -0.5),
        'ln2_g': 1.0 + nrm(ks[22], (DEPTH, Dm), 0.05),
        'ln2_b': nrm(ks[23], (DEPTH, Dm), 0.02),
    }


def reference(x, c, ctx, c_ctx, w_mod, b_mod, w_in, q_norm, k_norm, pool_w, pool_scale, w_out,
              ln1_g, ln1_b, w_router, router_bias, w_gate, w_up, w_down, ws_gate, ws_up, ws_down,
              ln2_g, ln2_b):
    B_, S_, _ = x.shape
    rows = S_ // GRID_W
    cos, sin = axial_rope_tables(rows)
    for i in range(DEPTH):
        last = i == DEPTH - 1
        mod_lat = (jax.nn.silu(c) @ w_mod[i] + b_mod[i])[:, None, :]
        mod_ctx = (jax.nn.silu(c_ctx) @ w_mod[i] + b_mod[i])[None, None, :]
        sh1, sc1, g1, sh2, sc2, g2 = jnp.split(mod_lat, 6, axis=-1)
        csh1, csc1, cg1, csh2, csc2, cg2 = jnp.split(mod_ctx, 6, axis=-1)

        u_l, q_l, k_l, v_l = split_projection((x * (1.0 + sc1) + sh1) @ w_in[i])
        u_c, q_c, k_c, v_c = split_projection((ctx * (1.0 + csc1) + csh1) @ w_in[i])
        q_l = apply_rope(head_rms_norm(q_l, q_norm[i]), cos, sin)
        k_l = apply_rope(head_rms_norm(k_l, k_norm[i]), cos, sin)
        k_c = head_rms_norm(k_c, k_norm[i])
        k_all = jnp.concatenate([k_c, k_l], axis=1)
        v_all = jnp.concatenate([v_c, v_l], axis=1)
        attn_l = attend_latent_blocks(q_l, k_all, v_all)
        mix_l = jnp.concatenate([pool_mixer(u_l, pool_w[i], pool_scale[i]), attn_l], axis=-1) @ w_out[i]
        x_mid = layer_norm(ALPHA * x + g1 * mix_l, ln1_g[i], ln1_b[i])
        ffn_l = moe_ffn(x_mid * (1.0 + sc2) + sh2, w_router[i], router_bias[i], w_gate[i], w_up[i],
                        w_down[i], ws_gate[i], ws_up[i], ws_down[i])
        x_new = layer_norm(ALPHA * x_mid + g2 * ffn_l, ln2_g[i], ln2_b[i])

        if not last:
            q_c = head_rms_norm(q_c, q_norm[i])
            attn_c = attend(q_c, k_c, v_c).reshape(B_, ctx.shape[1], ATTN_WIDTH)
            mix_c = jnp.concatenate([pool_mixer(u_c, pool_w[i], pool_scale[i]), attn_c], axis=-1) @ w_out[i]
            ctx_mid = layer_norm(ALPHA * ctx + cg1 * mix_c, ln1_g[i], ln1_b[i])
            ffn_c = moe_ffn(ctx_mid * (1.0 + csc2) + csh2, w_router[i], router_bias[i], w_gate[i], w_up[i],
                            w_down[i], ws_gate[i], ws_up[i], ws_down[i])
            ctx = layer_norm(ALPHA * ctx_mid + cg2 * ffn_c, ln2_g[i], ln2_b[i])
        x = x_new
    return x
```

```cpp
#include <hip/hip_runtime.h>
#include <hip/hip_cooperative_groups.h>
#include <stdint.h>
#include <stdio.h>
namespace cg = cooperative_groups;

#ifndef FUSED
#define FUSED 0
#endif

#define LAS __attribute__((address_space(3)))
typedef unsigned short bf16_t;
typedef short bf16x8 __attribute__((ext_vector_type(8)));
typedef float f32x4 __attribute__((ext_vector_type(4)));
typedef unsigned u32x4 __attribute__((ext_vector_type(4)));
typedef unsigned u32x2 __attribute__((ext_vector_type(2)));

constexpr int D = 1024, NB = 16, SEQ = 2048, T = NB * SEQ, CTXL = 256, TC = NB * CTXL, KVL = CTXL + SEQ;
constexpr int PW = 1536, NE = 64, NEX = 65, FF = 256, NSLOT = 9, MODW = 6 * D;
constexpr float ALPHA = 1.189207115002721f;
constexpr float C2 = 0.125f * 1.4426950408889634f;
constexpr int NPHASE = 16;

constexpr size_t MiB = 1u << 20;
constexpr size_t OFF_CNT = 0, OFF_MOD = 4096, OFF_ROPE = 512 * 1024;
constexpr size_t OFF_WTIN = 1 * MiB, OFF_WTOUT = 4 * MiB, OFF_WGU = 6 * MiB, OFF_WD = 71 * MiB;
constexpr size_t OFF_H = 104 * MiB, OFF_LDST = 168 * MiB, OFF_LW = 176 * MiB, OFF_ACT = 184 * MiB, OFF_SLOTS = 333 * MiB;
constexpr size_t OFF_XN = 184 * MiB, OFF_Q = 256 * MiB, OFF_K = 304 * MiB, OFF_V = 322 * MiB, OFF_U = 340 * MiB, OFF_AO = 356 * MiB, OFF_STATS = 420 * MiB;
constexpr size_t WS_NEED = 477 * MiB;

struct Params {
    const float *x, *c, *ctx, *c_ctx, *w_mod, *b_mod, *w_in, *q_norm, *k_norm, *pool_w, *pool_scale, *w_out, *ln1_g, *ln1_b,
        *w_router, *router_bias, *w_gate, *w_up, *w_down, *ws_gate, *ws_up, *ws_down, *ln2_g, *ln2_b;
    float* out;
    unsigned char* ws;
};

__device__ __forceinline__ unsigned f2bf(float f) { unsigned u = __float_as_uint(f); return (u + 0x7fffu + ((u >> 16) & 1u)) >> 16; }
__device__ __forceinline__ unsigned pk2(float lo, float hi) { return f2bf(lo) | (f2bf(hi) << 16); }
__device__ __forceinline__ float bf2f(unsigned h) { return __uint_as_float(h << 16); }
__device__ __forceinline__ float bflo(unsigned w) { return __uint_as_float(w << 16); }
__device__ __forceinline__ float bfhi(unsigned w) { return __uint_as_float(w & 0xffff0000u); }

template <int K, class Epi>
__device__ __forceinline__ void gemm128(LAS unsigned char* lds, const bf16_t* a0, const bf16_t* a1, const bf16_t* bt, const Epi& epi) {
    const int tid = threadIdx.x, lane = tid & 63, wid = tid >> 6, wr = wid >> 1, wc = wid & 1, fr = lane & 15, fq = lane >> 4;
    const bf16_t* b0 = bt + (size_t)(tid >> 2) * K + (tid & 3) * 8;
    const bf16_t* b1 = b0 + (size_t)64 * K;
    f32x4 acc[4][4];
#pragma unroll
    for (int m = 0; m < 4; ++m)
#pragma unroll
        for (int n = 0; n < 4; ++n) acc[m][n] = (f32x4){0.f, 0.f, 0.f, 0.f};
    for (int t = 0; t < K / 32; ++t) {
        __builtin_amdgcn_global_load_lds((const unsigned*)(a0 + t * 32), (LAS unsigned*)(lds + tid * 16), 16, 0, 0);
        __builtin_amdgcn_global_load_lds((const unsigned*)(a1 + t * 32), (LAS unsigned*)(lds + 4096 + tid * 16), 16, 0, 0);
        __builtin_amdgcn_global_load_lds((const unsigned*)(b0 + t * 32), (LAS unsigned*)(lds + 8192 + tid * 16), 16, 0, 0);
        __builtin_amdgcn_global_load_lds((const unsigned*)(b1 + t * 32), (LAS unsigned*)(lds + 12288 + tid * 16), 16, 0, 0);
        asm volatile("s_waitcnt vmcnt(0)" ::: "memory");
        __syncthreads();
        bf16x8 At[4], Bf[4];
#pragma unroll
        for (int m = 0; m < 4; ++m) At[m] = *(const LAS bf16x8*)(lds + (wr * 64 + m * 16 + fr) * 64 + fq * 16);
#pragma unroll
        for (int n = 0; n < 4; ++n) Bf[n] = *(const LAS bf16x8*)(lds + 8192 + (wc * 64 + n * 16 + fr) * 64 + fq * 16);
#pragma unroll
        for (int m = 0; m < 4; ++m)
#pragma unroll
            for (int n = 0; n < 4; ++n) acc[m][n] = __builtin_amdgcn_mfma_f32_16x16x32_bf16(At[m], Bf[n], acc[m][n], 0, 0, 0);
        __syncthreads();
    }
    epi(acc, wr, wc, fr, fq);
}

__device__ __forceinline__ int gu_row(int j, int half) { return (j >> 6) * 128 + ((j >> 5) & 1) * 64 + (2 * ((j >> 4) & 1) + half) * 16 + (j & 15); }

template <class RowMap>
__device__ __forceinline__ void transpose_tile(LAS float* tile, const float* src, int ld, int k0, int n0, bf16_t* dst, int Kdst, RowMap rowmap) {
    const int tid = threadIdx.x;
#pragma unroll
    for (int pss = 0; pss < 4; ++pss) {
        const int k = pss * 16 + (tid >> 4), n4 = (tid & 15) * 4;
        const f32x4 v = *(const f32x4*)(src + (size_t)(k0 + k) * ld + n0 + n4);
        tile[k * 65 + n4 + 0] = v[0]; tile[k * 65 + n4 + 1] = v[1]; tile[k * 65 + n4 + 2] = v[2]; tile[k * 65 + n4 + 3] = v[3];
    }
    __syncthreads();
    {
        const int n = tid >> 2, kc = (tid & 3) * 16;
        unsigned w[8];
#pragma unroll
        for (int i = 0; i < 8; ++i) w[i] = pk2(tile[(kc + 2 * i) * 65 + n], tile[(kc + 2 * i + 1) * 65 + n]);
        bf16_t* dp = dst + (size_t)rowmap(n0 + n) * Kdst + k0 + kc;
        *(u32x4*)dp = (u32x4){w[0], w[1], w[2], w[3]};
        *(u32x4*)(dp + 8) = (u32x4){w[4], w[5], w[6], w[7]};
    }
    __syncthreads();
}

__device__ __forceinline__ void phase_prep(const Params& p, LAS unsigned char* lds) {
    const int tid = threadIdx.x;
    int* gcnt = (int*)(p.ws + OFF_CNT);
    if (blockIdx.x == 0 && tid < 128) gcnt[tid] = 0;
    float* mod = (float*)(p.ws + OFF_MOD);
    float* rope = (float*)(p.ws + OFF_ROPE);
    constexpr int N_MOD = 192, N_ROPE = 256, N_TR = 384 + 256 + NEX * 192;
    for (int it = blockIdx.x; it < N_MOD + N_ROPE + N_TR; it += gridDim.x) {
        if (it < N_MOD) {
            LAS float* red = (LAS float*)lds;
            const int col = it * 32 + (tid & 31), kk = tid >> 5;
            float acc[17];
#pragma unroll
            for (int r = 0; r < 17; ++r) acc[r] = 0.f;
            for (int i = 0; i < 128; ++i) {
                const int k = kk + 8 * i;
                const float wv = p.w_mod[(size_t)k * MODW + col];
#pragma unroll
                for (int r = 0; r < 17; ++r) {
                    const float cv = (r < 16) ? p.c[r * D + k] : p.c_ctx[k];
                    acc[r] += (cv / (1.f + expf(-cv))) * wv;
                }
            }
#pragma unroll
            for (int r = 0; r < 17; ++r) red[(kk * 17 + r) * 32 + (tid & 31)] = acc[r];
            __syncthreads();
            for (int o = tid; o < 17 * 32; o += 256) {
                const int r = o >> 5, j = o & 31;
                float s = p.b_mod[it * 32 + j];
#pragma unroll
                for (int g = 0; g < 8; ++g) s += red[(g * 17 + r) * 32 + j];
                mod[r * MODW + it * 32 + j] = s;
            }
            __syncthreads();
        } else if (it < N_MOD + N_ROPE) {
            const int idx = (it - N_MOD) * 256 + tid, t = idx >> 5, i = idx & 31;
            const int pos = (i < 16) ? (t >> 6) : (t & 63);
            const float invf = (float)exp(-(double)(i & 15) / 16.0 * 9.210340371976184);
            const double ang = (double)((float)pos * invf);
            rope[idx * 2 + 0] = (float)cos(ang);
            rope[idx * 2 + 1] = (float)sin(ang);
        } else {
            LAS float* tile = (LAS float*)lds;
            int idx = it - N_MOD - N_ROPE;
            if (idx < 384) {
                transpose_tile(tile, p.w_in, PW, (idx / 24) * 64, (idx % 24) * 64, (bf16_t*)(p.ws + OFF_WTIN), D, [](int n) { return n; });
            } else if (idx < 640) {
                idx -= 384;
                transpose_tile(tile, p.w_out, D, (idx / 16) * 64, (idx % 16) * 64, (bf16_t*)(p.ws + OFF_WTOUT), D, [](int n) { return n; });
            } else {
                idx -= 640;
                const int e = idx / 192, r = idx % 192;
                if (r < 128) {
                    const int half = r >> 6, rr = r & 63;
                    const float* src = half ? (e < NE ? p.w_up + (size_t)e * D * FF : p.ws_up) : (e < NE ? p.w_gate + (size_t)e * D * FF : p.ws_gate);
                    transpose_tile(tile, src, FF, (rr / 4) * 64, (rr % 4) * 64, (bf16_t*)(p.ws + OFF_WGU) + (size_t)e * 512 * D, D, [half](int n) { return gu_row(n, half); });
                } else {
                    const int rr = r - 128;
                    const float* src = e < NE ? p.w_down + (size_t)e * FF * D : p.ws_down;
                    transpose_tile(tile, src, D, (rr / 16) * 64, (rr % 16) * 64, (bf16_t*)(p.ws + OFF_WD) + (size_t)e * D * FF, FF, [](int n) { return n; });
                }
            }
        }
    }
}

__device__ __forceinline__ void phase_xn(const Params& p) {
    const int lane = threadIdx.x & 63, gw = blockIdx.x * 4 + (threadIdx.x >> 6), ngw = gridDim.x * 4;
    const float* mod = (const float*)(p.ws + OFF_MOD);
    bf16_t* XN = (bf16_t*)(p.ws + OFF_XN);
    for (int row = gw; row < T + TC; row += ngw) {
        const float* src = row < T ? p.x + (size_t)row * D : p.ctx + (size_t)(row - T) * D;
        const float* mr = mod + (size_t)(row < T ? row / SEQ : 16) * MODW;
#pragma unroll
        for (int j = 0; j < 4; ++j) {
            const int c = 4 * lane + 256 * j;
            const f32x4 v = *(const f32x4*)(src + c), sh = *(const f32x4*)(mr + c), sc = *(const f32x4*)(mr + D + c);
            u32x2 o; o.x = pk2(v[0] * (1.f + sc[0]) + sh[0], v[1] * (1.f + sc[1]) + sh[1]); o.y = pk2(v[2] * (1.f + sc[2]) + sh[2], v[3] * (1.f + sc[3]) + sh[3]);
            *(u32x2*)(XN + (size_t)row * D + c) = o;
        }
    }
}

__device__ __forceinline__ void phase_inproj(const Params& p, LAS unsigned char* lds) {
    const int tid = threadIdx.x;
    const bf16_t* XN = (const bf16_t*)(p.ws + OFF_XN);
    const bf16_t* WT = (const bf16_t*)(p.ws + OFF_WTIN);
    bf16_t* Qb = (bf16_t*)(p.ws + OFF_Q); bf16_t* Kb = (bf16_t*)(p.ws + OFF_K); bf16_t* Vb = (bf16_t*)(p.ws + OFF_V); bf16_t* Ub = (bf16_t*)(p.ws + OFF_U);
    const float* rope = (const float*)(p.ws + OFF_ROPE);
    for (int u = blockIdx.x; u < 3072 + 128; u += gridDim.x) {
        int mt, pn;
        if (u < 3072) { mt = u / 12; pn = u % 12; } else { mt = 256 + (u - 3072) / 4; pn = 8 + (u - 3072) % 4; }
        const int row0 = mt * 128;
        const bf16_t* a0 = XN + (size_t)(row0 + (tid >> 2)) * D + (tid & 3) * 8;
        auto epi = [&](f32x4 (&acc)[4][4], int wr, int wc, int fr, int fq) {
            const int cb = pn * 128 + wc * 64;
            const bool is_ctx = row0 >= T;
#pragma unroll
            for (int m = 0; m < 4; ++m)
#pragma unroll
                for (int j = 0; j < 4; ++j) {
                    const int row = row0 + wr * 64 + m * 16 + fq * 4 + j;
                    float v[4] = {acc[m][0][j], acc[m][1][j], acc[m][2][j], acc[m][3][j]};
                    if (cb < 256) {
#pragma unroll
                        for (int n = 0; n < 4; ++n) Ub[(size_t)row * 256 + cb + n * 16 + fr] = (bf16_t)f2bf(v[n]);
                    } else if (cb < 1280) {
                        const bool isq = cb < 1024;
                        const float* g = isq ? p.q_norm : p.k_norm;
                        float ss = v[0] * v[0] + v[1] * v[1] + v[2] * v[2] + v[3] * v[3];
                        ss += __shfl_xor(ss, 1); ss += __shfl_xor(ss, 2); ss += __shfl_xor(ss, 4); ss += __shfl_xor(ss, 8);
                        const float rs = 1.0f / sqrtf(ss * (1.f / 64.f) + 1e-6f);
#pragma unroll
                        for (int n = 0; n < 4; ++n) v[n] = v[n] * rs * g[n * 16 + fr];
                        if (!is_ctx) {
                            const int tpos = row & (SEQ - 1);
#pragma unroll
                            for (int n = 0; n < 4; ++n) {
                                const int d = n * 16 + fr;
                                const float cs = rope[(tpos * 32 + (d >> 1)) * 2], sn = rope[(tpos * 32 + (d >> 1)) * 2 + 1];
                                const float pv = __shfl_xor(v[n], 1);
                                v[n] = (d & 1) ? (pv * sn + v[n] * cs) : (v[n] * cs - pv * sn);
                            }
                        }
                        if (isq) {
#pragma unroll
                            for (int n = 0; n < 4; ++n) Qb[(size_t)row * 768 + (cb - 256) + n * 16 + fr] = (bf16_t)f2bf(v[n] * C2);
                        } else {
                            const size_t krow = is_ctx ? (size_t)((row - T) / CTXL) * KVL + ((row - T) % CTXL) : (size_t)(row / SEQ) * KVL + CTXL + (row % SEQ);
#pragma unroll
                            for (int n = 0; n < 4; ++n) Kb[krow * 256 + (cb - 1024) + n * 16 + fr] = (bf16_t)f2bf(v[n]);
                        }
                    } else {
                        const size_t krow = is_ctx ? (size_t)((row - T) / CTXL) * KVL + ((row - T) % CTXL) : (size_t)(row / SEQ) * KVL + CTXL + (row % SEQ);
#pragma unroll
                        for (int n = 0; n < 4; ++n) Vb[krow * 256 + (cb - 1280) + n * 16 + fr] = (bf16_t)f2bf(v[n]);
                    }
                }
        };
        gemm128<D>(lds, a0, a0 + (size_t)64 * D, WT + (size_t)pn * 128 * D, epi);
    }
}

__device__ __forceinline__ void attn_unit(const Params& p, LAS unsigned char* lds, int unit) {
    const int tid = threadIdx.x, lane = tid & 63, wid = tid >> 6, fr = lane & 15, fq = lane >> 4;
    const int qt = unit & 31, h = (unit >> 5) % 12, b = unit / (32 * 12), kh = h / 3;
    const bf16_t* Qb = (const bf16_t*)(p.ws + OFF_Q);
    const bf16_t* Kb = (const bf16_t*)(p.ws + OFF_K) + (size_t)b * KVL * 256 + kh * 64;
    const bf16_t* Vb = (const bf16_t*)(p.ws + OFF_V) + (size_t)b * KVL * 256 + kh * 64;
    bf16_t* AO = (bf16_t*)(p.ws + OFF_AO);
    LAS bf16_t* Ks = (LAS bf16_t*)lds;
    LAS bf16_t* Vt = (LAS bf16_t*)(lds + 9216);
    LAS bf16_t* Pw = (LAS bf16_t*)(lds + 18432) + wid * 16 * 72;
    const int qrow = b * SEQ + qt * 64 + wid * 16;
    bf16x8 qa[2];
#pragma unroll
    for (int ks = 0; ks < 2; ++ks) qa[ks] = *(const bf16x8*)(Qb + (size_t)(qrow + fr) * 768 + h * 64 + ks * 32 + fq * 8);
    float mrow[4], lrow[4];
    f32x4 o[4];
#pragma unroll
    for (int j = 0; j < 4; ++j) { mrow[j] = -1e30f; lrow[j] = 0.f; o[j] = (f32x4){0.f, 0.f, 0.f, 0.f}; }
    for (int kt = 0; kt < KVL / 64; ++kt) {
        __syncthreads();
#pragma unroll
        for (int i = 0; i < 2; ++i) {
            const int idx = tid + i * 256, key = idx >> 3, dc = (idx & 7) * 8;
            const u32x4 kv = *(const u32x4*)(Kb + (size_t)(kt * 64 + key) * 256 + dc);
            *(LAS u32x4*)(Ks + key * 72 + dc) = kv;
            const u32x4 vv = *(const u32x4*)(Vb + (size_t)(kt * 64 + key) * 256 + dc);
#pragma unroll
            for (int e = 0; e < 4; ++e) { Vt[(dc + 2 * e) * 72 + key] = (bf16_t)(vv[e] & 0xffffu); Vt[(dc + 2 * e + 1) * 72 + key] = (bf16_t)(vv[e] >> 16); }
        }
        __syncthreads();
        f32x4 s[4];
#pragma unroll
        for (int nt = 0; nt < 4; ++nt) {
            s[nt] = (f32x4){0.f, 0.f, 0.f, 0.f};
#pragma unroll
            for (int ks = 0; ks < 2; ++ks) {
                const bf16x8 kb = *(const LAS bf16x8*)(Ks + (nt * 16 + fr) * 72 + ks * 32 + fq * 8);
                s[nt] = __builtin_amdgcn_mfma_f32_16x16x32_bf16(qa[ks], kb, s[nt], 0, 0, 0);
            }
        }
        float alpha[4];
#pragma unroll
        for (int j = 0; j < 4; ++j) {
            float mx = fmaxf(fmaxf(s[0][j], s[1][j]), fmaxf(s[2][j], s[3][j]));
            mx = fmaxf(mx, __shfl_xor(mx, 1)); mx = fmaxf(mx, __shfl_xor(mx, 2)); mx = fmaxf(mx, __shfl_xor(mx, 4)); mx = fmaxf(mx, __shfl_xor(mx, 8));
            const float mn = fmaxf(mrow[j], mx);
            alpha[j] = exp2f(mrow[j] - mn);
            mrow[j] = mn;
            float rsum = 0.f;
#pragma unroll
            for (int nt = 0; nt < 4; ++nt) { const float pe = exp2f(s[nt][j] - mn); s[nt][j] = pe; rsum += pe; }
            rsum += __shfl_xor(rsum, 1); rsum += __shfl_xor(rsum, 2); rsum += __shfl_xor(rsum, 4); rsum += __shfl_xor(rsum, 8);
            lrow[j] = lrow[j] * alpha[j] + rsum;
#pragma unroll
            for (int nt = 0; nt < 4; ++nt) Pw[(fq * 4 + j) * 72 + nt * 16 + fr] = (bf16_t)f2bf(s[nt][j]);
        }
#pragma unroll
        for (int nb = 0; nb < 4; ++nb)
#pragma unroll
            for (int j = 0; j < 4; ++j) o[nb][j] *= alpha[j];
        __syncthreads();
#pragma unroll
        for (int ks = 0; ks < 2; ++ks) {
            const bf16x8 pa = *(const LAS bf16x8*)(Pw + fr * 72 + ks * 32 + fq * 8);
#pragma unroll
            for (int nb = 0; nb < 4; ++nb) {
                const bf16x8 vb = *(const LAS bf16x8*)(Vt + (nb * 16 + fr) * 72 + ks * 32 + fq * 8);
                o[nb] = __builtin_amdgcn_mfma_f32_16x16x32_bf16(pa, vb, o[nb], 0, 0, 0);
            }
        }
    }
#pragma unroll
    for (int j = 0; j < 4; ++j) {
        const float il = 1.0f / lrow[j];
#pragma unroll
        for (int nb = 0; nb < 4; ++nb) AO[(size_t)(qrow + fq * 4 + j) * D + 256 + h * 64 + nb * 16 + fr] = (bf16_t)f2bf(o[nb][j] * il);
    }
}

__device__ __forceinline__ void pool_item(const Params& p, LAS unsigned char* lds, int item) {
    const int tid = threadIdx.x;
    const int gi = item & 3, tile = item >> 2, t0 = tile * 32, b = t0 / SEQ, tl0 = t0 % SEQ, half = 1 << gi;
    const bf16_t* Ub = (const bf16_t*)(p.ws + OFF_U);
    bf16_t* AO = (bf16_t*)(p.ws + OFF_AO);
    LAS float* us = (LAS float*)lds;
    LAS float* dl = (LAS float*)(lds + 48 * 64 * 4);
    __syncthreads();
    for (int i = tid; i < 48 * 64; i += 256) {
        const int r = i >> 6, c = i & 63, tl = tl0 - 8 + r;
        us[i] = (tl >= 0 && tl < SEQ) ? bf2f(Ub[(size_t)(b * SEQ + tl) * 256 + gi * 64 + c]) : 0.f;
    }
    __syncthreads();
    {
        const int c = tid & 63, tg = tid >> 6;
#pragma unroll
        for (int k = 0; k < 8; ++k) {
            const int tk = tg * 8 + k, tl = tl0 + tk;
            const int lo = max(tl - half, 0), hi = min(tl + half, SEQ);
            float s = 0.f;
            for (int r = lo; r < hi; ++r) s += us[(r - tl0 + 8) * 64 + c];
            dl[tk * 64 + c] = s / (float)(hi - lo) - us[(tk + 8) * 64 + c];
        }
    }
    __syncthreads();
    {
        const int dd = tid & 63, tg = tid >> 6;
        float acc[8];
#pragma unroll
        for (int k = 0; k < 8; ++k) acc[k] = 0.f;
        const float* w = p.pool_w + gi * 4096 + dd;
        for (int c = 0; c < 64; ++c) {
            const float wv = w[c * 64];
#pragma unroll
            for (int k = 0; k < 8; ++k) acc[k] += dl[(tg * 8 + k) * 64 + c] * wv;
        }
        const float ps = p.pool_scale[gi * 64 + dd];
#pragma unroll
        for (int k = 0; k < 8; ++k) AO[(size_t)(t0 + tg * 8 + k) * D + gi * 64 + dd] = (bf16_t)f2bf(acc[k] * ps);
    }
}

__device__ __forceinline__ void phase_attn_pool(const Params& p, LAS unsigned char* lds) {
    constexpr int N_ATT = NB * 12 * 32, N_POOL = (T / 32) * 4;
    for (int it = blockIdx.x; it < N_ATT + N_POOL; it += gridDim.x) {
        if (it < N_ATT) attn_unit(p, lds, it); else pool_item(p, lds, it - N_ATT);
    }
}

__device__ __forceinline__ void phase_outproj(const Params& p, LAS unsigned char* lds) {
    const int tid = threadIdx.x;
    const bf16_t* AO = (const bf16_t*)(p.ws + OFF_AO);
    const bf16_t* WT = (const bf16_t*)(p.ws + OFF_WTOUT);
    const float* mod = (const float*)(p.ws + OFF_MOD);
    float* stats = (float*)(p.ws + OFF_STATS);
    for (int u = blockIdx.x; u < 2048; u += gridDim.x) {
        const int mt = u >> 3, pn = u & 7, row0 = mt * 128;
        const bf16_t* a0 = AO + (size_t)(row0 + (tid >> 2)) * D + (tid & 3) * 8;
        const float* g1 = mod + (size_t)(row0 / SEQ) * MODW + 2 * D;
        auto epi = [&](f32x4 (&acc)[4][4], int wr, int wc, int fr, int fq) {
#pragma unroll
            for (int m = 0; m < 4; ++m)
#pragma unroll
                for (int j = 0; j < 4; ++j) {
                    const int row = row0 + wr * 64 + m * 16 + fq * 4 + j;
                    float s1 = 0.f, s2 = 0.f;
#pragma unroll
                    for (int n = 0; n < 4; ++n) {
                        const int col = pn * 128 + wc * 64 + n * 16 + fr;
                        const float y = ALPHA * p.x[(size_t)row * D + col] + g1[col] * acc[m][n][j];
                        p.out[(size_t)row * D + col] = y;
                        s1 += y; s2 += y * y;
                    }
                    s1 += __shfl_xor(s1, 1); s1 += __shfl_xor(s1, 2); s1 += __shfl_xor(s1, 4); s1 += __shfl_xor(s1, 8);
                    s2 += __shfl_xor(s2, 1); s2 += __shfl_xor(s2, 2); s2 += __shfl_xor(s2, 4); s2 += __shfl_xor(s2, 8);
                    if (fr == 0) { stats[((size_t)row * 16 + pn * 2 + wc) * 2] = s1; stats[((size_t)row * 16 + pn * 2 + wc) * 2 + 1] = s2; }
                }
        };
        gemm128<D>(lds, a0, a0 + (size_t)64 * D, WT + (size_t)pn * 128 * D, epi);
    }
}

__device__ __forceinline__ void phase_router(const Params& p, LAS unsigned char* lds) {
    const int tid = threadIdx.x, lane = tid & 63, wid = tid >> 6;
    const float* mod = (const float*)(p.ws + OFF_MOD);
    const float* stats = (const float*)(p.ws + OFF_STATS);
    bf16_t* H = (bf16_t*)(p.ws + OFF_H);
    int* gcnt = (int*)(p.ws + OFF_CNT);
    int* LDST = (int*)(p.ws + OFF_LDST);
    float* LWt = (float*)(p.ws + OFF_LW);
    LAS float* hs = (LAS float*)lds + wid * 16 * 64;
    LAS int* lcnt = (LAS int*)(lds + 16384);
    LAS int* lbase = (LAS int*)(lds + 16384 + 256);
    LAS int* sel_ep = (LAS int*)(lds + 16384 + 512);
    LAS float* sel_w = (LAS float*)(lds + 16384 + 512 + 2048);
    for (int item = blockIdx.x; item < T / 64; item += gridDim.x) {
        const int t0 = item * 64, b = t0 / SEQ, tw0 = t0 + wid * 16;
        __syncthreads();
        if (tid < 64) lcnt[tid] = 0;
        float meanv = 0.f, rstdv = 0.f;
        if (lane < 16) {
            float s1 = 0.f, s2 = 0.f;
            const float* st = stats + (size_t)(tw0 + lane) * 32;
#pragma unroll
            for (int i = 0; i < 16; ++i) { s1 += st[2 * i]; s2 += st[2 * i + 1]; }
            meanv = s1 * (1.f / D);
            const float var = fmaxf(s2 * (1.f / D) - meanv * meanv, 0.f);
            rstdv = 1.0f / sqrtf(var + 1e-5f);
        }
        float acc[16];
#pragma unroll
        for (int r = 0; r < 16; ++r) acc[r] = 0.f;
        for (int kc = 0; kc < 16; ++kc) {
            const int k = kc * 64 + lane;
            const float g = p.ln1_g[k], bb = p.ln1_b[k], sc = mod[(size_t)b * MODW + 4 * D + k], sh = mod[(size_t)b * MODW + 3 * D + k];
            __syncthreads();
#pragma unroll
            for (int r = 0; r < 16; ++r) {
                const size_t off = (size_t)(tw0 + r) * D + k;
                const float y = p.out[off];
                const float mu = __shfl(meanv, r), rs = __shfl(rstdv, r);
                const float xm = (y - mu) * rs * g + bb;
                p.out[off] = xm;
                const float hv = xm * (1.f + sc) + sh;
                H[off] = (bf16_t)f2bf(hv);
                hs[r * 64 + lane] = hv;
            }
            __syncthreads();
            const float* wr_ = p.w_router + (size_t)(kc * 64) * NE + lane;
            for (int k4 = 0; k4 < 16; ++k4) {
                const float w0 = wr_[(k4 * 4 + 0) * NE], w1 = wr_[(k4 * 4 + 1) * NE], w2 = wr_[(k4 * 4 + 2) * NE], w3 = wr_[(k4 * 4 + 3) * NE];
#pragma unroll
                for (int r = 0; r < 16; ++r) {
                    const f32x4 hv = *(const LAS f32x4*)(hs + r * 64 + k4 * 4);
                    acc[r] += hv[0] * w0; acc[r] += hv[1] * w1; acc[r] += hv[2] * w2; acc[r] += hv[3] * w3;
                }
            }
        }
        __syncthreads();
#pragma unroll
        for (int r = 0; r < 16; ++r) hs[r * 64 + lane] = acc[r];
        __syncthreads();
        const float bias = p.router_bias[lane];
        for (int r = 0; r < 16; ++r) {
            const float lg = hs[r * 64 + lane];
            const float s = 1.0f / (1.0f + expf(-lg));
            const float sel = s + bias;
            float m1 = fmaxf(sel, __shfl_xor(sel, 1)); m1 = fmaxf(m1, __shfl_xor(m1, 2)); m1 = fmaxf(m1, __shfl_xor(m1, 4));
            int cand = (sel == m1) ? lane : 64;
            cand = min(cand, __shfl_xor(cand, 1)); cand = min(cand, __shfl_xor(cand, 2)); cand = min(cand, __shfl_xor(cand, 4));
            const float sel2 = (lane == cand) ? -INFINITY : sel;
            float m2 = fmaxf(sel2, __shfl_xor(sel2, 1)); m2 = fmaxf(m2, __shfl_xor(m2, 2)); m2 = fmaxf(m2, __shfl_xor(m2, 4));
            const float gs = m1 + m2;
            const int g = lane >> 3;
            int cntg = 0;
#pragma unroll
            for (int gg = 0; gg < 8; ++gg) { const float v = __shfl(gs, gg * 8); cntg += (v > gs || (v == gs && gg < g)) ? 1 : 0; }
            const bool keep = cntg < 4;
            const float msel = keep ? sel : -INFINITY;
            hs[r * 64 + lane] = msel;
            int cnt = 0;
#pragma unroll 4
            for (int q4 = 0; q4 < 16; ++q4) {
                const f32x4 v = *(const LAS f32x4*)(hs + r * 64 + q4 * 4);
#pragma unroll
                for (int i = 0; i < 4; ++i) cnt += (v[i] > msel || (v[i] == msel && (q4 * 4 + i) < lane)) ? 1 : 0;
            }
            const bool chosen = keep && cnt < 8;
            float wsum = chosen ? s : 0.f;
#pragma unroll
            for (int o = 1; o < 64; o <<= 1) wsum += __shfl_xor(wsum, o);
            if (chosen) {
                const int pos = atomicAdd((int*)&lcnt[lane], 1);
                sel_ep[(wid * 16 + r) * 8 + cnt] = lane | (pos << 8);
                sel_w[(wid * 16 + r) * 8 + cnt] = s / wsum * 2.5f;
            }
        }
        __syncthreads();
        if (tid < 64) lbase[tid] = atomicAdd(&gcnt[tid], lcnt[tid]);
        __syncthreads();
        for (int idx = tid; idx < 512; idx += 256) {
            const int ep = sel_ep[idx], e = ep & 0xff, pos = ep >> 8, gi = lbase[e] + pos;
            LDST[(size_t)e * T + gi] = (t0 + (idx >> 3)) * NSLOT + (idx & 7);
            LWt[(size_t)e * T + gi] = sel_w[idx];
        }
    }
}

__device__ __forceinline__ void moe_setup(const Params& p, LAS int* tstart  , LAS int* ecnt  ) {
    __syncthreads();
    if (threadIdx.x == 0) {
        const int* gcnt = (const int*)(p.ws + OFF_CNT);
        int a = 0;
        for (int e = 0; e < NEX; ++e) { const int c = e < NE ? gcnt[e] : T; ecnt[e] = c; tstart[e] = a; a += (c + 127) >> 7; }
        tstart[NEX] = a;
    }
    __syncthreads();
}
__device__ __forceinline__ int find_expert(LAS const int* tstart, int mt) { int e = 0; while (e < NEX - 1 && mt >= tstart[e + 1]) ++e; return e; }

__device__ __forceinline__ void phase_gateup(const Params& p, LAS unsigned char* lds) {
    const int tid = threadIdx.x;
    LAS int* tstart = (LAS int*)(lds + 16384); LAS int* ecnt = (LAS int*)(lds + 16384 + 512);
    moe_setup(p, tstart, ecnt);
    const bf16_t* H = (const bf16_t*)(p.ws + OFF_H);
    const bf16_t* WGU = (const bf16_t*)(p.ws + OFF_WGU);
    const int* LDST = (const int*)(p.ws + OFF_LDST);
    const float* LWt = (const float*)(p.ws + OFF_LW);
    bf16_t* ACT = (bf16_t*)(p.ws + OFF_ACT);
    const int MT = tstart[NEX];
    for (int u = blockIdx.x; u < MT * 4; u += gridDim.x) {
        const int mt = u >> 2, pn = u & 3, e = find_expert(tstart, mt), i0 = (mt - tstart[e]) * 128, cnt = ecnt[e];
        const bf16_t* ap[2];
#pragma unroll
        for (int i = 0; i < 2; ++i) {
            const int li = i0 + (tid >> 2) + i * 64;
            int tok = 0;
            if (li < cnt) tok = e < NE ? LDST[(size_t)e * T + li] / NSLOT : li;
            ap[i] = H + (size_t)tok * D + (tid & 3) * 8;
        }
        auto epi = [&](f32x4 (&acc)[4][4], int wr, int wc, int fr, int fq) {
#pragma unroll
            for (int m = 0; m < 4; ++m)
#pragma unroll
                for (int j = 0; j < 4; ++j) {
                    const int li = i0 + wr * 64 + m * 16 + fq * 4 + j;
                    const float wrow = li < cnt ? (e < NE ? LWt[(size_t)e * T + li] : 1.f) : 0.f;
                    bf16_t* dst = ACT + (size_t)(tstart[e] * 128 + li) * FF + pn * 64 + wc * 32 + fr;
#pragma unroll
                    for (int np = 0; np < 2; ++np) {
                        const float g = acc[m][2 * np][j], uu = acc[m][2 * np + 1][j];
                        dst[np * 16] = (bf16_t)f2bf(g / (1.f + expf(-g)) * uu * wrow);
                    }
                }
        };
        gemm128<D>(lds, ap[0], ap[1], WGU + (size_t)e * 512 * D + (size_t)pn * 128 * D, epi);
    }
}

__device__ __forceinline__ void phase_down(const Params& p, LAS unsigned char* lds, int c) {
    const int tid = threadIdx.x;
    LAS int* tstart = (LAS int*)(lds + 16384); LAS int* ecnt = (LAS int*)(lds + 16384 + 512);
    moe_setup(p, tstart, ecnt);
    const bf16_t* WD = (const bf16_t*)(p.ws + OFF_WD);
    const int* LDST = (const int*)(p.ws + OFF_LDST);
    const bf16_t* ACT = (const bf16_t*)(p.ws + OFF_ACT);
    bf16_t* SL = (bf16_t*)(p.ws + OFF_SLOTS);
    const int MT = tstart[NEX];
    for (int u = blockIdx.x; u < MT * 2; u += gridDim.x) {
        const int mt = u >> 1, pn = u & 1, e = find_expert(tstart, mt), i0 = (mt - tstart[e]) * 128, cnt = ecnt[e];
        const bf16_t* a0 = ACT + (size_t)(mt * 128 + (tid >> 2)) * FF + (tid & 3) * 8;
        auto epi = [&](f32x4 (&acc)[4][4], int wr, int wc, int fr, int fq) {
#pragma unroll
            for (int m = 0; m < 4; ++m)
#pragma unroll
                for (int j = 0; j < 4; ++j) {
                    const int li = i0 + wr * 64 + m * 16 + fq * 4 + j;
                    if (li < cnt) {
                        const int dst = e < NE ? LDST[(size_t)e * T + li] : li * NSLOT + 8;
                        bf16_t* dp = SL + (size_t)dst * 256 + pn * 128 + wc * 64 + fr;
#pragma unroll
                        for (int n = 0; n < 4; ++n) dp[n * 16] = (bf16_t)f2bf(acc[m][n][j]);
                    }
                }
        };
        gemm128<FF>(lds, a0, a0 + (size_t)64 * FF, WD + (size_t)e * D * FF + (size_t)(c * 256 + pn * 128) * FF, epi);
    }
}

__device__ __forceinline__ void phase_combine(const Params& p, int c) {
    const int tid = threadIdx.x;
    const bf16_t* SL = (const bf16_t*)(p.ws + OFF_SLOTS);
    bf16_t* FFN = (bf16_t*)(p.ws + OFF_H);
    for (int item = blockIdx.x; item < T / 8; item += gridDim.x) {
        const int t = item * 8 + (tid >> 5), cc = (tid & 31) * 8;
        float s[8];
#pragma unroll
        for (int i = 0; i < 8; ++i) s[i] = 0.f;
#pragma unroll
        for (int k = 0; k < NSLOT; ++k) {
            const u32x4 v = *(const u32x4*)(SL + (size_t)(t * NSLOT + k) * 256 + cc);
#pragma unroll
            for (int i = 0; i < 4; ++i) { s[2 * i] += bflo(v[i]); s[2 * i + 1] += bfhi(v[i]); }
        }
        *(u32x4*)(FFN + (size_t)t * D + c * 256 + cc) = (u32x4){pk2(s[0], s[1]), pk2(s[2], s[3]), pk2(s[4], s[5]), pk2(s[6], s[7])};
    }
}

__device__ __forceinline__ void phase_final(const Params& p) {
    const int lane = threadIdx.x & 63, gw = blockIdx.x * 4 + (threadIdx.x >> 6), ngw = gridDim.x * 4;
    const float* mod = (const float*)(p.ws + OFF_MOD);
    const bf16_t* FFN = (const bf16_t*)(p.ws + OFF_H);
    for (int row = gw; row < T; row += ngw) {
        const float* g2 = mod + (size_t)(row / SEQ) * MODW + 5 * D;
        f32x4 y[4]; float s = 0.f;
#pragma unroll
        for (int j = 0; j < 4; ++j) {
            const int c = 4 * lane + 256 * j;
            const f32x4 xm = *(const f32x4*)(p.out + (size_t)row * D + c), gg = *(const f32x4*)(g2 + c);
            const u32x2 f = *(const u32x2*)(FFN + (size_t)row * D + c);
            y[j][0] = ALPHA * xm[0] + gg[0] * bflo(f.x); y[j][1] = ALPHA * xm[1] + gg[1] * bfhi(f.x);
            y[j][2] = ALPHA * xm[2] + gg[2] * bflo(f.y); y[j][3] = ALPHA * xm[3] + gg[3] * bfhi(f.y);
            s += (y[j][0] + y[j][1]) + (y[j][2] + y[j][3]);
        }
#pragma unroll
        for (int o = 1; o < 64; o <<= 1) s += __shfl_xor(s, o);
        const float mean = s * (1.f / D);
        float q = 0.f;
#pragma unroll
        for (int j = 0; j < 4; ++j) { y[j] = y[j] - mean; q += (y[j][0] * y[j][0] + y[j][1] * y[j][1]) + (y[j][2] * y[j][2] + y[j][3] * y[j][3]); }
#pragma unroll
        for (int o = 1; o < 64; o <<= 1) q += __shfl_xor(q, o);
        const float rstd = 1.0f / sqrtf(q * (1.f / D) + 1e-5f);
#pragma unroll
        for (int j = 0; j < 4; ++j) {
            const int c = 4 * lane + 256 * j;
            const f32x4 g = *(const f32x4*)(p.ln2_g + c), bb = *(const f32x4*)(p.ln2_b + c);
            *(f32x4*)(p.out + (size_t)row * D + c) = y[j] * rstd * g + bb;
        }
    }
}

__global__ void __launch_bounds__(256, 2) mk_fwd(Params p, int lo, int hi) {
    __shared__ __attribute__((aligned(16))) unsigned char smem[32768];
    LAS unsigned char* lds = (LAS unsigned char*)smem;
#define RUN_PHASE(k, call) if (lo <= (k) && (k) < hi) { if ((k) > lo) cg::this_grid().sync(); call; }
    RUN_PHASE(0, phase_prep(p, lds))
    RUN_PHASE(1, phase_xn(p))
    RUN_PHASE(2, phase_inproj(p, lds))
    RUN_PHASE(3, phase_attn_pool(p, lds))
    RUN_PHASE(4, phase_outproj(p, lds))
    RUN_PHASE(5, phase_router(p, lds))
    RUN_PHASE(6, phase_gateup(p, lds))
    RUN_PHASE(7, phase_down(p, lds, 0))
    RUN_PHASE(8, phase_combine(p, 0))
    RUN_PHASE(9, phase_down(p, lds, 1))
    RUN_PHASE(10, phase_combine(p, 1))
    RUN_PHASE(11, phase_down(p, lds, 2))
    RUN_PHASE(12, phase_combine(p, 2))
    RUN_PHASE(13, phase_down(p, lds, 3))
    RUN_PHASE(14, phase_combine(p, 3))
    RUN_PHASE(15, phase_final(p))
}

extern "C" void kernel_launch(void* const* d_in, const int* in_sizes, int n_in, void* d_out, int out_size, void* d_ws, size_t ws_size, hipStream_t stream) {
    static int grid = 0;
    if (grid == 0) {
        int dev = 0, cus = 0, per_cu = 0;
        hipGetDevice(&dev);
        hipDeviceGetAttribute(&cus, hipDeviceAttributeMultiprocessorCount, dev);
        hipOccupancyMaxActiveBlocksPerMultiprocessor(&per_cu, mk_fwd, 256, 0);
        if (per_cu > 2) per_cu = 2;
        if (per_cu < 1) per_cu = 1;
        grid = cus * per_cu;
        if (ws_size < WS_NEED) fprintf(stderr, "kernel_launch: workspace too small: %zu < %zu\n", ws_size, (size_t)WS_NEED);
    }
    Params p{};
    const float** pp = (const float**)&p;
    for (int i = 0; i < 24; ++i) pp[i] = (const float*)d_in[i];
    p.out = (float*)d_out; p.ws = (unsigned char*)d_ws;
#if FUSED
    int lo = 0, hi = NPHASE;
    void* args[] = {&p, &lo, &hi};
    hipError_t e = hipLaunchCooperativeKernel((void*)mk_fwd, dim3(grid), dim3(256), args, 0, stream);
    if (e != hipSuccess) fprintf(stderr, "cooperative launch failed: %s (grid %d)\n", hipGetErrorString(e), grid);
#else
    for (int ph = 0; ph < NPHASE; ++ph) hipLaunchKernelGGL(mk_fwd, dim3(grid), dim3(256), 0, stream, p, ph, ph + 1);
#endif
}
```

```cpp
#include <hip/hip_runtime.h>
#include <hip/hip_cooperative_groups.h>
#include <stdint.h>
#include <stdio.h>
namespace cg = cooperative_groups;

#ifndef FUSED
#define FUSED 1
#endif

#define LAS __attribute__((address_space(3)))
typedef unsigned short bf16_t;
typedef short bf16x8 __attribute__((ext_vector_type(8)));
typedef float f32x4 __attribute__((ext_vector_type(4)));
typedef unsigned u32x4 __attribute__((ext_vector_type(4)));
typedef unsigned u32x2 __attribute__((ext_vector_type(2)));

constexpr int D = 1024, NB = 16, SEQ = 2048, T = NB * SEQ, CTXL = 256, TC = NB * CTXL, KVL = CTXL + SEQ;
constexpr int PW = 1536, NE = 64, NEX = 65, FF = 256, NSLOT = 9, MODW = 6 * D;
constexpr float ALPHA = 1.189207115002721f;
constexpr float C2 = 0.125f * 1.4426950408889634f;
constexpr int NPHASE = 16;

constexpr size_t MiB = 1u << 20;
constexpr size_t OFF_CNT = 0, OFF_MOD = 4096, OFF_ROPE = 512 * 1024;
constexpr size_t OFF_WTIN = 1 * MiB, OFF_WTOUT = 4 * MiB, OFF_WGU = 6 * MiB, OFF_WD = 71 * MiB;
constexpr size_t OFF_H = 104 * MiB, OFF_LDST = 168 * MiB, OFF_LW = 176 * MiB, OFF_ACT = 184 * MiB, OFF_SLOTS = 333 * MiB;
constexpr size_t OFF_XN = 184 * MiB, OFF_Q = 256 * MiB, OFF_K = 304 * MiB, OFF_V = 322 * MiB, OFF_U = 340 * MiB, OFF_AO = 356 * MiB, OFF_STATS = 420 * MiB;
constexpr size_t WS_NEED = 477 * MiB;

struct Params {
    const float *x, *c, *ctx, *c_ctx, *w_mod, *b_mod, *w_in, *q_norm, *k_norm, *pool_w, *pool_scale, *w_out, *ln1_g, *ln1_b,
        *w_router, *router_bias, *w_gate, *w_up, *w_down, *ws_gate, *ws_up, *ws_down, *ln2_g, *ln2_b;
    float* out;
    unsigned char* ws;
};

__device__ __forceinline__ unsigned f2bf(float f) { unsigned u = __float_as_uint(f); return (u + 0x7fffu + ((u >> 16) & 1u)) >> 16; }
__device__ __forceinline__ unsigned pk2(float lo, float hi) { return f2bf(lo) | (f2bf(hi) << 16); }
__device__ __forceinline__ float bf2f(unsigned h) { return __uint_as_float(h << 16); }
__device__ __forceinline__ float bflo(unsigned w) { return __uint_as_float(w << 16); }
__device__ __forceinline__ float bfhi(unsigned w) { return __uint_as_float(w & 0xffff0000u); }

template <int K, class Epi>
__device__ __forceinline__ void gemm128(LAS unsigned char* lds, const bf16_t* a0, const bf16_t* a1, const bf16_t* bt, const Epi& epi) {
    const int tid = threadIdx.x, lane = tid & 63, wid = tid >> 6, wr = wid >> 1, wc = wid & 1, fr = lane & 15, fq = lane >> 4;
    const bf16_t* b0 = bt + (size_t)(tid >> 2) * K + (tid & 3) * 8;
    const bf16_t* b1 = b0 + (size_t)64 * K;
    f32x4 acc[4][4];
#pragma unroll
    for (int m = 0; m < 4; ++m)
#pragma unroll
        for (int n = 0; n < 4; ++n) acc[m][n] = (f32x4){0.f, 0.f, 0.f, 0.f};
    for (int t = 0; t < K / 32; ++t) {
        __builtin_amdgcn_global_load_lds((const unsigned*)(a0 + t * 32), (LAS unsigned*)(lds + tid * 16), 16, 0, 0);
        __builtin_amdgcn_global_load_lds((const unsigned*)(a1 + t * 32), (LAS unsigned*)(lds + 4096 + tid * 16), 16, 0, 0);
        __builtin_amdgcn_global_load_lds((const unsigned*)(b0 + t * 32), (LAS unsigned*)(lds + 8192 + tid * 16), 16, 0, 0);
        __builtin_amdgcn_global_load_lds((const unsigned*)(b1 + t * 32), (LAS unsigned*)(lds + 12288 + tid * 16), 16, 0, 0);
        asm volatile("s_waitcnt vmcnt(0)" ::: "memory");
        __syncthreads();
        bf16x8 At[4], Bf[4];
#pragma unroll
        for (int m = 0; m < 4; ++m) At[m] = *(const LAS bf16x8*)(lds + (wr * 64 + m * 16 + fr) * 64 + fq * 16);
#pragma unroll
        for (int n = 0; n < 4; ++n) Bf[n] = *(const LAS bf16x8*)(lds + 8192 + (wc * 64 + n * 16 + fr) * 64 + fq * 16);
#pragma unroll
        for (int m = 0; m < 4; ++m)
#pragma unroll
            for (int n = 0; n < 4; ++n) acc[m][n] = __builtin_amdgcn_mfma_f32_16x16x32_bf16(At[m], Bf[n], acc[m][n], 0, 0, 0);
        __syncthreads();
    }
    epi(acc, wr, wc, fr, fq);
}

__device__ __forceinline__ int gu_row(int j, int half) { return (j >> 6) * 128 + ((j >> 5) & 1) * 64 + (2 * ((j >> 4) & 1) + half) * 16 + (j & 15); }

template <class RowMap>
__device__ __forceinline__ void transpose_tile(LAS float* tile, const float* src, int ld, int k0, int n0, bf16_t* dst, int Kdst, RowMap rowmap) {
    const int tid = threadIdx.x;
#pragma unroll
    for (int pss = 0; pss < 4; ++pss) {
        const int k = pss * 16 + (tid >> 4), n4 = (tid & 15) * 4;
        const f32x4 v = *(const f32x4*)(src + (size_t)(k0 + k) * ld + n0 + n4);
        tile[k * 65 + n4 + 0] = v[0]; tile[k * 65 + n4 + 1] = v[1]; tile[k * 65 + n4 + 2] = v[2]; tile[k * 65 + n4 + 3] = v[3];
    }
    __syncthreads();
    {
        const int n = tid >> 2, kc = (tid & 3) * 16;
        unsigned w[8];
#pragma unroll
        for (int i = 0; i < 8; ++i) w[i] = pk2(tile[(kc + 2 * i) * 65 + n], tile[(kc + 2 * i + 1) * 65 + n]);
        bf16_t* dp = dst + (size_t)rowmap(n0 + n) * Kdst + k0 + kc;
        *(u32x4*)dp = (u32x4){w[0], w[1], w[2], w[3]};
        *(u32x4*)(dp + 8) = (u32x4){w[4], w[5], w[6], w[7]};
    }
    __syncthreads();
}

__device__ __forceinline__ void phase_prep(const Params& p, LAS unsigned char* lds) {
    const int tid = threadIdx.x;
    int* gcnt = (int*)(p.ws + OFF_CNT);
    if (blockIdx.x == 0 && tid < 128) gcnt[tid] = 0;
    float* mod = (float*)(p.ws + OFF_MOD);
    float* rope = (float*)(p.ws + OFF_ROPE);
    constexpr int N_MOD = 192, N_ROPE = 256, N_TR = 384 + 256 + NEX * 192;
    for (int it = blockIdx.x; it < N_MOD + N_ROPE + N_TR; it += gridDim.x) {
        if (it < N_MOD) {
            LAS float* red = (LAS float*)lds;
            const int col = it * 32 + (tid & 31), kk = tid >> 5;
            float acc[17];
#pragma unroll
            for (int r = 0; r < 17; ++r) acc[r] = 0.f;
            for (int i = 0; i < 128; ++i) {
                const int k = kk + 8 * i;
                const float wv = p.w_mod[(size_t)k * MODW + col];
#pragma unroll
                for (int r = 0; r < 17; ++r) {
                    const float cv = (r < 16) ? p.c[r * D + k] : p.c_ctx[k];
                    acc[r] += (cv / (1.f + expf(-cv))) * wv;
                }
            }
#pragma unroll
            for (int r = 0; r < 17; ++r) red[(kk * 17 + r) * 32 + (tid & 31)] = acc[r];
            __syncthreads();
            for (int o = tid; o < 17 * 32; o += 256) {
                const int r = o >> 5, j = o & 31;
                float s = p.b_mod[it * 32 + j];
#pragma unroll
                for (int g = 0; g < 8; ++g) s += red[(g * 17 + r) * 32 + j];
                mod[r * MODW + it * 32 + j] = s;
            }
            __syncthreads();
        } else if (it < N_MOD + N_ROPE) {
            const int idx = (it - N_MOD) * 256 + tid, t = idx >> 5, i = idx & 31;
            const int pos = (i < 16) ? (t >> 6) : (t & 63);
            const float invf = (float)exp(-(double)(i & 15) / 16.0 * 9.210340371976184);
            const double ang = (double)((float)pos * invf);
            rope[idx * 2 + 0] = (float)cos(ang);
            rope[idx * 2 + 1] = (float)sin(ang);
        } else {
            LAS float* tile = (LAS float*)lds;
            int idx = it - N_MOD - N_ROPE;
            if (idx < 384) {
                transpose_tile(tile, p.w_in, PW, (idx / 24) * 64, (idx % 24) * 64, (bf16_t*)(p.ws + OFF_WTIN), D, [](int n) { return n; });
            } else if (idx < 640) {
                idx -= 384;
                transpose_tile(tile, p.w_out, D, (idx / 16) * 64, (idx % 16) * 64, (bf16_t*)(p.ws + OFF_WTOUT), D, [](int n) { return n; });
            } else {
                idx -= 640;
                const int e = idx / 192, r = idx % 192;
                if (r < 128) {
                    const int half = r >> 6, rr = r & 63;
                    const float* src = half ? (e < NE ? p.w_up + (size_t)e * D * FF : p.ws_up) : (e < NE ? p.w_gate + (size_t)e * D * FF : p.ws_gate);
                    transpose_tile(tile, src, FF, (rr / 4) * 64, (rr % 4) * 64, (bf16_t*)(p.ws + OFF_WGU) + (size_t)e * 512 * D, D, [half](int n) { return gu_row(n, half); });
                } else {
                    const int rr = r - 128;
                    const float* src = e < NE ? p.w_down + (size_t)e * FF * D : p.ws_down;
                    transpose_tile(tile, src, D, (rr / 16) * 64, (rr % 16) * 64, (bf16_t*)(p.ws + OFF_WD) + (size_t)e * D * FF, FF, [](int n) { return n; });
                }
            }
        }
    }
}

__device__ __forceinline__ void phase_xn(const Params& p) {
    const int lane = threadIdx.x & 63, gw = blockIdx.x * 4 + (threadIdx.x >> 6), ngw = gridDim.x * 4;
    const float* mod = (const float*)(p.ws + OFF_MOD);
    bf16_t* XN = (bf16_t*)(p.ws + OFF_XN);
    for (int row = gw; row < T + TC; row += ngw) {
        const float* src = row < T ? p.x + (size_t)row * D : p.ctx + (size_t)(row - T) * D;
        const float* mr = mod + (size_t)(row < T ? row / SEQ : 16) * MODW;
#pragma unroll
        for (int j = 0; j < 4; ++j) {
            const int c = 4 * lane + 256 * j;
            const f32x4 v = *(const f32x4*)(src + c), sh = *(const f32x4*)(mr + c), sc = *(const f32x4*)(mr + D + c);
            u32x2 o; o.x = pk2(v[0] * (1.f + sc[0]) + sh[0], v[1] * (1.f + sc[1]) + sh[1]); o.y = pk2(v[2] * (1.f + sc[2]) + sh[2], v[3] * (1.f + sc[3]) + sh[3]);
            *(u32x2*)(XN + (size_t)row * D + c) = o;
        }
    }
}

__device__ __forceinline__ void phase_inproj(const Params& p, LAS unsigned char* lds) {
    const int tid = threadIdx.x;
    const bf16_t* XN = (const bf16_t*)(p.ws + OFF_XN);
    const bf16_t* WT = (const bf16_t*)(p.ws + OFF_WTIN);
    bf16_t* Qb = (bf16_t*)(p.ws + OFF_Q); bf16_t* Kb = (bf16_t*)(p.ws + OFF_K); bf16_t* Vb = (bf16_t*)(p.ws + OFF_V); bf16_t* Ub = (bf16_t*)(p.ws + OFF_U);
    const float* rope = (const float*)(p.ws + OFF_ROPE);
    for (int u = blockIdx.x; u < 3072 + 128; u += gridDim.x) {
        int mt, pn;
        if (u < 3072) { mt = u / 12; pn = u % 12; } else { mt = 256 + (u - 3072) / 4; pn = 8 + (u - 3072) % 4; }
        const int row0 = mt * 128;
        const bf16_t* a0 = XN + (size_t)(row0 + (tid >> 2)) * D + (tid & 3) * 8;
        auto epi = [&](f32x4 (&acc)[4][4], int wr, int wc, int fr, int fq) {
            const int cb = pn * 128 + wc * 64;
            const bool is_ctx = row0 >= T;
#pragma unroll
            for (int m = 0; m < 4; ++m)
#pragma unroll
                for (int j = 0; j < 4; ++j) {
                    const int row = row0 + wr * 64 + m * 16 + fq * 4 + j;
                    float v[4] = {acc[m][0][j], acc[m][1][j], acc[m][2][j], acc[m][3][j]};
                    if (cb < 256) {
#pragma unroll
                        for (int n = 0; n < 4; ++n) Ub[(size_t)row * 256 + cb + n * 16 + fr] = (bf16_t)f2bf(v[n]);
                    } else if (cb < 1280) {
                        const bool isq = cb < 1024;
                        const float* g = isq ? p.q_norm : p.k_norm;
                        float ss = v[0] * v[0] + v[1] * v[1] + v[2] * v[2] + v[3] * v[3];
                        ss += __shfl_xor(ss, 1); ss += __shfl_xor(ss, 2); ss += __shfl_xor(ss, 4); ss += __shfl_xor(ss, 8);
                        const float rs = 1.0f / sqrtf(ss * (1.f / 64.f) + 1e-6f);
#pragma unroll
                        for (int n = 0; n < 4; ++n) v[n] = v[n] * rs * g[n * 16 + fr];
                        if (!is_ctx) {
                            const int tpos = row & (SEQ - 1);
#pragma unroll
                            for (int n = 0; n < 4; ++n) {
                                const int d = n * 16 + fr;
                                const float cs = rope[(tpos * 32 + (d >> 1)) * 2], sn = rope[(tpos * 32 + (d >> 1)) * 2 + 1];
                                const float pv = __shfl_xor(v[n], 1);
                                v[n] = (d & 1) ? (pv * sn + v[n] * cs) : (v[n] * cs - pv * sn);
                            }
                        }
                        if (isq) {
#pragma unroll
                            for (int n = 0; n < 4; ++n) Qb[(size_t)row * 768 + (cb - 256) + n * 16 + fr] = (bf16_t)f2bf(v[n] * C2);
                        } else {
                            const size_t krow = is_ctx ? (size_t)((row - T) / CTXL) * KVL + ((row - T) % CTXL) : (size_t)(row / SEQ) * KVL + CTXL + (row % SEQ);
#pragma unroll
                            for (int n = 0; n < 4; ++n) Kb[krow * 256 + (cb - 1024) + n * 16 + fr] = (bf16_t)f2bf(v[n]);
                        }
                    } else {
                        const size_t krow = is_ctx ? (size_t)((row - T) / CTXL) * KVL + ((row - T) % CTXL) : (size_t)(row / SEQ) * KVL + CTXL + (row % SEQ);
#pragma unroll
                        for (int n = 0; n < 4; ++n) Vb[krow * 256 + (cb - 1280) + n * 16 + fr] = (bf16_t)f2bf(v[n]);
                    }
                }
        };
        gemm128<D>(lds, a0, a0 + (size_t)64 * D, WT + (size_t)pn * 128 * D, epi);
    }
}

__device__ __forceinline__ void attn_unit(const Params& p, LAS unsigned char* lds, int unit) {
    const int tid = threadIdx.x, lane = tid & 63, wid = tid >> 6, fr = lane & 15, fq = lane >> 4;
    const int qt = unit & 31, h = (unit >> 5) % 12, b = unit / (32 * 12), kh = h / 3;
    const bf16_t* Qb = (const bf16_t*)(p.ws + OFF_Q);
    const bf16_t* Kb = (const bf16_t*)(p.ws + OFF_K) + (size_t)b * KVL * 256 + kh * 64;
    const bf16_t* Vb = (const bf16_t*)(p.ws + OFF_V) + (size_t)b * KVL * 256 + kh * 64;
    bf16_t* AO = (bf16_t*)(p.ws + OFF_AO);
    LAS bf16_t* Ks = (LAS bf16_t*)lds;
    LAS bf16_t* Vt = (LAS bf16_t*)(lds + 9216);
    LAS bf16_t* Pw = (LAS bf16_t*)(lds + 18432) + wid * 16 * 72;
    const int qrow = b * SEQ + qt * 64 + wid * 16;
    bf16x8 qa[2];
#pragma unroll
    for (int ks = 0; ks < 2; ++ks) qa[ks] = *(const bf16x8*)(Qb + (size_t)(qrow + fr) * 768 + h * 64 + ks * 32 + fq * 8);
    float mrow[4], lrow[4];
    f32x4 o[4];
#pragma unroll
    for (int j = 0; j < 4; ++j) { mrow[j] = -1e30f; lrow[j] = 0.f; o[j] = (f32x4){0.f, 0.f, 0.f, 0.f}; }
    for (int kt = 0; kt < KVL / 64; ++kt) {
        __syncthreads();
#pragma unroll
        for (int i = 0; i < 2; ++i) {
            const int idx = tid + i * 256, key = idx >> 3, dc = (idx & 7) * 8;
            const u32x4 kv = *(const u32x4*)(Kb + (size_t)(kt * 64 + key) * 256 + dc);
            *(LAS u32x4*)(Ks + key * 72 + dc) = kv;
            const u32x4 vv = *(const u32x4*)(Vb + (size_t)(kt * 64 + key) * 256 + dc);
#pragma unroll
            for (int e = 0; e < 4; ++e) { Vt[(dc + 2 * e) * 72 + key] = (bf16_t)(vv[e] & 0xffffu); Vt[(dc + 2 * e + 1) * 72 + key] = (bf16_t)(vv[e] >> 16); }
        }
        __syncthreads();
        f32x4 s[4];
#pragma unroll
        for (int nt = 0; nt < 4; ++nt) {
            s[nt] = (f32x4){0.f, 0.f, 0.f, 0.f};
#pragma unroll
            for (int ks = 0; ks < 2; ++ks) {
                const bf16x8 kb = *(const LAS bf16x8*)(Ks + (nt * 16 + fr) * 72 + ks * 32 + fq * 8);
                s[nt] = __builtin_amdgcn_mfma_f32_16x16x32_bf16(qa[ks], kb, s[nt], 0, 0, 0);
            }
        }
        float alpha[4];
#pragma unroll
        for (int j = 0; j < 4; ++j) {
            float mx = fmaxf(fmaxf(s[0][j], s[1][j]), fmaxf(s[2][j], s[3][j]));
            mx = fmaxf(mx, __shfl_xor(mx, 1)); mx = fmaxf(mx, __shfl_xor(mx, 2)); mx = fmaxf(mx, __shfl_xor(mx, 4)); mx = fmaxf(mx, __shfl_xor(mx, 8));
            const float mn = fmaxf(mrow[j], mx);
            alpha[j] = exp2f(mrow[j] - mn);
            mrow[j] = mn;
            float rsum = 0.f;
#pragma unroll
            for (int nt = 0; nt < 4; ++nt) { const float pe = exp2f(s[nt][j] - mn); s[nt][j] = pe; rsum += pe; }
            rsum += __shfl_xor(rsum, 1); rsum += __shfl_xor(rsum, 2); rsum += __shfl_xor(rsum, 4); rsum += __shfl_xor(rsum, 8);
            lrow[j] = lrow[j] * alpha[j] + rsum;
#pragma unroll
            for (int nt = 0; nt < 4; ++nt) Pw[(fq * 4 + j) * 72 + nt * 16 + fr] = (bf16_t)f2bf(s[nt][j]);
        }
#pragma unroll
        for (int nb = 0; nb < 4; ++nb)
#pragma unroll
            for (int j = 0; j < 4; ++j) o[nb][j] *= alpha[j];
        __syncthreads();
#pragma unroll
        for (int ks = 0; ks < 2; ++ks) {
            const bf16x8 pa = *(const LAS bf16x8*)(Pw + fr * 72 + ks * 32 + fq * 8);
#pragma unroll
            for (int nb = 0; nb < 4; ++nb) {
                const bf16x8 vb = *(const LAS bf16x8*)(Vt + (nb * 16 + fr) * 72 + ks * 32 + fq * 8);
                o[nb] = __builtin_amdgcn_mfma_f32_16x16x32_bf16(pa, vb, o[nb], 0, 0, 0);
            }
        }
    }
#pragma unroll
    for (int j = 0; j < 4; ++j) {
        const float il = 1.0f / lrow[j];
#pragma unroll
        for (int nb = 0; nb < 4; ++nb) AO[(size_t)(qrow + fq * 4 + j) * D + 256 + h * 64 + nb * 16 + fr] = (bf16_t)f2bf(o[nb][j] * il);
    }
}

__device__ __forceinline__ void pool_item(const Params& p, LAS unsigned char* lds, int item) {
    const int tid = threadIdx.x;
    const int gi = item & 3, tile = item >> 2, t0 = tile * 32, b = t0 / SEQ, tl0 = t0 % SEQ, half = 1 << gi;
    const bf16_t* Ub = (const bf16_t*)(p.ws + OFF_U);
    bf16_t* AO = (bf16_t*)(p.ws + OFF_AO);
    LAS float* us = (LAS float*)lds;
    LAS float* dl = (LAS float*)(lds + 48 * 64 * 4);
    __syncthreads();
    for (int i = tid; i < 48 * 64; i += 256) {
        const int r = i >> 6, c = i & 63, tl = tl0 - 8 + r;
        us[i] = (tl >= 0 && tl < SEQ) ? bf2f(Ub[(size_t)(b * SEQ + tl) * 256 + gi * 64 + c]) : 0.f;
    }
    __syncthreads();
    {
        const int c = tid & 63, tg = tid >> 6;
#pragma unroll
        for (int k = 0; k < 8; ++k) {
            const int tk = tg * 8 + k, tl = tl0 + tk;
            const int lo = max(tl - half, 0), hi = min(tl + half, SEQ);
            float s = 0.f;
            for (int r = lo; r < hi; ++r) s += us[(r - tl0 + 8) * 64 + c];
            dl[tk * 64 + c] = s / (float)(hi - lo) - us[(tk + 8) * 64 + c];
        }
    }
    __syncthreads();
    {
        const int dd = tid & 63, tg = tid >> 6;
        float acc[8];
#pragma unroll
        for (int k = 0; k < 8; ++k) acc[k] = 0.f;
        const float* w = p.pool_w + gi * 4096 + dd;
        for (int c = 0; c < 64; ++c) {
            const float wv = w[c * 64];
#pragma unroll
            for (int k = 0; k < 8; ++k) acc[k] += dl[(tg * 8 + k) * 64 + c] * wv;
        }
        const float ps = p.pool_scale[gi * 64 + dd];
#pragma unroll
        for (int k = 0; k < 8; ++k) AO[(size_t)(t0 + tg * 8 + k) * D + gi * 64 + dd] = (bf16_t)f2bf(acc[k] * ps);
    }
}

__device__ __forceinline__ void phase_attn_pool(const Params& p, LAS unsigned char* lds) {
    constexpr int N_ATT = NB * 12 * 32, N_POOL = (T / 32) * 4;
    for (int it = blockIdx.x; it < N_ATT + N_POOL; it += gridDim.x) {
        if (it < N_ATT) attn_unit(p, lds, it); else pool_item(p, lds, it - N_ATT);
    }
}

__device__ __forceinline__ void phase_outproj(const Params& p, LAS unsigned char* lds) {
    const int tid = threadIdx.x;
    const bf16_t* AO = (const bf16_t*)(p.ws + OFF_AO);
    const bf16_t* WT = (const bf16_t*)(p.ws + OFF_WTOUT);
    const float* mod = (const float*)(p.ws + OFF_MOD);
    float* stats = (float*)(p.ws + OFF_STATS);
    for (int u = blockIdx.x; u < 2048; u += gridDim.x) {
        const int mt = u >> 3, pn = u & 7, row0 = mt * 128;
        const bf16_t* a0 = AO + (size_t)(row0 + (tid >> 2)) * D + (tid & 3) * 8;
        const float* g1 = mod + (size_t)(row0 / SEQ) * MODW + 2 * D;
        auto epi = [&](f32x4 (&acc)[4][4], int wr, int wc, int fr, int fq) {
#pragma unroll
            for (int m = 0; m < 4; ++m)
#pragma unroll
                for (int j = 0; j < 4; ++j) {
                    const int row = row0 + wr * 64 + m * 16 + fq * 4 + j;
                    float s1 = 0.f, s2 = 0.f;
#pragma unroll
                    for (int n = 0; n < 4; ++n) {
                        const int col = pn * 128 + wc * 64 + n * 16 + fr;
                        const float y = ALPHA * p.x[(size_t)row * D + col] + g1[col] * acc[m][n][j];
                        p.out[(size_t)row * D + col] = y;
                        s1 += y; s2 += y * y;
                    }
                    s1 += __shfl_xor(s1, 1); s1 += __shfl_xor(s1, 2); s1 += __shfl_xor(s1, 4); s1 += __shfl_xor(s1, 8);
                    s2 += __shfl_xor(s2, 1); s2 += __shfl_xor(s2, 2); s2 += __shfl_xor(s2, 4); s2 += __shfl_xor(s2, 8);
                    if (fr == 0) { stats[((size_t)row * 16 + pn * 2 + wc) * 2] = s1; stats[((size_t)row * 16 + pn * 2 + wc) * 2 + 1] = s2; }
                }
        };
        gemm128<D>(lds, a0, a0 + (size_t)64 * D, WT + (size_t)pn * 128 * D, epi);
    }
}

__device__ __forceinline__ void phase_router(const Params& p, LAS unsigned char* lds) {
    const int tid = threadIdx.x, lane = tid & 63, wid = tid >> 6;
    const float* mod = (const float*)(p.ws + OFF_MOD);
    const float* stats = (const float*)(p.ws + OFF_STATS);
    bf16_t* H = (bf16_t*)(p.ws + OFF_H);
    int* gcnt = (int*)(p.ws + OFF_CNT);
    int* LDST = (int*)(p.ws + OFF_LDST);
    float* LWt = (float*)(p.ws + OFF_LW);
    LAS float* hs = (LAS float*)lds + wid * 16 * 64;
    LAS int* lcnt = (LAS int*)(lds + 16384);
    LAS int* lbase = (LAS int*)(lds + 16384 + 256);
    LAS int* sel_ep = (LAS int*)(lds + 16384 + 512);
    LAS float* sel_w = (LAS float*)(lds + 16384 + 512 + 2048);
    for (int item = blockIdx.x; item < T / 64; item += gridDim.x) {
        const int t0 = item * 64, b = t0 / SEQ, tw0 = t0 + wid * 16;
        __syncthreads();
        if (tid < 64) lcnt[tid] = 0;
        float meanv = 0.f, rstdv = 0.f;
        if (lane < 16) {
            float s1 = 0.f, s2 = 0.f;
            const float* st = stats + (size_t)(tw0 + lane) * 32;
#pragma unroll
            for (int i = 0; i < 16; ++i) { s1 += st[2 * i]; s2 += st[2 * i + 1]; }
            meanv = s1 * (1.f / D);
            const float var = fmaxf(s2 * (1.f / D) - meanv * meanv, 0.f);
            rstdv = 1.0f / sqrtf(var + 1e-5f);
        }
        float acc[16];
#pragma unroll
        for (int r = 0; r < 16; ++r) acc[r] = 0.f;
        for (int kc = 0; kc < 16; ++kc) {
            const int k = kc * 64 + lane;
            const float g = p.ln1_g[k], bb = p.ln1_b[k], sc = mod[(size_t)b * MODW + 4 * D + k], sh = mod[(size_t)b * MODW + 3 * D + k];
            __syncthreads();
#pragma unroll
            for (int r = 0; r < 16; ++r) {
                const size_t off = (size_t)(tw0 + r) * D + k;
                const float y = p.out[off];
                const float mu = __shfl(meanv, r), rs = __shfl(rstdv, r);
                const float xm = (y - mu) * rs * g + bb;
                p.out[off] = xm;
                const float hv = xm * (1.f + sc) + sh;
                H[off] = (bf16_t)f2bf(hv);
                hs[r * 64 + lane] = hv;
            }
            __syncthreads();
            const float* wr_ = p.w_router + (size_t)(kc * 64) * NE + lane;
            for (int k4 = 0; k4 < 16; ++k4) {
                const float w0 = wr_[(k4 * 4 + 0) * NE], w1 = wr_[(k4 * 4 + 1) * NE], w2 = wr_[(k4 * 4 + 2) * NE], w3 = wr_[(k4 * 4 + 3) * NE];
#pragma unroll
                for (int r = 0; r < 16; ++r) {
                    const f32x4 hv = *(const LAS f32x4*)(hs + r * 64 + k4 * 4);
                    acc[r] += hv[0] * w0; acc[r] += hv[1] * w1; acc[r] += hv[2] * w2; acc[r] += hv[3] * w3;
                }
            }
        }
        __syncthreads();
#pragma unroll
        for (int r = 0; r < 16; ++r) hs[r * 64 + lane] = acc[r];
        __syncthreads();
        const float bias = p.router_bias[lane];
        for (int r = 0; r < 16; ++r) {
            const float lg = hs[r * 64 + lane];
            const float s = 1.0f / (1.0f + expf(-lg));
            const float sel = s + bias;
            float m1 = fmaxf(sel, __shfl_xor(sel, 1)); m1 = fmaxf(m1, __shfl_xor(m1, 2)); m1 = fmaxf(m1, __shfl_xor(m1, 4));
            int cand = (sel == m1) ? lane : 64;
            cand = min(cand, __shfl_xor(cand, 1)); cand = min(cand, __shfl_xor(cand, 2)); cand = min(cand, __shfl_xor(cand, 4));
            const float sel2 = (lane == cand) ? -INFINITY : sel;
            float m2 = fmaxf(sel2, __shfl_xor(sel2, 1)); m2 = fmaxf(m2, __shfl_xor(m2, 2)); m2 = fmaxf(m2, __shfl_xor(m2, 4));
            const float gs = m1 + m2;
            const int g = lane >> 3;
            int cntg = 0;
#pragma unroll
            for (int gg = 0; gg < 8; ++gg) { const float v = __shfl(gs, gg * 8); cntg += (v > gs || (v == gs && gg < g)) ? 1 : 0; }
            const bool keep = cntg < 4;
            const float msel = keep ? sel : -INFINITY;
            hs[r * 64 + lane] = msel;
            int cnt = 0;
#pragma unroll 4
            for (int q4 = 0; q4 < 16; ++q4) {
                const f32x4 v = *(const LAS f32x4*)(hs + r * 64 + q4 * 4);
#pragma unroll
                for (int i = 0; i < 4; ++i) cnt += (v[i] > msel || (v[i] == msel && (q4 * 4 + i) < lane)) ? 1 : 0;
            }
            const bool chosen = keep && cnt < 8;
            float wsum = chosen ? s : 0.f;
#pragma unroll
            for (int o = 1; o < 64; o <<= 1) wsum += __shfl_xor(wsum, o);
            if (chosen) {
                const int pos = atomicAdd((int*)&lcnt[lane], 1);
                sel_ep[(wid * 16 + r) * 8 + cnt] = lane | (pos << 8);
                sel_w[(wid * 16 + r) * 8 + cnt] = s / wsum * 2.5f;
            }
        }
        __syncthreads();
        if (tid < 64) lbase[tid] = atomicAdd(&gcnt[tid], lcnt[tid]);
        __syncthreads();
        for (int idx = tid; idx < 512; idx += 256) {
            const int ep = sel_ep[idx], e = ep & 0xff, pos = ep >> 8, gi = lbase[e] + pos;
            LDST[(size_t)e * T + gi] = (t0 + (idx >> 3)) * NSLOT + (idx & 7);
            LWt[(size_t)e * T + gi] = sel_w[idx];
        }
    }
}

__device__ __forceinline__ void moe_setup(const Params& p, LAS int* tstart  , LAS int* ecnt  ) {
    __syncthreads();
    if (threadIdx.x == 0) {
        const int* gcnt = (const int*)(p.ws + OFF_CNT);
        int a = 0;
        for (int e = 0; e < NEX; ++e) { const int c = e < NE ? gcnt[e] : T; ecnt[e] = c; tstart[e] = a; a += (c + 127) >> 7; }
        tstart[NEX] = a;
    }
    __syncthreads();
}
__device__ __forceinline__ int find_expert(LAS const int* tstart, int mt) { int e = 0; while (e < NEX - 1 && mt >= tstart[e + 1]) ++e; return e; }

__device__ __forceinline__ void phase_gateup(const Params& p, LAS unsigned char* lds) {
    const int tid = threadIdx.x;
    LAS int* tstart = (LAS int*)(lds + 16384); LAS int* ecnt = (LAS int*)(lds + 16384 + 512);
    moe_setup(p, tstart, ecnt);
    const bf16_t* H = (const bf16_t*)(p.ws + OFF_H);
    const bf16_t* WGU = (const bf16_t*)(p.ws + OFF_WGU);
    const int* LDST = (const int*)(p.ws + OFF_LDST);
    const float* LWt = (const float*)(p.ws + OFF_LW);
    bf16_t* ACT = (bf16_t*)(p.ws + OFF_ACT);
    const int MT = tstart[NEX];
    for (int u = blockIdx.x; u < MT * 4; u += gridDim.x) {
        const int mt = u >> 2, pn = u & 3, e = find_expert(tstart, mt), i0 = (mt - tstart[e]) * 128, cnt = ecnt[e];
        const bf16_t* ap[2];
#pragma unroll
        for (int i = 0; i < 2; ++i) {
            const int li = i0 + (tid >> 2) + i * 64;
            int tok = 0;
            if (li < cnt) tok = e < NE ? LDST[(size_t)e * T + li] / NSLOT : li;
            ap[i] = H + (size_t)tok * D + (tid & 3) * 8;
        }
        auto epi = [&](f32x4 (&acc)[4][4], int wr, int wc, int fr, int fq) {
#pragma unroll
            for (int m = 0; m < 4; ++m)
#pragma unroll
                for (int j = 0; j < 4; ++j) {
                    const int li = i0 + wr * 64 + m * 16 + fq * 4 + j;
                    const float wrow = li < cnt ? (e < NE ? LWt[(size_t)e * T + li] : 1.f) : 0.f;
                    bf16_t* dst = ACT + (size_t)(tstart[e] * 128 + li) * FF + pn * 64 + wc * 32 + fr;
#pragma unroll
                    for (int np = 0; np < 2; ++np) {
                        const float g = acc[m][2 * np][j], uu = acc[m][2 * np + 1][j];
                        dst[np * 16] = (bf16_t)f2bf(g / (1.f + expf(-g)) * uu * wrow);
                    }
                }
        };
        gemm128<D>(lds, ap[0], ap[1], WGU + (size_t)e * 512 * D + (size_t)pn * 128 * D, epi);
    }
}

__device__ __forceinline__ void phase_down(const Params& p, LAS unsigned char* lds, int c) {
    const int tid = threadIdx.x;
    LAS int* tstart = (LAS int*)(lds + 16384); LAS int* ecnt = (LAS int*)(lds + 16384 + 512);
    moe_setup(p, tstart, ecnt);
    const bf16_t* WD = (const bf16_t*)(p.ws + OFF_WD);
    const int* LDST = (const int*)(p.ws + OFF_LDST);
    const bf16_t* ACT = (const bf16_t*)(p.ws + OFF_ACT);
    bf16_t* SL = (bf16_t*)(p.ws + OFF_SLOTS);
    const int MT = tstart[NEX];
    for (int u = blockIdx.x; u < MT * 2; u += gridDim.x) {
        const int mt = u >> 1, pn = u & 1, e = find_expert(tstart, mt), i0 = (mt - tstart[e]) * 128, cnt = ecnt[e];
        const bf16_t* a0 = ACT + (size_t)(mt * 128 + (tid >> 2)) * FF + (tid & 3) * 8;
        auto epi = [&](f32x4 (&acc)[4][4], int wr, int wc, int fr, int fq) {
#pragma unroll
            for (int m = 0; m < 4; ++m)
#pragma unroll
                for (int j = 0; j < 4; ++j) {
                    const int li = i0 + wr * 64 + m * 16 + fq * 4 + j;
                    if (li < cnt) {
                        const int dst = e < NE ? LDST[(size_t)e * T + li] : li * NSLOT + 8;
                        bf16_t* dp = SL + (size_t)dst * 256 + pn * 128 + wc * 64 + fr;
#pragma unroll
                        for (int n = 0; n < 4; ++n) dp[n * 16] = (bf16_t)f2bf(acc[m][n][j]);
                    }
                }
        };
        gemm128<FF>(lds, a0, a0 + (size_t)64 * FF, WD + (size_t)e * D * FF + (size_t)(c * 256 + pn * 128) * FF, epi);
    }
}

__device__ __forceinline__ void phase_combine(const Params& p, int c) {
    const int tid = threadIdx.x;
    const bf16_t* SL = (const bf16_t*)(p.ws + OFF_SLOTS);
    bf16_t* FFN = (bf16_t*)(p.ws + OFF_H);
    for (int item = blockIdx.x; item < T / 8; item += gridDim.x) {
        const int t = item * 8 + (tid >> 5), cc = (tid & 31) * 8;
        float s[8];
#pragma unroll
        for (int i = 0; i < 8; ++i) s[i] = 0.f;
#pragma unroll
        for (int k = 0; k < NSLOT; ++k) {
            const u32x4 v = *(const u32x4*)(SL + (size_t)(t * NSLOT + k) * 256 + cc);
#pragma unroll
            for (int i = 0; i < 4; ++i) { s[2 * i] += bflo(v[i]); s[2 * i + 1] += bfhi(v[i]); }
        }
        *(u32x4*)(FFN + (size_t)t * D + c * 256 + cc) = (u32x4){pk2(s[0], s[1]), pk2(s[2], s[3]), pk2(s[4], s[5]), pk2(s[6], s[7])};
    }
}

__device__ __forceinline__ void phase_final(const Params& p) {
    const int lane = threadIdx.x & 63, gw = blockIdx.x * 4 + (threadIdx.x >> 6), ngw = gridDim.x * 4;
    const float* mod = (const float*)(p.ws + OFF_MOD);
    const bf16_t* FFN = (const bf16_t*)(p.ws + OFF_H);
    for (int row = gw; row < T; row += ngw) {
        const float* g2 = mod + (size_t)(row / SEQ) * MODW + 5 * D;
        f32x4 y[4]; float s = 0.f;
#pragma unroll
        for (int j = 0; j < 4; ++j) {
            const int c = 4 * lane + 256 * j;
            const f32x4 xm = *(const f32x4*)(p.out + (size_t)row * D + c), gg = *(const f32x4*)(g2 + c);
            const u32x2 f = *(const u32x2*)(FFN + (size_t)row * D + c);
            y[j][0] = ALPHA * xm[0] + gg[0] * bflo(f.x); y[j][1] = ALPHA * xm[1] + gg[1] * bfhi(f.x);
            y[j][2] = ALPHA * xm[2] + gg[2] * bflo(f.y); y[j][3] = ALPHA * xm[3] + gg[3] * bfhi(f.y);
            s += (y[j][0] + y[j][1]) + (y[j][2] + y[j][3]);
        }
#pragma unroll
        for (int o = 1; o < 64; o <<= 1) s += __shfl_xor(s, o);
        const float mean = s * (1.f / D);
        float q = 0.f;
#pragma unroll
        for (int j = 0; j < 4; ++j) { y[j] = y[j] - mean; q += (y[j][0] * y[j][0] + y[j][1] * y[j][1]) + (y[j][2] * y[j][2] + y[j][3] * y[j][3]); }
#pragma unroll
        for (int o = 1; o < 64; o <<= 1) q += __shfl_xor(q, o);
        const float rstd = 1.0f / sqrtf(q * (1.f / D) + 1e-5f);
#pragma unroll
        for (int j = 0; j < 4; ++j) {
            const int c = 4 * lane + 256 * j;
            const f32x4 g = *(const f32x4*)(p.ln2_g + c), bb = *(const f32x4*)(p.ln2_b + c);
            *(f32x4*)(p.out + (size_t)row * D + c) = y[j] * rstd * g + bb;
        }
    }
}

__global__ void __launch_bounds__(256, 2) mk_fwd(Params p, int lo, int hi) {
    __shared__ __attribute__((aligned(16))) unsigned char smem[32768];
    LAS unsigned char* lds = (LAS unsigned char*)smem;
#define RUN_PHASE(k, call) if (lo <= (k) && (k) < hi) { if ((k) > lo) cg::this_grid().sync(); call; }
    RUN_PHASE(0, phase_prep(p, lds))
    RUN_PHASE(1, phase_xn(p))
    RUN_PHASE(2, phase_inproj(p, lds))
    RUN_PHASE(3, phase_attn_pool(p, lds))
    RUN_PHASE(4, phase_outproj(p, lds))
    RUN_PHASE(5, phase_router(p, lds))
    RUN_PHASE(6, phase_gateup(p, lds))
    RUN_PHASE(7, phase_down(p, lds, 0))
    RUN_PHASE(8, phase_combine(p, 0))
    RUN_PHASE(9, phase_down(p, lds, 1))
    RUN_PHASE(10, phase_combine(p, 1))
    RUN_PHASE(11, phase_down(p, lds, 2))
    RUN_PHASE(12, phase_combine(p, 2))
    RUN_PHASE(13, phase_down(p, lds, 3))
    RUN_PHASE(14, phase_combine(p, 3))
    RUN_PHASE(15, phase_final(p))
}

extern "C" void kernel_launch(void* const* d_in, const int* in_sizes, int n_in, void* d_out, int out_size, void* d_ws, size_t ws_size, hipStream_t stream) {
    static int grid = 0;
    if (grid == 0) {
        int dev = 0, cus = 0, per_cu = 0;
        hipGetDevice(&dev);
        hipDeviceGetAttribute(&cus, hipDeviceAttributeMultiprocessorCount, dev);
        hipOccupancyMaxActiveBlocksPerMultiprocessor(&per_cu, mk_fwd, 256, 0);
        if (per_cu > 2) per_cu = 2;
        if (per_cu < 1) per_cu = 1;
        grid = cus * per_cu;
        if (ws_size < WS_NEED) fprintf(stderr, "kernel_launch: workspace too small: %zu < %zu\n", ws_size, (size_t)WS_NEED);
    }
    Params p{};
    const float** pp = (const float**)&p;
    for (int i = 0; i < 24; ++i) pp[i] = (const float*)d_in[i];
    p.out = (float*)d_out; p.ws = (unsigned char*)d_ws;
#if FUSED
    int lo = 0, hi = NPHASE;
    void* args[] = {&p, &lo, &hi};
    hipError_t e = hipLaunchCooperativeKernel((void*)mk_fwd, dim3(grid), dim3(256), args, 0, stream);
    if (e != hipSuccess) fprintf(stderr, "cooperative launch failed: %s (grid %d)\n", hipGetErrorString(e), grid);
#else
    for (int ph = 0; ph < NPHASE; ++ph) hipLaunchKernelGGL(mk_fwd, dim3(grid), dim3(256), 0, stream, p, ph, ph + 1);
#endif
}
```

```cpp
#include <hip/hip_runtime.h>
#include <stdint.h>
#include <stdio.h>

#ifndef FUSED
#define FUSED 1
#endif

#define LAS __attribute__((address_space(3)))
#define TIDX ((int)(threadIdx.x & 255))
#define VBLK ((int)(blockIdx.x * 2 + (threadIdx.x >> 8)))
#define NVBLK ((int)(gridDim.x * 2))
typedef unsigned short bf16_t;
typedef short bf16x8 __attribute__((ext_vector_type(8)));
typedef float f32x4 __attribute__((ext_vector_type(4)));
typedef unsigned u32x4 __attribute__((ext_vector_type(4)));
typedef unsigned u32x2 __attribute__((ext_vector_type(2)));

constexpr int D = 1024, NB = 16, SEQ = 2048, T = NB * SEQ, CTXL = 256, TC = NB * CTXL, KVL = CTXL + SEQ;
constexpr int PW = 1536, NE = 64, NEX = 65, FF = 256, NSLOT = 9, MODW = 6 * D;
constexpr float ALPHA = 1.189207115002721f;
constexpr float C2 = 0.125f * 1.4426950408889634f;
constexpr int NPHASE = 16;

constexpr size_t MiB = 1u << 20;
constexpr size_t OFF_CNT = 0, OFF_MOD = 4096, OFF_ROPE = 512 * 1024;
constexpr size_t OFF_WTIN = 1 * MiB, OFF_WTOUT = 4 * MiB, OFF_WGU = 6 * MiB, OFF_WD = 71 * MiB;
constexpr size_t OFF_H = 104 * MiB, OFF_LDST = 168 * MiB, OFF_LW = 176 * MiB, OFF_ACT = 184 * MiB, OFF_SLOTS = 333 * MiB;
constexpr size_t OFF_XN = 184 * MiB, OFF_Q = 256 * MiB, OFF_K = 304 * MiB, OFF_V = 322 * MiB, OFF_U = 340 * MiB, OFF_AO = 356 * MiB, OFF_STATS = 420 * MiB;
constexpr size_t WS_NEED = 477 * MiB;

struct Params {
    const float *x, *c, *ctx, *c_ctx, *w_mod, *b_mod, *w_in, *q_norm, *k_norm, *pool_w, *pool_scale, *w_out, *ln1_g, *ln1_b,
        *w_router, *router_bias, *w_gate, *w_up, *w_down, *ws_gate, *ws_up, *ws_down, *ln2_g, *ln2_b;
    float* out;
    unsigned char* ws;
};

__device__ __forceinline__ unsigned f2bf(float f) { unsigned u = __float_as_uint(f); return (u + 0x7fffu + ((u >> 16) & 1u)) >> 16; }
__device__ __forceinline__ unsigned pk2(float lo, float hi) { return f2bf(lo) | (f2bf(hi) << 16); }
__device__ __forceinline__ float bf2f(unsigned h) { return __uint_as_float(h << 16); }
__device__ __forceinline__ float bflo(unsigned w) { return __uint_as_float(w << 16); }
__device__ __forceinline__ float bfhi(unsigned w) { return __uint_as_float(w & 0xffff0000u); }

template <int K, class Epi>
__device__ __forceinline__ void gemm128(LAS unsigned char* lds, const bf16_t* a0, const bf16_t* a1, const bf16_t* bt, const Epi& epi) {
    const int tid = TIDX, lane = tid & 63, wid = tid >> 6, wr = wid >> 1, wc = wid & 1, fr = lane & 15, fq = lane >> 4;
    const bf16_t* b0 = bt + (size_t)(tid >> 2) * K + (tid & 3) * 8;
    const bf16_t* b1 = b0 + (size_t)64 * K;
    f32x4 acc[4][4];
#pragma unroll
    for (int m = 0; m < 4; ++m)
#pragma unroll
        for (int n = 0; n < 4; ++n) acc[m][n] = (f32x4){0.f, 0.f, 0.f, 0.f};
    for (int t = 0; t < K / 32; ++t) {
        __builtin_amdgcn_global_load_lds((const unsigned*)(a0 + t * 32), (LAS unsigned*)(lds + tid * 16), 16, 0, 0);
        __builtin_amdgcn_global_load_lds((const unsigned*)(a1 + t * 32), (LAS unsigned*)(lds + 4096 + tid * 16), 16, 0, 0);
        __builtin_amdgcn_global_load_lds((const unsigned*)(b0 + t * 32), (LAS unsigned*)(lds + 8192 + tid * 16), 16, 0, 0);
        __builtin_amdgcn_global_load_lds((const unsigned*)(b1 + t * 32), (LAS unsigned*)(lds + 12288 + tid * 16), 16, 0, 0);
        asm volatile("s_waitcnt vmcnt(0)" ::: "memory");
        __syncthreads();
        bf16x8 At[4], Bf[4];
#pragma unroll
        for (int m = 0; m < 4; ++m) At[m] = *(const LAS bf16x8*)(lds + (wr * 64 + m * 16 + fr) * 64 + fq * 16);
#pragma unroll
        for (int n = 0; n < 4; ++n) Bf[n] = *(const LAS bf16x8*)(lds + 8192 + (wc * 64 + n * 16 + fr) * 64 + fq * 16);
#pragma unroll
        for (int m = 0; m < 4; ++m)
#pragma unroll
            for (int n = 0; n < 4; ++n) acc[m][n] = __builtin_amdgcn_mfma_f32_16x16x32_bf16(At[m], Bf[n], acc[m][n], 0, 0, 0);
        __syncthreads();
    }
    epi(acc, wr, wc, fr, fq);
}

__device__ __forceinline__ int gu_row(int j, int half) { return (j >> 6) * 128 + ((j >> 5) & 1) * 64 + (2 * ((j >> 4) & 1) + half) * 16 + (j & 15); }

template <class RowMap>
__device__ __forceinline__ void transpose_tile(LAS float* tile, const float* src, int ld, int k0, int n0, bf16_t* dst, int Kdst, RowMap rowmap) {
    const int tid = TIDX;
#pragma unroll
    for (int pss = 0; pss < 4; ++pss) {
        const int k = pss * 16 + (tid >> 4), n4 = (tid & 15) * 4;
        const f32x4 v = *(const f32x4*)(src + (size_t)(k0 + k) * ld + n0 + n4);
        tile[k * 65 + n4 + 0] = v[0]; tile[k * 65 + n4 + 1] = v[1]; tile[k * 65 + n4 + 2] = v[2]; tile[k * 65 + n4 + 3] = v[3];
    }
    __syncthreads();
    {
        const int n = tid >> 2, kc = (tid & 3) * 16;
        unsigned w[8];
#pragma unroll
        for (int i = 0; i < 8; ++i) w[i] = pk2(tile[(kc + 2 * i) * 65 + n], tile[(kc + 2 * i + 1) * 65 + n]);
        bf16_t* dp = dst + (size_t)rowmap(n0 + n) * Kdst + k0 + kc;
        *(u32x4*)dp = (u32x4){w[0], w[1], w[2], w[3]};
        *(u32x4*)(dp + 8) = (u32x4){w[4], w[5], w[6], w[7]};
    }
    __syncthreads();
}

__device__ __forceinline__ void phase_prep(const Params& p, LAS unsigned char* lds) {
    const int tid = TIDX;
    int* gcnt = (int*)(p.ws + OFF_CNT);
    if (VBLK == 0 && tid < 128) gcnt[tid] = 0;
    float* mod = (float*)(p.ws + OFF_MOD);
    float* rope = (float*)(p.ws + OFF_ROPE);
    constexpr int N_MOD = 192, N_ROPE = 256, N_TR = 384 + 256 + NEX * 192;
    for (int it = VBLK; it < N_MOD + N_ROPE + N_TR; it += NVBLK) {
        if (it < N_MOD) {
            LAS float* red = (LAS float*)lds;
            const int col = it * 32 + (tid & 31), kk = tid >> 5;
            float acc[17];
#pragma unroll
            for (int r = 0; r < 17; ++r) acc[r] = 0.f;
            for (int i = 0; i < 128; ++i) {
                const int k = kk + 8 * i;
                const float wv = p.w_mod[(size_t)k * MODW + col];
#pragma unroll
                for (int r = 0; r < 17; ++r) {
                    const float cv = (r < 16) ? p.c[r * D + k] : p.c_ctx[k];
                    acc[r] += (cv / (1.f + expf(-cv))) * wv;
                }
            }
#pragma unroll
            for (int r = 0; r < 17; ++r) red[(kk * 17 + r) * 32 + (tid & 31)] = acc[r];
            __syncthreads();
            for (int o = tid; o < 17 * 32; o += 256) {
                const int r = o >> 5, j = o & 31;
                float s = p.b_mod[it * 32 + j];
#pragma unroll
                for (int g = 0; g < 8; ++g) s += red[(g * 17 + r) * 32 + j];
                mod[r * MODW + it * 32 + j] = s;
            }
            __syncthreads();
        } else if (it < N_MOD + N_ROPE) {
            const int idx = (it - N_MOD) * 256 + tid, t = idx >> 5, i = idx & 31;
            const int pos = (i < 16) ? (t >> 6) : (t & 63);
            const float invf = (float)exp(-(double)(i & 15) / 16.0 * 9.210340371976184);
            const double ang = (double)((float)pos * invf);
            rope[idx * 2 + 0] = (float)cos(ang);
            rope[idx * 2 + 1] = (float)sin(ang);
        } else {
            LAS float* tile = (LAS float*)lds;
            int idx = it - N_MOD - N_ROPE;
            if (idx < 384) {
                transpose_tile(tile, p.w_in, PW, (idx / 24) * 64, (idx % 24) * 64, (bf16_t*)(p.ws + OFF_WTIN), D, [](int n) { return n; });
            } else if (idx < 640) {
                idx -= 384;
                transpose_tile(tile, p.w_out, D, (idx / 16) * 64, (idx % 16) * 64, (bf16_t*)(p.ws + OFF_WTOUT), D, [](int n) { return n; });
            } else {
                idx -= 640;
                const int e = idx / 192, r = idx % 192;
                if (r < 128) {
                    const int half = r >> 6, rr = r & 63;
                    const float* src = half ? (e < NE ? p.w_up + (size_t)e * D * FF : p.ws_up) : (e < NE ? p.w_gate + (size_t)e * D * FF : p.ws_gate);
                    transpose_tile(tile, src, FF, (rr / 4) * 64, (rr % 4) * 64, (bf16_t*)(p.ws + OFF_WGU) + (size_t)e * 512 * D, D, [half](int n) { return gu_row(n, half); });
                } else {
                    const int rr = r - 128;
                    const float* src = e < NE ? p.w_down + (size_t)e * FF * D : p.ws_down;
                    transpose_tile(tile, src, D, (rr / 16) * 64, (rr % 16) * 64, (bf16_t*)(p.ws + OFF_WD) + (size_t)e * D * FF, FF, [](int n) { return n; });
                }
            }
        }
    }
}

__device__ __forceinline__ void phase_xn(const Params& p) {
    const int lane = TIDX & 63, gw = VBLK * 4 + (TIDX >> 6), ngw = NVBLK * 4;
    const float* mod = (const float*)(p.ws + OFF_MOD);
    bf16_t* XN = (bf16_t*)(p.ws + OFF_XN);
    for (int row = gw; row < T + TC; row += ngw) {
        const float* src = row < T ? p.x + (size_t)row * D : p.ctx + (size_t)(row - T) * D;
        const float* mr = mod + (size_t)(row < T ? row / SEQ : 16) * MODW;
#pragma unroll
        for (int j = 0; j < 4; ++j) {
            const int c = 4 * lane + 256 * j;
            const f32x4 v = *(const f32x4*)(src + c), sh = *(const f32x4*)(mr + c), sc = *(const f32x4*)(mr + D + c);
            u32x2 o; o.x = pk2(v[0] * (1.f + sc[0]) + sh[0], v[1] * (1.f + sc[1]) + sh[1]); o.y = pk2(v[2] * (1.f + sc[2]) + sh[2], v[3] * (1.f + sc[3]) + sh[3]);
            *(u32x2*)(XN + (size_t)row * D + c) = o;
        }
    }
}

__device__ __forceinline__ void phase_inproj(const Params& p, LAS unsigned char* lds) {
    const int tid = TIDX;
    const bf16_t* XN = (const bf16_t*)(p.ws + OFF_XN);
    const bf16_t* WT = (const bf16_t*)(p.ws + OFF_WTIN);
    bf16_t* Qb = (bf16_t*)(p.ws + OFF_Q); bf16_t* Kb = (bf16_t*)(p.ws + OFF_K); bf16_t* Vb = (bf16_t*)(p.ws + OFF_V); bf16_t* Ub = (bf16_t*)(p.ws + OFF_U);
    const float* rope = (const float*)(p.ws + OFF_ROPE);
    for (int u = VBLK; u < 3072 + 128; u += NVBLK) {
        int mt, pn;
        if (u < 3072) { mt = u / 12; pn = u % 12; } else { mt = 256 + (u - 3072) / 4; pn = 8 + (u - 3072) % 4; }
        const int row0 = mt * 128;
        const bf16_t* a0 = XN + (size_t)(row0 + (tid >> 2)) * D + (tid & 3) * 8;
        auto epi = [&](f32x4 (&acc)[4][4], int wr, int wc, int fr, int fq) {
            const int cb = pn * 128 + wc * 64;
            const bool is_ctx = row0 >= T;
#pragma unroll
            for (int m = 0; m < 4; ++m)
#pragma unroll
                for (int j = 0; j < 4; ++j) {
                    const int row = row0 + wr * 64 + m * 16 + fq * 4 + j;
                    float v[4] = {acc[m][0][j], acc[m][1][j], acc[m][2][j], acc[m][3][j]};
                    if (cb < 256) {
#pragma unroll
                        for (int n = 0; n < 4; ++n) Ub[(size_t)row * 256 + cb + n * 16 + fr] = (bf16_t)f2bf(v[n]);
                    } else if (cb < 1280) {
                        const bool isq = cb < 1024;
                        const float* g = isq ? p.q_norm : p.k_norm;
                        float ss = v[0] * v[0] + v[1] * v[1] + v[2] * v[2] + v[3] * v[3];
                        ss += __shfl_xor(ss, 1); ss += __shfl_xor(ss, 2); ss += __shfl_xor(ss, 4); ss += __shfl_xor(ss, 8);
                        const float rs = 1.0f / sqrtf(ss * (1.f / 64.f) + 1e-6f);
#pragma unroll
                        for (int n = 0; n < 4; ++n) v[n] = v[n] * rs * g[n * 16 + fr];
                        if (!is_ctx) {
                            const int tpos = row & (SEQ - 1);
#pragma unroll
                            for (int n = 0; n < 4; ++n) {
                                const int d = n * 16 + fr;
                                const float cs = rope[(tpos * 32 + (d >> 1)) * 2], sn = rope[(tpos * 32 + (d >> 1)) * 2 + 1];
                                const float pv = __shfl_xor(v[n], 1);
                                v[n] = (d & 1) ? (pv * sn + v[n] * cs) : (v[n] * cs - pv * sn);
                            }
                        }
                        if (isq) {
#pragma unroll
                            for (int n = 0; n < 4; ++n) Qb[(size_t)row * 768 + (cb - 256) + n * 16 + fr] = (bf16_t)f2bf(v[n] * C2);
                        } else {
                            const size_t krow = is_ctx ? (size_t)((row - T) / CTXL) * KVL + ((row - T) % CTXL) : (size_t)(row / SEQ) * KVL + CTXL + (row % SEQ);
#pragma unroll
                            for (int n = 0; n < 4; ++n) Kb[krow * 256 + (cb - 1024) + n * 16 + fr] = (bf16_t)f2bf(v[n]);
                        }
                    } else {
                        const size_t krow = is_ctx ? (size_t)((row - T) / CTXL) * KVL + ((row - T) % CTXL) : (size_t)(row / SEQ) * KVL + CTXL + (row % SEQ);
#pragma unroll
                        for (int n = 0; n < 4; ++n) Vb[krow * 256 + (cb - 1280) + n * 16 + fr] = (bf16_t)f2bf(v[n]);
                    }
                }
        };
        gemm128<D>(lds, a0, a0 + (size_t)64 * D, WT + (size_t)pn * 128 * D, epi);
    }
}

__device__ __forceinline__ void attn_unit(const Params& p, LAS unsigned char* lds, int unit) {
    const int tid = TIDX, lane = tid & 63, wid = tid >> 6, fr = lane & 15, fq = lane >> 4;
    const int qt = unit & 31, h = (unit >> 5) % 12, b = unit / (32 * 12), kh = h / 3;
    const bf16_t* Qb = (const bf16_t*)(p.ws + OFF_Q);
    const bf16_t* Kb = (const bf16_t*)(p.ws + OFF_K) + (size_t)b * KVL * 256 + kh * 64;
    const bf16_t* Vb = (const bf16_t*)(p.ws + OFF_V) + (size_t)b * KVL * 256 + kh * 64;
    bf16_t* AO = (bf16_t*)(p.ws + OFF_AO);
    LAS bf16_t* Ks = (LAS bf16_t*)lds;
    LAS bf16_t* Vt = (LAS bf16_t*)(lds + 9216);
    LAS bf16_t* Pw = (LAS bf16_t*)(lds + 18432) + wid * 16 * 72;
    const int qrow = b * SEQ + qt * 64 + wid * 16;
    bf16x8 qa[2];
#pragma unroll
    for (int ks = 0; ks < 2; ++ks) qa[ks] = *(const bf16x8*)(Qb + (size_t)(qrow + fr) * 768 + h * 64 + ks * 32 + fq * 8);
    float mrow[4], lrow[4];
    f32x4 o[4];
#pragma unroll
    for (int j = 0; j < 4; ++j) { mrow[j] = -1e30f; lrow[j] = 0.f; o[j] = (f32x4){0.f, 0.f, 0.f, 0.f}; }
    for (int kt = 0; kt < KVL / 64; ++kt) {
        __syncthreads();
#pragma unroll
        for (int i = 0; i < 2; ++i) {
            const int idx = tid + i * 256, key = idx >> 3, dc = (idx & 7) * 8;
            const u32x4 kv = *(const u32x4*)(Kb + (size_t)(kt * 64 + key) * 256 + dc);
            *(LAS u32x4*)(Ks + key * 72 + dc) = kv;
            const u32x4 vv = *(const u32x4*)(Vb + (size_t)(kt * 64 + key) * 256 + dc);
#pragma unroll
            for (int e = 0; e < 4; ++e) { Vt[(dc + 2 * e) * 72 + key] = (bf16_t)(vv[e] & 0xffffu); Vt[(dc + 2 * e + 1) * 72 + key] = (bf16_t)(vv[e] >> 16); }
        }
        __syncthreads();
        f32x4 s[4];
#pragma unroll
        for (int nt = 0; nt < 4; ++nt) {
            s[nt] = (f32x4){0.f, 0.f, 0.f, 0.f};
#pragma unroll
            for (int ks = 0; ks < 2; ++ks) {
                const bf16x8 kb = *(const LAS bf16x8*)(Ks + (nt * 16 + fr) * 72 + ks * 32 + fq * 8);
                s[nt] = __builtin_amdgcn_mfma_f32_16x16x32_bf16(qa[ks], kb, s[nt], 0, 0, 0);
            }
        }
        float alpha[4];
#pragma unroll
        for (int j = 0; j < 4; ++j) {
            float mx = fmaxf(fmaxf(s[0][j], s[1][j]), fmaxf(s[2][j], s[3][j]));
            mx = fmaxf(mx, __shfl_xor(mx, 1)); mx = fmaxf(mx, __shfl_xor(mx, 2)); mx = fmaxf(mx, __shfl_xor(mx, 4)); mx = fmaxf(mx, __shfl_xor(mx, 8));
            const float mn = fmaxf(mrow[j], mx);
            alpha[j] = exp2f(mrow[j] - mn);
            mrow[j] = mn;
            float rsum = 0.f;
#pragma unroll
            for (int nt = 0; nt < 4; ++nt) { const float pe = exp2f(s[nt][j] - mn); s[nt][j] = pe; rsum += pe; }
            rsum += __shfl_xor(rsum, 1); rsum += __shfl_xor(rsum, 2); rsum += __shfl_xor(rsum, 4); rsum += __shfl_xor(rsum, 8);
            lrow[j] = lrow[j] * alpha[j] + rsum;
#pragma unroll
            for (int nt = 0; nt < 4; ++nt) Pw[(fq * 4 + j) * 72 + nt * 16 + fr] = (bf16_t)f2bf(s[nt][j]);
        }
#pragma unroll
        for (int nb = 0; nb < 4; ++nb)
#pragma unroll
            for (int j = 0; j < 4; ++j) o[nb][j] *= alpha[j];
        __syncthreads();
#pragma unroll
        for (int ks = 0; ks < 2; ++ks) {
            const bf16x8 pa = *(const LAS bf16x8*)(Pw + fr * 72 + ks * 32 + fq * 8);
#pragma unroll
            for (int nb = 0; nb < 4; ++nb) {
                const bf16x8 vb = *(const LAS bf16x8*)(Vt + (nb * 16 + fr) * 72 + ks * 32 + fq * 8);
                o[nb] = __builtin_amdgcn_mfma_f32_16x16x32_bf16(pa, vb, o[nb], 0, 0, 0);
            }
        }
    }
#pragma unroll
    for (int j = 0; j < 4; ++j) {
        const float il = 1.0f / lrow[j];
#pragma unroll
        for (int nb = 0; nb < 4; ++nb) AO[(size_t)(qrow + fq * 4 + j) * D + 256 + h * 64 + nb * 16 + fr] = (bf16_t)f2bf(o[nb][j] * il);
    }
}

__device__ __forceinline__ void pool_item(const Params& p, LAS unsigned char* lds, int item) {
    const int tid = TIDX;
    const int gi = item & 3, tile = item >> 2, t0 = tile * 32, b = t0 / SEQ, tl0 = t0 % SEQ, half = 1 << gi;
    const bf16_t* Ub = (const bf16_t*)(p.ws + OFF_U);
    bf16_t* AO = (bf16_t*)(p.ws + OFF_AO);
    LAS float* us = (LAS float*)lds;
    LAS float* dl = (LAS float*)(lds + 48 * 64 * 4);
    __syncthreads();
    for (int i = tid; i < 48 * 64; i += 256) {
        const int r = i >> 6, c = i & 63, tl = tl0 - 8 + r;
        us[i] = (tl >= 0 && tl < SEQ) ? bf2f(Ub[(size_t)(b * SEQ + tl) * 256 + gi * 64 + c]) : 0.f;
    }
    __syncthreads();
    {
        const int c = tid & 63, tg = tid >> 6;
#pragma unroll
        for (int k = 0; k < 8; ++k) {
            const int tk = tg * 8 + k, tl = tl0 + tk;
            const int lo = max(tl - half, 0), hi = min(tl + half, SEQ);
            float s = 0.f;
            for (int r = lo; r < hi; ++r) s += us[(r - tl0 + 8) * 64 + c];
            dl[tk * 64 + c] = s / (float)(hi - lo) - us[(tk + 8) * 64 + c];
        }
    }
    __syncthreads();
    {
        const int dd = tid & 63, tg = tid >> 6;
        float acc[8];
#pragma unroll
        for (int k = 0; k < 8; ++k) acc[k] = 0.f;
        const float* w = p.pool_w + gi * 4096 + dd;
        for (int c = 0; c < 64; ++c) {
            const float wv = w[c * 64];
#pragma unroll
            for (int k = 0; k < 8; ++k) acc[k] += dl[(tg * 8 + k) * 64 + c] * wv;
        }
        const float ps = p.pool_scale[gi * 64 + dd];
#pragma unroll
        for (int k = 0; k < 8; ++k) AO[(size_t)(t0 + tg * 8 + k) * D + gi * 64 + dd] = (bf16_t)f2bf(acc[k] * ps);
    }
}

__device__ __forceinline__ void phase_attn_pool(const Params& p, LAS unsigned char* lds) {
    constexpr int N_ATT = NB * 12 * 32, N_POOL = (T / 32) * 4;
    for (int it = VBLK; it < N_ATT + N_POOL; it += NVBLK) {
        if (it < N_ATT) attn_unit(p, lds, it); else pool_item(p, lds, it - N_ATT);
    }
}

__device__ __forceinline__ void phase_outproj(const Params& p, LAS unsigned char* lds) {
    const int tid = TIDX;
    const bf16_t* AO = (const bf16_t*)(p.ws + OFF_AO);
    const bf16_t* WT = (const bf16_t*)(p.ws + OFF_WTOUT);
    const float* mod = (const float*)(p.ws + OFF_MOD);
    float* stats = (float*)(p.ws + OFF_STATS);
    for (int u = VBLK; u < 2048; u += NVBLK) {
        const int mt = u >> 3, pn = u & 7, row0 = mt * 128;
        const bf16_t* a0 = AO + (size_t)(row0 + (tid >> 2)) * D + (tid & 3) * 8;
        const float* g1 = mod + (size_t)(row0 / SEQ) * MODW + 2 * D;
        auto epi = [&](f32x4 (&acc)[4][4], int wr, int wc, int fr, int fq) {
#pragma unroll
            for (int m = 0; m < 4; ++m)
#pragma unroll
                for (int j = 0; j < 4; ++j) {
                    const int row = row0 + wr * 64 + m * 16 + fq * 4 + j;
                    float s1 = 0.f, s2 = 0.f;
#pragma unroll
                    for (int n = 0; n < 4; ++n) {
                        const int col = pn * 128 + wc * 64 + n * 16 + fr;
                        const float y = ALPHA * p.x[(size_t)row * D + col] + g1[col] * acc[m][n][j];
                        p.out[(size_t)row * D + col] = y;
                        s1 += y; s2 += y * y;
                    }
                    s1 += __shfl_xor(s1, 1); s1 += __shfl_xor(s1, 2); s1 += __shfl_xor(s1, 4); s1 += __shfl_xor(s1, 8);
                    s2 += __shfl_xor(s2, 1); s2 += __shfl_xor(s2, 2); s2 += __shfl_xor(s2, 4); s2 += __shfl_xor(s2, 8);
                    if (fr == 0) { stats[((size_t)row * 16 + pn * 2 + wc) * 2] = s1; stats[((size_t)row * 16 + pn * 2 + wc) * 2 + 1] = s2; }
                }
        };
        gemm128<D>(lds, a0, a0 + (size_t)64 * D, WT + (size_t)pn * 128 * D, epi);
    }
}

__device__ __forceinline__ void phase_router(const Params& p, LAS unsigned char* lds) {
    const int tid = TIDX, lane = tid & 63, wid = tid >> 6;
    const float* mod = (const float*)(p.ws + OFF_MOD);
    const float* stats = (const float*)(p.ws + OFF_STATS);
    bf16_t* H = (bf16_t*)(p.ws + OFF_H);
    int* gcnt = (int*)(p.ws + OFF_CNT);
    int* LDST = (int*)(p.ws + OFF_LDST);
    float* LWt = (float*)(p.ws + OFF_LW);
    LAS float* hs = (LAS float*)lds + wid * 16 * 64;
    LAS int* lcnt = (LAS int*)(lds + 16384);
    LAS int* lbase = (LAS int*)(lds + 16384 + 256);
    LAS int* sel_ep = (LAS int*)(lds + 16384 + 512);
    LAS float* sel_w = (LAS float*)(lds + 16384 + 512 + 2048);
    for (int item = VBLK; item < T / 64; item += NVBLK) {
        const int t0 = item * 64, b = t0 / SEQ, tw0 = t0 + wid * 16;
        __syncthreads();
        if (tid < 64) lcnt[tid] = 0;
        float meanv = 0.f, rstdv = 0.f;
        if (lane < 16) {
            float s1 = 0.f, s2 = 0.f;
            const float* st = stats + (size_t)(tw0 + lane) * 32;
#pragma unroll
            for (int i = 0; i < 16; ++i) { s1 += st[2 * i]; s2 += st[2 * i + 1]; }
            meanv = s1 * (1.f / D);
            const float var = fmaxf(s2 * (1.f / D) - meanv * meanv, 0.f);
            rstdv = 1.0f / sqrtf(var + 1e-5f);
        }
        float acc[16];
#pragma unroll
        for (int r = 0; r < 16; ++r) acc[r] = 0.f;
        for (int kc = 0; kc < 16; ++kc) {
            const int k = kc * 64 + lane;
            const float g = p.ln1_g[k], bb = p.ln1_b[k], sc = mod[(size_t)b * MODW + 4 * D + k], sh = mod[(size_t)b * MODW + 3 * D + k];
            __syncthreads();
#pragma unroll
            for (int r = 0; r < 16; ++r) {
                const size_t off = (size_t)(tw0 + r) * D + k;
                const float y = p.out[off];
                const float mu = __shfl(meanv, r), rs = __shfl(rstdv, r);
                const float xm = (y - mu) * rs * g + bb;
                p.out[off] = xm;
                const float hv = xm * (1.f + sc) + sh;
                H[off] = (bf16_t)f2bf(hv);
                hs[r * 64 + lane] = hv;
            }
            __syncthreads();
            const float* wr_ = p.w_router + (size_t)(kc * 64) * NE + lane;
            for (int k4 = 0; k4 < 16; ++k4) {
                const float w0 = wr_[(k4 * 4 + 0) * NE], w1 = wr_[(k4 * 4 + 1) * NE], w2 = wr_[(k4 * 4 + 2) * NE], w3 = wr_[(k4 * 4 + 3) * NE];
#pragma unroll
                for (int r = 0; r < 16; ++r) {
                    const f32x4 hv = *(const LAS f32x4*)(hs + r * 64 + k4 * 4);
                    acc[r] += hv[0] * w0; acc[r] += hv[1] * w1; acc[r] += hv[2] * w2; acc[r] += hv[3] * w3;
                }
            }
        }
        __syncthreads();
#pragma unroll
        for (int r = 0; r < 16; ++r) hs[r * 64 + lane] = acc[r];
        __syncthreads();
        const float bias = p.router_bias[lane];
        for (int r = 0; r < 16; ++r) {
            const float lg = hs[r * 64 + lane];
            const float s = 1.0f / (1.0f + expf(-lg));
            const float sel = s + bias;
            float m1 = fmaxf(sel, __shfl_xor(sel, 1)); m1 = fmaxf(m1, __shfl_xor(m1, 2)); m1 = fmaxf(m1, __shfl_xor(m1, 4));
            int cand = (sel == m1) ? lane : 64;
            cand = min(cand, __shfl_xor(cand, 1)); cand = min(cand, __shfl_xor(cand, 2)); cand = min(cand, __shfl_xor(cand, 4));
            const float sel2 = (lane == cand) ? -INFINITY : sel;
            float m2 = fmaxf(sel2, __shfl_xor(sel2, 1)); m2 = fmaxf(m2, __shfl_xor(m2, 2)); m2 = fmaxf(m2, __shfl_xor(m2, 4));
            const float gs = m1 + m2;
            const int g = lane >> 3;
            int cntg = 0;
#pragma unroll
            for (int gg = 0; gg < 8; ++gg) { const float v = __shfl(gs, gg * 8); cntg += (v > gs || (v == gs && gg < g)) ? 1 : 0; }
            const bool keep = cntg < 4;
            const float msel = keep ? sel : -INFINITY;
            hs[r * 64 + lane] = msel;
            int cnt = 0;
#pragma unroll 4
            for (int q4 = 0; q4 < 16; ++q4) {
                const f32x4 v = *(const LAS f32x4*)(hs + r * 64 + q4 * 4);
#pragma unroll
                for (int i = 0; i < 4; ++i) cnt += (v[i] > msel || (v[i] == msel && (q4 * 4 + i) < lane)) ? 1 : 0;
            }
            const bool chosen = keep && cnt < 8;
            float wsum = chosen ? s : 0.f;
#pragma unroll
            for (int o = 1; o < 64; o <<= 1) wsum += __shfl_xor(wsum, o);
            if (chosen) {
                const int pos = atomicAdd((int*)&lcnt[lane], 1);
                sel_ep[(wid * 16 + r) * 8 + cnt] = lane | (pos << 8);
                sel_w[(wid * 16 + r) * 8 + cnt] = s / wsum * 2.5f;
            }
        }
        __syncthreads();
        if (tid < 64) lbase[tid] = atomicAdd(&gcnt[tid], lcnt[tid]);
        __syncthreads();
        for (int idx = tid; idx < 512; idx += 256) {
            const int ep = sel_ep[idx], e = ep & 0xff, pos = ep >> 8, gi = lbase[e] + pos;
            LDST[(size_t)e * T + gi] = (t0 + (idx >> 3)) * NSLOT + (idx & 7);
            LWt[(size_t)e * T + gi] = sel_w[idx];
        }
    }
}

__device__ __forceinline__ void moe_setup(const Params& p, LAS int* tstart  , LAS int* ecnt  ) {
    __syncthreads();
    if (TIDX == 0) {
        const int* gcnt = (const int*)(p.ws + OFF_CNT);
        int a = 0;
        for (int e = 0; e < NEX; ++e) { const int c = e < NE ? gcnt[e] : T; ecnt[e] = c; tstart[e] = a; a += (c + 127) >> 7; }
        tstart[NEX] = a;
    }
    __syncthreads();
}
__device__ __forceinline__ int find_expert(LAS const int* tstart, int mt) { int e = 0; while (e < NEX - 1 && mt >= tstart[e + 1]) ++e; return e; }

__device__ __forceinline__ void phase_gateup(const Params& p, LAS unsigned char* lds) {
    const int tid = TIDX;
    LAS int* tstart = (LAS int*)(lds + 16384); LAS int* ecnt = (LAS int*)(lds + 16384 + 512);
    moe_setup(p, tstart, ecnt);
    const bf16_t* H = (const bf16_t*)(p.ws + OFF_H);
    const bf16_t* WGU = (const bf16_t*)(p.ws + OFF_WGU);
    const int* LDST = (const int*)(p.ws + OFF_LDST);
    const float* LWt = (const float*)(p.ws + OFF_LW);
    bf16_t* ACT = (bf16_t*)(p.ws + OFF_ACT);
    const int MT = tstart[NEX];
    for (int u = VBLK; u < MT * 4; u += NVBLK) {
        const int mt = u >> 2, pn = u & 3, e = find_expert(tstart, mt), i0 = (mt - tstart[e]) * 128, cnt = ecnt[e];
        const bf16_t* ap[2];
#pragma unroll
        for (int i = 0; i < 2; ++i) {
            const int li = i0 + (tid >> 2) + i * 64;
            int tok = 0;
            if (li < cnt) tok = e < NE ? LDST[(size_t)e * T + li] / NSLOT : li;
            ap[i] = H + (size_t)tok * D + (tid & 3) * 8;
        }
        auto epi = [&](f32x4 (&acc)[4][4], int wr, int wc, int fr, int fq) {
#pragma unroll
            for (int m = 0; m < 4; ++m)
#pragma unroll
                for (int j = 0; j < 4; ++j) {
                    const int li = i0 + wr * 64 + m * 16 + fq * 4 + j;
                    const float wrow = li < cnt ? (e < NE ? LWt[(size_t)e * T + li] : 1.f) : 0.f;
                    bf16_t* dst = ACT + (size_t)(tstart[e] * 128 + li) * FF + pn * 64 + wc * 32 + fr;
#pragma unroll
                    for (int np = 0; np < 2; ++np) {
                        const float g = acc[m][2 * np][j], uu = acc[m][2 * np + 1][j];
                        dst[np * 16] = (bf16_t)f2bf(g / (1.f + expf(-g)) * uu * wrow);
                    }
                }
        };
        gemm128<D>(lds, ap[0], ap[1], WGU + (size_t)e * 512 * D + (size_t)pn * 128 * D, epi);
    }
}

__device__ __forceinline__ void phase_down(const Params& p, LAS unsigned char* lds, int c) {
    const int tid = TIDX;
    LAS int* tstart = (LAS int*)(lds + 16384); LAS int* ecnt = (LAS int*)(lds + 16384 + 512);
    moe_setup(p, tstart, ecnt);
    const bf16_t* WD = (const bf16_t*)(p.ws + OFF_WD);
    const int* LDST = (const int*)(p.ws + OFF_LDST);
    const bf16_t* ACT = (const bf16_t*)(p.ws + OFF_ACT);
    bf16_t* SL = (bf16_t*)(p.ws + OFF_SLOTS);
    const int MT = tstart[NEX];
    for (int u = VBLK; u < MT * 2; u += NVBLK) {
        const int mt = u >> 1, pn = u & 1, e = find_expert(tstart, mt), i0 = (mt - tstart[e]) * 128, cnt = ecnt[e];
        const bf16_t* a0 = ACT + (size_t)(mt * 128 + (tid >> 2)) * FF + (tid & 3) * 8;
        auto epi = [&](f32x4 (&acc)[4][4], int wr, int wc, int fr, int fq) {
#pragma unroll
            for (int m = 0; m < 4; ++m)
#pragma unroll
                for (int j = 0; j < 4; ++j) {
                    const int li = i0 + wr * 64 + m * 16 + fq * 4 + j;
                    if (li < cnt) {
                        const int dst = e < NE ? LDST[(size_t)e * T + li] : li * NSLOT + 8;
                        bf16_t* dp = SL + (size_t)dst * 256 + pn * 128 + wc * 64 + fr;
#pragma unroll
                        for (int n = 0; n < 4; ++n) dp[n * 16] = (bf16_t)f2bf(acc[m][n][j]);
                    }
                }
        };
        gemm128<FF>(lds, a0, a0 + (size_t)64 * FF, WD + (size_t)e * D * FF + (size_t)(c * 256 + pn * 128) * FF, epi);
    }
}

__device__ __forceinline__ void phase_combine(const Params& p, int c) {
    const int tid = TIDX;
    const bf16_t* SL = (const bf16_t*)(p.ws + OFF_SLOTS);
    bf16_t* FFN = (bf16_t*)(p.ws + OFF_H);
    for (int item = VBLK; item < T / 8; item += NVBLK) {
        const int t = item * 8 + (tid >> 5), cc = (tid & 31) * 8;
        float s[8];
#pragma unroll
        for (int i = 0; i < 8; ++i) s[i] = 0.f;
#pragma unroll
        for (int k = 0; k < NSLOT; ++k) {
            const u32x4 v = *(const u32x4*)(SL + (size_t)(t * NSLOT + k) * 256 + cc);
#pragma unroll
            for (int i = 0; i < 4; ++i) { s[2 * i] += bflo(v[i]); s[2 * i + 1] += bfhi(v[i]); }
        }
        *(u32x4*)(FFN + (size_t)t * D + c * 256 + cc) = (u32x4){pk2(s[0], s[1]), pk2(s[2], s[3]), pk2(s[4], s[5]), pk2(s[6], s[7])};
    }
}

__device__ __forceinline__ void phase_final(const Params& p) {
    const int lane = TIDX & 63, gw = VBLK * 4 + (TIDX >> 6), ngw = NVBLK * 4;
    const float* mod = (const float*)(p.ws + OFF_MOD);
    const bf16_t* FFN = (const bf16_t*)(p.ws + OFF_H);
    for (int row = gw; row < T; row += ngw) {
        const float* g2 = mod + (size_t)(row / SEQ) * MODW + 5 * D;
        f32x4 y[4]; float s = 0.f;
#pragma unroll
        for (int j = 0; j < 4; ++j) {
            const int c = 4 * lane + 256 * j;
            const f32x4 xm = *(const f32x4*)(p.out + (size_t)row * D + c), gg = *(const f32x4*)(g2 + c);
            const u32x2 f = *(const u32x2*)(FFN + (size_t)row * D + c);
            y[j][0] = ALPHA * xm[0] + gg[0] * bflo(f.x); y[j][1] = ALPHA * xm[1] + gg[1] * bfhi(f.x);
            y[j][2] = ALPHA * xm[2] + gg[2] * bflo(f.y); y[j][3] = ALPHA * xm[3] + gg[3] * bfhi(f.y);
            s += (y[j][0] + y[j][1]) + (y[j][2] + y[j][3]);
        }
#pragma unroll
        for (int o = 1; o < 64; o <<= 1) s += __shfl_xor(s, o);
        const float mean = s * (1.f / D);
        float q = 0.f;
#pragma unroll
        for (int j = 0; j < 4; ++j) { y[j] = y[j] - mean; q += (y[j][0] * y[j][0] + y[j][1] * y[j][1]) + (y[j][2] * y[j][2] + y[j][3] * y[j][3]); }
#pragma unroll
        for (int o = 1; o < 64; o <<= 1) q += __shfl_xor(q, o);
        const float rstd = 1.0f / sqrtf(q * (1.f / D) + 1e-5f);
#pragma unroll
        for (int j = 0; j < 4; ++j) {
            const int c = 4 * lane + 256 * j;
            const f32x4 g = *(const f32x4*)(p.ln2_g + c), bb = *(const f32x4*)(p.ln2_b + c);
            *(f32x4*)(p.out + (size_t)row * D + c) = y[j] * rstd * g + bb;
        }
    }
}


#define XB_TMO      128
#define XB_XCNT(j)  (256  + 64 * (j))
#define XB_XSUB(j)  (1280 + 64 * (j))
#define XB_XGEN(j)  (2304 + 64 * (j))
#define XB_TOP      3328
#define XB_TOPGEN   3392
#define XCD_BAR_WORDS 3456
#define XB_SPIN_CAP (1u << 18)
__device__ __forceinline__ unsigned xb_ld(unsigned* p)              { return __hip_atomic_load(p, __ATOMIC_RELAXED, __HIP_MEMORY_SCOPE_AGENT); }
__device__ __forceinline__ unsigned xb_add(unsigned* p, unsigned v) { return __hip_atomic_fetch_add(p, v, __ATOMIC_RELAXED, __HIP_MEMORY_SCOPE_AGENT); }
__device__ __forceinline__ unsigned xb_xcc_id() { return (unsigned)__builtin_amdgcn_s_getreg((3 << 11) | 20) & 0xFu; }
#define XB_SPIN(cond, bar) do { unsigned _sp = 0; while (cond) { __builtin_amdgcn_s_sleep(1); \
    if ((++_sp & 255u) == 0u) { if (xb_ld(&(bar)[XB_TMO])) break; if (_sp > XB_SPIN_CAP) { atomicAdd(&(bar)[XB_TMO], 1u); break; } } } } while (0)
struct XcdBarrier { unsigned* bar; unsigned x; volatile LAS unsigned* st; };
__device__ __forceinline__ XcdBarrier xcd_barrier_post(unsigned* bar, volatile LAS unsigned* st) {
    XcdBarrier b; b.bar = bar; b.x = xb_xcc_id(); b.st = st;
    if (threadIdx.x == 0) (void)xb_add(&bar[XB_XCNT(b.x)], 1u);
    return b;
}
__device__ __forceinline__ void xcd_barrier_complete(unsigned* bar, unsigned x, unsigned& nloc, unsigned& nx) {
    const unsigned G = gridDim.x * gridDim.y * gridDim.z;
    unsigned sum, cnt, mine, sp = 0u;
    for (;;) {
        sum = 0u; cnt = 0u; mine = 0u;
#pragma unroll
        for (unsigned j = 0; j < 16; ++j) { const unsigned c = xb_ld(&bar[XB_XCNT(j)]); sum += c; cnt += (c > 0u) ? 1u : 0u; mine = (j == x) ? c : mine; }
        if (sum == G) break;
        __builtin_amdgcn_s_sleep(1);
        if ((++sp & 255u) == 0u) { if (xb_ld(&bar[XB_TMO])) break; if (sp > XB_SPIN_CAP) { atomicAdd(&bar[XB_TMO], 1u); break; } }
    }
    nloc = mine > 0u ? mine : 1u; nx = cnt > 0u ? cnt : 1u;
}
__device__ __forceinline__ void xcd_barrier(const XcdBarrier& b) {
    asm volatile("s_waitcnt vmcnt(0)" ::: "memory");
    __syncthreads();
    if (threadIdx.x == 0) {
        unsigned* bar = b.bar;
        __builtin_amdgcn_s_waitcnt(0);
        unsigned nloc = b.st[0], nx = b.st[1];
        if (nloc == 0u) { xcd_barrier_complete(bar, b.x, nloc, nx); b.st[0] = nloc; b.st[1] = nx; }
        const unsigned old = xb_add(&bar[XB_XSUB(b.x)], 1u);
        const unsigned gen = old / nloc;
        if (old + 1u == (gen + 1u) * nloc) {
            __builtin_amdgcn_fence(__ATOMIC_RELEASE, "agent");
            asm volatile("s_waitcnt vmcnt(0)" ::: "memory");
            const unsigned og = xb_add(&bar[XB_TOP], 1u);
            const unsigned tg = og / nx;
            if (og + 1u == (tg + 1u) * nx) xb_add(&bar[XB_TOPGEN], 1u);
            else XB_SPIN(xb_ld(&bar[XB_TOPGEN]) == tg, bar);
            __builtin_amdgcn_fence(__ATOMIC_ACQUIRE, "agent");
            xb_add(&bar[XB_XGEN(b.x)], 1u);
            asm volatile("s_waitcnt vmcnt(0)" ::: "memory");
        } else {
            XB_SPIN(xb_ld(&bar[XB_XGEN(b.x)]) == gen, bar);
            __builtin_amdgcn_fence(__ATOMIC_ACQUIRE, "agent");
            asm volatile("s_waitcnt vmcnt(0)" ::: "memory");
        }
    }
    __syncthreads();
}

constexpr int LDS_BYTES = 147456, LDS_CTL = 143360;
constexpr size_t OFF_BAR = 448 * 1024;

__global__ void __launch_bounds__(512, 2) mk_fwd(Params p, int lo, int hi) {
    extern __shared__ __attribute__((aligned(16))) unsigned char smem[];
    LAS unsigned char* lds0 = (LAS unsigned char*)smem;
    if (threadIdx.x < 64) ((LAS unsigned*)(lds0 + LDS_CTL))[threadIdx.x] = 0u;
    __syncthreads();
    XcdBarrier bar; bar.bar = (unsigned*)(p.ws + OFF_BAR); bar.x = 0; bar.st = nullptr;
    if (hi - lo > 1) bar = xcd_barrier_post((unsigned*)(p.ws + OFF_BAR), (volatile LAS unsigned*)(lds0 + LDS_CTL));
    LAS unsigned char* lds = lds0 + (threadIdx.x >> 8) * 32768;
#define RUN_PHASE(k, call) if (lo <= (k) && (k) < hi) { if ((k) > lo) xcd_barrier(bar); call; }
    RUN_PHASE(0, phase_prep(p, lds))
    RUN_PHASE(1, phase_xn(p))
    RUN_PHASE(2, phase_inproj(p, lds))
    RUN_PHASE(3, phase_attn_pool(p, lds))
    RUN_PHASE(4, phase_outproj(p, lds))
    RUN_PHASE(5, phase_router(p, lds))
    RUN_PHASE(6, phase_gateup(p, lds))
    RUN_PHASE(7, phase_down(p, lds, 0))
    RUN_PHASE(8, phase_combine(p, 0))
    RUN_PHASE(9, phase_down(p, lds, 1))
    RUN_PHASE(10, phase_combine(p, 1))
    RUN_PHASE(11, phase_down(p, lds, 2))
    RUN_PHASE(12, phase_combine(p, 2))
    RUN_PHASE(13, phase_down(p, lds, 3))
    RUN_PHASE(14, phase_combine(p, 3))
    RUN_PHASE(15, phase_final(p))
}

extern "C" void kernel_launch(void* const* d_in, const int* in_sizes, int n_in, void* d_out, int out_size, void* d_ws, size_t ws_size, hipStream_t stream) {
    static int grid = 0;
    if (grid == 0) {
        int dev = 0, cus = 0, per_cu = 0;
        (void)hipGetDevice(&dev);
        (void)hipDeviceGetAttribute(&cus, hipDeviceAttributeMultiprocessorCount, dev);
        (void)hipFuncSetAttribute((const void*)mk_fwd, hipFuncAttributeMaxDynamicSharedMemorySize, LDS_BYTES);
        (void)hipOccupancyMaxActiveBlocksPerMultiprocessor(&per_cu, (const void*)mk_fwd, 512, LDS_BYTES);
        if (per_cu < 1) fprintf(stderr, "kernel_launch: occupancy query says %d blocks per CU\n", per_cu);
        (void)hipGetLastError();
        grid = cus;
        if (ws_size < WS_NEED) fprintf(stderr, "kernel_launch: workspace too small: %zu < %zu\n", ws_size, (size_t)WS_NEED);
    }
    Params p{};
    const float** pp = (const float**)&p;
    for (int i = 0; i < 24; ++i) pp[i] = (const float*)d_in[i];
    p.out = (float*)d_out; p.ws = (unsigned char*)d_ws;
    (void)hipMemsetAsync((char*)d_ws + OFF_BAR, 0, XCD_BAR_WORDS * 4, stream);
#if FUSED
    hipLaunchKernelGGL(mk_fwd, dim3(grid), dim3(512), LDS_BYTES, stream, p, 0, NPHASE);
#else
    for (int ph = 0; ph < NPHASE; ++ph) hipLaunchKernelGGL(mk_fwd, dim3(grid), dim3(512), LDS_BYTES, stream, p, ph, ph + 1);
#endif
}
```

```cpp
#include <hip/hip_runtime.h>
#include <stdint.h>
#include <stdio.h>


#define LAS __attribute__((address_space(3)))
#define TIDX ((int)(threadIdx.x & 255))
#define VBLK ((int)(blockIdx.x * 2 + (threadIdx.x >> 8)))
#define NVBLK ((int)(gridDim.x * 2))
typedef unsigned short bf16_t;
typedef short bf16x8 __attribute__((ext_vector_type(8)));
typedef float f32x4 __attribute__((ext_vector_type(4)));
typedef unsigned u32x4 __attribute__((ext_vector_type(4)));
typedef unsigned u32x2 __attribute__((ext_vector_type(2)));

constexpr int D = 1024, NB = 16, SEQ = 2048, T = NB * SEQ, CTXL = 256, TC = NB * CTXL, KVL = CTXL + SEQ;
constexpr int PW = 1536, NE = 64, NEX = 65, FF = 256, NSLOT = 9, MODW = 6 * D;
constexpr float ALPHA = 1.189207115002721f;
constexpr float C2 = 0.125f * 1.4426950408889634f;
constexpr int NPHASE = 16;
constexpr int LDS_BYTES = 147456, LDS_CTL = 143360;

constexpr size_t MiB = 1u << 20;
constexpr size_t OFF_CNT = 0, OFF_MOD = 4096, OFF_ROPE = 512 * 1024;
constexpr size_t OFF_WTIN = 1 * MiB, OFF_WTOUT = 4 * MiB, OFF_WGU = 6 * MiB, OFF_WD = 71 * MiB;
constexpr size_t OFF_H = 104 * MiB, OFF_LDST = 168 * MiB, OFF_LW = 176 * MiB, OFF_ACT = 184 * MiB, OFF_SLOTS = 338 * MiB;
constexpr size_t OFF_XN = 184 * MiB, OFF_Q = 256 * MiB, OFF_K = 304 * MiB, OFF_V = 322 * MiB, OFF_U = 340 * MiB, OFF_AO = 356 * MiB, OFF_STATS = 420 * MiB;
constexpr size_t WS_NEED = 483 * MiB;

struct Params {
    const float *x, *c, *ctx, *c_ctx, *w_mod, *b_mod, *w_in, *q_norm, *k_norm, *pool_w, *pool_scale, *w_out, *ln1_g, *ln1_b,
        *w_router, *router_bias, *w_gate, *w_up, *w_down, *ws_gate, *ws_up, *ws_down, *ln2_g, *ln2_b;
    float* out;
    unsigned char* ws;
};

__device__ __forceinline__ unsigned f2bf(float f) { unsigned u = __float_as_uint(f); return (u + 0x7fffu + ((u >> 16) & 1u)) >> 16; }
__device__ __forceinline__ unsigned pk2(float lo, float hi) { return f2bf(lo) | (f2bf(hi) << 16); }
__device__ __forceinline__ float bf2f(unsigned h) { return __uint_as_float(h << 16); }
__device__ __forceinline__ float bflo(unsigned w) { return __uint_as_float(w << 16); }
__device__ __forceinline__ float bfhi(unsigned w) { return __uint_as_float(w & 0xffff0000u); }

namespace pg8 {
constexpr int BM = 256, BK = 64, HALF = 128, HTB = HALF * BK * 2, STAGE_BYTES = 8 * HTB;
__host__ __device__ __forceinline__ int lds_byte(int r, int c) { const int st = (r >> 4) * 2 + (c >> 5), rr = r & 15, cc = c & 31, ob = rr * 64 + cc * 2; return st * 1024 + (ob ^ (((ob >> 9) & 1) << 5)); }
__host__ __device__ __forceinline__ void stage_rc(int b, int& R, int& C) { const int st = b / 1024, sb = b % 1024, swz = sb ^ (((sb >> 9) & 1) << 5); R = (st >> 1) * 16 + swz / 64; C = (st & 1) * 32 + (swz % 64) / 2; }
__host__ __device__ __forceinline__ int perm32(int rho) { const int n = rho >> 4, i = rho & 15; return 8 * (i >> 2) + 4 * n + (i & 3); }
struct Unit { int pm, pn, idx, e; };
struct Gemm { const bf16_t* A; const bf16_t* Bt; };
__device__ __forceinline__ unsigned cvt_pk_bf16(float lo, float hi) { unsigned r; asm volatile("v_cvt_pk_bf16_f32 %0, %1, %2" : "=v"(r) : "v"(lo), "v"(hi)); return r; }

template <int K, class Epi, class Sched, bool GATHER, bool ALIGN_EPI = true>
__device__ __forceinline__ void gemm_phase(LAS unsigned char* lds, const Gemm g, const Sched& S, const Epi& E) {
    const int tid = threadIdx.x, wid = __builtin_amdgcn_readfirstlane(tid >> 6), lane = tid & 63, wr = wid >> 2, wc = wid & 3, fr = lane & 15, fq = lane >> 4;
    constexpr int nt = K / BK;
    unsigned voffA[2], voffB[2], colA = 0; int rowA = 0;
#pragma unroll
    for (int i = 0; i < 2; ++i) { int R, C; stage_rc(tid * 16 + i * 8192, R, C); const int Rb = Epi::PERM ? ((R & ~31) + perm32(R & 31)) : R;
        voffA[i] = (unsigned)(R * K + C) * 2u; voffB[i] = (unsigned)(Rb * K + C) * 2u; if (i == 0) { colA = (unsigned)C * 2u; rowA = R; } }
    const size_t kstep = (size_t)(BK * 2);
    const size_t hstep = (size_t)HALF * K * 2;
    const size_t tstep = 2 * hstep;
    const unsigned ldsw = (unsigned)wid * 1024u;
    const int aoff = lds_byte(wr * 64 + fr, fq * 8), boff = lds_byte(wc * 32 + fr, fq * 8);
#define PG8_SA(b, h) (((b) * 2 + (h)) * HTB)
#define PG8_SB(b, h) ((4 + (b) * 2 + (h)) * HTB)
#define PG8_STAGE(bufoff, gbase, voff) do { _Pragma("unroll") for (int _i = 0; _i < 2; ++_i) \
        __builtin_amdgcn_global_load_lds((const unsigned*)((const char*)(gbase) + (voff)[_i]), (LAS unsigned*)(lds + (bufoff) + ldsw + _i * 8192), 16, 0, 0); } while (0)
#define PG8_STAGE_A(bufoff, ptr, h, NX) do { if constexpr (GATHER) { unsigned _v[2]; \
            if (NX) { _v[0] = S.row_off(nidx, (h) * HALF + rowA) + colA; _v[1] = S.row_off(nidx, (h) * HALF + rowA + 64) + colA; } else { _v[0] = vA[h][0]; _v[1] = vA[h][1]; } PG8_STAGE(bufoff, ptr, _v); } \
        else { PG8_STAGE(bufoff, (ptr) + (h) * hstep, voffA); } } while (0)
#define PG8_LDA(dst, b, h) do { _Pragma("unroll") for (int m = 0; m < 4; ++m) _Pragma("unroll") for (int k = 0; k < 2; ++k) dst[m][k] = *(const LAS bf16x8*)(lds + PG8_SA(b, h) + aoff + m * 2048 + k * 1024); } while (0)
#define PG8_LDB(dst, b, h) do { _Pragma("unroll") for (int n = 0; n < 2; ++n) _Pragma("unroll") for (int k = 0; k < 2; ++k) dst[n][k] = *(const LAS bf16x8*)(lds + PG8_SB(b, h) + boff + n * 2048 + k * 1024); } while (0)
#define PG8_MMA(ai, bj, At, Bt) do { __builtin_amdgcn_s_setprio(1); _Pragma("unroll") for (int m = 0; m < 4; ++m) _Pragma("unroll") for (int n = 0; n < 2; ++n) _Pragma("unroll") for (int k = 0; k < 2; ++k) \
        acc[ai][bj][m][n] = __builtin_amdgcn_mfma_f32_16x16x32_bf16(Bt[n][k], At[m][k], acc[ai][bj][m][n], 0, 0, 0); __builtin_amdgcn_s_setprio(0); } while (0)
#define PG8_WAIT_V(n) asm volatile("s_waitcnt vmcnt(" #n ")" ::: "memory")
#define PG8_WAIT_L(n) asm volatile("s_waitcnt lgkmcnt(" #n ")" ::: "memory")
#define PG8_BAR __builtin_amdgcn_s_barrier()
#define PG8_SCHED __builtin_amdgcn_sched_barrier(0)
    Unit cur, nxt; int ui = 0;
    if (!S.next(0, cur)) return;
    f32x4 acc[2][2][4][2];
#pragma unroll
    for (int a = 0; a < 2; ++a)
#pragma unroll
        for (int b = 0; b < 2; ++b)
#pragma unroll
            for (int m = 0; m < 4; ++m)
#pragma unroll
                for (int n = 0; n < 2; ++n) acc[a][b][m][n] = (f32x4){0.f, 0.f, 0.f, 0.f};
    bf16x8 At[4][2], B0[2][2], B1[2][2];
    unsigned vA[2][2]; int nidx = 0;
    if constexpr (GATHER) {
#pragma unroll
        for (int h = 0; h < 2; ++h)
#pragma unroll
            for (int i = 0; i < 2; ++i) vA[h][i] = S.row_off(cur.idx, h * HALF + rowA + 64 * i) + colA;
    }
    const char* cA = GATHER ? (const char*)g.A : (const char*)g.A + (size_t)cur.pm * tstep; const char* cB = (const char*)g.Bt + (size_t)cur.pn * tstep;
    S.a_ready(cur);
    PG8_STAGE(PG8_SB(0, 0), cB, voffB); PG8_STAGE(PG8_SB(0, 1), cB + hstep, voffB); PG8_STAGE_A(PG8_SA(0, 0), cA, 0, false); PG8_STAGE_A(PG8_SA(0, 1), cA, 1, false);
    if (wr == 1) PG8_BAR;
    PG8_WAIT_V(2); PG8_BAR;
    PG8_STAGE(PG8_SB(1, 0), cB + kstep, voffB); PG8_STAGE_A(PG8_SA(1, 0), cA + kstep, 0, false); PG8_STAGE(PG8_SB(1, 1), cB + hstep + kstep, voffB);
    PG8_WAIT_V(6); PG8_BAR;
    for (;;) {
        const bool has_next = S.next(ui + 1, nxt);
        if constexpr (GATHER) nidx = has_next ? nxt.idx : cur.idx;
        const char* nA = GATHER ? (const char*)g.A : (has_next ? (const char*)g.A + (size_t)nxt.pm * tstep : cA); const char* nB = has_next ? (const char*)g.Bt + (size_t)nxt.pn * tstep : cB;
        for (int t = 0; t < nt; t += 2) {
            const bool last = (t == nt - 2);
            const char* a1 = cA + (size_t)(t + 1) * kstep;
            const char* a2 = last ? nA : cA + (size_t)(t + 2) * kstep; const char* b2 = last ? nB : cB + (size_t)(t + 2) * kstep;
            const char* a3 = a2 + kstep; const char* b3 = b2 + kstep;
            if (last && has_next) S.a_ready(nxt);
            PG8_LDB(B0, 0, 0); PG8_LDB(B1, 0, 1); PG8_SCHED; PG8_LDA(At, 0, 0); PG8_STAGE_A(PG8_SA(1, 1), a1, 1, false);
            PG8_WAIT_V(8); PG8_WAIT_L(0); PG8_BAR; PG8_MMA(0, 0, At, B0); PG8_MMA(0, 1, At, B1); PG8_BAR; PG8_SCHED;
            PG8_LDA(At, 0, 1); PG8_STAGE(PG8_SB(0, 0), b2, voffB); PG8_STAGE(PG8_SB(0, 1), b2 + hstep, voffB); PG8_STAGE_A(PG8_SA(0, 0), a2, 0, last);
            PG8_WAIT_V(8); PG8_WAIT_L(0); PG8_BAR; PG8_MMA(1, 0, At, B0); PG8_MMA(1, 1, At, B1); PG8_BAR; PG8_SCHED;
            PG8_LDB(B0, 1, 0); PG8_LDB(B1, 1, 1); PG8_SCHED; PG8_LDA(At, 1, 0); PG8_STAGE_A(PG8_SA(0, 1), a2, 1, last);
            PG8_WAIT_V(8); PG8_WAIT_L(0); PG8_BAR; PG8_MMA(0, 0, At, B0); PG8_MMA(0, 1, At, B1); PG8_BAR; PG8_SCHED;
            PG8_LDA(At, 1, 1); PG8_STAGE(PG8_SB(1, 0), b3, voffB); PG8_STAGE(PG8_SB(1, 1), b3 + hstep, voffB); PG8_STAGE_A(PG8_SA(1, 0), a3, 0, last);
            PG8_WAIT_V(8); PG8_WAIT_L(0); PG8_BAR; PG8_MMA(1, 0, At, B0); PG8_MMA(1, 1, At, B1); PG8_BAR; PG8_SCHED;
        }
        if constexpr (ALIGN_EPI) { if (wr == 0) PG8_BAR; }
        E(acc, cur, wr, wc, fr, fq); S.done(cur);
        if (!has_next) break;
#pragma unroll
        for (int a = 0; a < 2; ++a)
#pragma unroll
            for (int b = 0; b < 2; ++b)
#pragma unroll
                for (int m = 0; m < 4; ++m)
#pragma unroll
                    for (int n = 0; n < 2; ++n) acc[a][b][m][n] = (f32x4){0.f, 0.f, 0.f, 0.f};
        cur = nxt; cA = nA; cB = nB; ++ui;
        if constexpr (GATHER) {
#pragma unroll
            for (int h = 0; h < 2; ++h)
#pragma unroll
                for (int i = 0; i < 2; ++i) vA[h][i] = S.row_off(cur.idx, h * HALF + rowA + 64 * i) + colA;
        }
        if constexpr (ALIGN_EPI) { if (wr == 1) PG8_BAR; }
    }
    PG8_WAIT_V(0);
    if constexpr (!ALIGN_EPI) { if (wr == 0) PG8_BAR; }
    PG8_BAR;
#undef PG8_SA
#undef PG8_SB
#undef PG8_STAGE
#undef PG8_STAGE_A
#undef PG8_LDA
#undef PG8_LDB
#undef PG8_MMA
#undef PG8_WAIT_V
#undef PG8_WAIT_L
#undef PG8_BAR
#undef PG8_SCHED
}

struct DenseSched {
    int nN, n1, total, pn2lo, nN2, G, c;
    __device__ __forceinline__ bool next(int i, Unit& u) const {
        const int L = i * G + c; if (L >= total) return false;
        if (L < n1) { u.pm = L / nN; u.pn = L % nN; } else { const int r = L - n1; u.pm = n1 / nN + r / nN2; u.pn = pn2lo + r % nN2; }
        u.idx = i; u.e = 0; return true;
    }
    __device__ __forceinline__ void a_ready(const Unit&) const {}
    __device__ __forceinline__ void done(const Unit&) const {}
};
}

__device__ __forceinline__ int win_row(int n) { return (n & ~255) + 128 * ((n >> 5) & 1) + 32 * ((n >> 6) & 3) + (n & 31); }
__device__ __forceinline__ int gu_row(int j, int half) { return (j >> 7) * 256 + half * 128 + (j & 127); }

template <class RowMap>
__device__ __forceinline__ void transpose_tile(LAS float* tile, const float* src, int ld, int k0, int n0, bf16_t* dst, int Kdst, RowMap rowmap) {
    const int tid = TIDX;
#pragma unroll
    for (int pss = 0; pss < 4; ++pss) {
        const int k = pss * 16 + (tid >> 4), n4 = (tid & 15) * 4;
        const f32x4 v = *(const f32x4*)(src + (size_t)(k0 + k) * ld + n0 + n4);
        tile[k * 65 + n4 + 0] = v[0]; tile[k * 65 + n4 + 1] = v[1]; tile[k * 65 + n4 + 2] = v[2]; tile[k * 65 + n4 + 3] = v[3];
    }
    __syncthreads();
    {
        const int n = tid >> 2, kc = (tid & 3) * 16;
        unsigned w[8];
#pragma unroll
        for (int i = 0; i < 8; ++i) w[i] = pk2(tile[(kc + 2 * i) * 65 + n], tile[(kc + 2 * i + 1) * 65 + n]);
        bf16_t* dp = dst + (size_t)rowmap(n0 + n) * Kdst + k0 + kc;
        *(u32x4*)dp = (u32x4){w[0], w[1], w[2], w[3]};
        *(u32x4*)(dp + 8) = (u32x4){w[4], w[5], w[6], w[7]};
    }
    __syncthreads();
}

__device__ __forceinline__ void phase_prep(const Params& p, LAS unsigned char* lds) {
    const int tid = TIDX;
    int* gcnt = (int*)(p.ws + OFF_CNT);
    if (VBLK == 0 && tid < 128) gcnt[tid] = 0;
    float* mod = (float*)(p.ws + OFF_MOD);
    float* rope = (float*)(p.ws + OFF_ROPE);
    constexpr int N_MOD = 192, N_ROPE = 256, N_TR = 384 + 256 + NEX * 192;
    for (int it = VBLK; it < N_MOD + N_ROPE + N_TR; it += NVBLK) {
        if (it < N_MOD) {
            LAS float* red = (LAS float*)lds;
            const int col = it * 32 + (tid & 31), kk = tid >> 5;
            float acc[17];
#pragma unroll
            for (int r = 0; r < 17; ++r) acc[r] = 0.f;
            for (int i = 0; i < 128; ++i) {
                const int k = kk + 8 * i;
                const float wv = p.w_mod[(size_t)k * MODW + col];
#pragma unroll
                for (int r = 0; r < 17; ++r) {
                    const float cv = (r < 16) ? p.c[r * D + k] : p.c_ctx[k];
                    acc[r] += (cv / (1.f + expf(-cv))) * wv;
                }
            }
#pragma unroll
            for (int r = 0; r < 17; ++r) red[(kk * 17 + r) * 32 + (tid & 31)] = acc[r];
            __syncthreads();
            for (int o = tid; o < 17 * 32; o += 256) {
                const int r = o >> 5, j = o & 31;
                float s = p.b_mod[it * 32 + j];
#pragma unroll
                for (int g = 0; g < 8; ++g) s += red[(g * 17 + r) * 32 + j];
                mod[r * MODW + it * 32 + j] = s;
            }
            __syncthreads();
        } else if (it < N_MOD + N_ROPE) {
            const int idx = (it - N_MOD) * 256 + tid, t = idx >> 5, i = idx & 31;
            const int pos = (i < 16) ? (t >> 6) : (t & 63);
            const float invf = (float)exp(-(double)(i & 15) / 16.0 * 9.210340371976184);
            const double ang = (double)((float)pos * invf);
            rope[idx * 2 + 0] = (float)cos(ang);
            rope[idx * 2 + 1] = (float)sin(ang);
        } else {
            LAS float* tile = (LAS float*)lds;
            int idx = it - N_MOD - N_ROPE;
            if (idx < 384) {
                transpose_tile(tile, p.w_in, PW, (idx / 24) * 64, (idx % 24) * 64, (bf16_t*)(p.ws + OFF_WTIN), D, [](int n) { return win_row(n); });
            } else if (idx < 640) {
                idx -= 384;
                transpose_tile(tile, p.w_out, D, (idx / 16) * 64, (idx % 16) * 64, (bf16_t*)(p.ws + OFF_WTOUT), D, [](int n) { return n; });
            } else {
                idx -= 640;
                const int e = idx / 192, r = idx % 192;
                if (r < 128) {
                    const int half = r >> 6, rr = r & 63;
                    const float* src = half ? (e < NE ? p.w_up + (size_t)e * D * FF : p.ws_up) : (e < NE ? p.w_gate + (size_t)e * D * FF : p.ws_gate);
                    transpose_tile(tile, src, FF, (rr / 4) * 64, (rr % 4) * 64, (bf16_t*)(p.ws + OFF_WGU) + (size_t)e * 512 * D, D, [half](int n) { return gu_row(n, half); });
                } else {
                    const int rr = r - 128;
                    const float* src = e < NE ? p.w_down + (size_t)e * FF * D : p.ws_down;
                    transpose_tile(tile, src, D, (rr / 16) * 64, (rr % 16) * 64, (bf16_t*)(p.ws + OFF_WD) + (size_t)e * D * FF, FF, [](int n) { return n; });
                }
            }
        }
    }
}

__device__ __forceinline__ void phase_xn(const Params& p) {
    const int lane = TIDX & 63, gw = VBLK * 4 + (TIDX >> 6), ngw = NVBLK * 4;
    const float* mod = (const float*)(p.ws + OFF_MOD);
    bf16_t* XN = (bf16_t*)(p.ws + OFF_XN);
    for (int row = gw; row < T + TC; row += ngw) {
        const float* src = row < T ? p.x + (size_t)row * D : p.ctx + (size_t)(row - T) * D;
        const float* mr = mod + (size_t)(row < T ? row / SEQ : 16) * MODW;
#pragma unroll
        for (int j = 0; j < 4; ++j) {
            const int c = 4 * lane + 256 * j;
            const f32x4 v = *(const f32x4*)(src + c), sh = *(const f32x4*)(mr + c), sc = *(const f32x4*)(mr + D + c);
            u32x2 o; o.x = pk2(v[0] * (1.f + sc[0]) + sh[0], v[1] * (1.f + sc[1]) + sh[1]); o.y = pk2(v[2] * (1.f + sc[2]) + sh[2], v[3] * (1.f + sc[3]) + sh[3]);
            *(u32x2*)(XN + (size_t)row * D + c) = o;
        }
    }
}

struct EpiIn {
    static constexpr bool PERM = true;
    const float *q_norm, *k_norm, *rope; bf16_t *Qb, *Kb, *Vb, *Ub;
    __device__ __forceinline__ void operator()(const f32x4 (&acc)[2][2][4][2], const pg8::Unit& u, int wr, int wc, int fr, int fq) const {
        const int grp = u.pn * 4 + wc;
        const bool is_ctx = u.pm >= T / 256;
        f32x4 gn[2][2];
        if (grp >= 4 && grp < 20) {
            const float* g = grp < 16 ? q_norm : k_norm;
#pragma unroll
            for (int bj = 0; bj < 2; ++bj)
#pragma unroll
                for (int n = 0; n < 2; ++n) gn[bj][n] = *(const f32x4*)(g + 32 * bj + 8 * fq + 4 * n);
        }
#pragma unroll
        for (int ai = 0; ai < 2; ++ai)
#pragma unroll
            for (int m = 0; m < 4; ++m) {
                const int row = u.pm * 256 + ai * 128 + wr * 64 + m * 16 + fr;
                f32x4 v[2][2];
#pragma unroll
                for (int bj = 0; bj < 2; ++bj)
#pragma unroll
                    for (int n = 0; n < 2; ++n) v[bj][n] = acc[ai][bj][m][n];
                bf16_t* dst;
                if (grp < 4) dst = Ub + (size_t)row * 256 + grp * 64;
                else if (grp < 16) dst = Qb + (size_t)row * 768 + (grp - 4) * 64;
                else {
                    const size_t krow = is_ctx ? (size_t)((row - T) >> 8) * KVL + ((row - T) & 255) : (size_t)(row >> 11) * KVL + CTXL + (row & (SEQ - 1));
                    dst = (grp < 20 ? Kb + (grp - 16) * 64 : Vb + (grp - 20) * 64) + krow * 256;
                }
                if (grp >= 4 && grp < 20) {
                    float ss = 0.f;
#pragma unroll
                    for (int bj = 0; bj < 2; ++bj)
#pragma unroll
                        for (int n = 0; n < 2; ++n) ss += (v[bj][n][0] * v[bj][n][0] + v[bj][n][1] * v[bj][n][1]) + (v[bj][n][2] * v[bj][n][2] + v[bj][n][3] * v[bj][n][3]);
                    ss += __shfl_xor(ss, 16); ss += __shfl_xor(ss, 32);
                    const float rs = 1.0f / sqrtf(ss * (1.f / 64.f) + 1e-6f);
#pragma unroll
                    for (int bj = 0; bj < 2; ++bj)
#pragma unroll
                        for (int n = 0; n < 2; ++n) v[bj][n] = v[bj][n] * rs * gn[bj][n];
                    if (!is_ctx) {
                        const int tpos = row & (SEQ - 1);
#pragma unroll
                        for (int bj = 0; bj < 2; ++bj)
#pragma unroll
                            for (int n = 0; n < 2; ++n) {
                                const f32x4 cs = *(const f32x4*)(rope + (size_t)(tpos * 32 + 16 * bj + 4 * fq + 2 * n) * 2);
                                const f32x4 x = v[bj][n];
                                v[bj][n] = (f32x4){x[0] * cs[0] - x[1] * cs[1], x[0] * cs[1] + x[1] * cs[0], x[2] * cs[2] - x[3] * cs[3], x[2] * cs[3] + x[3] * cs[2]};
                            }
                    }
                    if (grp < 16) {
#pragma unroll
                        for (int bj = 0; bj < 2; ++bj)
#pragma unroll
                            for (int n = 0; n < 2; ++n) v[bj][n] = v[bj][n] * C2;
                    }
                }
#pragma unroll
                for (int bj = 0; bj < 2; ++bj) {
                    u32x4 w; w.x = pk2(v[bj][0][0], v[bj][0][1]); w.y = pk2(v[bj][0][2], v[bj][0][3]); w.z = pk2(v[bj][1][0], v[bj][1][1]); w.w = pk2(v[bj][1][2], v[bj][1][3]);
                    *(u32x4*)(dst + 32 * bj + 8 * fq) = w;
                }
            }
    }
};
__device__ __forceinline__ int vcu_of_block() { const int G = gridDim.x, bx = blockIdx.x; return (G % 8 == 0) ? (bx % 8) * (G / 8) + bx / 8 : bx; }
__device__ __forceinline__ void phase_inproj(const Params& p, LAS unsigned char* lds) {
    pg8::Gemm g{(const bf16_t*)(p.ws + OFF_XN), (const bf16_t*)(p.ws + OFF_WTIN)};
    pg8::DenseSched S{6, 768, 800, 4, 2, (int)gridDim.x, vcu_of_block()};
    EpiIn E{p.q_norm, p.k_norm, (const float*)(p.ws + OFF_ROPE), (bf16_t*)(p.ws + OFF_Q), (bf16_t*)(p.ws + OFF_K), (bf16_t*)(p.ws + OFF_V), (bf16_t*)(p.ws + OFF_U)};
    pg8::gemm_phase<D, EpiIn, pg8::DenseSched, false>(lds, g, S, E);
}

__device__ __forceinline__ void attn_unit(const Params& p, LAS unsigned char* lds, int unit) {
    const int tid = TIDX, lane = tid & 63, wid = tid >> 6, fr = lane & 15, fq = lane >> 4;
    const int qt = unit & 31, h = (unit >> 5) % 12, b = unit / (32 * 12), kh = h / 3;
    const bf16_t* Qb = (const bf16_t*)(p.ws + OFF_Q);
    const bf16_t* Kb = (const bf16_t*)(p.ws + OFF_K) + (size_t)b * KVL * 256 + kh * 64;
    const bf16_t* Vb = (const bf16_t*)(p.ws + OFF_V) + (size_t)b * KVL * 256 + kh * 64;
    bf16_t* AO = (bf16_t*)(p.ws + OFF_AO);
    LAS bf16_t* Ks = (LAS bf16_t*)lds;
    LAS bf16_t* Vt = (LAS bf16_t*)(lds + 9216);
    LAS bf16_t* Pw = (LAS bf16_t*)(lds + 18432) + wid * 16 * 72;
    const int qrow = b * SEQ + qt * 64 + wid * 16;
    bf16x8 qa[2];
#pragma unroll
    for (int ks = 0; ks < 2; ++ks) qa[ks] = *(const bf16x8*)(Qb + (size_t)(qrow + fr) * 768 + h * 64 + ks * 32 + fq * 8);
    float mrow[4], lrow[4];
    f32x4 o[4];
#pragma unroll
    for (int j = 0; j < 4; ++j) { mrow[j] = -1e30f; lrow[j] = 0.f; o[j] = (f32x4){0.f, 0.f, 0.f, 0.f}; }
    for (int kt = 0; kt < KVL / 64; ++kt) {
        __syncthreads();
#pragma unroll
        for (int i = 0; i < 2; ++i) {
            const int idx = tid + i * 256, key = idx >> 3, dc = (idx & 7) * 8;
            const u32x4 kv = *(const u32x4*)(Kb + (size_t)(kt * 64 + key) * 256 + dc);
            *(LAS u32x4*)(Ks + key * 72 + dc) = kv;
            const u32x4 vv = *(const u32x4*)(Vb + (size_t)(kt * 64 + key) * 256 + dc);
#pragma unroll
            for (int e = 0; e < 4; ++e) { Vt[(dc + 2 * e) * 72 + key] = (bf16_t)(vv[e] & 0xffffu); Vt[(dc + 2 * e + 1) * 72 + key] = (bf16_t)(vv[e] >> 16); }
        }
        __syncthreads();
        f32x4 s[4];
#pragma unroll
        for (int nt = 0; nt < 4; ++nt) {
            s[nt] = (f32x4){0.f, 0.f, 0.f, 0.f};
#pragma unroll
            for (int ks = 0; ks < 2; ++ks) {
                const bf16x8 kb = *(const LAS bf16x8*)(Ks + (nt * 16 + fr) * 72 + ks * 32 + fq * 8);
                s[nt] = __builtin_amdgcn_mfma_f32_16x16x32_bf16(qa[ks], kb, s[nt], 0, 0, 0);
            }
        }
        float alpha[4];
#pragma unroll
        for (int j = 0; j < 4; ++j) {
            float mx = fmaxf(fmaxf(s[0][j], s[1][j]), fmaxf(s[2][j], s[3][j]));
            mx = fmaxf(mx, __shfl_xor(mx, 1)); mx = fmaxf(mx, __shfl_xor(mx, 2)); mx = fmaxf(mx, __shfl_xor(mx, 4)); mx = fmaxf(mx, __shfl_xor(mx, 8));
            const float mn = fmaxf(mrow[j], mx);
            alpha[j] = exp2f(mrow[j] - mn);
            mrow[j] = mn;
            float rsum = 0.f;
#pragma unroll
            for (int nt = 0; nt < 4; ++nt) { const float pe = exp2f(s[nt][j] - mn); s[nt][j] = pe; rsum += pe; }
            rsum += __shfl_xor(rsum, 1); rsum += __shfl_xor(rsum, 2); rsum += __shfl_xor(rsum, 4); rsum += __shfl_xor(rsum, 8);
            lrow[j] = lrow[j] * alpha[j] + rsum;
#pragma unroll
            for (int nt = 0; nt < 4; ++nt) Pw[(fq * 4 + j) * 72 + nt * 16 + fr] = (bf16_t)f2bf(s[nt][j]);
        }
#pragma unroll
        for (int nb = 0; nb < 4; ++nb)
#pragma unroll
            for (int j = 0; j < 4; ++j) o[nb][j] *= alpha[j];
        __syncthreads();
#pragma unroll
        for (int ks = 0; ks < 2; ++ks) {
            const bf16x8 pa = *(const LAS bf16x8*)(Pw + fr * 72 + ks * 32 + fq * 8);
#pragma unroll
            for (int nb = 0; nb < 4; ++nb) {
                const bf16x8 vb = *(const LAS bf16x8*)(Vt + (nb * 16 + fr) * 72 + ks * 32 + fq * 8);
                o[nb] = __builtin_amdgcn_mfma_f32_16x16x32_bf16(pa, vb, o[nb], 0, 0, 0);
            }
        }
    }
#pragma unroll
    for (int j = 0; j < 4; ++j) {
        const float il = 1.0f / lrow[j];
#pragma unroll
        for (int nb = 0; nb < 4; ++nb) AO[(size_t)(qrow + fq * 4 + j) * D + 256 + h * 64 + nb * 16 + fr] = (bf16_t)f2bf(o[nb][j] * il);
    }
}

__device__ __forceinline__ void pool_item(const Params& p, LAS unsigned char* lds, int item) {
    const int tid = TIDX;
    const int gi = item & 3, tile = item >> 2, t0 = tile * 32, b = t0 / SEQ, tl0 = t0 % SEQ, half = 1 << gi;
    const bf16_t* Ub = (const bf16_t*)(p.ws + OFF_U);
    bf16_t* AO = (bf16_t*)(p.ws + OFF_AO);
    LAS float* us = (LAS float*)lds;
    LAS float* dl = (LAS float*)(lds + 48 * 64 * 4);
    __syncthreads();
    for (int i = tid; i < 48 * 64; i += 256) {
        const int r = i >> 6, c = i & 63, tl = tl0 - 8 + r;
        us[i] = (tl >= 0 && tl < SEQ) ? bf2f(Ub[(size_t)(b * SEQ + tl) * 256 + gi * 64 + c]) : 0.f;
    }
    __syncthreads();
    {
        const int c = tid & 63, tg = tid >> 6;
#pragma unroll
        for (int k = 0; k < 8; ++k) {
            const int tk = tg * 8 + k, tl = tl0 + tk;
            const int lo = max(tl - half, 0), hi = min(tl + half, SEQ);
            float s = 0.f;
            for (int r = lo; r < hi; ++r) s += us[(r - tl0 + 8) * 64 + c];
            dl[tk * 64 + c] = s / (float)(hi - lo) - us[(tk + 8) * 64 + c];
        }
    }
    __syncthreads();
    {
        const int dd = tid & 63, tg = tid >> 6;
        float acc[8];
#pragma unroll
        for (int k = 0; k < 8; ++k) acc[k] = 0.f;
        const float* w = p.pool_w + gi * 4096 + dd;
        for (int c = 0; c < 64; ++c) {
            const float wv = w[c * 64];
#pragma unroll
            for (int k = 0; k < 8; ++k) acc[k] += dl[(tg * 8 + k) * 64 + c] * wv;
        }
        const float ps = p.pool_scale[gi * 64 + dd];
#pragma unroll
        for (int k = 0; k < 8; ++k) AO[(size_t)(t0 + tg * 8 + k) * D + gi * 64 + dd] = (bf16_t)f2bf(acc[k] * ps);
    }
}

__device__ __forceinline__ void phase_attn_pool(const Params& p, LAS unsigned char* lds) {
    constexpr int N_ATT = NB * 12 * 32, N_POOL = (T / 32) * 4;
    for (int it = VBLK; it < N_ATT + N_POOL; it += NVBLK) {
        if (it < N_ATT) attn_unit(p, lds, it); else pool_item(p, lds, it - N_ATT);
    }
}

struct EpiOut {
    static constexpr bool PERM = false;
    const float* x; float* y; const float* mod; float* stats;
    __device__ __forceinline__ void operator()(const f32x4 (&acc)[2][2][4][2], const pg8::Unit& u, int wr, int wc, int fr, int fq) const {
        const float* g1 = mod + (size_t)(u.pm >> 3) * MODW + 2 * D;
        const int col0 = u.pn * 256 + wc * 32 + fq * 4;
        f32x4 gv[2][2];
#pragma unroll
        for (int bj = 0; bj < 2; ++bj)
#pragma unroll
            for (int n = 0; n < 2; ++n) gv[bj][n] = *(const f32x4*)(g1 + col0 + bj * 128 + n * 16);
#pragma unroll
        for (int ai = 0; ai < 2; ++ai)
#pragma unroll
            for (int m = 0; m < 4; ++m) {
                const int row = u.pm * 256 + ai * 128 + wr * 64 + m * 16 + fr;
                float s1 = 0.f, s2 = 0.f;
#pragma unroll
                for (int bj = 0; bj < 2; ++bj)
#pragma unroll
                    for (int n = 0; n < 2; ++n) {
                        const size_t off = (size_t)row * D + col0 + bj * 128 + n * 16;
                        const f32x4 xv = *(const f32x4*)(x + off);
                        const f32x4 yv = xv * ALPHA + gv[bj][n] * acc[ai][bj][m][n];
                        *(f32x4*)(y + off) = yv;
                        s1 += (yv[0] + yv[1]) + (yv[2] + yv[3]);
                        s2 += (yv[0] * yv[0] + yv[1] * yv[1]) + (yv[2] * yv[2] + yv[3] * yv[3]);
                    }
                s1 += __shfl_xor(s1, 16); s1 += __shfl_xor(s1, 32);
                s2 += __shfl_xor(s2, 16); s2 += __shfl_xor(s2, 32);
                if (fq == 0) { float* st = stats + ((size_t)row * 16 + u.pn * 4 + wc) * 2; st[0] = s1; st[1] = s2; }
            }
    }
};
__device__ __forceinline__ void phase_outproj(const Params& p, LAS unsigned char* lds) {
    pg8::Gemm g{(const bf16_t*)(p.ws + OFF_AO), (const bf16_t*)(p.ws + OFF_WTOUT)};
    pg8::DenseSched S{4, 512, 512, 0, 1, (int)gridDim.x, vcu_of_block()};
    EpiOut E{p.x, p.out, (const float*)(p.ws + OFF_MOD), (float*)(p.ws + OFF_STATS)};
    pg8::gemm_phase<D, EpiOut, pg8::DenseSched, false>(lds, g, S, E);
}

__device__ __forceinline__ void phase_router(const Params& p, LAS unsigned char* lds) {
    const int tid = TIDX, lane = tid & 63, wid = tid >> 6;
    const float* mod = (const float*)(p.ws + OFF_MOD);
    const float* stats = (const float*)(p.ws + OFF_STATS);
    bf16_t* H = (bf16_t*)(p.ws + OFF_H);
    int* gcnt = (int*)(p.ws + OFF_CNT);
    int* LDST = (int*)(p.ws + OFF_LDST);
    float* LWt = (float*)(p.ws + OFF_LW);
    LAS float* hs = (LAS float*)lds + wid * 16 * 64;
    LAS int* lcnt = (LAS int*)(lds + 16384);
    LAS int* lbase = (LAS int*)(lds + 16384 + 256);
    LAS int* sel_ep = (LAS int*)(lds + 16384 + 512);
    LAS float* sel_w = (LAS float*)(lds + 16384 + 512 + 2048);
    for (int item = VBLK; item < T / 64; item += NVBLK) {
        const int t0 = item * 64, b = t0 / SEQ, tw0 = t0 + wid * 16;
        __syncthreads();
        if (tid < 64) lcnt[tid] = 0;
        float meanv = 0.f, rstdv = 0.f;
        if (lane < 16) {
            float s1 = 0.f, s2 = 0.f;
            const float* st = stats + (size_t)(tw0 + lane) * 32;
#pragma unroll
            for (int i = 0; i < 16; ++i) { s1 += st[2 * i]; s2 += st[2 * i + 1]; }
            meanv = s1 * (1.f / D);
            const float var = fmaxf(s2 * (1.f / D) - meanv * meanv, 0.f);
            rstdv = 1.0f / sqrtf(var + 1e-5f);
        }
        float acc[16];
#pragma unroll
        for (int r = 0; r < 16; ++r) acc[r] = 0.f;
        for (int kc = 0; kc < 16; ++kc) {
            const int k = kc * 64 + lane;
            const float g = p.ln1_g[k], bb = p.ln1_b[k], sc = mod[(size_t)b * MODW + 4 * D + k], sh = mod[(size_t)b * MODW + 3 * D + k];
            __syncthreads();
#pragma unroll
            for (int r = 0; r < 16; ++r) {
                const size_t off = (size_t)(tw0 + r) * D + k;
                const float y = p.out[off];
                const float mu = __shfl(meanv, r), rs = __shfl(rstdv, r);
                const float xm = (y - mu) * rs * g + bb;
                p.out[off] = xm;
                const float hv = xm * (1.f + sc) + sh;
                H[off] = (bf16_t)f2bf(hv);
                hs[r * 64 + lane] = hv;
            }
            __syncthreads();
            const float* wr_ = p.w_router + (size_t)(kc * 64) * NE + lane;
            for (int k4 = 0; k4 < 16; ++k4) {
                const float w0 = wr_[(k4 * 4 + 0) * NE], w1 = wr_[(k4 * 4 + 1) * NE], w2 = wr_[(k4 * 4 + 2) * NE], w3 = wr_[(k4 * 4 + 3) * NE];
#pragma unroll
                for (int r = 0; r < 16; ++r) {
                    const f32x4 hv = *(const LAS f32x4*)(hs + r * 64 + k4 * 4);
                    acc[r] += hv[0] * w0; acc[r] += hv[1] * w1; acc[r] += hv[2] * w2; acc[r] += hv[3] * w3;
                }
            }
        }
        __syncthreads();
#pragma unroll
        for (int r = 0; r < 16; ++r) hs[r * 64 + lane] = acc[r];
        __syncthreads();
        const float bias = p.router_bias[lane];
        for (int r = 0; r < 16; ++r) {
            const float lg = hs[r * 64 + lane];
            const float s = 1.0f / (1.0f + expf(-lg));
            const float sel = s + bias;
            float m1 = fmaxf(sel, __shfl_xor(sel, 1)); m1 = fmaxf(m1, __shfl_xor(m1, 2)); m1 = fmaxf(m1, __shfl_xor(m1, 4));
            int cand = (sel == m1) ? lane : 64;
            cand = min(cand, __shfl_xor(cand, 1)); cand = min(cand, __shfl_xor(cand, 2)); cand = min(cand, __shfl_xor(cand, 4));
            const float sel2 = (lane == cand) ? -INFINITY : sel;
            float m2 = fmaxf(sel2, __shfl_xor(sel2, 1)); m2 = fmaxf(m2, __shfl_xor(m2, 2)); m2 = fmaxf(m2, __shfl_xor(m2, 4));
            const float gs = m1 + m2;
            const int g = lane >> 3;
            int cntg = 0;
#pragma unroll
            for (int gg = 0; gg < 8; ++gg) { const float v = __shfl(gs, gg * 8); cntg += (v > gs || (v == gs && gg < g)) ? 1 : 0; }
            const bool keep = cntg < 4;
            const float msel = keep ? sel : -INFINITY;
            hs[r * 64 + lane] = msel;
            int cnt = 0;
#pragma unroll 4
            for (int q4 = 0; q4 < 16; ++q4) {
                const f32x4 v = *(const LAS f32x4*)(hs + r * 64 + q4 * 4);
#pragma unroll
                for (int i = 0; i < 4; ++i) cnt += (v[i] > msel || (v[i] == msel && (q4 * 4 + i) < lane)) ? 1 : 0;
            }
            const bool chosen = keep && cnt < 8;
            float wsum = chosen ? s : 0.f;
#pragma unroll
            for (int o = 1; o < 64; o <<= 1) wsum += __shfl_xor(wsum, o);
            if (chosen) {
                const int pos = atomicAdd((int*)&lcnt[lane], 1);
                sel_ep[(wid * 16 + r) * 8 + cnt] = lane | (pos << 8);
                sel_w[(wid * 16 + r) * 8 + cnt] = s / wsum * 2.5f;
            }
        }
        __syncthreads();
        if (tid < 64) { int tt = tid; asm volatile("" : "+v"(tt)); lbase[tt] = atomicAdd(&gcnt[tt], lcnt[tt]); }
        __syncthreads();
        for (int idx = tid; idx < 512; idx += 256) {
            const int ep = sel_ep[idx], e = ep & 0xff, pos = ep >> 8, gi = lbase[e] + pos;
            LDST[(size_t)e * T + gi] = (t0 + (idx >> 3)) * NSLOT + (idx & 7);
            LWt[(size_t)e * T + gi] = sel_w[idx];
        }
    }
}

constexpr int LDS_ROWTAB = 131072, MOE_MAX_UNITS = 12, LDS_UTAB = LDS_CTL + 256, LDS_TSTART = LDS_UTAB + MOE_MAX_UNITS * 32;
__device__ __forceinline__ int moe_setup(const Params& p, LAS unsigned char* lds0, int nN, int bmul, int badd) {
    LAS int* tstart = (LAS int*)(lds0 + LDS_TSTART); LAS int* utab = (LAS int*)(lds0 + LDS_UTAB);
    const int* gcnt = (const int*)(p.ws + OFF_CNT);
    __syncthreads();
    if (threadIdx.x == 0) {
        int a = 0;
        for (int e = 0; e < NEX; ++e) { const int c = e < NE ? gcnt[e] : T; tstart[e] = a; a += (c + 255) >> 8; }
        tstart[NEX] = a;
    }
    __syncthreads();
    const int total = tstart[NEX] * nN, G = gridDim.x, c = blockIdx.x;
    if (threadIdx.x < MOE_MAX_UNITS) {
        const int i = threadIdx.x, L = i * G + c;
        int pm = 0, pn = 0, e = 0, i0 = 0, cnt = 0;
        if (L < total) {
            const int mt = L / nN, pl = L % nN;
            for (int j = 1; j < NEX; ++j) e += (mt >= tstart[j]) ? 1 : 0;
            pm = mt; pn = e * bmul + badd + pl; i0 = (mt - tstart[e]) * 256; cnt = e < NE ? gcnt[e] : T;
        }
        utab[i * 8 + 0] = pm; utab[i * 8 + 1] = pn; utab[i * 8 + 2] = e; utab[i * 8 + 3] = i0; utab[i * 8 + 4] = cnt;
    }
    __syncthreads();
    const int n = (total - c + G - 1) / G;
    return n < 0 ? 0 : (n > MOE_MAX_UNITS ? MOE_MAX_UNITS : n);
}
struct MoeSched {
    LAS const int* utab; LAS const unsigned* rowtab; int n;
    __device__ __forceinline__ bool next(int i, pg8::Unit& u) const {
        if (i >= n) return false;
        u.pm = __builtin_amdgcn_readfirstlane(utab[i * 8 + 0]); u.pn = __builtin_amdgcn_readfirstlane(utab[i * 8 + 1]); u.e = __builtin_amdgcn_readfirstlane(utab[i * 8 + 2]); u.idx = i; return true;
    }
    __device__ __forceinline__ unsigned row_off(int i, int r) const { return rowtab[i * 256 + r]; }
    __device__ __forceinline__ void a_ready(const pg8::Unit&) const {}
    __device__ __forceinline__ void done(const pg8::Unit&) const {}
};
struct EpiGU {
    static constexpr bool PERM = true;
    LAS const int* utab; unsigned char* ws;
    __device__ __forceinline__ void operator()(const f32x4 (&acc)[2][2][4][2], const pg8::Unit& u, int wr, int wc, int fr, int fq) const {
        const int e = u.e, i0 = utab[u.idx * 8 + 3], cnt = utab[u.idx * 8 + 4], pl = u.pn & 1;
        const float* LWt = (const float*)(ws + OFF_LW) + (size_t)(e < NE ? e : 0) * T;
        bf16_t* ACT = (bf16_t*)(ws + OFF_ACT) + (size_t)u.pm * 256 * FF + pl * 128 + wc * 32 + 8 * fq;
#pragma unroll
        for (int ai = 0; ai < 2; ++ai)
#pragma unroll
            for (int m = 0; m < 4; ++m) {
                const int rl = ai * 128 + wr * 64 + m * 16 + fr, li = i0 + rl;
                const float lw = LWt[li];
                const float wrow = li < cnt ? (e < NE ? lw : 1.f) : 0.f;
                float a[8];
#pragma unroll
                for (int n = 0; n < 2; ++n)
#pragma unroll
                    for (int q = 0; q < 4; ++q) { const float g = acc[ai][0][m][n][q], uu = acc[ai][1][m][n][q]; a[n * 4 + q] = g / (1.f + __expf(-g)) * uu * wrow; }
                u32x4 w; w.x = pk2(a[0], a[1]); w.y = pk2(a[2], a[3]); w.z = pk2(a[4], a[5]); w.w = pk2(a[6], a[7]);
                *(u32x4*)(ACT + (size_t)rl * FF) = w;
                asm volatile("" ::: "memory");
            }
    }
};
__device__ __forceinline__ void phase_gateup(const Params& p, LAS unsigned char* lds0) {
    const int n = moe_setup(p, lds0, 2, 2, 0);
    LAS const int* utab = (LAS const int*)(lds0 + LDS_UTAB);
    LAS unsigned* rowtab = (LAS unsigned*)(lds0 + LDS_ROWTAB);
    const int* LDST = (const int*)(p.ws + OFF_LDST);
    for (int i = 0; i < n; ++i) {
        const int e = utab[i * 8 + 2], i0 = utab[i * 8 + 3], cnt = utab[i * 8 + 4];
        if (threadIdx.x < 256) {
            const int li = i0 + threadIdx.x; int tok = 0;
            if (li < cnt) tok = e < NE ? LDST[(size_t)e * T + li] / NSLOT : li;
            rowtab[i * 256 + threadIdx.x] = (unsigned)tok * (unsigned)(D * 2);
        }
    }
    __syncthreads();
    MoeSched S{utab, rowtab, n};
    pg8::Gemm g{(const bf16_t*)(p.ws + OFF_H), (const bf16_t*)(p.ws + OFF_WGU)};
    EpiGU E{utab, p.ws};
    pg8::gemm_phase<D, EpiGU, MoeSched, true>(lds0, g, S, E);
}
struct EpiDown {
    static constexpr bool PERM = true;
    LAS const int* utab; unsigned char* ws;
    __device__ __forceinline__ void operator()(const f32x4 (&acc)[2][2][4][2], const pg8::Unit& u, int wr, int wc, int fr, int fq) const {
        const int e = u.e, i0 = utab[u.idx * 8 + 3], cnt = utab[u.idx * 8 + 4];
        const int* LDST = (const int*)(ws + OFF_LDST) + (size_t)(e < NE ? e : 0) * T;
        bf16_t* SL = (bf16_t*)(ws + OFF_SLOTS) + wc * 32 + 8 * fq;
#pragma unroll
        for (int ai = 0; ai < 2; ++ai)
#pragma unroll
            for (int m = 0; m < 4; ++m) {
                const int li = i0 + ai * 128 + wr * 64 + m * 16 + fr;
                const int ld = LDST[li];
                const int dst = li < cnt ? (e < NE ? ld : li * NSLOT + 8) : T * NSLOT;
#pragma unroll
                for (int bj = 0; bj < 2; ++bj) {
                    u32x4 w; w.x = pk2(acc[ai][bj][m][0][0], acc[ai][bj][m][0][1]); w.y = pk2(acc[ai][bj][m][0][2], acc[ai][bj][m][0][3]);
                    w.z = pk2(acc[ai][bj][m][1][0], acc[ai][bj][m][1][1]); w.w = pk2(acc[ai][bj][m][1][2], acc[ai][bj][m][1][3]);
                    *(u32x4*)(SL + (size_t)dst * 256 + bj * 128) = w;
                }
                asm volatile("" ::: "memory");
            }
    }
};
__device__ __forceinline__ void phase_down(const Params& p, LAS unsigned char* lds0, int c) {
    const int n = moe_setup(p, lds0, 1, 4, c);
    LAS const int* utab = (LAS const int*)(lds0 + LDS_UTAB);
    MoeSched S{utab, (LAS const unsigned*)(lds0 + LDS_ROWTAB), n};
    pg8::Gemm g{(const bf16_t*)(p.ws + OFF_ACT), (const bf16_t*)(p.ws + OFF_WD)};
    EpiDown E{utab, p.ws};
    pg8::gemm_phase<FF, EpiDown, MoeSched, false>(lds0, g, S, E);
}

__device__ __forceinline__ void phase_combine(const Params& p, int c) {
    const int tid = TIDX;
    const bf16_t* SL = (const bf16_t*)(p.ws + OFF_SLOTS);
    bf16_t* FFN = (bf16_t*)(p.ws + OFF_H);
    for (int item = VBLK; item < T / 8; item += NVBLK) {
        const int t = item * 8 + (tid >> 5), cc = (tid & 31) * 8;
        float s[8];
#pragma unroll
        for (int i = 0; i < 8; ++i) s[i] = 0.f;
#pragma unroll
        for (int k = 0; k < NSLOT; ++k) {
            const u32x4 v = *(const u32x4*)(SL + (size_t)(t * NSLOT + k) * 256 + cc);
#pragma unroll
            for (int i = 0; i < 4; ++i) { s[2 * i] += bflo(v[i]); s[2 * i + 1] += bfhi(v[i]); }
        }
        *(u32x4*)(FFN + (size_t)t * D + c * 256 + cc) = (u32x4){pk2(s[0], s[1]), pk2(s[2], s[3]), pk2(s[4], s[5]), pk2(s[6], s[7])};
    }
}

__device__ __forceinline__ void phase_final(const Params& p) {
    const int lane = TIDX & 63, gw = VBLK * 4 + (TIDX >> 6), ngw = NVBLK * 4;
    const float* mod = (const float*)(p.ws + OFF_MOD);
    const bf16_t* FFN = (const bf16_t*)(p.ws + OFF_H);
    for (int row = gw; row < T; row += ngw) {
        const float* g2 = mod + (size_t)(row / SEQ) * MODW + 5 * D;
        f32x4 y[4]; float s = 0.f;
#pragma unroll
        for (int j = 0; j < 4; ++j) {
            const int c = 4 * lane + 256 * j;
            const f32x4 xm = *(const f32x4*)(p.out + (size_t)row * D + c), gg = *(const f32x4*)(g2 + c);
            const u32x2 f = *(const u32x2*)(FFN + (size_t)row * D + c);
            y[j][0] = ALPHA * xm[0] + gg[0] * bflo(f.x); y[j][1] = ALPHA * xm[1] + gg[1] * bfhi(f.x);
            y[j][2] = ALPHA * xm[2] + gg[2] * bflo(f.y); y[j][3] = ALPHA * xm[3] + gg[3] * bfhi(f.y);
            s += (y[j][0] + y[j][1]) + (y[j][2] + y[j][3]);
        }
#pragma unroll
        for (int o = 1; o < 64; o <<= 1) s += __shfl_xor(s, o);
        const float mean = s * (1.f / D);
        float q = 0.f;
#pragma unroll
        for (int j = 0; j < 4; ++j) { y[j] = y[j] - mean; q += (y[j][0] * y[j][0] + y[j][1] * y[j][1]) + (y[j][2] * y[j][2] + y[j][3] * y[j][3]); }
#pragma unroll
        for (int o = 1; o < 64; o <<= 1) q += __shfl_xor(q, o);
        const float rstd = 1.0f / sqrtf(q * (1.f / D) + 1e-5f);
#pragma unroll
        for (int j = 0; j < 4; ++j) {
            const int c = 4 * lane + 256 * j;
            const f32x4 g = *(const f32x4*)(p.ln2_g + c), bb = *(const f32x4*)(p.ln2_b + c);
            *(f32x4*)(p.out + (size_t)row * D + c) = y[j] * rstd * g + bb;
        }
    }
}


#define XB_TMO      128
#define XB_XCNT(j)  (256  + 64 * (j))
#define XB_XSUB(j)  (1280 + 64 * (j))
#define XB_XGEN(j)  (2304 + 64 * (j))
#define XB_TOP      3328
#define XB_TOPGEN   3392
#define XCD_BAR_WORDS 3456
#define XB_SPIN_CAP (1u << 18)
__device__ __forceinline__ unsigned xb_ld(unsigned* p)              { return __hip_atomic_load(p, __ATOMIC_RELAXED, __HIP_MEMORY_SCOPE_AGENT); }
__device__ __forceinline__ unsigned xb_add(unsigned* p, unsigned v) { return __hip_atomic_fetch_add(p, v, __ATOMIC_RELAXED, __HIP_MEMORY_SCOPE_AGENT); }
__device__ __forceinline__ unsigned xb_xcc_id() { return (unsigned)__builtin_amdgcn_s_getreg((3 << 11) | 20) & 0xFu; }
#define XB_SPIN(cond, bar) do { unsigned _sp = 0; while (cond) { __builtin_amdgcn_s_sleep(1); \
    if ((++_sp & 255u) == 0u) { if (xb_ld(&(bar)[XB_TMO])) break; if (_sp > XB_SPIN_CAP) { atomicAdd(&(bar)[XB_TMO], 1u); break; } } } } while (0)
struct XcdBarrier { unsigned* bar; unsigned x; volatile LAS unsigned* st; };
__device__ __forceinline__ XcdBarrier xcd_barrier_post(unsigned* bar, volatile LAS unsigned* st) {
    XcdBarrier b; b.bar = bar; b.x = xb_xcc_id(); b.st = st;
    if (threadIdx.x == 0) (void)xb_add(&bar[XB_XCNT(b.x)], 1u);
    return b;
}
__device__ __forceinline__ void xcd_barrier_complete(unsigned* bar, unsigned x, unsigned& nloc, unsigned& nx) {
    const unsigned G = gridDim.x * gridDim.y * gridDim.z;
    unsigned sum, cnt, mine, sp = 0u;
    for (;;) {
        sum = 0u; cnt = 0u; mine = 0u;
#pragma unroll
        for (unsigned j = 0; j < 16; ++j) { const unsigned c = xb_ld(&bar[XB_XCNT(j)]); sum += c; cnt += (c > 0u) ? 1u : 0u; mine = (j == x) ? c : mine; }
        if (sum == G) break;
        __builtin_amdgcn_s_sleep(1);
        if ((++sp & 255u) == 0u) { if (xb_ld(&bar[XB_TMO])) break; if (sp > XB_SPIN_CAP) { atomicAdd(&bar[XB_TMO], 1u); break; } }
    }
    nloc = mine > 0u ? mine : 1u; nx = cnt > 0u ? cnt : 1u;
}
__device__ __forceinline__ void xcd_barrier(const XcdBarrier& b) {
    asm volatile("s_waitcnt vmcnt(0)" ::: "memory");
    __syncthreads();
    if (threadIdx.x == 0) {
        unsigned* bar = b.bar;
        __builtin_amdgcn_s_waitcnt(0);
        unsigned nloc = b.st[0], nx = b.st[1];
        if (nloc == 0u) { xcd_barrier_complete(bar, b.x, nloc, nx); b.st[0] = nloc; b.st[1] = nx; }
        const unsigned old = xb_add(&bar[XB_XSUB(b.x)], 1u);
        const unsigned gen = old / nloc;
        if (old + 1u == (gen + 1u) * nloc) {
            __builtin_amdgcn_fence(__ATOMIC_RELEASE, "agent");
            asm volatile("s_waitcnt vmcnt(0)" ::: "memory");
            const unsigned og = xb_add(&bar[XB_TOP], 1u);
            const unsigned tg = og / nx;
            if (og + 1u == (tg + 1u) * nx) xb_add(&bar[XB_TOPGEN], 1u);
            else XB_SPIN(xb_ld(&bar[XB_TOPGEN]) == tg, bar);
            __builtin_amdgcn_fence(__ATOMIC_ACQUIRE, "agent");
            xb_add(&bar[XB_XGEN(b.x)], 1u);
            asm volatile("s_waitcnt vmcnt(0)" ::: "memory");
        } else {
            XB_SPIN(xb_ld(&bar[XB_XGEN(b.x)]) == gen, bar);
            __builtin_amdgcn_fence(__ATOMIC_ACQUIRE, "agent");
            asm volatile("s_waitcnt vmcnt(0)" ::: "memory");
        }
    }
    __syncthreads();
}

constexpr size_t OFF_BAR = 448 * 1024;

__global__ void __launch_bounds__(512, 2) mk_fwd(Params p) {
    extern __shared__ __attribute__((aligned(16))) unsigned char smem[];
    LAS unsigned char* lds0 = (LAS unsigned char*)smem;
    if (threadIdx.x < 64) ((LAS unsigned*)(lds0 + LDS_CTL))[threadIdx.x] = 0u;
    __syncthreads();
    XcdBarrier bar; bar.bar = (unsigned*)(p.ws + OFF_BAR); bar.x = 0; bar.st = nullptr;
    bar = xcd_barrier_post((unsigned*)(p.ws + OFF_BAR), (volatile LAS unsigned*)(lds0 + LDS_CTL));
#define RUN_PHASE(k, call) { if ((k) > 0) xcd_barrier(bar); int on_ = 1; asm volatile("" : "+s"(on_)); if (on_) { int grp_ = threadIdx.x >> 8; asm volatile("" : "+v"(grp_)); LAS unsigned char* lds = lds0 + grp_ * 32768; (void)lds; call; } }
    RUN_PHASE(0, phase_prep(p, lds))
    RUN_PHASE(1, phase_xn(p))
    RUN_PHASE(2, phase_inproj(p, lds0))
    RUN_PHASE(3, phase_attn_pool(p, lds))
    RUN_PHASE(4, phase_outproj(p, lds0))
    RUN_PHASE(5, phase_router(p, lds))
    RUN_PHASE(6, phase_gateup(p, lds0))
    RUN_PHASE(7, phase_down(p, lds0, 0))
    RUN_PHASE(8, phase_combine(p, 0))
    RUN_PHASE(9, phase_down(p, lds0, 1))
    RUN_PHASE(10, phase_combine(p, 1))
    RUN_PHASE(11, phase_down(p, lds0, 2))
    RUN_PHASE(12, phase_combine(p, 2))
    RUN_PHASE(13, phase_down(p, lds0, 3))
    RUN_PHASE(14, phase_combine(p, 3))
    RUN_PHASE(15, phase_final(p))
}

extern "C" void kernel_launch(void* const* d_in, const int* in_sizes, int n_in, void* d_out, int out_size, void* d_ws, size_t ws_size, hipStream_t stream) {
    static int grid = 0;
    if (grid == 0) {
        int dev = 0, cus = 0, per_cu = 0;
        (void)hipGetDevice(&dev);
        (void)hipDeviceGetAttribute(&cus, hipDeviceAttributeMultiprocessorCount, dev);
        (void)hipFuncSetAttribute((const void*)mk_fwd, hipFuncAttributeMaxDynamicSharedMemorySize, LDS_BYTES);
        (void)hipOccupancyMaxActiveBlocksPerMultiprocessor(&per_cu, (const void*)mk_fwd, 512, LDS_BYTES);
        if (per_cu < 1) fprintf(stderr, "kernel_launch: occupancy query says %d blocks per CU\n", per_cu);
        (void)hipGetLastError();
        grid = cus;
        if (ws_size < WS_NEED) fprintf(stderr, "kernel_launch: workspace too small: %zu < %zu\n", ws_size, (size_t)WS_NEED);
    }
    Params p{};
    const float** pp = (const float**)&p;
    for (int i = 0; i < 24; ++i) pp[i] = (const float*)d_in[i];
    p.out = (float*)d_out; p.ws = (unsigned char*)d_ws;
    (void)hipMemsetAsync((char*)d_ws + OFF_BAR, 0, XCD_BAR_WORDS * 4, stream);
    hipLaunchKernelGGL(mk_fwd, dim3(grid), dim3(512), LDS_BYTES, stream, p);
}
```

```cpp
#include <hip/hip_runtime.h>
#include <stdint.h>
#include <stdio.h>


#define LAS __attribute__((address_space(3)))
#define TIDX ((int)(threadIdx.x & 255))
#define VBLK ((int)(blockIdx.x * 2 + (threadIdx.x >> 8)))
#define NVBLK ((int)(gridDim.x * 2))
typedef unsigned short bf16_t;
typedef short bf16x8 __attribute__((ext_vector_type(8)));
typedef float f32x4 __attribute__((ext_vector_type(4)));
typedef unsigned u32x4 __attribute__((ext_vector_type(4)));
typedef unsigned u32x2 __attribute__((ext_vector_type(2)));

constexpr int D = 1024, NB = 16, SEQ = 2048, T = NB * SEQ, CTXL = 256, TC = NB * CTXL, KVL = CTXL + SEQ;
constexpr int PW = 1536, NE = 64, NEX = 65, FF = 256, NSLOT = 9, MODW = 6 * D;
constexpr float ALPHA = 1.189207115002721f;
constexpr float C2 = 0.125f * 1.4426950408889634f;
constexpr int NPHASE = 16;
constexpr int LDS_BYTES = 147456, LDS_CTL = 143360;

constexpr size_t MiB = 1u << 20;
constexpr size_t OFF_CNT = 0, OFF_MOD = 4096, OFF_ROPE = 512 * 1024;
constexpr size_t OFF_WTIN = 1 * MiB, OFF_WTOUT = 4 * MiB, OFF_WGU = 6 * MiB, OFF_WD = 71 * MiB;
constexpr size_t OFF_H = 104 * MiB, OFF_LDST = 168 * MiB, OFF_LW = 176 * MiB, OFF_ACT = 184 * MiB, OFF_SLOTS = 338 * MiB;
constexpr size_t OFF_XN = 184 * MiB, OFF_Q = 256 * MiB, OFF_K = 304 * MiB, OFF_V = 322 * MiB, OFF_U = 340 * MiB, OFF_AO = 356 * MiB, OFF_STATS = 420 * MiB;
constexpr size_t WS_NEED = 483 * MiB;

struct Params {
    const float *x, *c, *ctx, *c_ctx, *w_mod, *b_mod, *w_in, *q_norm, *k_norm, *pool_w, *pool_scale, *w_out, *ln1_g, *ln1_b,
        *w_router, *router_bias, *w_gate, *w_up, *w_down, *ws_gate, *ws_up, *ws_down, *ln2_g, *ln2_b;
    float* out;
    unsigned char* ws;
};

__device__ __forceinline__ unsigned f2bf(float f) { unsigned u = __float_as_uint(f); return (u + 0x7fffu + ((u >> 16) & 1u)) >> 16; }
__device__ __forceinline__ unsigned pk2(float lo, float hi) { return f2bf(lo) | (f2bf(hi) << 16); }
__device__ __forceinline__ float bf2f(unsigned h) { return __uint_as_float(h << 16); }
__device__ __forceinline__ float bflo(unsigned w) { return __uint_as_float(w << 16); }
__device__ __forceinline__ float bfhi(unsigned w) { return __uint_as_float(w & 0xffff0000u); }

namespace pg8 {
constexpr int BM = 256, BK = 64, HALF = 128, HTB = HALF * BK * 2, STAGE_BYTES = 8 * HTB;
__host__ __device__ __forceinline__ int lds_byte(int r, int c) { const int st = (r >> 4) * 2 + (c >> 5), rr = r & 15, cc = c & 31, ob = rr * 64 + cc * 2; return st * 1024 + (ob ^ (((ob >> 9) & 1) << 5)); }
__host__ __device__ __forceinline__ void stage_rc(int b, int& R, int& C) { const int st = b / 1024, sb = b % 1024, swz = sb ^ (((sb >> 9) & 1) << 5); R = (st >> 1) * 16 + swz / 64; C = (st & 1) * 32 + (swz % 64) / 2; }
__host__ __device__ __forceinline__ int perm32(int rho) { const int n = rho >> 4, i = rho & 15; return 8 * (i >> 2) + 4 * n + (i & 3); }
struct Unit { int pm, pn, idx, e; };
struct Gemm { const bf16_t* A; const bf16_t* Bt; };
__device__ __forceinline__ unsigned cvt_pk_bf16(float lo, float hi) { unsigned r; asm volatile("v_cvt_pk_bf16_f32 %0, %1, %2" : "=v"(r) : "v"(lo), "v"(hi)); return r; }

template <int K, class Epi, class Sched, bool GATHER, bool ALIGN_EPI = true>
__device__ __forceinline__ void gemm_phase(LAS unsigned char* lds, const Gemm g, const Sched& S, const Epi& E) {
    const int tid = threadIdx.x, wid = __builtin_amdgcn_readfirstlane(tid >> 6), lane = tid & 63, wr = wid >> 2, wc = wid & 3, fr = lane & 15, fq = lane >> 4;
    constexpr int nt = K / BK;
    unsigned voffA[2], voffB[2], colA = 0; int rowA = 0;
#pragma unroll
    for (int i = 0; i < 2; ++i) { int R, C; stage_rc(tid * 16 + i * 8192, R, C); const int Rb = Epi::PERM ? ((R & ~31) + perm32(R & 31)) : R;
        voffA[i] = (unsigned)(R * K + C) * 2u; voffB[i] = (unsigned)(Rb * K + C) * 2u; if (i == 0) { colA = (unsigned)C * 2u; rowA = R; } }
    const size_t kstep = (size_t)(BK * 2);
    const size_t hstep = (size_t)HALF * K * 2;
    const size_t tstep = 2 * hstep;
    const unsigned ldsw = (unsigned)wid * 1024u;
    const int aoff = lds_byte(wr * 64 + fr, fq * 8), boff = lds_byte(wc * 32 + fr, fq * 8);
#define PG8_SA(b, h) (((b) * 2 + (h)) * HTB)
#define PG8_SB(b, h) ((4 + (b) * 2 + (h)) * HTB)
#define PG8_STAGE(bufoff, gbase, voff) do { _Pragma("unroll") for (int _i = 0; _i < 2; ++_i) \
        __builtin_amdgcn_global_load_lds((const unsigned*)((const char*)(gbase) + (voff)[_i]), (LAS unsigned*)(lds + (bufoff) + ldsw + _i * 8192), 16, 0, 0); } while (0)
#define PG8_STAGE_A(bufoff, ptr, h, NX) do { if constexpr (GATHER) { unsigned _v[2]; \
            if (NX) { _v[0] = S.row_off(nidx, (h) * HALF + rowA) + colA; _v[1] = S.row_off(nidx, (h) * HALF + rowA + 64) + colA; } else { _v[0] = vA[h][0]; _v[1] = vA[h][1]; } PG8_STAGE(bufoff, ptr, _v); } \
        else { PG8_STAGE(bufoff, (ptr) + (h) * hstep, voffA); } } while (0)
#define PG8_LDA(dst, b, h) do { _Pragma("unroll") for (int m = 0; m < 4; ++m) _Pragma("unroll") for (int k = 0; k < 2; ++k) dst[m][k] = *(const LAS bf16x8*)(lds + PG8_SA(b, h) + aoff + m * 2048 + k * 1024); } while (0)
#define PG8_LDB(dst, b, h) do { _Pragma("unroll") for (int n = 0; n < 2; ++n) _Pragma("unroll") for (int k = 0; k < 2; ++k) dst[n][k] = *(const LAS bf16x8*)(lds + PG8_SB(b, h) + boff + n * 2048 + k * 1024); } while (0)
#define PG8_MMA(ai, bj, At, Bt) do { __builtin_amdgcn_s_setprio(1); _Pragma("unroll") for (int m = 0; m < 4; ++m) _Pragma("unroll") for (int n = 0; n < 2; ++n) _Pragma("unroll") for (int k = 0; k < 2; ++k) \
        acc[ai][bj][m][n] = __builtin_amdgcn_mfma_f32_16x16x32_bf16(Bt[n][k], At[m][k], acc[ai][bj][m][n], 0, 0, 0); __builtin_amdgcn_s_setprio(0); } while (0)
#define PG8_WAIT_V(n) asm volatile("s_waitcnt vmcnt(" #n ")" ::: "memory")
#define PG8_WAIT_L(n) asm volatile("s_waitcnt lgkmcnt(" #n ")" ::: "memory")
#define PG8_BAR __builtin_amdgcn_s_barrier()
#define PG8_SCHED __builtin_amdgcn_sched_barrier(0)
    Unit cur, nxt; int ui = 0;
    if (!S.next(0, cur)) return;
    f32x4 acc[2][2][4][2];
#pragma unroll
    for (int a = 0; a < 2; ++a)
#pragma unroll
        for (int b = 0; b < 2; ++b)
#pragma unroll
            for (int m = 0; m < 4; ++m)
#pragma unroll
                for (int n = 0; n < 2; ++n) acc[a][b][m][n] = (f32x4){0.f, 0.f, 0.f, 0.f};
    bf16x8 At[4][2], B0[2][2], B1[2][2];
    unsigned vA[2][2]; int nidx = 0;
    if constexpr (GATHER) {
#pragma unroll
        for (int h = 0; h < 2; ++h)
#pragma unroll
            for (int i = 0; i < 2; ++i) vA[h][i] = S.row_off(cur.idx, h * HALF + rowA + 64 * i) + colA;
    }
    const char* cA = GATHER ? (const char*)g.A : (const char*)g.A + (size_t)cur.pm * tstep; const char* cB = (const char*)g.Bt + (size_t)cur.pn * tstep;
    S.a_ready(cur);
    PG8_STAGE(PG8_SB(0, 0), cB, voffB); PG8_STAGE(PG8_SB(0, 1), cB + hstep, voffB); PG8_STAGE_A(PG8_SA(0, 0), cA, 0, false); PG8_STAGE_A(PG8_SA(0, 1), cA, 1, false);
    if (wr == 1) PG8_BAR;
    PG8_WAIT_V(2); PG8_BAR;
    PG8_STAGE(PG8_SB(1, 0), cB + kstep, voffB); PG8_STAGE_A(PG8_SA(1, 0), cA + kstep, 0, false); PG8_STAGE(PG8_SB(1, 1), cB + hstep + kstep, voffB);
    PG8_WAIT_V(6); PG8_BAR;
    for (;;) {
        const bool has_next = S.next(ui + 1, nxt);
        if constexpr (GATHER) nidx = has_next ? nxt.idx : cur.idx;
        const char* nA = GATHER ? (const char*)g.A : (has_next ? (const char*)g.A + (size_t)nxt.pm * tstep : cA); const char* nB = has_next ? (const char*)g.Bt + (size_t)nxt.pn * tstep : cB;
        for (int t = 0; t < nt; t += 2) {
            const bool last = (t == nt - 2);
            const char* a1 = cA + (size_t)(t + 1) * kstep;
            const char* a2 = last ? nA : cA + (size_t)(t + 2) * kstep; const char* b2 = last ? nB : cB + (size_t)(t + 2) * kstep;
            const char* a3 = a2 + kstep; const char* b3 = b2 + kstep;
            if (last && has_next) S.a_ready(nxt);
            PG8_LDB(B0, 0, 0); PG8_LDB(B1, 0, 1); PG8_SCHED; PG8_LDA(At, 0, 0); PG8_STAGE_A(PG8_SA(1, 1), a1, 1, false);
            PG8_WAIT_V(8); PG8_WAIT_L(0); PG8_BAR; PG8_MMA(0, 0, At, B0); PG8_MMA(0, 1, At, B1); PG8_BAR; PG8_SCHED;
            PG8_LDA(At, 0, 1); PG8_STAGE(PG8_SB(0, 0), b2, voffB); PG8_STAGE(PG8_SB(0, 1), b2 + hstep, voffB); PG8_STAGE_A(PG8_SA(0, 0), a2, 0, last);
            PG8_WAIT_V(8); PG8_WAIT_L(0); PG8_BAR; PG8_MMA(1, 0, At, B0); PG8_MMA(1, 1, At, B1); PG8_BAR; PG8_SCHED;
            PG8_LDB(B0, 1, 0); PG8_LDB(B1, 1, 1); PG8_SCHED; PG8_LDA(At, 1, 0); PG8_STAGE_A(PG8_SA(0, 1), a2, 1, last);
            PG8_WAIT_V(8); PG8_WAIT_L(0); PG8_BAR; PG8_MMA(0, 0, At, B0); PG8_MMA(0, 1, At, B1); PG8_BAR; PG8_SCHED;
            PG8_LDA(At, 1, 1); PG8_STAGE(PG8_SB(1, 0), b3, voffB); PG8_STAGE(PG8_SB(1, 1), b3 + hstep, voffB); PG8_STAGE_A(PG8_SA(1, 0), a3, 0, last);
            PG8_WAIT_V(8); PG8_WAIT_L(0); PG8_BAR; PG8_MMA(1, 0, At, B0); PG8_MMA(1, 1, At, B1); PG8_BAR; PG8_SCHED;
        }
        if constexpr (ALIGN_EPI) { if (wr == 0) PG8_BAR; }
        E(acc, cur, wr, wc, fr, fq); S.done(cur);
        if (!has_next) break;
#pragma unroll
        for (int a = 0; a < 2; ++a)
#pragma unroll
            for (int b = 0; b < 2; ++b)
#pragma unroll
                for (int m = 0; m < 4; ++m)
#pragma unroll
                    for (int n = 0; n < 2; ++n) acc[a][b][m][n] = (f32x4){0.f, 0.f, 0.f, 0.f};
        cur = nxt; cA = nA; cB = nB; ++ui;
        if constexpr (GATHER) {
#pragma unroll
            for (int h = 0; h < 2; ++h)
#pragma unroll
                for (int i = 0; i < 2; ++i) vA[h][i] = S.row_off(cur.idx, h * HALF + rowA + 64 * i) + colA;
        }
        if constexpr (ALIGN_EPI) { if (wr == 1) PG8_BAR; }
    }
    PG8_WAIT_V(0);
    if constexpr (!ALIGN_EPI) { if (wr == 0) PG8_BAR; }
    PG8_BAR;
#undef PG8_SA
#undef PG8_SB
#undef PG8_STAGE
#undef PG8_STAGE_A
#undef PG8_LDA
#undef PG8_LDB
#undef PG8_MMA
#undef PG8_WAIT_V
#undef PG8_WAIT_L
#undef PG8_BAR
#undef PG8_SCHED
}

struct DenseSched {
    int nN, n1, total, pn2lo, nN2, G, c;
    __device__ __forceinline__ bool next(int i, Unit& u) const {
        const int L = i * G + c; if (L >= total) return false;
        if (L < n1) { u.pm = L / nN; u.pn = L % nN; } else { const int r = L - n1; u.pm = n1 / nN + r / nN2; u.pn = pn2lo + r % nN2; }
        u.idx = i; u.e = 0; return true;
    }
    __device__ __forceinline__ void a_ready(const Unit&) const {}
    __device__ __forceinline__ void done(const Unit&) const {}
};
}

__device__ __forceinline__ int win_row(int n) { return (n & ~255) + 128 * ((n >> 5) & 1) + 32 * ((n >> 6) & 3) + (n & 31); }
__device__ __forceinline__ int gu_row(int j, int half) { return (j >> 7) * 256 + half * 128 + (j & 127); }

template <class RowMap>
__device__ __forceinline__ void transpose_tile(LAS float* tile, const float* src, int ld, int k0, int n0, bf16_t* dst, int Kdst, RowMap rowmap) {
    const int tid = TIDX;
#pragma unroll
    for (int pss = 0; pss < 4; ++pss) {
        const int k = pss * 16 + (tid >> 4), n4 = (tid & 15) * 4;
        const f32x4 v = *(const f32x4*)(src + (size_t)(k0 + k) * ld + n0 + n4);
        tile[k * 65 + n4 + 0] = v[0]; tile[k * 65 + n4 + 1] = v[1]; tile[k * 65 + n4 + 2] = v[2]; tile[k * 65 + n4 + 3] = v[3];
    }
    __syncthreads();
    {
        const int n = tid >> 2, kc = (tid & 3) * 16;
        unsigned w[8];
#pragma unroll
        for (int i = 0; i < 8; ++i) w[i] = pk2(tile[(kc + 2 * i) * 65 + n], tile[(kc + 2 * i + 1) * 65 + n]);
        bf16_t* dp = dst + (size_t)rowmap(n0 + n) * Kdst + k0 + kc;
        *(u32x4*)dp = (u32x4){w[0], w[1], w[2], w[3]};
        *(u32x4*)(dp + 8) = (u32x4){w[4], w[5], w[6], w[7]};
    }
    __syncthreads();
}

__device__ __forceinline__ void phase_prep(const Params& p, LAS unsigned char* lds) {
    const int tid = TIDX;
    int* gcnt = (int*)(p.ws + OFF_CNT);
    if (VBLK == 0 && tid < 128) gcnt[tid] = 0;
    float* mod = (float*)(p.ws + OFF_MOD);
    float* rope = (float*)(p.ws + OFF_ROPE);
    constexpr int N_MOD = 192, N_ROPE = 256, N_TR = 384 + 256 + NEX * 192;
    for (int it = VBLK; it < N_MOD + N_ROPE + N_TR; it += NVBLK) {
        if (it < N_MOD) {
            LAS float* red = (LAS float*)lds;
            const int col = it * 32 + (tid & 31), kk = tid >> 5;
            float acc[17];
#pragma unroll
            for (int r = 0; r < 17; ++r) acc[r] = 0.f;
            for (int i = 0; i < 128; ++i) {
                const int k = kk + 8 * i;
                const float wv = p.w_mod[(size_t)k * MODW + col];
#pragma unroll
                for (int r = 0; r < 17; ++r) {
                    const float cv = (r < 16) ? p.c[r * D + k] : p.c_ctx[k];
                    acc[r] += (cv / (1.f + expf(-cv))) * wv;
                }
            }
#pragma unroll
            for (int r = 0; r < 17; ++r) red[(kk * 17 + r) * 32 + (tid & 31)] = acc[r];
            __syncthreads();
            for (int o = tid; o < 17 * 32; o += 256) {
                const int r = o >> 5, j = o & 31;
                float s = p.b_mod[it * 32 + j];
#pragma unroll
                for (int g = 0; g < 8; ++g) s += red[(g * 17 + r) * 32 + j];
                mod[r * MODW + it * 32 + j] = s;
            }
            __syncthreads();
        } else if (it < N_MOD + N_ROPE) {
            const int idx = (it - N_MOD) * 256 + tid, t = idx >> 5, i = idx & 31;
            const int pos = (i < 16) ? (t >> 6) : (t & 63);
            const float invf = (float)exp(-(double)(i & 15) / 16.0 * 9.210340371976184);
            const double ang = (double)((float)pos * invf);
            rope[idx * 2 + 0] = (float)cos(ang);
            rope[idx * 2 + 1] = (float)sin(ang);
        } else {
            LAS float* tile = (LAS float*)lds;
            int idx = it - N_MOD - N_ROPE;
            if (idx < 384) {
                transpose_tile(tile, p.w_in, PW, (idx / 24) * 64, (idx % 24) * 64, (bf16_t*)(p.ws + OFF_WTIN), D, [](int n) { return win_row(n); });
            } else if (idx < 640) {
                idx -= 384;
                transpose_tile(tile, p.w_out, D, (idx / 16) * 64, (idx % 16) * 64, (bf16_t*)(p.ws + OFF_WTOUT), D, [](int n) { return n; });
            } else {
                idx -= 640;
                const int e = idx / 192, r = idx % 192;
                if (r < 128) {
                    const int half = r >> 6, rr = r & 63;
                    const float* src = half ? (e < NE ? p.w_up + (size_t)e * D * FF : p.ws_up) : (e < NE ? p.w_gate + (size_t)e * D * FF : p.ws_gate);
                    transpose_tile(tile, src, FF, (rr / 4) * 64, (rr % 4) * 64, (bf16_t*)(p.ws + OFF_WGU) + (size_t)e * 512 * D, D, [half](int n) { return gu_row(n, half); });
                } else {
                    const int rr = r - 128;
                    const float* src = e < NE ? p.w_down + (size_t)e * FF * D : p.ws_down;
                    transpose_tile(tile, src, D, (rr / 16) * 64, (rr % 16) * 64, (bf16_t*)(p.ws + OFF_WD) + (size_t)e * D * FF, FF, [](int n) { return n; });
                }
            }
        }
    }
}

__device__ __forceinline__ void phase_xn(const Params& p) {
    const int lane = TIDX & 63, gw = VBLK * 4 + (TIDX >> 6), ngw = NVBLK * 4;
    const float* mod = (const float*)(p.ws + OFF_MOD);
    bf16_t* XN = (bf16_t*)(p.ws + OFF_XN);
    for (int row = gw; row < T + TC; row += ngw) {
        const float* src = row < T ? p.x + (size_t)row * D : p.ctx + (size_t)(row - T) * D;
        const float* mr = mod + (size_t)(row < T ? row / SEQ : 16) * MODW;
#pragma unroll
        for (int j = 0; j < 4; ++j) {
            const int c = 4 * lane + 256 * j;
            const f32x4 v = *(const f32x4*)(src + c), sh = *(const f32x4*)(mr + c), sc = *(const f32x4*)(mr + D + c);
            u32x2 o; o.x = pk2(v[0] * (1.f + sc[0]) + sh[0], v[1] * (1.f + sc[1]) + sh[1]); o.y = pk2(v[2] * (1.f + sc[2]) + sh[2], v[3] * (1.f + sc[3]) + sh[3]);
            *(u32x2*)(XN + (size_t)row * D + c) = o;
        }
    }
}

struct EpiIn {
    static constexpr bool PERM = true;
    const float *q_norm, *k_norm, *rope; bf16_t *Qb, *Kb, *Vb, *Ub;
    __device__ __forceinline__ void operator()(const f32x4 (&acc)[2][2][4][2], const pg8::Unit& u, int wr, int wc, int fr, int fq) const {
        const int grp = u.pn * 4 + wc;
        const bool is_ctx = u.pm >= T / 256;
        f32x4 gn[2][2];
        if (grp >= 4 && grp < 20) {
            const float* g = grp < 16 ? q_norm : k_norm;
#pragma unroll
            for (int bj = 0; bj < 2; ++bj)
#pragma unroll
                for (int n = 0; n < 2; ++n) gn[bj][n] = *(const f32x4*)(g + 32 * bj + 8 * fq + 4 * n);
        }
#pragma unroll
        for (int ai = 0; ai < 2; ++ai)
#pragma unroll
            for (int m = 0; m < 4; ++m) {
                const int row = u.pm * 256 + ai * 128 + wr * 64 + m * 16 + fr;
                f32x4 v[2][2];
#pragma unroll
                for (int bj = 0; bj < 2; ++bj)
#pragma unroll
                    for (int n = 0; n < 2; ++n) v[bj][n] = acc[ai][bj][m][n];
                bf16_t* dst;
                if (grp < 4) dst = Ub + (size_t)row * 256 + grp * 64;
                else if (grp < 16) dst = Qb + (size_t)row * 768 + (grp - 4) * 64;
                else {
                    const size_t krow = is_ctx ? (size_t)((row - T) >> 8) * KVL + ((row - T) & 255) : (size_t)(row >> 11) * KVL + CTXL + (row & (SEQ - 1));
                    dst = (grp < 20 ? Kb + (grp - 16) * 64 : Vb + (grp - 20) * 64) + krow * 256;
                }
                if (grp >= 4 && grp < 20) {
                    float ss = 0.f;
#pragma unroll
                    for (int bj = 0; bj < 2; ++bj)
#pragma unroll
                        for (int n = 0; n < 2; ++n) ss += (v[bj][n][0] * v[bj][n][0] + v[bj][n][1] * v[bj][n][1]) + (v[bj][n][2] * v[bj][n][2] + v[bj][n][3] * v[bj][n][3]);
                    ss += __shfl_xor(ss, 16); ss += __shfl_xor(ss, 32);
                    const float rs = 1.0f / sqrtf(ss * (1.f / 64.f) + 1e-6f);
#pragma unroll
                    for (int bj = 0; bj < 2; ++bj)
#pragma unroll
                        for (int n = 0; n < 2; ++n) v[bj][n] = v[bj][n] * rs * gn[bj][n];
                    if (!is_ctx) {
                        const int tpos = row & (SEQ - 1);
#pragma unroll
                        for (int bj = 0; bj < 2; ++bj)
#pragma unroll
                            for (int n = 0; n < 2; ++n) {
                                const f32x4 cs = *(const f32x4*)(rope + (size_t)(tpos * 32 + 16 * bj + 4 * fq + 2 * n) * 2);
                                const f32x4 x = v[bj][n];
                                v[bj][n] = (f32x4){x[0] * cs[0] - x[1] * cs[1], x[0] * cs[1] + x[1] * cs[0], x[2] * cs[2] - x[3] * cs[3], x[2] * cs[3] + x[3] * cs[2]};
                            }
                    }
                    if (grp < 16) {
#pragma unroll
                        for (int bj = 0; bj < 2; ++bj)
#pragma unroll
                            for (int n = 0; n < 2; ++n) v[bj][n] = v[bj][n] * C2;
                    }
                }
#pragma unroll
                for (int bj = 0; bj < 2; ++bj) {
                    u32x4 w; w.x = pk2(v[bj][0][0], v[bj][0][1]); w.y = pk2(v[bj][0][2], v[bj][0][3]); w.z = pk2(v[bj][1][0], v[bj][1][1]); w.w = pk2(v[bj][1][2], v[bj][1][3]);
                    *(u32x4*)(dst + 32 * bj + 8 * fq) = w;
                }
            }
    }
};
__device__ __forceinline__ int vcu_of_block() { const int G = gridDim.x, bx = blockIdx.x; return (G % 8 == 0) ? (bx % 8) * (G / 8) + bx / 8 : bx; }
__device__ __forceinline__ void phase_inproj(const Params& p, LAS unsigned char* lds) {
    pg8::Gemm g{(const bf16_t*)(p.ws + OFF_XN), (const bf16_t*)(p.ws + OFF_WTIN)};
    pg8::DenseSched S{6, 768, 800, 4, 2, (int)gridDim.x, vcu_of_block()};
    EpiIn E{p.q_norm, p.k_norm, (const float*)(p.ws + OFF_ROPE), (bf16_t*)(p.ws + OFF_Q), (bf16_t*)(p.ws + OFF_K), (bf16_t*)(p.ws + OFF_V), (bf16_t*)(p.ws + OFF_U)};
    pg8::gemm_phase<D, EpiIn, pg8::DenseSched, false>(lds, g, S, E);
}

namespace attn_body {
using bf16=unsigned short;
using bf16x8=__attribute__((ext_vector_type(8)))short;
using s16x4=__attribute__((ext_vector_type(4)))short;
using f32x16=__attribute__((ext_vector_type(16)))float;
using u32x4=__attribute__((ext_vector_type(4)))unsigned;
constexpr int D=64,QP=768,KP=256,OP=1024,SEQ=2048,KVLEN=2304;
constexpr int NW=8,QBLK=32,QB=QBLK*NW,KVBLK=64,NT=KVLEN/KVBLK;
__device__ __forceinline__ int crow(int r,int hi){return (r&3)+8*(r>>2)+4*hi;}
#define SBAR() __builtin_amdgcn_sched_barrier(0)
constexpr int NSLOT=3, SLOTB=8192;
constexpr int LDS_K=0, LDS_V=NSLOT*SLOTB, LDS_WS=2*NSLOT*SLOTB, LDS_OST=LDS_WS+NW*64*4, LDS_BYTES=LDS_OST+NW*4096;
constexpr float C2=0.125f*1.4426950408889634f;
__device__ __forceinline__ void glds16(const void*gsrc,unsigned lds_dst){unsigned keep;
  asm volatile("s_mov_b32 %0, m0\n\ts_mov_b32 m0, %2\n\ts_nop 0\n\tglobal_load_lds_dwordx4 %1, off\n\ts_mov_b32 m0, %0":"=&s"(keep):"v"(gsrc),"s"(lds_dst):"memory");}
__device__ __forceinline__ float max3f(float a,float b,float c){float r;asm("v_max3_f32 %0, %1, %2, %3":"=v"(r):"v"(a),"v"(b),"v"(c));return r;}
__device__ __forceinline__ float max2f(float a,float b){float r;asm("v_max_f32_e32 %0, %1, %2":"=v"(r):"v"(a),"v"(b));return r;}
__device__ __forceinline__ float fadd_s(float a,float b){float r;asm("v_add_f32_e32 %0, %1, %2":"=v"(r):"v"(a),"v"(b));return r;}
__device__ __forceinline__ float fsub_s(float a,float b){float r;asm("v_sub_f32_e32 %0, %1, %2":"=v"(r):"v"(a),"v"(b));return r;}
typedef float f32x2_t __attribute__((ext_vector_type(2))); typedef __bf16 bf16x2_t __attribute__((ext_vector_type(2)));
__device__ __forceinline__ unsigned cvtpk_s(float lo,float hi){f32x2_t v={lo,hi};bf16x2_t b=__builtin_convertvector(v,bf16x2_t);return __builtin_bit_cast(unsigned,b);}
#define WAIT_BAR(N) asm volatile("s_waitcnt vmcnt(" #N ") lgkmcnt(0)\n\ts_barrier":::"memory")

__device__ __forceinline__ void qkt(f32x16&p0,f32x16&p1,const char*Kslot,const bf16x8*qr,const f32x16&negm,int r32,int hi){
  const char*kb=Kslot+hi*1024+r32*16;
  #pragma unroll
  for(int d0=0;d0<4;++d0){
    const bf16x8 b0=*reinterpret_cast<const bf16x8*>(kb+d0*2048);
    const bf16x8 b1=*reinterpret_cast<const bf16x8*>(kb+d0*2048+512);
    if(d0==0){p0=__builtin_amdgcn_mfma_f32_32x32x16_bf16(b0,qr[0],negm,0,0,0);p1=__builtin_amdgcn_mfma_f32_32x32x16_bf16(b1,qr[0],negm,0,0,0);}
    else{p0=__builtin_amdgcn_mfma_f32_32x32x16_bf16(b0,qr[d0],p0,0,0,0);p1=__builtin_amdgcn_mfma_f32_32x32x16_bf16(b1,qr[d0],p1,0,0,0);}}
}
typedef __attribute__((address_space(3))) const char* lds_cptr;
typedef short v4i16_t __attribute__((ext_vector_type(4)));
__device__ __forceinline__ void kload8(bf16x8*kf,lds_cptr kp){
  kf[0]=*(const __attribute__((address_space(3))) bf16x8*)(kp);      kf[1]=*(const __attribute__((address_space(3))) bf16x8*)(kp+512);
  kf[2]=*(const __attribute__((address_space(3))) bf16x8*)(kp+2048); kf[3]=*(const __attribute__((address_space(3))) bf16x8*)(kp+2560);
  kf[4]=*(const __attribute__((address_space(3))) bf16x8*)(kp+4096); kf[5]=*(const __attribute__((address_space(3))) bf16x8*)(kp+4608);
  kf[6]=*(const __attribute__((address_space(3))) bf16x8*)(kp+6144); kf[7]=*(const __attribute__((address_space(3))) bf16x8*)(kp+6656);
}
__device__ __forceinline__ void kload2(bf16x8*kf,lds_cptr kp,int j){ kf[2*j]=*(const __attribute__((address_space(3))) bf16x8*)(kp+j*2048); kf[2*j+1]=*(const __attribute__((address_space(3))) bf16x8*)(kp+j*2048+512); }
__device__ __forceinline__ s16x4 vtr(lds_cptr p){ return __builtin_bit_cast(s16x4,__builtin_amdgcn_ds_read_tr16_b64_v4i16((__attribute__((address_space(3))) v4i16_t*)p)); }
__device__ __forceinline__ float rowmax(const f32x16&p0,const f32x16&p1){
  float a=max3f(p0[0],p0[1],p1[0]),b=max3f(p0[2],p0[3],p1[1]);a=max3f(a,p1[2],p1[3]);
  #pragma unroll
  for(int r=4;r<16;r+=4){a=max3f(a,p0[r],p0[r+1]);b=max3f(b,p0[r+2],p0[r+3]);a=max3f(a,p1[r],p1[r+1]);b=max3f(b,p1[r+2],p1[r+3]);}
  const float m=max2f(a,b);
  auto rr=__builtin_amdgcn_permlane32_swap(__float_as_uint(m),__float_as_uint(m),false,false);
  return max2f(__uint_as_float(rr[0]),__uint_as_float(rr[1]));
}
__device__ __forceinline__ void pv(f32x16*o,int vb,bf16x8 pa0,bf16x8 pa1,bf16x8 pa2,bf16x8 pa3){
  #pragma unroll
  for(int d0=0;d0<2;++d0){s16x4 lo[4],hi[4];
    #pragma unroll
    for(int ks=0;ks<4;++ks){
      asm volatile("ds_read_b64_tr_b16 %0,%1 offset:%c2":"=&v"(lo[ks]):"v"(vb),"i"(d0*4096+ks*1024):"memory");
      asm volatile("ds_read_b64_tr_b16 %0,%1 offset:%c2":"=&v"(hi[ks]):"v"(vb),"i"(d0*4096+ks*1024+512):"memory");}
    asm volatile("s_waitcnt lgkmcnt(0)":::"memory");SBAR();
    #define PK(k) (bf16x8){lo[k][0],lo[k][1],lo[k][2],lo[k][3],hi[k][0],hi[k][1],hi[k][2],hi[k][3]}
    o[d0]=__builtin_amdgcn_mfma_f32_32x32x16_bf16(pa0,PK(0),o[d0],0,0,0);
    o[d0]=__builtin_amdgcn_mfma_f32_32x32x16_bf16(pa1,PK(1),o[d0],0,0,0);
    o[d0]=__builtin_amdgcn_mfma_f32_32x32x16_bf16(pa2,PK(2),o[d0],0,0,0);
    o[d0]=__builtin_amdgcn_mfma_f32_32x32x16_bf16(pa3,PK(3),o[d0],0,0,0);
    #undef PK
  }
}

#ifndef ATTN_STORE16
#define ATTN_STORE16(p,v) (*(u32x4*)(p)=(v))
#endif
template<int THRL> __device__ __forceinline__ void attn_unit(int b,int h,int qb,const bf16*Q,const bf16*__restrict__ K,const bf16*__restrict__ V,bf16*O,char*shm){
  const int tid=threadIdx.x,lane=tid&63,r32=lane&31,hi=lane>>5; const int wid=__builtin_amdgcn_readfirstlane(tid>>6);
  const long rowbase=(long)b*SEQ, kvbase=(long)b*KVLEN; const int q0=qb*QB, kh=h/3;
  const bf16*Qw=Q+(rowbase+q0+wid*QBLK)*QP+h*D;
  const bf16*Kh=K+kvbase*KP+kh*D,*Vh=V+kvbase*KP+kh*D;
  const unsigned lds0=(unsigned)(uintptr_t)shm;
  float*wsf=(float*)(shm+LDS_WS)+wid*64;
  const bf16*ksrc=Kh+(long)lane*KP+wid*8;
  const bf16*vsrc=Vh+(long)(16*(wid&3)+(lane>>2))*KP+(wid>>2)*32+(lane&3)*8;
  const unsigned kdst=lds0+LDS_K+wid*1024, vdst=lds0+LDS_V+wid*1024;
  #define DMA_K(t,slot) glds16(ksrc+(long)(t)*KVBLK*KP,(unsigned)__builtin_amdgcn_readfirstlane(kdst+(slot)))
  #define DMA_V(t,slot) glds16(vsrc+(long)(t)*KVBLK*KP,(unsigned)__builtin_amdgcn_readfirstlane(vdst+(slot)))
  const int vb0=(int)(lds0+LDS_V)+((lane>>4)&1)*32+(lane&3)*8+(4*hi+((lane&15)>>2))*64;
  const char*Kbase=shm+LDS_K; bf16x8 kf[8];
  const lds_cptr shm3=(lds_cptr)shm; const lds_cptr kp0=shm3+LDS_K+hi*1024+r32*16; const lds_cptr vp0=shm3+LDS_V+((lane>>4)&1)*32+(lane&3)*8+(4*hi+((lane&15)>>2))*64;
  DMA_K(0,0);DMA_V(0,0);DMA_K(1,SLOTB);
  bf16x8 qr[4];
  #pragma unroll
  for(int d0=0;d0<4;++d0)qr[d0]=*reinterpret_cast<const bf16x8*>(&Qw[(long)r32*QP+d0*16+hi*8]);
  float mhat=0.f,l_reg=0.f;f32x16 o[2];o[0]=f32x16{};o[1]=f32x16{};f32x16 negm=f32x16{};asm volatile("":"+v"(negm));
  #define CMASK(P0,P1,t) do{}while(0)
  bool resc=false;
  #define START(P0,P1) do{ const float rm=rowmax(P0,P1); resc=false; \
    { const float dl=rm; mhat=fadd_s(mhat,dl); \
      _Pragma("unroll") for(int r=0;r<16;++r){P0[r]=fsub_s(P0[r],dl);P1[r]=fsub_s(P1[r],dl);} \
      _Pragma("unroll") for(int r=0;r<16;++r)negm[r]=-mhat; asm volatile("":"+v"(negm)); } \
    _Pragma("unroll") for(int r=0;r<16;++r)P0[r]=__builtin_amdgcn_exp2f(P0[r]); }while(0)
  #define RESC() do{ if(resc){ asm volatile("s_waitcnt lgkmcnt(0)":::"memory"); \
      _Pragma("unroll") for(int d_=0;d_<2;++d_) _Pragma("unroll") for(int r=0;r<16;++r)o[d_][r]*=wsf[crow(r,hi)]; } }while(0)
  f32x16 pA0,pA1,pB0,pB1;
  int sl_prev=0,sl_cur=0,sl_next=SLOTB;
  #define ROT() do{sl_prev=sl_cur;sl_cur=sl_next;sl_next=(sl_next==(NSLOT-1)*SLOTB)?0:sl_next+SLOTB;}while(0)
  DMA_K(2,2*SLOTB);
  WAIT_BAR(3);
  qkt(pA0,pA1,Kbase,qr,negm,r32,hi);asm volatile("s_nop 15\n\ts_nop 7":"+v"(pA0),"+v"(pA1));CMASK(pA0,pA1,0);
  START(pA0,pA1);
  _Pragma("unroll") for(int r=0;r<16;++r)pA1[r]=__builtin_amdgcn_exp2f(pA1[r]);
  WAIT_BAR(0);
  DMA_K(3,0);DMA_V(1,SLOTB);
  ROT();
  kload8(kf,kp0+sl_cur);
  WAIT_BAR(2);
  s16x4 vlo[8],vhi[8]; u32x4 pw0,pw1,pw2,pw3;
  #define PKW(P,B) cvtpk_s(P[B],P[B+1])
  #define PAF(k) __builtin_bit_cast(bf16x8,pw##k)
  #define VFR(i) (bf16x8){vlo[i][0],vlo[i][1],vlo[i][2],vlo[i][3],vhi[i][0],vhi[i][1],vhi[i][2],vhi[i][3]}
  #define PIN(x) asm volatile("":"+v"(x))
  #define MX3(a,b,c) __builtin_fmaxf(__builtin_fmaxf((a),(b)),(c))
  #define GAPA(MF,A0,A1,A2,A3,W0,W1,PW) do{ MF; sacc+=A0; sacc+=A1; sacc+=A2; sacc+=A3; PIN(sacc); W0; W1; PIN(PW); SBAR(); }while(0)
  #define EX(v) __builtin_amdgcn_exp2f(v)
  #define GAPB(MF,X,B) do{ MF; X[B]=EX(X[B]); X[B+1]=EX(X[B+1]); X[B+2]=EX(X[B+2]); X[B+3]=EX(X[B+3]); PIN(X); SBAR(); }while(0)
  #define VRD(i) do{ vlo[i]=vtr(vp_+(((i)>>2)*4096+((i)&3)*1024)); vhi[i]=vtr(vp_+(((i)>>2)*4096+((i)&3)*1024+512)); }while(0)
  #define KRD(G,j) do{ if(G){ kload2(kf,kp0+sl_next,j); SBAR(); } }while(0)
  #define STEP(C0,C1,P0,P1,t,GK,GV,GL) do{ SBAR(); \
    const lds_cptr vp_=vp0+sl_prev; \
    VRD(0); SBAR(); float sacc=(P0[0]+P0[1]); \
    GAPA(C0=__builtin_amdgcn_mfma_f32_32x32x16_bf16(kf[0],qr[0],negm,0,0,0), P0[2],P0[3],P0[4],P0[5],     pw0[0]=PKW(P0,0), pw0[1]=PKW(P0,2), pw0); \
    VRD(4); SBAR(); GAPA(C1=__builtin_amdgcn_mfma_f32_32x32x16_bf16(kf[1],qr[0],negm,0,0,0), P0[6],P0[7],P0[8],P0[9],     pw0[2]=PKW(P0,4), pw0[3]=PKW(P0,6), pw0); \
    VRD(1); SBAR(); GAPA(C0=__builtin_amdgcn_mfma_f32_32x32x16_bf16(kf[2],qr[1],C0,0,0,0),   P0[10],P0[11],P0[12],P0[13], pw1[0]=PKW(P0,8), pw1[1]=PKW(P0,10), pw1); \
    VRD(5); SBAR(); GAPA(C1=__builtin_amdgcn_mfma_f32_32x32x16_bf16(kf[3],qr[1],C1,0,0,0),   P0[14],P0[15],P1[0],P1[1],   pw1[2]=PKW(P0,12),pw1[3]=PKW(P0,14), pw1); \
    VRD(2); SBAR(); GAPA(C0=__builtin_amdgcn_mfma_f32_32x32x16_bf16(kf[4],qr[2],C0,0,0,0),   P1[2],P1[3],P1[4],P1[5],     pw2[0]=PKW(P1,0), pw2[1]=PKW(P1,2), pw2); \
    VRD(6); SBAR(); GAPA(C1=__builtin_amdgcn_mfma_f32_32x32x16_bf16(kf[5],qr[2],C1,0,0,0),   P1[6],P1[7],P1[8],P1[9],     pw2[2]=PKW(P1,4), pw2[3]=PKW(P1,6), pw2); \
    VRD(3); SBAR(); GAPA(C0=__builtin_amdgcn_mfma_f32_32x32x16_bf16(kf[6],qr[3],C0,0,0,0),   P1[10],P1[11],P1[12],P1[13], pw3[0]=PKW(P1,8), pw3[1]=PKW(P1,10), pw3); \
    VRD(7); SBAR(); GAPA(C1=__builtin_amdgcn_mfma_f32_32x32x16_bf16(kf[7],qr[3],C1,0,0,0),   P1[14],P1[15],0.f,0.f,       pw3[2]=PKW(P1,12),pw3[3]=PKW(P1,14), pw3); \
    l_reg+=sacc; \
    if(GK){DMA_K((t)+3,sl_cur);} if(GV){DMA_V((t)+1,sl_next);} \
    CMASK(C0,C1,t); \
    { float a=MX3(C0[0],C0[1],C1[0]),b=MX3(C0[2],C0[3],C1[1]); a=MX3(a,C1[2],C1[3]); \
      _Pragma("unroll") for(int r=4;r<16;r+=4){a=MX3(a,C0[r],C0[r+1]);b=MX3(b,C0[r+2],C0[r+3]);a=MX3(a,C1[r],C1[r+1]);b=MX3(b,C1[r+2],C1[r+3]);} \
      float rm=__builtin_fmaxf(a,b); { auto rr=__builtin_amdgcn_permlane32_swap(__float_as_uint(rm),__float_as_uint(rm),false,false); rm=__builtin_fmaxf(__uint_as_float(rr[0]),__uint_as_float(rr[1])); } \
      resc=false; \
      if(__builtin_expect(__any(rm>(float)THRL),0)){ const float dl=__builtin_fmaxf(rm,0.f); mhat+=dl; \
        _Pragma("unroll") for(int r=0;r<16;++r){C0[r]-=dl;C1[r]-=dl;} \
        _Pragma("unroll") for(int r=0;r<16;++r)negm[r]=-mhat; asm volatile("":"+v"(negm)); \
        const float f=__builtin_amdgcn_exp2f(-dl); l_reg*=f; if(hi==0)wsf[r32]=f; resc=true; } } \
    SBAR(); \
    GAPB(o[0]=__builtin_amdgcn_mfma_f32_32x32x16_bf16(PAF(0),VFR(0),o[0],0,0,0), C0,0); \
    GAPB(o[1]=__builtin_amdgcn_mfma_f32_32x32x16_bf16(PAF(0),VFR(4),o[1],0,0,0), C0,4); \
    KRD(GL,0); GAPB(o[0]=__builtin_amdgcn_mfma_f32_32x32x16_bf16(PAF(1),VFR(1),o[0],0,0,0), C0,8); \
    KRD(GL,1); GAPB(o[1]=__builtin_amdgcn_mfma_f32_32x32x16_bf16(PAF(1),VFR(5),o[1],0,0,0), C0,12); \
    KRD(GL,2); GAPB(o[0]=__builtin_amdgcn_mfma_f32_32x32x16_bf16(PAF(2),VFR(2),o[0],0,0,0), C1,0); \
    KRD(GL,3); GAPB(o[1]=__builtin_amdgcn_mfma_f32_32x32x16_bf16(PAF(2),VFR(6),o[1],0,0,0), C1,4); \
    GAPB(o[0]=__builtin_amdgcn_mfma_f32_32x32x16_bf16(PAF(3),VFR(3),o[0],0,0,0), C1,8); \
    GAPB(o[1]=__builtin_amdgcn_mfma_f32_32x32x16_bf16(PAF(3),VFR(7),o[1],0,0,0), C1,12); \
    }while(0)
  int t=1;
  for(;t+5<NT;t+=2){
    STEP(pB0,pB1,pA0,pA1,t,true,true,true);     WAIT_BAR(2); RESC(); ROT();
    STEP(pA0,pA1,pB0,pB1,t+1,true,true,true);   WAIT_BAR(2); RESC(); ROT();
  }
  #define ENDW(tt) do{ if((tt)+3<NT){WAIT_BAR(2);} else if((tt)+2<NT){WAIT_BAR(1);} else {WAIT_BAR(0);} }while(0)
  for(;t+1<NT;t+=2){
    STEP(pB0,pB1,pA0,pA1,t,(t+3<NT),(t+1<NT),(t+1<NT));       ENDW(t);   RESC(); ROT();
    STEP(pA0,pA1,pB0,pB1,t+1,(t+4<NT),(t+2<NT),(t+2<NT));     ENDW(t+1); RESC(); ROT();
  }
  STEP(pB0,pB1,pA0,pA1,NT-1,false,false,false); RESC();
  { float sacc=pB0[0]+pB0[1]; _Pragma("unroll") for(int r=2;r<16;++r)sacc+=pB0[r]; _Pragma("unroll") for(int r=0;r<16;++r)sacc+=pB1[r]; l_reg+=sacc;
    pw0=(u32x4){PKW(pB0,0),PKW(pB0,2),PKW(pB0,4),PKW(pB0,6)};pw1=(u32x4){PKW(pB0,8),PKW(pB0,10),PKW(pB0,12),PKW(pB0,14)};pw2=(u32x4){PKW(pB1,0),PKW(pB1,2),PKW(pB1,4),PKW(pB1,6)};pw3=(u32x4){PKW(pB1,8),PKW(pB1,10),PKW(pB1,12),PKW(pB1,14)};
    SBAR(); pv(o,vb0+sl_cur,PAF(0),PAF(1),PAF(2),PAF(3)); }
  #undef PKW
  #undef PAF
  #undef VFR
  #undef PIN
  #undef MX3
  #undef GAPA
  #undef GAPB
  #undef EX
  #undef VRD
  #undef KRD
  #undef STEP
  #undef ENDW
  {auto rr=__builtin_amdgcn_permlane32_swap(__float_as_uint(l_reg),__float_as_uint(l_reg),false,false);l_reg=__uint_as_float(rr[0])+__uint_as_float(rr[1]);}
  if(hi==0)wsf[32+r32]=l_reg;asm volatile("s_waitcnt lgkmcnt(0)":::"memory");
  float rli[16];
  #pragma unroll
  for(int r=0;r<16;++r)rli[r]=__builtin_amdgcn_rcpf(wsf[32+crow(r,hi)]);
  bf16*Ow=O+(rowbase+q0+wid*QBLK)*OP+h*D;
  { bf16*stg=(bf16*)(shm+LDS_OST)+wid*2048;
    #pragma unroll
    for(int r=0;r<16;++r){const int orow=crow(r,hi);
      #pragma unroll
      for(int d0=0;d0<2;++d0)stg[orow*64+d0*32+r32]=(bf16)f2bf(o[d0][r]*rli[r]);}
    asm volatile("s_waitcnt lgkmcnt(0)":::"memory");
    #pragma unroll
    for(int i=0;i<4;++i){const int row=i*8+(lane>>3),ch=lane&7; const u32x4 v=*(const u32x4*)(stg+row*64+ch*8); ATTN_STORE16(Ow+(long)row*OP+ch*8,v);} }
  asm volatile("s_waitcnt lgkmcnt(0)\n\ts_barrier":::"memory");
  #undef DMA_K
  #undef DMA_V
  #undef CMASK
  #undef START
  #undef RESC
  #undef ROT
}
constexpr int ATTN_LDS_BYTES=LDS_BYTES;
struct AttnTensors { const bf16* Q; const bf16* K; const bf16* V; bf16* O; };
template<int THRL=8> __device__ __forceinline__ void attn_phase(char*lds,const AttnTensors&T){
  const int G=gridDim.x, bx=blockIdx.x, v=(G%8==0)?(bx%8)*(G/8)+bx/8:bx;
  for(int u=v;u<16*12*8;u+=G){
    const int pair=(u%256)/4, j=((u%256)%4)*6+u/256;
    const int b=pair>>2, kh=pair&3, g=j>>3, qb=j&7;
    attn_unit<THRL>(b,kh*3+g,qb,T.Q,T.K,T.V,T.O,lds);
  }
}
#undef SBAR
#undef WAIT_BAR
}

__device__ __forceinline__ void pool_item(const Params& p, LAS unsigned char* lds, int item) {
    const int tid = TIDX;
    const int gi = item & 3, tile = item >> 2, t0 = tile * 32, b = t0 / SEQ, tl0 = t0 % SEQ, half = 1 << gi;
    const bf16_t* Ub = (const bf16_t*)(p.ws + OFF_U);
    bf16_t* AO = (bf16_t*)(p.ws + OFF_AO);
    LAS float* us = (LAS float*)lds;
    LAS float* dl = (LAS float*)(lds + 48 * 64 * 4);
    __syncthreads();
    for (int i = tid; i < 48 * 64; i += 256) {
        const int r = i >> 6, c = i & 63, tl = tl0 - 8 + r;
        us[i] = (tl >= 0 && tl < SEQ) ? bf2f(Ub[(size_t)(b * SEQ + tl) * 256 + gi * 64 + c]) : 0.f;
    }
    __syncthreads();
    {
        const int c = tid & 63, tg = tid >> 6;
#pragma unroll
        for (int k = 0; k < 8; ++k) {
            const int tk = tg * 8 + k, tl = tl0 + tk;
            const int lo = max(tl - half, 0), hi = min(tl + half, SEQ);
            float s = 0.f;
            for (int r = lo; r < hi; ++r) s += us[(r - tl0 + 8) * 64 + c];
            dl[tk * 64 + c] = s / (float)(hi - lo) - us[(tk + 8) * 64 + c];
        }
    }
    __syncthreads();
    {
        const int dd = tid & 63, tg = tid >> 6;
        float acc[8];
#pragma unroll
        for (int k = 0; k < 8; ++k) acc[k] = 0.f;
        const float* w = p.pool_w + gi * 4096 + dd;
        for (int c = 0; c < 64; ++c) {
            const float wv = w[c * 64];
#pragma unroll
            for (int k = 0; k < 8; ++k) acc[k] += dl[(tg * 8 + k) * 64 + c] * wv;
        }
        const float ps = p.pool_scale[gi * 64 + dd];
#pragma unroll
        for (int k = 0; k < 8; ++k) AO[(size_t)(t0 + tg * 8 + k) * D + gi * 64 + dd] = (bf16_t)f2bf(acc[k] * ps);
    }
}

__device__ __forceinline__ void phase_attn_pool(const Params& p, LAS unsigned char* lds, char* smem) {
    const attn_body::AttnTensors AT{(const bf16_t*)(p.ws + OFF_Q), (const bf16_t*)(p.ws + OFF_K), (const bf16_t*)(p.ws + OFF_V), (bf16_t*)(p.ws + OFF_AO) + 256};
    attn_body::attn_phase<8>(smem, AT);
    __syncthreads();
    constexpr int N_POOL = (T / 32) * 4;
    for (int it = VBLK; it < N_POOL; it += NVBLK) pool_item(p, lds, it);
}

struct EpiOut {
    static constexpr bool PERM = false;
    const float* x; float* y; const float* mod; float* stats;
    __device__ __forceinline__ void operator()(const f32x4 (&acc)[2][2][4][2], const pg8::Unit& u, int wr, int wc, int fr, int fq) const {
        const float* g1 = mod + (size_t)(u.pm >> 3) * MODW + 2 * D;
        const int col0 = u.pn * 256 + wc * 32 + fq * 4;
        f32x4 gv[2][2];
#pragma unroll
        for (int bj = 0; bj < 2; ++bj)
#pragma unroll
            for (int n = 0; n < 2; ++n) gv[bj][n] = *(const f32x4*)(g1 + col0 + bj * 128 + n * 16);
#pragma unroll
        for (int ai = 0; ai < 2; ++ai)
#pragma unroll
            for (int m = 0; m < 4; ++m) {
                const int row = u.pm * 256 + ai * 128 + wr * 64 + m * 16 + fr;
                float s1 = 0.f, s2 = 0.f;
#pragma unroll
                for (int bj = 0; bj < 2; ++bj)
#pragma unroll
                    for (int n = 0; n < 2; ++n) {
                        const size_t off = (size_t)row * D + col0 + bj * 128 + n * 16;
                        const f32x4 xv = *(const f32x4*)(x + off);
                        const f32x4 yv = xv * ALPHA + gv[bj][n] * acc[ai][bj][m][n];
                        *(f32x4*)(y + off) = yv;
                        s1 += (yv[0] + yv[1]) + (yv[2] + yv[3]);
                        s2 += (yv[0] * yv[0] + yv[1] * yv[1]) + (yv[2] * yv[2] + yv[3] * yv[3]);
                    }
                s1 += __shfl_xor(s1, 16); s1 += __shfl_xor(s1, 32);
                s2 += __shfl_xor(s2, 16); s2 += __shfl_xor(s2, 32);
                if (fq == 0) { float* st = stats + ((size_t)row * 16 + u.pn * 4 + wc) * 2; st[0] = s1; st[1] = s2; }
            }
    }
};
__device__ __forceinline__ void phase_outproj(const Params& p, LAS unsigned char* lds) {
    pg8::Gemm g{(const bf16_t*)(p.ws + OFF_AO), (const bf16_t*)(p.ws + OFF_WTOUT)};
    pg8::DenseSched S{4, 512, 512, 0, 1, (int)gridDim.x, vcu_of_block()};
    EpiOut E{p.x, p.out, (const float*)(p.ws + OFF_MOD), (float*)(p.ws + OFF_STATS)};
    pg8::gemm_phase<D, EpiOut, pg8::DenseSched, false>(lds, g, S, E);
}

__device__ __forceinline__ void phase_router(const Params& p, LAS unsigned char* lds) {
    const int tid = TIDX, lane = tid & 63, wid = tid >> 6;
    const float* mod = (const float*)(p.ws + OFF_MOD);
    const float* stats = (const float*)(p.ws + OFF_STATS);
    bf16_t* H = (bf16_t*)(p.ws + OFF_H);
    int* gcnt = (int*)(p.ws + OFF_CNT);
    int* LDST = (int*)(p.ws + OFF_LDST);
    float* LWt = (float*)(p.ws + OFF_LW);
    LAS float* hs = (LAS float*)lds + wid * 16 * 64;
    LAS int* lcnt = (LAS int*)(lds + 16384);
    LAS int* lbase = (LAS int*)(lds + 16384 + 256);
    LAS int* sel_ep = (LAS int*)(lds + 16384 + 512);
    LAS float* sel_w = (LAS float*)(lds + 16384 + 512 + 2048);
    for (int item = VBLK; item < T / 64; item += NVBLK) {
        const int t0 = item * 64, b = t0 / SEQ, tw0 = t0 + wid * 16;
        __syncthreads();
        if (tid < 64) lcnt[tid] = 0;
        float meanv = 0.f, rstdv = 0.f;
        if (lane < 16) {
            float s1 = 0.f, s2 = 0.f;
            const float* st = stats + (size_t)(tw0 + lane) * 32;
#pragma unroll
            for (int i = 0; i < 16; ++i) { s1 += st[2 * i]; s2 += st[2 * i + 1]; }
            meanv = s1 * (1.f / D);
            const float var = fmaxf(s2 * (1.f / D) - meanv * meanv, 0.f);
            rstdv = 1.0f / sqrtf(var + 1e-5f);
        }
        float acc[16];
#pragma unroll
        for (int r = 0; r < 16; ++r) acc[r] = 0.f;
        for (int kc = 0; kc < 16; ++kc) {
            const int k = kc * 64 + lane;
            const float g = p.ln1_g[k], bb = p.ln1_b[k], sc = mod[(size_t)b * MODW + 4 * D + k], sh = mod[(size_t)b * MODW + 3 * D + k];
            __syncthreads();
#pragma unroll
            for (int r = 0; r < 16; ++r) {
                const size_t off = (size_t)(tw0 + r) * D + k;
                const float y = p.out[off];
                const float mu = __shfl(meanv, r), rs = __shfl(rstdv, r);
                const float xm = (y - mu) * rs * g + bb;
                p.out[off] = xm;
                const float hv = xm * (1.f + sc) + sh;
                H[off] = (bf16_t)f2bf(hv);
                hs[r * 64 + lane] = hv;
            }
            __syncthreads();
            const float* wr_ = p.w_router + (size_t)(kc * 64) * NE + lane;
            for (int k4 = 0; k4 < 16; ++k4) {
                const float w0 = wr_[(k4 * 4 + 0) * NE], w1 = wr_[(k4 * 4 + 1) * NE], w2 = wr_[(k4 * 4 + 2) * NE], w3 = wr_[(k4 * 4 + 3) * NE];
#pragma unroll
                for (int r = 0; r < 16; ++r) {
                    const f32x4 hv = *(const LAS f32x4*)(hs + r * 64 + k4 * 4);
                    acc[r] += hv[0] * w0; acc[r] += hv[1] * w1; acc[r] += hv[2] * w2; acc[r] += hv[3] * w3;
                }
            }
        }
        __syncthreads();
#pragma unroll
        for (int r = 0; r < 16; ++r) hs[r * 64 + lane] = acc[r];
        __syncthreads();
        const float bias = p.router_bias[lane];
        for (int r = 0; r < 16; ++r) {
            const float lg = hs[r * 64 + lane];
            const float s = 1.0f / (1.0f + expf(-lg));
            const float sel = s + bias;
            float m1 = fmaxf(sel, __shfl_xor(sel, 1)); m1 = fmaxf(m1, __shfl_xor(m1, 2)); m1 = fmaxf(m1, __shfl_xor(m1, 4));
            int cand = (sel == m1) ? lane : 64;
            cand = min(cand, __shfl_xor(cand, 1)); cand = min(cand, __shfl_xor(cand, 2)); cand = min(cand, __shfl_xor(cand, 4));
            const float sel2 = (lane == cand) ? -INFINITY : sel;
            float m2 = fmaxf(sel2, __shfl_xor(sel2, 1)); m2 = fmaxf(m2, __shfl_xor(m2, 2)); m2 = fmaxf(m2, __shfl_xor(m2, 4));
            const float gs = m1 + m2;
            const int g = lane >> 3;
            int cntg = 0;
#pragma unroll
            for (int gg = 0; gg < 8; ++gg) { const float v = __shfl(gs, gg * 8); cntg += (v > gs || (v == gs && gg < g)) ? 1 : 0; }
            const bool keep = cntg < 4;
            const float msel = keep ? sel : -INFINITY;
            hs[r * 64 + lane] = msel;
            int cnt = 0;
#pragma unroll 4
            for (int q4 = 0; q4 < 16; ++q4) {
                const f32x4 v = *(const LAS f32x4*)(hs + r * 64 + q4 * 4);
#pragma unroll
                for (int i = 0; i < 4; ++i) cnt += (v[i] > msel || (v[i] == msel && (q4 * 4 + i) < lane)) ? 1 : 0;
            }
            const bool chosen = keep && cnt < 8;
            float wsum = chosen ? s : 0.f;
#pragma unroll
            for (int o = 1; o < 64; o <<= 1) wsum += __shfl_xor(wsum, o);
            if (chosen) {
                const int pos = atomicAdd((int*)&lcnt[lane], 1);
                sel_ep[(wid * 16 + r) * 8 + cnt] = lane | (pos << 8);
                sel_w[(wid * 16 + r) * 8 + cnt] = s / wsum * 2.5f;
            }
        }
        __syncthreads();
        if (tid < 64) { int tt = tid; asm volatile("" : "+v"(tt)); lbase[tt] = atomicAdd(&gcnt[tt], lcnt[tt]); }
        __syncthreads();
        for (int idx = tid; idx < 512; idx += 256) {
            const int ep = sel_ep[idx], e = ep & 0xff, pos = ep >> 8, gi = lbase[e] + pos;
            LDST[(size_t)e * T + gi] = (t0 + (idx >> 3)) * NSLOT + (idx & 7);
            LWt[(size_t)e * T + gi] = sel_w[idx];
        }
    }
}

constexpr int LDS_ROWTAB = 131072, MOE_MAX_UNITS = 12, LDS_UTAB = LDS_CTL + 256, LDS_TSTART = LDS_UTAB + MOE_MAX_UNITS * 32;
__device__ __forceinline__ int moe_setup(const Params& p, LAS unsigned char* lds0, int nN, int bmul, int badd) {
    LAS int* tstart = (LAS int*)(lds0 + LDS_TSTART); LAS int* utab = (LAS int*)(lds0 + LDS_UTAB);
    const int* gcnt = (const int*)(p.ws + OFF_CNT);
    __syncthreads();
    if (threadIdx.x == 0) {
        int a = 0;
        for (int e = 0; e < NEX; ++e) { const int c = e < NE ? gcnt[e] : T; tstart[e] = a; a += (c + 255) >> 8; }
        tstart[NEX] = a;
    }
    __syncthreads();
    const int total = tstart[NEX] * nN, G = gridDim.x, c = blockIdx.x;
    if (threadIdx.x < MOE_MAX_UNITS) {
        const int i = threadIdx.x, L = i * G + c;
        int pm = 0, pn = 0, e = 0, i0 = 0, cnt = 0;
        if (L < total) {
            const int mt = L / nN, pl = L % nN;
            for (int j = 1; j < NEX; ++j) e += (mt >= tstart[j]) ? 1 : 0;
            pm = mt; pn = e * bmul + badd + pl; i0 = (mt - tstart[e]) * 256; cnt = e < NE ? gcnt[e] : T;
        }
        utab[i * 8 + 0] = pm; utab[i * 8 + 1] = pn; utab[i * 8 + 2] = e; utab[i * 8 + 3] = i0; utab[i * 8 + 4] = cnt;
    }
    __syncthreads();
    const int n = (total - c + G - 1) / G;
    return n < 0 ? 0 : (n > MOE_MAX_UNITS ? MOE_MAX_UNITS : n);
}
struct MoeSched {
    LAS const int* utab; LAS const unsigned* rowtab; int n;
    __device__ __forceinline__ bool next(int i, pg8::Unit& u) const {
        if (i >= n) return false;
        u.pm = __builtin_amdgcn_readfirstlane(utab[i * 8 + 0]); u.pn = __builtin_amdgcn_readfirstlane(utab[i * 8 + 1]); u.e = __builtin_amdgcn_readfirstlane(utab[i * 8 + 2]); u.idx = i; return true;
    }
    __device__ __forceinline__ unsigned row_off(int i, int r) const { return rowtab[i * 256 + r]; }
    __device__ __forceinline__ void a_ready(const pg8::Unit&) const {}
    __device__ __forceinline__ void done(const pg8::Unit&) const {}
};
struct EpiGU {
    static constexpr bool PERM = true;
    LAS const int* utab; unsigned char* ws;
    __device__ __forceinline__ void operator()(const f32x4 (&acc)[2][2][4][2], const pg8::Unit& u, int wr, int wc, int fr, int fq) const {
        const int e = u.e, i0 = utab[u.idx * 8 + 3], cnt = utab[u.idx * 8 + 4], pl = u.pn & 1;
        const float* LWt = (const float*)(ws + OFF_LW) + (size_t)(e < NE ? e : 0) * T;
        bf16_t* ACT = (bf16_t*)(ws + OFF_ACT) + (size_t)u.pm * 256 * FF + pl * 128 + wc * 32 + 8 * fq;
#pragma unroll
        for (int ai = 0; ai < 2; ++ai)
#pragma unroll
            for (int m = 0; m < 4; ++m) {
                const int rl = ai * 128 + wr * 64 + m * 16 + fr, li = i0 + rl;
                const float lw = LWt[li];
                const float wrow = li < cnt ? (e < NE ? lw : 1.f) : 0.f;
                float a[8];
#pragma unroll
                for (int n = 0; n < 2; ++n)
#pragma unroll
                    for (int q = 0; q < 4; ++q) { const float g = acc[ai][0][m][n][q], uu = acc[ai][1][m][n][q]; a[n * 4 + q] = g / (1.f + __expf(-g)) * uu * wrow; }
                u32x4 w; w.x = pk2(a[0], a[1]); w.y = pk2(a[2], a[3]); w.z = pk2(a[4], a[5]); w.w = pk2(a[6], a[7]);
                *(u32x4*)(ACT + (size_t)rl * FF) = w;
                asm volatile("" ::: "memory");
            }
    }
};
__device__ __forceinline__ void phase_gateup(const Params& p, LAS unsigned char* lds0) {
    const int n = moe_setup(p, lds0, 2, 2, 0);
    LAS const int* utab = (LAS const int*)(lds0 + LDS_UTAB);
    LAS unsigned* rowtab = (LAS unsigned*)(lds0 + LDS_ROWTAB);
    const int* LDST = (const int*)(p.ws + OFF_LDST);
    for (int i = 0; i < n; ++i) {
        const int e = utab[i * 8 + 2], i0 = utab[i * 8 + 3], cnt = utab[i * 8 + 4];
        if (threadIdx.x < 256) {
            const int li = i0 + threadIdx.x; int tok = 0;
            if (li < cnt) tok = e < NE ? LDST[(size_t)e * T + li] / NSLOT : li;
            rowtab[i * 256 + threadIdx.x] = (unsigned)tok * (unsigned)(D * 2);
        }
    }
    __syncthreads();
    MoeSched S{utab, rowtab, n};
    pg8::Gemm g{(const bf16_t*)(p.ws + OFF_H), (const bf16_t*)(p.ws + OFF_WGU)};
    EpiGU E{utab, p.ws};
    pg8::gemm_phase<D, EpiGU, MoeSched, true>(lds0, g, S, E);
}
struct EpiDown {
    static constexpr bool PERM = true;
    LAS const int* utab; unsigned char* ws;
    __device__ __forceinline__ void operator()(const f32x4 (&acc)[2][2][4][2], const pg8::Unit& u, int wr, int wc, int fr, int fq) const {
        const int e = u.e, i0 = utab[u.idx * 8 + 3], cnt = utab[u.idx * 8 + 4];
        const int* LDST = (const int*)(ws + OFF_LDST) + (size_t)(e < NE ? e : 0) * T;
        bf16_t* SL = (bf16_t*)(ws + OFF_SLOTS) + wc * 32 + 8 * fq;
#pragma unroll
        for (int ai = 0; ai < 2; ++ai)
#pragma unroll
            for (int m = 0; m < 4; ++m) {
                const int li = i0 + ai * 128 + wr * 64 + m * 16 + fr;
                const int ld = LDST[li];
                const int dst = li < cnt ? (e < NE ? ld : li * NSLOT + 8) : T * NSLOT;
#pragma unroll
                for (int bj = 0; bj < 2; ++bj) {
                    u32x4 w; w.x = pk2(acc[ai][bj][m][0][0], acc[ai][bj][m][0][1]); w.y = pk2(acc[ai][bj][m][0][2], acc[ai][bj][m][0][3]);
                    w.z = pk2(acc[ai][bj][m][1][0], acc[ai][bj][m][1][1]); w.w = pk2(acc[ai][bj][m][1][2], acc[ai][bj][m][1][3]);
                    *(u32x4*)(SL + (size_t)dst * 256 + bj * 128) = w;
                }
                asm volatile("" ::: "memory");
            }
    }
};
__device__ __forceinline__ void phase_down(const Params& p, LAS unsigned char* lds0, int c) {
    const int n = moe_setup(p, lds0, 1, 4, c);
    LAS const int* utab = (LAS const int*)(lds0 + LDS_UTAB);
    MoeSched S{utab, (LAS const unsigned*)(lds0 + LDS_ROWTAB), n};
    pg8::Gemm g{(const bf16_t*)(p.ws + OFF_ACT), (const bf16_t*)(p.ws + OFF_WD)};
    EpiDown E{utab, p.ws};
    pg8::gemm_phase<FF, EpiDown, MoeSched, false>(lds0, g, S, E);
}

__device__ __forceinline__ void phase_combine(const Params& p, int c) {
    const int tid = TIDX;
    const bf16_t* SL = (const bf16_t*)(p.ws + OFF_SLOTS);
    bf16_t* FFN = (bf16_t*)(p.ws + OFF_H);
    for (int item = VBLK; item < T / 8; item += NVBLK) {
        const int t = item * 8 + (tid >> 5), cc = (tid & 31) * 8;
        float s[8];
#pragma unroll
        for (int i = 0; i < 8; ++i) s[i] = 0.f;
#pragma unroll
        for (int k = 0; k < NSLOT; ++k) {
            const u32x4 v = *(const u32x4*)(SL + (size_t)(t * NSLOT + k) * 256 + cc);
#pragma unroll
            for (int i = 0; i < 4; ++i) { s[2 * i] += bflo(v[i]); s[2 * i + 1] += bfhi(v[i]); }
        }
        *(u32x4*)(FFN + (size_t)t * D + c * 256 + cc) = (u32x4){pk2(s[0], s[1]), pk2(s[2], s[3]), pk2(s[4], s[5]), pk2(s[6], s[7])};
    }
}

__device__ __forceinline__ void phase_final(const Params& p) {
    const int lane = TIDX & 63, gw = VBLK * 4 + (TIDX >> 6), ngw = NVBLK * 4;
    const float* mod = (const float*)(p.ws + OFF_MOD);
    const bf16_t* FFN = (const bf16_t*)(p.ws + OFF_H);
    for (int row = gw; row < T; row += ngw) {
        const float* g2 = mod + (size_t)(row / SEQ) * MODW + 5 * D;
        f32x4 y[4]; float s = 0.f;
#pragma unroll
        for (int j = 0; j < 4; ++j) {
            const int c = 4 * lane + 256 * j;
            const f32x4 xm = *(const f32x4*)(p.out + (size_t)row * D + c), gg = *(const f32x4*)(g2 + c);
            const u32x2 f = *(const u32x2*)(FFN + (size_t)row * D + c);
            y[j][0] = ALPHA * xm[0] + gg[0] * bflo(f.x); y[j][1] = ALPHA * xm[1] + gg[1] * bfhi(f.x);
            y[j][2] = ALPHA * xm[2] + gg[2] * bflo(f.y); y[j][3] = ALPHA * xm[3] + gg[3] * bfhi(f.y);
            s += (y[j][0] + y[j][1]) + (y[j][2] + y[j][3]);
        }
#pragma unroll
        for (int o = 1; o < 64; o <<= 1) s += __shfl_xor(s, o);
        const float mean = s * (1.f / D);
        float q = 0.f;
#pragma unroll
        for (int j = 0; j < 4; ++j) { y[j] = y[j] - mean; q += (y[j][0] * y[j][0] + y[j][1] * y[j][1]) + (y[j][2] * y[j][2] + y[j][3] * y[j][3]); }
#pragma unroll
        for (int o = 1; o < 64; o <<= 1) q += __shfl_xor(q, o);
        const float rstd = 1.0f / sqrtf(q * (1.f / D) + 1e-5f);
#pragma unroll
        for (int j = 0; j < 4; ++j) {
            const int c = 4 * lane + 256 * j;
            const f32x4 g = *(const f32x4*)(p.ln2_g + c), bb = *(const f32x4*)(p.ln2_b + c);
            *(f32x4*)(p.out + (size_t)row * D + c) = y[j] * rstd * g + bb;
        }
    }
}


#define XB_TMO      128
#define XB_XCNT(j)  (256  + 64 * (j))
#define XB_XSUB(j)  (1280 + 64 * (j))
#define XB_XGEN(j)  (2304 + 64 * (j))
#define XB_TOP      3328
#define XB_TOPGEN   3392
#define XCD_BAR_WORDS 3456
#define XB_SPIN_CAP (1u << 18)
__device__ __forceinline__ unsigned xb_ld(unsigned* p)              { return __hip_atomic_load(p, __ATOMIC_RELAXED, __HIP_MEMORY_SCOPE_AGENT); }
__device__ __forceinline__ unsigned xb_add(unsigned* p, unsigned v) { return __hip_atomic_fetch_add(p, v, __ATOMIC_RELAXED, __HIP_MEMORY_SCOPE_AGENT); }
__device__ __forceinline__ unsigned xb_xcc_id() { return (unsigned)__builtin_amdgcn_s_getreg((3 << 11) | 20) & 0xFu; }
#define XB_SPIN(cond, bar) do { unsigned _sp = 0; while (cond) { __builtin_amdgcn_s_sleep(1); \
    if ((++_sp & 255u) == 0u) { if (xb_ld(&(bar)[XB_TMO])) break; if (_sp > XB_SPIN_CAP) { atomicAdd(&(bar)[XB_TMO], 1u); break; } } } } while (0)
struct XcdBarrier { unsigned* bar; unsigned x; volatile LAS unsigned* st; };
__device__ __forceinline__ XcdBarrier xcd_barrier_post(unsigned* bar, volatile LAS unsigned* st) {
    XcdBarrier b; b.bar = bar; b.x = xb_xcc_id(); b.st = st;
    if (threadIdx.x == 0) (void)xb_add(&bar[XB_XCNT(b.x)], 1u);
    return b;
}
__device__ __forceinline__ void xcd_barrier_complete(unsigned* bar, unsigned x, unsigned& nloc, unsigned& nx) {
    const unsigned G = gridDim.x * gridDim.y * gridDim.z;
    unsigned sum, cnt, mine, sp = 0u;
    for (;;) {
        sum = 0u; cnt = 0u; mine = 0u;
#pragma unroll
        for (unsigned j = 0; j < 16; ++j) { const unsigned c = xb_ld(&bar[XB_XCNT(j)]); sum += c; cnt += (c > 0u) ? 1u : 0u; mine = (j == x) ? c : mine; }
        if (sum == G) break;
        __builtin_amdgcn_s_sleep(1);
        if ((++sp & 255u) == 0u) { if (xb_ld(&bar[XB_TMO])) break; if (sp > XB_SPIN_CAP) { atomicAdd(&bar[XB_TMO], 1u); break; } }
    }
    nloc = mine > 0u ? mine : 1u; nx = cnt > 0u ? cnt : 1u;
}
__device__ __forceinline__ void xcd_barrier(const XcdBarrier& b) {
    asm volatile("s_waitcnt vmcnt(0)" ::: "memory");
    __syncthreads();
    if (threadIdx.x == 0) {
        unsigned* bar = b.bar;
        __builtin_amdgcn_s_waitcnt(0);
        unsigned nloc = b.st[0], nx = b.st[1];
        if (nloc == 0u) { xcd_barrier_complete(bar, b.x, nloc, nx); b.st[0] = nloc; b.st[1] = nx; }
        const unsigned old = xb_add(&bar[XB_XSUB(b.x)], 1u);
        const unsigned gen = old / nloc;
        if (old + 1u == (gen + 1u) * nloc) {
            __builtin_amdgcn_fence(__ATOMIC_RELEASE, "agent");
            asm volatile("s_waitcnt vmcnt(0)" ::: "memory");
            const unsigned og = xb_add(&bar[XB_TOP], 1u);
            const unsigned tg = og / nx;
            if (og + 1u == (tg + 1u) * nx) xb_add(&bar[XB_TOPGEN], 1u);
            else XB_SPIN(xb_ld(&bar[XB_TOPGEN]) == tg, bar);
            __builtin_amdgcn_fence(__ATOMIC_ACQUIRE, "agent");
            xb_add(&bar[XB_XGEN(b.x)], 1u);
            asm volatile("s_waitcnt vmcnt(0)" ::: "memory");
        } else {
            XB_SPIN(xb_ld(&bar[XB_XGEN(b.x)]) == gen, bar);
            __builtin_amdgcn_fence(__ATOMIC_ACQUIRE, "agent");
            asm volatile("s_waitcnt vmcnt(0)" ::: "memory");
        }
    }
    __syncthreads();
}

constexpr size_t OFF_BAR = 448 * 1024;

__global__ void __launch_bounds__(512, 2) mk_fwd(Params p) {
    extern __shared__ __attribute__((aligned(16))) unsigned char smem[];
    LAS unsigned char* lds0 = (LAS unsigned char*)smem;
    if (threadIdx.x < 64) ((LAS unsigned*)(lds0 + LDS_CTL))[threadIdx.x] = 0u;
    __syncthreads();
    XcdBarrier bar; bar.bar = (unsigned*)(p.ws + OFF_BAR); bar.x = 0; bar.st = nullptr;
    bar = xcd_barrier_post((unsigned*)(p.ws + OFF_BAR), (volatile LAS unsigned*)(lds0 + LDS_CTL));
#define RUN_PHASE(k, call) { if ((k) > 0) xcd_barrier(bar); int on_ = 1; asm volatile("" : "+s"(on_)); if (on_) { int grp_ = threadIdx.x >> 8; asm volatile("" : "+v"(grp_)); LAS unsigned char* lds = lds0 + grp_ * 32768; (void)lds; call; } }
    RUN_PHASE(0, phase_prep(p, lds))
    RUN_PHASE(1, phase_xn(p))
    RUN_PHASE(2, phase_inproj(p, lds0))
    RUN_PHASE(3, phase_attn_pool(p, lds, (char*)smem))
    RUN_PHASE(4, phase_outproj(p, lds0))
    RUN_PHASE(5, phase_router(p, lds))
    RUN_PHASE(6, phase_gateup(p, lds0))
    RUN_PHASE(7, phase_down(p, lds0, 0))
    RUN_PHASE(8, phase_combine(p, 0))
    RUN_PHASE(9, phase_down(p, lds0, 1))
    RUN_PHASE(10, phase_combine(p, 1))
    RUN_PHASE(11, phase_down(p, lds0, 2))
    RUN_PHASE(12, phase_combine(p, 2))
    RUN_PHASE(13, phase_down(p, lds0, 3))
    RUN_PHASE(14, phase_combine(p, 3))
    RUN_PHASE(15, phase_final(p))
}

extern "C" void kernel_launch(void* const* d_in, const int* in_sizes, int n_in, void* d_out, int out_size, void* d_ws, size_t ws_size, hipStream_t stream) {
    static int grid = 0;
    if (grid == 0) {
        int dev = 0, cus = 0, per_cu = 0;
        (void)hipGetDevice(&dev);
        (void)hipDeviceGetAttribute(&cus, hipDeviceAttributeMultiprocessorCount, dev);
        (void)hipFuncSetAttribute((const void*)mk_fwd, hipFuncAttributeMaxDynamicSharedMemorySize, LDS_BYTES);
        (void)hipOccupancyMaxActiveBlocksPerMultiprocessor(&per_cu, (const void*)mk_fwd, 512, LDS_BYTES);
        if (per_cu < 1) fprintf(stderr, "kernel_launch: occupancy query says %d blocks per CU\n", per_cu);
        (void)hipGetLastError();
        grid = cus;
        if (ws_size < WS_NEED) fprintf(stderr, "kernel_launch: workspace too small: %zu < %zu\n", ws_size, (size_t)WS_NEED);
    }
    Params p{};
    const float** pp = (const float**)&p;
    for (int i = 0; i < 24; ++i) pp[i] = (const float*)d_in[i];
    p.out = (float*)d_out; p.ws = (unsigned char*)d_ws;
    (void)hipMemsetAsync((char*)d_ws + OFF_BAR, 0, XCD_BAR_WORDS * 4, stream);
    hipLaunchKernelGGL(mk_fwd, dim3(grid), dim3(512), LDS_BYTES, stream, p);
}
```

```cpp
#include <hip/hip_runtime.h>
#include <stdint.h>
#include <stdio.h>


#define LAS __attribute__((address_space(3)))
#define TIDX ((int)(threadIdx.x & 255))
#define VBLK ((int)(blockIdx.x * 2 + (threadIdx.x >> 8)))
#define NVBLK ((int)(gridDim.x * 2))
typedef unsigned short bf16_t;
typedef short bf16x8 __attribute__((ext_vector_type(8)));
typedef float f32x4 __attribute__((ext_vector_type(4)));
typedef unsigned u32x4 __attribute__((ext_vector_type(4)));
typedef unsigned u32x2 __attribute__((ext_vector_type(2)));

constexpr int D = 1024, NB = 16, SEQ = 2048, T = NB * SEQ, CTXL = 256, TC = NB * CTXL, KVL = CTXL + SEQ;
constexpr int PW = 1536, NE = 64, NEX = 65, FF = 256, NSLOT = 9, MODW = 6 * D;
constexpr float ALPHA = 1.189207115002721f;
constexpr float C2 = 0.125f * 1.4426950408889634f;
constexpr int NPHASE = 16;
constexpr int LDS_BYTES = 147456, LDS_CTL = 143360;

constexpr size_t MiB = 1u << 20;
constexpr size_t OFF_CNT = 0, OFF_MOD = 4096, OFF_ROPE = 512 * 1024;
constexpr size_t OFF_WTIN = 1 * MiB, OFF_WTOUT = 4 * MiB, OFF_WGU = 6 * MiB, OFF_WD = 71 * MiB;
constexpr size_t OFF_H = 104 * MiB, OFF_LDST = 168 * MiB, OFF_LW = 176 * MiB, OFF_ACT = 184 * MiB, OFF_SLOTS = 338 * MiB;
constexpr size_t OFF_XN = 184 * MiB, OFF_Q = 256 * MiB, OFF_K = 304 * MiB, OFF_V = 322 * MiB, OFF_U = 340 * MiB, OFF_AO = 356 * MiB, OFF_STATS = 420 * MiB;
constexpr size_t WS_NEED = 483 * MiB;

struct Params {
    const float *x, *c, *ctx, *c_ctx, *w_mod, *b_mod, *w_in, *q_norm, *k_norm, *pool_w, *pool_scale, *w_out, *ln1_g, *ln1_b,
        *w_router, *router_bias, *w_gate, *w_up, *w_down, *ws_gate, *ws_up, *ws_down, *ln2_g, *ln2_b;
    float* out;
    unsigned char* ws;
};

__device__ __forceinline__ unsigned f2bf(float f) { unsigned u = __float_as_uint(f); return (u + 0x7fffu + ((u >> 16) & 1u)) >> 16; }
__device__ __forceinline__ unsigned pk2(float lo, float hi) { return f2bf(lo) | (f2bf(hi) << 16); }
__device__ __forceinline__ float bf2f(unsigned h) { return __uint_as_float(h << 16); }
__device__ __forceinline__ float bflo(unsigned w) { return __uint_as_float(w << 16); }
__device__ __forceinline__ float bfhi(unsigned w) { return __uint_as_float(w & 0xffff0000u); }

namespace pg8 {
constexpr int BM = 256, BK = 64, HALF = 128, HTB = HALF * BK * 2, STAGE_BYTES = 8 * HTB;
__host__ __device__ __forceinline__ int lds_byte(int r, int c) { const int st = (r >> 4) * 2 + (c >> 5), rr = r & 15, cc = c & 31, ob = rr * 64 + cc * 2; return st * 1024 + (ob ^ (((ob >> 9) & 1) << 5)); }
__host__ __device__ __forceinline__ void stage_rc(int b, int& R, int& C) { const int st = b / 1024, sb = b % 1024, swz = sb ^ (((sb >> 9) & 1) << 5); R = (st >> 1) * 16 + swz / 64; C = (st & 1) * 32 + (swz % 64) / 2; }
__host__ __device__ __forceinline__ int perm32(int rho) { const int n = rho >> 4, i = rho & 15; return 8 * (i >> 2) + 4 * n + (i & 3); }
struct Unit { int pm, pn, idx, e; };
struct Gemm { const bf16_t* A; const bf16_t* Bt; };
__device__ __forceinline__ unsigned cvt_pk_bf16(float lo, float hi) { unsigned r; asm volatile("v_cvt_pk_bf16_f32 %0, %1, %2" : "=v"(r) : "v"(lo), "v"(hi)); return r; }

template <int K, class Epi, class Sched, bool GATHER, bool ALIGN_EPI = true>
__device__ __forceinline__ void gemm_phase(LAS unsigned char* lds, const Gemm g, const Sched& S, const Epi& E) {
    const int tid = threadIdx.x, wid = __builtin_amdgcn_readfirstlane(tid >> 6), lane = tid & 63, wr = wid >> 2, wc = wid & 3, fr = lane & 15, fq = lane >> 4;
    constexpr int nt = K / BK;
    unsigned voffA[2], voffB[2], colA = 0; int rowA = 0;
#pragma unroll
    for (int i = 0; i < 2; ++i) { int R, C; stage_rc(tid * 16 + i * 8192, R, C); const int Rb = Epi::PERM ? ((R & ~31) + perm32(R & 31)) : R;
        voffA[i] = (unsigned)(R * K + C) * 2u; voffB[i] = (unsigned)(Rb * K + C) * 2u; if (i == 0) { colA = (unsigned)C * 2u; rowA = R; } }
    const size_t kstep = (size_t)(BK * 2);
    const size_t hstep = (size_t)HALF * K * 2;
    const size_t tstep = 2 * hstep;
    const unsigned ldsw = (unsigned)wid * 1024u;
    const int aoff = lds_byte(wr * 64 + fr, fq * 8), boff = lds_byte(wc * 32 + fr, fq * 8);
#define PG8_SA(b, h) (((b) * 2 + (h)) * HTB)
#define PG8_SB(b, h) ((4 + (b) * 2 + (h)) * HTB)
#define PG8_STAGE(bufoff, gbase, voff) do { _Pragma("unroll") for (int _i = 0; _i < 2; ++_i) \
        __builtin_amdgcn_global_load_lds((const unsigned*)((const char*)(gbase) + (voff)[_i]), (LAS unsigned*)(lds + (bufoff) + ldsw + _i * 8192), 16, 0, 0); } while (0)
#define PG8_STAGE_A(bufoff, ptr, h, NX) do { if constexpr (GATHER) { unsigned _v[2]; \
            if (NX) { _v[0] = S.row_off(nidx, (h) * HALF + rowA) + colA; _v[1] = S.row_off(nidx, (h) * HALF + rowA + 64) + colA; } else { _v[0] = vA[h][0]; _v[1] = vA[h][1]; } PG8_STAGE(bufoff, ptr, _v); } \
        else { PG8_STAGE(bufoff, (ptr) + (h) * hstep, voffA); } } while (0)
#define PG8_LDA(dst, b, h) do { _Pragma("unroll") for (int m = 0; m < 4; ++m) _Pragma("unroll") for (int k = 0; k < 2; ++k) dst[m][k] = *(const LAS bf16x8*)(lds + PG8_SA(b, h) + aoff + m * 2048 + k * 1024); } while (0)
#define PG8_LDB(dst, b, h) do { _Pragma("unroll") for (int n = 0; n < 2; ++n) _Pragma("unroll") for (int k = 0; k < 2; ++k) dst[n][k] = *(const LAS bf16x8*)(lds + PG8_SB(b, h) + boff + n * 2048 + k * 1024); } while (0)
#define PG8_MMA(ai, bj, At, Bt) do { __builtin_amdgcn_s_setprio(1); _Pragma("unroll") for (int m = 0; m < 4; ++m) _Pragma("unroll") for (int n = 0; n < 2; ++n) _Pragma("unroll") for (int k = 0; k < 2; ++k) \
        acc[ai][bj][m][n] = __builtin_amdgcn_mfma_f32_16x16x32_bf16(Bt[n][k], At[m][k], acc[ai][bj][m][n], 0, 0, 0); __builtin_amdgcn_s_setprio(0); } while (0)
#define PG8_WAIT_V(n) asm volatile("s_waitcnt vmcnt(" #n ")" ::: "memory")
#define PG8_WAIT_L(n) asm volatile("s_waitcnt lgkmcnt(" #n ")" ::: "memory")
#define PG8_BAR __builtin_amdgcn_s_barrier()
#define PG8_SCHED __builtin_amdgcn_sched_barrier(0)
    Unit cur, nxt; int ui = 0;
    if (!S.next(0, cur)) return;
    f32x4 acc[2][2][4][2];
#pragma unroll
    for (int a = 0; a < 2; ++a)
#pragma unroll
        for (int b = 0; b < 2; ++b)
#pragma unroll
            for (int m = 0; m < 4; ++m)
#pragma unroll
                for (int n = 0; n < 2; ++n) acc[a][b][m][n] = (f32x4){0.f, 0.f, 0.f, 0.f};
    bf16x8 At[4][2], B0[2][2], B1[2][2];
    unsigned vA[2][2]; int nidx = 0;
    if constexpr (GATHER) {
#pragma unroll
        for (int h = 0; h < 2; ++h)
#pragma unroll
            for (int i = 0; i < 2; ++i) vA[h][i] = S.row_off(cur.idx, h * HALF + rowA + 64 * i) + colA;
    }
    const char* cA = GATHER ? (const char*)g.A : (const char*)g.A + (size_t)cur.pm * tstep; const char* cB = (const char*)g.Bt + (size_t)cur.pn * tstep;
    S.a_ready(cur);
    PG8_STAGE(PG8_SB(0, 0), cB, voffB); PG8_STAGE(PG8_SB(0, 1), cB + hstep, voffB); PG8_STAGE_A(PG8_SA(0, 0), cA, 0, false); PG8_STAGE_A(PG8_SA(0, 1), cA, 1, false);
    if (wr == 1) PG8_BAR;
    PG8_WAIT_V(2); PG8_BAR;
    PG8_STAGE(PG8_SB(1, 0), cB + kstep, voffB); PG8_STAGE_A(PG8_SA(1, 0), cA + kstep, 0, false); PG8_STAGE(PG8_SB(1, 1), cB + hstep + kstep, voffB);
    PG8_WAIT_V(6); PG8_BAR;
    for (;;) {
        const bool has_next = S.next(ui + 1, nxt);
        if constexpr (GATHER) nidx = has_next ? nxt.idx : cur.idx;
        const char* nA = GATHER ? (const char*)g.A : (has_next ? (const char*)g.A + (size_t)nxt.pm * tstep : cA); const char* nB = has_next ? (const char*)g.Bt + (size_t)nxt.pn * tstep : cB;
        for (int t = 0; t < nt; t += 2) {
            const bool last = (t == nt - 2);
            const char* a1 = cA + (size_t)(t + 1) * kstep;
            const char* a2 = last ? nA : cA + (size_t)(t + 2) * kstep; const char* b2 = last ? nB : cB + (size_t)(t + 2) * kstep;
            const char* a3 = a2 + kstep; const char* b3 = b2 + kstep;
            if (last && has_next) S.a_ready(nxt);
            PG8_LDB(B0, 0, 0); PG8_LDB(B1, 0, 1); PG8_SCHED; PG8_LDA(At, 0, 0); PG8_STAGE_A(PG8_SA(1, 1), a1, 1, false);
            PG8_WAIT_V(8); PG8_WAIT_L(0); PG8_BAR; PG8_MMA(0, 0, At, B0); PG8_MMA(0, 1, At, B1); PG8_BAR; PG8_SCHED;
            PG8_LDA(At, 0, 1); PG8_STAGE(PG8_SB(0, 0), b2, voffB); PG8_STAGE(PG8_SB(0, 1), b2 + hstep, voffB); PG8_STAGE_A(PG8_SA(0, 0), a2, 0, last);
            PG8_WAIT_V(8); PG8_WAIT_L(0); PG8_BAR; PG8_MMA(1, 0, At, B0); PG8_MMA(1, 1, At, B1); PG8_BAR; PG8_SCHED;
            PG8_LDB(B0, 1, 0); PG8_LDB(B1, 1, 1); PG8_SCHED; PG8_LDA(At, 1, 0); PG8_STAGE_A(PG8_SA(0, 1), a2, 1, last);
            PG8_WAIT_V(8); PG8_WAIT_L(0); PG8_BAR; PG8_MMA(0, 0, At, B0); PG8_MMA(0, 1, At, B1); PG8_BAR; PG8_SCHED;
            PG8_LDA(At, 1, 1); PG8_STAGE(PG8_SB(1, 0), b3, voffB); PG8_STAGE(PG8_SB(1, 1), b3 + hstep, voffB); PG8_STAGE_A(PG8_SA(1, 0), a3, 0, last);
            PG8_WAIT_V(8); PG8_WAIT_L(0); PG8_BAR; PG8_MMA(1, 0, At, B0); PG8_MMA(1, 1, At, B1); PG8_BAR; PG8_SCHED;
        }
        if constexpr (ALIGN_EPI) { if (wr == 0) PG8_BAR; }
        E(acc, cur, wr, wc, fr, fq); S.done(cur);
        if (!has_next) break;
#pragma unroll
        for (int a = 0; a < 2; ++a)
#pragma unroll
            for (int b = 0; b < 2; ++b)
#pragma unroll
                for (int m = 0; m < 4; ++m)
#pragma unroll
                    for (int n = 0; n < 2; ++n) acc[a][b][m][n] = (f32x4){0.f, 0.f, 0.f, 0.f};
        cur = nxt; cA = nA; cB = nB; ++ui;
        if constexpr (GATHER) {
#pragma unroll
            for (int h = 0; h < 2; ++h)
#pragma unroll
                for (int i = 0; i < 2; ++i) vA[h][i] = S.row_off(cur.idx, h * HALF + rowA + 64 * i) + colA;
        }
        if constexpr (ALIGN_EPI) { if (wr == 1) PG8_BAR; }
    }
    PG8_WAIT_V(0);
    if constexpr (!ALIGN_EPI) { if (wr == 0) PG8_BAR; }
    PG8_BAR;
#undef PG8_SA
#undef PG8_SB
#undef PG8_STAGE
#undef PG8_STAGE_A
#undef PG8_LDA
#undef PG8_LDB
#undef PG8_MMA
#undef PG8_WAIT_V
#undef PG8_WAIT_L
#undef PG8_BAR
#undef PG8_SCHED
}

struct DenseSched {
    int nN, n1, total, pn2lo, nN2, G, c;
    __device__ __forceinline__ bool next(int i, Unit& u) const {
        const int L = i * G + c; if (L >= total) return false;
        if (L < n1) { u.pm = L / nN; u.pn = L % nN; } else { const int r = L - n1; u.pm = n1 / nN + r / nN2; u.pn = pn2lo + r % nN2; }
        u.idx = i; u.e = 0; return true;
    }
    __device__ __forceinline__ void a_ready(const Unit&) const {}
    __device__ __forceinline__ void done(const Unit&) const {}
};
}

__device__ __forceinline__ int win_row(int n) { return (n & ~255) + 128 * ((n >> 5) & 1) + 32 * ((n >> 6) & 3) + (n & 31); }
__device__ __forceinline__ int gu_row(int j, int half) { return (j >> 7) * 256 + half * 128 + (j & 127); }

template <class RowMap>
__device__ __forceinline__ void transpose_tile(LAS float* tile, const float* src, int ld, int k0, int n0, bf16_t* dst, int Kdst, RowMap rowmap) {
    const int tid = TIDX;
#pragma unroll
    for (int pss = 0; pss < 4; ++pss) {
        const int k = pss * 16 + (tid >> 4), n4 = (tid & 15) * 4;
        const f32x4 v = *(const f32x4*)(src + (size_t)(k0 + k) * ld + n0 + n4);
        tile[k * 65 + n4 + 0] = v[0]; tile[k * 65 + n4 + 1] = v[1]; tile[k * 65 + n4 + 2] = v[2]; tile[k * 65 + n4 + 3] = v[3];
    }
    __syncthreads();
    {
        const int n = tid >> 2, kc = (tid & 3) * 16;
        unsigned w[8];
#pragma unroll
        for (int i = 0; i < 8; ++i) w[i] = pk2(tile[(kc + 2 * i) * 65 + n], tile[(kc + 2 * i + 1) * 65 + n]);
        bf16_t* dp = dst + (size_t)rowmap(n0 + n) * Kdst + k0 + kc;
        *(u32x4*)dp = (u32x4){w[0], w[1], w[2], w[3]};
        *(u32x4*)(dp + 8) = (u32x4){w[4], w[5], w[6], w[7]};
    }
    __syncthreads();
}

__device__ __forceinline__ void phase_prep(const Params& p, LAS unsigned char* lds) {
    const int tid = TIDX;
    int* gcnt = (int*)(p.ws + OFF_CNT);
    if (VBLK == 0 && tid < 128) gcnt[tid] = 0;
    float* mod = (float*)(p.ws + OFF_MOD);
    float* rope = (float*)(p.ws + OFF_ROPE);
    constexpr int N_MOD = 192, N_ROPE = 256, N_TR = 384 + 256 + NEX * 192;
    for (int it = VBLK; it < N_MOD + N_ROPE + N_TR; it += NVBLK) {
        if (it < N_MOD) {
            LAS float* sl = (LAS float*)lds;
            LAS float* red = (LAS float*)(lds + 10240);
            const int col = it * 32 + (tid & 31), kk = tid >> 5;
            float acc[17];
#pragma unroll
            for (int r = 0; r < 17; ++r) acc[r] = 0.f;
            for (int kc = 0; kc < 8; ++kc) {
                __syncthreads();
                for (int o = tid; o < 17 * 128; o += 256) {
                    const int r = o >> 7, kl = o & 127;
                    const float cv = (r < 16) ? p.c[r * D + kc * 128 + kl] : p.c_ctx[kc * 128 + kl];
                    sl[kl * 20 + r] = cv / (1.f + expf(-cv));
                }
                __syncthreads();
#pragma unroll 4
                for (int i = 0; i < 16; ++i) {
                    const int kl = kk + 8 * i;
                    const float wv = p.w_mod[(size_t)(kc * 128 + kl) * MODW + col];
                    const f32x4 s0 = *(const LAS f32x4*)(sl + kl * 20), s1 = *(const LAS f32x4*)(sl + kl * 20 + 4), s2 = *(const LAS f32x4*)(sl + kl * 20 + 8), s3 = *(const LAS f32x4*)(sl + kl * 20 + 12);
                    const float s4 = sl[kl * 20 + 16];
#pragma unroll
                    for (int q = 0; q < 4; ++q) { acc[q] += s0[q] * wv; acc[4 + q] += s1[q] * wv; acc[8 + q] += s2[q] * wv; acc[12 + q] += s3[q] * wv; }
                    acc[16] += s4 * wv;
                }
            }
#pragma unroll
            for (int r = 0; r < 17; ++r) red[(kk * 17 + r) * 32 + (tid & 31)] = acc[r];
            __syncthreads();
            for (int o = tid; o < 17 * 32; o += 256) {
                const int r = o >> 5, j = o & 31;
                float sm = p.b_mod[it * 32 + j];
#pragma unroll
                for (int g = 0; g < 8; ++g) sm += red[(g * 17 + r) * 32 + j];
                mod[r * MODW + it * 32 + j] = sm;
            }
            __syncthreads();
        } else if (it < N_MOD + N_ROPE) {
            const int idx = (it - N_MOD) * 256 + tid, t = idx >> 5, i = idx & 31;
            const int pos = (i < 16) ? (t >> 6) : (t & 63);
            const float invf = (float)exp(-(double)(i & 15) / 16.0 * 9.210340371976184);
            const double ang = (double)((float)pos * invf);
            rope[idx * 2 + 0] = (float)cos(ang);
            rope[idx * 2 + 1] = (float)sin(ang);
        } else {
            LAS float* tile = (LAS float*)lds;
            int idx = it - N_MOD - N_ROPE;
            if (idx < 384) {
                transpose_tile(tile, p.w_in, PW, (idx / 24) * 64, (idx % 24) * 64, (bf16_t*)(p.ws + OFF_WTIN), D, [](int n) { return win_row(n); });
            } else if (idx < 640) {
                idx -= 384;
                transpose_tile(tile, p.w_out, D, (idx / 16) * 64, (idx % 16) * 64, (bf16_t*)(p.ws + OFF_WTOUT), D, [](int n) { return n; });
            } else {
                idx -= 640;
                const int e = idx / 192, r = idx % 192;
                if (r < 128) {
                    const int half = r >> 6, rr = r & 63;
                    const float* src = half ? (e < NE ? p.w_up + (size_t)e * D * FF : p.ws_up) : (e < NE ? p.w_gate + (size_t)e * D * FF : p.ws_gate);
                    transpose_tile(tile, src, FF, (rr / 4) * 64, (rr % 4) * 64, (bf16_t*)(p.ws + OFF_WGU) + (size_t)e * 512 * D, D, [half](int n) { return gu_row(n, half); });
                } else {
                    const int rr = r - 128;
                    const float* src = e < NE ? p.w_down + (size_t)e * FF * D : p.ws_down;
                    transpose_tile(tile, src, D, (rr / 16) * 64, (rr % 16) * 64, (bf16_t*)(p.ws + OFF_WD) + (size_t)e * D * FF, FF, [](int n) { return n; });
                }
            }
        }
    }
}

__device__ __forceinline__ void phase_xn(const Params& p) {
    const int lane = TIDX & 63, gw = VBLK * 4 + (TIDX >> 6), ngw = NVBLK * 4;
    const float* mod = (const float*)(p.ws + OFF_MOD);
    bf16_t* XN = (bf16_t*)(p.ws + OFF_XN);
    for (int row = gw; row < T + TC; row += ngw) {
        const float* src = row < T ? p.x + (size_t)row * D : p.ctx + (size_t)(row - T) * D;
        const float* mr = mod + (size_t)(row < T ? row / SEQ : 16) * MODW;
#pragma unroll
        for (int j = 0; j < 4; ++j) {
            const int c = 4 * lane + 256 * j;
            const f32x4 v = *(const f32x4*)(src + c), sh = *(const f32x4*)(mr + c), sc = *(const f32x4*)(mr + D + c);
            u32x2 o; o.x = pk2(v[0] * (1.f + sc[0]) + sh[0], v[1] * (1.f + sc[1]) + sh[1]); o.y = pk2(v[2] * (1.f + sc[2]) + sh[2], v[3] * (1.f + sc[3]) + sh[3]);
            *(u32x2*)(XN + (size_t)row * D + c) = o;
        }
    }
}

struct EpiIn {
    static constexpr bool PERM = true;
    const float *q_norm, *k_norm, *rope; bf16_t *Qb, *Kb, *Vb, *Ub;
    __device__ __forceinline__ void operator()(const f32x4 (&acc)[2][2][4][2], const pg8::Unit& u, int wr, int wc, int fr, int fq) const {
        const int grp = u.pn * 4 + wc;
        const bool is_ctx = u.pm >= T / 256;
        f32x4 gn[2][2];
        if (grp >= 4 && grp < 20) {
            const float* g = grp < 16 ? q_norm : k_norm;
#pragma unroll
            for (int bj = 0; bj < 2; ++bj)
#pragma unroll
                for (int n = 0; n < 2; ++n) gn[bj][n] = *(const f32x4*)(g + 32 * bj + 8 * fq + 4 * n);
        }
#pragma unroll
        for (int ai = 0; ai < 2; ++ai)
#pragma unroll
            for (int m = 0; m < 4; ++m) {
                const int row = u.pm * 256 + ai * 128 + wr * 64 + m * 16 + fr;
                f32x4 v[2][2];
#pragma unroll
                for (int bj = 0; bj < 2; ++bj)
#pragma unroll
                    for (int n = 0; n < 2; ++n) v[bj][n] = acc[ai][bj][m][n];
                bf16_t* dst;
                if (grp < 4) dst = Ub + (size_t)row * 256 + grp * 64;
                else if (grp < 16) dst = Qb + (size_t)row * 768 + (grp - 4) * 64;
                else {
                    const size_t krow = is_ctx ? (size_t)((row - T) >> 8) * KVL + ((row - T) & 255) : (size_t)(row >> 11) * KVL + CTXL + (row & (SEQ - 1));
                    dst = (grp < 20 ? Kb + (grp - 16) * 64 : Vb + (grp - 20) * 64) + krow * 256;
                }
                if (grp >= 4 && grp < 20) {
                    float ss = 0.f;
#pragma unroll
                    for (int bj = 0; bj < 2; ++bj)
#pragma unroll
                        for (int n = 0; n < 2; ++n) ss += (v[bj][n][0] * v[bj][n][0] + v[bj][n][1] * v[bj][n][1]) + (v[bj][n][2] * v[bj][n][2] + v[bj][n][3] * v[bj][n][3]);
                    ss += __shfl_xor(ss, 16); ss += __shfl_xor(ss, 32);
                    const float rs = 1.0f / sqrtf(ss * (1.f / 64.f) + 1e-6f);
#pragma unroll
                    for (int bj = 0; bj < 2; ++bj)
#pragma unroll
                        for (int n = 0; n < 2; ++n) v[bj][n] = v[bj][n] * rs * gn[bj][n];
                    if (!is_ctx) {
                        const int tpos = row & (SEQ - 1);
#pragma unroll
                        for (int bj = 0; bj < 2; ++bj)
#pragma unroll
                            for (int n = 0; n < 2; ++n) {
                                const f32x4 cs = *(const f32x4*)(rope + (size_t)(tpos * 32 + 16 * bj + 4 * fq + 2 * n) * 2);
                                const f32x4 x = v[bj][n];
                                v[bj][n] = (f32x4){x[0] * cs[0] - x[1] * cs[1], x[0] * cs[1] + x[1] * cs[0], x[2] * cs[2] - x[3] * cs[3], x[2] * cs[3] + x[3] * cs[2]};
                            }
                    }
                    if (grp < 16) {
#pragma unroll
                        for (int bj = 0; bj < 2; ++bj)
#pragma unroll
                            for (int n = 0; n < 2; ++n) v[bj][n] = v[bj][n] * C2;
                    }
                }
#pragma unroll
                for (int bj = 0; bj < 2; ++bj) {
                    u32x4 w; w.x = pk2(v[bj][0][0], v[bj][0][1]); w.y = pk2(v[bj][0][2], v[bj][0][3]); w.z = pk2(v[bj][1][0], v[bj][1][1]); w.w = pk2(v[bj][1][2], v[bj][1][3]);
                    *(u32x4*)(dst + 32 * bj + 8 * fq) = w;
                }
            }
    }
};
__device__ __forceinline__ int vcu_of_block() { const int G = gridDim.x, bx = blockIdx.x; return (G % 8 == 0) ? (bx % 8) * (G / 8) + bx / 8 : bx; }
__device__ __forceinline__ void phase_inproj(const Params& p, LAS unsigned char* lds) {
    pg8::Gemm g{(const bf16_t*)(p.ws + OFF_XN), (const bf16_t*)(p.ws + OFF_WTIN)};
    pg8::DenseSched S{6, 768, 800, 4, 2, (int)gridDim.x, vcu_of_block()};
    EpiIn E{p.q_norm, p.k_norm, (const float*)(p.ws + OFF_ROPE), (bf16_t*)(p.ws + OFF_Q), (bf16_t*)(p.ws + OFF_K), (bf16_t*)(p.ws + OFF_V), (bf16_t*)(p.ws + OFF_U)};
    pg8::gemm_phase<D, EpiIn, pg8::DenseSched, false>(lds, g, S, E);
}

namespace attn_body {
using bf16=unsigned short;
using bf16x8=__attribute__((ext_vector_type(8)))short;
using s16x4=__attribute__((ext_vector_type(4)))short;
using f32x16=__attribute__((ext_vector_type(16)))float;
using u32x4=__attribute__((ext_vector_type(4)))unsigned;
constexpr int D=64,QP=768,KP=256,OP=1024,SEQ=2048,KVLEN=2304;
constexpr int NW=8,QBLK=32,QB=QBLK*NW,KVBLK=64,NT=KVLEN/KVBLK;
__device__ __forceinline__ int crow(int r,int hi){return (r&3)+8*(r>>2)+4*hi;}
#define SBAR() __builtin_amdgcn_sched_barrier(0)
constexpr int NSLOT=3, SLOTB=8192;
constexpr int LDS_K=0, LDS_V=NSLOT*SLOTB, LDS_WS=2*NSLOT*SLOTB, LDS_OST=LDS_WS+NW*64*4, LDS_BYTES=LDS_OST+NW*4096;
constexpr float C2=0.125f*1.4426950408889634f;
__device__ __forceinline__ void glds16(const void*gsrc,unsigned lds_dst){unsigned keep;
  asm volatile("s_mov_b32 %0, m0\n\ts_mov_b32 m0, %2\n\ts_nop 0\n\tglobal_load_lds_dwordx4 %1, off\n\ts_mov_b32 m0, %0":"=&s"(keep):"v"(gsrc),"s"(lds_dst):"memory");}
__device__ __forceinline__ float max3f(float a,float b,float c){float r;asm("v_max3_f32 %0, %1, %2, %3":"=v"(r):"v"(a),"v"(b),"v"(c));return r;}
__device__ __forceinline__ float max2f(float a,float b){float r;asm("v_max_f32_e32 %0, %1, %2":"=v"(r):"v"(a),"v"(b));return r;}
__device__ __forceinline__ float fadd_s(float a,float b){float r;asm("v_add_f32_e32 %0, %1, %2":"=v"(r):"v"(a),"v"(b));return r;}
__device__ __forceinline__ float fsub_s(float a,float b){float r;asm("v_sub_f32_e32 %0, %1, %2":"=v"(r):"v"(a),"v"(b));return r;}
typedef float f32x2_t __attribute__((ext_vector_type(2))); typedef __bf16 bf16x2_t __attribute__((ext_vector_type(2)));
__device__ __forceinline__ unsigned cvtpk_s(float lo,float hi){f32x2_t v={lo,hi};bf16x2_t b=__builtin_convertvector(v,bf16x2_t);return __builtin_bit_cast(unsigned,b);}
#define WAIT_BAR(N) asm volatile("s_waitcnt vmcnt(" #N ") lgkmcnt(0)\n\ts_barrier":::"memory")

__device__ __forceinline__ void qkt(f32x16&p0,f32x16&p1,const char*Kslot,const bf16x8*qr,const f32x16&negm,int r32,int hi){
  const char*kb=Kslot+hi*1024+r32*16;
  #pragma unroll
  for(int d0=0;d0<4;++d0){
    const bf16x8 b0=*reinterpret_cast<const bf16x8*>(kb+d0*2048);
    const bf16x8 b1=*reinterpret_cast<const bf16x8*>(kb+d0*2048+512);
    if(d0==0){p0=__builtin_amdgcn_mfma_f32_32x32x16_bf16(b0,qr[0],negm,0,0,0);p1=__builtin_amdgcn_mfma_f32_32x32x16_bf16(b1,qr[0],negm,0,0,0);}
    else{p0=__builtin_amdgcn_mfma_f32_32x32x16_bf16(b0,qr[d0],p0,0,0,0);p1=__builtin_amdgcn_mfma_f32_32x32x16_bf16(b1,qr[d0],p1,0,0,0);}}
}
typedef __attribute__((address_space(3))) const char* lds_cptr;
typedef short v4i16_t __attribute__((ext_vector_type(4)));
__device__ __forceinline__ void kload8(bf16x8*kf,lds_cptr kp){
  kf[0]=*(const __attribute__((address_space(3))) bf16x8*)(kp);      kf[1]=*(const __attribute__((address_space(3))) bf16x8*)(kp+512);
  kf[2]=*(const __attribute__((address_space(3))) bf16x8*)(kp+2048); kf[3]=*(const __attribute__((address_space(3))) bf16x8*)(kp+2560);
  kf[4]=*(const __attribute__((address_space(3))) bf16x8*)(kp+4096); kf[5]=*(const __attribute__((address_space(3))) bf16x8*)(kp+4608);
  kf[6]=*(const __attribute__((address_space(3))) bf16x8*)(kp+6144); kf[7]=*(const __attribute__((address_space(3))) bf16x8*)(kp+6656);
}
__device__ __forceinline__ void kload2(bf16x8*kf,lds_cptr kp,int j){ kf[2*j]=*(const __attribute__((address_space(3))) bf16x8*)(kp+j*2048); kf[2*j+1]=*(const __attribute__((address_space(3))) bf16x8*)(kp+j*2048+512); }
__device__ __forceinline__ s16x4 vtr(lds_cptr p){ return __builtin_bit_cast(s16x4,__builtin_amdgcn_ds_read_tr16_b64_v4i16((__attribute__((address_space(3))) v4i16_t*)p)); }
__device__ __forceinline__ float rowmax(const f32x16&p0,const f32x16&p1){
  float a=max3f(p0[0],p0[1],p1[0]),b=max3f(p0[2],p0[3],p1[1]);a=max3f(a,p1[2],p1[3]);
  #pragma unroll
  for(int r=4;r<16;r+=4){a=max3f(a,p0[r],p0[r+1]);b=max3f(b,p0[r+2],p0[r+3]);a=max3f(a,p1[r],p1[r+1]);b=max3f(b,p1[r+2],p1[r+3]);}
  const float m=max2f(a,b);
  auto rr=__builtin_amdgcn_permlane32_swap(__float_as_uint(m),__float_as_uint(m),false,false);
  return max2f(__uint_as_float(rr[0]),__uint_as_float(rr[1]));
}
__device__ __forceinline__ void pv(f32x16*o,int vb,bf16x8 pa0,bf16x8 pa1,bf16x8 pa2,bf16x8 pa3){
  #pragma unroll
  for(int d0=0;d0<2;++d0){s16x4 lo[4],hi[4];
    #pragma unroll
    for(int ks=0;ks<4;++ks){
      asm volatile("ds_read_b64_tr_b16 %0,%1 offset:%c2":"=&v"(lo[ks]):"v"(vb),"i"(d0*4096+ks*1024):"memory");
      asm volatile("ds_read_b64_tr_b16 %0,%1 offset:%c2":"=&v"(hi[ks]):"v"(vb),"i"(d0*4096+ks*1024+512):"memory");}
    asm volatile("s_waitcnt lgkmcnt(0)":::"memory");SBAR();
    #define PK(k) (bf16x8){lo[k][0],lo[k][1],lo[k][2],lo[k][3],hi[k][0],hi[k][1],hi[k][2],hi[k][3]}
    o[d0]=__builtin_amdgcn_mfma_f32_32x32x16_bf16(pa0,PK(0),o[d0],0,0,0);
    o[d0]=__builtin_amdgcn_mfma_f32_32x32x16_bf16(pa1,PK(1),o[d0],0,0,0);
    o[d0]=__builtin_amdgcn_mfma_f32_32x32x16_bf16(pa2,PK(2),o[d0],0,0,0);
    o[d0]=__builtin_amdgcn_mfma_f32_32x32x16_bf16(pa3,PK(3),o[d0],0,0,0);
    #undef PK
  }
}

#ifndef ATTN_STORE16
#define ATTN_STORE16(p,v) (*(u32x4*)(p)=(v))
#endif
template<int THRL> __device__ __forceinline__ void attn_unit(int b,int h,int qb,const bf16*Q,const bf16*__restrict__ K,const bf16*__restrict__ V,bf16*O,char*shm){
  const int tid=threadIdx.x,lane=tid&63,r32=lane&31,hi=lane>>5; const int wid=__builtin_amdgcn_readfirstlane(tid>>6);
  const long rowbase=(long)b*SEQ, kvbase=(long)b*KVLEN; const int q0=qb*QB, kh=h/3;
  const bf16*Qw=Q+(rowbase+q0+wid*QBLK)*QP+h*D;
  const bf16*Kh=K+kvbase*KP+kh*D,*Vh=V+kvbase*KP+kh*D;
  const unsigned lds0=(unsigned)(uintptr_t)shm;
  float*wsf=(float*)(shm+LDS_WS)+wid*64;
  const bf16*ksrc=Kh+(long)lane*KP+wid*8;
  const bf16*vsrc=Vh+(long)(16*(wid&3)+(lane>>2))*KP+(wid>>2)*32+(lane&3)*8;
  const unsigned kdst=lds0+LDS_K+wid*1024, vdst=lds0+LDS_V+wid*1024;
  #define DMA_K(t,slot) glds16(ksrc+(long)(t)*KVBLK*KP,(unsigned)__builtin_amdgcn_readfirstlane(kdst+(slot)))
  #define DMA_V(t,slot) glds16(vsrc+(long)(t)*KVBLK*KP,(unsigned)__builtin_amdgcn_readfirstlane(vdst+(slot)))
  const int vb0=(int)(lds0+LDS_V)+((lane>>4)&1)*32+(lane&3)*8+(4*hi+((lane&15)>>2))*64;
  const char*Kbase=shm+LDS_K; bf16x8 kf[8];
  const lds_cptr shm3=(lds_cptr)shm; const lds_cptr kp0=shm3+LDS_K+hi*1024+r32*16; const lds_cptr vp0=shm3+LDS_V+((lane>>4)&1)*32+(lane&3)*8+(4*hi+((lane&15)>>2))*64;
  DMA_K(0,0);DMA_V(0,0);DMA_K(1,SLOTB);
  bf16x8 qr[4];
  #pragma unroll
  for(int d0=0;d0<4;++d0)qr[d0]=*reinterpret_cast<const bf16x8*>(&Qw[(long)r32*QP+d0*16+hi*8]);
  float mhat=0.f,l_reg=0.f;f32x16 o[2];o[0]=f32x16{};o[1]=f32x16{};f32x16 negm=f32x16{};asm volatile("":"+v"(negm));
  #define CMASK(P0,P1,t) do{}while(0)
  bool resc=false;
  #define START(P0,P1) do{ const float rm=rowmax(P0,P1); resc=false; \
    { const float dl=rm; mhat=fadd_s(mhat,dl); \
      _Pragma("unroll") for(int r=0;r<16;++r){P0[r]=fsub_s(P0[r],dl);P1[r]=fsub_s(P1[r],dl);} \
      _Pragma("unroll") for(int r=0;r<16;++r)negm[r]=-mhat; asm volatile("":"+v"(negm)); } \
    _Pragma("unroll") for(int r=0;r<16;++r)P0[r]=__builtin_amdgcn_exp2f(P0[r]); }while(0)
  #define RESC() do{ if(resc){ asm volatile("s_waitcnt lgkmcnt(0)":::"memory"); \
      _Pragma("unroll") for(int d_=0;d_<2;++d_) _Pragma("unroll") for(int r=0;r<16;++r)o[d_][r]*=wsf[crow(r,hi)]; } }while(0)
  f32x16 pA0,pA1,pB0,pB1;
  int sl_prev=0,sl_cur=0,sl_next=SLOTB;
  #define ROT() do{sl_prev=sl_cur;sl_cur=sl_next;sl_next=(sl_next==(NSLOT-1)*SLOTB)?0:sl_next+SLOTB;}while(0)
  DMA_K(2,2*SLOTB);
  WAIT_BAR(3);
  qkt(pA0,pA1,Kbase,qr,negm,r32,hi);asm volatile("s_nop 15\n\ts_nop 7":"+v"(pA0),"+v"(pA1));CMASK(pA0,pA1,0);
  START(pA0,pA1);
  _Pragma("unroll") for(int r=0;r<16;++r)pA1[r]=__builtin_amdgcn_exp2f(pA1[r]);
  WAIT_BAR(0);
  DMA_K(3,0);DMA_V(1,SLOTB);
  ROT();
  kload8(kf,kp0+sl_cur);
  WAIT_BAR(2);
  s16x4 vlo[8],vhi[8]; u32x4 pw0,pw1,pw2,pw3;
  #define PKW(P,B) cvtpk_s(P[B],P[B+1])
  #define PAF(k) __builtin_bit_cast(bf16x8,pw##k)
  #define VFR(i) (bf16x8){vlo[i][0],vlo[i][1],vlo[i][2],vlo[i][3],vhi[i][0],vhi[i][1],vhi[i][2],vhi[i][3]}
  #define PIN(x) asm volatile("":"+v"(x))
  #define MX3(a,b,c) __builtin_fmaxf(__builtin_fmaxf((a),(b)),(c))
  #define GAPA(MF,A0,A1,A2,A3,W0,W1,PW) do{ MF; sacc+=A0; sacc+=A1; sacc+=A2; sacc+=A3; PIN(sacc); W0; W1; PIN(PW); SBAR(); }while(0)
  #define EX(v) __builtin_amdgcn_exp2f(v)
  #define GAPB(MF,X,B) do{ MF; X[B]=EX(X[B]); X[B+1]=EX(X[B+1]); X[B+2]=EX(X[B+2]); X[B+3]=EX(X[B+3]); PIN(X); SBAR(); }while(0)
  #define VRD(i) do{ vlo[i]=vtr(vp_+(((i)>>2)*4096+((i)&3)*1024)); vhi[i]=vtr(vp_+(((i)>>2)*4096+((i)&3)*1024+512)); }while(0)
  #define KRD(G,j) do{ if(G){ kload2(kf,kp0+sl_next,j); SBAR(); } }while(0)
  #define STEP(C0,C1,P0,P1,t,GK,GV,GL) do{ SBAR(); \
    const lds_cptr vp_=vp0+sl_prev; \
    VRD(0); SBAR(); float sacc=(P0[0]+P0[1]); \
    GAPA(C0=__builtin_amdgcn_mfma_f32_32x32x16_bf16(kf[0],qr[0],negm,0,0,0), P0[2],P0[3],P0[4],P0[5],     pw0[0]=PKW(P0,0), pw0[1]=PKW(P0,2), pw0); \
    VRD(4); SBAR(); GAPA(C1=__builtin_amdgcn_mfma_f32_32x32x16_bf16(kf[1],qr[0],negm,0,0,0), P0[6],P0[7],P0[8],P0[9],     pw0[2]=PKW(P0,4), pw0[3]=PKW(P0,6), pw0); \
    VRD(1); SBAR(); GAPA(C0=__builtin_amdgcn_mfma_f32_32x32x16_bf16(kf[2],qr[1],C0,0,0,0),   P0[10],P0[11],P0[12],P0[13], pw1[0]=PKW(P0,8), pw1[1]=PKW(P0,10), pw1); \
    VRD(5); SBAR(); GAPA(C1=__builtin_amdgcn_mfma_f32_32x32x16_bf16(kf[3],qr[1],C1,0,0,0),   P0[14],P0[15],P1[0],P1[1],   pw1[2]=PKW(P0,12),pw1[3]=PKW(P0,14), pw1); \
    VRD(2); SBAR(); GAPA(C0=__builtin_amdgcn_mfma_f32_32x32x16_bf16(kf[4],qr[2],C0,0,0,0),   P1[2],P1[3],P1[4],P1[5],     pw2[0]=PKW(P1,0), pw2[1]=PKW(P1,2), pw2); \
    VRD(6); SBAR(); GAPA(C1=__builtin_amdgcn_mfma_f32_32x32x16_bf16(kf[5],qr[2],C1,0,0,0),   P1[6],P1[7],P1[8],P1[9],     pw2[2]=PKW(P1,4), pw2[3]=PKW(P1,6), pw2); \
    VRD(3); SBAR(); GAPA(C0=__builtin_amdgcn_mfma_f32_32x32x16_bf16(kf[6],qr[3],C0,0,0,0),   P1[10],P1[11],P1[12],P1[13], pw3[0]=PKW(P1,8), pw3[1]=PKW(P1,10), pw3); \
    VRD(7); SBAR(); GAPA(C1=__builtin_amdgcn_mfma_f32_32x32x16_bf16(kf[7],qr[3],C1,0,0,0),   P1[14],P1[15],0.f,0.f,       pw3[2]=PKW(P1,12),pw3[3]=PKW(P1,14), pw3); \
    l_reg+=sacc; \
    if(GK){DMA_K((t)+3,sl_cur);} if(GV){DMA_V((t)+1,sl_next);} \
    CMASK(C0,C1,t); \
    { float a=MX3(C0[0],C0[1],C1[0]),b=MX3(C0[2],C0[3],C1[1]); a=MX3(a,C1[2],C1[3]); \
      _Pragma("unroll") for(int r=4;r<16;r+=4){a=MX3(a,C0[r],C0[r+1]);b=MX3(b,C0[r+2],C0[r+3]);a=MX3(a,C1[r],C1[r+1]);b=MX3(b,C1[r+2],C1[r+3]);} \
      float rm=__builtin_fmaxf(a,b); { auto rr=__builtin_amdgcn_permlane32_swap(__float_as_uint(rm),__float_as_uint(rm),false,false); rm=__builtin_fmaxf(__uint_as_float(rr[0]),__uint_as_float(rr[1])); } \
      resc=false; \
      if(__builtin_expect(__any(rm>(float)THRL),0)){ const float dl=__builtin_fmaxf(rm,0.f); mhat+=dl; \
        _Pragma("unroll") for(int r=0;r<16;++r){C0[r]-=dl;C1[r]-=dl;} \
        _Pragma("unroll") for(int r=0;r<16;++r)negm[r]=-mhat; asm volatile("":"+v"(negm)); \
        const float f=__builtin_amdgcn_exp2f(-dl); l_reg*=f; if(hi==0)wsf[r32]=f; resc=true; } } \
    SBAR(); \
    GAPB(o[0]=__builtin_amdgcn_mfma_f32_32x32x16_bf16(PAF(0),VFR(0),o[0],0,0,0), C0,0); \
    GAPB(o[1]=__builtin_amdgcn_mfma_f32_32x32x16_bf16(PAF(0),VFR(4),o[1],0,0,0), C0,4); \
    KRD(GL,0); GAPB(o[0]=__builtin_amdgcn_mfma_f32_32x32x16_bf16(PAF(1),VFR(1),o[0],0,0,0), C0,8); \
    KRD(GL,1); GAPB(o[1]=__builtin_amdgcn_mfma_f32_32x32x16_bf16(PAF(1),VFR(5),o[1],0,0,0), C0,12); \
    KRD(GL,2); GAPB(o[0]=__builtin_amdgcn_mfma_f32_32x32x16_bf16(PAF(2),VFR(2),o[0],0,0,0), C1,0); \
    KRD(GL,3); GAPB(o[1]=__builtin_amdgcn_mfma_f32_32x32x16_bf16(PAF(2),VFR(6),o[1],0,0,0), C1,4); \
    GAPB(o[0]=__builtin_amdgcn_mfma_f32_32x32x16_bf16(PAF(3),VFR(3),o[0],0,0,0), C1,8); \
    GAPB(o[1]=__builtin_amdgcn_mfma_f32_32x32x16_bf16(PAF(3),VFR(7),o[1],0,0,0), C1,12); \
    }while(0)
  int t=1;
  for(;t+5<NT;t+=2){
    STEP(pB0,pB1,pA0,pA1,t,true,true,true);     WAIT_BAR(2); RESC(); ROT();
    STEP(pA0,pA1,pB0,pB1,t+1,true,true,true);   WAIT_BAR(2); RESC(); ROT();
  }
  #define ENDW(tt) do{ if((tt)+3<NT){WAIT_BAR(2);} else if((tt)+2<NT){WAIT_BAR(1);} else {WAIT_BAR(0);} }while(0)
  for(;t+1<NT;t+=2){
    STEP(pB0,pB1,pA0,pA1,t,(t+3<NT),(t+1<NT),(t+1<NT));       ENDW(t);   RESC(); ROT();
    STEP(pA0,pA1,pB0,pB1,t+1,(t+4<NT),(t+2<NT),(t+2<NT));     ENDW(t+1); RESC(); ROT();
  }
  STEP(pB0,pB1,pA0,pA1,NT-1,false,false,false); RESC();
  { float sacc=pB0[0]+pB0[1]; _Pragma("unroll") for(int r=2;r<16;++r)sacc+=pB0[r]; _Pragma("unroll") for(int r=0;r<16;++r)sacc+=pB1[r]; l_reg+=sacc;
    pw0=(u32x4){PKW(pB0,0),PKW(pB0,2),PKW(pB0,4),PKW(pB0,6)};pw1=(u32x4){PKW(pB0,8),PKW(pB0,10),PKW(pB0,12),PKW(pB0,14)};pw2=(u32x4){PKW(pB1,0),PKW(pB1,2),PKW(pB1,4),PKW(pB1,6)};pw3=(u32x4){PKW(pB1,8),PKW(pB1,10),PKW(pB1,12),PKW(pB1,14)};
    SBAR(); pv(o,vb0+sl_cur,PAF(0),PAF(1),PAF(2),PAF(3)); }
  #undef PKW
  #undef PAF
  #undef VFR
  #undef PIN
  #undef MX3
  #undef GAPA
  #undef GAPB
  #undef EX
  #undef VRD
  #undef KRD
  #undef STEP
  #undef ENDW
  {auto rr=__builtin_amdgcn_permlane32_swap(__float_as_uint(l_reg),__float_as_uint(l_reg),false,false);l_reg=__uint_as_float(rr[0])+__uint_as_float(rr[1]);}
  if(hi==0)wsf[32+r32]=l_reg;asm volatile("s_waitcnt lgkmcnt(0)":::"memory");
  float rli[16];
  #pragma unroll
  for(int r=0;r<16;++r)rli[r]=__builtin_amdgcn_rcpf(wsf[32+crow(r,hi)]);
  bf16*Ow=O+(rowbase+q0+wid*QBLK)*OP+h*D;
  { bf16*stg=(bf16*)(shm+LDS_OST)+wid*2048;
    #pragma unroll
    for(int r=0;r<16;++r){const int orow=crow(r,hi);
      #pragma unroll
      for(int d0=0;d0<2;++d0)stg[orow*64+d0*32+r32]=(bf16)f2bf(o[d0][r]*rli[r]);}
    asm volatile("s_waitcnt lgkmcnt(0)":::"memory");
    #pragma unroll
    for(int i=0;i<4;++i){const int row=i*8+(lane>>3),ch=lane&7; const u32x4 v=*(const u32x4*)(stg+row*64+ch*8); ATTN_STORE16(Ow+(long)row*OP+ch*8,v);} }
  asm volatile("s_waitcnt lgkmcnt(0)\n\ts_barrier":::"memory");
  #undef DMA_K
  #undef DMA_V
  #undef CMASK
  #undef START
  #undef RESC
  #undef ROT
}
constexpr int ATTN_LDS_BYTES=LDS_BYTES;
struct AttnTensors { const bf16* Q; const bf16* K; const bf16* V; bf16* O; };
template<int THRL=8> __device__ __forceinline__ void attn_phase(char*lds,const AttnTensors&T){
  const int G=gridDim.x, bx=blockIdx.x, v=(G%8==0)?(bx%8)*(G/8)+bx/8:bx;
  for(int u=v;u<16*12*8;u+=G){
    const int pair=(u%256)/4, j=((u%256)%4)*6+u/256;
    const int b=pair>>2, kh=pair&3, g=j>>3, qb=j&7;
    attn_unit<THRL>(b,kh*3+g,qb,T.Q,T.K,T.V,T.O,lds);
  }
}
#undef SBAR
#undef WAIT_BAR
}

__device__ __forceinline__ void pool_item(const Params& p, LAS unsigned char* lds, int item) {
    const int tid = TIDX;
    const int gi = item & 3, tile = item >> 2, t0 = tile * 32, b = t0 / SEQ, tl0 = t0 % SEQ, half = 1 << gi;
    const bf16_t* Ub = (const bf16_t*)(p.ws + OFF_U);
    bf16_t* AO = (bf16_t*)(p.ws + OFF_AO);
    LAS float* us = (LAS float*)lds;
    LAS float* dl = (LAS float*)(lds + 48 * 64 * 4);
    __syncthreads();
    for (int i = tid; i < 48 * 64; i += 256) {
        const int r = i >> 6, c = i & 63, tl = tl0 - 8 + r;
        us[i] = (tl >= 0 && tl < SEQ) ? bf2f(Ub[(size_t)(b * SEQ + tl) * 256 + gi * 64 + c]) : 0.f;
    }
    __syncthreads();
    {
        const int c = tid & 63, tg = tid >> 6;
#pragma unroll
        for (int k = 0; k < 8; ++k) {
            const int tk = tg * 8 + k, tl = tl0 + tk;
            const int lo = max(tl - half, 0), hi = min(tl + half, SEQ);
            float s = 0.f;
            for (int r = lo; r < hi; ++r) s += us[(r - tl0 + 8) * 64 + c];
            dl[tk * 64 + c] = s / (float)(hi - lo) - us[(tk + 8) * 64 + c];
        }
    }
    __syncthreads();
    {
        const int dd = tid & 63, tg = tid >> 6;
        float acc[8];
#pragma unroll
        for (int k = 0; k < 8; ++k) acc[k] = 0.f;
        const float* w = p.pool_w + gi * 4096 + dd;
        for (int c = 0; c < 64; ++c) {
            const float wv = w[c * 64];
#pragma unroll
            for (int k = 0; k < 8; ++k) acc[k] += dl[(tg * 8 + k) * 64 + c] * wv;
        }
        const float ps = p.pool_scale[gi * 64 + dd];
#pragma unroll
        for (int k = 0; k < 8; ++k) AO[(size_t)(t0 + tg * 8 + k) * D + gi * 64 + dd] = (bf16_t)f2bf(acc[k] * ps);
    }
}

__device__ __forceinline__ void phase_attn_pool(const Params& p, LAS unsigned char* lds, char* smem) {
    const attn_body::AttnTensors AT{(const bf16_t*)(p.ws + OFF_Q), (const bf16_t*)(p.ws + OFF_K), (const bf16_t*)(p.ws + OFF_V), (bf16_t*)(p.ws + OFF_AO) + 256};
    attn_body::attn_phase<8>(smem, AT);
    __syncthreads();
    constexpr int N_POOL = (T / 32) * 4;
    for (int it = VBLK; it < N_POOL; it += NVBLK) pool_item(p, lds, it);
}

struct EpiOut {
    static constexpr bool PERM = false;
    const float* x; float* y; const float* mod; float* stats;
    __device__ __forceinline__ void operator()(const f32x4 (&acc)[2][2][4][2], const pg8::Unit& u, int wr, int wc, int fr, int fq) const {
        const float* g1 = mod + (size_t)(u.pm >> 3) * MODW + 2 * D;
        const int col0 = u.pn * 256 + wc * 32 + fq * 4;
        f32x4 gv[2][2];
#pragma unroll
        for (int bj = 0; bj < 2; ++bj)
#pragma unroll
            for (int n = 0; n < 2; ++n) gv[bj][n] = *(const f32x4*)(g1 + col0 + bj * 128 + n * 16);
#pragma unroll
        for (int ai = 0; ai < 2; ++ai)
#pragma unroll
            for (int m = 0; m < 4; ++m) {
                const int row = u.pm * 256 + ai * 128 + wr * 64 + m * 16 + fr;
                float s1 = 0.f, s2 = 0.f;
#pragma unroll
                for (int bj = 0; bj < 2; ++bj)
#pragma unroll
                    for (int n = 0; n < 2; ++n) {
                        const size_t off = (size_t)row * D + col0 + bj * 128 + n * 16;
                        const f32x4 xv = *(const f32x4*)(x + off);
                        const f32x4 yv = xv * ALPHA + gv[bj][n] * acc[ai][bj][m][n];
                        *(f32x4*)(y + off) = yv;
                        s1 += (yv[0] + yv[1]) + (yv[2] + yv[3]);
                        s2 += (yv[0] * yv[0] + yv[1] * yv[1]) + (yv[2] * yv[2] + yv[3] * yv[3]);
                    }
                s1 += __shfl_xor(s1, 16); s1 += __shfl_xor(s1, 32);
                s2 += __shfl_xor(s2, 16); s2 += __shfl_xor(s2, 32);
                if (fq == 0) { float* st = stats + ((size_t)row * 16 + u.pn * 4 + wc) * 2; st[0] = s1; st[1] = s2; }
            }
    }
};
__device__ __forceinline__ void phase_outproj(const Params& p, LAS unsigned char* lds) {
    pg8::Gemm g{(const bf16_t*)(p.ws + OFF_AO), (const bf16_t*)(p.ws + OFF_WTOUT)};
    pg8::DenseSched S{4, 512, 512, 0, 1, (int)gridDim.x, vcu_of_block()};
    EpiOut E{p.x, p.out, (const float*)(p.ws + OFF_MOD), (float*)(p.ws + OFF_STATS)};
    pg8::gemm_phase<D, EpiOut, pg8::DenseSched, false>(lds, g, S, E);
}

__device__ __forceinline__ void phase_router(const Params& p, LAS unsigned char* lds) {
    const int tid = TIDX, lane = tid & 63, wid = tid >> 6;
    const float* mod = (const float*)(p.ws + OFF_MOD);
    const float* stats = (const float*)(p.ws + OFF_STATS);
    bf16_t* H = (bf16_t*)(p.ws + OFF_H);
    int* gcnt = (int*)(p.ws + OFF_CNT);
    int* LDST = (int*)(p.ws + OFF_LDST);
    float* LWt = (float*)(p.ws + OFF_LW);
    LAS float* hs = (LAS float*)lds + wid * 16 * 64;
    LAS int* lcnt = (LAS int*)(lds + 16384);
    LAS int* lbase = (LAS int*)(lds + 16384 + 256);
    LAS int* sel_ep = (LAS int*)(lds + 16384 + 512);
    LAS float* sel_w = (LAS float*)(lds + 16384 + 512 + 2048);
    for (int item = VBLK; item < T / 64; item += NVBLK) {
        const int t0 = item * 64, b = t0 / SEQ, tw0 = t0 + wid * 16;
        __syncthreads();
        if (tid < 64) lcnt[tid] = 0;
        float meanv = 0.f, rstdv = 0.f;
        if (lane < 16) {
            float s1 = 0.f, s2 = 0.f;
            const float* st = stats + (size_t)(tw0 + lane) * 32;
#pragma unroll
            for (int i = 0; i < 16; ++i) { s1 += st[2 * i]; s2 += st[2 * i + 1]; }
            meanv = s1 * (1.f / D);
            const float var = fmaxf(s2 * (1.f / D) - meanv * meanv, 0.f);
            rstdv = 1.0f / sqrtf(var + 1e-5f);
        }
        float acc[16];
#pragma unroll
        for (int r = 0; r < 16; ++r) acc[r] = 0.f;
        for (int kc = 0; kc < 16; ++kc) {
            const int k = kc * 64 + lane;
            const float g = p.ln1_g[k], bb = p.ln1_b[k], sc = mod[(size_t)b * MODW + 4 * D + k], sh = mod[(size_t)b * MODW + 3 * D + k];
            __syncthreads();
#pragma unroll
            for (int r = 0; r < 16; ++r) {
                const size_t off = (size_t)(tw0 + r) * D + k;
                const float y = p.out[off];
                const float mu = __shfl(meanv, r), rs = __shfl(rstdv, r);
                const float xm = (y - mu) * rs * g + bb;
                p.out[off] = xm;
                const float hv = xm * (1.f + sc) + sh;
                H[off] = (bf16_t)f2bf(hv);
                hs[r * 64 + lane] = hv;
            }
            __syncthreads();
            const float* wr_ = p.w_router + (size_t)(kc * 64) * NE + lane;
            for (int k4 = 0; k4 < 16; ++k4) {
                const float w0 = wr_[(k4 * 4 + 0) * NE], w1 = wr_[(k4 * 4 + 1) * NE], w2 = wr_[(k4 * 4 + 2) * NE], w3 = wr_[(k4 * 4 + 3) * NE];
#pragma unroll
                for (int r = 0; r < 16; ++r) {
                    const f32x4 hv = *(const LAS f32x4*)(hs + r * 64 + k4 * 4);
                    acc[r] += hv[0] * w0; acc[r] += hv[1] * w1; acc[r] += hv[2] * w2; acc[r] += hv[3] * w3;
                }
            }
        }
        __syncthreads();
#pragma unroll
        for (int r = 0; r < 16; ++r) hs[r * 64 + lane] = acc[r];
        __syncthreads();
        const float bias = p.router_bias[lane];
        for (int r = 0; r < 16; ++r) {
            const float lg = hs[r * 64 + lane];
            const float s = 1.0f / (1.0f + expf(-lg));
            const float sel = s + bias;
            float m1 = fmaxf(sel, __shfl_xor(sel, 1)); m1 = fmaxf(m1, __shfl_xor(m1, 2)); m1 = fmaxf(m1, __shfl_xor(m1, 4));
            int cand = (sel == m1) ? lane : 64;
            cand = min(cand, __shfl_xor(cand, 1)); cand = min(cand, __shfl_xor(cand, 2)); cand = min(cand, __shfl_xor(cand, 4));
            const float sel2 = (lane == cand) ? -INFINITY : sel;
            float m2 = fmaxf(sel2, __shfl_xor(sel2, 1)); m2 = fmaxf(m2, __shfl_xor(m2, 2)); m2 = fmaxf(m2, __shfl_xor(m2, 4));
            const float gs = m1 + m2;
            const int g = lane >> 3;
            int cntg = 0;
#pragma unroll
            for (int gg = 0; gg < 8; ++gg) { const float v = __shfl(gs, gg * 8); cntg += (v > gs || (v == gs && gg < g)) ? 1 : 0; }
            const bool keep = cntg < 4;
            const float msel = keep ? sel : -INFINITY;
            hs[r * 64 + lane] = msel;
            int cnt = 0;
#pragma unroll 4
            for (int q4 = 0; q4 < 16; ++q4) {
                const f32x4 v = *(const LAS f32x4*)(hs + r * 64 + q4 * 4);
#pragma unroll
                for (int i = 0; i < 4; ++i) cnt += (v[i] > msel || (v[i] == msel && (q4 * 4 + i) < lane)) ? 1 : 0;
            }
            const bool chosen = keep && cnt < 8;
            float wsum = chosen ? s : 0.f;
#pragma unroll
            for (int o = 1; o < 64; o <<= 1) wsum += __shfl_xor(wsum, o);
            if (chosen) {
                const int pos = atomicAdd((int*)&lcnt[lane], 1);
                sel_ep[(wid * 16 + r) * 8 + cnt] = lane | (pos << 8);
                sel_w[(wid * 16 + r) * 8 + cnt] = s / wsum * 2.5f;
            }
        }
        __syncthreads();
        if (tid < 64) { int tt = tid; asm volatile("" : "+v"(tt)); lbase[tt] = atomicAdd(&gcnt[tt], lcnt[tt]); }
        __syncthreads();
        for (int idx = tid; idx < 512; idx += 256) {
            const int ep = sel_ep[idx], e = ep & 0xff, pos = ep >> 8, gi = lbase[e] + pos;
            LDST[(size_t)e * T + gi] = (t0 + (idx >> 3)) * NSLOT + (idx & 7);
            LWt[(size_t)e * T + gi] = sel_w[idx];
        }
    }
}

constexpr int LDS_ROWTAB = 131072, MOE_MAX_UNITS = 12, LDS_UTAB = LDS_CTL + 256, LDS_TSTART = LDS_UTAB + MOE_MAX_UNITS * 32;
__device__ __forceinline__ int moe_setup(const Params& p, LAS unsigned char* lds0, int nN, int bmul, int badd) {
    LAS int* tstart = (LAS int*)(lds0 + LDS_TSTART); LAS int* utab = (LAS int*)(lds0 + LDS_UTAB);
    const int* gcnt = (const int*)(p.ws + OFF_CNT);
    __syncthreads();
    if (threadIdx.x == 0) {
        int a = 0;
        for (int e = 0; e < NEX; ++e) { const int c = e < NE ? gcnt[e] : T; tstart[e] = a; a += (c + 255) >> 8; }
        tstart[NEX] = a;
    }
    __syncthreads();
    const int total = tstart[NEX] * nN, G = gridDim.x, c = blockIdx.x;
    if (threadIdx.x < MOE_MAX_UNITS) {
        const int i = threadIdx.x, L = i * G + c;
        int pm = 0, pn = 0, e = 0, i0 = 0, cnt = 0;
        if (L < total) {
            const int mt = L / nN, pl = L % nN;
            for (int j = 1; j < NEX; ++j) e += (mt >= tstart[j]) ? 1 : 0;
            pm = mt; pn = e * bmul + badd + pl; i0 = (mt - tstart[e]) * 256; cnt = e < NE ? gcnt[e] : T;
        }
        utab[i * 8 + 0] = pm; utab[i * 8 + 1] = pn; utab[i * 8 + 2] = e; utab[i * 8 + 3] = i0; utab[i * 8 + 4] = cnt;
    }
    __syncthreads();
    const int n = (total - c + G - 1) / G;
    return n < 0 ? 0 : (n > MOE_MAX_UNITS ? MOE_MAX_UNITS : n);
}
struct MoeSched {
    LAS const int* utab; LAS const unsigned* rowtab; int n;
    __device__ __forceinline__ bool next(int i, pg8::Unit& u) const {
        if (i >= n) return false;
        u.pm = __builtin_amdgcn_readfirstlane(utab[i * 8 + 0]); u.pn = __builtin_amdgcn_readfirstlane(utab[i * 8 + 1]); u.e = __builtin_amdgcn_readfirstlane(utab[i * 8 + 2]); u.idx = i; return true;
    }
    __device__ __forceinline__ unsigned row_off(int i, int r) const { return rowtab[i * 256 + r]; }
    __device__ __forceinline__ void a_ready(const pg8::Unit&) const {}
    __device__ __forceinline__ void done(const pg8::Unit&) const {}
};
struct EpiGU {
    static constexpr bool PERM = true;
    LAS const int* utab; unsigned char* ws;
    __device__ __forceinline__ void operator()(const f32x4 (&acc)[2][2][4][2], const pg8::Unit& u, int wr, int wc, int fr, int fq) const {
        const int e = u.e, i0 = utab[u.idx * 8 + 3], cnt = utab[u.idx * 8 + 4], pl = u.pn & 1;
        const float* LWt = (const float*)(ws + OFF_LW) + (size_t)(e < NE ? e : 0) * T;
        bf16_t* ACT = (bf16_t*)(ws + OFF_ACT) + (size_t)u.pm * 256 * FF + pl * 128 + wc * 32 + 8 * fq;
#pragma unroll
        for (int ai = 0; ai < 2; ++ai)
#pragma unroll
            for (int m = 0; m < 4; ++m) {
                const int rl = ai * 128 + wr * 64 + m * 16 + fr, li = i0 + rl;
                const float lw = LWt[li];
                const float wrow = li < cnt ? (e < NE ? lw : 1.f) : 0.f;
                float a[8];
#pragma unroll
                for (int n = 0; n < 2; ++n)
#pragma unroll
                    for (int q = 0; q < 4; ++q) { const float g = acc[ai][0][m][n][q], uu = acc[ai][1][m][n][q]; a[n * 4 + q] = g / (1.f + __expf(-g)) * uu * wrow; }
                u32x4 w; w.x = pk2(a[0], a[1]); w.y = pk2(a[2], a[3]); w.z = pk2(a[4], a[5]); w.w = pk2(a[6], a[7]);
                *(u32x4*)(ACT + (size_t)rl * FF) = w;
                asm volatile("" ::: "memory");
            }
    }
};
__device__ __forceinline__ void phase_gateup(const Params& p, LAS unsigned char* lds0) {
    const int n = moe_setup(p, lds0, 2, 2, 0);
    LAS const int* utab = (LAS const int*)(lds0 + LDS_UTAB);
    LAS unsigned* rowtab = (LAS unsigned*)(lds0 + LDS_ROWTAB);
    const int* LDST = (const int*)(p.ws + OFF_LDST);
    for (int i = 0; i < n; ++i) {
        const int e = utab[i * 8 + 2], i0 = utab[i * 8 + 3], cnt = utab[i * 8 + 4];
        if (threadIdx.x < 256) {
            const int li = i0 + threadIdx.x; int tok = 0;
            if (li < cnt) tok = e < NE ? LDST[(size_t)e * T + li] / NSLOT : li;
            rowtab[i * 256 + threadIdx.x] = (unsigned)tok * (unsigned)(D * 2);
        }
    }
    __syncthreads();
    MoeSched S{utab, rowtab, n};
    pg8::Gemm g{(const bf16_t*)(p.ws + OFF_H), (const bf16_t*)(p.ws + OFF_WGU)};
    EpiGU E{utab, p.ws};
    pg8::gemm_phase<D, EpiGU, MoeSched, true>(lds0, g, S, E);
}
struct EpiDown {
    static constexpr bool PERM = true;
    LAS const int* utab; unsigned char* ws;
    __device__ __forceinline__ void operator()(const f32x4 (&acc)[2][2][4][2], const pg8::Unit& u, int wr, int wc, int fr, int fq) const {
        const int e = u.e, i0 = utab[u.idx * 8 + 3], cnt = utab[u.idx * 8 + 4];
        const int* LDST = (const int*)(ws + OFF_LDST) + (size_t)(e < NE ? e : 0) * T;
        bf16_t* SL = (bf16_t*)(ws + OFF_SLOTS) + wc * 32 + 8 * fq;
#pragma unroll
        for (int ai = 0; ai < 2; ++ai)
#pragma unroll
            for (int m = 0; m < 4; ++m) {
                const int li = i0 + ai * 128 + wr * 64 + m * 16 + fr;
                const int ld = LDST[li];
                const int dst = li < cnt ? (e < NE ? ld : li * NSLOT + 8) : T * NSLOT;
#pragma unroll
                for (int bj = 0; bj < 2; ++bj) {
                    u32x4 w; w.x = pk2(acc[ai][bj][m][0][0], acc[ai][bj][m][0][1]); w.y = pk2(acc[ai][bj][m][0][2], acc[ai][bj][m][0][3]);
                    w.z = pk2(acc[ai][bj][m][1][0], acc[ai][bj][m][1][1]); w.w = pk2(acc[ai][bj][m][1][2], acc[ai][bj][m][1][3]);
                    *(u32x4*)(SL + (size_t)dst * 256 + bj * 128) = w;
                }
                asm volatile("" ::: "memory");
            }
    }
};
__device__ __forceinline__ void phase_down(const Params& p, LAS unsigned char* lds0, int c) {
    const int n = moe_setup(p, lds0, 1, 4, c);
    LAS const int* utab = (LAS const int*)(lds0 + LDS_UTAB);
    MoeSched S{utab, (LAS const unsigned*)(lds0 + LDS_ROWTAB), n};
    pg8::Gemm g{(const bf16_t*)(p.ws + OFF_ACT), (const bf16_t*)(p.ws + OFF_WD)};
    EpiDown E{utab, p.ws};
    pg8::gemm_phase<FF, EpiDown, MoeSched, false>(lds0, g, S, E);
}

__device__ __forceinline__ void phase_combine(const Params& p, int c) {
    const int tid = TIDX;
    const bf16_t* SL = (const bf16_t*)(p.ws + OFF_SLOTS);
    bf16_t* FFN = (bf16_t*)(p.ws + OFF_H);
    for (int item = VBLK; item < T / 8; item += NVBLK) {
        const int t = item * 8 + (tid >> 5), cc = (tid & 31) * 8;
        float s[8];
#pragma unroll
        for (int i = 0; i < 8; ++i) s[i] = 0.f;
#pragma unroll
        for (int k = 0; k < NSLOT; ++k) {
            const u32x4 v = *(const u32x4*)(SL + (size_t)(t * NSLOT + k) * 256 + cc);
#pragma unroll
            for (int i = 0; i < 4; ++i) { s[2 * i] += bflo(v[i]); s[2 * i + 1] += bfhi(v[i]); }
        }
        *(u32x4*)(FFN + (size_t)t * D + c * 256 + cc) = (u32x4){pk2(s[0], s[1]), pk2(s[2], s[3]), pk2(s[4], s[5]), pk2(s[6], s[7])};
    }
}

__device__ __forceinline__ void phase_final(const Params& p) {
    const int lane = TIDX & 63, gw = VBLK * 4 + (TIDX >> 6), ngw = NVBLK * 4;
    const float* mod = (const float*)(p.ws + OFF_MOD);
    const bf16_t* FFN = (const bf16_t*)(p.ws + OFF_H);
    for (int row = gw; row < T; row += ngw) {
        const float* g2 = mod + (size_t)(row / SEQ) * MODW + 5 * D;
        f32x4 y[4]; float s = 0.f;
#pragma unroll
        for (int j = 0; j < 4; ++j) {
            const int c = 4 * lane + 256 * j;
            const f32x4 xm = *(const f32x4*)(p.out + (size_t)row * D + c), gg = *(const f32x4*)(g2 + c);
            const u32x2 f = *(const u32x2*)(FFN + (size_t)row * D + c);
            y[j][0] = ALPHA * xm[0] + gg[0] * bflo(f.x); y[j][1] = ALPHA * xm[1] + gg[1] * bfhi(f.x);
            y[j][2] = ALPHA * xm[2] + gg[2] * bflo(f.y); y[j][3] = ALPHA * xm[3] + gg[3] * bfhi(f.y);
            s += (y[j][0] + y[j][1]) + (y[j][2] + y[j][3]);
        }
#pragma unroll
        for (int o = 1; o < 64; o <<= 1) s += __shfl_xor(s, o);
        const float mean = s * (1.f / D);
        float q = 0.f;
#pragma unroll
        for (int j = 0; j < 4; ++j) { y[j] = y[j] - mean; q += (y[j][0] * y[j][0] + y[j][1] * y[j][1]) + (y[j][2] * y[j][2] + y[j][3] * y[j][3]); }
#pragma unroll
        for (int o = 1; o < 64; o <<= 1) q += __shfl_xor(q, o);
        const float rstd = 1.0f / sqrtf(q * (1.f / D) + 1e-5f);
#pragma unroll
        for (int j = 0; j < 4; ++j) {
            const int c = 4 * lane + 256 * j;
            const f32x4 g = *(const f32x4*)(p.ln2_g + c), bb = *(const f32x4*)(p.ln2_b + c);
            *(f32x4*)(p.out + (size_t)row * D + c) = y[j] * rstd * g + bb;
        }
    }
}


#define XB_TMO      128
#define XB_XCNT(j)  (256  + 64 * (j))
#define XB_XSUB(j)  (1280 + 64 * (j))
#define XB_XGEN(j)  (2304 + 64 * (j))
#define XB_TOP      3328
#define XB_TOPGEN   3392
#define XCD_BAR_WORDS 3456
#define XB_SPIN_CAP (1u << 18)
__device__ __forceinline__ unsigned xb_ld(unsigned* p)              { return __hip_atomic_load(p, __ATOMIC_RELAXED, __HIP_MEMORY_SCOPE_AGENT); }
__device__ __forceinline__ unsigned xb_add(unsigned* p, unsigned v) { return __hip_atomic_fetch_add(p, v, __ATOMIC_RELAXED, __HIP_MEMORY_SCOPE_AGENT); }
__device__ __forceinline__ unsigned xb_xcc_id() { return (unsigned)__builtin_amdgcn_s_getreg((3 << 11) | 20) & 0xFu; }
#define XB_SPIN(cond, bar) do { unsigned _sp = 0; while (cond) { __builtin_amdgcn_s_sleep(1); \
    if ((++_sp & 255u) == 0u) { if (xb_ld(&(bar)[XB_TMO])) break; if (_sp > XB_SPIN_CAP) { atomicAdd(&(bar)[XB_TMO], 1u); break; } } } } while (0)
struct XcdBarrier { unsigned* bar; unsigned x; volatile LAS unsigned* st; };
__device__ __forceinline__ XcdBarrier xcd_barrier_post(unsigned* bar, volatile LAS unsigned* st) {
    XcdBarrier b; b.bar = bar; b.x = xb_xcc_id(); b.st = st;
    if (threadIdx.x == 0) (void)xb_add(&bar[XB_XCNT(b.x)], 1u);
    return b;
}
__device__ __forceinline__ void xcd_barrier_complete(unsigned* bar, unsigned x, unsigned& nloc, unsigned& nx) {
    const unsigned G = gridDim.x * gridDim.y * gridDim.z;
    unsigned sum, cnt, mine, sp = 0u;
    for (;;) {
        sum = 0u; cnt = 0u; mine = 0u;
#pragma unroll
        for (unsigned j = 0; j < 16; ++j) { const unsigned c = xb_ld(&bar[XB_XCNT(j)]); sum += c; cnt += (c > 0u) ? 1u : 0u; mine = (j == x) ? c : mine; }
        if (sum == G) break;
        __builtin_amdgcn_s_sleep(1);
        if ((++sp & 255u) == 0u) { if (xb_ld(&bar[XB_TMO])) break; if (sp > XB_SPIN_CAP) { atomicAdd(&bar[XB_TMO], 1u); break; } }
    }
    nloc = mine > 0u ? mine : 1u; nx = cnt > 0u ? cnt : 1u;
}
__device__ __forceinline__ void xcd_barrier(const XcdBarrier& b) {
    asm volatile("s_waitcnt vmcnt(0)" ::: "memory");
    __syncthreads();
    if (threadIdx.x == 0) {
        unsigned* bar = b.bar;
        __builtin_amdgcn_s_waitcnt(0);
        unsigned nloc = b.st[0], nx = b.st[1];
        if (nloc == 0u) { xcd_barrier_complete(bar, b.x, nloc, nx); b.st[0] = nloc; b.st[1] = nx; }
        const unsigned old = xb_add(&bar[XB_XSUB(b.x)], 1u);
        const unsigned gen = old / nloc;
        if (old + 1u == (gen + 1u) * nloc) {
            __builtin_amdgcn_fence(__ATOMIC_RELEASE, "agent");
            asm volatile("s_waitcnt vmcnt(0)" ::: "memory");
            const unsigned og = xb_add(&bar[XB_TOP], 1u);
            const unsigned tg = og / nx;
            if (og + 1u == (tg + 1u) * nx) xb_add(&bar[XB_TOPGEN], 1u);
            else XB_SPIN(xb_ld(&bar[XB_TOPGEN]) == tg, bar);
            __builtin_amdgcn_fence(__ATOMIC_ACQUIRE, "agent");
            xb_add(&bar[XB_XGEN(b.x)], 1u);
            asm volatile("s_waitcnt vmcnt(0)" ::: "memory");
        } else {
            XB_SPIN(xb_ld(&bar[XB_XGEN(b.x)]) == gen, bar);
            __builtin_amdgcn_fence(__ATOMIC_ACQUIRE, "agent");
            asm volatile("s_waitcnt vmcnt(0)" ::: "memory");
        }
    }
    __syncthreads();
}

constexpr size_t OFF_BAR = 448 * 1024;

__global__ void __launch_bounds__(512, 2) mk_fwd(Params p) {
    extern __shared__ __attribute__((aligned(16))) unsigned char smem[];
    LAS unsigned char* lds0 = (LAS unsigned char*)smem;
    if (threadIdx.x < 64) ((LAS unsigned*)(lds0 + LDS_CTL))[threadIdx.x] = 0u;
    __syncthreads();
    XcdBarrier bar; bar.bar = (unsigned*)(p.ws + OFF_BAR); bar.x = 0; bar.st = nullptr;
    bar = xcd_barrier_post((unsigned*)(p.ws + OFF_BAR), (volatile LAS unsigned*)(lds0 + LDS_CTL));
#ifndef PROBE
#define PROBE -1
#endif
#ifndef PROBE_END
#define PROBE_END (PROBE + 1)
#endif
    unsigned long long pt0 = 0, pt1 = 0;
#define RUN_PHASE(k, call) { if ((k) > 0) xcd_barrier(bar); if (PROBE >= 0 && (k) == PROBE) pt0 = __builtin_amdgcn_s_memrealtime(); if (PROBE >= 0 && (k) == PROBE_END) pt1 = __builtin_amdgcn_s_memrealtime(); \
    int on_ = 1; asm volatile("" : "+s"(on_)); if (on_) { int grp_ = threadIdx.x >> 8; asm volatile("" : "+v"(grp_)); LAS unsigned char* lds = lds0 + grp_ * 32768; (void)lds; call; } }
    RUN_PHASE(0, phase_prep(p, lds))
    RUN_PHASE(1, phase_xn(p))
    RUN_PHASE(2, phase_inproj(p, lds0))
    RUN_PHASE(3, phase_attn_pool(p, lds, (char*)smem))
    RUN_PHASE(4, phase_outproj(p, lds0))
    RUN_PHASE(5, phase_router(p, lds))
    RUN_PHASE(6, phase_gateup(p, lds0))
    RUN_PHASE(7, phase_down(p, lds0, 0))
    RUN_PHASE(8, phase_combine(p, 0))
    RUN_PHASE(9, phase_down(p, lds0, 1))
    RUN_PHASE(10, phase_combine(p, 1))
    RUN_PHASE(11, phase_down(p, lds0, 2))
    RUN_PHASE(12, phase_combine(p, 2))
    RUN_PHASE(13, phase_down(p, lds0, 3))
    RUN_PHASE(14, phase_combine(p, 3))
    RUN_PHASE(15, phase_final(p))
    if (PROBE >= 0) {
        if (PROBE_END == 16) pt1 = __builtin_amdgcn_s_memrealtime();
        if (blockIdx.x == 0 && threadIdx.x == 0) { const unsigned long long tend = __builtin_amdgcn_s_memrealtime() + 8ull * (pt1 - pt0); while (__builtin_amdgcn_s_memrealtime() < tend) __builtin_amdgcn_s_sleep(8); }
    }
}

extern "C" void kernel_launch(void* const* d_in, const int* in_sizes, int n_in, void* d_out, int out_size, void* d_ws, size_t ws_size, hipStream_t stream) {
    static int grid = 0;
    if (grid == 0) {
        int dev = 0, cus = 0, per_cu = 0;
        (void)hipGetDevice(&dev);
        (void)hipDeviceGetAttribute(&cus, hipDeviceAttributeMultiprocessorCount, dev);
        (void)hipFuncSetAttribute((const void*)mk_fwd, hipFuncAttributeMaxDynamicSharedMemorySize, LDS_BYTES);
        (void)hipOccupancyMaxActiveBlocksPerMultiprocessor(&per_cu, (const void*)mk_fwd, 512, LDS_BYTES);
        if (per_cu < 1) fprintf(stderr, "kernel_launch: occupancy query says %d blocks per CU\n", per_cu);
        (void)hipGetLastError();
        grid = cus;
        if (ws_size < WS_NEED) fprintf(stderr, "kernel_launch: workspace too small: %zu < %zu\n", ws_size, (size_t)WS_NEED);
    }
    Params p{};
    const float** pp = (const float**)&p;
    for (int i = 0; i < 24; ++i) pp[i] = (const float*)d_in[i];
    p.out = (float*)d_out; p.ws = (unsigned char*)d_ws;
    (void)hipMemsetAsync((char*)d_ws + OFF_BAR, 0, XCD_BAR_WORDS * 4, stream);
    hipLaunchKernelGGL(mk_fwd, dim3(grid), dim3(512), LDS_BYTES, stream, p);
}
```

```cpp
#include <hip/hip_runtime.h>
#include <stdint.h>
#include <stdio.h>


#define LAS __attribute__((address_space(3)))
#define TIDX ((int)(threadIdx.x & 255))
#define VBLK ((int)(blockIdx.x * 2 + (threadIdx.x >> 8)))
#define NVBLK ((int)(gridDim.x * 2))
typedef unsigned short bf16_t;
typedef short bf16x8 __attribute__((ext_vector_type(8)));
typedef float f32x4 __attribute__((ext_vector_type(4)));
typedef unsigned u32x4 __attribute__((ext_vector_type(4)));
typedef unsigned u32x2 __attribute__((ext_vector_type(2)));

constexpr int D = 1024, NB = 16, SEQ = 2048, T = NB * SEQ, CTXL = 256, TC = NB * CTXL, KVL = CTXL + SEQ;
constexpr int PW = 1536, NE = 64, NEX = 65, FF = 256, NSLOT = 9, MODW = 6 * D;
constexpr float ALPHA = 1.189207115002721f;
constexpr float C2 = 0.125f * 1.4426950408889634f;
constexpr int NPHASE = 16;
constexpr int LDS_BYTES = 147456, LDS_CTL = 143360;

constexpr size_t MiB = 1u << 20;
constexpr size_t OFF_CNT = 0, OFF_MOD = 4096, OFF_ROPE = 512 * 1024;
constexpr size_t OFF_WRH = 483 * MiB, OFF_WRL = OFF_WRH + 128 * 1024;
constexpr size_t OFF_WTIN = 1 * MiB, OFF_WTOUT = 4 * MiB, OFF_WGU = 6 * MiB, OFF_WD = 71 * MiB;
constexpr size_t OFF_H = 104 * MiB, OFF_LDST = 168 * MiB, OFF_LW = 176 * MiB, OFF_ACT = 184 * MiB, OFF_SLOTS = 338 * MiB;
constexpr size_t OFF_XN = 184 * MiB, OFF_Q = 256 * MiB, OFF_K = 304 * MiB, OFF_V = 322 * MiB, OFF_U = 340 * MiB, OFF_AO = 356 * MiB, OFF_STATS = 420 * MiB;
constexpr size_t WS_NEED = 484 * MiB;

struct Params {
    const float *x, *c, *ctx, *c_ctx, *w_mod, *b_mod, *w_in, *q_norm, *k_norm, *pool_w, *pool_scale, *w_out, *ln1_g, *ln1_b,
        *w_router, *router_bias, *w_gate, *w_up, *w_down, *ws_gate, *ws_up, *ws_down, *ln2_g, *ln2_b;
    float* out;
    unsigned char* ws;
};

__device__ __forceinline__ unsigned f2bf(float f) { unsigned u = __float_as_uint(f); return (u + 0x7fffu + ((u >> 16) & 1u)) >> 16; }
__device__ __forceinline__ unsigned pk2(float lo, float hi) { return f2bf(lo) | (f2bf(hi) << 16); }
__device__ __forceinline__ float bf2f(unsigned h) { return __uint_as_float(h << 16); }
__device__ __forceinline__ float bflo(unsigned w) { return __uint_as_float(w << 16); }
__device__ __forceinline__ float bfhi(unsigned w) { return __uint_as_float(w & 0xffff0000u); }

namespace pg8 {
constexpr int BM = 256, BK = 64, HALF = 128, HTB = HALF * BK * 2, STAGE_BYTES = 8 * HTB;
__host__ __device__ __forceinline__ int lds_byte(int r, int c) { const int st = (r >> 4) * 2 + (c >> 5), rr = r & 15, cc = c & 31, ob = rr * 64 + cc * 2; return st * 1024 + (ob ^ (((ob >> 9) & 1) << 5)); }
__host__ __device__ __forceinline__ void stage_rc(int b, int& R, int& C) { const int st = b / 1024, sb = b % 1024, swz = sb ^ (((sb >> 9) & 1) << 5); R = (st >> 1) * 16 + swz / 64; C = (st & 1) * 32 + (swz % 64) / 2; }
__host__ __device__ __forceinline__ int perm32(int rho) { const int n = rho >> 4, i = rho & 15; return 8 * (i >> 2) + 4 * n + (i & 3); }
struct Unit { int pm, pn, idx, e; };
struct Gemm { const bf16_t* A; const bf16_t* Bt; };
__device__ __forceinline__ unsigned cvt_pk_bf16(float lo, float hi) { unsigned r; asm volatile("v_cvt_pk_bf16_f32 %0, %1, %2" : "=v"(r) : "v"(lo), "v"(hi)); return r; }

template <int K, class Epi, class Sched, bool GATHER, bool ALIGN_EPI = true>
__device__ __forceinline__ void gemm_phase(LAS unsigned char* lds, const Gemm g, const Sched& S, const Epi& E) {
    const int tid = threadIdx.x, wid = __builtin_amdgcn_readfirstlane(tid >> 6), lane = tid & 63, wr = wid >> 2, wc = wid & 3, fr = lane & 15, fq = lane >> 4;
    constexpr int nt = K / BK;
    unsigned voffA[2], voffB[2], colA = 0; int rowA = 0;
#pragma unroll
    for (int i = 0; i < 2; ++i) { int R, C; stage_rc(tid * 16 + i * 8192, R, C); const int Rb = Epi::PERM ? ((R & ~31) + perm32(R & 31)) : R;
        voffA[i] = (unsigned)(R * K + C) * 2u; voffB[i] = (unsigned)(Rb * K + C) * 2u; if (i == 0) { colA = (unsigned)C * 2u; rowA = R; } }
    const size_t kstep = (size_t)(BK * 2);
    const size_t hstep = (size_t)HALF * K * 2;
    const size_t tstep = 2 * hstep;
    const unsigned ldsw = (unsigned)wid * 1024u;
    const int aoff = lds_byte(wr * 64 + fr, fq * 8), boff = lds_byte(wc * 32 + fr, fq * 8);
#define PG8_SA(b, h) (((b) * 2 + (h)) * HTB)
#define PG8_SB(b, h) ((4 + (b) * 2 + (h)) * HTB)
#define PG8_STAGE(bufoff, gbase, voff) do { _Pragma("unroll") for (int _i = 0; _i < 2; ++_i) \
        __builtin_amdgcn_global_load_lds((const unsigned*)((const char*)(gbase) + (voff)[_i]), (LAS unsigned*)(lds + (bufoff) + ldsw + _i * 8192), 16, 0, 0); } while (0)
#define PG8_STAGE_A(bufoff, ptr, h, NX) do { if constexpr (GATHER) { unsigned _v[2]; \
            if (NX) { _v[0] = S.row_off(nidx, (h) * HALF + rowA) + colA; _v[1] = S.row_off(nidx, (h) * HALF + rowA + 64) + colA; } else { _v[0] = vA[h][0]; _v[1] = vA[h][1]; } PG8_STAGE(bufoff, ptr, _v); } \
        else { PG8_STAGE(bufoff, (ptr) + (h) * hstep, voffA); } } while (0)
#define PG8_LDA(dst, b, h) do { _Pragma("unroll") for (int m = 0; m < 4; ++m) _Pragma("unroll") for (int k = 0; k < 2; ++k) dst[m][k] = *(const LAS bf16x8*)(lds + PG8_SA(b, h) + aoff + m * 2048 + k * 1024); } while (0)
#define PG8_LDB(dst, b, h) do { _Pragma("unroll") for (int n = 0; n < 2; ++n) _Pragma("unroll") for (int k = 0; k < 2; ++k) dst[n][k] = *(const LAS bf16x8*)(lds + PG8_SB(b, h) + boff + n * 2048 + k * 1024); } while (0)
#define PG8_MMA(ai, bj, At, Bt) do { __builtin_amdgcn_s_setprio(1); _Pragma("unroll") for (int m = 0; m < 4; ++m) _Pragma("unroll") for (int n = 0; n < 2; ++n) _Pragma("unroll") for (int k = 0; k < 2; ++k) \
        acc[ai][bj][m][n] = __builtin_amdgcn_mfma_f32_16x16x32_bf16(Bt[n][k], At[m][k], acc[ai][bj][m][n], 0, 0, 0); __builtin_amdgcn_s_setprio(0); } while (0)
#define PG8_WAIT_V(n) asm volatile("s_waitcnt vmcnt(" #n ")" ::: "memory")
#define PG8_WAIT_L(n) asm volatile("s_waitcnt lgkmcnt(" #n ")" ::: "memory")
#define PG8_BAR __builtin_amdgcn_s_barrier()
#define PG8_SCHED __builtin_amdgcn_sched_barrier(0)
    Unit cur, nxt; int ui = 0;
    if (!S.next(0, cur)) return;
    f32x4 acc[2][2][4][2];
#pragma unroll
    for (int a = 0; a < 2; ++a)
#pragma unroll
        for (int b = 0; b < 2; ++b)
#pragma unroll
            for (int m = 0; m < 4; ++m)
#pragma unroll
                for (int n = 0; n < 2; ++n) acc[a][b][m][n] = (f32x4){0.f, 0.f, 0.f, 0.f};
    bf16x8 At[4][2], B0[2][2], B1[2][2];
    unsigned vA[2][2]; int nidx = 0;
    if constexpr (GATHER) {
#pragma unroll
        for (int h = 0; h < 2; ++h)
#pragma unroll
            for (int i = 0; i < 2; ++i) vA[h][i] = S.row_off(cur.idx, h * HALF + rowA + 64 * i) + colA;
    }
    const char* cA = GATHER ? (const char*)g.A : (const char*)g.A + (size_t)cur.pm * tstep; const char* cB = (const char*)g.Bt + (size_t)cur.pn * tstep;
    S.a_ready(cur);
    PG8_STAGE(PG8_SB(0, 0), cB, voffB); PG8_STAGE(PG8_SB(0, 1), cB + hstep, voffB); PG8_STAGE_A(PG8_SA(0, 0), cA, 0, false); PG8_STAGE_A(PG8_SA(0, 1), cA, 1, false);
    if (wr == 1) PG8_BAR;
    PG8_WAIT_V(2); PG8_BAR;
    PG8_STAGE(PG8_SB(1, 0), cB + kstep, voffB); PG8_STAGE_A(PG8_SA(1, 0), cA + kstep, 0, false); PG8_STAGE(PG8_SB(1, 1), cB + hstep + kstep, voffB);
    PG8_WAIT_V(6); PG8_BAR;
    for (;;) {
        const bool has_next = S.next(ui + 1, nxt);
        if constexpr (GATHER) nidx = has_next ? nxt.idx : cur.idx;
        const char* nA = GATHER ? (const char*)g.A : (has_next ? (const char*)g.A + (size_t)nxt.pm * tstep : cA); const char* nB = has_next ? (const char*)g.Bt + (size_t)nxt.pn * tstep : cB;
        for (int t = 0; t < nt; t += 2) {
            const bool last = (t == nt - 2);
            const char* a1 = cA + (size_t)(t + 1) * kstep;
            const char* a2 = last ? nA : cA + (size_t)(t + 2) * kstep; const char* b2 = last ? nB : cB + (size_t)(t + 2) * kstep;
            const char* a3 = a2 + kstep; const char* b3 = b2 + kstep;
            if (last && has_next) S.a_ready(nxt);
            PG8_LDB(B0, 0, 0); PG8_LDB(B1, 0, 1); PG8_SCHED; PG8_LDA(At, 0, 0); PG8_STAGE_A(PG8_SA(1, 1), a1, 1, false);
            PG8_WAIT_V(8); PG8_WAIT_L(0); PG8_BAR; PG8_MMA(0, 0, At, B0); PG8_MMA(0, 1, At, B1); PG8_BAR; PG8_SCHED;
            PG8_LDA(At, 0, 1); PG8_STAGE(PG8_SB(0, 0), b2, voffB); PG8_STAGE(PG8_SB(0, 1), b2 + hstep, voffB); PG8_STAGE_A(PG8_SA(0, 0), a2, 0, last);
            PG8_WAIT_V(8); PG8_WAIT_L(0); PG8_BAR; PG8_MMA(1, 0, At, B0); PG8_MMA(1, 1, At, B1); PG8_BAR; PG8_SCHED;
            PG8_LDB(B0, 1, 0); PG8_LDB(B1, 1, 1); PG8_SCHED; PG8_LDA(At, 1, 0); PG8_STAGE_A(PG8_SA(0, 1), a2, 1, last);
            PG8_WAIT_V(8); PG8_WAIT_L(0); PG8_BAR; PG8_MMA(0, 0, At, B0); PG8_MMA(0, 1, At, B1); PG8_BAR; PG8_SCHED;
            PG8_LDA(At, 1, 1); PG8_STAGE(PG8_SB(1, 0), b3, voffB); PG8_STAGE(PG8_SB(1, 1), b3 + hstep, voffB); PG8_STAGE_A(PG8_SA(1, 0), a3, 0, last);
            PG8_WAIT_V(8); PG8_WAIT_L(0); PG8_BAR; PG8_MMA(1, 0, At, B0); PG8_MMA(1, 1, At, B1); PG8_BAR; PG8_SCHED;
        }
        if constexpr (ALIGN_EPI) { if (wr == 0) PG8_BAR; }
        E(acc, cur, wr, wc, fr, fq); S.done(cur);
        if (!has_next) break;
#pragma unroll
        for (int a = 0; a < 2; ++a)
#pragma unroll
            for (int b = 0; b < 2; ++b)
#pragma unroll
                for (int m = 0; m < 4; ++m)
#pragma unroll
                    for (int n = 0; n < 2; ++n) acc[a][b][m][n] = (f32x4){0.f, 0.f, 0.f, 0.f};
        cur = nxt; cA = nA; cB = nB; ++ui;
        if constexpr (GATHER) {
#pragma unroll
            for (int h = 0; h < 2; ++h)
#pragma unroll
                for (int i = 0; i < 2; ++i) vA[h][i] = S.row_off(cur.idx, h * HALF + rowA + 64 * i) + colA;
        }
        if constexpr (ALIGN_EPI) { if (wr == 1) PG8_BAR; }
    }
    PG8_WAIT_V(0);
    if constexpr (!ALIGN_EPI) { if (wr == 0) PG8_BAR; }
    PG8_BAR;
#undef PG8_SA
#undef PG8_SB
#undef PG8_STAGE
#undef PG8_STAGE_A
#undef PG8_LDA
#undef PG8_LDB
#undef PG8_MMA
#undef PG8_WAIT_V
#undef PG8_WAIT_L
#undef PG8_BAR
#undef PG8_SCHED
}

struct DenseSched {
    int nN, n1, total, pn2lo, nN2, G, c;
    __device__ __forceinline__ bool next(int i, Unit& u) const {
        const int L = i * G + c; if (L >= total) return false;
        if (L < n1) { u.pm = L / nN; u.pn = L % nN; } else { const int r = L - n1; u.pm = n1 / nN + r / nN2; u.pn = pn2lo + r % nN2; }
        u.idx = i; u.e = 0; return true;
    }
    __device__ __forceinline__ void a_ready(const Unit&) const {}
    __device__ __forceinline__ void done(const Unit&) const {}
};
}

__device__ __forceinline__ int win_row(int n) { return (n & ~255) + 128 * ((n >> 5) & 1) + 32 * ((n >> 6) & 3) + (n & 31); }
__device__ __forceinline__ int gu_row(int j, int half) { return (j >> 7) * 256 + half * 128 + (j & 127); }

template <class RowMap>
__device__ __forceinline__ void transpose_tile(LAS float* tile, const float* src, int ld, int k0, int n0, bf16_t* dst, int Kdst, RowMap rowmap) {
    const int tid = TIDX;
#pragma unroll
    for (int pss = 0; pss < 4; ++pss) {
        const int k = pss * 16 + (tid >> 4), n4 = (tid & 15) * 4;
        const f32x4 v = *(const f32x4*)(src + (size_t)(k0 + k) * ld + n0 + n4);
        tile[k * 65 + n4 + 0] = v[0]; tile[k * 65 + n4 + 1] = v[1]; tile[k * 65 + n4 + 2] = v[2]; tile[k * 65 + n4 + 3] = v[3];
    }
    __syncthreads();
    {
        const int n = tid >> 2, kc = (tid & 3) * 16;
        unsigned w[8];
#pragma unroll
        for (int i = 0; i < 8; ++i) w[i] = pk2(tile[(kc + 2 * i) * 65 + n], tile[(kc + 2 * i + 1) * 65 + n]);
        bf16_t* dp = dst + (size_t)rowmap(n0 + n) * Kdst + k0 + kc;
        *(u32x4*)dp = (u32x4){w[0], w[1], w[2], w[3]};
        *(u32x4*)(dp + 8) = (u32x4){w[4], w[5], w[6], w[7]};
    }
    __syncthreads();
}

__device__ __forceinline__ void phase_prep(const Params& p, LAS unsigned char* lds) {
    const int tid = TIDX;
    int* gcnt = (int*)(p.ws + OFF_CNT);
    if (VBLK == 0 && tid < 128) gcnt[tid] = 0;
    float* mod = (float*)(p.ws + OFF_MOD);
    float* rope = (float*)(p.ws + OFF_ROPE);
    constexpr int N_MOD = 192, N_ROPE = 256, N_TR = 384 + 256 + NEX * 192 + 16;
    for (int it = VBLK; it < N_MOD + N_ROPE + N_TR; it += NVBLK) {
        if (it < N_MOD) {
            LAS float* sl = (LAS float*)lds;
            LAS float* red = (LAS float*)(lds + 10240);
            const int col = it * 32 + (tid & 31), kk = tid >> 5;
            float acc[17];
#pragma unroll
            for (int r = 0; r < 17; ++r) acc[r] = 0.f;
            for (int kc = 0; kc < 8; ++kc) {
                __syncthreads();
                for (int o = tid; o < 17 * 128; o += 256) {
                    const int r = o >> 7, kl = o & 127;
                    const float cv = (r < 16) ? p.c[r * D + kc * 128 + kl] : p.c_ctx[kc * 128 + kl];
                    sl[kl * 20 + r] = cv / (1.f + expf(-cv));
                }
                __syncthreads();
#pragma unroll 4
                for (int i = 0; i < 16; ++i) {
                    const int kl = kk + 8 * i;
                    const float wv = p.w_mod[(size_t)(kc * 128 + kl) * MODW + col];
                    const f32x4 s0 = *(const LAS f32x4*)(sl + kl * 20), s1 = *(const LAS f32x4*)(sl + kl * 20 + 4), s2 = *(const LAS f32x4*)(sl + kl * 20 + 8), s3 = *(const LAS f32x4*)(sl + kl * 20 + 12);
                    const float s4 = sl[kl * 20 + 16];
#pragma unroll
                    for (int q = 0; q < 4; ++q) { acc[q] += s0[q] * wv; acc[4 + q] += s1[q] * wv; acc[8 + q] += s2[q] * wv; acc[12 + q] += s3[q] * wv; }
                    acc[16] += s4 * wv;
                }
            }
#pragma unroll
            for (int r = 0; r < 17; ++r) red[(kk * 17 + r) * 32 + (tid & 31)] = acc[r];
            __syncthreads();
            for (int o = tid; o < 17 * 32; o += 256) {
                const int r = o >> 5, j = o & 31;
                float sm = p.b_mod[it * 32 + j];
#pragma unroll
                for (int g = 0; g < 8; ++g) sm += red[(g * 17 + r) * 32 + j];
                mod[r * MODW + it * 32 + j] = sm;
            }
            __syncthreads();
        } else if (it < N_MOD + N_ROPE) {
            const int idx = (it - N_MOD) * 256 + tid, t = idx >> 5, i = idx & 31;
            const int pos = (i < 16) ? (t >> 6) : (t & 63);
            const float invf = (float)exp(-(double)(i & 15) / 16.0 * 9.210340371976184);
            const double ang = (double)((float)pos * invf);
            rope[idx * 2 + 0] = (float)cos(ang);
            rope[idx * 2 + 1] = (float)sin(ang);
        } else {
            LAS float* tile = (LAS float*)lds;
            int idx = it - N_MOD - N_ROPE;
            if (idx < 384) {
                transpose_tile(tile, p.w_in, PW, (idx / 24) * 64, (idx % 24) * 64, (bf16_t*)(p.ws + OFF_WTIN), D, [](int n) { return win_row(n); });
            } else if (idx < 640) {
                idx -= 384;
                transpose_tile(tile, p.w_out, D, (idx / 16) * 64, (idx % 16) * 64, (bf16_t*)(p.ws + OFF_WTOUT), D, [](int n) { return n; });
            } else if (idx >= 640 + NEX * 192) {
                const int k0 = (idx - 640 - NEX * 192) * 64;
#pragma unroll
                for (int pss = 0; pss < 4; ++pss) {
                    const int k = pss * 16 + (tid >> 4), n4 = (tid & 15) * 4;
                    const f32x4 v = *(const f32x4*)(p.w_router + (size_t)(k0 + k) * NE + n4);
                    tile[k * 65 + n4 + 0] = v[0]; tile[k * 65 + n4 + 1] = v[1]; tile[k * 65 + n4 + 2] = v[2]; tile[k * 65 + n4 + 3] = v[3];
                }
                __syncthreads();
                {
                    const int n = tid >> 2, kc = (tid & 3) * 16;
                    unsigned wh[8], wl[8];
#pragma unroll
                    for (int i = 0; i < 8; ++i) {
                        const float a = tile[(kc + 2 * i) * 65 + n], b = tile[(kc + 2 * i + 1) * 65 + n];
                        const unsigned ha = f2bf(a), hb = f2bf(b);
                        wh[i] = ha | (hb << 16);
                        wl[i] = pk2(a - bf2f(ha), b - bf2f(hb));
                    }
                    bf16_t* dh = (bf16_t*)(p.ws + OFF_WRH) + (size_t)n * D + k0 + kc;
                    bf16_t* dl = (bf16_t*)(p.ws + OFF_WRL) + (size_t)n * D + k0 + kc;
                    *(u32x4*)dh = (u32x4){wh[0], wh[1], wh[2], wh[3]}; *(u32x4*)(dh + 8) = (u32x4){wh[4], wh[5], wh[6], wh[7]};
                    *(u32x4*)dl = (u32x4){wl[0], wl[1], wl[2], wl[3]}; *(u32x4*)(dl + 8) = (u32x4){wl[4], wl[5], wl[6], wl[7]};
                }
                __syncthreads();
            } else {
                idx -= 640;
                const int e = idx / 192, r = idx % 192;
                if (r < 128) {
                    const int half = r >> 6, rr = r & 63;
                    const float* src = half ? (e < NE ? p.w_up + (size_t)e * D * FF : p.ws_up) : (e < NE ? p.w_gate + (size_t)e * D * FF : p.ws_gate);
                    transpose_tile(tile, src, FF, (rr / 4) * 64, (rr % 4) * 64, (bf16_t*)(p.ws + OFF_WGU) + (size_t)e * 512 * D, D, [half](int n) { return gu_row(n, half); });
                } else {
                    const int rr = r - 128;
                    const float* src = e < NE ? p.w_down + (size_t)e * FF * D : p.ws_down;
                    transpose_tile(tile, src, D, (rr / 16) * 64, (rr % 16) * 64, (bf16_t*)(p.ws + OFF_WD) + (size_t)e * D * FF, FF, [](int n) { return n; });
                }
            }
        }
    }
}

__device__ __forceinline__ void phase_xn(const Params& p) {
    const int lane = TIDX & 63, gw = VBLK * 4 + (TIDX >> 6), ngw = NVBLK * 4;
    const float* mod = (const float*)(p.ws + OFF_MOD);
    bf16_t* XN = (bf16_t*)(p.ws + OFF_XN);
    for (int row = gw; row < T + TC; row += ngw) {
        const float* src = row < T ? p.x + (size_t)row * D : p.ctx + (size_t)(row - T) * D;
        const float* mr = mod + (size_t)(row < T ? row / SEQ : 16) * MODW;
#pragma unroll
        for (int j = 0; j < 4; ++j) {
            const int c = 4 * lane + 256 * j;
            const f32x4 v = *(const f32x4*)(src + c), sh = *(const f32x4*)(mr + c), sc = *(const f32x4*)(mr + D + c);
            u32x2 o; o.x = pk2(v[0] * (1.f + sc[0]) + sh[0], v[1] * (1.f + sc[1]) + sh[1]); o.y = pk2(v[2] * (1.f + sc[2]) + sh[2], v[3] * (1.f + sc[3]) + sh[3]);
            *(u32x2*)(XN + (size_t)row * D + c) = o;
        }
    }
}

struct EpiIn {
    static constexpr bool PERM = true;
    const float *q_norm, *k_norm, *rope; bf16_t *Qb, *Kb, *Vb, *Ub;
    __device__ __forceinline__ void operator()(const f32x4 (&acc)[2][2][4][2], const pg8::Unit& u, int wr, int wc, int fr, int fq) const {
        const int grp = u.pn * 4 + wc;
        const bool is_ctx = u.pm >= T / 256;
        f32x4 gn[2][2];
        if (grp >= 4 && grp < 20) {
            const float* g = grp < 16 ? q_norm : k_norm;
#pragma unroll
            for (int bj = 0; bj < 2; ++bj)
#pragma unroll
                for (int n = 0; n < 2; ++n) gn[bj][n] = *(const f32x4*)(g + 32 * bj + 8 * fq + 4 * n);
        }
#pragma unroll
        for (int ai = 0; ai < 2; ++ai)
#pragma unroll
            for (int m = 0; m < 4; ++m) {
                const int row = u.pm * 256 + ai * 128 + wr * 64 + m * 16 + fr;
                f32x4 v[2][2];
#pragma unroll
                for (int bj = 0; bj < 2; ++bj)
#pragma unroll
                    for (int n = 0; n < 2; ++n) v[bj][n] = acc[ai][bj][m][n];
                bf16_t* dst;
                if (grp < 4) dst = Ub + (size_t)row * 256 + grp * 64;
                else if (grp < 16) dst = Qb + (size_t)row * 768 + (grp - 4) * 64;
                else {
                    const size_t krow = is_ctx ? (size_t)((row - T) >> 8) * KVL + ((row - T) & 255) : (size_t)(row >> 11) * KVL + CTXL + (row & (SEQ - 1));
                    dst = (grp < 20 ? Kb + (grp - 16) * 64 : Vb + (grp - 20) * 64) + krow * 256;
                }
                if (grp >= 4 && grp < 20) {
                    float ss = 0.f;
#pragma unroll
                    for (int bj = 0; bj < 2; ++bj)
#pragma unroll
                        for (int n = 0; n < 2; ++n) ss += (v[bj][n][0] * v[bj][n][0] + v[bj][n][1] * v[bj][n][1]) + (v[bj][n][2] * v[bj][n][2] + v[bj][n][3] * v[bj][n][3]);
                    ss += __shfl_xor(ss, 16); ss += __shfl_xor(ss, 32);
                    const float rs = 1.0f / sqrtf(ss * (1.f / 64.f) + 1e-6f);
#pragma unroll
                    for (int bj = 0; bj < 2; ++bj)
#pragma unroll
                        for (int n = 0; n < 2; ++n) v[bj][n] = v[bj][n] * rs * gn[bj][n];
                    if (!is_ctx) {
                        const int tpos = row & (SEQ - 1);
#pragma unroll
                        for (int bj = 0; bj < 2; ++bj)
#pragma unroll
                            for (int n = 0; n < 2; ++n) {
                                const f32x4 cs = *(const f32x4*)(rope + (size_t)(tpos * 32 + 16 * bj + 4 * fq + 2 * n) * 2);
                                const f32x4 x = v[bj][n];
                                v[bj][n] = (f32x4){x[0] * cs[0] - x[1] * cs[1], x[0] * cs[1] + x[1] * cs[0], x[2] * cs[2] - x[3] * cs[3], x[2] * cs[3] + x[3] * cs[2]};
                            }
                    }
                    if (grp < 16) {
#pragma unroll
                        for (int bj = 0; bj < 2; ++bj)
#pragma unroll
                            for (int n = 0; n < 2; ++n) v[bj][n] = v[bj][n] * C2;
                    }
                }
#pragma unroll
                for (int bj = 0; bj < 2; ++bj) {
                    u32x4 w; w.x = pk2(v[bj][0][0], v[bj][0][1]); w.y = pk2(v[bj][0][2], v[bj][0][3]); w.z = pk2(v[bj][1][0], v[bj][1][1]); w.w = pk2(v[bj][1][2], v[bj][1][3]);
                    *(u32x4*)(dst + 32 * bj + 8 * fq) = w;
                }
            }
    }
};
__device__ __forceinline__ int vcu_of_block() { const int G = gridDim.x, bx = blockIdx.x; return (G % 8 == 0) ? (bx % 8) * (G / 8) + bx / 8 : bx; }
__device__ __forceinline__ void phase_inproj(const Params& p, LAS unsigned char* lds) {
    pg8::Gemm g{(const bf16_t*)(p.ws + OFF_XN), (const bf16_t*)(p.ws + OFF_WTIN)};
    pg8::DenseSched S{6, 768, 800, 4, 2, (int)gridDim.x, vcu_of_block()};
    EpiIn E{p.q_norm, p.k_norm, (const float*)(p.ws + OFF_ROPE), (bf16_t*)(p.ws + OFF_Q), (bf16_t*)(p.ws + OFF_K), (bf16_t*)(p.ws + OFF_V), (bf16_t*)(p.ws + OFF_U)};
    pg8::gemm_phase<D, EpiIn, pg8::DenseSched, false>(lds, g, S, E);
}

namespace attn_body {
using bf16=unsigned short;
using bf16x8=__attribute__((ext_vector_type(8)))short;
using s16x4=__attribute__((ext_vector_type(4)))short;
using f32x16=__attribute__((ext_vector_type(16)))float;
using u32x4=__attribute__((ext_vector_type(4)))unsigned;
constexpr int D=64,QP=768,KP=256,OP=1024,SEQ=2048,KVLEN=2304;
constexpr int NW=8,QBLK=32,QB=QBLK*NW,KVBLK=64,NT=KVLEN/KVBLK;
__device__ __forceinline__ int crow(int r,int hi){return (r&3)+8*(r>>2)+4*hi;}
#define SBAR() __builtin_amdgcn_sched_barrier(0)
constexpr int NSLOT=3, SLOTB=8192;
constexpr int LDS_K=0, LDS_V=NSLOT*SLOTB, LDS_WS=2*NSLOT*SLOTB, LDS_OST=LDS_WS+NW*64*4, LDS_BYTES=LDS_OST+NW*4096;
constexpr float C2=0.125f*1.4426950408889634f;
__device__ __forceinline__ void glds16(const void*gsrc,unsigned lds_dst){unsigned keep;
  asm volatile("s_mov_b32 %0, m0\n\ts_mov_b32 m0, %2\n\ts_nop 0\n\tglobal_load_lds_dwordx4 %1, off\n\ts_mov_b32 m0, %0":"=&s"(keep):"v"(gsrc),"s"(lds_dst):"memory");}
__device__ __forceinline__ float max3f(float a,float b,float c){float r;asm("v_max3_f32 %0, %1, %2, %3":"=v"(r):"v"(a),"v"(b),"v"(c));return r;}
__device__ __forceinline__ float max2f(float a,float b){float r;asm("v_max_f32_e32 %0, %1, %2":"=v"(r):"v"(a),"v"(b));return r;}
__device__ __forceinline__ float fadd_s(float a,float b){float r;asm("v_add_f32_e32 %0, %1, %2":"=v"(r):"v"(a),"v"(b));return r;}
__device__ __forceinline__ float fsub_s(float a,float b){float r;asm("v_sub_f32_e32 %0, %1, %2":"=v"(r):"v"(a),"v"(b));return r;}
typedef float f32x2_t __attribute__((ext_vector_type(2))); typedef __bf16 bf16x2_t __attribute__((ext_vector_type(2)));
__device__ __forceinline__ unsigned cvtpk_s(float lo,float hi){f32x2_t v={lo,hi};bf16x2_t b=__builtin_convertvector(v,bf16x2_t);return __builtin_bit_cast(unsigned,b);}
#define WAIT_BAR(N) asm volatile("s_waitcnt vmcnt(" #N ") lgkmcnt(0)\n\ts_barrier":::"memory")

__device__ __forceinline__ void qkt(f32x16&p0,f32x16&p1,const char*Kslot,const bf16x8*qr,const f32x16&negm,int r32,int hi){
  const char*kb=Kslot+hi*1024+r32*16;
  #pragma unroll
  for(int d0=0;d0<4;++d0){
    const bf16x8 b0=*reinterpret_cast<const bf16x8*>(kb+d0*2048);
    const bf16x8 b1=*reinterpret_cast<const bf16x8*>(kb+d0*2048+512);
    if(d0==0){p0=__builtin_amdgcn_mfma_f32_32x32x16_bf16(b0,qr[0],negm,0,0,0);p1=__builtin_amdgcn_mfma_f32_32x32x16_bf16(b1,qr[0],negm,0,0,0);}
    else{p0=__builtin_amdgcn_mfma_f32_32x32x16_bf16(b0,qr[d0],p0,0,0,0);p1=__builtin_amdgcn_mfma_f32_32x32x16_bf16(b1,qr[d0],p1,0,0,0);}}
}
typedef __attribute__((address_space(3))) const char* lds_cptr;
typedef short v4i16_t __attribute__((ext_vector_type(4)));
__device__ __forceinline__ void kload8(bf16x8*kf,lds_cptr kp){
  kf[0]=*(const __attribute__((address_space(3))) bf16x8*)(kp);      kf[1]=*(const __attribute__((address_space(3))) bf16x8*)(kp+512);
  kf[2]=*(const __attribute__((address_space(3))) bf16x8*)(kp+2048); kf[3]=*(const __attribute__((address_space(3))) bf16x8*)(kp+2560);
  kf[4]=*(const __attribute__((address_space(3))) bf16x8*)(kp+4096); kf[5]=*(const __attribute__((address_space(3))) bf16x8*)(kp+4608);
  kf[6]=*(const __attribute__((address_space(3))) bf16x8*)(kp+6144); kf[7]=*(const __attribute__((address_space(3))) bf16x8*)(kp+6656);
}
__device__ __forceinline__ void kload2(bf16x8*kf,lds_cptr kp,int j){ kf[2*j]=*(const __attribute__((address_space(3))) bf16x8*)(kp+j*2048); kf[2*j+1]=*(const __attribute__((address_space(3))) bf16x8*)(kp+j*2048+512); }
__device__ __forceinline__ s16x4 vtr(lds_cptr p){ return __builtin_bit_cast(s16x4,__builtin_amdgcn_ds_read_tr16_b64_v4i16((__attribute__((address_space(3))) v4i16_t*)p)); }
__device__ __forceinline__ float rowmax(const f32x16&p0,const f32x16&p1){
  float a=max3f(p0[0],p0[1],p1[0]),b=max3f(p0[2],p0[3],p1[1]);a=max3f(a,p1[2],p1[3]);
  #pragma unroll
  for(int r=4;r<16;r+=4){a=max3f(a,p0[r],p0[r+1]);b=max3f(b,p0[r+2],p0[r+3]);a=max3f(a,p1[r],p1[r+1]);b=max3f(b,p1[r+2],p1[r+3]);}
  const float m=max2f(a,b);
  auto rr=__builtin_amdgcn_permlane32_swap(__float_as_uint(m),__float_as_uint(m),false,false);
  return max2f(__uint_as_float(rr[0]),__uint_as_float(rr[1]));
}
__device__ __forceinline__ void pv(f32x16*o,int vb,bf16x8 pa0,bf16x8 pa1,bf16x8 pa2,bf16x8 pa3){
  #pragma unroll
  for(int d0=0;d0<2;++d0){s16x4 lo[4],hi[4];
    #pragma unroll
    for(int ks=0;ks<4;++ks){
      asm volatile("ds_read_b64_tr_b16 %0,%1 offset:%c2":"=&v"(lo[ks]):"v"(vb),"i"(d0*4096+ks*1024):"memory");
      asm volatile("ds_read_b64_tr_b16 %0,%1 offset:%c2":"=&v"(hi[ks]):"v"(vb),"i"(d0*4096+ks*1024+512):"memory");}
    asm volatile("s_waitcnt lgkmcnt(0)":::"memory");SBAR();
    #define PK(k) (bf16x8){lo[k][0],lo[k][1],lo[k][2],lo[k][3],hi[k][0],hi[k][1],hi[k][2],hi[k][3]}
    o[d0]=__builtin_amdgcn_mfma_f32_32x32x16_bf16(pa0,PK(0),o[d0],0,0,0);
    o[d0]=__builtin_amdgcn_mfma_f32_32x32x16_bf16(pa1,PK(1),o[d0],0,0,0);
    o[d0]=__builtin_amdgcn_mfma_f32_32x32x16_bf16(pa2,PK(2),o[d0],0,0,0);
    o[d0]=__builtin_amdgcn_mfma_f32_32x32x16_bf16(pa3,PK(3),o[d0],0,0,0);
    #undef PK
  }
}

#ifndef ATTN_STORE16
#define ATTN_STORE16(p,v) (*(u32x4*)(p)=(v))
#endif
template<int THRL> __device__ __forceinline__ void attn_unit(int b,int h,int qb,const bf16*Q,const bf16*__restrict__ K,const bf16*__restrict__ V,bf16*O,char*shm){
  const int tid=threadIdx.x,lane=tid&63,r32=lane&31,hi=lane>>5; const int wid=__builtin_amdgcn_readfirstlane(tid>>6);
  const long rowbase=(long)b*SEQ, kvbase=(long)b*KVLEN; const int q0=qb*QB, kh=h/3;
  const bf16*Qw=Q+(rowbase+q0+wid*QBLK)*QP+h*D;
  const bf16*Kh=K+kvbase*KP+kh*D,*Vh=V+kvbase*KP+kh*D;
  const unsigned lds0=(unsigned)(uintptr_t)shm;
  float*wsf=(float*)(shm+LDS_WS)+wid*64;
  const bf16*ksrc=Kh+(long)lane*KP+wid*8;
  const bf16*vsrc=Vh+(long)(16*(wid&3)+(lane>>2))*KP+(wid>>2)*32+(lane&3)*8;
  const unsigned kdst=lds0+LDS_K+wid*1024, vdst=lds0+LDS_V+wid*1024;
  #define DMA_K(t,slot) glds16(ksrc+(long)(t)*KVBLK*KP,(unsigned)__builtin_amdgcn_readfirstlane(kdst+(slot)))
  #define DMA_V(t,slot) glds16(vsrc+(long)(t)*KVBLK*KP,(unsigned)__builtin_amdgcn_readfirstlane(vdst+(slot)))
  const int vb0=(int)(lds0+LDS_V)+((lane>>4)&1)*32+(lane&3)*8+(4*hi+((lane&15)>>2))*64;
  const char*Kbase=shm+LDS_K; bf16x8 kf[8];
  const lds_cptr shm3=(lds_cptr)shm; const lds_cptr kp0=shm3+LDS_K+hi*1024+r32*16; const lds_cptr vp0=shm3+LDS_V+((lane>>4)&1)*32+(lane&3)*8+(4*hi+((lane&15)>>2))*64;
  DMA_K(0,0);DMA_V(0,0);DMA_K(1,SLOTB);
  bf16x8 qr[4];
  #pragma unroll
  for(int d0=0;d0<4;++d0)qr[d0]=*reinterpret_cast<const bf16x8*>(&Qw[(long)r32*QP+d0*16+hi*8]);
  float mhat=0.f,l_reg=0.f;f32x16 o[2];o[0]=f32x16{};o[1]=f32x16{};f32x16 negm=f32x16{};asm volatile("":"+v"(negm));
  #define CMASK(P0,P1,t) do{}while(0)
  bool resc=false;
  #define START(P0,P1) do{ const float rm=rowmax(P0,P1); resc=false; \
    { const float dl=rm; mhat=fadd_s(mhat,dl); \
      _Pragma("unroll") for(int r=0;r<16;++r){P0[r]=fsub_s(P0[r],dl);P1[r]=fsub_s(P1[r],dl);} \
      _Pragma("unroll") for(int r=0;r<16;++r)negm[r]=-mhat; asm volatile("":"+v"(negm)); } \
    _Pragma("unroll") for(int r=0;r<16;++r)P0[r]=__builtin_amdgcn_exp2f(P0[r]); }while(0)
  #define RESC() do{ if(resc){ asm volatile("s_waitcnt lgkmcnt(0)":::"memory"); \
      _Pragma("unroll") for(int d_=0;d_<2;++d_) _Pragma("unroll") for(int r=0;r<16;++r)o[d_][r]*=wsf[crow(r,hi)]; } }while(0)
  f32x16 pA0,pA1,pB0,pB1;
  int sl_prev=0,sl_cur=0,sl_next=SLOTB;
  #define ROT() do{sl_prev=sl_cur;sl_cur=sl_next;sl_next=(sl_next==(NSLOT-1)*SLOTB)?0:sl_next+SLOTB;}while(0)
  DMA_K(2,2*SLOTB);
  WAIT_BAR(3);
  qkt(pA0,pA1,Kbase,qr,negm,r32,hi);asm volatile("s_nop 15\n\ts_nop 7":"+v"(pA0),"+v"(pA1));CMASK(pA0,pA1,0);
  START(pA0,pA1);
  _Pragma("unroll") for(int r=0;r<16;++r)pA1[r]=__builtin_amdgcn_exp2f(pA1[r]);
  WAIT_BAR(0);
  DMA_K(3,0);DMA_V(1,SLOTB);
  ROT();
  kload8(kf,kp0+sl_cur);
  WAIT_BAR(2);
  s16x4 vlo[8],vhi[8]; u32x4 pw0,pw1,pw2,pw3;
  #define PKW(P,B) cvtpk_s(P[B],P[B+1])
  #define PAF(k) __builtin_bit_cast(bf16x8,pw##k)
  #define VFR(i) (bf16x8){vlo[i][0],vlo[i][1],vlo[i][2],vlo[i][3],vhi[i][0],vhi[i][1],vhi[i][2],vhi[i][3]}
  #define PIN(x) asm volatile("":"+v"(x))
  #define MX3(a,b,c) __builtin_fmaxf(__builtin_fmaxf((a),(b)),(c))
  #define GAPA(MF,A0,A1,A2,A3,W0,W1,PW) do{ MF; sacc+=A0; sacc+=A1; sacc+=A2; sacc+=A3; PIN(sacc); W0; W1; PIN(PW); SBAR(); }while(0)
  #define EX(v) __builtin_amdgcn_exp2f(v)
  #define GAPB(MF,X,B) do{ MF; X[B]=EX(X[B]); X[B+1]=EX(X[B+1]); X[B+2]=EX(X[B+2]); X[B+3]=EX(X[B+3]); PIN(X); SBAR(); }while(0)
  #define VRD(i) do{ vlo[i]=vtr(vp_+(((i)>>2)*4096+((i)&3)*1024)); vhi[i]=vtr(vp_+(((i)>>2)*4096+((i)&3)*1024+512)); }while(0)
  #define KRD(G,j) do{ if(G){ kload2(kf,kp0+sl_next,j); SBAR(); } }while(0)
  #define STEP(C0,C1,P0,P1,t,GK,GV,GL) do{ SBAR(); \
    const lds_cptr vp_=vp0+sl_prev; \
    VRD(0); SBAR(); float sacc=(P0[0]+P0[1]); \
    GAPA(C0=__builtin_amdgcn_mfma_f32_32x32x16_bf16(kf[0],qr[0],negm,0,0,0), P0[2],P0[3],P0[4],P0[5],     pw0[0]=PKW(P0,0), pw0[1]=PKW(P0,2), pw0); \
    VRD(4); SBAR(); GAPA(C1=__builtin_amdgcn_mfma_f32_32x32x16_bf16(kf[1],qr[0],negm,0,0,0), P0[6],P0[7],P0[8],P0[9],     pw0[2]=PKW(P0,4), pw0[3]=PKW(P0,6), pw0); \
    VRD(1); SBAR(); GAPA(C0=__builtin_amdgcn_mfma_f32_32x32x16_bf16(kf[2],qr[1],C0,0,0,0),   P0[10],P0[11],P0[12],P0[13], pw1[0]=PKW(P0,8), pw1[1]=PKW(P0,10), pw1); \
    VRD(5); SBAR(); GAPA(C1=__builtin_amdgcn_mfma_f32_32x32x16_bf16(kf[3],qr[1],C1,0,0,0),   P0[14],P0[15],P1[0],P1[1],   pw1[2]=PKW(P0,12),pw1[3]=PKW(P0,14), pw1); \
    VRD(2); SBAR(); GAPA(C0=__builtin_amdgcn_mfma_f32_32x32x16_bf16(kf[4],qr[2],C0,0,0,0),   P1[2],P1[3],P1[4],P1[5],     pw2[0]=PKW(P1,0), pw2[1]=PKW(P1,2), pw2); \
    VRD(6); SBAR(); GAPA(C1=__builtin_amdgcn_mfma_f32_32x32x16_bf16(kf[5],qr[2],C1,0,0,0),   P1[6],P1[7],P1[8],P1[9],     pw2[2]=PKW(P1,4), pw2[3]=PKW(P1,6), pw2); \
    VRD(3); SBAR(); GAPA(C0=__builtin_amdgcn_mfma_f32_32x32x16_bf16(kf[6],qr[3],C0,0,0,0),   P1[10],P1[11],P1[12],P1[13], pw3[0]=PKW(P1,8), pw3[1]=PKW(P1,10), pw3); \
    VRD(7); SBAR(); GAPA(C1=__builtin_amdgcn_mfma_f32_32x32x16_bf16(kf[7],qr[3],C1,0,0,0),   P1[14],P1[15],0.f,0.f,       pw3[2]=PKW(P1,12),pw3[3]=PKW(P1,14), pw3); \
    l_reg+=sacc; \
    if(GK){DMA_K((t)+3,sl_cur);} if(GV){DMA_V((t)+1,sl_next);} \
    CMASK(C0,C1,t); \
    { float a=MX3(C0[0],C0[1],C1[0]),b=MX3(C0[2],C0[3],C1[1]); a=MX3(a,C1[2],C1[3]); \
      _Pragma("unroll") for(int r=4;r<16;r+=4){a=MX3(a,C0[r],C0[r+1]);b=MX3(b,C0[r+2],C0[r+3]);a=MX3(a,C1[r],C1[r+1]);b=MX3(b,C1[r+2],C1[r+3]);} \
      float rm=__builtin_fmaxf(a,b); { auto rr=__builtin_amdgcn_permlane32_swap(__float_as_uint(rm),__float_as_uint(rm),false,false); rm=__builtin_fmaxf(__uint_as_float(rr[0]),__uint_as_float(rr[1])); } \
      resc=false; \
      if(__builtin_expect(__any(rm>(float)THRL),0)){ const float dl=__builtin_fmaxf(rm,0.f); mhat+=dl; \
        _Pragma("unroll") for(int r=0;r<16;++r){C0[r]-=dl;C1[r]-=dl;} \
        _Pragma("unroll") for(int r=0;r<16;++r)negm[r]=-mhat; asm volatile("":"+v"(negm)); \
        const float f=__builtin_amdgcn_exp2f(-dl); l_reg*=f; if(hi==0)wsf[r32]=f; resc=true; } } \
    SBAR(); \
    GAPB(o[0]=__builtin_amdgcn_mfma_f32_32x32x16_bf16(PAF(0),VFR(0),o[0],0,0,0), C0,0); \
    GAPB(o[1]=__builtin_amdgcn_mfma_f32_32x32x16_bf16(PAF(0),VFR(4),o[1],0,0,0), C0,4); \
    KRD(GL,0); GAPB(o[0]=__builtin_amdgcn_mfma_f32_32x32x16_bf16(PAF(1),VFR(1),o[0],0,0,0), C0,8); \
    KRD(GL,1); GAPB(o[1]=__builtin_amdgcn_mfma_f32_32x32x16_bf16(PAF(1),VFR(5),o[1],0,0,0), C0,12); \
    KRD(GL,2); GAPB(o[0]=__builtin_amdgcn_mfma_f32_32x32x16_bf16(PAF(2),VFR(2),o[0],0,0,0), C1,0); \
    KRD(GL,3); GAPB(o[1]=__builtin_amdgcn_mfma_f32_32x32x16_bf16(PAF(2),VFR(6),o[1],0,0,0), C1,4); \
    GAPB(o[0]=__builtin_amdgcn_mfma_f32_32x32x16_bf16(PAF(3),VFR(3),o[0],0,0,0), C1,8); \
    GAPB(o[1]=__builtin_amdgcn_mfma_f32_32x32x16_bf16(PAF(3),VFR(7),o[1],0,0,0), C1,12); \
    }while(0)
  int t=1;
  for(;t+5<NT;t+=2){
    STEP(pB0,pB1,pA0,pA1,t,true,true,true);     WAIT_BAR(2); RESC(); ROT();
    STEP(pA0,pA1,pB0,pB1,t+1,true,true,true);   WAIT_BAR(2); RESC(); ROT();
  }
  #define ENDW(tt) do{ if((tt)+3<NT){WAIT_BAR(2);} else if((tt)+2<NT){WAIT_BAR(1);} else {WAIT_BAR(0);} }while(0)
  for(;t+1<NT;t+=2){
    STEP(pB0,pB1,pA0,pA1,t,(t+3<NT),(t+1<NT),(t+1<NT));       ENDW(t);   RESC(); ROT();
    STEP(pA0,pA1,pB0,pB1,t+1,(t+4<NT),(t+2<NT),(t+2<NT));     ENDW(t+1); RESC(); ROT();
  }
  STEP(pB0,pB1,pA0,pA1,NT-1,false,false,false); RESC();
  { float sacc=pB0[0]+pB0[1]; _Pragma("unroll") for(int r=2;r<16;++r)sacc+=pB0[r]; _Pragma("unroll") for(int r=0;r<16;++r)sacc+=pB1[r]; l_reg+=sacc;
    pw0=(u32x4){PKW(pB0,0),PKW(pB0,2),PKW(pB0,4),PKW(pB0,6)};pw1=(u32x4){PKW(pB0,8),PKW(pB0,10),PKW(pB0,12),PKW(pB0,14)};pw2=(u32x4){PKW(pB1,0),PKW(pB1,2),PKW(pB1,4),PKW(pB1,6)};pw3=(u32x4){PKW(pB1,8),PKW(pB1,10),PKW(pB1,12),PKW(pB1,14)};
    SBAR(); pv(o,vb0+sl_cur,PAF(0),PAF(1),PAF(2),PAF(3)); }
  #undef PKW
  #undef PAF
  #undef VFR
  #undef PIN
  #undef MX3
  #undef GAPA
  #undef GAPB
  #undef EX
  #undef VRD
  #undef KRD
  #undef STEP
  #undef ENDW
  {auto rr=__builtin_amdgcn_permlane32_swap(__float_as_uint(l_reg),__float_as_uint(l_reg),false,false);l_reg=__uint_as_float(rr[0])+__uint_as_float(rr[1]);}
  if(hi==0)wsf[32+r32]=l_reg;asm volatile("s_waitcnt lgkmcnt(0)":::"memory");
  float rli[16];
  #pragma unroll
  for(int r=0;r<16;++r)rli[r]=__builtin_amdgcn_rcpf(wsf[32+crow(r,hi)]);
  bf16*Ow=O+(rowbase+q0+wid*QBLK)*OP+h*D;
  { bf16*stg=(bf16*)(shm+LDS_OST)+wid*2048;
    #pragma unroll
    for(int r=0;r<16;++r){const int orow=crow(r,hi);
      #pragma unroll
      for(int d0=0;d0<2;++d0)stg[orow*64+d0*32+r32]=(bf16)f2bf(o[d0][r]*rli[r]);}
    asm volatile("s_waitcnt lgkmcnt(0)":::"memory");
    #pragma unroll
    for(int i=0;i<4;++i){const int row=i*8+(lane>>3),ch=lane&7; const u32x4 v=*(const u32x4*)(stg+row*64+ch*8); ATTN_STORE16(Ow+(long)row*OP+ch*8,v);} }
  asm volatile("s_waitcnt lgkmcnt(0)\n\ts_barrier":::"memory");
  #undef DMA_K
  #undef DMA_V
  #undef CMASK
  #undef START
  #undef RESC
  #undef ROT
}
constexpr int ATTN_LDS_BYTES=LDS_BYTES;
struct AttnTensors { const bf16* Q; const bf16* K; const bf16* V; bf16* O; };
template<int THRL=8> __device__ __forceinline__ void attn_phase(char*lds,const AttnTensors&T){
  const int G=gridDim.x, bx=blockIdx.x, v=(G%8==0)?(bx%8)*(G/8)+bx/8:bx;
  for(int u=v;u<16*12*8;u+=G){
    const int pair=(u%256)/4, j=((u%256)%4)*6+u/256;
    const int b=pair>>2, kh=pair&3, g=j>>3, qb=j&7;
    attn_unit<THRL>(b,kh*3+g,qb,T.Q,T.K,T.V,T.O,lds);
  }
}
#undef SBAR
#undef WAIT_BAR
}

__device__ __forceinline__ void pool_item(const Params& p, LAS unsigned char* lds, int item) {
    const int tid = TIDX;
    const int gi = item & 3, tile = item >> 2, t0 = tile * 32, b = t0 / SEQ, tl0 = t0 % SEQ, half = 1 << gi;
    const bf16_t* Ub = (const bf16_t*)(p.ws + OFF_U);
    bf16_t* AO = (bf16_t*)(p.ws + OFF_AO);
    LAS float* us = (LAS float*)lds;
    LAS float* dl = (LAS float*)(lds + 48 * 64 * 4);
    __syncthreads();
    for (int i = tid; i < 48 * 64; i += 256) {
        const int r = i >> 6, c = i & 63, tl = tl0 - 8 + r;
        us[i] = (tl >= 0 && tl < SEQ) ? bf2f(Ub[(size_t)(b * SEQ + tl) * 256 + gi * 64 + c]) : 0.f;
    }
    __syncthreads();
    {
        const int c = tid & 63, tg = tid >> 6;
#pragma unroll
        for (int k = 0; k < 8; ++k) {
            const int tk = tg * 8 + k, tl = tl0 + tk;
            const int lo = max(tl - half, 0), hi = min(tl + half, SEQ);
            float s = 0.f;
            for (int r = lo; r < hi; ++r) s += us[(r - tl0 + 8) * 64 + c];
            dl[tk * 64 + c] = s / (float)(hi - lo) - us[(tk + 8) * 64 + c];
        }
    }
    __syncthreads();
    {
        const int dd = tid & 63, tg = tid >> 6;
        float acc[8];
#pragma unroll
        for (int k = 0; k < 8; ++k) acc[k] = 0.f;
        const float* w = p.pool_w + gi * 4096 + dd;
        for (int c = 0; c < 64; ++c) {
            const float wv = w[c * 64];
#pragma unroll
            for (int k = 0; k < 8; ++k) acc[k] += dl[(tg * 8 + k) * 64 + c] * wv;
        }
        const float ps = p.pool_scale[gi * 64 + dd];
#pragma unroll
        for (int k = 0; k < 8; ++k) AO[(size_t)(t0 + tg * 8 + k) * D + gi * 64 + dd] = (bf16_t)f2bf(acc[k] * ps);
    }
}

__device__ __forceinline__ void phase_attn_pool(const Params& p, LAS unsigned char* lds, char* smem) {
    const attn_body::AttnTensors AT{(const bf16_t*)(p.ws + OFF_Q), (const bf16_t*)(p.ws + OFF_K), (const bf16_t*)(p.ws + OFF_V), (bf16_t*)(p.ws + OFF_AO) + 256};
    attn_body::attn_phase<8>(smem, AT);
    __syncthreads();
    constexpr int N_POOL = (T / 32) * 4;
    for (int it = VBLK; it < N_POOL; it += NVBLK) pool_item(p, lds, it);
}

struct EpiOut {
    static constexpr bool PERM = false;
    const float* x; float* y; const float* mod; float* stats;
    __device__ __forceinline__ void operator()(const f32x4 (&acc)[2][2][4][2], const pg8::Unit& u, int wr, int wc, int fr, int fq) const {
        const float* g1 = mod + (size_t)(u.pm >> 3) * MODW + 2 * D;
        const int col0 = u.pn * 256 + wc * 32 + fq * 4;
        f32x4 gv[2][2];
#pragma unroll
        for (int bj = 0; bj < 2; ++bj)
#pragma unroll
            for (int n = 0; n < 2; ++n) gv[bj][n] = *(const f32x4*)(g1 + col0 + bj * 128 + n * 16);
#pragma unroll
        for (int ai = 0; ai < 2; ++ai)
#pragma unroll
            for (int m = 0; m < 4; ++m) {
                const int row = u.pm * 256 + ai * 128 + wr * 64 + m * 16 + fr;
                float s1 = 0.f, s2 = 0.f;
#pragma unroll
                for (int bj = 0; bj < 2; ++bj)
#pragma unroll
                    for (int n = 0; n < 2; ++n) {
                        const size_t off = (size_t)row * D + col0 + bj * 128 + n * 16;
                        const f32x4 xv = *(const f32x4*)(x + off);
                        const f32x4 yv = xv * ALPHA + gv[bj][n] * acc[ai][bj][m][n];
                        *(f32x4*)(y + off) = yv;
                        s1 += (yv[0] + yv[1]) + (yv[2] + yv[3]);
                        s2 += (yv[0] * yv[0] + yv[1] * yv[1]) + (yv[2] * yv[2] + yv[3] * yv[3]);
                    }
                s1 += __shfl_xor(s1, 16); s1 += __shfl_xor(s1, 32);
                s2 += __shfl_xor(s2, 16); s2 += __shfl_xor(s2, 32);
                if (fq == 0) { float* st = stats + ((size_t)row * 16 + u.pn * 4 + wc) * 2; st[0] = s1; st[1] = s2; }
            }
    }
};
__device__ __forceinline__ void phase_outproj(const Params& p, LAS unsigned char* lds) {
    pg8::Gemm g{(const bf16_t*)(p.ws + OFF_AO), (const bf16_t*)(p.ws + OFF_WTOUT)};
    pg8::DenseSched S{4, 512, 512, 0, 1, (int)gridDim.x, vcu_of_block()};
    EpiOut E{p.x, p.out, (const float*)(p.ws + OFF_MOD), (float*)(p.ws + OFF_STATS)};
    pg8::gemm_phase<D, EpiOut, pg8::DenseSched, false>(lds, g, S, E);
}

__device__ __forceinline__ void phase_router(const Params& p, LAS unsigned char* lds0) {
    const int tid = threadIdx.x, lane = tid & 63, wid = tid >> 6, r16 = lane & 15, q = lane >> 4;
    const float* mod = (const float*)(p.ws + OFF_MOD);
    const float* stats = (const float*)(p.ws + OFF_STATS);
    bf16_t* H = (bf16_t*)(p.ws + OFF_H);
    const bf16_t* WRH = (const bf16_t*)(p.ws + OFF_WRH); const bf16_t* WRL = (const bf16_t*)(p.ws + OFF_WRL);
    int* gcnt = (int*)(p.ws + OFF_CNT);
    int* LDST = (int*)(p.ws + OFF_LDST);
    float* LWt = (float*)(p.ws + OFF_LW);
    LAS float* vec = (LAS float*)lds0;
    LAS float* lg = (LAS float*)(lds0 + 16384) + wid * 16 * 64;
    LAS int* lcnt = (LAS int*)(lds0 + 49152);
    LAS int* lbase = (LAS int*)(lds0 + 49152 + 256);
    LAS int* sel_ep = (LAS int*)(lds0 + 49152 + 512);
    LAS float* sel_w = (LAS float*)(lds0 + 49152 + 512 + 4096);
    for (int item = blockIdx.x; item < T / 128; item += gridDim.x) {
        const int t0 = item * 128, b = t0 / SEQ, tw0 = t0 + wid * 16;
        __syncthreads();
        if (tid < 64) lcnt[tid] = 0;
        for (int i = tid; i < 1024; i += 512) {
            vec[i] = p.ln1_g[i]; vec[1024 + i] = p.ln1_b[i];
            vec[2048 + i] = 1.f + mod[(size_t)b * MODW + 4 * D + i]; vec[3072 + i] = mod[(size_t)b * MODW + 3 * D + i];
        }
        float meanv = 0.f, rstdv = 0.f;
        if (lane < 16) {
            float s1 = 0.f, s2 = 0.f;
            const float* st = stats + (size_t)(tw0 + lane) * 32;
#pragma unroll
            for (int i = 0; i < 16; ++i) { s1 += st[2 * i]; s2 += st[2 * i + 1]; }
            meanv = s1 * (1.f / D);
            const float var = fmaxf(s2 * (1.f / D) - meanv * meanv, 0.f);
            rstdv = 1.0f / sqrtf(var + 1e-5f);
        }
        const float mu = __shfl(meanv, r16), rs = __shfl(rstdv, r16);
        __syncthreads();
        f32x4 acc[4];
#pragma unroll
        for (int nb = 0; nb < 4; ++nb) acc[nb] = (f32x4){0.f, 0.f, 0.f, 0.f};
        float* yrow = p.out + (size_t)(tw0 + r16) * D + q * 8;
        bf16_t* hrow = H + (size_t)(tw0 + r16) * D + q * 8;
        LAS unsigned char* wb = lds0 + 57856;
        f32x4 vn[4][2];
#pragma unroll
        for (int u = 0; u < 4; ++u) { vn[u][0] = *(const f32x4*)(yrow + u * 32); vn[u][1] = *(const f32x4*)(yrow + u * 32 + 4); }
        for (int ch = 0; ch < 4; ++ch) {
            __syncthreads();
#pragma unroll
            for (int i = 0; i < 8; ++i) {
                const int idx = tid + i * 512, part = idx >> 11, row = (idx >> 5) & 63, c16 = idx & 31;
                const u32x4 w = *(const u32x4*)((part ? WRL : WRH) + (size_t)row * D + ch * 256 + c16 * 8);
                *(LAS u32x4*)(wb + part * 33792 + row * 528 + c16 * 16) = w;
            }
            __syncthreads();
#pragma unroll
            for (int s4 = ch * 8; s4 < ch * 8 + 8; s4 += 4) {
                f32x4 vv[4][2];
#pragma unroll
                for (int u = 0; u < 4; ++u) { vv[u][0] = vn[u][0]; vv[u][1] = vn[u][1]; }
                if (s4 + 4 < 32) {
#pragma unroll
                    for (int u = 0; u < 4; ++u) { vn[u][0] = *(const f32x4*)(yrow + (s4 + 4 + u) * 32); vn[u][1] = *(const f32x4*)(yrow + (s4 + 4 + u) * 32 + 4); }
                }
#pragma unroll
                for (int u = 0; u < 4; ++u) {
                    const int s = s4 + u, k0 = s * 32 + q * 8;
                    float hv[8];
#pragma unroll
                    for (int hh = 0; hh < 2; ++hh) {
                        const f32x4 g = *(const LAS f32x4*)(vec + k0 + 4 * hh), bb = *(const LAS f32x4*)(vec + 1024 + k0 + 4 * hh);
                        const f32x4 sc = *(const LAS f32x4*)(vec + 2048 + k0 + 4 * hh), sh = *(const LAS f32x4*)(vec + 3072 + k0 + 4 * hh);
                        const f32x4 xm = (vv[u][hh] - mu) * rs * g + bb;
                        *(f32x4*)(yrow + s * 32 + 4 * hh) = xm;
                        const f32x4 h4 = xm * sc + sh;
                        hv[4 * hh + 0] = h4[0]; hv[4 * hh + 1] = h4[1]; hv[4 * hh + 2] = h4[2]; hv[4 * hh + 3] = h4[3];
                    }
                    unsigned wh[4], wl[4];
#pragma unroll
                    for (int i = 0; i < 4; ++i) {
                        const unsigned ha = f2bf(hv[2 * i]), hb = f2bf(hv[2 * i + 1]);
                        wh[i] = ha | (hb << 16);
                        wl[i] = pk2(hv[2 * i] - bf2f(ha), hv[2 * i + 1] - bf2f(hb));
                    }
                    *(u32x4*)(hrow + s * 32) = (u32x4){wh[0], wh[1], wh[2], wh[3]};
                    const bf16x8 ah = __builtin_bit_cast(bf16x8, (u32x4){wh[0], wh[1], wh[2], wh[3]}), al = __builtin_bit_cast(bf16x8, (u32x4){wl[0], wl[1], wl[2], wl[3]});
                    const int kb = ((s & 7) * 32 + q * 8) * 2;
#pragma unroll
                    for (int nb = 0; nb < 4; ++nb) {
                        const bf16x8 bh = *(const LAS bf16x8*)(wb + (nb * 16 + r16) * 528 + kb), bl = *(const LAS bf16x8*)(wb + 33792 + (nb * 16 + r16) * 528 + kb);
                        acc[nb] = __builtin_amdgcn_mfma_f32_16x16x32_bf16(ah, bh, acc[nb], 0, 0, 0);
                        acc[nb] = __builtin_amdgcn_mfma_f32_16x16x32_bf16(al, bh, acc[nb], 0, 0, 0);
                        acc[nb] = __builtin_amdgcn_mfma_f32_16x16x32_bf16(ah, bl, acc[nb], 0, 0, 0);
                    }
                }
            }
        }
#pragma unroll
        for (int nb = 0; nb < 4; ++nb)
#pragma unroll
            for (int j = 0; j < 4; ++j) lg[(4 * q + j) * 64 + nb * 16 + r16] = acc[nb][j];
        __syncthreads();
        const float bias = p.router_bias[lane];
        for (int r = 0; r < 16; ++r) {
            const float lgv = lg[r * 64 + lane];
            const float sg = 1.0f / (1.0f + expf(-lgv));
            const float sel = sg + bias;
            float m1 = fmaxf(sel, __shfl_xor(sel, 1)); m1 = fmaxf(m1, __shfl_xor(m1, 2)); m1 = fmaxf(m1, __shfl_xor(m1, 4));
            int cand = (sel == m1) ? lane : 64;
            cand = min(cand, __shfl_xor(cand, 1)); cand = min(cand, __shfl_xor(cand, 2)); cand = min(cand, __shfl_xor(cand, 4));
            const float sel2 = (lane == cand) ? -INFINITY : sel;
            float m2 = fmaxf(sel2, __shfl_xor(sel2, 1)); m2 = fmaxf(m2, __shfl_xor(m2, 2)); m2 = fmaxf(m2, __shfl_xor(m2, 4));
            const float gs = m1 + m2;
            const int g = lane >> 3;
            int cntg = 0;
#pragma unroll
            for (int gg = 0; gg < 8; ++gg) { const float v = __shfl(gs, gg * 8); cntg += (v > gs || (v == gs && gg < g)) ? 1 : 0; }
            const bool keep = cntg < 4;
            const float msel = keep ? sel : -INFINITY;
            lg[r * 64 + lane] = msel;
            int cnt = 0;
#pragma unroll 4
            for (int q4 = 0; q4 < 16; ++q4) {
                const f32x4 v = *(const LAS f32x4*)(lg + r * 64 + q4 * 4);
#pragma unroll
                for (int i = 0; i < 4; ++i) cnt += (v[i] > msel || (v[i] == msel && (q4 * 4 + i) < lane)) ? 1 : 0;
            }
            const bool chosen = keep && cnt < 8;
            float wsum = chosen ? sg : 0.f;
#pragma unroll
            for (int o = 1; o < 64; o <<= 1) wsum += __shfl_xor(wsum, o);
            if (chosen) {
                const int pos = atomicAdd((int*)&lcnt[lane], 1);
                sel_ep[(wid * 16 + r) * 8 + cnt] = lane | (pos << 8);
                sel_w[(wid * 16 + r) * 8 + cnt] = sg / wsum * 2.5f;
            }
        }
        __syncthreads();
        if (tid < 64) { int tt = tid; asm volatile("" : "+v"(tt)); lbase[tt] = atomicAdd(&gcnt[tt], lcnt[tt]); }
        __syncthreads();
        for (int idx = tid; idx < 1024; idx += 512) {
            const int ep = sel_ep[idx], e = ep & 0xff, pos = ep >> 8, gi = lbase[e] + pos;
            LDST[(size_t)e * T + gi] = (t0 + (idx >> 3)) * NSLOT + (idx & 7);
            LWt[(size_t)e * T + gi] = sel_w[idx];
        }
    }
}

constexpr int LDS_ROWTAB = 131072, MOE_MAX_UNITS = 12, LDS_UTAB = LDS_CTL + 256, LDS_TSTART = LDS_UTAB + MOE_MAX_UNITS * 32;
__device__ __forceinline__ int moe_setup(const Params& p, LAS unsigned char* lds0, int nN, int bmul, int badd) {
    LAS int* tstart = (LAS int*)(lds0 + LDS_TSTART); LAS int* utab = (LAS int*)(lds0 + LDS_UTAB);
    const int* gcnt = (const int*)(p.ws + OFF_CNT);
    __syncthreads();
    if (threadIdx.x == 0) {
        int a = 0;
        for (int e = 0; e < NEX; ++e) { const int c = e < NE ? gcnt[e] : T; tstart[e] = a; a += (c + 255) >> 8; }
        tstart[NEX] = a;
    }
    __syncthreads();
    const int total = tstart[NEX] * nN, G = gridDim.x, c = blockIdx.x;
    if (threadIdx.x < MOE_MAX_UNITS) {
        const int i = threadIdx.x, L = i * G + c;
        int pm = 0, pn = 0, e = 0, i0 = 0, cnt = 0;
        if (L < total) {
            const int mt = L / nN, pl = L % nN;
            for (int j = 1; j < NEX; ++j) e += (mt >= tstart[j]) ? 1 : 0;
            pm = mt; pn = e * bmul + badd + pl; i0 = (mt - tstart[e]) * 256; cnt = e < NE ? gcnt[e] : T;
        }
        utab[i * 8 + 0] = pm; utab[i * 8 + 1] = pn; utab[i * 8 + 2] = e; utab[i * 8 + 3] = i0; utab[i * 8 + 4] = cnt;
    }
    __syncthreads();
    const int n = (total - c + G - 1) / G;
    return n < 0 ? 0 : (n > MOE_MAX_UNITS ? MOE_MAX_UNITS : n);
}
struct MoeSched {
    LAS const int* utab; LAS const unsigned* rowtab; int n;
    __device__ __forceinline__ bool next(int i, pg8::Unit& u) const {
        if (i >= n) return false;
        u.pm = __builtin_amdgcn_readfirstlane(utab[i * 8 + 0]); u.pn = __builtin_amdgcn_readfirstlane(utab[i * 8 + 1]); u.e = __builtin_amdgcn_readfirstlane(utab[i * 8 + 2]); u.idx = i; return true;
    }
    __device__ __forceinline__ unsigned row_off(int i, int r) const { return rowtab[i * 256 + r]; }
    __device__ __forceinline__ void a_ready(const pg8::Unit&) const {}
    __device__ __forceinline__ void done(const pg8::Unit&) const {}
};
struct EpiGU {
    static constexpr bool PERM = true;
    LAS const int* utab; unsigned char* ws;
    __device__ __forceinline__ void operator()(const f32x4 (&acc)[2][2][4][2], const pg8::Unit& u, int wr, int wc, int fr, int fq) const {
        const int e = u.e, i0 = utab[u.idx * 8 + 3], cnt = utab[u.idx * 8 + 4], pl = u.pn & 1;
        const float* LWt = (const float*)(ws + OFF_LW) + (size_t)(e < NE ? e : 0) * T;
        bf16_t* ACT = (bf16_t*)(ws + OFF_ACT) + (size_t)u.pm * 256 * FF + pl * 128 + wc * 32 + 8 * fq;
        float lw[2][4];
#pragma unroll
        for (int ai = 0; ai < 2; ++ai)
#pragma unroll
            for (int m = 0; m < 4; ++m) lw[ai][m] = LWt[i0 + ai * 128 + wr * 64 + m * 16 + fr];
#pragma unroll
        for (int ai = 0; ai < 2; ++ai)
#pragma unroll
            for (int m = 0; m < 4; ++m) {
                const int rl = ai * 128 + wr * 64 + m * 16 + fr, li = i0 + rl;
                const float wrow = li < cnt ? (e < NE ? lw[ai][m] : 1.f) : 0.f;
                float a[8];
#pragma unroll
                for (int n = 0; n < 2; ++n)
#pragma unroll
                    for (int q = 0; q < 4; ++q) { const float g = acc[ai][0][m][n][q], uu = acc[ai][1][m][n][q]; a[n * 4 + q] = g / (1.f + __expf(-g)) * uu * wrow; }
                u32x4 w; w.x = pk2(a[0], a[1]); w.y = pk2(a[2], a[3]); w.z = pk2(a[4], a[5]); w.w = pk2(a[6], a[7]);
                *(u32x4*)(ACT + (size_t)rl * FF) = w;
            }
    }
};
__device__ __forceinline__ void phase_gateup(const Params& p, LAS unsigned char* lds0) {
    const int n = moe_setup(p, lds0, 2, 2, 0);
    LAS const int* utab = (LAS const int*)(lds0 + LDS_UTAB);
    LAS unsigned* rowtab = (LAS unsigned*)(lds0 + LDS_ROWTAB);
    const int* LDST = (const int*)(p.ws + OFF_LDST);
    for (int i = 0; i < n; ++i) {
        const int e = utab[i * 8 + 2], i0 = utab[i * 8 + 3], cnt = utab[i * 8 + 4];
        if (threadIdx.x < 256) {
            const int li = i0 + threadIdx.x; int tok = 0;
            if (li < cnt) tok = e < NE ? LDST[(size_t)e * T + li] / NSLOT : li;
            rowtab[i * 256 + threadIdx.x] = (unsigned)tok * (unsigned)(D * 2);
        }
    }
    __syncthreads();
    MoeSched S{utab, rowtab, n};
    pg8::Gemm g{(const bf16_t*)(p.ws + OFF_H), (const bf16_t*)(p.ws + OFF_WGU)};
    EpiGU E{utab, p.ws};
    pg8::gemm_phase<D, EpiGU, MoeSched, true>(lds0, g, S, E);
}
struct EpiDown {
    static constexpr bool PERM = true;
    LAS const int* utab; unsigned char* ws;
    __device__ __forceinline__ void operator()(const f32x4 (&acc)[2][2][4][2], const pg8::Unit& u, int wr, int wc, int fr, int fq) const {
        const int e = u.e, i0 = utab[u.idx * 8 + 3], cnt = utab[u.idx * 8 + 4];
        const int* LDST = (const int*)(ws + OFF_LDST) + (size_t)(e < NE ? e : 0) * T;
        bf16_t* SL = (bf16_t*)(ws + OFF_SLOTS) + wc * 32 + 8 * fq;
        int dst[2][4];
#pragma unroll
        for (int ai = 0; ai < 2; ++ai)
#pragma unroll
            for (int m = 0; m < 4; ++m) dst[ai][m] = LDST[i0 + ai * 128 + wr * 64 + m * 16 + fr];
#pragma unroll
        for (int ai = 0; ai < 2; ++ai)
#pragma unroll
            for (int m = 0; m < 4; ++m) {
                const int li = i0 + ai * 128 + wr * 64 + m * 16 + fr;
                const int d = li < cnt ? (e < NE ? dst[ai][m] : li * NSLOT + 8) : T * NSLOT;
#pragma unroll
                for (int bj = 0; bj < 2; ++bj) {
                    u32x4 w; w.x = pk2(acc[ai][bj][m][0][0], acc[ai][bj][m][0][1]); w.y = pk2(acc[ai][bj][m][0][2], acc[ai][bj][m][0][3]);
                    w.z = pk2(acc[ai][bj][m][1][0], acc[ai][bj][m][1][1]); w.w = pk2(acc[ai][bj][m][1][2], acc[ai][bj][m][1][3]);
                    *(u32x4*)(SL + (size_t)d * 256 + bj * 128) = w;
                }
            }
    }
};
__device__ __forceinline__ void phase_down(const Params& p, LAS unsigned char* lds0, int c) {
    const int n = moe_setup(p, lds0, 1, 4, c);
    LAS const int* utab = (LAS const int*)(lds0 + LDS_UTAB);
    MoeSched S{utab, (LAS const unsigned*)(lds0 + LDS_ROWTAB), n};
    pg8::Gemm g{(const bf16_t*)(p.ws + OFF_ACT), (const bf16_t*)(p.ws + OFF_WD)};
    EpiDown E{utab, p.ws};
    pg8::gemm_phase<FF, EpiDown, MoeSched, false>(lds0, g, S, E);
}

__device__ __forceinline__ void phase_combine(const Params& p, int c) {
    const int tid = TIDX;
    const bf16_t* SL = (const bf16_t*)(p.ws + OFF_SLOTS);
    bf16_t* FFN = (bf16_t*)(p.ws + OFF_H);
    for (int item = VBLK; item < T / 8; item += NVBLK) {
        const int t = item * 8 + (tid >> 5), cc = (tid & 31) * 8;
        float s[8];
#pragma unroll
        for (int i = 0; i < 8; ++i) s[i] = 0.f;
#pragma unroll
        for (int k = 0; k < NSLOT; ++k) {
            const u32x4 v = *(const u32x4*)(SL + (size_t)(t * NSLOT + k) * 256 + cc);
#pragma unroll
            for (int i = 0; i < 4; ++i) { s[2 * i] += bflo(v[i]); s[2 * i + 1] += bfhi(v[i]); }
        }
        *(u32x4*)(FFN + (size_t)t * D + c * 256 + cc) = (u32x4){pk2(s[0], s[1]), pk2(s[2], s[3]), pk2(s[4], s[5]), pk2(s[6], s[7])};
    }
}

__device__ __forceinline__ void phase_final(const Params& p) {
    const int lane = TIDX & 63, gw = VBLK * 4 + (TIDX >> 6), ngw = NVBLK * 4;
    const float* mod = (const float*)(p.ws + OFF_MOD);
    const bf16_t* FFN = (const bf16_t*)(p.ws + OFF_H);
    for (int row = gw; row < T; row += ngw) {
        const float* g2 = mod + (size_t)(row / SEQ) * MODW + 5 * D;
        f32x4 y[4]; float s = 0.f;
#pragma unroll
        for (int j = 0; j < 4; ++j) {
            const int c = 4 * lane + 256 * j;
            const f32x4 xm = *(const f32x4*)(p.out + (size_t)row * D + c), gg = *(const f32x4*)(g2 + c);
            const u32x2 f = *(const u32x2*)(FFN + (size_t)row * D + c);
            y[j][0] = ALPHA * xm[0] + gg[0] * bflo(f.x); y[j][1] = ALPHA * xm[1] + gg[1] * bfhi(f.x);
            y[j][2] = ALPHA * xm[2] + gg[2] * bflo(f.y); y[j][3] = ALPHA * xm[3] + gg[3] * bfhi(f.y);
            s += (y[j][0] + y[j][1]) + (y[j][2] + y[j][3]);
        }
#pragma unroll
        for (int o = 1; o < 64; o <<= 1) s += __shfl_xor(s, o);
        const float mean = s * (1.f / D);
        float q = 0.f;
#pragma unroll
        for (int j = 0; j < 4; ++j) { y[j] = y[j] - mean; q += (y[j][0] * y[j][0] + y[j][1] * y[j][1]) + (y[j][2] * y[j][2] + y[j][3] * y[j][3]); }
#pragma unroll
        for (int o = 1; o < 64; o <<= 1) q += __shfl_xor(q, o);
        const float rstd = 1.0f / sqrtf(q * (1.f / D) + 1e-5f);
#pragma unroll
        for (int j = 0; j < 4; ++j) {
            const int c = 4 * lane + 256 * j;
            const f32x4 g = *(const f32x4*)(p.ln2_g + c), bb = *(const f32x4*)(p.ln2_b + c);
            *(f32x4*)(p.out + (size_t)row * D + c) = y[j] * rstd * g + bb;
        }
    }
}


#define XB_TMO      128
#define XB_XCNT(j)  (256  + 64 * (j))
#define XB_XSUB(j)  (1280 + 64 * (j))
#define XB_XGEN(j)  (2304 + 64 * (j))
#define XB_TOP      3328
#define XB_TOPGEN   3392
#define XCD_BAR_WORDS 3456
#define XB_SPIN_CAP (1u << 18)
__device__ __forceinline__ unsigned xb_ld(unsigned* p)              { return __hip_atomic_load(p, __ATOMIC_RELAXED, __HIP_MEMORY_SCOPE_AGENT); }
__device__ __forceinline__ unsigned xb_add(unsigned* p, unsigned v) { return __hip_atomic_fetch_add(p, v, __ATOMIC_RELAXED, __HIP_MEMORY_SCOPE_AGENT); }
__device__ __forceinline__ unsigned xb_xcc_id() { return (unsigned)__builtin_amdgcn_s_getreg((3 << 11) | 20) & 0xFu; }
#define XB_SPIN(cond, bar) do { unsigned _sp = 0; while (cond) { __builtin_amdgcn_s_sleep(1); \
    if ((++_sp & 255u) == 0u) { if (xb_ld(&(bar)[XB_TMO])) break; if (_sp > XB_SPIN_CAP) { atomicAdd(&(bar)[XB_TMO], 1u); break; } } } } while (0)
struct XcdBarrier { unsigned* bar; unsigned x; volatile LAS unsigned* st; };
__device__ __forceinline__ XcdBarrier xcd_barrier_post(unsigned* bar, volatile LAS unsigned* st) {
    XcdBarrier b; b.bar = bar; b.x = xb_xcc_id(); b.st = st;
    if (threadIdx.x == 0) (void)xb_add(&bar[XB_XCNT(b.x)], 1u);
    return b;
}
__device__ __forceinline__ void xcd_barrier_complete(unsigned* bar, unsigned x, unsigned& nloc, unsigned& nx) {
    const unsigned G = gridDim.x * gridDim.y * gridDim.z;
    unsigned sum, cnt, mine, sp = 0u;
    for (;;) {
        sum = 0u; cnt = 0u; mine = 0u;
#pragma unroll
        for (unsigned j = 0; j < 16; ++j) { const unsigned c = xb_ld(&bar[XB_XCNT(j)]); sum += c; cnt += (c > 0u) ? 1u : 0u; mine = (j == x) ? c : mine; }
        if (sum == G) break;
        __builtin_amdgcn_s_sleep(1);
        if ((++sp & 255u) == 0u) { if (xb_ld(&bar[XB_TMO])) break; if (sp > XB_SPIN_CAP) { atomicAdd(&bar[XB_TMO], 1u); break; } }
    }
    nloc = mine > 0u ? mine : 1u; nx = cnt > 0u ? cnt : 1u;
}
__device__ __forceinline__ void xcd_barrier(const XcdBarrier& b) {
    asm volatile("s_waitcnt vmcnt(0)" ::: "memory");
    __syncthreads();
    if (threadIdx.x == 0) {
        unsigned* bar = b.bar;
        __builtin_amdgcn_s_waitcnt(0);
        unsigned nloc = b.st[0], nx = b.st[1];
        if (nloc == 0u) { xcd_barrier_complete(bar, b.x, nloc, nx); b.st[0] = nloc; b.st[1] = nx; }
        const unsigned old = xb_add(&bar[XB_XSUB(b.x)], 1u);
        const unsigned gen = old / nloc;
        if (old + 1u == (gen + 1u) * nloc) {
            __builtin_amdgcn_fence(__ATOMIC_RELEASE, "agent");
            asm volatile("s_waitcnt vmcnt(0)" ::: "memory");
            const unsigned og = xb_add(&bar[XB_TOP], 1u);
            const unsigned tg = og / nx;
            if (og + 1u == (tg + 1u) * nx) xb_add(&bar[XB_TOPGEN], 1u);
            else XB_SPIN(xb_ld(&bar[XB_TOPGEN]) == tg, bar);
            __builtin_amdgcn_fence(__ATOMIC_ACQUIRE, "agent");
            xb_add(&bar[XB_XGEN(b.x)], 1u);
            asm volatile("s_waitcnt vmcnt(0)" ::: "memory");
        } else {
            XB_SPIN(xb_ld(&bar[XB_XGEN(b.x)]) == gen, bar);
            __builtin_amdgcn_fence(__ATOMIC_ACQUIRE, "agent");
            asm volatile("s_waitcnt vmcnt(0)" ::: "memory");
        }
    }
    __syncthreads();
}

constexpr size_t OFF_BAR = 448 * 1024;

__global__ void __launch_bounds__(512, 2) mk_fwd(Params p) {
    extern __shared__ __attribute__((aligned(16))) unsigned char smem[];
    LAS unsigned char* lds0 = (LAS unsigned char*)smem;
    if (threadIdx.x < 64) ((LAS unsigned*)(lds0 + LDS_CTL))[threadIdx.x] = 0u;
    __syncthreads();
    XcdBarrier bar; bar.bar = (unsigned*)(p.ws + OFF_BAR); bar.x = 0; bar.st = nullptr;
    bar = xcd_barrier_post((unsigned*)(p.ws + OFF_BAR), (volatile LAS unsigned*)(lds0 + LDS_CTL));
#ifndef PROBE
#define PROBE -1
#endif
#ifndef PROBE_END
#define PROBE_END (PROBE + 1)
#endif
    unsigned long long pt0 = 0, pt1 = 0;
#define RUN_PHASE(k, call) { if ((k) > 0) xcd_barrier(bar); if (PROBE >= 0 && (k) == PROBE) pt0 = __builtin_amdgcn_s_memrealtime(); if (PROBE >= 0 && (k) == PROBE_END) pt1 = __builtin_amdgcn_s_memrealtime(); \
    int on_ = 1; asm volatile("" : "+s"(on_)); if (on_) { int grp_ = threadIdx.x >> 8; asm volatile("" : "+v"(grp_)); LAS unsigned char* lds = lds0 + grp_ * 32768; (void)lds; call; } }
    RUN_PHASE(0, phase_prep(p, lds))
    RUN_PHASE(1, phase_xn(p))
    RUN_PHASE(2, phase_inproj(p, lds0))
    RUN_PHASE(3, phase_attn_pool(p, lds, (char*)smem))
    RUN_PHASE(4, phase_outproj(p, lds0))
    RUN_PHASE(5, phase_router(p, lds0))
    RUN_PHASE(6, phase_gateup(p, lds0))
    RUN_PHASE(7, phase_down(p, lds0, 0))
    RUN_PHASE(8, phase_combine(p, 0))
    RUN_PHASE(9, phase_down(p, lds0, 1))
    RUN_PHASE(10, phase_combine(p, 1))
    RUN_PHASE(11, phase_down(p, lds0, 2))
    RUN_PHASE(12, phase_combine(p, 2))
    RUN_PHASE(13, phase_down(p, lds0, 3))
    RUN_PHASE(14, phase_combine(p, 3))
    RUN_PHASE(15, phase_final(p))
    if (PROBE >= 0) {
        if (PROBE_END == 16) pt1 = __builtin_amdgcn_s_memrealtime();
        if (blockIdx.x == 0 && threadIdx.x == 0) { const unsigned long long tend = __builtin_amdgcn_s_memrealtime() + 8ull * (pt1 - pt0); while (__builtin_amdgcn_s_memrealtime() < tend) __builtin_amdgcn_s_sleep(8); }
    }
}

extern "C" void kernel_launch(void* const* d_in, const int* in_sizes, int n_in, void* d_out, int out_size, void* d_ws, size_t ws_size, hipStream_t stream) {
    static int grid = 0;
    if (grid == 0) {
        int dev = 0, cus = 0, per_cu = 0;
        (void)hipGetDevice(&dev);
        (void)hipDeviceGetAttribute(&cus, hipDeviceAttributeMultiprocessorCount, dev);
        (void)hipFuncSetAttribute((const void*)mk_fwd, hipFuncAttributeMaxDynamicSharedMemorySize, LDS_BYTES);
        (void)hipOccupancyMaxActiveBlocksPerMultiprocessor(&per_cu, (const void*)mk_fwd, 512, LDS_BYTES);
        if (per_cu < 1) fprintf(stderr, "kernel_launch: occupancy query says %d blocks per CU\n", per_cu);
        (void)hipGetLastError();
        grid = cus;
        if (ws_size < WS_NEED) fprintf(stderr, "kernel_launch: workspace too small: %zu < %zu\n", ws_size, (size_t)WS_NEED);
    }
    Params p{};
    const float** pp = (const float**)&p;
    for (int i = 0; i < 24; ++i) pp[i] = (const float*)d_in[i];
    p.out = (float*)d_out; p.ws = (unsigned char*)d_ws;
    (void)hipMemsetAsync((char*)d_ws + OFF_BAR, 0, XCD_BAR_WORDS * 4, stream);
    hipLaunchKernelGGL(mk_fwd, dim3(grid), dim3(512), LDS_BYTES, stream, p);
}
```

```cpp
#include <hip/hip_runtime.h>
#include <stdint.h>
#include <stdio.h>


#define LAS __attribute__((address_space(3)))
#define TIDX ((int)(hw_tid() & 255))
#define VBLK ((int)(blockIdx.x * 2 + (hw_tid() >> 8)))
#define NVBLK ((int)(gridDim.x * 2))
typedef unsigned short bf16_t;
typedef short bf16x8 __attribute__((ext_vector_type(8)));
typedef float f32x4 __attribute__((ext_vector_type(4)));
typedef unsigned u32x4 __attribute__((ext_vector_type(4)));
typedef unsigned u32x2 __attribute__((ext_vector_type(2)));

constexpr int D = 1024, NB = 16, SEQ = 2048, T = NB * SEQ, CTXL = 256, TC = NB * CTXL, KVL = CTXL + SEQ;
constexpr int PW = 1536, NE = 64, NEX = 65, FF = 256, NSLOT = 9, MODW = 6 * D;
constexpr float ALPHA = 1.189207115002721f;
constexpr float C2 = 0.125f * 1.4426950408889634f;
constexpr int NPHASE = 11;
constexpr int LDS_BYTES = 147456, LDS_CTL = 143360;
constexpr int LDS_HWTAB = LDS_CTL + 1024;
__device__ __forceinline__ int hw_tid() {
    const unsigned hw = (unsigned)__builtin_amdgcn_s_getreg((5 << 11) | 4) & 63u;
    const int w = __builtin_amdgcn_readfirstlane(*(volatile LAS int*)(LDS_HWTAB + hw * 4));
    return w * 64 + (int)__builtin_amdgcn_mbcnt_hi(~0u, __builtin_amdgcn_mbcnt_lo(~0u, 0u));
}

constexpr size_t MiB = 1u << 20;
constexpr size_t OFF_CNT = 0, OFF_MOD = 4096, OFF_ROPE = 512 * 1024;
constexpr size_t OFF_WRH = 483 * MiB, OFF_WRL = OFF_WRH + 128 * 1024;
constexpr size_t OFF_WTIN = 1 * MiB, OFF_WTOUT = 4 * MiB, OFF_WGU = 6 * MiB, OFF_WD = 71 * MiB;
constexpr size_t OFF_H = 104 * MiB, OFF_LDST = 168 * MiB, OFF_LW = 176 * MiB, OFF_ACT = 184 * MiB, OFF_SLOTS = 338 * MiB;
constexpr size_t OFF_XN = 184 * MiB, OFF_Q = 256 * MiB, OFF_K = 304 * MiB, OFF_V = 322 * MiB, OFF_U = 340 * MiB, OFF_AO = 356 * MiB, OFF_STATS = 420 * MiB;
constexpr size_t WS_NEED = 484 * MiB;

struct Params {
    const float *x, *c, *ctx, *c_ctx, *w_mod, *b_mod, *w_in, *q_norm, *k_norm, *pool_w, *pool_scale, *w_out, *ln1_g, *ln1_b,
        *w_router, *router_bias, *w_gate, *w_up, *w_down, *ws_gate, *ws_up, *ws_down, *ln2_g, *ln2_b;
    float* out;
    unsigned char* ws;
};

__device__ __forceinline__ unsigned f2bf(float f) { unsigned u = __float_as_uint(f); return (u + 0x7fffu + ((u >> 16) & 1u)) >> 16; }
__device__ __forceinline__ unsigned pk2(float lo, float hi) { return f2bf(lo) | (f2bf(hi) << 16); }
__device__ __forceinline__ float bf2f(unsigned h) { return __uint_as_float(h << 16); }
__device__ __forceinline__ float bflo(unsigned w) { return __uint_as_float(w << 16); }
__device__ __forceinline__ float bfhi(unsigned w) { return __uint_as_float(w & 0xffff0000u); }

namespace pg8 {
constexpr int BM = 256, BK = 64, HALF = 128, HTB = HALF * BK * 2, STAGE_BYTES = 8 * HTB;
__host__ __device__ __forceinline__ int lds_byte(int r, int c) { const int st = (r >> 4) * 2 + (c >> 5), rr = r & 15, cc = c & 31, ob = rr * 64 + cc * 2; return st * 1024 + (ob ^ (((ob >> 9) & 1) << 5)); }
__host__ __device__ __forceinline__ void stage_rc(int b, int& R, int& C) { const int st = b / 1024, sb = b % 1024, swz = sb ^ (((sb >> 9) & 1) << 5); R = (st >> 1) * 16 + swz / 64; C = (st & 1) * 32 + (swz % 64) / 2; }
__host__ __device__ __forceinline__ int perm32(int rho) { const int n = rho >> 4, i = rho & 15; return 8 * (i >> 2) + 4 * n + (i & 3); }
struct Unit { int pm, pn, idx, e; };
struct Gemm { const bf16_t* A; const bf16_t* Bt; };
__device__ __forceinline__ unsigned cvt_pk_bf16(float lo, float hi) { unsigned r; asm volatile("v_cvt_pk_bf16_f32 %0, %1, %2" : "=v"(r) : "v"(lo), "v"(hi)); return r; }

template <int K, class Epi, class Sched, bool GATHER, bool ALIGN_EPI = true>
__device__ __forceinline__ void gemm_phase(LAS unsigned char* lds, const Gemm g, const Sched& S, const Epi& E) {
    const int tid = hw_tid(), wid = __builtin_amdgcn_readfirstlane(tid >> 6), lane = tid & 63, wr = wid >> 2, wc = wid & 3, fr = lane & 15, fq = lane >> 4;
    constexpr int nt = K / BK;
    unsigned voffA[2], voffB[2], colA = 0; int rowA = 0;
#pragma unroll
    for (int i = 0; i < 2; ++i) { int R, C; stage_rc(tid * 16 + i * 8192, R, C); const int Rb = Epi::PERM ? ((R & ~31) + perm32(R & 31)) : R;
        voffA[i] = (unsigned)(R * K + C) * 2u; voffB[i] = (unsigned)(Rb * K + C) * 2u; if (i == 0) { colA = (unsigned)C * 2u; rowA = R; } }
    const size_t kstep = (size_t)(BK * 2);
    const size_t hstep = (size_t)HALF * K * 2;
    const size_t tstep = 2 * hstep;
    const unsigned ldsw = (unsigned)wid * 1024u;
    const int aoff = lds_byte(wr * 64 + fr, fq * 8), boff = lds_byte(wc * 32 + fr, fq * 8);
#define PG8_SA(b, h) (((b) * 2 + (h)) * HTB)
#define PG8_SB(b, h) ((4 + (b) * 2 + (h)) * HTB)
#define PG8_STAGE(bufoff, gbase, voff) do { _Pragma("unroll") for (int _i = 0; _i < 2; ++_i) \
        __builtin_amdgcn_global_load_lds((const unsigned*)((const char*)(gbase) + (voff)[_i]), (LAS unsigned*)(lds + (bufoff) + ldsw + _i * 8192), 16, 0, 0); } while (0)
#define PG8_STAGE_A(bufoff, ptr, h, NX) do { if constexpr (GATHER) { unsigned _v[2]; \
            if (NX) { _v[0] = S.row_off(nidx, (h) * HALF + rowA) + colA; _v[1] = S.row_off(nidx, (h) * HALF + rowA + 64) + colA; } else { _v[0] = vA[h][0]; _v[1] = vA[h][1]; } PG8_STAGE(bufoff, ptr, _v); } \
        else { PG8_STAGE(bufoff, (ptr) + (h) * hstep, voffA); } } while (0)
#define PG8_LDA(dst, b, h) do { _Pragma("unroll") for (int m = 0; m < 4; ++m) _Pragma("unroll") for (int k = 0; k < 2; ++k) dst[m][k] = *(const LAS bf16x8*)(lds + PG8_SA(b, h) + aoff + m * 2048 + k * 1024); } while (0)
#define PG8_LDB(dst, b, h) do { _Pragma("unroll") for (int n = 0; n < 2; ++n) _Pragma("unroll") for (int k = 0; k < 2; ++k) dst[n][k] = *(const LAS bf16x8*)(lds + PG8_SB(b, h) + boff + n * 2048 + k * 1024); } while (0)
#define PG8_MMA(ai, bj, At, Bt) do { __builtin_amdgcn_s_setprio(1); _Pragma("unroll") for (int m = 0; m < 4; ++m) _Pragma("unroll") for (int n = 0; n < 2; ++n) _Pragma("unroll") for (int k = 0; k < 2; ++k) \
        acc[ai][bj][m][n] = __builtin_amdgcn_mfma_f32_16x16x32_bf16(Bt[n][k], At[m][k], acc[ai][bj][m][n], 0, 0, 0); __builtin_amdgcn_s_setprio(0); } while (0)
#define PG8_WAIT_V(n) asm volatile("s_waitcnt vmcnt(" #n ")" ::: "memory")
#define PG8_WAIT_L(n) asm volatile("s_waitcnt lgkmcnt(" #n ")" ::: "memory")
#define PG8_BAR __builtin_amdgcn_s_barrier()
#define PG8_SCHED __builtin_amdgcn_sched_barrier(0)
    Unit cur, nxt; int ui = 0;
    if (!S.next(0, cur)) return;
    f32x4 acc[2][2][4][2];
#pragma unroll
    for (int a = 0; a < 2; ++a)
#pragma unroll
        for (int b = 0; b < 2; ++b)
#pragma unroll
            for (int m = 0; m < 4; ++m)
#pragma unroll
                for (int n = 0; n < 2; ++n) acc[a][b][m][n] = (f32x4){0.f, 0.f, 0.f, 0.f};
    bf16x8 At[4][2], B0[2][2], B1[2][2];
    unsigned vA[2][2]; int nidx = 0;
    if constexpr (GATHER) {
#pragma unroll
        for (int h = 0; h < 2; ++h)
#pragma unroll
            for (int i = 0; i < 2; ++i) vA[h][i] = S.row_off(cur.idx, h * HALF + rowA + 64 * i) + colA;
    }
    const char* cA = GATHER ? (const char*)g.A : (const char*)g.A + (size_t)cur.pm * tstep; const char* cB = (const char*)g.Bt + (size_t)cur.pn * tstep;
    S.a_ready(cur);
    PG8_STAGE(PG8_SB(0, 0), cB, voffB); PG8_STAGE(PG8_SB(0, 1), cB + hstep, voffB); PG8_STAGE_A(PG8_SA(0, 0), cA, 0, false); PG8_STAGE_A(PG8_SA(0, 1), cA, 1, false);
    if (wr == 1) PG8_BAR;
    PG8_WAIT_V(2); PG8_BAR;
    PG8_STAGE(PG8_SB(1, 0), cB + kstep, voffB); PG8_STAGE_A(PG8_SA(1, 0), cA + kstep, 0, false); PG8_STAGE(PG8_SB(1, 1), cB + hstep + kstep, voffB);
    PG8_WAIT_V(6); PG8_BAR;
    for (;;) {
        const bool has_next = S.next(ui + 1, nxt);
        if constexpr (GATHER) nidx = has_next ? nxt.idx : cur.idx;
        const char* nA = GATHER ? (const char*)g.A : (has_next ? (const char*)g.A + (size_t)nxt.pm * tstep : cA); const char* nB = has_next ? (const char*)g.Bt + (size_t)nxt.pn * tstep : cB;
        for (int t = 0; t < nt; t += 2) {
            const bool last = (t == nt - 2);
            const char* a1 = cA + (size_t)(t + 1) * kstep;
            const char* a2 = last ? nA : cA + (size_t)(t + 2) * kstep; const char* b2 = last ? nB : cB + (size_t)(t + 2) * kstep;
            const char* a3 = a2 + kstep; const char* b3 = b2 + kstep;
            if (last && has_next) S.a_ready(nxt);
            PG8_LDB(B0, 0, 0); PG8_LDB(B1, 0, 1); PG8_SCHED; PG8_LDA(At, 0, 0); PG8_STAGE_A(PG8_SA(1, 1), a1, 1, false);
            PG8_WAIT_V(8); PG8_WAIT_L(0); PG8_BAR; PG8_MMA(0, 0, At, B0); PG8_MMA(0, 1, At, B1); PG8_BAR; PG8_SCHED;
            PG8_LDA(At, 0, 1); PG8_STAGE(PG8_SB(0, 0), b2, voffB); PG8_STAGE(PG8_SB(0, 1), b2 + hstep, voffB); PG8_STAGE_A(PG8_SA(0, 0), a2, 0, last);
            PG8_WAIT_V(8); PG8_WAIT_L(0); PG8_BAR; PG8_MMA(1, 0, At, B0); PG8_MMA(1, 1, At, B1); PG8_BAR; PG8_SCHED;
            PG8_LDB(B0, 1, 0); PG8_LDB(B1, 1, 1); PG8_SCHED; PG8_LDA(At, 1, 0); PG8_STAGE_A(PG8_SA(0, 1), a2, 1, last);
            PG8_WAIT_V(8); PG8_WAIT_L(0); PG8_BAR; PG8_MMA(0, 0, At, B0); PG8_MMA(0, 1, At, B1); PG8_BAR; PG8_SCHED;
            PG8_LDA(At, 1, 1); PG8_STAGE(PG8_SB(1, 0), b3, voffB); PG8_STAGE(PG8_SB(1, 1), b3 + hstep, voffB); PG8_STAGE_A(PG8_SA(1, 0), a3, 0, last);
            PG8_WAIT_V(8); PG8_WAIT_L(0); PG8_BAR; PG8_MMA(1, 0, At, B0); PG8_MMA(1, 1, At, B1); PG8_BAR; PG8_SCHED;
        }
        if constexpr (ALIGN_EPI) { if (wr == 0) PG8_BAR; }
        E(acc, cur, wr, wc, fr, fq); S.done(cur);
        if (!has_next) break;
#pragma unroll
        for (int a = 0; a < 2; ++a)
#pragma unroll
            for (int b = 0; b < 2; ++b)
#pragma unroll
                for (int m = 0; m < 4; ++m)
#pragma unroll
                    for (int n = 0; n < 2; ++n) acc[a][b][m][n] = (f32x4){0.f, 0.f, 0.f, 0.f};
        cur = nxt; cA = nA; cB = nB; ++ui;
        if constexpr (GATHER) {
#pragma unroll
            for (int h = 0; h < 2; ++h)
#pragma unroll
                for (int i = 0; i < 2; ++i) vA[h][i] = S.row_off(cur.idx, h * HALF + rowA + 64 * i) + colA;
        }
        if constexpr (ALIGN_EPI) { if (wr == 1) PG8_BAR; }
    }
    PG8_WAIT_V(0);
    if constexpr (!ALIGN_EPI) { if (wr == 0) PG8_BAR; }
    PG8_BAR;
#undef PG8_SA
#undef PG8_SB
#undef PG8_STAGE
#undef PG8_STAGE_A
#undef PG8_LDA
#undef PG8_LDB
#undef PG8_MMA
#undef PG8_WAIT_V
#undef PG8_WAIT_L
#undef PG8_BAR
#undef PG8_SCHED
}

struct DenseSched {
    int nN, n1, total, pn2lo, nN2, G, c;
    __device__ __forceinline__ bool next(int i, Unit& u) const {
        const int L = i * G + c; if (L >= total) return false;
        if (L < n1) { u.pm = L / nN; u.pn = L % nN; } else { const int r = L - n1; u.pm = n1 / nN + r / nN2; u.pn = pn2lo + r % nN2; }
        u.idx = i; u.e = 0; return true;
    }
    __device__ __forceinline__ void a_ready(const Unit&) const {}
    __device__ __forceinline__ void done(const Unit&) const {}
};
}

__device__ __forceinline__ int win_row(int n) { return (n & ~255) + 128 * ((n >> 5) & 1) + 32 * ((n >> 6) & 3) + (n & 31); }
__device__ __forceinline__ int gu_row(int j, int half) { return (j >> 7) * 256 + half * 128 + (j & 127); }

template <class RowMap>
__device__ __forceinline__ void transpose_tile(LAS float* tile, const float* src, int ld, int k0, int n0, bf16_t* dst, int Kdst, RowMap rowmap) {
    const int tid = TIDX;
#pragma unroll
    for (int pss = 0; pss < 4; ++pss) {
        const int k = pss * 16 + (tid >> 4), n4 = (tid & 15) * 4;
        const f32x4 v = *(const f32x4*)(src + (size_t)(k0 + k) * ld + n0 + n4);
        tile[k * 65 + n4 + 0] = v[0]; tile[k * 65 + n4 + 1] = v[1]; tile[k * 65 + n4 + 2] = v[2]; tile[k * 65 + n4 + 3] = v[3];
    }
    __syncthreads();
    {
        const int n = tid >> 2, kc = (tid & 3) * 16;
        unsigned w[8];
#pragma unroll
        for (int i = 0; i < 8; ++i) w[i] = pk2(tile[(kc + 2 * i) * 65 + n], tile[(kc + 2 * i + 1) * 65 + n]);
        bf16_t* dp = dst + (size_t)rowmap(n0 + n) * Kdst + k0 + kc;
        *(u32x4*)dp = (u32x4){w[0], w[1], w[2], w[3]};
        *(u32x4*)(dp + 8) = (u32x4){w[4], w[5], w[6], w[7]};
    }
    __syncthreads();
}

__device__ __forceinline__ void phase_prep(const Params& p, LAS unsigned char* lds) {
    const int tid = TIDX;
    int* gcnt = (int*)(p.ws + OFF_CNT);
    if (VBLK == 0 && tid < 128) gcnt[tid] = 0;
    float* mod = (float*)(p.ws + OFF_MOD);
    float* rope = (float*)(p.ws + OFF_ROPE);
    constexpr int N_MOD = 192, N_ROPE = 256, N_TR = 384 + 256 + NEX * 192 + 16;
    for (int it = VBLK; it < N_MOD + N_ROPE + N_TR; it += NVBLK) {
        if (it < N_MOD) {
            LAS float* sl = (LAS float*)lds;
            LAS float* red = (LAS float*)(lds + 10240);
            const int col = it * 32 + (tid & 31), kk = tid >> 5;
            float acc[17];
#pragma unroll
            for (int r = 0; r < 17; ++r) acc[r] = 0.f;
            for (int kc = 0; kc < 8; ++kc) {
                __syncthreads();
                for (int o = tid; o < 17 * 128; o += 256) {
                    const int r = o >> 7, kl = o & 127;
                    const float cv = (r < 16) ? p.c[r * D + kc * 128 + kl] : p.c_ctx[kc * 128 + kl];
                    sl[kl * 20 + r] = cv / (1.f + expf(-cv));
                }
                __syncthreads();
#pragma unroll 4
                for (int i = 0; i < 16; ++i) {
                    const int kl = kk + 8 * i;
                    const float wv = p.w_mod[(size_t)(kc * 128 + kl) * MODW + col];
                    const f32x4 s0 = *(const LAS f32x4*)(sl + kl * 20), s1 = *(const LAS f32x4*)(sl + kl * 20 + 4), s2 = *(const LAS f32x4*)(sl + kl * 20 + 8), s3 = *(const LAS f32x4*)(sl + kl * 20 + 12);
                    const float s4 = sl[kl * 20 + 16];
#pragma unroll
                    for (int q = 0; q < 4; ++q) { acc[q] += s0[q] * wv; acc[4 + q] += s1[q] * wv; acc[8 + q] += s2[q] * wv; acc[12 + q] += s3[q] * wv; }
                    acc[16] += s4 * wv;
                }
            }
#pragma unroll
            for (int r = 0; r < 17; ++r) red[(kk * 17 + r) * 32 + (tid & 31)] = acc[r];
            __syncthreads();
            for (int o = tid; o < 17 * 32; o += 256) {
                const int r = o >> 5, j = o & 31;
                float sm = p.b_mod[it * 32 + j];
#pragma unroll
                for (int g = 0; g < 8; ++g) sm += red[(g * 17 + r) * 32 + j];
                mod[r * MODW + it * 32 + j] = sm;
            }
            __syncthreads();
        } else if (it < N_MOD + N_ROPE) {
            const int idx = (it - N_MOD) * 256 + tid, t = idx >> 5, i = idx & 31;
            const int pos = (i < 16) ? (t >> 6) : (t & 63);
            const float invf = (float)exp(-(double)(i & 15) / 16.0 * 9.210340371976184);
            const double ang = (double)((float)pos * invf);
            rope[idx * 2 + 0] = (float)cos(ang);
            rope[idx * 2 + 1] = (float)sin(ang);
        } else {
            LAS float* tile = (LAS float*)lds;
            int idx = it - N_MOD - N_ROPE;
            if (idx < 384) {
                transpose_tile(tile, p.w_in, PW, (idx / 24) * 64, (idx % 24) * 64, (bf16_t*)(p.ws + OFF_WTIN), D, [](int n) { return win_row(n); });
            } else if (idx < 640) {
                idx -= 384;
                transpose_tile(tile, p.w_out, D, (idx / 16) * 64, (idx % 16) * 64, (bf16_t*)(p.ws + OFF_WTOUT), D, [](int n) { return n; });
            } else if (idx >= 640 + NEX * 192) {
                const int k0 = (idx - 640 - NEX * 192) * 64;
#pragma unroll
                for (int pss = 0; pss < 4; ++pss) {
                    const int k = pss * 16 + (tid >> 4), n4 = (tid & 15) * 4;
                    const f32x4 v = *(const f32x4*)(p.w_router + (size_t)(k0 + k) * NE + n4);
                    tile[k * 65 + n4 + 0] = v[0]; tile[k * 65 + n4 + 1] = v[1]; tile[k * 65 + n4 + 2] = v[2]; tile[k * 65 + n4 + 3] = v[3];
                }
                __syncthreads();
                {
                    const int n = tid >> 2, kc = (tid & 3) * 16;
                    unsigned wh[8], wl[8];
#pragma unroll
                    for (int i = 0; i < 8; ++i) {
                        const float a = tile[(kc + 2 * i) * 65 + n], b = tile[(kc + 2 * i + 1) * 65 + n];
                        const unsigned ha = f2bf(a), hb = f2bf(b);
                        wh[i] = ha | (hb << 16);
                        wl[i] = pk2(a - bf2f(ha), b - bf2f(hb));
                    }
                    bf16_t* dh = (bf16_t*)(p.ws + OFF_WRH) + (size_t)n * D + k0 + kc;
                    bf16_t* dl = (bf16_t*)(p.ws + OFF_WRL) + (size_t)n * D + k0 + kc;
                    *(u32x4*)dh = (u32x4){wh[0], wh[1], wh[2], wh[3]}; *(u32x4*)(dh + 8) = (u32x4){wh[4], wh[5], wh[6], wh[7]};
                    *(u32x4*)dl = (u32x4){wl[0], wl[1], wl[2], wl[3]}; *(u32x4*)(dl + 8) = (u32x4){wl[4], wl[5], wl[6], wl[7]};
                }
                __syncthreads();
            } else {
                idx -= 640;
                const int e = idx / 192, r = idx % 192;
                if (r < 128) {
                    const int half = r >> 6, rr = r & 63;
                    const float* src = half ? (e < NE ? p.w_up + (size_t)e * D * FF : p.ws_up) : (e < NE ? p.w_gate + (size_t)e * D * FF : p.ws_gate);
                    transpose_tile(tile, src, FF, (rr / 4) * 64, (rr % 4) * 64, (bf16_t*)(p.ws + OFF_WGU) + (size_t)e * 512 * D, D, [half](int n) { return gu_row(n, half); });
                } else {
                    const int rr = r - 128;
                    const float* src = e < NE ? p.w_down + (size_t)e * FF * D : p.ws_down;
                    transpose_tile(tile, src, D, (rr / 16) * 64, (rr % 16) * 64, (bf16_t*)(p.ws + OFF_WD) + (size_t)e * D * FF, FF, [](int n) { return n; });
                }
            }
        }
    }
}

__device__ __forceinline__ void phase_xn(const Params& p) {
    const int lane = TIDX & 63, gw = VBLK * 4 + (TIDX >> 6), ngw = NVBLK * 4;
    const float* mod = (const float*)(p.ws + OFF_MOD);
    bf16_t* XN = (bf16_t*)(p.ws + OFF_XN);
    for (int row = gw; row < T + TC; row += ngw) {
        const float* src = row < T ? p.x + (size_t)row * D : p.ctx + (size_t)(row - T) * D;
        const float* mr = mod + (size_t)(row < T ? row / SEQ : 16) * MODW;
#pragma unroll
        for (int j = 0; j < 4; ++j) {
            const int c = 4 * lane + 256 * j;
            const f32x4 v = *(const f32x4*)(src + c), sh = *(const f32x4*)(mr + c), sc = *(const f32x4*)(mr + D + c);
            u32x2 o; o.x = pk2(v[0] * (1.f + sc[0]) + sh[0], v[1] * (1.f + sc[1]) + sh[1]); o.y = pk2(v[2] * (1.f + sc[2]) + sh[2], v[3] * (1.f + sc[3]) + sh[3]);
            *(u32x2*)(XN + (size_t)row * D + c) = o;
        }
    }
}

struct EpiIn {
    static constexpr bool PERM = true;
    const float *q_norm, *k_norm, *rope; bf16_t *Qb, *Kb, *Vb, *Ub;
    __device__ __forceinline__ void operator()(const f32x4 (&acc)[2][2][4][2], const pg8::Unit& u, int wr, int wc, int fr, int fq) const {
        const int grp = u.pn * 4 + wc;
        const bool is_ctx = u.pm >= T / 256;
        f32x4 gn[2][2];
        if (grp >= 4 && grp < 20) {
            const float* g = grp < 16 ? q_norm : k_norm;
#pragma unroll
            for (int bj = 0; bj < 2; ++bj)
#pragma unroll
                for (int n = 0; n < 2; ++n) gn[bj][n] = *(const f32x4*)(g + 32 * bj + 8 * fq + 4 * n);
        }
#pragma unroll
        for (int ai = 0; ai < 2; ++ai)
#pragma unroll
            for (int m = 0; m < 4; ++m) {
                const int row = u.pm * 256 + ai * 128 + wr * 64 + m * 16 + fr;
                f32x4 v[2][2];
#pragma unroll
                for (int bj = 0; bj < 2; ++bj)
#pragma unroll
                    for (int n = 0; n < 2; ++n) v[bj][n] = acc[ai][bj][m][n];
                bf16_t* dst;
                if (grp < 4) dst = Ub + (size_t)row * 256 + grp * 64;
                else if (grp < 16) dst = Qb + (size_t)row * 768 + (grp - 4) * 64;
                else {
                    const size_t krow = is_ctx ? (size_t)((row - T) >> 8) * KVL + ((row - T) & 255) : (size_t)(row >> 11) * KVL + CTXL + (row & (SEQ - 1));
                    dst = (grp < 20 ? Kb + (grp - 16) * 64 : Vb + (grp - 20) * 64) + krow * 256;
                }
                if (grp >= 4 && grp < 20) {
                    float ss = 0.f;
#pragma unroll
                    for (int bj = 0; bj < 2; ++bj)
#pragma unroll
                        for (int n = 0; n < 2; ++n) ss += (v[bj][n][0] * v[bj][n][0] + v[bj][n][1] * v[bj][n][1]) + (v[bj][n][2] * v[bj][n][2] + v[bj][n][3] * v[bj][n][3]);
                    ss += __shfl_xor(ss, 16); ss += __shfl_xor(ss, 32);
                    const float rs = 1.0f / sqrtf(ss * (1.f / 64.f) + 1e-6f);
#pragma unroll
                    for (int bj = 0; bj < 2; ++bj)
#pragma unroll
                        for (int n = 0; n < 2; ++n) v[bj][n] = v[bj][n] * rs * gn[bj][n];
                    if (!is_ctx) {
                        const int tpos = row & (SEQ - 1);
#pragma unroll
                        for (int bj = 0; bj < 2; ++bj)
#pragma unroll
                            for (int n = 0; n < 2; ++n) {
                                const f32x4 cs = *(const f32x4*)(rope + (size_t)(tpos * 32 + 16 * bj + 4 * fq + 2 * n) * 2);
                                const f32x4 x = v[bj][n];
                                v[bj][n] = (f32x4){x[0] * cs[0] - x[1] * cs[1], x[0] * cs[1] + x[1] * cs[0], x[2] * cs[2] - x[3] * cs[3], x[2] * cs[3] + x[3] * cs[2]};
                            }
                    }
                    if (grp < 16) {
#pragma unroll
                        for (int bj = 0; bj < 2; ++bj)
#pragma unroll
                            for (int n = 0; n < 2; ++n) v[bj][n] = v[bj][n] * C2;
                    }
                }
#pragma unroll
                for (int bj = 0; bj < 2; ++bj) {
                    u32x4 w; w.x = pk2(v[bj][0][0], v[bj][0][1]); w.y = pk2(v[bj][0][2], v[bj][0][3]); w.z = pk2(v[bj][1][0], v[bj][1][1]); w.w = pk2(v[bj][1][2], v[bj][1][3]);
                    *(u32x4*)(dst + 32 * bj + 8 * fq) = w;
                }
            }
    }
};
__device__ __forceinline__ int vcu_of_block() { const int G = gridDim.x, bx = blockIdx.x; return (G % 8 == 0) ? (bx % 8) * (G / 8) + bx / 8 : bx; }
__device__ __forceinline__ void phase_inproj(const Params& p, LAS unsigned char* lds) {
    pg8::Gemm g{(const bf16_t*)(p.ws + OFF_XN), (const bf16_t*)(p.ws + OFF_WTIN)};
    pg8::DenseSched S{6, 768, 800, 4, 2, (int)gridDim.x, vcu_of_block()};
    EpiIn E{p.q_norm, p.k_norm, (const float*)(p.ws + OFF_ROPE), (bf16_t*)(p.ws + OFF_Q), (bf16_t*)(p.ws + OFF_K), (bf16_t*)(p.ws + OFF_V), (bf16_t*)(p.ws + OFF_U)};
    pg8::gemm_phase<D, EpiIn, pg8::DenseSched, false>(lds, g, S, E);
}

namespace attn_body {
using bf16=unsigned short;
using bf16x8=__attribute__((ext_vector_type(8)))short;
using s16x4=__attribute__((ext_vector_type(4)))short;
using f32x16=__attribute__((ext_vector_type(16)))float;
using u32x4=__attribute__((ext_vector_type(4)))unsigned;
constexpr int D=64,QP=768,KP=256,OP=1024,SEQ=2048,KVLEN=2304;
constexpr int NW=8,QBLK=32,QB=QBLK*NW,KVBLK=64,NT=KVLEN/KVBLK;
__device__ __forceinline__ int crow(int r,int hi){return (r&3)+8*(r>>2)+4*hi;}
#define SBAR() __builtin_amdgcn_sched_barrier(0)
constexpr int NSLOT=3, SLOTB=8192;
constexpr int LDS_K=0, LDS_V=NSLOT*SLOTB, LDS_WS=2*NSLOT*SLOTB, LDS_OST=LDS_WS+NW*64*4, LDS_BYTES=LDS_OST+NW*4096;
constexpr float C2=0.125f*1.4426950408889634f;
__device__ __forceinline__ void glds16(const void*gsrc,unsigned lds_dst){unsigned keep;
  asm volatile("s_mov_b32 %0, m0\n\ts_mov_b32 m0, %2\n\ts_nop 0\n\tglobal_load_lds_dwordx4 %1, off\n\ts_mov_b32 m0, %0":"=&s"(keep):"v"(gsrc),"s"(lds_dst):"memory");}
__device__ __forceinline__ float max3f(float a,float b,float c){float r;asm("v_max3_f32 %0, %1, %2, %3":"=v"(r):"v"(a),"v"(b),"v"(c));return r;}
__device__ __forceinline__ float max2f(float a,float b){float r;asm("v_max_f32_e32 %0, %1, %2":"=v"(r):"v"(a),"v"(b));return r;}
__device__ __forceinline__ float fadd_s(float a,float b){float r;asm("v_add_f32_e32 %0, %1, %2":"=v"(r):"v"(a),"v"(b));return r;}
__device__ __forceinline__ float fsub_s(float a,float b){float r;asm("v_sub_f32_e32 %0, %1, %2":"=v"(r):"v"(a),"v"(b));return r;}
typedef float f32x2_t __attribute__((ext_vector_type(2))); typedef __bf16 bf16x2_t __attribute__((ext_vector_type(2)));
__device__ __forceinline__ unsigned cvtpk_s(float lo,float hi){f32x2_t v={lo,hi};bf16x2_t b=__builtin_convertvector(v,bf16x2_t);return __builtin_bit_cast(unsigned,b);}
#define WAIT_BAR(N) asm volatile("s_waitcnt vmcnt(" #N ") lgkmcnt(0)\n\ts_barrier":::"memory")

__device__ __forceinline__ void qkt(f32x16&p0,f32x16&p1,const char*Kslot,const bf16x8*qr,const f32x16&negm,int r32,int hi){
  const char*kb=Kslot+hi*1024+r32*16;
  #pragma unroll
  for(int d0=0;d0<4;++d0){
    const bf16x8 b0=*reinterpret_cast<const bf16x8*>(kb+d0*2048);
    const bf16x8 b1=*reinterpret_cast<const bf16x8*>(kb+d0*2048+512);
    if(d0==0){p0=__builtin_amdgcn_mfma_f32_32x32x16_bf16(b0,qr[0],negm,0,0,0);p1=__builtin_amdgcn_mfma_f32_32x32x16_bf16(b1,qr[0],negm,0,0,0);}
    else{p0=__builtin_amdgcn_mfma_f32_32x32x16_bf16(b0,qr[d0],p0,0,0,0);p1=__builtin_amdgcn_mfma_f32_32x32x16_bf16(b1,qr[d0],p1,0,0,0);}}
}
typedef __attribute__((address_space(3))) const char* lds_cptr;
typedef short v4i16_t __attribute__((ext_vector_type(4)));
__device__ __forceinline__ void kload8(bf16x8*kf,lds_cptr kp){
  kf[0]=*(const __attribute__((address_space(3))) bf16x8*)(kp);      kf[1]=*(const __attribute__((address_space(3))) bf16x8*)(kp+512);
  kf[2]=*(const __attribute__((address_space(3))) bf16x8*)(kp+2048); kf[3]=*(const __attribute__((address_space(3))) bf16x8*)(kp+2560);
  kf[4]=*(const __attribute__((address_space(3))) bf16x8*)(kp+4096); kf[5]=*(const __attribute__((address_space(3))) bf16x8*)(kp+4608);
  kf[6]=*(const __attribute__((address_space(3))) bf16x8*)(kp+6144); kf[7]=*(const __attribute__((address_space(3))) bf16x8*)(kp+6656);
}
__device__ __forceinline__ void kload2(bf16x8*kf,lds_cptr kp,int j){ kf[2*j]=*(const __attribute__((address_space(3))) bf16x8*)(kp+j*2048); kf[2*j+1]=*(const __attribute__((address_space(3))) bf16x8*)(kp+j*2048+512); }
__device__ __forceinline__ s16x4 vtr(lds_cptr p){ return __builtin_bit_cast(s16x4,__builtin_amdgcn_ds_read_tr16_b64_v4i16((__attribute__((address_space(3))) v4i16_t*)p)); }
__device__ __forceinline__ float rowmax(const f32x16&p0,const f32x16&p1){
  float a=max3f(p0[0],p0[1],p1[0]),b=max3f(p0[2],p0[3],p1[1]);a=max3f(a,p1[2],p1[3]);
  #pragma unroll
  for(int r=4;r<16;r+=4){a=max3f(a,p0[r],p0[r+1]);b=max3f(b,p0[r+2],p0[r+3]);a=max3f(a,p1[r],p1[r+1]);b=max3f(b,p1[r+2],p1[r+3]);}
  const float m=max2f(a,b);
  auto rr=__builtin_amdgcn_permlane32_swap(__float_as_uint(m),__float_as_uint(m),false,false);
  return max2f(__uint_as_float(rr[0]),__uint_as_float(rr[1]));
}
__device__ __forceinline__ void pv(f32x16*o,int vb,bf16x8 pa0,bf16x8 pa1,bf16x8 pa2,bf16x8 pa3){
  #pragma unroll
  for(int d0=0;d0<2;++d0){s16x4 lo[4],hi[4];
    #pragma unroll
    for(int ks=0;ks<4;++ks){
      asm volatile("ds_read_b64_tr_b16 %0,%1 offset:%c2":"=&v"(lo[ks]):"v"(vb),"i"(d0*4096+ks*1024):"memory");
      asm volatile("ds_read_b64_tr_b16 %0,%1 offset:%c2":"=&v"(hi[ks]):"v"(vb),"i"(d0*4096+ks*1024+512):"memory");}
    asm volatile("s_waitcnt lgkmcnt(0)":::"memory");SBAR();
    #define PK(k) (bf16x8){lo[k][0],lo[k][1],lo[k][2],lo[k][3],hi[k][0],hi[k][1],hi[k][2],hi[k][3]}
    o[d0]=__builtin_amdgcn_mfma_f32_32x32x16_bf16(pa0,PK(0),o[d0],0,0,0);
    o[d0]=__builtin_amdgcn_mfma_f32_32x32x16_bf16(pa1,PK(1),o[d0],0,0,0);
    o[d0]=__builtin_amdgcn_mfma_f32_32x32x16_bf16(pa2,PK(2),o[d0],0,0,0);
    o[d0]=__builtin_amdgcn_mfma_f32_32x32x16_bf16(pa3,PK(3),o[d0],0,0,0);
    #undef PK
  }
}

#ifndef ATTN_STORE16
#define ATTN_STORE16(p,v) (*(u32x4*)(p)=(v))
#endif
template<int THRL> __device__ __forceinline__ void attn_unit(int b,int h,int qb,const bf16*Q,const bf16*__restrict__ K,const bf16*__restrict__ V,bf16*O,char*shm){
  const int tid=hw_tid(),lane=tid&63,r32=lane&31,hi=lane>>5; const int wid=__builtin_amdgcn_readfirstlane(tid>>6);
  const long rowbase=(long)b*SEQ, kvbase=(long)b*KVLEN; const int q0=qb*QB, kh=h/3;
  const bf16*Qw=Q+(rowbase+q0+wid*QBLK)*QP+h*D;
  const bf16*Kh=K+kvbase*KP+kh*D,*Vh=V+kvbase*KP+kh*D;
  const unsigned lds0=(unsigned)(uintptr_t)shm;
  float*wsf=(float*)(shm+LDS_WS)+wid*64;
  const bf16*ksrc=Kh+(long)lane*KP+wid*8;
  const bf16*vsrc=Vh+(long)(16*(wid&3)+(lane>>2))*KP+(wid>>2)*32+(lane&3)*8;
  const unsigned kdst=lds0+LDS_K+wid*1024, vdst=lds0+LDS_V+wid*1024;
  #define DMA_K(t,slot) glds16(ksrc+(long)(t)*KVBLK*KP,(unsigned)__builtin_amdgcn_readfirstlane(kdst+(slot)))
  #define DMA_V(t,slot) glds16(vsrc+(long)(t)*KVBLK*KP,(unsigned)__builtin_amdgcn_readfirstlane(vdst+(slot)))
  const int vb0=(int)(lds0+LDS_V)+((lane>>4)&1)*32+(lane&3)*8+(4*hi+((lane&15)>>2))*64;
  const char*Kbase=shm+LDS_K; bf16x8 kf[8];
  const lds_cptr shm3=(lds_cptr)shm; const lds_cptr kp0=shm3+LDS_K+hi*1024+r32*16; const lds_cptr vp0=shm3+LDS_V+((lane>>4)&1)*32+(lane&3)*8+(4*hi+((lane&15)>>2))*64;
  DMA_K(0,0);DMA_V(0,0);DMA_K(1,SLOTB);
  bf16x8 qr[4];
  #pragma unroll
  for(int d0=0;d0<4;++d0)qr[d0]=*reinterpret_cast<const bf16x8*>(&Qw[(long)r32*QP+d0*16+hi*8]);
  float mhat=0.f,l_reg=0.f;f32x16 o[2];o[0]=f32x16{};o[1]=f32x16{};f32x16 negm=f32x16{};asm volatile("":"+v"(negm));
  #define CMASK(P0,P1,t) do{}while(0)
  bool resc=false;
  #define START(P0,P1) do{ const float rm=rowmax(P0,P1); resc=false; \
    { const float dl=rm; mhat=fadd_s(mhat,dl); \
      _Pragma("unroll") for(int r=0;r<16;++r){P0[r]=fsub_s(P0[r],dl);P1[r]=fsub_s(P1[r],dl);} \
      _Pragma("unroll") for(int r=0;r<16;++r)negm[r]=-mhat; asm volatile("":"+v"(negm)); } \
    _Pragma("unroll") for(int r=0;r<16;++r)P0[r]=__builtin_amdgcn_exp2f(P0[r]); }while(0)
  #define RESC() do{ if(resc){ asm volatile("s_waitcnt lgkmcnt(0)":::"memory"); \
      _Pragma("unroll") for(int d_=0;d_<2;++d_) _Pragma("unroll") for(int r=0;r<16;++r)o[d_][r]*=wsf[crow(r,hi)]; } }while(0)
  f32x16 pA0,pA1,pB0,pB1;
  int sl_prev=0,sl_cur=0,sl_next=SLOTB;
  #define ROT() do{sl_prev=sl_cur;sl_cur=sl_next;sl_next=(sl_next==(NSLOT-1)*SLOTB)?0:sl_next+SLOTB;}while(0)
  DMA_K(2,2*SLOTB);
  WAIT_BAR(3);
  qkt(pA0,pA1,Kbase,qr,negm,r32,hi);asm volatile("s_nop 15\n\ts_nop 7":"+v"(pA0),"+v"(pA1));CMASK(pA0,pA1,0);
  START(pA0,pA1);
  _Pragma("unroll") for(int r=0;r<16;++r)pA1[r]=__builtin_amdgcn_exp2f(pA1[r]);
  WAIT_BAR(0);
  DMA_K(3,0);DMA_V(1,SLOTB);
  ROT();
  kload8(kf,kp0+sl_cur);
  WAIT_BAR(2);
  s16x4 vlo[8],vhi[8]; u32x4 pw0,pw1,pw2,pw3;
  #define PKW(P,B) cvtpk_s(P[B],P[B+1])
  #define PAF(k) __builtin_bit_cast(bf16x8,pw##k)
  #define VFR(i) (bf16x8){vlo[i][0],vlo[i][1],vlo[i][2],vlo[i][3],vhi[i][0],vhi[i][1],vhi[i][2],vhi[i][3]}
  #define PIN(x) asm volatile("":"+v"(x))
  #define MX3(a,b,c) __builtin_fmaxf(__builtin_fmaxf((a),(b)),(c))
  #define GAPA(MF,A0,A1,A2,A3,W0,W1,PW) do{ MF; sacc+=A0; sacc+=A1; sacc+=A2; sacc+=A3; PIN(sacc); W0; W1; PIN(PW); SBAR(); }while(0)
  #define EX(v) __builtin_amdgcn_exp2f(v)
  #define GAPB(MF,X,B) do{ MF; X[B]=EX(X[B]); X[B+1]=EX(X[B+1]); X[B+2]=EX(X[B+2]); X[B+3]=EX(X[B+3]); PIN(X); SBAR(); }while(0)
  #define VRD(i) do{ vlo[i]=vtr(vp_+(((i)>>2)*4096+((i)&3)*1024)); vhi[i]=vtr(vp_+(((i)>>2)*4096+((i)&3)*1024+512)); }while(0)
  #define KRD(G,j) do{ if(G){ kload2(kf,kp0+sl_next,j); SBAR(); } }while(0)
  #define STEP(C0,C1,P0,P1,t,GK,GV,GL) do{ SBAR(); \
    const lds_cptr vp_=vp0+sl_prev; \
    VRD(0); SBAR(); float sacc=(P0[0]+P0[1]); \
    GAPA(C0=__builtin_amdgcn_mfma_f32_32x32x16_bf16(kf[0],qr[0],negm,0,0,0), P0[2],P0[3],P0[4],P0[5],     pw0[0]=PKW(P0,0), pw0[1]=PKW(P0,2), pw0); \
    VRD(4); SBAR(); GAPA(C1=__builtin_amdgcn_mfma_f32_32x32x16_bf16(kf[1],qr[0],negm,0,0,0), P0[6],P0[7],P0[8],P0[9],     pw0[2]=PKW(P0,4), pw0[3]=PKW(P0,6), pw0); \
    VRD(1); SBAR(); GAPA(C0=__builtin_amdgcn_mfma_f32_32x32x16_bf16(kf[2],qr[1],C0,0,0,0),   P0[10],P0[11],P0[12],P0[13], pw1[0]=PKW(P0,8), pw1[1]=PKW(P0,10), pw1); \
    VRD(5); SBAR(); GAPA(C1=__builtin_amdgcn_mfma_f32_32x32x16_bf16(kf[3],qr[1],C1,0,0,0),   P0[14],P0[15],P1[0],P1[1],   pw1[2]=PKW(P0,12),pw1[3]=PKW(P0,14), pw1); \
    VRD(2); SBAR(); GAPA(C0=__builtin_amdgcn_mfma_f32_32x32x16_bf16(kf[4],qr[2],C0,0,0,0),   P1[2],P1[3],P1[4],P1[5],     pw2[0]=PKW(P1,0), pw2[1]=PKW(P1,2), pw2); \
    VRD(6); SBAR(); GAPA(C1=__builtin_amdgcn_mfma_f32_32x32x16_bf16(kf[5],qr[2],C1,0,0,0),   P1[6],P1[7],P1[8],P1[9],     pw2[2]=PKW(P1,4), pw2[3]=PKW(P1,6), pw2); \
    VRD(3); SBAR(); GAPA(C0=__builtin_amdgcn_mfma_f32_32x32x16_bf16(kf[6],qr[3],C0,0,0,0),   P1[10],P1[11],P1[12],P1[13], pw3[0]=PKW(P1,8), pw3[1]=PKW(P1,10), pw3); \
    VRD(7); SBAR(); GAPA(C1=__builtin_amdgcn_mfma_f32_32x32x16_bf16(kf[7],qr[3],C1,0,0,0),   P1[14],P1[15],0.f,0.f,       pw3[2]=PKW(P1,12),pw3[3]=PKW(P1,14), pw3); \
    l_reg+=sacc; \
    if(GK){DMA_K((t)+3,sl_cur);} if(GV){DMA_V((t)+1,sl_next);} \
    CMASK(C0,C1,t); \
    { float a=MX3(C0[0],C0[1],C1[0]),b=MX3(C0[2],C0[3],C1[1]); a=MX3(a,C1[2],C1[3]); \
      _Pragma("unroll") for(int r=4;r<16;r+=4){a=MX3(a,C0[r],C0[r+1]);b=MX3(b,C0[r+2],C0[r+3]);a=MX3(a,C1[r],C1[r+1]);b=MX3(b,C1[r+2],C1[r+3]);} \
      float rm=__builtin_fmaxf(a,b); { auto rr=__builtin_amdgcn_permlane32_swap(__float_as_uint(rm),__float_as_uint(rm),false,false); rm=__builtin_fmaxf(__uint_as_float(rr[0]),__uint_as_float(rr[1])); } \
      resc=false; \
      if(__builtin_expect(__any(rm>(float)THRL),0)){ const float dl=__builtin_fmaxf(rm,0.f); mhat+=dl; \
        _Pragma("unroll") for(int r=0;r<16;++r){C0[r]-=dl;C1[r]-=dl;} \
        _Pragma("unroll") for(int r=0;r<16;++r)negm[r]=-mhat; asm volatile("":"+v"(negm)); \
        const float f=__builtin_amdgcn_exp2f(-dl); l_reg*=f; if(hi==0)wsf[r32]=f; resc=true; } } \
    SBAR(); \
    GAPB(o[0]=__builtin_amdgcn_mfma_f32_32x32x16_bf16(PAF(0),VFR(0),o[0],0,0,0), C0,0); \
    GAPB(o[1]=__builtin_amdgcn_mfma_f32_32x32x16_bf16(PAF(0),VFR(4),o[1],0,0,0), C0,4); \
    KRD(GL,0); GAPB(o[0]=__builtin_amdgcn_mfma_f32_32x32x16_bf16(PAF(1),VFR(1),o[0],0,0,0), C0,8); \
    KRD(GL,1); GAPB(o[1]=__builtin_amdgcn_mfma_f32_32x32x16_bf16(PAF(1),VFR(5),o[1],0,0,0), C0,12); \
    KRD(GL,2); GAPB(o[0]=__builtin_amdgcn_mfma_f32_32x32x16_bf16(PAF(2),VFR(2),o[0],0,0,0), C1,0); \
    KRD(GL,3); GAPB(o[1]=__builtin_amdgcn_mfma_f32_32x32x16_bf16(PAF(2),VFR(6),o[1],0,0,0), C1,4); \
    GAPB(o[0]=__builtin_amdgcn_mfma_f32_32x32x16_bf16(PAF(3),VFR(3),o[0],0,0,0), C1,8); \
    GAPB(o[1]=__builtin_amdgcn_mfma_f32_32x32x16_bf16(PAF(3),VFR(7),o[1],0,0,0), C1,12); \
    }while(0)
  int t=1;
  for(;t+5<NT;t+=2){
    STEP(pB0,pB1,pA0,pA1,t,true,true,true);     WAIT_BAR(2); RESC(); ROT();
    STEP(pA0,pA1,pB0,pB1,t+1,true,true,true);   WAIT_BAR(2); RESC(); ROT();
  }
  #define ENDW(tt) do{ if((tt)+3<NT){WAIT_BAR(2);} else if((tt)+2<NT){WAIT_BAR(1);} else {WAIT_BAR(0);} }while(0)
  for(;t+1<NT;t+=2){
    STEP(pB0,pB1,pA0,pA1,t,(t+3<NT),(t+1<NT),(t+1<NT));       ENDW(t);   RESC(); ROT();
    STEP(pA0,pA1,pB0,pB1,t+1,(t+4<NT),(t+2<NT),(t+2<NT));     ENDW(t+1); RESC(); ROT();
  }
  STEP(pB0,pB1,pA0,pA1,NT-1,false,false,false); RESC();
  { float sacc=pB0[0]+pB0[1]; _Pragma("unroll") for(int r=2;r<16;++r)sacc+=pB0[r]; _Pragma("unroll") for(int r=0;r<16;++r)sacc+=pB1[r]; l_reg+=sacc;
    pw0=(u32x4){PKW(pB0,0),PKW(pB0,2),PKW(pB0,4),PKW(pB0,6)};pw1=(u32x4){PKW(pB0,8),PKW(pB0,10),PKW(pB0,12),PKW(pB0,14)};pw2=(u32x4){PKW(pB1,0),PKW(pB1,2),PKW(pB1,4),PKW(pB1,6)};pw3=(u32x4){PKW(pB1,8),PKW(pB1,10),PKW(pB1,12),PKW(pB1,14)};
    SBAR(); pv(o,vb0+sl_cur,PAF(0),PAF(1),PAF(2),PAF(3)); }
  #undef PKW
  #undef PAF
  #undef VFR
  #undef PIN
  #undef MX3
  #undef GAPA
  #undef GAPB
  #undef EX
  #undef VRD
  #undef KRD
  #undef STEP
  #undef ENDW
  {auto rr=__builtin_amdgcn_permlane32_swap(__float_as_uint(l_reg),__float_as_uint(l_reg),false,false);l_reg=__uint_as_float(rr[0])+__uint_as_float(rr[1]);}
  if(hi==0)wsf[32+r32]=l_reg;asm volatile("s_waitcnt lgkmcnt(0)":::"memory");
  float rli[16];
  #pragma unroll
  for(int r=0;r<16;++r)rli[r]=__builtin_amdgcn_rcpf(wsf[32+crow(r,hi)]);
  bf16*Ow=O+(rowbase+q0+wid*QBLK)*OP+h*D;
  { bf16*stg=(bf16*)(shm+LDS_OST)+wid*2048;
    #pragma unroll
    for(int r=0;r<16;++r){const int orow=crow(r,hi);
      #pragma unroll
      for(int d0=0;d0<2;++d0)stg[orow*64+d0*32+r32]=(bf16)f2bf(o[d0][r]*rli[r]);}
    asm volatile("s_waitcnt lgkmcnt(0)":::"memory");
    #pragma unroll
    for(int i=0;i<4;++i){const int row=i*8+(lane>>3),ch=lane&7; const u32x4 v=*(const u32x4*)(stg+row*64+ch*8); ATTN_STORE16(Ow+(long)row*OP+ch*8,v);} }
  asm volatile("s_waitcnt lgkmcnt(0)\n\ts_barrier":::"memory");
  #undef DMA_K
  #undef DMA_V
  #undef CMASK
  #undef START
  #undef RESC
  #undef ROT
}
constexpr int ATTN_LDS_BYTES=LDS_BYTES;
struct AttnTensors { const bf16* Q; const bf16* K; const bf16* V; bf16* O; };
template<int THRL=8> __device__ __forceinline__ void attn_phase(char*lds,const AttnTensors&T){
  const int G=gridDim.x, bx=blockIdx.x, v=(G%8==0)?(bx%8)*(G/8)+bx/8:bx;
  for(int u=v;u<16*12*8;u+=G){
    const int pair=(u%256)/4, j=((u%256)%4)*6+u/256;
    const int b=pair>>2, kh=pair&3, g=j>>3, qb=j&7;
    attn_unit<THRL>(b,kh*3+g,qb,T.Q,T.K,T.V,T.O,lds);
  }
}
#undef SBAR
#undef WAIT_BAR
}

__device__ __forceinline__ void pool_item(const Params& p, LAS unsigned char* lds, int item) {
    const int tid = TIDX;
    const int gi = item & 3, tile = item >> 2, t0 = tile * 32, b = t0 / SEQ, tl0 = t0 % SEQ, half = 1 << gi;
    const bf16_t* Ub = (const bf16_t*)(p.ws + OFF_U);
    bf16_t* AO = (bf16_t*)(p.ws + OFF_AO);
    LAS float* us = (LAS float*)lds;
    LAS float* dl = (LAS float*)(lds + 48 * 64 * 4);
    __syncthreads();
    for (int i = tid; i < 48 * 64; i += 256) {
        const int r = i >> 6, c = i & 63, tl = tl0 - 8 + r;
        us[i] = (tl >= 0 && tl < SEQ) ? bf2f(Ub[(size_t)(b * SEQ + tl) * 256 + gi * 64 + c]) : 0.f;
    }
    __syncthreads();
    {
        const int c = tid & 63, tg = tid >> 6;
#pragma unroll
        for (int k = 0; k < 8; ++k) {
            const int tk = tg * 8 + k, tl = tl0 + tk;
            const int lo = max(tl - half, 0), hi = min(tl + half, SEQ);
            float s = 0.f;
            for (int r = lo; r < hi; ++r) s += us[(r - tl0 + 8) * 64 + c];
            dl[tk * 64 + c] = s / (float)(hi - lo) - us[(tk + 8) * 64 + c];
        }
    }
    __syncthreads();
    {
        const int dd = tid & 63, tg = tid >> 6;
        float acc[8];
#pragma unroll
        for (int k = 0; k < 8; ++k) acc[k] = 0.f;
        const float* w = p.pool_w + gi * 4096 + dd;
        for (int c = 0; c < 64; ++c) {
            const float wv = w[c * 64];
#pragma unroll
            for (int k = 0; k < 8; ++k) acc[k] += dl[(tg * 8 + k) * 64 + c] * wv;
        }
        const float ps = p.pool_scale[gi * 64 + dd];
#pragma unroll
        for (int k = 0; k < 8; ++k) AO[(size_t)(t0 + tg * 8 + k) * D + gi * 64 + dd] = (bf16_t)f2bf(acc[k] * ps);
    }
}

__device__ __forceinline__ void phase_attn_pool(const Params& p, LAS unsigned char* lds, char* smem) {
    const attn_body::AttnTensors AT{(const bf16_t*)(p.ws + OFF_Q), (const bf16_t*)(p.ws + OFF_K), (const bf16_t*)(p.ws + OFF_V), (bf16_t*)(p.ws + OFF_AO) + 256};
    attn_body::attn_phase<8>(smem, AT);
    __syncthreads();
    constexpr int N_POOL = (T / 32) * 4;
    for (int it = VBLK; it < N_POOL; it += NVBLK) pool_item(p, lds, it);
}

struct EpiOut {
    static constexpr bool PERM = false;
    const float* x; float* y; const float* mod; float* stats;
    __device__ __forceinline__ void operator()(const f32x4 (&acc)[2][2][4][2], const pg8::Unit& u, int wr, int wc, int fr, int fq) const {
        const float* g1 = mod + (size_t)(u.pm >> 3) * MODW + 2 * D;
        const int col0 = u.pn * 256 + wc * 32 + fq * 4;
        f32x4 gv[2][2];
#pragma unroll
        for (int bj = 0; bj < 2; ++bj)
#pragma unroll
            for (int n = 0; n < 2; ++n) gv[bj][n] = *(const f32x4*)(g1 + col0 + bj * 128 + n * 16);
#pragma unroll
        for (int ai = 0; ai < 2; ++ai)
#pragma unroll
            for (int m = 0; m < 4; ++m) {
                const int row = u.pm * 256 + ai * 128 + wr * 64 + m * 16 + fr;
                float s1 = 0.f, s2 = 0.f;
#pragma unroll
                for (int bj = 0; bj < 2; ++bj)
#pragma unroll
                    for (int n = 0; n < 2; ++n) {
                        const size_t off = (size_t)row * D + col0 + bj * 128 + n * 16;
                        const f32x4 xv = *(const f32x4*)(x + off);
                        const f32x4 yv = xv * ALPHA + gv[bj][n] * acc[ai][bj][m][n];
                        *(f32x4*)(y + off) = yv;
                        s1 += (yv[0] + yv[1]) + (yv[2] + yv[3]);
                        s2 += (yv[0] * yv[0] + yv[1] * yv[1]) + (yv[2] * yv[2] + yv[3] * yv[3]);
                    }
                s1 += __shfl_xor(s1, 16); s1 += __shfl_xor(s1, 32);
                s2 += __shfl_xor(s2, 16); s2 += __shfl_xor(s2, 32);
                if (fq == 0) { float* st = stats + ((size_t)row * 16 + u.pn * 4 + wc) * 2; st[0] = s1; st[1] = s2; }
            }
    }
};
__device__ __forceinline__ void phase_outproj(const Params& p, LAS unsigned char* lds) {
    pg8::Gemm g{(const bf16_t*)(p.ws + OFF_AO), (const bf16_t*)(p.ws + OFF_WTOUT)};
    pg8::DenseSched S{4, 512, 512, 0, 1, (int)gridDim.x, vcu_of_block()};
    EpiOut E{p.x, p.out, (const float*)(p.ws + OFF_MOD), (float*)(p.ws + OFF_STATS)};
    pg8::gemm_phase<D, EpiOut, pg8::DenseSched, false>(lds, g, S, E);
}

__device__ __forceinline__ void phase_router(const Params& p, LAS unsigned char* lds0) {
    const int tid = hw_tid(), lane = tid & 63, wid = tid >> 6, r16 = lane & 15, q = lane >> 4;
    const float* mod = (const float*)(p.ws + OFF_MOD);
    const float* stats = (const float*)(p.ws + OFF_STATS);
    bf16_t* H = (bf16_t*)(p.ws + OFF_H);
    const bf16_t* WRH = (const bf16_t*)(p.ws + OFF_WRH); const bf16_t* WRL = (const bf16_t*)(p.ws + OFF_WRL);
    int* gcnt = (int*)(p.ws + OFF_CNT);
    int* LDST = (int*)(p.ws + OFF_LDST);
    float* LWt = (float*)(p.ws + OFF_LW);
    LAS float* vec = (LAS float*)lds0;
    LAS float* lg = (LAS float*)(lds0 + 16384) + wid * 16 * 64;
    LAS int* lcnt = (LAS int*)(lds0 + 49152);
    LAS int* lbase = (LAS int*)(lds0 + 49152 + 256);
    LAS int* sel_ep = (LAS int*)(lds0 + 49152 + 512);
    LAS float* sel_w = (LAS float*)(lds0 + 49152 + 512 + 4096);
    for (int item = blockIdx.x; item < T / 128; item += gridDim.x) {
        const int t0 = item * 128, b = t0 / SEQ, tw0 = t0 + wid * 16;
        __syncthreads();
        if (tid < 64) lcnt[tid] = 0;
        for (int i = tid; i < 1024; i += 512) {
            vec[i] = p.ln1_g[i]; vec[1024 + i] = p.ln1_b[i];
            vec[2048 + i] = 1.f + mod[(size_t)b * MODW + 4 * D + i]; vec[3072 + i] = mod[(size_t)b * MODW + 3 * D + i];
        }
        float meanv = 0.f, rstdv = 0.f;
        if (lane < 16) {
            float s1 = 0.f, s2 = 0.f;
            const float* st = stats + (size_t)(tw0 + lane) * 32;
#pragma unroll
            for (int i = 0; i < 16; ++i) { s1 += st[2 * i]; s2 += st[2 * i + 1]; }
            meanv = s1 * (1.f / D);
            const float var = fmaxf(s2 * (1.f / D) - meanv * meanv, 0.f);
            rstdv = 1.0f / sqrtf(var + 1e-5f);
        }
        const float mu = __shfl(meanv, r16), rs = __shfl(rstdv, r16);
        __syncthreads();
        f32x4 acc[4];
#pragma unroll
        for (int nb = 0; nb < 4; ++nb) acc[nb] = (f32x4){0.f, 0.f, 0.f, 0.f};
        float* yrow = p.out + (size_t)(tw0 + r16) * D + q * 8;
        bf16_t* hrow = H + (size_t)(tw0 + r16) * D + q * 8;
        LAS unsigned char* wb = lds0 + 57856;
        f32x4 vn[4][2];
#pragma unroll
        for (int u = 0; u < 4; ++u) { vn[u][0] = *(const f32x4*)(yrow + u * 32); vn[u][1] = *(const f32x4*)(yrow + u * 32 + 4); }
        for (int ch = 0; ch < 4; ++ch) {
            __syncthreads();
#pragma unroll
            for (int i = 0; i < 8; ++i) {
                const int idx = tid + i * 512, part = idx >> 11, row = (idx >> 5) & 63, c16 = idx & 31;
                const u32x4 w = *(const u32x4*)((part ? WRL : WRH) + (size_t)row * D + ch * 256 + c16 * 8);
                *(LAS u32x4*)(wb + part * 33792 + row * 528 + c16 * 16) = w;
            }
            __syncthreads();
#pragma unroll
            for (int s4 = ch * 8; s4 < ch * 8 + 8; s4 += 4) {
                f32x4 vv[4][2];
#pragma unroll
                for (int u = 0; u < 4; ++u) { vv[u][0] = vn[u][0]; vv[u][1] = vn[u][1]; }
                if (s4 + 4 < 32) {
#pragma unroll
                    for (int u = 0; u < 4; ++u) { vn[u][0] = *(const f32x4*)(yrow + (s4 + 4 + u) * 32); vn[u][1] = *(const f32x4*)(yrow + (s4 + 4 + u) * 32 + 4); }
                }
#pragma unroll
                for (int u = 0; u < 4; ++u) {
                    const int s = s4 + u, k0 = s * 32 + q * 8;
                    float hv[8];
#pragma unroll
                    for (int hh = 0; hh < 2; ++hh) {
                        const f32x4 g = *(const LAS f32x4*)(vec + k0 + 4 * hh), bb = *(const LAS f32x4*)(vec + 1024 + k0 + 4 * hh);
                        const f32x4 sc = *(const LAS f32x4*)(vec + 2048 + k0 + 4 * hh), sh = *(const LAS f32x4*)(vec + 3072 + k0 + 4 * hh);
                        const f32x4 xm = (vv[u][hh] - mu) * rs * g + bb;
                        *(f32x4*)(yrow + s * 32 + 4 * hh) = xm;
                        const f32x4 h4 = xm * sc + sh;
                        hv[4 * hh + 0] = h4[0]; hv[4 * hh + 1] = h4[1]; hv[4 * hh + 2] = h4[2]; hv[4 * hh + 3] = h4[3];
                    }
                    unsigned wh[4], wl[4];
#pragma unroll
                    for (int i = 0; i < 4; ++i) {
                        const unsigned ha = f2bf(hv[2 * i]), hb = f2bf(hv[2 * i + 1]);
                        wh[i] = ha | (hb << 16);
                        wl[i] = pk2(hv[2 * i] - bf2f(ha), hv[2 * i + 1] - bf2f(hb));
                    }
                    *(u32x4*)(hrow + s * 32) = (u32x4){wh[0], wh[1], wh[2], wh[3]};
                    const bf16x8 ah = __builtin_bit_cast(bf16x8, (u32x4){wh[0], wh[1], wh[2], wh[3]}), al = __builtin_bit_cast(bf16x8, (u32x4){wl[0], wl[1], wl[2], wl[3]});
                    const int kb = ((s & 7) * 32 + q * 8) * 2;
#pragma unroll
                    for (int nb = 0; nb < 4; ++nb) {
                        const bf16x8 bh = *(const LAS bf16x8*)(wb + (nb * 16 + r16) * 528 + kb), bl = *(const LAS bf16x8*)(wb + 33792 + (nb * 16 + r16) * 528 + kb);
                        acc[nb] = __builtin_amdgcn_mfma_f32_16x16x32_bf16(ah, bh, acc[nb], 0, 0, 0);
                        acc[nb] = __builtin_amdgcn_mfma_f32_16x16x32_bf16(al, bh, acc[nb], 0, 0, 0);
                        acc[nb] = __builtin_amdgcn_mfma_f32_16x16x32_bf16(ah, bl, acc[nb], 0, 0, 0);
                    }
                }
            }
        }
#pragma unroll
        for (int nb = 0; nb < 4; ++nb)
#pragma unroll
            for (int j = 0; j < 4; ++j) lg[(4 * q + j) * 64 + nb * 16 + r16] = acc[nb][j];
        __syncthreads();
        const float bias = p.router_bias[lane];
        for (int r = 0; r < 16; ++r) {
            const float lgv = lg[r * 64 + lane];
            const float sg = 1.0f / (1.0f + expf(-lgv));
            const float sel = sg + bias;
            float m1 = fmaxf(sel, __shfl_xor(sel, 1)); m1 = fmaxf(m1, __shfl_xor(m1, 2)); m1 = fmaxf(m1, __shfl_xor(m1, 4));
            int cand = (sel == m1) ? lane : 64;
            cand = min(cand, __shfl_xor(cand, 1)); cand = min(cand, __shfl_xor(cand, 2)); cand = min(cand, __shfl_xor(cand, 4));
            const float sel2 = (lane == cand) ? -INFINITY : sel;
            float m2 = fmaxf(sel2, __shfl_xor(sel2, 1)); m2 = fmaxf(m2, __shfl_xor(m2, 2)); m2 = fmaxf(m2, __shfl_xor(m2, 4));
            const float gs = m1 + m2;
            const int g = lane >> 3;
            int cntg = 0;
#pragma unroll
            for (int gg = 0; gg < 8; ++gg) { const float v = __shfl(gs, gg * 8); cntg += (v > gs || (v == gs && gg < g)) ? 1 : 0; }
            const bool keep = cntg < 4;
            const float msel = keep ? sel : -INFINITY;
            lg[r * 64 + lane] = msel;
            int cnt = 0;
#pragma unroll 4
            for (int q4 = 0; q4 < 16; ++q4) {
                const f32x4 v = *(const LAS f32x4*)(lg + r * 64 + q4 * 4);
#pragma unroll
                for (int i = 0; i < 4; ++i) cnt += (v[i] > msel || (v[i] == msel && (q4 * 4 + i) < lane)) ? 1 : 0;
            }
            const bool chosen = keep && cnt < 8;
            float wsum = chosen ? sg : 0.f;
#pragma unroll
            for (int o = 1; o < 64; o <<= 1) wsum += __shfl_xor(wsum, o);
            if (chosen) {
                const int pos = atomicAdd((int*)&lcnt[lane], 1);
                sel_ep[(wid * 16 + r) * 8 + cnt] = lane | (pos << 8);
                sel_w[(wid * 16 + r) * 8 + cnt] = sg / wsum * 2.5f;
            }
        }
        __syncthreads();
        if (tid < 64) { int tt = tid; asm volatile("" : "+v"(tt)); lbase[tt] = atomicAdd(&gcnt[tt], lcnt[tt]); }
        __syncthreads();
        for (int idx = tid; idx < 1024; idx += 512) {
            const int ep = sel_ep[idx], e = ep & 0xff, pos = ep >> 8, gi = lbase[e] + pos;
            LDST[(size_t)e * T + gi] = (t0 + (idx >> 3)) * NSLOT + (idx & 7);
            LWt[(size_t)e * T + gi] = sel_w[idx];
        }
    }
}

constexpr int LDS_ROWTAB = 131072, MOE_MAX_UNITS = 12, LDS_UTAB = LDS_CTL + 256, LDS_TSTART = LDS_UTAB + MOE_MAX_UNITS * 32;
__device__ __forceinline__ int moe_setup(const Params& p, LAS unsigned char* lds0, int nN, int bmul, int badd) {
    LAS int* tstart = (LAS int*)(lds0 + LDS_TSTART); LAS int* utab = (LAS int*)(lds0 + LDS_UTAB);
    const int* gcnt = (const int*)(p.ws + OFF_CNT);
    __syncthreads();
    if (hw_tid() == 0) {
        int a = 0;
        for (int e = 0; e < NEX; ++e) { const int c = e < NE ? gcnt[e] : T; tstart[e] = a; a += (c + 255) >> 8; }
        tstart[NEX] = a;
    }
    __syncthreads();
    const int total = tstart[NEX] * nN, G = gridDim.x, c = blockIdx.x;
    if (hw_tid() < MOE_MAX_UNITS) {
        const int i = hw_tid(), L = i * G + c;
        int pm = 0, pn = 0, e = 0, i0 = 0, cnt = 0;
        if (L < total) {
            const int mt = L / nN, pl = L % nN;
            for (int j = 1; j < NEX; ++j) e += (mt >= tstart[j]) ? 1 : 0;
            pm = mt; pn = e * bmul + badd + pl; i0 = (mt - tstart[e]) * 256; cnt = e < NE ? gcnt[e] : T;
        }
        utab[i * 8 + 0] = pm; utab[i * 8 + 1] = pn; utab[i * 8 + 2] = e; utab[i * 8 + 3] = i0; utab[i * 8 + 4] = cnt;
    }
    __syncthreads();
    const int n = (total - c + G - 1) / G;
    return n < 0 ? 0 : (n > MOE_MAX_UNITS ? MOE_MAX_UNITS : n);
}
struct MoeSched {
    LAS const int* utab; LAS const unsigned* rowtab; int n;
    __device__ __forceinline__ bool next(int i, pg8::Unit& u) const {
        if (i >= n) return false;
        u.pm = __builtin_amdgcn_readfirstlane(utab[i * 8 + 0]); u.pn = __builtin_amdgcn_readfirstlane(utab[i * 8 + 1]); u.e = __builtin_amdgcn_readfirstlane(utab[i * 8 + 2]); u.idx = i; return true;
    }
    __device__ __forceinline__ unsigned row_off(int i, int r) const { return rowtab[i * 256 + r]; }
    __device__ __forceinline__ void a_ready(const pg8::Unit&) const {}
    __device__ __forceinline__ void done(const pg8::Unit&) const {}
};
struct EpiGU {
    static constexpr bool PERM = true;
    LAS const int* utab; unsigned char* ws;
    __device__ __forceinline__ void operator()(const f32x4 (&acc)[2][2][4][2], const pg8::Unit& u, int wr, int wc, int fr, int fq) const {
        const int e = u.e, i0 = utab[u.idx * 8 + 3], cnt = utab[u.idx * 8 + 4], pl = u.pn & 1;
        const float* LWt = (const float*)(ws + OFF_LW) + (size_t)(e < NE ? e : 0) * T;
        bf16_t* ACT = (bf16_t*)(ws + OFF_ACT) + (size_t)u.pm * 256 * FF + pl * 128 + wc * 32 + 8 * fq;
        float lw[2][4];
#pragma unroll
        for (int ai = 0; ai < 2; ++ai)
#pragma unroll
            for (int m = 0; m < 4; ++m) lw[ai][m] = LWt[i0 + ai * 128 + wr * 64 + m * 16 + fr];
#pragma unroll
        for (int ai = 0; ai < 2; ++ai)
#pragma unroll
            for (int m = 0; m < 4; ++m) {
                const int rl = ai * 128 + wr * 64 + m * 16 + fr, li = i0 + rl;
                const float wrow = li < cnt ? (e < NE ? lw[ai][m] : 1.f) : 0.f;
                float a[8];
#pragma unroll
                for (int n = 0; n < 2; ++n)
#pragma unroll
                    for (int q = 0; q < 4; ++q) { const float g = acc[ai][0][m][n][q], uu = acc[ai][1][m][n][q]; a[n * 4 + q] = g / (1.f + __expf(-g)) * uu * wrow; }
                u32x4 w; w.x = pk2(a[0], a[1]); w.y = pk2(a[2], a[3]); w.z = pk2(a[4], a[5]); w.w = pk2(a[6], a[7]);
                *(u32x4*)(ACT + (size_t)rl * FF) = w;
            }
    }
};
__device__ __forceinline__ void phase_gateup(const Params& p, LAS unsigned char* lds0) {
    const int n = moe_setup(p, lds0, 2, 2, 0);
    LAS const int* utab = (LAS const int*)(lds0 + LDS_UTAB);
    LAS unsigned* rowtab = (LAS unsigned*)(lds0 + LDS_ROWTAB);
    const int* LDST = (const int*)(p.ws + OFF_LDST);
    for (int i = 0; i < n; ++i) {
        const int e = utab[i * 8 + 2], i0 = utab[i * 8 + 3], cnt = utab[i * 8 + 4];
        if (hw_tid() < 256) {
            const int li = i0 + hw_tid(); int tok = 0;
            if (li < cnt) tok = e < NE ? LDST[(size_t)e * T + li] / NSLOT : li;
            rowtab[i * 256 + hw_tid()] = (unsigned)tok * (unsigned)(D * 2);
        }
    }
    __syncthreads();
    MoeSched S{utab, rowtab, n};
    pg8::Gemm g{(const bf16_t*)(p.ws + OFF_H), (const bf16_t*)(p.ws + OFF_WGU)};
    EpiGU E{utab, p.ws};
    pg8::gemm_phase<D, EpiGU, MoeSched, true>(lds0, g, S, E);
}
constexpr float FP8S = 32.f, FP8I = 1.f / 32.f;
__device__ __forceinline__ unsigned pk4_fp8(float a, float b, float c, float d) {
    a = __builtin_amdgcn_fmed3f(a * FP8S, -440.f, 440.f); b = __builtin_amdgcn_fmed3f(b * FP8S, -440.f, 440.f);
    c = __builtin_amdgcn_fmed3f(c * FP8S, -440.f, 440.f); d = __builtin_amdgcn_fmed3f(d * FP8S, -440.f, 440.f);
    int w = __builtin_amdgcn_cvt_pk_fp8_f32(a, b, 0, false);
    w = __builtin_amdgcn_cvt_pk_fp8_f32(c, d, w, true);
    return (unsigned)w;
}
struct EpiDown {
    static constexpr bool PERM = true;
    LAS const int* utab; unsigned char* ws;
    __device__ __forceinline__ void operator()(const f32x4 (&acc)[2][2][4][2], const pg8::Unit& u, int wr, int wc, int fr, int fq) const {
        const int e = u.e, i0 = utab[u.idx * 8 + 3], cnt = utab[u.idx * 8 + 4], pl = u.pn & 1;
        const int* LDST = (const int*)(ws + OFF_LDST) + (size_t)(e < NE ? e : 0) * T;
        unsigned char* SL = ws + OFF_SLOTS + pl * 256 + wc * 32 + 8 * fq;
        int dst[2][4];
#pragma unroll
        for (int ai = 0; ai < 2; ++ai)
#pragma unroll
            for (int m = 0; m < 4; ++m) dst[ai][m] = LDST[i0 + ai * 128 + wr * 64 + m * 16 + fr];
#pragma unroll
        for (int ai = 0; ai < 2; ++ai)
#pragma unroll
            for (int m = 0; m < 4; ++m) {
                const int li = i0 + ai * 128 + wr * 64 + m * 16 + fr;
                const int d = li < cnt ? (e < NE ? dst[ai][m] : li * NSLOT + 8) : T * NSLOT;
#pragma unroll
                for (int bj = 0; bj < 2; ++bj) {
                    u32x2 w; w.x = pk4_fp8(acc[ai][bj][m][0][0], acc[ai][bj][m][0][1], acc[ai][bj][m][0][2], acc[ai][bj][m][0][3]);
                    w.y = pk4_fp8(acc[ai][bj][m][1][0], acc[ai][bj][m][1][1], acc[ai][bj][m][1][2], acc[ai][bj][m][1][3]);
                    *(u32x2*)(SL + (size_t)d * 512 + bj * 128) = w;
                }
                asm volatile("" ::: "memory");
            }
    }
};
__device__ __forceinline__ void phase_down(const Params& p, LAS unsigned char* lds0, int c) {
    const int n = moe_setup(p, lds0, 2, 4, 2 * c);
    LAS const int* utab = (LAS const int*)(lds0 + LDS_UTAB);
    MoeSched S{utab, (LAS const unsigned*)(lds0 + LDS_ROWTAB), n};
    pg8::Gemm g{(const bf16_t*)(p.ws + OFF_ACT), (const bf16_t*)(p.ws + OFF_WD)};
    EpiDown E{utab, p.ws};
    pg8::gemm_phase<FF, EpiDown, MoeSched, false>(lds0, g, S, E);
}

__device__ __forceinline__ void slot_sum16(const unsigned char* SL, int t, int cb, float (&s)[16]) {
#pragma unroll
    for (int i = 0; i < 16; ++i) s[i] = 0.f;
    u32x4 v[NSLOT];
#pragma unroll
    for (int k = 0; k < NSLOT; ++k) v[k] = *(const u32x4*)(SL + (size_t)(t * NSLOT + k) * 512 + cb);
#pragma unroll
    for (int k = 0; k < NSLOT; ++k)
#pragma unroll
        for (int i = 0; i < 4; ++i) {
            typedef float f32x2 __attribute__((ext_vector_type(2)));
            const f32x2 lo = __builtin_amdgcn_cvt_pk_f32_fp8((int)v[k][i], false), hi = __builtin_amdgcn_cvt_pk_f32_fp8((int)v[k][i], true);
            s[4 * i] += lo.x; s[4 * i + 1] += lo.y; s[4 * i + 2] += hi.x; s[4 * i + 3] += hi.y;
        }
#pragma unroll
    for (int i = 0; i < 16; ++i) s[i] *= FP8I;
}
__device__ __forceinline__ void phase_combine(const Params& p) {
    const unsigned char* SL = p.ws + OFF_SLOTS;
    bf16_t* FFN = (bf16_t*)(p.ws + OFF_H);
    for (int item = blockIdx.x; item < T / 16; item += gridDim.x) {
        const int t = item * 16 + (hw_tid() >> 5), cc = (hw_tid() & 31) * 16;
        float s[16];
        slot_sum16(SL, t, cc, s);
        u32x4 w0 = {pk2(s[0], s[1]), pk2(s[2], s[3]), pk2(s[4], s[5]), pk2(s[6], s[7])}, w1 = {pk2(s[8], s[9]), pk2(s[10], s[11]), pk2(s[12], s[13]), pk2(s[14], s[15])};
        *(u32x4*)(FFN + (size_t)t * D + cc) = w0; *(u32x4*)(FFN + (size_t)t * D + cc + 8) = w1;
    }
}

__device__ __forceinline__ void phase_final(const Params& p) {
    const int lane = hw_tid() & 63, gw = blockIdx.x * 8 + (hw_tid() >> 6), ngw = gridDim.x * 8;
    const float* mod = (const float*)(p.ws + OFF_MOD);
    const bf16_t* FFN = (const bf16_t*)(p.ws + OFF_H);
    const unsigned char* SL = p.ws + OFF_SLOTS;
    const int c0 = lane * 16;
    for (int row = gw; row < T; row += ngw) {
        const float* g2 = mod + (size_t)(row / SEQ) * MODW + 5 * D;
        float f[16];
        if (lane < 32) {
            const u32x4 a = *(const u32x4*)(FFN + (size_t)row * D + c0), b = *(const u32x4*)(FFN + (size_t)row * D + c0 + 8);
#pragma unroll
            for (int i = 0; i < 4; ++i) { f[2 * i] = bflo(a[i]); f[2 * i + 1] = bfhi(a[i]); f[8 + 2 * i] = bflo(b[i]); f[8 + 2 * i + 1] = bfhi(b[i]); }
        } else {
            slot_sum16(SL, row, c0 - 512, f);
        }
        f32x4 y[4]; float s = 0.f;
#pragma unroll
        for (int j = 0; j < 4; ++j) {
            const f32x4 xm = *(const f32x4*)(p.out + (size_t)row * D + c0 + 4 * j), gg = *(const f32x4*)(g2 + c0 + 4 * j);
            y[j][0] = ALPHA * xm[0] + gg[0] * f[4 * j]; y[j][1] = ALPHA * xm[1] + gg[1] * f[4 * j + 1];
            y[j][2] = ALPHA * xm[2] + gg[2] * f[4 * j + 2]; y[j][3] = ALPHA * xm[3] + gg[3] * f[4 * j + 3];
            s += (y[j][0] + y[j][1]) + (y[j][2] + y[j][3]);
        }
#pragma unroll
        for (int o = 1; o < 64; o <<= 1) s += __shfl_xor(s, o);
        const float mean = s * (1.f / D);
        float qv = 0.f;
#pragma unroll
        for (int j = 0; j < 4; ++j) { y[j] = y[j] - mean; qv += (y[j][0] * y[j][0] + y[j][1] * y[j][1]) + (y[j][2] * y[j][2] + y[j][3] * y[j][3]); }
#pragma unroll
        for (int o = 1; o < 64; o <<= 1) qv += __shfl_xor(qv, o);
        const float rstd = 1.0f / sqrtf(qv * (1.f / D) + 1e-5f);
#pragma unroll
        for (int j = 0; j < 4; ++j) {
            const f32x4 g = *(const f32x4*)(p.ln2_g + c0 + 4 * j), bb = *(const f32x4*)(p.ln2_b + c0 + 4 * j);
            *(f32x4*)(p.out + (size_t)row * D + c0 + 4 * j) = y[j] * rstd * g + bb;
        }
    }
}

#define XB_TMO      128
#define XB_XCNT(j)  (256  + 64 * (j))
#define XB_XSUB(j)  (1280 + 64 * (j))
#define XB_XGEN(j)  (2304 + 64 * (j))
#define XB_TOP      3328
#define XB_TOPGEN   3392
#define XCD_BAR_WORDS 3456
#define XB_SPIN_CAP (1u << 18)
__device__ __forceinline__ unsigned xb_ld(unsigned* p)              { return __hip_atomic_load(p, __ATOMIC_RELAXED, __HIP_MEMORY_SCOPE_AGENT); }
__device__ __forceinline__ unsigned xb_add(unsigned* p, unsigned v) { return __hip_atomic_fetch_add(p, v, __ATOMIC_RELAXED, __HIP_MEMORY_SCOPE_AGENT); }
__device__ __forceinline__ unsigned xb_xcc_id() { return (unsigned)__builtin_amdgcn_s_getreg((3 << 11) | 20) & 0xFu; }
#define XB_SPIN(cond, bar) do { unsigned _sp = 0; while (cond) { __builtin_amdgcn_s_sleep(1); \
    if ((++_sp & 255u) == 0u) { if (xb_ld(&(bar)[XB_TMO])) break; if (_sp > XB_SPIN_CAP) { atomicAdd(&(bar)[XB_TMO], 1u); break; } } } } while (0)
struct XcdBarrier { unsigned* bar; unsigned x; volatile LAS unsigned* st; };
__device__ __forceinline__ XcdBarrier xcd_barrier_post(unsigned* bar, volatile LAS unsigned* st) {
    XcdBarrier b; b.bar = bar; b.x = xb_xcc_id(); b.st = st;
    if (hw_tid() == 0) (void)xb_add(&bar[XB_XCNT(b.x)], 1u);
    return b;
}
__device__ __forceinline__ void xcd_barrier_complete(unsigned* bar, unsigned x, unsigned& nloc, unsigned& nx) {
    const unsigned G = gridDim.x * gridDim.y * gridDim.z;
    unsigned sum, cnt, mine, sp = 0u;
    for (;;) {
        sum = 0u; cnt = 0u; mine = 0u;
#pragma unroll
        for (unsigned j = 0; j < 16; ++j) { const unsigned c = xb_ld(&bar[XB_XCNT(j)]); sum += c; cnt += (c > 0u) ? 1u : 0u; mine = (j == x) ? c : mine; }
        if (sum == G) break;
        __builtin_amdgcn_s_sleep(1);
        if ((++sp & 255u) == 0u) { if (xb_ld(&bar[XB_TMO])) break; if (sp > XB_SPIN_CAP) { atomicAdd(&bar[XB_TMO], 1u); break; } }
    }
    nloc = mine > 0u ? mine : 1u; nx = cnt > 0u ? cnt : 1u;
}
__device__ __forceinline__ void xcd_barrier(const XcdBarrier& b) {
    asm volatile("s_waitcnt vmcnt(0)" ::: "memory");
    __syncthreads();
    if (hw_tid() == 0) {
        unsigned* bar = b.bar;
        __builtin_amdgcn_s_waitcnt(0);
        unsigned nloc = b.st[0], nx = b.st[1];
        if (nloc == 0u) { xcd_barrier_complete(bar, b.x, nloc, nx); b.st[0] = nloc; b.st[1] = nx; }
        const unsigned old = xb_add(&bar[XB_XSUB(b.x)], 1u);
        const unsigned gen = old / nloc;
        if (old + 1u == (gen + 1u) * nloc) {
            __builtin_amdgcn_fence(__ATOMIC_RELEASE, "agent");
            asm volatile("s_waitcnt vmcnt(0)" ::: "memory");
            const unsigned og = xb_add(&bar[XB_TOP], 1u);
            const unsigned tg = og / nx;
            if (og + 1u == (tg + 1u) * nx) xb_add(&bar[XB_TOPGEN], 1u);
            else XB_SPIN(xb_ld(&bar[XB_TOPGEN]) == tg, bar);
            __builtin_amdgcn_fence(__ATOMIC_ACQUIRE, "agent");
            xb_add(&bar[XB_XGEN(b.x)], 1u);
            asm volatile("s_waitcnt vmcnt(0)" ::: "memory");
        } else {
            XB_SPIN(xb_ld(&bar[XB_XGEN(b.x)]) == gen, bar);
            __builtin_amdgcn_fence(__ATOMIC_ACQUIRE, "agent");
            asm volatile("s_waitcnt vmcnt(0)" ::: "memory");
        }
    }
    __syncthreads();
}

constexpr size_t OFF_BAR = 448 * 1024;

__global__ void __launch_bounds__(512, 2) mk_fwd(Params p) {
    extern __shared__ __attribute__((aligned(16))) unsigned char smem[];
    LAS unsigned char* lds0 = (LAS unsigned char*)smem;
    {
        const unsigned hw = (unsigned)__builtin_amdgcn_s_getreg((5 << 11) | 4) & 63u;
        if ((threadIdx.x & 63) == 0) *(volatile LAS int*)(LDS_HWTAB + hw * 4) = (int)(threadIdx.x >> 6);
        if (threadIdx.x < 64) ((LAS unsigned*)(lds0 + LDS_CTL))[threadIdx.x] = 0u;
    }
    __syncthreads();
    XcdBarrier bar; bar.bar = (unsigned*)(p.ws + OFF_BAR); bar.x = 0; bar.st = nullptr;
    bar = xcd_barrier_post((unsigned*)(p.ws + OFF_BAR), (volatile LAS unsigned*)(lds0 + LDS_CTL));
#ifndef PROBE
#define PROBE -1
#endif
#ifndef PROBE_END
#define PROBE_END (PROBE + 1)
#endif
    unsigned long long pt0 = 0, pt1 = 0;
#define RUN_PHASE(k, call) { if ((k) > 0) xcd_barrier(bar); if (PROBE >= 0 && (k) == PROBE) pt0 = __builtin_amdgcn_s_memrealtime(); if (PROBE >= 0 && (k) == PROBE_END) pt1 = __builtin_amdgcn_s_memrealtime(); \
    int on_ = 1; asm volatile("" : "+s"(on_)); if (on_) { int grp_ = hw_tid() >> 8; asm volatile("" : "+v"(grp_)); LAS unsigned char* lds = lds0 + grp_ * 32768; (void)lds; call; } }
    RUN_PHASE(0, phase_prep(p, lds))
    RUN_PHASE(1, phase_xn(p))
    RUN_PHASE(2, phase_inproj(p, lds0))
    RUN_PHASE(3, phase_attn_pool(p, lds, (char*)smem))
    RUN_PHASE(4, phase_outproj(p, lds0))
    RUN_PHASE(5, phase_router(p, lds0))
    RUN_PHASE(6, phase_gateup(p, lds0))
    RUN_PHASE(7, phase_down(p, lds0, 0))
    RUN_PHASE(8, phase_combine(p))
    RUN_PHASE(9, phase_down(p, lds0, 1))
    RUN_PHASE(10, phase_final(p))
    if (PROBE >= 0) {
        if (PROBE_END == 11) pt1 = __builtin_amdgcn_s_memrealtime();
        if (blockIdx.x == 0 && hw_tid() == 0) { const unsigned long long tend = __builtin_amdgcn_s_memrealtime() + 8ull * (pt1 - pt0); while (__builtin_amdgcn_s_memrealtime() < tend) __builtin_amdgcn_s_sleep(8); }
    }
}

extern "C" void kernel_launch(void* const* d_in, const int* in_sizes, int n_in, void* d_out, int out_size, void* d_ws, size_t ws_size, hipStream_t stream) {
    static int grid = 0;
    if (grid == 0) {
        int dev = 0, cus = 0, per_cu = 0;
        (void)hipGetDevice(&dev);
        (void)hipDeviceGetAttribute(&cus, hipDeviceAttributeMultiprocessorCount, dev);
        (void)hipFuncSetAttribute((const void*)mk_fwd, hipFuncAttributeMaxDynamicSharedMemorySize, LDS_BYTES);
        (void)hipOccupancyMaxActiveBlocksPerMultiprocessor(&per_cu, (const void*)mk_fwd, 512, LDS_BYTES);
        if (per_cu < 1) fprintf(stderr, "kernel_launch: occupancy query says %d blocks per CU\n", per_cu);
        (void)hipGetLastError();
        grid = cus;
        if (ws_size < WS_NEED) fprintf(stderr, "kernel_launch: workspace too small: %zu < %zu\n", ws_size, (size_t)WS_NEED);
    }
    Params p{};
    const float** pp = (const float**)&p;
    for (int i = 0; i < 24; ++i) pp[i] = (const float*)d_in[i];
    p.out = (float*)d_out; p.ws = (unsigned char*)d_ws;
    (void)hipMemsetAsync((char*)d_ws + OFF_BAR, 0, XCD_BAR_WORDS * 4, stream);
    hipLaunchKernelGGL(mk_fwd, dim3(grid), dim3(512), LDS_BYTES, stream, p);
}
```

```cpp
#include <hip/hip_runtime.h>
#include <stdint.h>
#include <stdio.h>


#define LAS __attribute__((address_space(3)))
#define TIDX ((int)(hw_tid() & 255))
#define VBLK ((int)(blockIdx.x * 2 + (hw_tid() >> 8)))
#define NVBLK ((int)(gridDim.x * 2))
typedef unsigned short bf16_t;
typedef short bf16x8 __attribute__((ext_vector_type(8)));
typedef float f32x4 __attribute__((ext_vector_type(4)));
typedef unsigned u32x4 __attribute__((ext_vector_type(4)));
typedef unsigned u32x2 __attribute__((ext_vector_type(2)));

constexpr int D = 1024, NB = 16, SEQ = 2048, T = NB * SEQ, CTXL = 256, TC = NB * CTXL, KVL = CTXL + SEQ;
constexpr int PW = 1536, NE = 64, NEX = 65, FF = 256, NSLOT = 9, MODW = 6 * D;
constexpr float ALPHA = 1.189207115002721f;
constexpr float C2 = 0.125f * 1.4426950408889634f;
constexpr int NPHASE = 11;
constexpr int LDS_BYTES = 163840, LDS_CTL = 143360, LDS_AUX = 147456;
constexpr int LDS_HWTAB = LDS_CTL + 1024;
__device__ __forceinline__ int hw_tid() {
    const unsigned hw = (unsigned)__builtin_amdgcn_s_getreg((5 << 11) | 4) & 63u;
    const int w = __builtin_amdgcn_readfirstlane(*(volatile LAS int*)(LDS_HWTAB + hw * 4));
    return w * 64 + (int)__builtin_amdgcn_mbcnt_hi(~0u, __builtin_amdgcn_mbcnt_lo(~0u, 0u));
}

constexpr size_t MiB = 1u << 20;
constexpr size_t OFF_CNT = 0, OFF_MOD = 4096, OFF_ROPE = 512 * 1024;
constexpr size_t OFF_WRH = 483 * MiB, OFF_WRL = OFF_WRH + 128 * 1024;
constexpr size_t OFF_WTIN = 1 * MiB, OFF_WTOUT = 4 * MiB, OFF_WGU = 6 * MiB, OFF_WD = 71 * MiB;
constexpr size_t OFF_H = 104 * MiB, OFF_LDST = 168 * MiB, OFF_LW = 176 * MiB, OFF_ACT = 184 * MiB, OFF_SLOTS = 338 * MiB;
constexpr size_t OFF_XN = 184 * MiB, OFF_Q = 256 * MiB, OFF_K = 304 * MiB, OFF_V = 322 * MiB, OFF_U = 340 * MiB, OFF_AO = 356 * MiB, OFF_STATS = 420 * MiB;
constexpr size_t WS_NEED = 484 * MiB;

struct Params {
    const float *x, *c, *ctx, *c_ctx, *w_mod, *b_mod, *w_in, *q_norm, *k_norm, *pool_w, *pool_scale, *w_out, *ln1_g, *ln1_b,
        *w_router, *router_bias, *w_gate, *w_up, *w_down, *ws_gate, *ws_up, *ws_down, *ln2_g, *ln2_b;
    float* out;
    unsigned char* ws;
};

__device__ __forceinline__ unsigned f2bf(float f) { unsigned u = __float_as_uint(f); return (u + 0x7fffu + ((u >> 16) & 1u)) >> 16; }
__device__ __forceinline__ unsigned pk2(float lo, float hi) { return f2bf(lo) | (f2bf(hi) << 16); }
__device__ __forceinline__ float bf2f(unsigned h) { return __uint_as_float(h << 16); }
__device__ __forceinline__ float bflo(unsigned w) { return __uint_as_float(w << 16); }
__device__ __forceinline__ float bfhi(unsigned w) { return __uint_as_float(w & 0xffff0000u); }

namespace pg8 {
constexpr int BM = 256, BK = 64, HALF = 128, HTB = HALF * BK * 2, STAGE_BYTES = 8 * HTB;
__host__ __device__ __forceinline__ int lds_byte(int r, int c) { const int st = (r >> 4) * 2 + (c >> 5), rr = r & 15, cc = c & 31, ob = rr * 64 + cc * 2; return st * 1024 + (ob ^ (((ob >> 9) & 1) << 5)); }
__host__ __device__ __forceinline__ void stage_rc(int b, int& R, int& C) { const int st = b / 1024, sb = b % 1024, swz = sb ^ (((sb >> 9) & 1) << 5); R = (st >> 1) * 16 + swz / 64; C = (st & 1) * 32 + (swz % 64) / 2; }
__host__ __device__ __forceinline__ int perm32(int rho) { const int n = rho >> 4, i = rho & 15; return 8 * (i >> 2) + 4 * n + (i & 3); }
struct Unit { int pm, pn, idx, e; };
struct Gemm { const bf16_t* A; const bf16_t* Bt; };
__device__ __forceinline__ unsigned cvt_pk_bf16(float lo, float hi) { unsigned r; asm volatile("v_cvt_pk_bf16_f32 %0, %1, %2" : "=v"(r) : "v"(lo), "v"(hi)); return r; }

template <int K, class Epi, class Sched, bool GATHER, bool ALIGN_EPI = true>
__device__ __forceinline__ void gemm_phase(LAS unsigned char* lds, const Gemm g, const Sched& S, const Epi& E) {
    const int tid = hw_tid(), wid = __builtin_amdgcn_readfirstlane(tid >> 6), lane = tid & 63, wr = wid >> 2, wc = wid & 3, fr = lane & 15, fq = lane >> 4;
    constexpr int nt = K / BK;
    unsigned voffA[2], voffB[2], colA = 0; int rowA = 0;
#pragma unroll
    for (int i = 0; i < 2; ++i) { int R, C; stage_rc(tid * 16 + i * 8192, R, C); const int Rb = Epi::PERM ? ((R & ~31) + perm32(R & 31)) : R;
        voffA[i] = (unsigned)(R * K + C) * 2u; voffB[i] = (unsigned)(Rb * K + C) * 2u; if (i == 0) { colA = (unsigned)C * 2u; rowA = R; } }
    const size_t kstep = (size_t)(BK * 2);
    const size_t hstep = (size_t)HALF * K * 2;
    const size_t tstep = 2 * hstep;
    const unsigned ldsw = (unsigned)wid * 1024u;
    const int aoff = lds_byte(wr * 64 + fr, fq * 8), boff = lds_byte(wc * 32 + fr, fq * 8);
#define PG8_SA(b, h) (((b) * 2 + (h)) * HTB)
#define PG8_SB(b, h) ((4 + (b) * 2 + (h)) * HTB)
#define PG8_STAGE(bufoff, gbase, voff) do { _Pragma("unroll") for (int _i = 0; _i < 2; ++_i) \
        __builtin_amdgcn_global_load_lds((const unsigned*)((const char*)(gbase) + (voff)[_i]), (LAS unsigned*)(lds + (bufoff) + ldsw + _i * 8192), 16, 0, 0); } while (0)
#define PG8_STAGE_A(bufoff, ptr, h, NX) do { if constexpr (GATHER) { unsigned _v[2]; \
            if (NX) { _v[0] = S.row_off(nidx, (h) * HALF + rowA) + colA; _v[1] = S.row_off(nidx, (h) * HALF + rowA + 64) + colA; } else { _v[0] = vA[h][0]; _v[1] = vA[h][1]; } PG8_STAGE(bufoff, ptr, _v); } \
        else { PG8_STAGE(bufoff, (ptr) + (h) * hstep, voffA); } } while (0)
#define PG8_LDA(dst, b, h) do { _Pragma("unroll") for (int m = 0; m < 4; ++m) _Pragma("unroll") for (int k = 0; k < 2; ++k) dst[m][k] = *(const LAS bf16x8*)(lds + PG8_SA(b, h) + aoff + m * 2048 + k * 1024); } while (0)
#define PG8_LDB(dst, b, h) do { _Pragma("unroll") for (int n = 0; n < 2; ++n) _Pragma("unroll") for (int k = 0; k < 2; ++k) dst[n][k] = *(const LAS bf16x8*)(lds + PG8_SB(b, h) + boff + n * 2048 + k * 1024); } while (0)
#define PG8_MMA(ai, bj, At, Bt) do { __builtin_amdgcn_s_setprio(1); _Pragma("unroll") for (int m = 0; m < 4; ++m) _Pragma("unroll") for (int n = 0; n < 2; ++n) _Pragma("unroll") for (int k = 0; k < 2; ++k) \
        acc[ai][bj][m][n] = __builtin_amdgcn_mfma_f32_16x16x32_bf16(Bt[n][k], At[m][k], acc[ai][bj][m][n], 0, 0, 0); __builtin_amdgcn_s_setprio(0); } while (0)
#define PG8_WAIT_V(n) asm volatile("s_waitcnt vmcnt(" #n ")" ::: "memory")
#define PG8_WAIT_L(n) asm volatile("s_waitcnt lgkmcnt(" #n ")" ::: "memory")
#define PG8_BAR __builtin_amdgcn_s_barrier()
#define PG8_SCHED __builtin_amdgcn_sched_barrier(0)
    Unit cur, nxt; int ui = 0;
    if (!S.next(0, cur)) return;
    f32x4 acc[2][2][4][2];
#pragma unroll
    for (int a = 0; a < 2; ++a)
#pragma unroll
        for (int b = 0; b < 2; ++b)
#pragma unroll
            for (int m = 0; m < 4; ++m)
#pragma unroll
                for (int n = 0; n < 2; ++n) acc[a][b][m][n] = (f32x4){0.f, 0.f, 0.f, 0.f};
    bf16x8 At[4][2], B0[2][2], B1[2][2];
    unsigned vA[2][2]; int nidx = 0;
    if constexpr (GATHER) {
#pragma unroll
        for (int h = 0; h < 2; ++h)
#pragma unroll
            for (int i = 0; i < 2; ++i) vA[h][i] = S.row_off(cur.idx, h * HALF + rowA + 64 * i) + colA;
    }
    const char* cA = GATHER ? (const char*)g.A : (const char*)g.A + (size_t)cur.pm * tstep; const char* cB = (const char*)g.Bt + (size_t)cur.pn * tstep;
    S.a_ready(cur);
    PG8_STAGE(PG8_SB(0, 0), cB, voffB); PG8_STAGE(PG8_SB(0, 1), cB + hstep, voffB); PG8_STAGE_A(PG8_SA(0, 0), cA, 0, false); PG8_STAGE_A(PG8_SA(0, 1), cA, 1, false);
    if (wr == 1) PG8_BAR;
    PG8_WAIT_V(2); PG8_BAR;
    PG8_STAGE(PG8_SB(1, 0), cB + kstep, voffB); PG8_STAGE_A(PG8_SA(1, 0), cA + kstep, 0, false); PG8_STAGE(PG8_SB(1, 1), cB + hstep + kstep, voffB);
    PG8_WAIT_V(6); PG8_BAR;
    for (;;) {
        const bool has_next = S.next(ui + 1, nxt);
        if constexpr (GATHER) nidx = has_next ? nxt.idx : cur.idx;
        const char* nA = GATHER ? (const char*)g.A : (has_next ? (const char*)g.A + (size_t)nxt.pm * tstep : cA); const char* nB = has_next ? (const char*)g.Bt + (size_t)nxt.pn * tstep : cB;
        for (int t = 0; t < nt; t += 2) {
            const bool last = (t == nt - 2);
            const char* a1 = cA + (size_t)(t + 1) * kstep;
            const char* a2 = last ? nA : cA + (size_t)(t + 2) * kstep; const char* b2 = last ? nB : cB + (size_t)(t + 2) * kstep;
            const char* a3 = a2 + kstep; const char* b3 = b2 + kstep;
            if (last && has_next) S.a_ready(nxt);
            PG8_LDB(B0, 0, 0); PG8_LDB(B1, 0, 1); PG8_SCHED; PG8_LDA(At, 0, 0); PG8_STAGE_A(PG8_SA(1, 1), a1, 1, false);
            PG8_WAIT_V(8); PG8_WAIT_L(0); PG8_BAR; PG8_MMA(0, 0, At, B0); PG8_MMA(0, 1, At, B1); PG8_BAR; PG8_SCHED;
            PG8_LDA(At, 0, 1); PG8_STAGE(PG8_SB(0, 0), b2, voffB); PG8_STAGE(PG8_SB(0, 1), b2 + hstep, voffB); PG8_STAGE_A(PG8_SA(0, 0), a2, 0, last);
            PG8_WAIT_V(8); PG8_WAIT_L(0); PG8_BAR; PG8_MMA(1, 0, At, B0); PG8_MMA(1, 1, At, B1); PG8_BAR; PG8_SCHED;
            PG8_LDB(B0, 1, 0); PG8_LDB(B1, 1, 1); PG8_SCHED; PG8_LDA(At, 1, 0); PG8_STAGE_A(PG8_SA(0, 1), a2, 1, last);
            PG8_WAIT_V(8); PG8_WAIT_L(0); PG8_BAR; PG8_MMA(0, 0, At, B0); PG8_MMA(0, 1, At, B1); PG8_BAR; PG8_SCHED;
            PG8_LDA(At, 1, 1); PG8_STAGE(PG8_SB(1, 0), b3, voffB); PG8_STAGE(PG8_SB(1, 1), b3 + hstep, voffB); PG8_STAGE_A(PG8_SA(1, 0), a3, 0, last);
            PG8_WAIT_V(8); PG8_WAIT_L(0); PG8_BAR; PG8_MMA(1, 0, At, B0); PG8_MMA(1, 1, At, B1); PG8_BAR; PG8_SCHED;
        }
        if constexpr (ALIGN_EPI) { if (wr == 0) PG8_BAR; }
        E(acc, cur, wr, wc, fr, fq); S.done(cur);
        if (!has_next) break;
#pragma unroll
        for (int a = 0; a < 2; ++a)
#pragma unroll
            for (int b = 0; b < 2; ++b)
#pragma unroll
                for (int m = 0; m < 4; ++m)
#pragma unroll
                    for (int n = 0; n < 2; ++n) acc[a][b][m][n] = (f32x4){0.f, 0.f, 0.f, 0.f};
        cur = nxt; cA = nA; cB = nB; ++ui;
        if constexpr (GATHER) {
#pragma unroll
            for (int h = 0; h < 2; ++h)
#pragma unroll
                for (int i = 0; i < 2; ++i) vA[h][i] = S.row_off(cur.idx, h * HALF + rowA + 64 * i) + colA;
        }
        if constexpr (ALIGN_EPI) { if (wr == 1) PG8_BAR; }
    }
    PG8_WAIT_V(0);
    if constexpr (!ALIGN_EPI) { if (wr == 0) PG8_BAR; }
    PG8_BAR;
#undef PG8_SA
#undef PG8_SB
#undef PG8_STAGE
#undef PG8_STAGE_A
#undef PG8_LDA
#undef PG8_LDB
#undef PG8_MMA
#undef PG8_WAIT_V
#undef PG8_WAIT_L
#undef PG8_BAR
#undef PG8_SCHED
}

struct DenseSched {
    int nN, n1, total, pn2lo, nN2, G, c;
    __device__ __forceinline__ bool next(int i, Unit& u) const {
        const int L = i * G + c; if (L >= total) return false;
        if (L < n1) { u.pm = L / nN; u.pn = L % nN; } else { const int r = L - n1; u.pm = n1 / nN + r / nN2; u.pn = pn2lo + r % nN2; }
        u.idx = i; u.e = 0; return true;
    }
    __device__ __forceinline__ void a_ready(const Unit&) const {}
    __device__ __forceinline__ void done(const Unit&) const {}
};
}

__device__ __forceinline__ int win_row(int n) { return (n & ~255) + 128 * ((n >> 5) & 1) + 32 * ((n >> 6) & 3) + (n & 31); }
__device__ __forceinline__ int gu_row(int j, int half) { return (j >> 7) * 256 + half * 128 + (j & 127); }

template <class RowMap>
__device__ __forceinline__ void transpose_tile(LAS float* tile, const float* src, int ld, int k0, int n0, bf16_t* dst, int Kdst, RowMap rowmap) {
    const int tid = TIDX;
#pragma unroll
    for (int pss = 0; pss < 4; ++pss) {
        const int k = pss * 16 + (tid >> 4), n4 = (tid & 15) * 4;
        const f32x4 v = *(const f32x4*)(src + (size_t)(k0 + k) * ld + n0 + n4);
        tile[k * 65 + n4 + 0] = v[0]; tile[k * 65 + n4 + 1] = v[1]; tile[k * 65 + n4 + 2] = v[2]; tile[k * 65 + n4 + 3] = v[3];
    }
    __syncthreads();
    {
        const int n = tid >> 2, kc = (tid & 3) * 16;
        unsigned w[8];
#pragma unroll
        for (int i = 0; i < 8; ++i) w[i] = pk2(tile[(kc + 2 * i) * 65 + n], tile[(kc + 2 * i + 1) * 65 + n]);
        bf16_t* dp = dst + (size_t)rowmap(n0 + n) * Kdst + k0 + kc;
        *(u32x4*)dp = (u32x4){w[0], w[1], w[2], w[3]};
        *(u32x4*)(dp + 8) = (u32x4){w[4], w[5], w[6], w[7]};
    }
    __syncthreads();
}

template <class RowMap>
__device__ __forceinline__ void wave_transpose(LAS float* scr, const float* src, int ld, int k0, int n0, bf16_t* dst, int Kdst, RowMap rowmap, int lane) {
#pragma unroll
    for (int i = 0; i < 8; ++i) {
        const int kk = 8 * i + (lane >> 3), n4 = (lane & 7) * 4;
        const f32x4 v = *(const f32x4*)(src + (size_t)(k0 + kk) * ld + n0 + n4);
        scr[kk * 33 + n4] = v[0]; scr[kk * 33 + n4 + 1] = v[1]; scr[kk * 33 + n4 + 2] = v[2]; scr[kk * 33 + n4 + 3] = v[3];
    }
    asm volatile("s_waitcnt lgkmcnt(0)" ::: "memory");
    const int c = lane & 7;
#pragma unroll
    for (int j = 0; j < 4; ++j) {
        const int n = (lane >> 3) + 8 * j; const LAS float* sp = scr + (8 * c) * 33 + n;
        u32x4 o; o.x = pk2(sp[0], sp[33]); o.y = pk2(sp[2 * 33], sp[3 * 33]); o.z = pk2(sp[4 * 33], sp[5 * 33]); o.w = pk2(sp[6 * 33], sp[7 * 33]);
        *(u32x4*)(dst + (size_t)rowmap(n0 + n) * Kdst + k0 + 8 * c) = o;
    }
    asm volatile("s_waitcnt lgkmcnt(0)" ::: "memory");
}

__device__ __forceinline__ void phase_prep(const Params& p, LAS unsigned char* lds) {
    const int tid = TIDX;
    int* gcnt = (int*)(p.ws + OFF_CNT);
    if (VBLK == 0 && tid < 128) gcnt[tid] = 0;
    float* mod = (float*)(p.ws + OFF_MOD);
    float* rope = (float*)(p.ws + OFF_ROPE);
    constexpr int N_MOD = 384, N_ROPE = 256, N_TR = 16;
    for (int it = VBLK; it < N_MOD + N_ROPE + N_TR; it += NVBLK) {
        if (it < N_MOD) {
            LAS float* sl = (LAS float*)lds;
            LAS float* red = (LAS float*)(lds + 10240);
            const int col = it * 16 + (tid & 15), kk = tid >> 4;
            float acc[17];
#pragma unroll
            for (int r = 0; r < 17; ++r) acc[r] = 0.f;
            for (int kc = 0; kc < 8; ++kc) {
                float wv[8];
#pragma unroll
                for (int i = 0; i < 8; ++i) wv[i] = p.w_mod[(size_t)(kc * 128 + kk + 16 * i) * MODW + col];
                __syncthreads();
                for (int o = tid; o < 17 * 128; o += 256) {
                    const int r = o >> 7, kl = o & 127;
                    const float cv = (r < 16) ? p.c[r * D + kc * 128 + kl] : p.c_ctx[kc * 128 + kl];
                    sl[kl * 20 + r] = cv / (1.f + expf(-cv));
                }
                __syncthreads();
#pragma unroll
                for (int i = 0; i < 8; ++i) {
                    const int kl = kk + 16 * i;
                    const f32x4 s0 = *(const LAS f32x4*)(sl + kl * 20), s1 = *(const LAS f32x4*)(sl + kl * 20 + 4), s2 = *(const LAS f32x4*)(sl + kl * 20 + 8), s3 = *(const LAS f32x4*)(sl + kl * 20 + 12);
                    const float s4 = sl[kl * 20 + 16];
#pragma unroll
                    for (int q = 0; q < 4; ++q) { acc[q] += s0[q] * wv[i]; acc[4 + q] += s1[q] * wv[i]; acc[8 + q] += s2[q] * wv[i]; acc[12 + q] += s3[q] * wv[i]; }
                    acc[16] += s4 * wv[i];
                }
            }
#pragma unroll
            for (int r = 0; r < 17; ++r) red[(kk * 17 + r) * 16 + (tid & 15)] = acc[r];
            __syncthreads();
            for (int o = tid; o < 17 * 16; o += 256) {
                const int r = o >> 4, j = o & 15;
                float sm = p.b_mod[it * 16 + j];
#pragma unroll
                for (int g = 0; g < 16; ++g) sm += red[(g * 17 + r) * 16 + j];
                mod[r * MODW + it * 16 + j] = sm;
            }
            __syncthreads();
        } else if (it < N_MOD + N_ROPE) {
            const int idx = (it - N_MOD) * 256 + tid, t = idx >> 5, i = idx & 31;
            const int pos = (i < 16) ? (t >> 6) : (t & 63);
            const float invf = (float)exp(-(double)(i & 15) / 16.0 * 9.210340371976184);
            const double ang = (double)((float)pos * invf);
            rope[idx * 2 + 0] = (float)cos(ang);
            rope[idx * 2 + 1] = (float)sin(ang);
        } else {
            LAS float* tile = (LAS float*)lds;
            const int idx = it - N_MOD - N_ROPE;
            {

                const int k0 = idx * 64;
#pragma unroll
                for (int pss = 0; pss < 4; ++pss) {
                    const int k = pss * 16 + (tid >> 4), n4 = (tid & 15) * 4;
                    const f32x4 v = *(const f32x4*)(p.w_router + (size_t)(k0 + k) * NE + n4);
                    tile[k * 65 + n4 + 0] = v[0]; tile[k * 65 + n4 + 1] = v[1]; tile[k * 65 + n4 + 2] = v[2]; tile[k * 65 + n4 + 3] = v[3];
                }
                __syncthreads();
                {
                    const int n = tid >> 2, kc = (tid & 3) * 16;
                    unsigned wh[8], wl[8];
#pragma unroll
                    for (int i = 0; i < 8; ++i) {
                        const float a = tile[(kc + 2 * i) * 65 + n], b = tile[(kc + 2 * i + 1) * 65 + n];
                        const unsigned ha = f2bf(a), hb = f2bf(b);
                        wh[i] = ha | (hb << 16);
                        wl[i] = pk2(a - bf2f(ha), b - bf2f(hb));
                    }
                    bf16_t* dh = (bf16_t*)(p.ws + OFF_WRH) + (size_t)n * D + k0 + kc;
                    bf16_t* dl = (bf16_t*)(p.ws + OFF_WRL) + (size_t)n * D + k0 + kc;
                    *(u32x4*)dh = (u32x4){wh[0], wh[1], wh[2], wh[3]}; *(u32x4*)(dh + 8) = (u32x4){wh[4], wh[5], wh[6], wh[7]};
                    *(u32x4*)dl = (u32x4){wl[0], wl[1], wl[2], wl[3]}; *(u32x4*)(dl + 8) = (u32x4){wl[4], wl[5], wl[6], wl[7]};
                }
                __syncthreads();
            }
        }
    }
    __syncthreads();
    {
        const int lane = hw_tid() & 63, wv = hw_tid() >> 6;
        LAS float* scr = (LAS float*)(lds - (hw_tid() >> 8) * 32768) + wv * (64 * 33);
        constexpr int I_IN = 16 * 48, I_OUT = 16 * 32, I_E = 384, NITEMS = I_IN + I_OUT + NEX * I_E;
        for (int it = blockIdx.x * 8 + wv; it < NITEMS; it += gridDim.x * 8) {
            int r = it;
            if (r < I_IN) { wave_transpose(scr, p.w_in, PW, (r / 48) * 64, (r % 48) * 32, (bf16_t*)(p.ws + OFF_WTIN), D, [](int n) { return win_row(n); }, lane); continue; }
            r -= I_IN;
            if (r < I_OUT) { wave_transpose(scr, p.w_out, D, (r / 32) * 64, (r % 32) * 32, (bf16_t*)(p.ws + OFF_WTOUT), D, [](int n) { return n; }, lane); continue; }
            r -= I_OUT;
            const int e = r / I_E, q = r % I_E;
            if (q < 256) {
                const int half = q >> 7, rr = q & 127;
                const float* src = half ? (e < NE ? p.w_up + (size_t)e * D * FF : p.ws_up) : (e < NE ? p.w_gate + (size_t)e * D * FF : p.ws_gate);
                wave_transpose(scr, src, FF, (rr / 8) * 64, (rr % 8) * 32, (bf16_t*)(p.ws + OFF_WGU) + (size_t)e * 512 * D, D, [half](int n) { return gu_row(n, half); }, lane);
            } else {
                const int rr = q - 256;
                const float* src = e < NE ? p.w_down + (size_t)e * FF * D : p.ws_down;
                wave_transpose(scr, src, D, (rr / 32) * 64, (rr % 32) * 32, (bf16_t*)(p.ws + OFF_WD) + (size_t)e * D * FF, FF, [](int n) { return n; }, lane);
            }
        }
    }
}

__device__ __forceinline__ void phase_xn(const Params& p) {
    const int lane = TIDX & 63, gw = VBLK * 4 + (TIDX >> 6), ngw = NVBLK * 4;
    const float* mod = (const float*)(p.ws + OFF_MOD);
    bf16_t* XN = (bf16_t*)(p.ws + OFF_XN);
    for (int row = gw; row < T + TC; row += ngw) {
        const float* src = row < T ? p.x + (size_t)row * D : p.ctx + (size_t)(row - T) * D;
        const float* mr = mod + (size_t)(row < T ? row / SEQ : 16) * MODW;
#pragma unroll
        for (int j = 0; j < 4; ++j) {
            const int c = 4 * lane + 256 * j;
            const f32x4 v = *(const f32x4*)(src + c), sh = *(const f32x4*)(mr + c), sc = *(const f32x4*)(mr + D + c);
            u32x2 o; o.x = pk2(v[0] * (1.f + sc[0]) + sh[0], v[1] * (1.f + sc[1]) + sh[1]); o.y = pk2(v[2] * (1.f + sc[2]) + sh[2], v[3] * (1.f + sc[3]) + sh[3]);
            *(u32x2*)(XN + (size_t)row * D + c) = o;
        }
    }
}

struct EpiIn {
    static constexpr bool PERM = true;
    const float *q_norm, *k_norm, *rope; bf16_t *Qb, *Kb, *Vb, *Ub;
    __device__ __forceinline__ void operator()(const f32x4 (&acc)[2][2][4][2], const pg8::Unit& u, int wr, int wc, int fr, int fq) const {
        const int grp = u.pn * 4 + wc;
        const bool is_ctx = u.pm >= T / 256;
        f32x4 gn[2][2];
        if (grp >= 4 && grp < 20) {
            const float* g = grp < 16 ? q_norm : k_norm;
#pragma unroll
            for (int bj = 0; bj < 2; ++bj)
#pragma unroll
                for (int n = 0; n < 2; ++n) gn[bj][n] = *(const f32x4*)(g + 32 * bj + 8 * fq + 4 * n);
        }
#pragma unroll
        for (int ai = 0; ai < 2; ++ai)
#pragma unroll
            for (int m = 0; m < 4; ++m) {
                const int row = u.pm * 256 + ai * 128 + wr * 64 + m * 16 + fr;
                f32x4 v[2][2];
#pragma unroll
                for (int bj = 0; bj < 2; ++bj)
#pragma unroll
                    for (int n = 0; n < 2; ++n) v[bj][n] = acc[ai][bj][m][n];
                bf16_t* dst;
                if (grp < 4) dst = Ub + (size_t)row * 256 + grp * 64;
                else if (grp < 16) dst = Qb + (size_t)row * 768 + (grp - 4) * 64;
                else {
                    const size_t krow = is_ctx ? (size_t)((row - T) >> 8) * KVL + ((row - T) & 255) : (size_t)(row >> 11) * KVL + CTXL + (row & (SEQ - 1));
                    dst = (grp < 20 ? Kb + (grp - 16) * 64 : Vb + (grp - 20) * 64) + krow * 256;
                }
                if (grp >= 4 && grp < 20) {
                    float ss = 0.f;
#pragma unroll
                    for (int bj = 0; bj < 2; ++bj)
#pragma unroll
                        for (int n = 0; n < 2; ++n) ss += (v[bj][n][0] * v[bj][n][0] + v[bj][n][1] * v[bj][n][1]) + (v[bj][n][2] * v[bj][n][2] + v[bj][n][3] * v[bj][n][3]);
                    ss += __shfl_xor(ss, 16); ss += __shfl_xor(ss, 32);
                    const float rs = 1.0f / sqrtf(ss * (1.f / 64.f) + 1e-6f);
#pragma unroll
                    for (int bj = 0; bj < 2; ++bj)
#pragma unroll
                        for (int n = 0; n < 2; ++n) v[bj][n] = v[bj][n] * rs * gn[bj][n];
                    if (!is_ctx) {
                        const int tpos = row & (SEQ - 1);
#pragma unroll
                        for (int bj = 0; bj < 2; ++bj)
#pragma unroll
                            for (int n = 0; n < 2; ++n) {
                                const f32x4 cs = *(const f32x4*)(rope + (size_t)(tpos * 32 + 16 * bj + 4 * fq + 2 * n) * 2);
                                const f32x4 x = v[bj][n];
                                v[bj][n] = (f32x4){x[0] * cs[0] - x[1] * cs[1], x[0] * cs[1] + x[1] * cs[0], x[2] * cs[2] - x[3] * cs[3], x[2] * cs[3] + x[3] * cs[2]};
                            }
                    }
                    if (grp < 16) {
#pragma unroll
                        for (int bj = 0; bj < 2; ++bj)
#pragma unroll
                            for (int n = 0; n < 2; ++n) v[bj][n] = v[bj][n] * C2;
                    }
                }
#pragma unroll
                for (int bj = 0; bj < 2; ++bj) {
                    u32x4 w; w.x = pk2(v[bj][0][0], v[bj][0][1]); w.y = pk2(v[bj][0][2], v[bj][0][3]); w.z = pk2(v[bj][1][0], v[bj][1][1]); w.w = pk2(v[bj][1][2], v[bj][1][3]);
                    *(u32x4*)(dst + 32 * bj + 8 * fq) = w;
                }
            }
    }
};
__device__ __forceinline__ int vcu_of_block() { const int G = gridDim.x, bx = blockIdx.x; return (G % 8 == 0) ? (bx % 8) * (G / 8) + bx / 8 : bx; }
__device__ __forceinline__ void phase_inproj(const Params& p, LAS unsigned char* lds) {
    pg8::Gemm g{(const bf16_t*)(p.ws + OFF_XN), (const bf16_t*)(p.ws + OFF_WTIN)};
    pg8::DenseSched S{6, 768, 800, 4, 2, (int)gridDim.x, vcu_of_block()};
    EpiIn E{p.q_norm, p.k_norm, (const float*)(p.ws + OFF_ROPE), (bf16_t*)(p.ws + OFF_Q), (bf16_t*)(p.ws + OFF_K), (bf16_t*)(p.ws + OFF_V), (bf16_t*)(p.ws + OFF_U)};
    pg8::gemm_phase<D, EpiIn, pg8::DenseSched, false>(lds, g, S, E);
}

namespace attn_body {
using bf16=unsigned short;
using bf16x8=__attribute__((ext_vector_type(8)))short;
using s16x4=__attribute__((ext_vector_type(4)))short;
using f32x16=__attribute__((ext_vector_type(16)))float;
using u32x4=__attribute__((ext_vector_type(4)))unsigned;
constexpr int D=64,QP=768,KP=256,OP=1024,SEQ=2048,KVLEN=2304;
constexpr int NW=8,QBLK=32,QB=QBLK*NW,KVBLK=64,NT=KVLEN/KVBLK;
__device__ __forceinline__ int crow(int r,int hi){return (r&3)+8*(r>>2)+4*hi;}
#define SBAR() __builtin_amdgcn_sched_barrier(0)
constexpr int NSLOT=3, SLOTB=8192;
constexpr int LDS_K=0, LDS_V=NSLOT*SLOTB, LDS_WS=2*NSLOT*SLOTB, LDS_OST=LDS_WS+NW*64*4, LDS_BYTES=LDS_OST+NW*4096;
constexpr float C2=0.125f*1.4426950408889634f;
__device__ __forceinline__ void glds16(const void*gsrc,unsigned lds_dst){unsigned keep;
  asm volatile("s_mov_b32 %0, m0\n\ts_mov_b32 m0, %2\n\ts_nop 0\n\tglobal_load_lds_dwordx4 %1, off\n\ts_mov_b32 m0, %0":"=&s"(keep):"v"(gsrc),"s"(lds_dst):"memory");}
__device__ __forceinline__ float max3f(float a,float b,float c){float r;asm("v_max3_f32 %0, %1, %2, %3":"=v"(r):"v"(a),"v"(b),"v"(c));return r;}
__device__ __forceinline__ float max2f(float a,float b){float r;asm("v_max_f32_e32 %0, %1, %2":"=v"(r):"v"(a),"v"(b));return r;}
__device__ __forceinline__ float fadd_s(float a,float b){float r;asm("v_add_f32_e32 %0, %1, %2":"=v"(r):"v"(a),"v"(b));return r;}
__device__ __forceinline__ float fsub_s(float a,float b){float r;asm("v_sub_f32_e32 %0, %1, %2":"=v"(r):"v"(a),"v"(b));return r;}
typedef float f32x2_t __attribute__((ext_vector_type(2))); typedef __bf16 bf16x2_t __attribute__((ext_vector_type(2)));
__device__ __forceinline__ unsigned cvtpk_s(float lo,float hi){f32x2_t v={lo,hi};bf16x2_t b=__builtin_convertvector(v,bf16x2_t);return __builtin_bit_cast(unsigned,b);}
#define WAIT_BAR(N) asm volatile("s_waitcnt vmcnt(" #N ") lgkmcnt(0)\n\ts_barrier":::"memory")

__device__ __forceinline__ void qkt(f32x16&p0,f32x16&p1,const char*Kslot,const bf16x8*qr,const f32x16&negm,int r32,int hi){
  const char*kb=Kslot+hi*1024+r32*16;
  #pragma unroll
  for(int d0=0;d0<4;++d0){
    const bf16x8 b0=*reinterpret_cast<const bf16x8*>(kb+d0*2048);
    const bf16x8 b1=*reinterpret_cast<const bf16x8*>(kb+d0*2048+512);
    if(d0==0){p0=__builtin_amdgcn_mfma_f32_32x32x16_bf16(b0,qr[0],negm,0,0,0);p1=__builtin_amdgcn_mfma_f32_32x32x16_bf16(b1,qr[0],negm,0,0,0);}
    else{p0=__builtin_amdgcn_mfma_f32_32x32x16_bf16(b0,qr[d0],p0,0,0,0);p1=__builtin_amdgcn_mfma_f32_32x32x16_bf16(b1,qr[d0],p1,0,0,0);}}
}
typedef __attribute__((address_space(3))) const char* lds_cptr;
typedef short v4i16_t __attribute__((ext_vector_type(4)));
__device__ __forceinline__ void kload8(bf16x8*kf,lds_cptr kp){
  kf[0]=*(const __attribute__((address_space(3))) bf16x8*)(kp);      kf[1]=*(const __attribute__((address_space(3))) bf16x8*)(kp+512);
  kf[2]=*(const __attribute__((address_space(3))) bf16x8*)(kp+2048); kf[3]=*(const __attribute__((address_space(3))) bf16x8*)(kp+2560);
  kf[4]=*(const __attribute__((address_space(3))) bf16x8*)(kp+4096); kf[5]=*(const __attribute__((address_space(3))) bf16x8*)(kp+4608);
  kf[6]=*(const __attribute__((address_space(3))) bf16x8*)(kp+6144); kf[7]=*(const __attribute__((address_space(3))) bf16x8*)(kp+6656);
}
__device__ __forceinline__ void kload2(bf16x8*kf,lds_cptr kp,int j){ kf[2*j]=*(const __attribute__((address_space(3))) bf16x8*)(kp+j*2048); kf[2*j+1]=*(const __attribute__((address_space(3))) bf16x8*)(kp+j*2048+512); }
__device__ __forceinline__ s16x4 vtr(lds_cptr p){ return __builtin_bit_cast(s16x4,__builtin_amdgcn_ds_read_tr16_b64_v4i16((__attribute__((address_space(3))) v4i16_t*)p)); }
__device__ __forceinline__ float rowmax(const f32x16&p0,const f32x16&p1){
  float a=max3f(p0[0],p0[1],p1[0]),b=max3f(p0[2],p0[3],p1[1]);a=max3f(a,p1[2],p1[3]);
  #pragma unroll
  for(int r=4;r<16;r+=4){a=max3f(a,p0[r],p0[r+1]);b=max3f(b,p0[r+2],p0[r+3]);a=max3f(a,p1[r],p1[r+1]);b=max3f(b,p1[r+2],p1[r+3]);}
  const float m=max2f(a,b);
  auto rr=__builtin_amdgcn_permlane32_swap(__float_as_uint(m),__float_as_uint(m),false,false);
  return max2f(__uint_as_float(rr[0]),__uint_as_float(rr[1]));
}
__device__ __forceinline__ void pv(f32x16*o,int vb,bf16x8 pa0,bf16x8 pa1,bf16x8 pa2,bf16x8 pa3){
  #pragma unroll
  for(int d0=0;d0<2;++d0){s16x4 lo[4],hi[4];
    #pragma unroll
    for(int ks=0;ks<4;++ks){
      asm volatile("ds_read_b64_tr_b16 %0,%1 offset:%c2":"=&v"(lo[ks]):"v"(vb),"i"(d0*4096+ks*1024):"memory");
      asm volatile("ds_read_b64_tr_b16 %0,%1 offset:%c2":"=&v"(hi[ks]):"v"(vb),"i"(d0*4096+ks*1024+512):"memory");}
    asm volatile("s_waitcnt lgkmcnt(0)":::"memory");SBAR();
    #define PK(k) (bf16x8){lo[k][0],lo[k][1],lo[k][2],lo[k][3],hi[k][0],hi[k][1],hi[k][2],hi[k][3]}
    o[d0]=__builtin_amdgcn_mfma_f32_32x32x16_bf16(pa0,PK(0),o[d0],0,0,0);
    o[d0]=__builtin_amdgcn_mfma_f32_32x32x16_bf16(pa1,PK(1),o[d0],0,0,0);
    o[d0]=__builtin_amdgcn_mfma_f32_32x32x16_bf16(pa2,PK(2),o[d0],0,0,0);
    o[d0]=__builtin_amdgcn_mfma_f32_32x32x16_bf16(pa3,PK(3),o[d0],0,0,0);
    #undef PK
  }
}

#ifndef ATTN_STORE16
#define ATTN_STORE16(p,v) (*(u32x4*)(p)=(v))
#endif
template<int THRL> __device__ __forceinline__ void attn_unit(int b,int h,int qb,const bf16*Q,const bf16*__restrict__ K,const bf16*__restrict__ V,bf16*O,char*shm){
  const int tid=hw_tid(),lane=tid&63,r32=lane&31,hi=lane>>5; const int wid=__builtin_amdgcn_readfirstlane(tid>>6);
  const long rowbase=(long)b*SEQ, kvbase=(long)b*KVLEN; const int q0=qb*QB, kh=h/3;
  const bf16*Qw=Q+(rowbase+q0+wid*QBLK)*QP+h*D;
  const bf16*Kh=K+kvbase*KP+kh*D,*Vh=V+kvbase*KP+kh*D;
  const unsigned lds0=(unsigned)(uintptr_t)shm;
  float*wsf=(float*)(shm+LDS_WS)+wid*64;
  const bf16*ksrc=Kh+(long)lane*KP+wid*8;
  const bf16*vsrc=Vh+(long)(16*(wid&3)+(lane>>2))*KP+(wid>>2)*32+(lane&3)*8;
  const unsigned kdst=lds0+LDS_K+wid*1024, vdst=lds0+LDS_V+wid*1024;
  #define DMA_K(t,slot) glds16(ksrc+(long)(t)*KVBLK*KP,(unsigned)__builtin_amdgcn_readfirstlane(kdst+(slot)))
  #define DMA_V(t,slot) glds16(vsrc+(long)(t)*KVBLK*KP,(unsigned)__builtin_amdgcn_readfirstlane(vdst+(slot)))
  const int vb0=(int)(lds0+LDS_V)+((lane>>4)&1)*32+(lane&3)*8+(4*hi+((lane&15)>>2))*64;
  const char*Kbase=shm+LDS_K; bf16x8 kf[8];
  const lds_cptr shm3=(lds_cptr)shm; const lds_cptr kp0=shm3+LDS_K+hi*1024+r32*16; const lds_cptr vp0=shm3+LDS_V+((lane>>4)&1)*32+(lane&3)*8+(4*hi+((lane&15)>>2))*64;
  DMA_K(0,0);DMA_V(0,0);DMA_K(1,SLOTB);
  bf16x8 qr[4];
  #pragma unroll
  for(int d0=0;d0<4;++d0)qr[d0]=*reinterpret_cast<const bf16x8*>(&Qw[(long)r32*QP+d0*16+hi*8]);
  float mhat=0.f,l_reg=0.f;f32x16 o[2];o[0]=f32x16{};o[1]=f32x16{};f32x16 negm=f32x16{};asm volatile("":"+v"(negm));
  #define CMASK(P0,P1,t) do{}while(0)
  bool resc=false;
  #define START(P0,P1) do{ const float rm=rowmax(P0,P1); resc=false; \
    { const float dl=rm; mhat=fadd_s(mhat,dl); \
      _Pragma("unroll") for(int r=0;r<16;++r){P0[r]=fsub_s(P0[r],dl);P1[r]=fsub_s(P1[r],dl);} \
      _Pragma("unroll") for(int r=0;r<16;++r)negm[r]=-mhat; asm volatile("":"+v"(negm)); } \
    _Pragma("unroll") for(int r=0;r<16;++r)P0[r]=__builtin_amdgcn_exp2f(P0[r]); }while(0)
  #define RESC() do{ if(resc){ asm volatile("s_waitcnt lgkmcnt(0)":::"memory"); \
      _Pragma("unroll") for(int d_=0;d_<2;++d_) _Pragma("unroll") for(int r=0;r<16;++r)o[d_][r]*=wsf[crow(r,hi)]; } }while(0)
  f32x16 pA0,pA1,pB0,pB1;
  int sl_prev=0,sl_cur=0,sl_next=SLOTB;
  #define ROT() do{sl_prev=sl_cur;sl_cur=sl_next;sl_next=(sl_next==(NSLOT-1)*SLOTB)?0:sl_next+SLOTB;}while(0)
  DMA_K(2,2*SLOTB);
  WAIT_BAR(3);
  qkt(pA0,pA1,Kbase,qr,negm,r32,hi);asm volatile("s_nop 15\n\ts_nop 7":"+v"(pA0),"+v"(pA1));CMASK(pA0,pA1,0);
  START(pA0,pA1);
  _Pragma("unroll") for(int r=0;r<16;++r)pA1[r]=__builtin_amdgcn_exp2f(pA1[r]);
  WAIT_BAR(0);
  DMA_K(3,0);DMA_V(1,SLOTB);
  ROT();
  kload8(kf,kp0+sl_cur);
  WAIT_BAR(2);
  s16x4 vlo[8],vhi[8]; u32x4 pw0,pw1,pw2,pw3;
  #define PKW(P,B) cvtpk_s(P[B],P[B+1])
  #define PAF(k) __builtin_bit_cast(bf16x8,pw##k)
  #define VFR(i) (bf16x8){vlo[i][0],vlo[i][1],vlo[i][2],vlo[i][3],vhi[i][0],vhi[i][1],vhi[i][2],vhi[i][3]}
  #define PIN(x) asm volatile("":"+v"(x))
  #define MX3(a,b,c) __builtin_fmaxf(__builtin_fmaxf((a),(b)),(c))
  #define GAPA(MF,A0,A1,A2,A3,W0,W1,PW) do{ MF; sacc+=A0; sacc+=A1; sacc+=A2; sacc+=A3; PIN(sacc); W0; W1; PIN(PW); SBAR(); }while(0)
  #define EX(v) __builtin_amdgcn_exp2f(v)
  #define GAPB(MF,X,B) do{ MF; X[B]=EX(X[B]); X[B+1]=EX(X[B+1]); X[B+2]=EX(X[B+2]); X[B+3]=EX(X[B+3]); PIN(X); SBAR(); }while(0)
  #define VRD(i) do{ vlo[i]=vtr(vp_+(((i)>>2)*4096+((i)&3)*1024)); vhi[i]=vtr(vp_+(((i)>>2)*4096+((i)&3)*1024+512)); }while(0)
  #define KRD(G,j) do{ if(G){ kload2(kf,kp0+sl_next,j); SBAR(); } }while(0)
  #define STEP(C0,C1,P0,P1,t,GK,GV,GL) do{ SBAR(); \
    const lds_cptr vp_=vp0+sl_prev; \
    VRD(0); SBAR(); float sacc=(P0[0]+P0[1]); \
    GAPA(C0=__builtin_amdgcn_mfma_f32_32x32x16_bf16(kf[0],qr[0],negm,0,0,0), P0[2],P0[3],P0[4],P0[5],     pw0[0]=PKW(P0,0), pw0[1]=PKW(P0,2), pw0); \
    VRD(4); SBAR(); GAPA(C1=__builtin_amdgcn_mfma_f32_32x32x16_bf16(kf[1],qr[0],negm,0,0,0), P0[6],P0[7],P0[8],P0[9],     pw0[2]=PKW(P0,4), pw0[3]=PKW(P0,6), pw0); \
    VRD(1); SBAR(); GAPA(C0=__builtin_amdgcn_mfma_f32_32x32x16_bf16(kf[2],qr[1],C0,0,0,0),   P0[10],P0[11],P0[12],P0[13], pw1[0]=PKW(P0,8), pw1[1]=PKW(P0,10), pw1); \
    VRD(5); SBAR(); GAPA(C1=__builtin_amdgcn_mfma_f32_32x32x16_bf16(kf[3],qr[1],C1,0,0,0),   P0[14],P0[15],P1[0],P1[1],   pw1[2]=PKW(P0,12),pw1[3]=PKW(P0,14), pw1); \
    VRD(2); SBAR(); GAPA(C0=__builtin_amdgcn_mfma_f32_32x32x16_bf16(kf[4],qr[2],C0,0,0,0),   P1[2],P1[3],P1[4],P1[5],     pw2[0]=PKW(P1,0), pw2[1]=PKW(P1,2), pw2); \
    VRD(6); SBAR(); GAPA(C1=__builtin_amdgcn_mfma_f32_32x32x16_bf16(kf[5],qr[2],C1,0,0,0),   P1[6],P1[7],P1[8],P1[9],     pw2[2]=PKW(P1,4), pw2[3]=PKW(P1,6), pw2); \
    VRD(3); SBAR(); GAPA(C0=__builtin_amdgcn_mfma_f32_32x32x16_bf16(kf[6],qr[3],C0,0,0,0),   P1[10],P1[11],P1[12],P1[13], pw3[0]=PKW(P1,8), pw3[1]=PKW(P1,10), pw3); \
    VRD(7); SBAR(); GAPA(C1=__builtin_amdgcn_mfma_f32_32x32x16_bf16(kf[7],qr[3],C1,0,0,0),   P1[14],P1[15],0.f,0.f,       pw3[2]=PKW(P1,12),pw3[3]=PKW(P1,14), pw3); \
    l_reg+=sacc; \
    if(GK){DMA_K((t)+3,sl_cur);} if(GV){DMA_V((t)+1,sl_next);} \
    CMASK(C0,C1,t); \
    { float a=MX3(C0[0],C0[1],C1[0]),b=MX3(C0[2],C0[3],C1[1]); a=MX3(a,C1[2],C1[3]); \
      _Pragma("unroll") for(int r=4;r<16;r+=4){a=MX3(a,C0[r],C0[r+1]);b=MX3(b,C0[r+2],C0[r+3]);a=MX3(a,C1[r],C1[r+1]);b=MX3(b,C1[r+2],C1[r+3]);} \
      float rm=__builtin_fmaxf(a,b); { auto rr=__builtin_amdgcn_permlane32_swap(__float_as_uint(rm),__float_as_uint(rm),false,false); rm=__builtin_fmaxf(__uint_as_float(rr[0]),__uint_as_float(rr[1])); } \
      resc=false; \
      if(__builtin_expect(__any(rm>(float)THRL),0)){ const float dl=__builtin_fmaxf(rm,0.f); mhat+=dl; \
        _Pragma("unroll") for(int r=0;r<16;++r){C0[r]-=dl;C1[r]-=dl;} \
        _Pragma("unroll") for(int r=0;r<16;++r)negm[r]=-mhat; asm volatile("":"+v"(negm)); \
        const float f=__builtin_amdgcn_exp2f(-dl); l_reg*=f; if(hi==0)wsf[r32]=f; resc=true; } } \
    SBAR(); \
    GAPB(o[0]=__builtin_amdgcn_mfma_f32_32x32x16_bf16(PAF(0),VFR(0),o[0],0,0,0), C0,0); \
    GAPB(o[1]=__builtin_amdgcn_mfma_f32_32x32x16_bf16(PAF(0),VFR(4),o[1],0,0,0), C0,4); \
    KRD(GL,0); GAPB(o[0]=__builtin_amdgcn_mfma_f32_32x32x16_bf16(PAF(1),VFR(1),o[0],0,0,0), C0,8); \
    KRD(GL,1); GAPB(o[1]=__builtin_amdgcn_mfma_f32_32x32x16_bf16(PAF(1),VFR(5),o[1],0,0,0), C0,12); \
    KRD(GL,2); GAPB(o[0]=__builtin_amdgcn_mfma_f32_32x32x16_bf16(PAF(2),VFR(2),o[0],0,0,0), C1,0); \
    KRD(GL,3); GAPB(o[1]=__builtin_amdgcn_mfma_f32_32x32x16_bf16(PAF(2),VFR(6),o[1],0,0,0), C1,4); \
    GAPB(o[0]=__builtin_amdgcn_mfma_f32_32x32x16_bf16(PAF(3),VFR(3),o[0],0,0,0), C1,8); \
    GAPB(o[1]=__builtin_amdgcn_mfma_f32_32x32x16_bf16(PAF(3),VFR(7),o[1],0,0,0), C1,12); \
    }while(0)
  int t=1;
  for(;t+5<NT;t+=2){
    STEP(pB0,pB1,pA0,pA1,t,true,true,true);     WAIT_BAR(2); RESC(); ROT();
    STEP(pA0,pA1,pB0,pB1,t+1,true,true,true);   WAIT_BAR(2); RESC(); ROT();
  }
  #define ENDW(tt) do{ if((tt)+3<NT){WAIT_BAR(2);} else if((tt)+2<NT){WAIT_BAR(1);} else {WAIT_BAR(0);} }while(0)
  for(;t+1<NT;t+=2){
    STEP(pB0,pB1,pA0,pA1,t,(t+3<NT),(t+1<NT),(t+1<NT));       ENDW(t);   RESC(); ROT();
    STEP(pA0,pA1,pB0,pB1,t+1,(t+4<NT),(t+2<NT),(t+2<NT));     ENDW(t+1); RESC(); ROT();
  }
  STEP(pB0,pB1,pA0,pA1,NT-1,false,false,false); RESC();
  { float sacc=pB0[0]+pB0[1]; _Pragma("unroll") for(int r=2;r<16;++r)sacc+=pB0[r]; _Pragma("unroll") for(int r=0;r<16;++r)sacc+=pB1[r]; l_reg+=sacc;
    pw0=(u32x4){PKW(pB0,0),PKW(pB0,2),PKW(pB0,4),PKW(pB0,6)};pw1=(u32x4){PKW(pB0,8),PKW(pB0,10),PKW(pB0,12),PKW(pB0,14)};pw2=(u32x4){PKW(pB1,0),PKW(pB1,2),PKW(pB1,4),PKW(pB1,6)};pw3=(u32x4){PKW(pB1,8),PKW(pB1,10),PKW(pB1,12),PKW(pB1,14)};
    SBAR(); pv(o,vb0+sl_cur,PAF(0),PAF(1),PAF(2),PAF(3)); }
  #undef PKW
  #undef PAF
  #undef VFR
  #undef PIN
  #undef MX3
  #undef GAPA
  #undef GAPB
  #undef EX
  #undef VRD
  #undef KRD
  #undef STEP
  #undef ENDW
  {auto rr=__builtin_amdgcn_permlane32_swap(__float_as_uint(l_reg),__float_as_uint(l_reg),false,false);l_reg=__uint_as_float(rr[0])+__uint_as_float(rr[1]);}
  if(hi==0)wsf[32+r32]=l_reg;asm volatile("s_waitcnt lgkmcnt(0)":::"memory");
  float rli[16];
  #pragma unroll
  for(int r=0;r<16;++r)rli[r]=__builtin_amdgcn_rcpf(wsf[32+crow(r,hi)]);
  bf16*Ow=O+(rowbase+q0+wid*QBLK)*OP+h*D;
  { bf16*stg=(bf16*)(shm+LDS_OST)+wid*2048;
    #pragma unroll
    for(int r=0;r<16;++r){const int orow=crow(r,hi);
      #pragma unroll
      for(int d0=0;d0<2;++d0)stg[orow*64+d0*32+r32]=(bf16)f2bf(o[d0][r]*rli[r]);}
    asm volatile("s_waitcnt lgkmcnt(0)":::"memory");
    #pragma unroll
    for(int i=0;i<4;++i){const int row=i*8+(lane>>3),ch=lane&7; const u32x4 v=*(const u32x4*)(stg+row*64+ch*8); ATTN_STORE16(Ow+(long)row*OP+ch*8,v);} }
  asm volatile("s_waitcnt lgkmcnt(0)\n\ts_barrier":::"memory");
  #undef DMA_K
  #undef DMA_V
  #undef CMASK
  #undef START
  #undef RESC
  #undef ROT
}
constexpr int ATTN_LDS_BYTES=LDS_BYTES;
struct AttnTensors { const bf16* Q; const bf16* K; const bf16* V; bf16* O; };
template<int THRL=8> __device__ __forceinline__ void attn_phase(char*lds,const AttnTensors&T){
  const int G=gridDim.x, bx=blockIdx.x, v=(G%8==0)?(bx%8)*(G/8)+bx/8:bx;
  for(int u=v;u<16*12*8;u+=G){
    const int pair=(u%256)/4, j=((u%256)%4)*6+u/256;
    const int b=pair>>2, kh=pair&3, g=j>>3, qb=j&7;
    attn_unit<THRL>(b,kh*3+g,qb,T.Q,T.K,T.V,T.O,lds);
  }
}
#undef SBAR
#undef WAIT_BAR
}

__device__ __forceinline__ void pool_item(const Params& p, LAS unsigned char* lds, int item) {
    const int tid = TIDX;
    const int gi = item & 3, tile = item >> 2, t0 = tile * 32, b = t0 / SEQ, tl0 = t0 % SEQ, half = 1 << gi;
    const bf16_t* Ub = (const bf16_t*)(p.ws + OFF_U);
    bf16_t* AO = (bf16_t*)(p.ws + OFF_AO);
    LAS float* us = (LAS float*)lds;
    LAS float* dl = (LAS float*)(lds + 48 * 64 * 4);
    __syncthreads();
    for (int i = tid; i < 48 * 64; i += 256) {
        const int r = i >> 6, c = i & 63, tl = tl0 - 8 + r;
        us[i] = (tl >= 0 && tl < SEQ) ? bf2f(Ub[(size_t)(b * SEQ + tl) * 256 + gi * 64 + c]) : 0.f;
    }
    __syncthreads();
    {
        const int c = tid & 63, tg = tid >> 6;
#pragma unroll
        for (int k = 0; k < 8; ++k) {
            const int tk = tg * 8 + k, tl = tl0 + tk;
            const int lo = max(tl - half, 0), hi = min(tl + half, SEQ);
            float s = 0.f;
            for (int r = lo; r < hi; ++r) s += us[(r - tl0 + 8) * 64 + c];
            dl[tk * 64 + c] = s / (float)(hi - lo) - us[(tk + 8) * 64 + c];
        }
    }
    __syncthreads();
    {
        const int dd = tid & 63, tg = tid >> 6;
        float acc[8];
#pragma unroll
        for (int k = 0; k < 8; ++k) acc[k] = 0.f;
        const float* w = p.pool_w + gi * 4096 + dd;
        for (int c = 0; c < 64; ++c) {
            const float wv = w[c * 64];
#pragma unroll
            for (int k = 0; k < 8; ++k) acc[k] += dl[(tg * 8 + k) * 64 + c] * wv;
        }
        const float ps = p.pool_scale[gi * 64 + dd];
#pragma unroll
        for (int k = 0; k < 8; ++k) AO[(size_t)(t0 + tg * 8 + k) * D + gi * 64 + dd] = (bf16_t)f2bf(acc[k] * ps);
    }
}

__device__ __forceinline__ void phase_attn_pool(const Params& p, LAS unsigned char* lds, char* smem) {
    const attn_body::AttnTensors AT{(const bf16_t*)(p.ws + OFF_Q), (const bf16_t*)(p.ws + OFF_K), (const bf16_t*)(p.ws + OFF_V), (bf16_t*)(p.ws + OFF_AO) + 256};
    attn_body::attn_phase<8>(smem, AT);
    __syncthreads();
    constexpr int N_POOL = (T / 32) * 4;
    for (int it = VBLK; it < N_POOL; it += NVBLK) pool_item(p, lds, it);
}

struct EpiOut {
    static constexpr bool PERM = false;
    const float* x; float* y; const float* mod; float* stats;
    __device__ __forceinline__ void operator()(const f32x4 (&acc)[2][2][4][2], const pg8::Unit& u, int wr, int wc, int fr, int fq) const {
        const float* g1 = mod + (size_t)(u.pm >> 3) * MODW + 2 * D;
        const int col0 = u.pn * 256 + wc * 32 + fq * 4;
        f32x4 gv[2][2];
#pragma unroll
        for (int bj = 0; bj < 2; ++bj)
#pragma unroll
            for (int n = 0; n < 2; ++n) gv[bj][n] = *(const f32x4*)(g1 + col0 + bj * 128 + n * 16);
#pragma unroll
        for (int ai = 0; ai < 2; ++ai)
#pragma unroll
            for (int m = 0; m < 4; ++m) {
                const int row = u.pm * 256 + ai * 128 + wr * 64 + m * 16 + fr;
                float s1 = 0.f, s2 = 0.f;
#pragma unroll
                for (int bj = 0; bj < 2; ++bj)
#pragma unroll
                    for (int n = 0; n < 2; ++n) {
                        const size_t off = (size_t)row * D + col0 + bj * 128 + n * 16;
                        const f32x4 xv = *(const f32x4*)(x + off);
                        const f32x4 yv = xv * ALPHA + gv[bj][n] * acc[ai][bj][m][n];
                        *(f32x4*)(y + off) = yv;
                        s1 += (yv[0] + yv[1]) + (yv[2] + yv[3]);
                        s2 += (yv[0] * yv[0] + yv[1] * yv[1]) + (yv[2] * yv[2] + yv[3] * yv[3]);
                    }
                s1 += __shfl_xor(s1, 16); s1 += __shfl_xor(s1, 32);
                s2 += __shfl_xor(s2, 16); s2 += __shfl_xor(s2, 32);
                if (fq == 0) { float* st = stats + ((size_t)row * 16 + u.pn * 4 + wc) * 2; st[0] = s1; st[1] = s2; }
            }
    }
};
__device__ __forceinline__ void phase_outproj(const Params& p, LAS unsigned char* lds) {
    pg8::Gemm g{(const bf16_t*)(p.ws + OFF_AO), (const bf16_t*)(p.ws + OFF_WTOUT)};
    pg8::DenseSched S{4, 512, 512, 0, 1, (int)gridDim.x, vcu_of_block()};
    EpiOut E{p.x, p.out, (const float*)(p.ws + OFF_MOD), (float*)(p.ws + OFF_STATS)};
    pg8::gemm_phase<D, EpiOut, pg8::DenseSched, false>(lds, g, S, E);
}

__device__ __forceinline__ void phase_router(const Params& p, LAS unsigned char* lds0) {
    const int tid = hw_tid(), lane = tid & 63, wid = tid >> 6, r16 = lane & 15, q = lane >> 4;
    const float* mod = (const float*)(p.ws + OFF_MOD);
    const float* stats = (const float*)(p.ws + OFF_STATS);
    bf16_t* H = (bf16_t*)(p.ws + OFF_H);
    const bf16_t* WRH = (const bf16_t*)(p.ws + OFF_WRH); const bf16_t* WRL = (const bf16_t*)(p.ws + OFF_WRL);
    int* gcnt = (int*)(p.ws + OFF_CNT);
    int* LDST = (int*)(p.ws + OFF_LDST);
    float* LWt = (float*)(p.ws + OFF_LW);
    LAS float* vec = (LAS float*)lds0;
    LAS float* lg = (LAS float*)(lds0 + 16384) + wid * 16 * 64;
    LAS int* lcnt = (LAS int*)(lds0 + 49152);
    LAS int* lbase = (LAS int*)(lds0 + 49152 + 256);
    LAS int* sel_ep = (LAS int*)(lds0 + 49152 + 512);
    LAS float* sel_w = (LAS float*)(lds0 + 49152 + 512 + 4096);
    for (int item = blockIdx.x; item < T / 128; item += gridDim.x) {
        const int t0 = item * 128, b = t0 / SEQ, tw0 = t0 + wid * 16;
        __syncthreads();
        if (tid < 64) lcnt[tid] = 0;
        for (int i = tid; i < 1024; i += 512) {
            vec[i] = p.ln1_g[i]; vec[1024 + i] = p.ln1_b[i];
            vec[2048 + i] = 1.f + mod[(size_t)b * MODW + 4 * D + i]; vec[3072 + i] = mod[(size_t)b * MODW + 3 * D + i];
        }
        float meanv = 0.f, rstdv = 0.f;
        if (lane < 16) {
            float s1 = 0.f, s2 = 0.f;
            const float* st = stats + (size_t)(tw0 + lane) * 32;
#pragma unroll
            for (int i = 0; i < 16; ++i) { s1 += st[2 * i]; s2 += st[2 * i + 1]; }
            meanv = s1 * (1.f / D);
            const float var = fmaxf(s2 * (1.f / D) - meanv * meanv, 0.f);
            rstdv = 1.0f / sqrtf(var + 1e-5f);
        }
        const float mu = __shfl(meanv, r16), rs = __shfl(rstdv, r16);
        __syncthreads();
        f32x4 acc[4];
#pragma unroll
        for (int nb = 0; nb < 4; ++nb) acc[nb] = (f32x4){0.f, 0.f, 0.f, 0.f};
        float* yrow = p.out + (size_t)(tw0 + r16) * D + q * 8;
        bf16_t* hrow = H + (size_t)(tw0 + r16) * D + q * 8;
        LAS unsigned char* wb = lds0 + 57856;
        f32x4 vn[4][2];
#pragma unroll
        for (int u = 0; u < 4; ++u) { vn[u][0] = *(const f32x4*)(yrow + u * 32); vn[u][1] = *(const f32x4*)(yrow + u * 32 + 4); }
        for (int ch = 0; ch < 4; ++ch) {
            __syncthreads();
#pragma unroll
            for (int i = 0; i < 8; ++i) {
                const int idx = tid + i * 512, part = idx >> 11, row = (idx >> 5) & 63, c16 = idx & 31;
                const u32x4 w = *(const u32x4*)((part ? WRL : WRH) + (size_t)row * D + ch * 256 + c16 * 8);
                *(LAS u32x4*)(wb + part * 33792 + row * 528 + c16 * 16) = w;
            }
            __syncthreads();
#pragma unroll
            for (int s4 = ch * 8; s4 < ch * 8 + 8; s4 += 4) {
                f32x4 vv[4][2];
#pragma unroll
                for (int u = 0; u < 4; ++u) { vv[u][0] = vn[u][0]; vv[u][1] = vn[u][1]; }
                if (s4 + 4 < 32) {
#pragma unroll
                    for (int u = 0; u < 4; ++u) { vn[u][0] = *(const f32x4*)(yrow + (s4 + 4 + u) * 32); vn[u][1] = *(const f32x4*)(yrow + (s4 + 4 + u) * 32 + 4); }
                }
#pragma unroll
                for (int u = 0; u < 4; ++u) {
                    const int s = s4 + u, k0 = s * 32 + q * 8;
                    float hv[8];
#pragma unroll
                    for (int hh = 0; hh < 2; ++hh) {
                        const f32x4 g = *(const LAS f32x4*)(vec + k0 + 4 * hh), bb = *(const LAS f32x4*)(vec + 1024 + k0 + 4 * hh);
                        const f32x4 sc = *(const LAS f32x4*)(vec + 2048 + k0 + 4 * hh), sh = *(const LAS f32x4*)(vec + 3072 + k0 + 4 * hh);
                        const f32x4 xm = (vv[u][hh] - mu) * rs * g + bb;
                        *(f32x4*)(yrow + s * 32 + 4 * hh) = xm;
                        const f32x4 h4 = xm * sc + sh;
                        hv[4 * hh + 0] = h4[0]; hv[4 * hh + 1] = h4[1]; hv[4 * hh + 2] = h4[2]; hv[4 * hh + 3] = h4[3];
                    }
                    unsigned wh[4], wl[4];
#pragma unroll
                    for (int i = 0; i < 4; ++i) {
                        const unsigned ha = f2bf(hv[2 * i]), hb = f2bf(hv[2 * i + 1]);
                        wh[i] = ha | (hb << 16);
                        wl[i] = pk2(hv[2 * i] - bf2f(ha), hv[2 * i + 1] - bf2f(hb));
                    }
                    *(u32x4*)(hrow + s * 32) = (u32x4){wh[0], wh[1], wh[2], wh[3]};
                    const bf16x8 ah = __builtin_bit_cast(bf16x8, (u32x4){wh[0], wh[1], wh[2], wh[3]}), al = __builtin_bit_cast(bf16x8, (u32x4){wl[0], wl[1], wl[2], wl[3]});
                    const int kb = ((s & 7) * 32 + q * 8) * 2;
#pragma unroll
                    for (int nb = 0; nb < 4; ++nb) {
                        const bf16x8 bh = *(const LAS bf16x8*)(wb + (nb * 16 + r16) * 528 + kb), bl = *(const LAS bf16x8*)(wb + 33792 + (nb * 16 + r16) * 528 + kb);
                        acc[nb] = __builtin_amdgcn_mfma_f32_16x16x32_bf16(ah, bh, acc[nb], 0, 0, 0);
                        acc[nb] = __builtin_amdgcn_mfma_f32_16x16x32_bf16(al, bh, acc[nb], 0, 0, 0);
                        acc[nb] = __builtin_amdgcn_mfma_f32_16x16x32_bf16(ah, bl, acc[nb], 0, 0, 0);
                    }
                }
            }
        }
#pragma unroll
        for (int nb = 0; nb < 4; ++nb)
#pragma unroll
            for (int j = 0; j < 4; ++j) lg[(4 * q + j) * 64 + nb * 16 + r16] = acc[nb][j];
        __syncthreads();
        const float bias = p.router_bias[lane];
        for (int r = 0; r < 16; ++r) {
            const float lgv = lg[r * 64 + lane];
            const float sg = 1.0f / (1.0f + expf(-lgv));
            const float sel = sg + bias;
            float m1 = fmaxf(sel, __shfl_xor(sel, 1)); m1 = fmaxf(m1, __shfl_xor(m1, 2)); m1 = fmaxf(m1, __shfl_xor(m1, 4));
            int cand = (sel == m1) ? lane : 64;
            cand = min(cand, __shfl_xor(cand, 1)); cand = min(cand, __shfl_xor(cand, 2)); cand = min(cand, __shfl_xor(cand, 4));
            const float sel2 = (lane == cand) ? -INFINITY : sel;
            float m2 = fmaxf(sel2, __shfl_xor(sel2, 1)); m2 = fmaxf(m2, __shfl_xor(m2, 2)); m2 = fmaxf(m2, __shfl_xor(m2, 4));
            const float gs = m1 + m2;
            const int g = lane >> 3;
            int cntg = 0;
#pragma unroll
            for (int gg = 0; gg < 8; ++gg) { const float v = __shfl(gs, gg * 8); cntg += (v > gs || (v == gs && gg < g)) ? 1 : 0; }
            const bool keep = cntg < 4;
            const float msel = keep ? sel : -INFINITY;
            lg[r * 64 + lane] = msel;
            int cnt = 0;
#pragma unroll 4
            for (int q4 = 0; q4 < 16; ++q4) {
                const f32x4 v = *(const LAS f32x4*)(lg + r * 64 + q4 * 4);
#pragma unroll
                for (int i = 0; i < 4; ++i) cnt += (v[i] > msel || (v[i] == msel && (q4 * 4 + i) < lane)) ? 1 : 0;
            }
            const bool chosen = keep && cnt < 8;
            float wsum = chosen ? sg : 0.f;
#pragma unroll
            for (int o = 1; o < 64; o <<= 1) wsum += __shfl_xor(wsum, o);
            if (chosen) {
                const int pos = atomicAdd((int*)&lcnt[lane], 1);
                sel_ep[(wid * 16 + r) * 8 + cnt] = lane | (pos << 8);
                sel_w[(wid * 16 + r) * 8 + cnt] = sg / wsum * 2.5f;
            }
        }
        __syncthreads();
        if (tid < 64) { int tt = tid; asm volatile("" : "+v"(tt)); lbase[tt] = atomicAdd(&gcnt[tt], lcnt[tt]); }
        __syncthreads();
        for (int idx = tid; idx < 1024; idx += 512) {
            const int ep = sel_ep[idx], e = ep & 0xff, pos = ep >> 8, gi = lbase[e] + pos;
            LDST[(size_t)e * T + gi] = (t0 + (idx >> 3)) * NSLOT + (idx & 7);
            LWt[(size_t)e * T + gi] = sel_w[idx];
        }
    }
}

constexpr int LDS_ROWTAB = 131072, MOE_MAX_UNITS = 12, LDS_UTAB = LDS_CTL + 256, LDS_TSTART = LDS_UTAB + MOE_MAX_UNITS * 32;
__device__ __forceinline__ int moe_setup(const Params& p, LAS unsigned char* lds0, int nN, int bmul, int badd) {
    LAS int* tstart = (LAS int*)(lds0 + LDS_TSTART); LAS int* utab = (LAS int*)(lds0 + LDS_UTAB);
    const int* gcnt = (const int*)(p.ws + OFF_CNT);
    __syncthreads();
    if (hw_tid() == 0) {
        int a = 0;
        for (int e = 0; e < NEX; ++e) { const int c = e < NE ? gcnt[e] : T; tstart[e] = a; a += (c + 255) >> 8; }
        tstart[NEX] = a;
    }
    __syncthreads();
    const int total = tstart[NEX] * nN, G = gridDim.x, c = blockIdx.x;
    if (hw_tid() < MOE_MAX_UNITS) {
        const int i = hw_tid(), L = i * G + c;
        int pm = 0, pn = 0, e = 0, i0 = 0, cnt = 0;
        if (L < total) {
            const int mt = L / nN, pl = L % nN;
            for (int j = 1; j < NEX; ++j) e += (mt >= tstart[j]) ? 1 : 0;
            pm = mt; pn = e * bmul + badd + pl; i0 = (mt - tstart[e]) * 256; cnt = e < NE ? gcnt[e] : T;
        }
        utab[i * 8 + 0] = pm; utab[i * 8 + 1] = pn; utab[i * 8 + 2] = e; utab[i * 8 + 3] = i0; utab[i * 8 + 4] = cnt;
    }
    __syncthreads();
    const int n = (total - c + G - 1) / G;
    return n < 0 ? 0 : (n > MOE_MAX_UNITS ? MOE_MAX_UNITS : n);
}
struct MoeSched {
    LAS const int* utab; LAS const unsigned* rowtab; int n;
    __device__ __forceinline__ bool next(int i, pg8::Unit& u) const {
        if (i >= n) return false;
        u.pm = __builtin_amdgcn_readfirstlane(utab[i * 8 + 0]); u.pn = __builtin_amdgcn_readfirstlane(utab[i * 8 + 1]); u.e = __builtin_amdgcn_readfirstlane(utab[i * 8 + 2]); u.idx = i; return true;
    }
    __device__ __forceinline__ unsigned row_off(int i, int r) const { return rowtab[i * 256 + r]; }
    __device__ __forceinline__ void a_ready(const pg8::Unit&) const {}
    __device__ __forceinline__ void done(const pg8::Unit&) const {}
};
struct EpiGU {
    static constexpr bool PERM = true;
    LAS const float* auxw; unsigned char* ws;
    __device__ __forceinline__ void operator()(const f32x4 (&acc)[2][2][4][2], const pg8::Unit& u, int wr, int wc, int fr, int fq) const {
        const int pl = u.pn & 1;
        bf16_t* ACT = (bf16_t*)(ws + OFF_ACT) + (size_t)u.pm * 256 * FF + pl * 128 + wc * 32 + 8 * fq;
#pragma unroll
        for (int ai = 0; ai < 2; ++ai)
#pragma unroll
            for (int m = 0; m < 4; ++m) {
                const int rl = ai * 128 + wr * 64 + m * 16 + fr;
                const float wrow = auxw[u.idx * 256 + rl];
                float a[8];
#pragma unroll
                for (int n = 0; n < 2; ++n)
#pragma unroll
                    for (int q = 0; q < 4; ++q) { const float g = acc[ai][0][m][n][q], uu = acc[ai][1][m][n][q]; a[n * 4 + q] = g / (1.f + __expf(-g)) * uu * wrow; }
                u32x4 w; w.x = pk2(a[0], a[1]); w.y = pk2(a[2], a[3]); w.z = pk2(a[4], a[5]); w.w = pk2(a[6], a[7]);
                *(u32x4*)(ACT + (size_t)rl * FF) = w;
            }
    }
};
__device__ __forceinline__ void phase_gateup(const Params& p, LAS unsigned char* lds0) {
    const int n = moe_setup(p, lds0, 2, 2, 0);
    LAS const int* utab = (LAS const int*)(lds0 + LDS_UTAB);
    LAS unsigned* rowtab = (LAS unsigned*)(lds0 + LDS_ROWTAB);
    LAS float* auxw = (LAS float*)(lds0 + LDS_AUX);
    const int* LDST = (const int*)(p.ws + OFF_LDST);
    const float* LWt = (const float*)(p.ws + OFF_LW);
    for (int i = 0; i < n; ++i) {
        const int e = utab[i * 8 + 2], i0 = utab[i * 8 + 3], cnt = utab[i * 8 + 4];
        if (hw_tid() < 256) {
            const int li = i0 + hw_tid(); int tok = 0; float w = 0.f;
            if (li < cnt) { if (e < NE) { tok = LDST[(size_t)e * T + li] / NSLOT; w = LWt[(size_t)e * T + li]; } else { tok = li; w = 1.f; } }
            rowtab[i * 256 + hw_tid()] = (unsigned)tok * (unsigned)(D * 2);
            auxw[i * 256 + hw_tid()] = w;
        }
    }
    __syncthreads();
    MoeSched S{utab, rowtab, n};
    pg8::Gemm g{(const bf16_t*)(p.ws + OFF_H), (const bf16_t*)(p.ws + OFF_WGU)};
    EpiGU E{auxw, p.ws};
    pg8::gemm_phase<D, EpiGU, MoeSched, true>(lds0, g, S, E);
}
constexpr float FP8S = 32.f, FP8I = 1.f / 32.f;
__device__ __forceinline__ unsigned pk4_fp8(float a, float b, float c, float d) {
    a = __builtin_amdgcn_fmed3f(a * FP8S, -440.f, 440.f); b = __builtin_amdgcn_fmed3f(b * FP8S, -440.f, 440.f);
    c = __builtin_amdgcn_fmed3f(c * FP8S, -440.f, 440.f); d = __builtin_amdgcn_fmed3f(d * FP8S, -440.f, 440.f);
    int w = __builtin_amdgcn_cvt_pk_fp8_f32(a, b, 0, false);
    w = __builtin_amdgcn_cvt_pk_fp8_f32(c, d, w, true);
    return (unsigned)w;
}
struct EpiDown {
    static constexpr bool PERM = true;
    LAS const int* auxd; unsigned char* ws;
    __device__ __forceinline__ void operator()(const f32x4 (&acc)[2][2][4][2], const pg8::Unit& u, int wr, int wc, int fr, int fq) const {
        const int pl = u.pn & 1;
        unsigned char* SL = ws + OFF_SLOTS + pl * 256 + wc * 64 + 16 * fq;
#pragma unroll
        for (int ai = 0; ai < 2; ++ai)
#pragma unroll
            for (int m = 0; m < 4; ++m) {
                const int d = auxd[u.idx * 256 + ai * 128 + wr * 64 + m * 16 + fr];
                u32x4 w;
                w.x = pk4_fp8(acc[ai][0][m][0][0], acc[ai][0][m][0][1], acc[ai][0][m][0][2], acc[ai][0][m][0][3]);
                w.y = pk4_fp8(acc[ai][0][m][1][0], acc[ai][0][m][1][1], acc[ai][0][m][1][2], acc[ai][0][m][1][3]);
                w.z = pk4_fp8(acc[ai][1][m][0][0], acc[ai][1][m][0][1], acc[ai][1][m][0][2], acc[ai][1][m][0][3]);
                w.w = pk4_fp8(acc[ai][1][m][1][0], acc[ai][1][m][1][1], acc[ai][1][m][1][2], acc[ai][1][m][1][3]);
                *(u32x4*)(SL + (size_t)d * 512) = w;
            }
    }
};
__device__ __forceinline__ void phase_down(const Params& p, LAS unsigned char* lds0, int c) {
    const int n = moe_setup(p, lds0, 2, 4, 2 * c);
    LAS const int* utab = (LAS const int*)(lds0 + LDS_UTAB);
    LAS int* auxd = (LAS int*)(lds0 + LDS_AUX);
    const int* LDST = (const int*)(p.ws + OFF_LDST);
    for (int i = 0; i < n; ++i) {
        const int e = utab[i * 8 + 2], i0 = utab[i * 8 + 3], cnt = utab[i * 8 + 4];
        if (hw_tid() < 256) {
            const int li = i0 + hw_tid();
            auxd[i * 256 + hw_tid()] = li < cnt ? (e < NE ? LDST[(size_t)e * T + li] : li * NSLOT + 8) : T * NSLOT;
        }
    }
    __syncthreads();
    MoeSched S{utab, (LAS const unsigned*)(lds0 + LDS_ROWTAB), n};
    pg8::Gemm g{(const bf16_t*)(p.ws + OFF_ACT), (const bf16_t*)(p.ws + OFF_WD)};
    EpiDown E{auxd, p.ws};
    pg8::gemm_phase<FF, EpiDown, MoeSched, false>(lds0, g, S, E);
}

__device__ __forceinline__ void slot_sum16(const unsigned char* SL, int t, int cb, float (&s)[16]) {
#pragma unroll
    for (int i = 0; i < 16; ++i) s[i] = 0.f;
    u32x4 v[NSLOT];
#pragma unroll
    for (int k = 0; k < NSLOT; ++k) v[k] = *(const u32x4*)(SL + (size_t)(t * NSLOT + k) * 512 + cb);
#pragma unroll
    for (int k = 0; k < NSLOT; ++k)
#pragma unroll
        for (int i = 0; i < 4; ++i) {
            typedef float f32x2 __attribute__((ext_vector_type(2)));
            const f32x2 lo = __builtin_amdgcn_cvt_pk_f32_fp8((int)v[k][i], false), hi = __builtin_amdgcn_cvt_pk_f32_fp8((int)v[k][i], true);
            s[4 * i] += lo.x; s[4 * i + 1] += lo.y; s[4 * i + 2] += hi.x; s[4 * i + 3] += hi.y;
        }
#pragma unroll
    for (int i = 0; i < 16; ++i) s[i] *= FP8I;
}
__device__ __forceinline__ int slot_col(int bb) { return (bb >> 4) * 256 + ((bb >> 2) & 3) * 32 + (bb & 3) * 8; }
__device__ __forceinline__ void phase_combine(const Params& p) {
    const unsigned char* SL = p.ws + OFF_SLOTS;
    bf16_t* FFN = (bf16_t*)(p.ws + OFF_H);
    for (int item = blockIdx.x; item < T / 16; item += gridDim.x) {
        const int t = item * 16 + (hw_tid() >> 5), bb = hw_tid() & 31, col = slot_col(bb);
        float s[16];
        slot_sum16(SL, t, bb * 16, s);
        u32x4 w0 = {pk2(s[0], s[1]), pk2(s[2], s[3]), pk2(s[4], s[5]), pk2(s[6], s[7])}, w1 = {pk2(s[8], s[9]), pk2(s[10], s[11]), pk2(s[12], s[13]), pk2(s[14], s[15])};
        *(u32x4*)(FFN + (size_t)t * D + col) = w0; *(u32x4*)(FFN + (size_t)t * D + col + 128) = w1;
    }
}

__device__ __forceinline__ void phase_final(const Params& p) {
    const int lane = hw_tid() & 63, gw = blockIdx.x * 8 + (hw_tid() >> 6), ngw = gridDim.x * 8;
    const float* mod = (const float*)(p.ws + OFF_MOD);
    const bf16_t* FFN = (const bf16_t*)(p.ws + OFF_H);
    const unsigned char* SL = p.ws + OFF_SLOTS;
    const int bb = lane & 31, c0 = (lane >> 5) * 512 + slot_col(bb);
    for (int row = gw; row < T; row += ngw) {
        const float* g2 = mod + (size_t)(row / SEQ) * MODW + 5 * D;
        float f[16];
        if (lane < 32) {
            const u32x4 a = *(const u32x4*)(FFN + (size_t)row * D + c0), b = *(const u32x4*)(FFN + (size_t)row * D + c0 + 128);
#pragma unroll
            for (int i = 0; i < 4; ++i) { f[2 * i] = bflo(a[i]); f[2 * i + 1] = bfhi(a[i]); f[8 + 2 * i] = bflo(b[i]); f[8 + 2 * i + 1] = bfhi(b[i]); }
        } else {
            slot_sum16(SL, row, bb * 16, f);
        }
        f32x4 y[4]; float s = 0.f;
#pragma unroll
        for (int j = 0; j < 4; ++j) {
            const int cj = c0 + (j >> 1) * 128 + (j & 1) * 4;
            const f32x4 xm = *(const f32x4*)(p.out + (size_t)row * D + cj), gg = *(const f32x4*)(g2 + cj);
            y[j][0] = ALPHA * xm[0] + gg[0] * f[4 * j]; y[j][1] = ALPHA * xm[1] + gg[1] * f[4 * j + 1];
            y[j][2] = ALPHA * xm[2] + gg[2] * f[4 * j + 2]; y[j][3] = ALPHA * xm[3] + gg[3] * f[4 * j + 3];
            s += (y[j][0] + y[j][1]) + (y[j][2] + y[j][3]);
        }
#pragma unroll
        for (int o = 1; o < 64; o <<= 1) s += __shfl_xor(s, o);
        const float mean = s * (1.f / D);
        float qv = 0.f;
#pragma unroll
        for (int j = 0; j < 4; ++j) { y[j] = y[j] - mean; qv += (y[j][0] * y[j][0] + y[j][1] * y[j][1]) + (y[j][2] * y[j][2] + y[j][3] * y[j][3]); }
#pragma unroll
        for (int o = 1; o < 64; o <<= 1) qv += __shfl_xor(qv, o);
        const float rstd = 1.0f / sqrtf(qv * (1.f / D) + 1e-5f);
#pragma unroll
        for (int j = 0; j < 4; ++j) {
            const int cj = c0 + (j >> 1) * 128 + (j & 1) * 4;
            const f32x4 g = *(const f32x4*)(p.ln2_g + cj), bb4 = *(const f32x4*)(p.ln2_b + cj);
            *(f32x4*)(p.out + (size_t)row * D + cj) = y[j] * rstd * g + bb4;
        }
    }
}

#define XB_TMO      128
#define XB_XCNT(j)  (256  + 64 * (j))
#define XB_XSUB(j)  (1280 + 64 * (j))
#define XB_XGEN(j)  (2304 + 64 * (j))
#define XB_TOP      3328
#define XB_TOPGEN   3392
#define XCD_BAR_WORDS 3456
#define XB_SPIN_CAP (1u << 18)
__device__ __forceinline__ unsigned xb_ld(unsigned* p)              { return __hip_atomic_load(p, __ATOMIC_RELAXED, __HIP_MEMORY_SCOPE_AGENT); }
__device__ __forceinline__ unsigned xb_add(unsigned* p, unsigned v) { return __hip_atomic_fetch_add(p, v, __ATOMIC_RELAXED, __HIP_MEMORY_SCOPE_AGENT); }
__device__ __forceinline__ unsigned xb_xcc_id() { return (unsigned)__builtin_amdgcn_s_getreg((3 << 11) | 20) & 0xFu; }
#define XB_SPIN(cond, bar) do { unsigned _sp = 0; while (cond) { __builtin_amdgcn_s_sleep(1); \
    if ((++_sp & 255u) == 0u) { if (xb_ld(&(bar)[XB_TMO])) break; if (_sp > XB_SPIN_CAP) { atomicAdd(&(bar)[XB_TMO], 1u); break; } } } } while (0)
struct XcdBarrier { unsigned* bar; unsigned x; volatile LAS unsigned* st; };
__device__ __forceinline__ XcdBarrier xcd_barrier_post(unsigned* bar, volatile LAS unsigned* st) {
    XcdBarrier b; b.bar = bar; b.x = xb_xcc_id(); b.st = st;
    if (hw_tid() == 0) (void)xb_add(&bar[XB_XCNT(b.x)], 1u);
    return b;
}
__device__ __forceinline__ void xcd_barrier_complete(unsigned* bar, unsigned x, unsigned& nloc, unsigned& nx) {
    const unsigned G = gridDim.x * gridDim.y * gridDim.z;
    unsigned sum, cnt, mine, sp = 0u;
    for (;;) {
        sum = 0u; cnt = 0u; mine = 0u;
#pragma unroll
        for (unsigned j = 0; j < 16; ++j) { const unsigned c = xb_ld(&bar[XB_XCNT(j)]); sum += c; cnt += (c > 0u) ? 1u : 0u; mine = (j == x) ? c : mine; }
        if (sum == G) break;
        __builtin_amdgcn_s_sleep(1);
        if ((++sp & 255u) == 0u) { if (xb_ld(&bar[XB_TMO])) break; if (sp > XB_SPIN_CAP) { atomicAdd(&bar[XB_TMO], 1u); break; } }
    }
    nloc = mine > 0u ? mine : 1u; nx = cnt > 0u ? cnt : 1u;
}
__device__ __forceinline__ void xcd_barrier(const XcdBarrier& b) {
    asm volatile("s_waitcnt vmcnt(0)" ::: "memory");
    __syncthreads();
    if (hw_tid() == 0) {
        unsigned* bar = b.bar;
        __builtin_amdgcn_s_waitcnt(0);
        unsigned nloc = b.st[0], nx = b.st[1];
        if (nloc == 0u) { xcd_barrier_complete(bar, b.x, nloc, nx); b.st[0] = nloc; b.st[1] = nx; }
        const unsigned old = xb_add(&bar[XB_XSUB(b.x)], 1u);
        const unsigned gen = old / nloc;
        if (old + 1u == (gen + 1u) * nloc) {
            __builtin_amdgcn_fence(__ATOMIC_RELEASE, "agent");
            asm volatile("s_waitcnt vmcnt(0)" ::: "memory");
            const unsigned og = xb_add(&bar[XB_TOP], 1u);
            const unsigned tg = og / nx;
            if (og + 1u == (tg + 1u) * nx) xb_add(&bar[XB_TOPGEN], 1u);
            else XB_SPIN(xb_ld(&bar[XB_TOPGEN]) == tg, bar);
            __builtin_amdgcn_fence(__ATOMIC_ACQUIRE, "agent");
            xb_add(&bar[XB_XGEN(b.x)], 1u);
            asm volatile("s_waitcnt vmcnt(0)" ::: "memory");
        } else {
            XB_SPIN(xb_ld(&bar[XB_XGEN(b.x)]) == gen, bar);
            __builtin_amdgcn_fence(__ATOMIC_ACQUIRE, "agent");
            asm volatile("s_waitcnt vmcnt(0)" ::: "memory");
        }
    }
    __syncthreads();
}

constexpr size_t OFF_BAR = 448 * 1024;

__global__ void __launch_bounds__(512, 2) mk_fwd(Params p) {
    extern __shared__ __attribute__((aligned(16))) unsigned char smem[];
    LAS unsigned char* lds0 = (LAS unsigned char*)smem;
    {
        const unsigned hw = (unsigned)__builtin_amdgcn_s_getreg((5 << 11) | 4) & 63u;
        if ((threadIdx.x & 63) == 0) *(volatile LAS int*)(LDS_HWTAB + hw * 4) = (int)(threadIdx.x >> 6);
        if (threadIdx.x < 64) ((LAS unsigned*)(lds0 + LDS_CTL))[threadIdx.x] = 0u;
    }
    __syncthreads();
    XcdBarrier bar; bar.bar = (unsigned*)(p.ws + OFF_BAR); bar.x = 0; bar.st = nullptr;
    bar = xcd_barrier_post((unsigned*)(p.ws + OFF_BAR), (volatile LAS unsigned*)(lds0 + LDS_CTL));
#ifndef PROBE
#define PROBE -1
#endif
#ifndef PROBE_END
#define PROBE_END (PROBE + 1)
#endif
    unsigned long long pt0 = 0, pt1 = 0;
#define RUN_PHASE(k, call) { if ((k) > 0) xcd_barrier(bar); if (PROBE >= 0 && (k) == PROBE) pt0 = __builtin_amdgcn_s_memrealtime(); if (PROBE >= 0 && (k) == PROBE_END) pt1 = __builtin_amdgcn_s_memrealtime(); \
    int on_ = 1; asm volatile("" : "+s"(on_)); if (on_) { int grp_ = hw_tid() >> 8; asm volatile("" : "+v"(grp_)); LAS unsigned char* lds = lds0 + grp_ * 32768; (void)lds; call; } }
    RUN_PHASE(0, phase_prep(p, lds))
    RUN_PHASE(1, phase_xn(p))
    RUN_PHASE(2, phase_inproj(p, lds0))
    RUN_PHASE(3, phase_attn_pool(p, lds, (char*)smem))
    RUN_PHASE(4, phase_outproj(p, lds0))
    RUN_PHASE(5, phase_router(p, lds0))
    RUN_PHASE(6, phase_gateup(p, lds0))
    RUN_PHASE(7, phase_down(p, lds0, 0))
    RUN_PHASE(8, phase_combine(p))
    RUN_PHASE(9, phase_down(p, lds0, 1))
    RUN_PHASE(10, phase_final(p))
    if (PROBE >= 0) {
        if (PROBE_END == 11) pt1 = __builtin_amdgcn_s_memrealtime();
        if (blockIdx.x == 0 && hw_tid() == 0) { const unsigned long long tend = __builtin_amdgcn_s_memrealtime() + 8ull * (pt1 - pt0); while (__builtin_amdgcn_s_memrealtime() < tend) __builtin_amdgcn_s_sleep(8); }
    }
}

extern "C" void kernel_launch(void* const* d_in, const int* in_sizes, int n_in, void* d_out, int out_size, void* d_ws, size_t ws_size, hipStream_t stream) {
    static int grid = 0;
    if (grid == 0) {
        int dev = 0, cus = 0, per_cu = 0;
        (void)hipGetDevice(&dev);
        (void)hipDeviceGetAttribute(&cus, hipDeviceAttributeMultiprocessorCount, dev);
        (void)hipFuncSetAttribute((const void*)mk_fwd, hipFuncAttributeMaxDynamicSharedMemorySize, LDS_BYTES);
        (void)hipOccupancyMaxActiveBlocksPerMultiprocessor(&per_cu, (const void*)mk_fwd, 512, LDS_BYTES);
        if (per_cu < 1) fprintf(stderr, "kernel_launch: occupancy query says %d blocks per CU\n", per_cu);
        (void)hipGetLastError();
        grid = cus;
        if (ws_size < WS_NEED) fprintf(stderr, "kernel_launch: workspace too small: %zu < %zu\n", ws_size, (size_t)WS_NEED);
    }
    Params p{};
    const float** pp = (const float**)&p;
    for (int i = 0; i < 24; ++i) pp[i] = (const float*)d_in[i];
    p.out = (float*)d_out; p.ws = (unsigned char*)d_ws;
    (void)hipMemsetAsync((char*)d_ws + OFF_BAR, 0, XCD_BAR_WORDS * 4, stream);
    hipLaunchKernelGGL(mk_fwd, dim3(grid), dim3(512), LDS_BYTES, stream, p);
}
```

```cpp
#include <hip/hip_runtime.h>
#include <stdint.h>
#include <stdio.h>


#define LAS __attribute__((address_space(3)))
#define TIDX ((int)(hw_tid() & 255))
#define VBLK ((int)(blockIdx.x * 2 + (hw_tid() >> 8)))
#define NVBLK ((int)(gridDim.x * 2))
typedef unsigned short bf16_t;
typedef short bf16x8 __attribute__((ext_vector_type(8)));
typedef float f32x4 __attribute__((ext_vector_type(4)));
typedef unsigned u32x4 __attribute__((ext_vector_type(4)));
typedef unsigned u32x2 __attribute__((ext_vector_type(2)));

constexpr int D = 1024, NB = 16, SEQ = 2048, T = NB * SEQ, CTXL = 256, TC = NB * CTXL, KVL = CTXL + SEQ;
constexpr int PW = 1536, NE = 64, NEX = 65, FF = 256, NSLOT = 9, MODW = 6 * D;
constexpr float ALPHA = 1.189207115002721f;
constexpr float C2 = 0.125f * 1.4426950408889634f;
constexpr int NPHASE = 9;
constexpr int LDS_BYTES = 163840, LDS_TAB = 131072, LDS_CTL = 155648;
constexpr int LDS_HWTAB = LDS_CTL + 2048;
__device__ __forceinline__ int hw_tid() {
    const unsigned hw = (unsigned)__builtin_amdgcn_s_getreg((5 << 11) | 4) & 63u;
    const int w = __builtin_amdgcn_readfirstlane(*(volatile LAS int*)(LDS_HWTAB + hw * 4));
    return w * 64 + (int)__builtin_amdgcn_mbcnt_hi(~0u, __builtin_amdgcn_mbcnt_lo(~0u, 0u));
}

constexpr size_t MiB = 1u << 20;
constexpr size_t OFF_CNT = 0, OFF_MOD = 4096, OFF_ROPE = 512 * 1024;
constexpr size_t OFF_WTIN = 1 * MiB, OFF_WTOUT = 4 * MiB, OFF_WD = 6 * MiB, OFF_LDST = 39 * MiB, OFF_ACT = 47 * MiB;
constexpr size_t OFF_SLOTS = 201 * MiB;
constexpr size_t OFF_WGU = 201 * MiB, OFF_H = 266 * MiB, OFF_LW = 330 * MiB;
constexpr size_t OFF_XN = 47 * MiB, OFF_Q = 119 * MiB, OFF_K = 167 * MiB;
constexpr size_t OFF_V = 338 * MiB, OFF_U = 356 * MiB, OFF_AO = 372 * MiB, OFF_STATS = 436 * MiB;
constexpr size_t OFF_WRH = 490 * MiB, OFF_WRL = OFF_WRH + 128 * 1024;
constexpr size_t WS_NEED = 491 * MiB;

struct Params {
    const float *x, *c, *ctx, *c_ctx, *w_mod, *b_mod, *w_in, *q_norm, *k_norm, *pool_w, *pool_scale, *w_out, *ln1_g, *ln1_b,
        *w_router, *router_bias, *w_gate, *w_up, *w_down, *ws_gate, *ws_up, *ws_down, *ln2_g, *ln2_b;
    float* out;
    unsigned char* ws;
};

__device__ __forceinline__ unsigned f2bf(float f) { unsigned u = __float_as_uint(f); return (u + 0x7fffu + ((u >> 16) & 1u)) >> 16; }
__device__ __forceinline__ unsigned pk2(float lo, float hi) { return f2bf(lo) | (f2bf(hi) << 16); }
__device__ __forceinline__ float bf2f(unsigned h) { return __uint_as_float(h << 16); }
__device__ __forceinline__ float bflo(unsigned w) { return __uint_as_float(w << 16); }
__device__ __forceinline__ float bfhi(unsigned w) { return __uint_as_float(w & 0xffff0000u); }

namespace pg8 {
constexpr int BM = 256, BK = 64, HALF = 128, HTB = HALF * BK * 2, STAGE_BYTES = 8 * HTB;
__host__ __device__ __forceinline__ int lds_byte(int r, int c) { const int st = (r >> 4) * 2 + (c >> 5), rr = r & 15, cc = c & 31, ob = rr * 64 + cc * 2; return st * 1024 + (ob ^ (((ob >> 9) & 1) << 5)); }
__host__ __device__ __forceinline__ void stage_rc(int b, int& R, int& C) { const int st = b / 1024, sb = b % 1024, swz = sb ^ (((sb >> 9) & 1) << 5); R = (st >> 1) * 16 + swz / 64; C = (st & 1) * 32 + (swz % 64) / 2; }
__host__ __device__ __forceinline__ int perm32(int rho) { const int n = rho >> 4, i = rho & 15; return 8 * (i >> 2) + 4 * n + (i & 3); }
struct Unit { int pm, pn, idx, e; };
struct Gemm { const bf16_t* A; const bf16_t* Bt; };
__device__ __forceinline__ unsigned cvt_pk_bf16(float lo, float hi) { unsigned r; asm volatile("v_cvt_pk_bf16_f32 %0, %1, %2" : "=v"(r) : "v"(lo), "v"(hi)); return r; }

template <int K, class Epi, class Sched, bool GATHER, bool ALIGN_EPI = true>
__device__ __forceinline__ void gemm_phase(LAS unsigned char* lds, const Gemm g, const Sched& S, const Epi& E) {
    const int tid = hw_tid(), wid = __builtin_amdgcn_readfirstlane(tid >> 6), lane = tid & 63, wr = wid >> 2, wc = wid & 3, fr = lane & 15, fq = lane >> 4;
    constexpr int nt = K / BK;
    unsigned voffA[2], voffB[2], colA = 0; int rowA = 0;
#pragma unroll
    for (int i = 0; i < 2; ++i) { int R, C; stage_rc(tid * 16 + i * 8192, R, C); const int Rb = Epi::PERM ? ((R & ~31) + perm32(R & 31)) : R;
        voffA[i] = (unsigned)(R * K + C) * 2u; voffB[i] = (unsigned)(Rb * K + C) * 2u; if (i == 0) { colA = (unsigned)C * 2u; rowA = R; } }
    const size_t kstep = (size_t)(BK * 2);
    const size_t hstep = (size_t)HALF * K * 2;
    const size_t tstep = 2 * hstep;
    const unsigned ldsw = (unsigned)wid * 1024u;
    const int aoff = lds_byte(wr * 64 + fr, fq * 8), boff = lds_byte(wc * 32 + fr, fq * 8);
#define PG8_SA(b, h) (((b) * 2 + (h)) * HTB)
#define PG8_SB(b, h) ((4 + (b) * 2 + (h)) * HTB)
#define PG8_STAGE(bufoff, gbase, voff) do { _Pragma("unroll") for (int _i = 0; _i < 2; ++_i) \
        __builtin_amdgcn_global_load_lds((const unsigned*)((const char*)(gbase) + (voff)[_i]), (LAS unsigned*)(lds + (bufoff) + ldsw + _i * 8192), 16, 0, 0); } while (0)
#define PG8_STAGE_A(bufoff, ptr, h, NX) do { if constexpr (GATHER) { unsigned _v[2]; \
            if (NX) { _v[0] = S.row_off(nidx, (h) * HALF + rowA) + colA; _v[1] = S.row_off(nidx, (h) * HALF + rowA + 64) + colA; } else { _v[0] = vA[h][0]; _v[1] = vA[h][1]; } PG8_STAGE(bufoff, ptr, _v); } \
        else { PG8_STAGE(bufoff, (ptr) + (h) * hstep, voffA); } } while (0)
#define PG8_LDA(dst, b, h) do { _Pragma("unroll") for (int m = 0; m < 4; ++m) _Pragma("unroll") for (int k = 0; k < 2; ++k) dst[m][k] = *(const LAS bf16x8*)(lds + PG8_SA(b, h) + aoff + m * 2048 + k * 1024); } while (0)
#define PG8_LDB(dst, b, h) do { _Pragma("unroll") for (int n = 0; n < 2; ++n) _Pragma("unroll") for (int k = 0; k < 2; ++k) dst[n][k] = *(const LAS bf16x8*)(lds + PG8_SB(b, h) + boff + n * 2048 + k * 1024); } while (0)
#define PG8_MMA(ai, bj, At, Bt) do { __builtin_amdgcn_s_setprio(1); _Pragma("unroll") for (int m = 0; m < 4; ++m) _Pragma("unroll") for (int n = 0; n < 2; ++n) _Pragma("unroll") for (int k = 0; k < 2; ++k) \
        acc[ai][bj][m][n] = __builtin_amdgcn_mfma_f32_16x16x32_bf16(Bt[n][k], At[m][k], acc[ai][bj][m][n], 0, 0, 0); __builtin_amdgcn_s_setprio(0); } while (0)
#define PG8_WAIT_V(n) asm volatile("s_waitcnt vmcnt(" #n ")" ::: "memory")
#define PG8_WAIT_L(n) asm volatile("s_waitcnt lgkmcnt(" #n ")" ::: "memory")
#define PG8_BAR __builtin_amdgcn_s_barrier()
#define PG8_SCHED __builtin_amdgcn_sched_barrier(0)
    Unit cur, nxt; int ui = 0;
    if (!S.next(0, cur)) return;
    f32x4 acc[2][2][4][2];
#pragma unroll
    for (int a = 0; a < 2; ++a)
#pragma unroll
        for (int b = 0; b < 2; ++b)
#pragma unroll
            for (int m = 0; m < 4; ++m)
#pragma unroll
                for (int n = 0; n < 2; ++n) acc[a][b][m][n] = (f32x4){0.f, 0.f, 0.f, 0.f};
    bf16x8 At[4][2], B0[2][2], B1[2][2];
    unsigned vA[2][2]; int nidx = 0;
    if constexpr (GATHER) {
#pragma unroll
        for (int h = 0; h < 2; ++h)
#pragma unroll
            for (int i = 0; i < 2; ++i) vA[h][i] = S.row_off(cur.idx, h * HALF + rowA + 64 * i) + colA;
    }
    const char* cA = GATHER ? (const char*)g.A : (const char*)g.A + (size_t)cur.pm * tstep; const char* cB = (const char*)g.Bt + (size_t)cur.pn * tstep;
    S.a_ready(cur);
    PG8_STAGE(PG8_SB(0, 0), cB, voffB); PG8_STAGE(PG8_SB(0, 1), cB + hstep, voffB); PG8_STAGE_A(PG8_SA(0, 0), cA, 0, false); PG8_STAGE_A(PG8_SA(0, 1), cA, 1, false);
    if (wr == 1) PG8_BAR;
    PG8_WAIT_V(2); PG8_BAR;
    PG8_STAGE(PG8_SB(1, 0), cB + kstep, voffB); PG8_STAGE_A(PG8_SA(1, 0), cA + kstep, 0, false); PG8_STAGE(PG8_SB(1, 1), cB + hstep + kstep, voffB);
    PG8_WAIT_V(6); PG8_BAR;
    for (;;) {
        const bool has_next = S.next(ui + 1, nxt);
        if constexpr (GATHER) nidx = has_next ? nxt.idx : cur.idx;
        const char* nA = GATHER ? (const char*)g.A : (has_next ? (const char*)g.A + (size_t)nxt.pm * tstep : cA); const char* nB = has_next ? (const char*)g.Bt + (size_t)nxt.pn * tstep : cB;
        for (int t = 0; t < nt; t += 2) {
            const bool last = (t == nt - 2);
            const char* a1 = cA + (size_t)(t + 1) * kstep;
            const char* a2 = last ? nA : cA + (size_t)(t + 2) * kstep; const char* b2 = last ? nB : cB + (size_t)(t + 2) * kstep;
            const char* a3 = a2 + kstep; const char* b3 = b2 + kstep;
            if (last && has_next) S.a_ready(nxt);
            PG8_LDB(B0, 0, 0); PG8_LDB(B1, 0, 1); PG8_SCHED; PG8_LDA(At, 0, 0); PG8_STAGE_A(PG8_SA(1, 1), a1, 1, false);
            PG8_WAIT_V(8); PG8_WAIT_L(0); PG8_BAR; PG8_MMA(0, 0, At, B0); PG8_MMA(0, 1, At, B1); PG8_BAR; PG8_SCHED;
            PG8_LDA(At, 0, 1); PG8_STAGE(PG8_SB(0, 0), b2, voffB); PG8_STAGE(PG8_SB(0, 1), b2 + hstep, voffB); PG8_STAGE_A(PG8_SA(0, 0), a2, 0, last);
            PG8_WAIT_V(8); PG8_WAIT_L(0); PG8_BAR; PG8_MMA(1, 0, At, B0); PG8_MMA(1, 1, At, B1); PG8_BAR; PG8_SCHED;
            PG8_LDB(B0, 1, 0); PG8_LDB(B1, 1, 1); PG8_SCHED; PG8_LDA(At, 1, 0); PG8_STAGE_A(PG8_SA(0, 1), a2, 1, last);
            PG8_WAIT_V(8); PG8_WAIT_L(0); PG8_BAR; PG8_MMA(0, 0, At, B0); PG8_MMA(0, 1, At, B1); PG8_BAR; PG8_SCHED;
            PG8_LDA(At, 1, 1); PG8_STAGE(PG8_SB(1, 0), b3, voffB); PG8_STAGE(PG8_SB(1, 1), b3 + hstep, voffB); PG8_STAGE_A(PG8_SA(1, 0), a3, 0, last);
            PG8_WAIT_V(8); PG8_WAIT_L(0); PG8_BAR; PG8_MMA(1, 0, At, B0); PG8_MMA(1, 1, At, B1); PG8_BAR; PG8_SCHED;
        }
        if constexpr (ALIGN_EPI) { if (wr == 0) PG8_BAR; }
        E(acc, cur, wr, wc, fr, fq); S.done(cur);
        if (!has_next) break;
#pragma unroll
        for (int a = 0; a < 2; ++a)
#pragma unroll
            for (int b = 0; b < 2; ++b)
#pragma unroll
                for (int m = 0; m < 4; ++m)
#pragma unroll
                    for (int n = 0; n < 2; ++n) acc[a][b][m][n] = (f32x4){0.f, 0.f, 0.f, 0.f};
        cur = nxt; cA = nA; cB = nB; ++ui;
        if constexpr (GATHER) {
#pragma unroll
            for (int h = 0; h < 2; ++h)
#pragma unroll
                for (int i = 0; i < 2; ++i) vA[h][i] = S.row_off(cur.idx, h * HALF + rowA + 64 * i) + colA;
        }
        if constexpr (ALIGN_EPI) { if (wr == 1) PG8_BAR; }
    }
    PG8_WAIT_V(0);
    if constexpr (!ALIGN_EPI) { if (wr == 0) PG8_BAR; }
    PG8_BAR;
#undef PG8_SA
#undef PG8_SB
#undef PG8_STAGE
#undef PG8_STAGE_A
#undef PG8_LDA
#undef PG8_LDB
#undef PG8_MMA
#undef PG8_WAIT_V
#undef PG8_WAIT_L
#undef PG8_BAR
#undef PG8_SCHED
}

struct DenseSched {
    int nN, n1, total, pn2lo, nN2, G, c;
    __device__ __forceinline__ bool next(int i, Unit& u) const {
        const int L = i * G + c; if (L >= total) return false;
        if (L < n1) { u.pm = L / nN; u.pn = L % nN; } else { const int r = L - n1; u.pm = n1 / nN + r / nN2; u.pn = pn2lo + r % nN2; }
        u.idx = i; u.e = 0; return true;
    }
    __device__ __forceinline__ void a_ready(const Unit&) const {}
    __device__ __forceinline__ void done(const Unit&) const {}
};
}

__device__ __forceinline__ int win_row(int n) { return (n & ~255) + 128 * ((n >> 5) & 1) + 32 * ((n >> 6) & 3) + (n & 31); }
__device__ __forceinline__ int gu_row(int j, int half) { return (j >> 7) * 256 + half * 128 + (j & 127); }

template <class RowMap>
__device__ __forceinline__ void transpose_tile(LAS float* tile, const float* src, int ld, int k0, int n0, bf16_t* dst, int Kdst, RowMap rowmap) {
    const int tid = TIDX;
#pragma unroll
    for (int pss = 0; pss < 4; ++pss) {
        const int k = pss * 16 + (tid >> 4), n4 = (tid & 15) * 4;
        const f32x4 v = *(const f32x4*)(src + (size_t)(k0 + k) * ld + n0 + n4);
        tile[k * 65 + n4 + 0] = v[0]; tile[k * 65 + n4 + 1] = v[1]; tile[k * 65 + n4 + 2] = v[2]; tile[k * 65 + n4 + 3] = v[3];
    }
    __syncthreads();
    {
        const int n = tid >> 2, kc = (tid & 3) * 16;
        unsigned w[8];
#pragma unroll
        for (int i = 0; i < 8; ++i) w[i] = pk2(tile[(kc + 2 * i) * 65 + n], tile[(kc + 2 * i + 1) * 65 + n]);
        bf16_t* dp = dst + (size_t)rowmap(n0 + n) * Kdst + k0 + kc;
        *(u32x4*)dp = (u32x4){w[0], w[1], w[2], w[3]};
        *(u32x4*)(dp + 8) = (u32x4){w[4], w[5], w[6], w[7]};
    }
    __syncthreads();
}

template <class RowMap>
__device__ __forceinline__ void wave_transpose(LAS float* scr, const float* src, int ld, int k0, int n0, bf16_t* dst, int Kdst, RowMap rowmap, int lane) {
#pragma unroll
    for (int i = 0; i < 8; ++i) {
        const int kk = 8 * i + (lane >> 3), n4 = (lane & 7) * 4;
        const f32x4 v = *(const f32x4*)(src + (size_t)(k0 + kk) * ld + n0 + n4);
        scr[kk * 33 + n4] = v[0]; scr[kk * 33 + n4 + 1] = v[1]; scr[kk * 33 + n4 + 2] = v[2]; scr[kk * 33 + n4 + 3] = v[3];
    }
    asm volatile("s_waitcnt lgkmcnt(0)" ::: "memory");
    const int c = lane & 7;
#pragma unroll
    for (int j = 0; j < 4; ++j) {
        const int n = (lane >> 3) + 8 * j; const LAS float* sp = scr + (8 * c) * 33 + n;
        u32x4 o; o.x = pk2(sp[0], sp[33]); o.y = pk2(sp[2 * 33], sp[3 * 33]); o.z = pk2(sp[4 * 33], sp[5 * 33]); o.w = pk2(sp[6 * 33], sp[7 * 33]);
        *(u32x4*)(dst + (size_t)rowmap(n0 + n) * Kdst + k0 + 8 * c) = o;
    }
    asm volatile("s_waitcnt lgkmcnt(0)" ::: "memory");
}

__device__ __forceinline__ void phase_prep(const Params& p, LAS unsigned char* lds) {
    const int tid = TIDX;
    int* gcnt = (int*)(p.ws + OFF_CNT);
    if (VBLK == 0 && tid < 128) gcnt[tid] = 0;
    float* mod = (float*)(p.ws + OFF_MOD);
    float* rope = (float*)(p.ws + OFF_ROPE);
    constexpr int N_MOD = 384, N_ROPE = 256, N_TR = 16;
    for (int it = VBLK; it < N_MOD + N_ROPE + N_TR; it += NVBLK) {
        if (it < N_MOD) {
            LAS float* sl = (LAS float*)lds;
            LAS float* red = (LAS float*)(lds + 10240);
            const int col = it * 16 + (tid & 15), kk = tid >> 4;
            float acc[17];
#pragma unroll
            for (int r = 0; r < 17; ++r) acc[r] = 0.f;
            for (int kc = 0; kc < 8; ++kc) {
                float wv[8];
#pragma unroll
                for (int i = 0; i < 8; ++i) wv[i] = p.w_mod[(size_t)(kc * 128 + kk + 16 * i) * MODW + col];
                __syncthreads();
                for (int o = tid; o < 17 * 128; o += 256) {
                    const int r = o >> 7, kl = o & 127;
                    const float cv = (r < 16) ? p.c[r * D + kc * 128 + kl] : p.c_ctx[kc * 128 + kl];
                    sl[kl * 20 + r] = cv / (1.f + expf(-cv));
                }
                __syncthreads();
#pragma unroll
                for (int i = 0; i < 8; ++i) {
                    const int kl = kk + 16 * i;
                    const f32x4 s0 = *(const LAS f32x4*)(sl + kl * 20), s1 = *(const LAS f32x4*)(sl + kl * 20 + 4), s2 = *(const LAS f32x4*)(sl + kl * 20 + 8), s3 = *(const LAS f32x4*)(sl + kl * 20 + 12);
                    const float s4 = sl[kl * 20 + 16];
#pragma unroll
                    for (int q = 0; q < 4; ++q) { acc[q] += s0[q] * wv[i]; acc[4 + q] += s1[q] * wv[i]; acc[8 + q] += s2[q] * wv[i]; acc[12 + q] += s3[q] * wv[i]; }
                    acc[16] += s4 * wv[i];
                }
            }
#pragma unroll
            for (int r = 0; r < 17; ++r) red[(kk * 17 + r) * 16 + (tid & 15)] = acc[r];
            __syncthreads();
            for (int o = tid; o < 17 * 16; o += 256) {
                const int r = o >> 4, j = o & 15;
                float sm = p.b_mod[it * 16 + j];
#pragma unroll
                for (int g = 0; g < 16; ++g) sm += red[(g * 17 + r) * 16 + j];
                mod[r * MODW + it * 16 + j] = sm;
            }
            __syncthreads();
        } else if (it < N_MOD + N_ROPE) {
            const int idx = (it - N_MOD) * 256 + tid, t = idx >> 5, i = idx & 31;
            const int pos = (i < 16) ? (t >> 6) : (t & 63);
            const float invf = (float)exp(-(double)(i & 15) / 16.0 * 9.210340371976184);
            const double ang = (double)((float)pos * invf);
            rope[idx * 2 + 0] = (float)cos(ang);
            rope[idx * 2 + 1] = (float)sin(ang);
        } else {
            LAS float* tile = (LAS float*)lds;
            const int idx = it - N_MOD - N_ROPE;
            {

                const int k0 = idx * 64;
#pragma unroll
                for (int pss = 0; pss < 4; ++pss) {
                    const int k = pss * 16 + (tid >> 4), n4 = (tid & 15) * 4;
                    const f32x4 v = *(const f32x4*)(p.w_router + (size_t)(k0 + k) * NE + n4);
                    tile[k * 65 + n4 + 0] = v[0]; tile[k * 65 + n4 + 1] = v[1]; tile[k * 65 + n4 + 2] = v[2]; tile[k * 65 + n4 + 3] = v[3];
                }
                __syncthreads();
                {
                    const int n = tid >> 2, kc = (tid & 3) * 16;
                    unsigned wh[8], wl[8];
#pragma unroll
                    for (int i = 0; i < 8; ++i) {
                        const float a = tile[(kc + 2 * i) * 65 + n], b = tile[(kc + 2 * i + 1) * 65 + n];
                        const unsigned ha = f2bf(a), hb = f2bf(b);
                        wh[i] = ha | (hb << 16);
                        wl[i] = pk2(a - bf2f(ha), b - bf2f(hb));
                    }
                    bf16_t* dh = (bf16_t*)(p.ws + OFF_WRH) + (size_t)n * D + k0 + kc;
                    bf16_t* dl = (bf16_t*)(p.ws + OFF_WRL) + (size_t)n * D + k0 + kc;
                    *(u32x4*)dh = (u32x4){wh[0], wh[1], wh[2], wh[3]}; *(u32x4*)(dh + 8) = (u32x4){wh[4], wh[5], wh[6], wh[7]};
                    *(u32x4*)dl = (u32x4){wl[0], wl[1], wl[2], wl[3]}; *(u32x4*)(dl + 8) = (u32x4){wl[4], wl[5], wl[6], wl[7]};
                }
                __syncthreads();
            }
        }
    }
    __syncthreads();
    {
        const int lane = hw_tid() & 63, wv = hw_tid() >> 6;
        LAS float* scr = (LAS float*)(lds - (hw_tid() >> 8) * 32768) + wv * (64 * 33);
        constexpr int I_IN = 16 * 48, I_OUT = 16 * 32, I_E = 384, NITEMS = I_IN + I_OUT + NEX * I_E;
        for (int it = blockIdx.x * 8 + wv; it < NITEMS; it += gridDim.x * 8) {
            int r = it;
            if (r < I_IN) { wave_transpose(scr, p.w_in, PW, (r / 48) * 64, (r % 48) * 32, (bf16_t*)(p.ws + OFF_WTIN), D, [](int n) { return win_row(n); }, lane); continue; }
            r -= I_IN;
            if (r < I_OUT) { wave_transpose(scr, p.w_out, D, (r / 32) * 64, (r % 32) * 32, (bf16_t*)(p.ws + OFF_WTOUT), D, [](int n) { return n; }, lane); continue; }
            r -= I_OUT;
            const int e = r / I_E, q = r % I_E;
            if (q < 256) {
                const int half = q >> 7, rr = q & 127;
                const float* src = half ? (e < NE ? p.w_up + (size_t)e * D * FF : p.ws_up) : (e < NE ? p.w_gate + (size_t)e * D * FF : p.ws_gate);
                wave_transpose(scr, src, FF, (rr / 8) * 64, (rr % 8) * 32, (bf16_t*)(p.ws + OFF_WGU) + (size_t)e * 512 * D, D, [half](int n) { return gu_row(n, half); }, lane);
            } else {
                const int rr = q - 256;
                const float* src = e < NE ? p.w_down + (size_t)e * FF * D : p.ws_down;
                wave_transpose(scr, src, D, (rr / 32) * 64, (rr % 32) * 32, (bf16_t*)(p.ws + OFF_WD) + (size_t)e * D * FF, FF, [](int n) { return n; }, lane);
            }
        }
    }
}

__device__ __forceinline__ void phase_xn(const Params& p) {
    const int lane = TIDX & 63, gw = VBLK * 4 + (TIDX >> 6), ngw = NVBLK * 4;
    const float* mod = (const float*)(p.ws + OFF_MOD);
    bf16_t* XN = (bf16_t*)(p.ws + OFF_XN);
    for (int row = gw; row < T + TC; row += ngw) {
        const float* src = row < T ? p.x + (size_t)row * D : p.ctx + (size_t)(row - T) * D;
        const float* mr = mod + (size_t)(row < T ? row / SEQ : 16) * MODW;
#pragma unroll
        for (int j = 0; j < 4; ++j) {
            const int c = 4 * lane + 256 * j;
            const f32x4 v = *(const f32x4*)(src + c), sh = *(const f32x4*)(mr + c), sc = *(const f32x4*)(mr + D + c);
            u32x2 o; o.x = pk2(v[0] * (1.f + sc[0]) + sh[0], v[1] * (1.f + sc[1]) + sh[1]); o.y = pk2(v[2] * (1.f + sc[2]) + sh[2], v[3] * (1.f + sc[3]) + sh[3]);
            *(u32x2*)(XN + (size_t)row * D + c) = o;
        }
    }
}

struct EpiIn {
    static constexpr bool PERM = true;
    const float *q_norm, *k_norm, *rope; bf16_t *Qb, *Kb, *Vb, *Ub;
    __device__ __forceinline__ void operator()(const f32x4 (&acc)[2][2][4][2], const pg8::Unit& u, int wr, int wc, int fr, int fq) const {
        const int grp = u.pn * 4 + wc;
        const bool is_ctx = u.pm >= T / 256;
        f32x4 gn[2][2];
        if (grp >= 4 && grp < 20) {
            const float* g = grp < 16 ? q_norm : k_norm;
#pragma unroll
            for (int bj = 0; bj < 2; ++bj)
#pragma unroll
                for (int n = 0; n < 2; ++n) gn[bj][n] = *(const f32x4*)(g + 32 * bj + 8 * fq + 4 * n);
        }
#pragma unroll
        for (int ai = 0; ai < 2; ++ai)
#pragma unroll
            for (int m = 0; m < 4; ++m) {
                const int row = u.pm * 256 + ai * 128 + wr * 64 + m * 16 + fr;
                f32x4 v[2][2];
#pragma unroll
                for (int bj = 0; bj < 2; ++bj)
#pragma unroll
                    for (int n = 0; n < 2; ++n) v[bj][n] = acc[ai][bj][m][n];
                bf16_t* dst;
                if (grp < 4) dst = Ub + (size_t)row * 256 + grp * 64;
                else if (grp < 16) dst = Qb + (size_t)row * 768 + (grp - 4) * 64;
                else {
                    const size_t krow = is_ctx ? (size_t)((row - T) >> 8) * KVL + ((row - T) & 255) : (size_t)(row >> 11) * KVL + CTXL + (row & (SEQ - 1));
                    dst = (grp < 20 ? Kb + (grp - 16) * 64 : Vb + (grp - 20) * 64) + krow * 256;
                }
                if (grp >= 4 && grp < 20) {
                    float ss = 0.f;
#pragma unroll
                    for (int bj = 0; bj < 2; ++bj)
#pragma unroll
                        for (int n = 0; n < 2; ++n) ss += (v[bj][n][0] * v[bj][n][0] + v[bj][n][1] * v[bj][n][1]) + (v[bj][n][2] * v[bj][n][2] + v[bj][n][3] * v[bj][n][3]);
                    ss += __shfl_xor(ss, 16); ss += __shfl_xor(ss, 32);
                    const float rs = 1.0f / sqrtf(ss * (1.f / 64.f) + 1e-6f);
#pragma unroll
                    for (int bj = 0; bj < 2; ++bj)
#pragma unroll
                        for (int n = 0; n < 2; ++n) v[bj][n] = v[bj][n] * rs * gn[bj][n];
                    if (!is_ctx) {
                        const int tpos = row & (SEQ - 1);
#pragma unroll
                        for (int bj = 0; bj < 2; ++bj)
#pragma unroll
                            for (int n = 0; n < 2; ++n) {
                                const f32x4 cs = *(const f32x4*)(rope + (size_t)(tpos * 32 + 16 * bj + 4 * fq + 2 * n) * 2);
                                const f32x4 x = v[bj][n];
                                v[bj][n] = (f32x4){x[0] * cs[0] - x[1] * cs[1], x[0] * cs[1] + x[1] * cs[0], x[2] * cs[2] - x[3] * cs[3], x[2] * cs[3] + x[3] * cs[2]};
                            }
                    }
                    if (grp < 16) {
#pragma unroll
                        for (int bj = 0; bj < 2; ++bj)
#pragma unroll
                            for (int n = 0; n < 2; ++n) v[bj][n] = v[bj][n] * C2;
                    }
                }
#pragma unroll
                for (int bj = 0; bj < 2; ++bj) {
                    u32x4 w; w.x = pk2(v[bj][0][0], v[bj][0][1]); w.y = pk2(v[bj][0][2], v[bj][0][3]); w.z = pk2(v[bj][1][0], v[bj][1][1]); w.w = pk2(v[bj][1][2], v[bj][1][3]);
                    *(u32x4*)(dst + 32 * bj + 8 * fq) = w;
                }
            }
    }
};
__device__ __forceinline__ int vcu_of_block() { const int G = gridDim.x, bx = blockIdx.x; return (G % 8 == 0) ? (bx % 8) * (G / 8) + bx / 8 : bx; }
__device__ __forceinline__ void phase_inproj(const Params& p, LAS unsigned char* lds) {
    pg8::Gemm g{(const bf16_t*)(p.ws + OFF_XN), (const bf16_t*)(p.ws + OFF_WTIN)};
    pg8::DenseSched S{6, 768, 800, 4, 2, (int)gridDim.x, vcu_of_block()};
    EpiIn E{p.q_norm, p.k_norm, (const float*)(p.ws + OFF_ROPE), (bf16_t*)(p.ws + OFF_Q), (bf16_t*)(p.ws + OFF_K), (bf16_t*)(p.ws + OFF_V), (bf16_t*)(p.ws + OFF_U)};
    pg8::gemm_phase<D, EpiIn, pg8::DenseSched, false>(lds, g, S, E);
}

namespace attn_body {
using bf16=unsigned short;
using bf16x8=__attribute__((ext_vector_type(8)))short;
using s16x4=__attribute__((ext_vector_type(4)))short;
using f32x16=__attribute__((ext_vector_type(16)))float;
using u32x4=__attribute__((ext_vector_type(4)))unsigned;
constexpr int D=64,QP=768,KP=256,OP=1024,SEQ=2048,KVLEN=2304;
constexpr int NW=8,QBLK=32,QB=QBLK*NW,KVBLK=64,NT=KVLEN/KVBLK;
__device__ __forceinline__ int crow(int r,int hi){return (r&3)+8*(r>>2)+4*hi;}
#define SBAR() __builtin_amdgcn_sched_barrier(0)
constexpr int NSLOT=3, SLOTB=8192;
constexpr int LDS_K=0, LDS_V=NSLOT*SLOTB, LDS_WS=2*NSLOT*SLOTB, LDS_OST=LDS_WS+NW*64*4, LDS_BYTES=LDS_OST+NW*4096;
constexpr float C2=0.125f*1.4426950408889634f;
__device__ __forceinline__ void glds16(const void*gsrc,unsigned lds_dst){unsigned keep;
  asm volatile("s_mov_b32 %0, m0\n\ts_mov_b32 m0, %2\n\ts_nop 0\n\tglobal_load_lds_dwordx4 %1, off\n\ts_mov_b32 m0, %0":"=&s"(keep):"v"(gsrc),"s"(lds_dst):"memory");}
__device__ __forceinline__ float max3f(float a,float b,float c){float r;asm("v_max3_f32 %0, %1, %2, %3":"=v"(r):"v"(a),"v"(b),"v"(c));return r;}
__device__ __forceinline__ float max2f(float a,float b){float r;asm("v_max_f32_e32 %0, %1, %2":"=v"(r):"v"(a),"v"(b));return r;}
__device__ __forceinline__ float fadd_s(float a,float b){float r;asm("v_add_f32_e32 %0, %1, %2":"=v"(r):"v"(a),"v"(b));return r;}
__device__ __forceinline__ float fsub_s(float a,float b){float r;asm("v_sub_f32_e32 %0, %1, %2":"=v"(r):"v"(a),"v"(b));return r;}
typedef float f32x2_t __attribute__((ext_vector_type(2))); typedef __bf16 bf16x2_t __attribute__((ext_vector_type(2)));
__device__ __forceinline__ unsigned cvtpk_s(float lo,float hi){f32x2_t v={lo,hi};bf16x2_t b=__builtin_convertvector(v,bf16x2_t);return __builtin_bit_cast(unsigned,b);}
#define WAIT_BAR(N) asm volatile("s_waitcnt vmcnt(" #N ") lgkmcnt(0)\n\ts_barrier":::"memory")

__device__ __forceinline__ void qkt(f32x16&p0,f32x16&p1,const char*Kslot,const bf16x8*qr,const f32x16&negm,int r32,int hi){
  const char*kb=Kslot+hi*1024+r32*16;
  #pragma unroll
  for(int d0=0;d0<4;++d0){
    const bf16x8 b0=*reinterpret_cast<const bf16x8*>(kb+d0*2048);
    const bf16x8 b1=*reinterpret_cast<const bf16x8*>(kb+d0*2048+512);
    if(d0==0){p0=__builtin_amdgcn_mfma_f32_32x32x16_bf16(b0,qr[0],negm,0,0,0);p1=__builtin_amdgcn_mfma_f32_32x32x16_bf16(b1,qr[0],negm,0,0,0);}
    else{p0=__builtin_amdgcn_mfma_f32_32x32x16_bf16(b0,qr[d0],p0,0,0,0);p1=__builtin_amdgcn_mfma_f32_32x32x16_bf16(b1,qr[d0],p1,0,0,0);}}
}
typedef __attribute__((address_space(3))) const char* lds_cptr;
typedef short v4i16_t __attribute__((ext_vector_type(4)));
__device__ __forceinline__ void kload8(bf16x8*kf,lds_cptr kp){
  kf[0]=*(const __attribute__((address_space(3))) bf16x8*)(kp);      kf[1]=*(const __attribute__((address_space(3))) bf16x8*)(kp+512);
  kf[2]=*(const __attribute__((address_space(3))) bf16x8*)(kp+2048); kf[3]=*(const __attribute__((address_space(3))) bf16x8*)(kp+2560);
  kf[4]=*(const __attribute__((address_space(3))) bf16x8*)(kp+4096); kf[5]=*(const __attribute__((address_space(3))) bf16x8*)(kp+4608);
  kf[6]=*(const __attribute__((address_space(3))) bf16x8*)(kp+6144); kf[7]=*(const __attribute__((address_space(3))) bf16x8*)(kp+6656);
}
__device__ __forceinline__ void kload2(bf16x8*kf,lds_cptr kp,int j){ kf[2*j]=*(const __attribute__((address_space(3))) bf16x8*)(kp+j*2048); kf[2*j+1]=*(const __attribute__((address_space(3))) bf16x8*)(kp+j*2048+512); }
__device__ __forceinline__ s16x4 vtr(lds_cptr p){ return __builtin_bit_cast(s16x4,__builtin_amdgcn_ds_read_tr16_b64_v4i16((__attribute__((address_space(3))) v4i16_t*)p)); }
__device__ __forceinline__ float rowmax(const f32x16&p0,const f32x16&p1){
  float a=max3f(p0[0],p0[1],p1[0]),b=max3f(p0[2],p0[3],p1[1]);a=max3f(a,p1[2],p1[3]);
  #pragma unroll
  for(int r=4;r<16;r+=4){a=max3f(a,p0[r],p0[r+1]);b=max3f(b,p0[r+2],p0[r+3]);a=max3f(a,p1[r],p1[r+1]);b=max3f(b,p1[r+2],p1[r+3]);}
  const float m=max2f(a,b);
  auto rr=__builtin_amdgcn_permlane32_swap(__float_as_uint(m),__float_as_uint(m),false,false);
  return max2f(__uint_as_float(rr[0]),__uint_as_float(rr[1]));
}
__device__ __forceinline__ void pv(f32x16*o,int vb,bf16x8 pa0,bf16x8 pa1,bf16x8 pa2,bf16x8 pa3){
  #pragma unroll
  for(int d0=0;d0<2;++d0){s16x4 lo[4],hi[4];
    #pragma unroll
    for(int ks=0;ks<4;++ks){
      asm volatile("ds_read_b64_tr_b16 %0,%1 offset:%c2":"=&v"(lo[ks]):"v"(vb),"i"(d0*4096+ks*1024):"memory");
      asm volatile("ds_read_b64_tr_b16 %0,%1 offset:%c2":"=&v"(hi[ks]):"v"(vb),"i"(d0*4096+ks*1024+512):"memory");}
    asm volatile("s_waitcnt lgkmcnt(0)":::"memory");SBAR();
    #define PK(k) (bf16x8){lo[k][0],lo[k][1],lo[k][2],lo[k][3],hi[k][0],hi[k][1],hi[k][2],hi[k][3]}
    o[d0]=__builtin_amdgcn_mfma_f32_32x32x16_bf16(pa0,PK(0),o[d0],0,0,0);
    o[d0]=__builtin_amdgcn_mfma_f32_32x32x16_bf16(pa1,PK(1),o[d0],0,0,0);
    o[d0]=__builtin_amdgcn_mfma_f32_32x32x16_bf16(pa2,PK(2),o[d0],0,0,0);
    o[d0]=__builtin_amdgcn_mfma_f32_32x32x16_bf16(pa3,PK(3),o[d0],0,0,0);
    #undef PK
  }
}

#ifndef ATTN_STORE16
#define ATTN_STORE16(p,v) (*(u32x4*)(p)=(v))
#endif
template<int THRL> __device__ __forceinline__ void attn_unit(int b,int h,int qb,const bf16*Q,const bf16*__restrict__ K,const bf16*__restrict__ V,bf16*O,char*shm){
  const int tid=hw_tid(),lane=tid&63,r32=lane&31,hi=lane>>5; const int wid=__builtin_amdgcn_readfirstlane(tid>>6);
  const long rowbase=(long)b*SEQ, kvbase=(long)b*KVLEN; const int q0=qb*QB, kh=h/3;
  const bf16*Qw=Q+(rowbase+q0+wid*QBLK)*QP+h*D;
  const bf16*Kh=K+kvbase*KP+kh*D,*Vh=V+kvbase*KP+kh*D;
  const unsigned lds0=(unsigned)(uintptr_t)shm;
  float*wsf=(float*)(shm+LDS_WS)+wid*64;
  const bf16*ksrc=Kh+(long)lane*KP+wid*8;
  const bf16*vsrc=Vh+(long)(16*(wid&3)+(lane>>2))*KP+(wid>>2)*32+(lane&3)*8;
  const unsigned kdst=lds0+LDS_K+wid*1024, vdst=lds0+LDS_V+wid*1024;
  #define DMA_K(t,slot) glds16(ksrc+(long)(t)*KVBLK*KP,(unsigned)__builtin_amdgcn_readfirstlane(kdst+(slot)))
  #define DMA_V(t,slot) glds16(vsrc+(long)(t)*KVBLK*KP,(unsigned)__builtin_amdgcn_readfirstlane(vdst+(slot)))
  const int vb0=(int)(lds0+LDS_V)+((lane>>4)&1)*32+(lane&3)*8+(4*hi+((lane&15)>>2))*64;
  const char*Kbase=shm+LDS_K; bf16x8 kf[8];
  const lds_cptr shm3=(lds_cptr)shm; const lds_cptr kp0=shm3+LDS_K+hi*1024+r32*16; const lds_cptr vp0=shm3+LDS_V+((lane>>4)&1)*32+(lane&3)*8+(4*hi+((lane&15)>>2))*64;
  DMA_K(0,0);DMA_V(0,0);DMA_K(1,SLOTB);
  bf16x8 qr[4];
  #pragma unroll
  for(int d0=0;d0<4;++d0)qr[d0]=*reinterpret_cast<const bf16x8*>(&Qw[(long)r32*QP+d0*16+hi*8]);
  float mhat=0.f,l_reg=0.f;f32x16 o[2];o[0]=f32x16{};o[1]=f32x16{};f32x16 negm=f32x16{};asm volatile("":"+v"(negm));
  #define CMASK(P0,P1,t) do{}while(0)
  bool resc=false;
  #define START(P0,P1) do{ const float rm=rowmax(P0,P1); resc=false; \
    { const float dl=rm; mhat=fadd_s(mhat,dl); \
      _Pragma("unroll") for(int r=0;r<16;++r){P0[r]=fsub_s(P0[r],dl);P1[r]=fsub_s(P1[r],dl);} \
      _Pragma("unroll") for(int r=0;r<16;++r)negm[r]=-mhat; asm volatile("":"+v"(negm)); } \
    _Pragma("unroll") for(int r=0;r<16;++r)P0[r]=__builtin_amdgcn_exp2f(P0[r]); }while(0)
  #define RESC() do{ if(resc){ asm volatile("s_waitcnt lgkmcnt(0)":::"memory"); \
      _Pragma("unroll") for(int d_=0;d_<2;++d_) _Pragma("unroll") for(int r=0;r<16;++r)o[d_][r]*=wsf[crow(r,hi)]; } }while(0)
  f32x16 pA0,pA1,pB0,pB1;
  int sl_prev=0,sl_cur=0,sl_next=SLOTB;
  #define ROT() do{sl_prev=sl_cur;sl_cur=sl_next;sl_next=(sl_next==(NSLOT-1)*SLOTB)?0:sl_next+SLOTB;}while(0)
  DMA_K(2,2*SLOTB);
  WAIT_BAR(3);
  qkt(pA0,pA1,Kbase,qr,negm,r32,hi);asm volatile("s_nop 15\n\ts_nop 7":"+v"(pA0),"+v"(pA1));CMASK(pA0,pA1,0);
  START(pA0,pA1);
  _Pragma("unroll") for(int r=0;r<16;++r)pA1[r]=__builtin_amdgcn_exp2f(pA1[r]);
  WAIT_BAR(0);
  DMA_K(3,0);DMA_V(1,SLOTB);
  ROT();
  kload8(kf,kp0+sl_cur);
  WAIT_BAR(2);
  s16x4 vlo[8],vhi[8]; u32x4 pw0,pw1,pw2,pw3;
  #define PKW(P,B) cvtpk_s(P[B],P[B+1])
  #define PAF(k) __builtin_bit_cast(bf16x8,pw##k)
  #define VFR(i) (bf16x8){vlo[i][0],vlo[i][1],vlo[i][2],vlo[i][3],vhi[i][0],vhi[i][1],vhi[i][2],vhi[i][3]}
  #define PIN(x) asm volatile("":"+v"(x))
  #define MX3(a,b,c) __builtin_fmaxf(__builtin_fmaxf((a),(b)),(c))
  #define GAPA(MF,A0,A1,A2,A3,W0,W1,PW) do{ MF; sacc+=A0; sacc+=A1; sacc+=A2; sacc+=A3; PIN(sacc); W0; W1; PIN(PW); SBAR(); }while(0)
  #define EX(v) __builtin_amdgcn_exp2f(v)
  #define GAPB(MF,X,B) do{ MF; X[B]=EX(X[B]); X[B+1]=EX(X[B+1]); X[B+2]=EX(X[B+2]); X[B+3]=EX(X[B+3]); PIN(X); SBAR(); }while(0)
  #define VRD(i) do{ vlo[i]=vtr(vp_+(((i)>>2)*4096+((i)&3)*1024)); vhi[i]=vtr(vp_+(((i)>>2)*4096+((i)&3)*1024+512)); }while(0)
  #define KRD(G,j) do{ if(G){ kload2(kf,kp0+sl_next,j); SBAR(); } }while(0)
  #define STEP(C0,C1,P0,P1,t,GK,GV,GL) do{ SBAR(); \
    const lds_cptr vp_=vp0+sl_prev; \
    VRD(0); SBAR(); float sacc=(P0[0]+P0[1]); \
    GAPA(C0=__builtin_amdgcn_mfma_f32_32x32x16_bf16(kf[0],qr[0],negm,0,0,0), P0[2],P0[3],P0[4],P0[5],     pw0[0]=PKW(P0,0), pw0[1]=PKW(P0,2), pw0); \
    VRD(4); SBAR(); GAPA(C1=__builtin_amdgcn_mfma_f32_32x32x16_bf16(kf[1],qr[0],negm,0,0,0), P0[6],P0[7],P0[8],P0[9],     pw0[2]=PKW(P0,4), pw0[3]=PKW(P0,6), pw0); \
    VRD(1); SBAR(); GAPA(C0=__builtin_amdgcn_mfma_f32_32x32x16_bf16(kf[2],qr[1],C0,0,0,0),   P0[10],P0[11],P0[12],P0[13], pw1[0]=PKW(P0,8), pw1[1]=PKW(P0,10), pw1); \
    VRD(5); SBAR(); GAPA(C1=__builtin_amdgcn_mfma_f32_32x32x16_bf16(kf[3],qr[1],C1,0,0,0),   P0[14],P0[15],P1[0],P1[1],   pw1[2]=PKW(P0,12),pw1[3]=PKW(P0,14), pw1); \
    VRD(2); SBAR(); GAPA(C0=__builtin_amdgcn_mfma_f32_32x32x16_bf16(kf[4],qr[2],C0,0,0,0),   P1[2],P1[3],P1[4],P1[5],     pw2[0]=PKW(P1,0), pw2[1]=PKW(P1,2), pw2); \
    VRD(6); SBAR(); GAPA(C1=__builtin_amdgcn_mfma_f32_32x32x16_bf16(kf[5],qr[2],C1,0,0,0),   P1[6],P1[7],P1[8],P1[9],     pw2[2]=PKW(P1,4), pw2[3]=PKW(P1,6), pw2); \
    VRD(3); SBAR(); GAPA(C0=__builtin_amdgcn_mfma_f32_32x32x16_bf16(kf[6],qr[3],C0,0,0,0),   P1[10],P1[11],P1[12],P1[13], pw3[0]=PKW(P1,8), pw3[1]=PKW(P1,10), pw3); \
    VRD(7); SBAR(); GAPA(C1=__builtin_amdgcn_mfma_f32_32x32x16_bf16(kf[7],qr[3],C1,0,0,0),   P1[14],P1[15],0.f,0.f,       pw3[2]=PKW(P1,12),pw3[3]=PKW(P1,14), pw3); \
    l_reg+=sacc; \
    if(GK){DMA_K((t)+3,sl_cur);} if(GV){DMA_V((t)+1,sl_next);} \
    CMASK(C0,C1,t); \
    { float a=MX3(C0[0],C0[1],C1[0]),b=MX3(C0[2],C0[3],C1[1]); a=MX3(a,C1[2],C1[3]); \
      _Pragma("unroll") for(int r=4;r<16;r+=4){a=MX3(a,C0[r],C0[r+1]);b=MX3(b,C0[r+2],C0[r+3]);a=MX3(a,C1[r],C1[r+1]);b=MX3(b,C1[r+2],C1[r+3]);} \
      float rm=__builtin_fmaxf(a,b); { auto rr=__builtin_amdgcn_permlane32_swap(__float_as_uint(rm),__float_as_uint(rm),false,false); rm=__builtin_fmaxf(__uint_as_float(rr[0]),__uint_as_float(rr[1])); } \
      resc=false; \
      if(__builtin_expect(__any(rm>(float)THRL),0)){ const float dl=__builtin_fmaxf(rm,0.f); mhat+=dl; \
        _Pragma("unroll") for(int r=0;r<16;++r){C0[r]-=dl;C1[r]-=dl;} \
        _Pragma("unroll") for(int r=0;r<16;++r)negm[r]=-mhat; asm volatile("":"+v"(negm)); \
        const float f=__builtin_amdgcn_exp2f(-dl); l_reg*=f; if(hi==0)wsf[r32]=f; resc=true; } } \
    SBAR(); \
    GAPB(o[0]=__builtin_amdgcn_mfma_f32_32x32x16_bf16(PAF(0),VFR(0),o[0],0,0,0), C0,0); \
    GAPB(o[1]=__builtin_amdgcn_mfma_f32_32x32x16_bf16(PAF(0),VFR(4),o[1],0,0,0), C0,4); \
    KRD(GL,0); GAPB(o[0]=__builtin_amdgcn_mfma_f32_32x32x16_bf16(PAF(1),VFR(1),o[0],0,0,0), C0,8); \
    KRD(GL,1); GAPB(o[1]=__builtin_amdgcn_mfma_f32_32x32x16_bf16(PAF(1),VFR(5),o[1],0,0,0), C0,12); \
    KRD(GL,2); GAPB(o[0]=__builtin_amdgcn_mfma_f32_32x32x16_bf16(PAF(2),VFR(2),o[0],0,0,0), C1,0); \
    KRD(GL,3); GAPB(o[1]=__builtin_amdgcn_mfma_f32_32x32x16_bf16(PAF(2),VFR(6),o[1],0,0,0), C1,4); \
    GAPB(o[0]=__builtin_amdgcn_mfma_f32_32x32x16_bf16(PAF(3),VFR(3),o[0],0,0,0), C1,8); \
    GAPB(o[1]=__builtin_amdgcn_mfma_f32_32x32x16_bf16(PAF(3),VFR(7),o[1],0,0,0), C1,12); \
    }while(0)
  int t=1;
  for(;t+5<NT;t+=2){
    STEP(pB0,pB1,pA0,pA1,t,true,true,true);     WAIT_BAR(2); RESC(); ROT();
    STEP(pA0,pA1,pB0,pB1,t+1,true,true,true);   WAIT_BAR(2); RESC(); ROT();
  }
  #define ENDW(tt) do{ if((tt)+3<NT){WAIT_BAR(2);} else if((tt)+2<NT){WAIT_BAR(1);} else {WAIT_BAR(0);} }while(0)
  for(;t+1<NT;t+=2){
    STEP(pB0,pB1,pA0,pA1,t,(t+3<NT),(t+1<NT),(t+1<NT));       ENDW(t);   RESC(); ROT();
    STEP(pA0,pA1,pB0,pB1,t+1,(t+4<NT),(t+2<NT),(t+2<NT));     ENDW(t+1); RESC(); ROT();
  }
  STEP(pB0,pB1,pA0,pA1,NT-1,false,false,false); RESC();
  { float sacc=pB0[0]+pB0[1]; _Pragma("unroll") for(int r=2;r<16;++r)sacc+=pB0[r]; _Pragma("unroll") for(int r=0;r<16;++r)sacc+=pB1[r]; l_reg+=sacc;
    pw0=(u32x4){PKW(pB0,0),PKW(pB0,2),PKW(pB0,4),PKW(pB0,6)};pw1=(u32x4){PKW(pB0,8),PKW(pB0,10),PKW(pB0,12),PKW(pB0,14)};pw2=(u32x4){PKW(pB1,0),PKW(pB1,2),PKW(pB1,4),PKW(pB1,6)};pw3=(u32x4){PKW(pB1,8),PKW(pB1,10),PKW(pB1,12),PKW(pB1,14)};
    SBAR(); pv(o,vb0+sl_cur,PAF(0),PAF(1),PAF(2),PAF(3)); }
  #undef PKW
  #undef PAF
  #undef VFR
  #undef PIN
  #undef MX3
  #undef GAPA
  #undef GAPB
  #undef EX
  #undef VRD
  #undef KRD
  #undef STEP
  #undef ENDW
  {auto rr=__builtin_amdgcn_permlane32_swap(__float_as_uint(l_reg),__float_as_uint(l_reg),false,false);l_reg=__uint_as_float(rr[0])+__uint_as_float(rr[1]);}
  if(hi==0)wsf[32+r32]=l_reg;asm volatile("s_waitcnt lgkmcnt(0)":::"memory");
  float rli[16];
  #pragma unroll
  for(int r=0;r<16;++r)rli[r]=__builtin_amdgcn_rcpf(wsf[32+crow(r,hi)]);
  bf16*Ow=O+(rowbase+q0+wid*QBLK)*OP+h*D;
  { bf16*stg=(bf16*)(shm+LDS_OST)+wid*2048;
    #pragma unroll
    for(int r=0;r<16;++r){const int orow=crow(r,hi);
      #pragma unroll
      for(int d0=0;d0<2;++d0)stg[orow*64+d0*32+r32]=(bf16)f2bf(o[d0][r]*rli[r]);}
    asm volatile("s_waitcnt lgkmcnt(0)":::"memory");
    #pragma unroll
    for(int i=0;i<4;++i){const int row=i*8+(lane>>3),ch=lane&7; const u32x4 v=*(const u32x4*)(stg+row*64+ch*8); ATTN_STORE16(Ow+(long)row*OP+ch*8,v);} }
  asm volatile("s_waitcnt lgkmcnt(0)\n\ts_barrier":::"memory");
  #undef DMA_K
  #undef DMA_V
  #undef CMASK
  #undef START
  #undef RESC
  #undef ROT
}
constexpr int ATTN_LDS_BYTES=LDS_BYTES;
struct AttnTensors { const bf16* Q; const bf16* K; const bf16* V; bf16* O; };
template<int THRL=8> __device__ __forceinline__ void attn_phase(char*lds,const AttnTensors&T){
  const int G=gridDim.x, bx=blockIdx.x, v=(G%8==0)?(bx%8)*(G/8)+bx/8:bx;
  for(int u=v;u<16*12*8;u+=G){
    const int pair=(u%256)/4, j=((u%256)%4)*6+u/256;
    const int b=pair>>2, kh=pair&3, g=j>>3, qb=j&7;
    attn_unit<THRL>(b,kh*3+g,qb,T.Q,T.K,T.V,T.O,lds);
  }
}
#undef SBAR
#undef WAIT_BAR
}

__device__ __forceinline__ void pool_item(const Params& p, LAS unsigned char* lds, int item) {
    const int tid = TIDX;
    const int gi = item & 3, tile = item >> 2, t0 = tile * 32, b = t0 / SEQ, tl0 = t0 % SEQ, half = 1 << gi;
    const bf16_t* Ub = (const bf16_t*)(p.ws + OFF_U);
    bf16_t* AO = (bf16_t*)(p.ws + OFF_AO);
    LAS float* us = (LAS float*)lds;
    LAS float* dl = (LAS float*)(lds + 48 * 64 * 4);
    __syncthreads();
    for (int i = tid; i < 48 * 64; i += 256) {
        const int r = i >> 6, c = i & 63, tl = tl0 - 8 + r;
        us[i] = (tl >= 0 && tl < SEQ) ? bf2f(Ub[(size_t)(b * SEQ + tl) * 256 + gi * 64 + c]) : 0.f;
    }
    __syncthreads();
    {
        const int c = tid & 63, tg = tid >> 6;
#pragma unroll
        for (int k = 0; k < 8; ++k) {
            const int tk = tg * 8 + k, tl = tl0 + tk;
            const int lo = max(tl - half, 0), hi = min(tl + half, SEQ);
            float s = 0.f;
            for (int r = lo; r < hi; ++r) s += us[(r - tl0 + 8) * 64 + c];
            dl[tk * 64 + c] = s / (float)(hi - lo) - us[(tk + 8) * 64 + c];
        }
    }
    __syncthreads();
    {
        const int dd = tid & 63, tg = tid >> 6;
        float acc[8];
#pragma unroll
        for (int k = 0; k < 8; ++k) acc[k] = 0.f;
        const float* w = p.pool_w + gi * 4096 + dd;
        for (int c = 0; c < 64; ++c) {
            const float wv = w[c * 64];
#pragma unroll
            for (int k = 0; k < 8; ++k) acc[k] += dl[(tg * 8 + k) * 64 + c] * wv;
        }
        const float ps = p.pool_scale[gi * 64 + dd];
#pragma unroll
        for (int k = 0; k < 8; ++k) AO[(size_t)(t0 + tg * 8 + k) * D + gi * 64 + dd] = (bf16_t)f2bf(acc[k] * ps);
    }
}

__device__ __forceinline__ void phase_attn_pool(const Params& p, LAS unsigned char* lds, char* smem) {
    const attn_body::AttnTensors AT{(const bf16_t*)(p.ws + OFF_Q), (const bf16_t*)(p.ws + OFF_K), (const bf16_t*)(p.ws + OFF_V), (bf16_t*)(p.ws + OFF_AO) + 256};
    attn_body::attn_phase<8>(smem, AT);
    __syncthreads();
    constexpr int N_POOL = (T / 32) * 4;
    for (int it = VBLK; it < N_POOL; it += NVBLK) pool_item(p, lds, it);
}

struct EpiOut {
    static constexpr bool PERM = false;
    const float* x; float* y; const float* mod; float* stats;
    __device__ __forceinline__ void operator()(const f32x4 (&acc)[2][2][4][2], const pg8::Unit& u, int wr, int wc, int fr, int fq) const {
        const float* g1 = mod + (size_t)(u.pm >> 3) * MODW + 2 * D;
        const int col0 = u.pn * 256 + wc * 32 + fq * 4;
        f32x4 gv[2][2];
#pragma unroll
        for (int bj = 0; bj < 2; ++bj)
#pragma unroll
            for (int n = 0; n < 2; ++n) gv[bj][n] = *(const f32x4*)(g1 + col0 + bj * 128 + n * 16);
#pragma unroll
        for (int ai = 0; ai < 2; ++ai)
#pragma unroll
            for (int m = 0; m < 4; ++m) {
                const int row = u.pm * 256 + ai * 128 + wr * 64 + m * 16 + fr;
                float s1 = 0.f, s2 = 0.f;
#pragma unroll
                for (int bj = 0; bj < 2; ++bj)
#pragma unroll
                    for (int n = 0; n < 2; ++n) {
                        const size_t off = (size_t)row * D + col0 + bj * 128 + n * 16;
                        const f32x4 xv = *(const f32x4*)(x + off);
                        const f32x4 yv = xv * ALPHA + gv[bj][n] * acc[ai][bj][m][n];
                        *(f32x4*)(y + off) = yv;
                        s1 += (yv[0] + yv[1]) + (yv[2] + yv[3]);
                        s2 += (yv[0] * yv[0] + yv[1] * yv[1]) + (yv[2] * yv[2] + yv[3] * yv[3]);
                    }
                s1 += __shfl_xor(s1, 16); s1 += __shfl_xor(s1, 32);
                s2 += __shfl_xor(s2, 16); s2 += __shfl_xor(s2, 32);
                if (fq == 0) { float* st = stats + ((size_t)row * 16 + u.pn * 4 + wc) * 2; st[0] = s1; st[1] = s2; }
            }
    }
};
__device__ __forceinline__ void phase_outproj(const Params& p, LAS unsigned char* lds) {
    pg8::Gemm g{(const bf16_t*)(p.ws + OFF_AO), (const bf16_t*)(p.ws + OFF_WTOUT)};
    pg8::DenseSched S{4, 512, 512, 0, 1, (int)gridDim.x, vcu_of_block()};
    EpiOut E{p.x, p.out, (const float*)(p.ws + OFF_MOD), (float*)(p.ws + OFF_STATS)};
    pg8::gemm_phase<D, EpiOut, pg8::DenseSched, false>(lds, g, S, E);
}

__device__ __forceinline__ void phase_router(const Params& p, LAS unsigned char* lds0) {
    const int tid = hw_tid(), lane = tid & 63, wid = tid >> 6, r16 = lane & 15, q = lane >> 4;
    const float* mod = (const float*)(p.ws + OFF_MOD);
    const float* stats = (const float*)(p.ws + OFF_STATS);
    bf16_t* H = (bf16_t*)(p.ws + OFF_H);
    const bf16_t* WRH = (const bf16_t*)(p.ws + OFF_WRH); const bf16_t* WRL = (const bf16_t*)(p.ws + OFF_WRL);
    int* gcnt = (int*)(p.ws + OFF_CNT);
    int* LDST = (int*)(p.ws + OFF_LDST);
    float* LWt = (float*)(p.ws + OFF_LW);
    LAS float* vec = (LAS float*)lds0;
    LAS float* lg = (LAS float*)(lds0 + 16384) + wid * 16 * 64;
    LAS int* lcnt = (LAS int*)(lds0 + 49152);
    LAS int* lbase = (LAS int*)(lds0 + 49152 + 256);
    LAS int* sel_ep = (LAS int*)(lds0 + 49152 + 512);
    LAS float* sel_w = (LAS float*)(lds0 + 49152 + 512 + 4096);
    for (int item = blockIdx.x; item < T / 128; item += gridDim.x) {
        const int t0 = item * 128, b = t0 / SEQ, tw0 = t0 + wid * 16;
        __syncthreads();
        if (tid < 64) lcnt[tid] = 0;
        for (int i = tid; i < 1024; i += 512) {
            vec[i] = p.ln1_g[i]; vec[1024 + i] = p.ln1_b[i];
            vec[2048 + i] = 1.f + mod[(size_t)b * MODW + 4 * D + i]; vec[3072 + i] = mod[(size_t)b * MODW + 3 * D + i];
        }
        float meanv = 0.f, rstdv = 0.f;
        if (lane < 16) {
            float s1 = 0.f, s2 = 0.f;
            const float* st = stats + (size_t)(tw0 + lane) * 32;
#pragma unroll
            for (int i = 0; i < 16; ++i) { s1 += st[2 * i]; s2 += st[2 * i + 1]; }
            meanv = s1 * (1.f / D);
            const float var = fmaxf(s2 * (1.f / D) - meanv * meanv, 0.f);
            rstdv = 1.0f / sqrtf(var + 1e-5f);
        }
        const float mu = __shfl(meanv, r16), rs = __shfl(rstdv, r16);
        __syncthreads();
        f32x4 acc[4];
#pragma unroll
        for (int nb = 0; nb < 4; ++nb) acc[nb] = (f32x4){0.f, 0.f, 0.f, 0.f};
        float* yrow = p.out + (size_t)(tw0 + r16) * D + q * 8;
        bf16_t* hrow = H + (size_t)(tw0 + r16) * D + q * 8;
        LAS unsigned char* wb = lds0 + 57856;
        f32x4 vn[4][2];
#pragma unroll
        for (int u = 0; u < 4; ++u) { vn[u][0] = *(const f32x4*)(yrow + u * 32); vn[u][1] = *(const f32x4*)(yrow + u * 32 + 4); }
        for (int ch = 0; ch < 4; ++ch) {
            __syncthreads();
#pragma unroll
            for (int i = 0; i < 8; ++i) {
                const int idx = tid + i * 512, part = idx >> 11, row = (idx >> 5) & 63, c16 = idx & 31;
                const u32x4 w = *(const u32x4*)((part ? WRL : WRH) + (size_t)row * D + ch * 256 + c16 * 8);
                *(LAS u32x4*)(wb + part * 33792 + row * 528 + c16 * 16) = w;
            }
            __syncthreads();
#pragma unroll
            for (int s4 = ch * 8; s4 < ch * 8 + 8; s4 += 4) {
                f32x4 vv[4][2];
#pragma unroll
                for (int u = 0; u < 4; ++u) { vv[u][0] = vn[u][0]; vv[u][1] = vn[u][1]; }
                if (s4 + 4 < 32) {
#pragma unroll
                    for (int u = 0; u < 4; ++u) { vn[u][0] = *(const f32x4*)(yrow + (s4 + 4 + u) * 32); vn[u][1] = *(const f32x4*)(yrow + (s4 + 4 + u) * 32 + 4); }
                }
#pragma unroll
                for (int u = 0; u < 4; ++u) {
                    const int s = s4 + u, k0 = s * 32 + q * 8;
                    float hv[8];
#pragma unroll
                    for (int hh = 0; hh < 2; ++hh) {
                        const f32x4 g = *(const LAS f32x4*)(vec + k0 + 4 * hh), bb = *(const LAS f32x4*)(vec + 1024 + k0 + 4 * hh);
                        const f32x4 sc = *(const LAS f32x4*)(vec + 2048 + k0 + 4 * hh), sh = *(const LAS f32x4*)(vec + 3072 + k0 + 4 * hh);
                        const f32x4 xm = (vv[u][hh] - mu) * rs * g + bb;
                        *(f32x4*)(yrow + s * 32 + 4 * hh) = xm;
                        const f32x4 h4 = xm * sc + sh;
                        hv[4 * hh + 0] = h4[0]; hv[4 * hh + 1] = h4[1]; hv[4 * hh + 2] = h4[2]; hv[4 * hh + 3] = h4[3];
                    }
                    unsigned wh[4], wl[4];
#pragma unroll
                    for (int i = 0; i < 4; ++i) {
                        const unsigned ha = f2bf(hv[2 * i]), hb = f2bf(hv[2 * i + 1]);
                        wh[i] = ha | (hb << 16);
                        wl[i] = pk2(hv[2 * i] - bf2f(ha), hv[2 * i + 1] - bf2f(hb));
                    }
                    *(u32x4*)(hrow + s * 32) = (u32x4){wh[0], wh[1], wh[2], wh[3]};
                    const bf16x8 ah = __builtin_bit_cast(bf16x8, (u32x4){wh[0], wh[1], wh[2], wh[3]}), al = __builtin_bit_cast(bf16x8, (u32x4){wl[0], wl[1], wl[2], wl[3]});
                    const int kb = ((s & 7) * 32 + q * 8) * 2;
#pragma unroll
                    for (int nb = 0; nb < 4; ++nb) {
                        const bf16x8 bh = *(const LAS bf16x8*)(wb + (nb * 16 + r16) * 528 + kb), bl = *(const LAS bf16x8*)(wb + 33792 + (nb * 16 + r16) * 528 + kb);
                        acc[nb] = __builtin_amdgcn_mfma_f32_16x16x32_bf16(ah, bh, acc[nb], 0, 0, 0);
                        acc[nb] = __builtin_amdgcn_mfma_f32_16x16x32_bf16(al, bh, acc[nb], 0, 0, 0);
                        acc[nb] = __builtin_amdgcn_mfma_f32_16x16x32_bf16(ah, bl, acc[nb], 0, 0, 0);
                    }
                }
            }
        }
#pragma unroll
        for (int nb = 0; nb < 4; ++nb)
#pragma unroll
            for (int j = 0; j < 4; ++j) lg[(4 * q + j) * 64 + nb * 16 + r16] = acc[nb][j];
        __syncthreads();
        const float bias = p.router_bias[lane];
        for (int r = 0; r < 16; ++r) {
            const float lgv = lg[r * 64 + lane];
            const float sg = 1.0f / (1.0f + expf(-lgv));
            const float sel = sg + bias;
            float m1 = fmaxf(sel, __shfl_xor(sel, 1)); m1 = fmaxf(m1, __shfl_xor(m1, 2)); m1 = fmaxf(m1, __shfl_xor(m1, 4));
            int cand = (sel == m1) ? lane : 64;
            cand = min(cand, __shfl_xor(cand, 1)); cand = min(cand, __shfl_xor(cand, 2)); cand = min(cand, __shfl_xor(cand, 4));
            const float sel2 = (lane == cand) ? -INFINITY : sel;
            float m2 = fmaxf(sel2, __shfl_xor(sel2, 1)); m2 = fmaxf(m2, __shfl_xor(m2, 2)); m2 = fmaxf(m2, __shfl_xor(m2, 4));
            const float gs = m1 + m2;
            const int g = lane >> 3;
            int cntg = 0;
#pragma unroll
            for (int gg = 0; gg < 8; ++gg) { const float v = __shfl(gs, gg * 8); cntg += (v > gs || (v == gs && gg < g)) ? 1 : 0; }
            const bool keep = cntg < 4;
            const float msel = keep ? sel : -INFINITY;
            lg[r * 64 + lane] = msel;
            int cnt = 0;
#pragma unroll 4
            for (int q4 = 0; q4 < 16; ++q4) {
                const f32x4 v = *(const LAS f32x4*)(lg + r * 64 + q4 * 4);
#pragma unroll
                for (int i = 0; i < 4; ++i) cnt += (v[i] > msel || (v[i] == msel && (q4 * 4 + i) < lane)) ? 1 : 0;
            }
            const bool chosen = keep && cnt < 8;
            float wsum = chosen ? sg : 0.f;
#pragma unroll
            for (int o = 1; o < 64; o <<= 1) wsum += __shfl_xor(wsum, o);
            if (chosen) {
                const int pos = atomicAdd((int*)&lcnt[lane], 1);
                sel_ep[(wid * 16 + r) * 8 + cnt] = lane | (pos << 8);
                sel_w[(wid * 16 + r) * 8 + cnt] = sg / wsum * 2.5f;
            }
        }
        __syncthreads();
        if (tid < 64) { int tt = tid; asm volatile("" : "+v"(tt)); lbase[tt] = atomicAdd(&gcnt[tt], lcnt[tt]); }
        __syncthreads();
        for (int idx = tid; idx < 1024; idx += 512) {
            const int ep = sel_ep[idx], e = ep & 0xff, pos = ep >> 8, gi = lbase[e] + pos;
            LDST[(size_t)e * T + gi] = (t0 + (idx >> 3)) * NSLOT + (idx & 7);
            LWt[(size_t)e * T + gi] = sel_w[idx];
        }
    }
}

constexpr int LDS_ROWTAB = LDS_TAB, LDS_AUX = LDS_TAB + 12288, MOE_MAX_UNITS = 20, LDS_UTAB = LDS_CTL + 256, LDS_TSTART = LDS_UTAB + MOE_MAX_UNITS * 32;
__device__ __forceinline__ int moe_setup(const Params& p, LAS unsigned char* lds0, int nN, int bmul, int badd) {
    LAS int* tstart = (LAS int*)(lds0 + LDS_TSTART); LAS int* utab = (LAS int*)(lds0 + LDS_UTAB);
    const int* gcnt = (const int*)(p.ws + OFF_CNT);
    __syncthreads();
    if (hw_tid() == 0) {
        int a = 0;
        for (int e = 0; e < NEX; ++e) { const int c = e < NE ? gcnt[e] : T; tstart[e] = a; a += (c + 255) >> 8; }
        tstart[NEX] = a;
    }
    __syncthreads();
    const int total = tstart[NEX] * nN, G = gridDim.x, c = blockIdx.x;
    if (hw_tid() < MOE_MAX_UNITS) {
        const int i = hw_tid(), L = i * G + c;
        int pm = 0, pn = 0, e = 0, i0 = 0, cnt = 0;
        if (L < total) {
            const int mt = L / nN, pl = L % nN;
            for (int j = 1; j < NEX; ++j) e += (mt >= tstart[j]) ? 1 : 0;
            pm = mt; pn = e * bmul + badd + pl; i0 = (mt - tstart[e]) * 256; cnt = e < NE ? gcnt[e] : T;
        }
        utab[i * 8 + 0] = pm; utab[i * 8 + 1] = pn; utab[i * 8 + 2] = e; utab[i * 8 + 3] = i0; utab[i * 8 + 4] = cnt;
    }
    __syncthreads();
    const int n = (total - c + G - 1) / G;
    return n < 0 ? 0 : (n > MOE_MAX_UNITS ? MOE_MAX_UNITS : n);
}
struct MoeSched {
    LAS const int* utab; LAS const unsigned* rowtab; int n;
    __device__ __forceinline__ bool next(int i, pg8::Unit& u) const {
        if (i >= n) return false;
        u.pm = __builtin_amdgcn_readfirstlane(utab[i * 8 + 0]); u.pn = __builtin_amdgcn_readfirstlane(utab[i * 8 + 1]); u.e = __builtin_amdgcn_readfirstlane(utab[i * 8 + 2]); u.idx = i; return true;
    }
    __device__ __forceinline__ unsigned row_off(int i, int r) const { return rowtab[i * 256 + r]; }
    __device__ __forceinline__ void a_ready(const pg8::Unit&) const {}
    __device__ __forceinline__ void done(const pg8::Unit&) const {}
};
struct EpiGU {
    static constexpr bool PERM = true;
    LAS const float* auxw; unsigned char* ws;
    __device__ __forceinline__ void operator()(const f32x4 (&acc)[2][2][4][2], const pg8::Unit& u, int wr, int wc, int fr, int fq) const {
        const int pl = u.pn & 1;
        bf16_t* ACT = (bf16_t*)(ws + OFF_ACT) + (size_t)u.pm * 256 * FF + pl * 128 + wc * 32 + 8 * fq;
#pragma unroll
        for (int ai = 0; ai < 2; ++ai)
#pragma unroll
            for (int m = 0; m < 4; ++m) {
                const int rl = ai * 128 + wr * 64 + m * 16 + fr;
                const float wrow = auxw[u.idx * 256 + rl];
                float a[8];
#pragma unroll
                for (int n = 0; n < 2; ++n)
#pragma unroll
                    for (int q = 0; q < 4; ++q) { const float g = acc[ai][0][m][n][q], uu = acc[ai][1][m][n][q]; a[n * 4 + q] = g / (1.f + __expf(-g)) * uu * wrow; }
                u32x4 w; w.x = pk2(a[0], a[1]); w.y = pk2(a[2], a[3]); w.z = pk2(a[4], a[5]); w.w = pk2(a[6], a[7]);
                *(u32x4*)(ACT + (size_t)rl * FF) = w;
            }
    }
};
__device__ __forceinline__ void phase_gateup(const Params& p, LAS unsigned char* lds0) {
    int n = moe_setup(p, lds0, 2, 2, 0); n = n > 12 ? 12 : n;
    LAS const int* utab = (LAS const int*)(lds0 + LDS_UTAB);
    LAS unsigned* rowtab = (LAS unsigned*)(lds0 + LDS_ROWTAB);
    LAS float* auxw = (LAS float*)(lds0 + LDS_AUX);
    const int* LDST = (const int*)(p.ws + OFF_LDST);
    const float* LWt = (const float*)(p.ws + OFF_LW);
    for (int i = 0; i < n; ++i) {
        const int e = utab[i * 8 + 2], i0 = utab[i * 8 + 3], cnt = utab[i * 8 + 4];
        if (hw_tid() < 256) {
            const int li = i0 + hw_tid(); int tok = 0; float w = 0.f;
            if (li < cnt) { if (e < NE) { tok = LDST[(size_t)e * T + li] / NSLOT; w = LWt[(size_t)e * T + li]; } else { tok = li; w = 1.f; } }
            rowtab[i * 256 + hw_tid()] = (unsigned)tok * (unsigned)(D * 2);
            auxw[i * 256 + hw_tid()] = w;
        }
    }
    __syncthreads();
    MoeSched S{utab, rowtab, n};
    pg8::Gemm g{(const bf16_t*)(p.ws + OFF_H), (const bf16_t*)(p.ws + OFF_WGU)};
    EpiGU E{auxw, p.ws};
    pg8::gemm_phase<D, EpiGU, MoeSched, true>(lds0, g, S, E);
}
constexpr float FP8S = 32.f, FP8I = 1.f / 32.f;
__device__ __forceinline__ unsigned pk4_fp8(float a, float b, float c, float d) {
    a = __builtin_amdgcn_fmed3f(a * FP8S, -440.f, 440.f); b = __builtin_amdgcn_fmed3f(b * FP8S, -440.f, 440.f);
    c = __builtin_amdgcn_fmed3f(c * FP8S, -440.f, 440.f); d = __builtin_amdgcn_fmed3f(d * FP8S, -440.f, 440.f);
    int w = __builtin_amdgcn_cvt_pk_fp8_f32(a, b, 0, false);
    w = __builtin_amdgcn_cvt_pk_fp8_f32(c, d, w, true);
    return (unsigned)w;
}
struct EpiDown {
    static constexpr bool PERM = true;
    LAS const int* auxd; unsigned char* ws;
    __device__ __forceinline__ void operator()(const f32x4 (&acc)[2][2][4][2], const pg8::Unit& u, int wr, int wc, int fr, int fq) const {
        const int pl = u.pn & 3;
        unsigned char* SL = ws + OFF_SLOTS + pl * 256 + wc * 64 + 16 * fq;
#pragma unroll
        for (int ai = 0; ai < 2; ++ai)
#pragma unroll
            for (int m = 0; m < 4; ++m) {
                const int d = auxd[u.idx * 256 + ai * 128 + wr * 64 + m * 16 + fr];
                u32x4 w;
                w.x = pk4_fp8(acc[ai][0][m][0][0], acc[ai][0][m][0][1], acc[ai][0][m][0][2], acc[ai][0][m][0][3]);
                w.y = pk4_fp8(acc[ai][0][m][1][0], acc[ai][0][m][1][1], acc[ai][0][m][1][2], acc[ai][0][m][1][3]);
                w.z = pk4_fp8(acc[ai][1][m][0][0], acc[ai][1][m][0][1], acc[ai][1][m][0][2], acc[ai][1][m][0][3]);
                w.w = pk4_fp8(acc[ai][1][m][1][0], acc[ai][1][m][1][1], acc[ai][1][m][1][2], acc[ai][1][m][1][3]);
                *(u32x4*)(SL + (size_t)d * 1024) = w;
            }
    }
};
__device__ __forceinline__ void phase_down(const Params& p, LAS unsigned char* lds0) {
    const int n = moe_setup(p, lds0, 4, 4, 0);
    LAS const int* utab = (LAS const int*)(lds0 + LDS_UTAB);
    LAS int* auxd = (LAS int*)(lds0 + LDS_TAB);
    const int* LDST = (const int*)(p.ws + OFF_LDST);
    for (int i = 0; i < n; ++i) {
        const int e = utab[i * 8 + 2], i0 = utab[i * 8 + 3], cnt = utab[i * 8 + 4];
        if (hw_tid() < 256) {
            const int li = i0 + hw_tid();
            auxd[i * 256 + hw_tid()] = li < cnt ? (e < NE ? LDST[(size_t)e * T + li] : li * NSLOT + 8) : T * NSLOT;
        }
    }
    __syncthreads();
    MoeSched S{utab, (LAS const unsigned*)(lds0 + LDS_ROWTAB), n};
    pg8::Gemm g{(const bf16_t*)(p.ws + OFF_ACT), (const bf16_t*)(p.ws + OFF_WD)};
    EpiDown E{auxd, p.ws};
    pg8::gemm_phase<FF, EpiDown, MoeSched, false>(lds0, g, S, E);
}

__device__ __forceinline__ void slot_sum16(const unsigned char* SL, int t, int cb, float (&s)[16]) {
#pragma unroll
    for (int i = 0; i < 16; ++i) s[i] = 0.f;
    u32x4 v[NSLOT];
#pragma unroll
    for (int k = 0; k < NSLOT; ++k) v[k] = *(const u32x4*)(SL + (size_t)(t * NSLOT + k) * 1024 + cb);
#pragma unroll
    for (int k = 0; k < NSLOT; ++k)
#pragma unroll
        for (int i = 0; i < 4; ++i) {
            typedef float f32x2 __attribute__((ext_vector_type(2)));
            const f32x2 lo = __builtin_amdgcn_cvt_pk_f32_fp8((int)v[k][i], false), hi = __builtin_amdgcn_cvt_pk_f32_fp8((int)v[k][i], true);
            s[4 * i] += lo.x; s[4 * i + 1] += lo.y; s[4 * i + 2] += hi.x; s[4 * i + 3] += hi.y;
        }
#pragma unroll
    for (int i = 0; i < 16; ++i) s[i] *= FP8I;
}
__device__ __forceinline__ int slot_col(int bb) { return (bb >> 4) * 256 + ((bb >> 2) & 3) * 32 + (bb & 3) * 8; }
__device__ __forceinline__ void phase_final(const Params& p) {
    const int lane = hw_tid() & 63, gw = blockIdx.x * 8 + (hw_tid() >> 6), ngw = gridDim.x * 8;
    const float* mod = (const float*)(p.ws + OFF_MOD);
    const unsigned char* SL = p.ws + OFF_SLOTS;
    const int c0 = slot_col(lane);
    for (int row = gw; row < T; row += ngw) {
        const float* g2 = mod + (size_t)(row / SEQ) * MODW + 5 * D;
        float f[16];
        slot_sum16(SL, row, lane * 16, f);
        f32x4 y[4]; float s = 0.f;
#pragma unroll
        for (int j = 0; j < 4; ++j) {
            const int cj = c0 + (j >> 1) * 128 + (j & 1) * 4;
            const f32x4 xm = *(const f32x4*)(p.out + (size_t)row * D + cj), gg = *(const f32x4*)(g2 + cj);
            y[j][0] = ALPHA * xm[0] + gg[0] * f[4 * j]; y[j][1] = ALPHA * xm[1] + gg[1] * f[4 * j + 1];
            y[j][2] = ALPHA * xm[2] + gg[2] * f[4 * j + 2]; y[j][3] = ALPHA * xm[3] + gg[3] * f[4 * j + 3];
            s += (y[j][0] + y[j][1]) + (y[j][2] + y[j][3]);
        }
#pragma unroll
        for (int o = 1; o < 64; o <<= 1) s += __shfl_xor(s, o);
        const float mean = s * (1.f / D);
        float qv = 0.f;
#pragma unroll
        for (int j = 0; j < 4; ++j) { y[j] = y[j] - mean; qv += (y[j][0] * y[j][0] + y[j][1] * y[j][1]) + (y[j][2] * y[j][2] + y[j][3] * y[j][3]); }
#pragma unroll
        for (int o = 1; o < 64; o <<= 1) qv += __shfl_xor(qv, o);
        const float rstd = 1.0f / sqrtf(qv * (1.f / D) + 1e-5f);
#pragma unroll
        for (int j = 0; j < 4; ++j) {
            const int cj = c0 + (j >> 1) * 128 + (j & 1) * 4;
            const f32x4 g = *(const f32x4*)(p.ln2_g + cj), bb4 = *(const f32x4*)(p.ln2_b + cj);
            *(f32x4*)(p.out + (size_t)row * D + cj) = y[j] * rstd * g + bb4;
        }
    }
}

#define XB_TMO      128
#define XB_XCNT(j)  (256  + 64 * (j))
#define XB_XSUB(j)  (1280 + 64 * (j))
#define XB_XGEN(j)  (2304 + 64 * (j))
#define XB_TOP      3328
#define XB_TOPGEN   3392
#define XCD_BAR_WORDS 3456
#define XB_SPIN_CAP (1u << 18)
__device__ __forceinline__ unsigned xb_ld(unsigned* p)              { return __hip_atomic_load(p, __ATOMIC_RELAXED, __HIP_MEMORY_SCOPE_AGENT); }
__device__ __forceinline__ unsigned xb_add(unsigned* p, unsigned v) { return __hip_atomic_fetch_add(p, v, __ATOMIC_RELAXED, __HIP_MEMORY_SCOPE_AGENT); }
__device__ __forceinline__ unsigned xb_xcc_id() { return (unsigned)__builtin_amdgcn_s_getreg((3 << 11) | 20) & 0xFu; }
#define XB_SPIN(cond, bar) do { unsigned _sp = 0; while (cond) { __builtin_amdgcn_s_sleep(1); \
    if ((++_sp & 255u) == 0u) { if (xb_ld(&(bar)[XB_TMO])) break; if (_sp > XB_SPIN_CAP) { atomicAdd(&(bar)[XB_TMO], 1u); break; } } } } while (0)
struct XcdBarrier { unsigned* bar; unsigned x; volatile LAS unsigned* st; };
__device__ __forceinline__ XcdBarrier xcd_barrier_post(unsigned* bar, volatile LAS unsigned* st) {
    XcdBarrier b; b.bar = bar; b.x = xb_xcc_id(); b.st = st;
    if (hw_tid() == 0) (void)xb_add(&bar[XB_XCNT(b.x)], 1u);
    return b;
}
__device__ __forceinline__ void xcd_barrier_complete(unsigned* bar, unsigned x, unsigned& nloc, unsigned& nx) {
    const unsigned G = gridDim.x * gridDim.y * gridDim.z;
    unsigned sum, cnt, mine, sp = 0u;
    for (;;) {
        sum = 0u; cnt = 0u; mine = 0u;
#pragma unroll
        for (unsigned j = 0; j < 16; ++j) { const unsigned c = xb_ld(&bar[XB_XCNT(j)]); sum += c; cnt += (c > 0u) ? 1u : 0u; mine = (j == x) ? c : mine; }
        if (sum == G) break;
        __builtin_amdgcn_s_sleep(1);
        if ((++sp & 255u) == 0u) { if (xb_ld(&bar[XB_TMO])) break; if (sp > XB_SPIN_CAP) { atomicAdd(&bar[XB_TMO], 1u); break; } }
    }
    nloc = mine > 0u ? mine : 1u; nx = cnt > 0u ? cnt : 1u;
}
__device__ __forceinline__ void xcd_barrier(const XcdBarrier& b) {
    asm volatile("s_waitcnt vmcnt(0)" ::: "memory");
    __syncthreads();
    if (hw_tid() == 0) {
        unsigned* bar = b.bar;
        __builtin_amdgcn_s_waitcnt(0);
        unsigned nloc = b.st[0], nx = b.st[1];
        if (nloc == 0u) { xcd_barrier_complete(bar, b.x, nloc, nx); b.st[0] = nloc; b.st[1] = nx; }
        const unsigned old = xb_add(&bar[XB_XSUB(b.x)], 1u);
        const unsigned gen = old / nloc;
        if (old + 1u == (gen + 1u) * nloc) {
            __builtin_amdgcn_fence(__ATOMIC_RELEASE, "agent");
            asm volatile("s_waitcnt vmcnt(0)" ::: "memory");
            const unsigned og = xb_add(&bar[XB_TOP], 1u);
            const unsigned tg = og / nx;
            if (og + 1u == (tg + 1u) * nx) xb_add(&bar[XB_TOPGEN], 1u);
            else XB_SPIN(xb_ld(&bar[XB_TOPGEN]) == tg, bar);
            __builtin_amdgcn_fence(__ATOMIC_ACQUIRE, "agent");
            xb_add(&bar[XB_XGEN(b.x)], 1u);
            asm volatile("s_waitcnt vmcnt(0)" ::: "memory");
        } else {
            XB_SPIN(xb_ld(&bar[XB_XGEN(b.x)]) == gen, bar);
            __builtin_amdgcn_fence(__ATOMIC_ACQUIRE, "agent");
            asm volatile("s_waitcnt vmcnt(0)" ::: "memory");
        }
    }
    __syncthreads();
}

constexpr size_t OFF_BAR = 448 * 1024;

__global__ void __launch_bounds__(512, 2) mk_fwd(Params p) {
    extern __shared__ __attribute__((aligned(16))) unsigned char smem[];
    LAS unsigned char* lds0 = (LAS unsigned char*)smem;
    {
        const unsigned hw = (unsigned)__builtin_amdgcn_s_getreg((5 << 11) | 4) & 63u;
        if ((threadIdx.x & 63) == 0) *(volatile LAS int*)(LDS_HWTAB + hw * 4) = (int)(threadIdx.x >> 6);
        if (threadIdx.x < 64) ((LAS unsigned*)(lds0 + LDS_CTL))[threadIdx.x] = 0u;
    }
    __syncthreads();
    XcdBarrier bar; bar.bar = (unsigned*)(p.ws + OFF_BAR); bar.x = 0; bar.st = nullptr;
    bar = xcd_barrier_post((unsigned*)(p.ws + OFF_BAR), (volatile LAS unsigned*)(lds0 + LDS_CTL));
#ifndef PROBE
#define PROBE -1
#endif
#ifndef PROBE_END
#define PROBE_END (PROBE + 1)
#endif
    unsigned long long pt0 = 0, pt1 = 0;
#define RUN_PHASE(k, call) { if ((k) > 0) xcd_barrier(bar); if (PROBE >= 0 && (k) == PROBE) pt0 = __builtin_amdgcn_s_memrealtime(); if (PROBE >= 0 && (k) == PROBE_END) pt1 = __builtin_amdgcn_s_memrealtime(); \
    int on_ = 1; asm volatile("" : "+s"(on_)); if (on_) { int grp_ = hw_tid() >> 8; asm volatile("" : "+v"(grp_)); LAS unsigned char* lds = lds0 + grp_ * 32768; (void)lds; call; } }
    RUN_PHASE(0, phase_prep(p, lds))
    RUN_PHASE(1, phase_xn(p))
    RUN_PHASE(2, phase_inproj(p, lds0))
    RUN_PHASE(3, phase_attn_pool(p, lds, (char*)smem))
    RUN_PHASE(4, phase_outproj(p, lds0))
    RUN_PHASE(5, phase_router(p, lds0))
    RUN_PHASE(6, phase_gateup(p, lds0))
    RUN_PHASE(7, phase_down(p, lds0))
    RUN_PHASE(8, phase_final(p))
    if (PROBE >= 0) {
        if (PROBE_END == 9) pt1 = __builtin_amdgcn_s_memrealtime();
        if (blockIdx.x == 0 && hw_tid() == 0) { const unsigned long long tend = __builtin_amdgcn_s_memrealtime() + 8ull * (pt1 - pt0); while (__builtin_amdgcn_s_memrealtime() < tend) __builtin_amdgcn_s_sleep(8); }
    }
}

extern "C" void kernel_launch(void* const* d_in, const int* in_sizes, int n_in, void* d_out, int out_size, void* d_ws, size_t ws_size, hipStream_t stream) {
    static int grid = 0;
    if (grid == 0) {
        int dev = 0, cus = 0, per_cu = 0;
        (void)hipGetDevice(&dev);
        (void)hipDeviceGetAttribute(&cus, hipDeviceAttributeMultiprocessorCount, dev);
        (void)hipFuncSetAttribute((const void*)mk_fwd, hipFuncAttributeMaxDynamicSharedMemorySize, LDS_BYTES);
        (void)hipOccupancyMaxActiveBlocksPerMultiprocessor(&per_cu, (const void*)mk_fwd, 512, LDS_BYTES);
        if (per_cu < 1) fprintf(stderr, "kernel_launch: occupancy query says %d blocks per CU\n", per_cu);
        (void)hipGetLastError();
        grid = cus;
        if (ws_size < WS_NEED) fprintf(stderr, "kernel_launch: workspace too small: %zu < %zu\n", ws_size, (size_t)WS_NEED);
    }
    Params p{};
    const float** pp = (const float**)&p;
    for (int i = 0; i < 24; ++i) pp[i] = (const float*)d_in[i];
    p.out = (float*)d_out; p.ws = (unsigned char*)d_ws;
    (void)hipMemsetAsync((char*)d_ws + OFF_BAR, 0, XCD_BAR_WORDS * 4, stream);
    hipLaunchKernelGGL(mk_fwd, dim3(grid), dim3(512), LDS_BYTES, stream, p);
}
```

```cpp
#include <hip/hip_runtime.h>
#include <stdint.h>
#include <stdio.h>


#define LAS __attribute__((address_space(3)))
#define TIDX ((int)(hw_tid() & 255))
#define VBLK ((int)(blockIdx.x * 2 + (hw_tid() >> 8)))
#define NVBLK ((int)(gridDim.x * 2))
typedef unsigned short bf16_t;
typedef short bf16x8 __attribute__((ext_vector_type(8)));
typedef float f32x4 __attribute__((ext_vector_type(4)));
typedef unsigned u32x4 __attribute__((ext_vector_type(4)));
typedef unsigned u32x2 __attribute__((ext_vector_type(2)));

constexpr int D = 1024, NB = 16, SEQ = 2048, T = NB * SEQ, CTXL = 256, TC = NB * CTXL, KVL = CTXL + SEQ;
constexpr int PW = 1536, NE = 64, NEX = 65, FF = 256, NSLOT = 9, MODW = 6 * D;
constexpr float ALPHA = 1.189207115002721f;
constexpr float C2 = 0.125f * 1.4426950408889634f;
constexpr int NPHASE = 9;
constexpr int LDS_BYTES = 163840, LDS_TAB = 131072, LDS_CTL = 155648;
constexpr int LDS_HWTAB = LDS_CTL + 2048;
__device__ __forceinline__ int hw_tid() {
    const unsigned hw = (unsigned)__builtin_amdgcn_s_getreg((5 << 11) | 4) & 63u;
    const int w = __builtin_amdgcn_readfirstlane(*(volatile LAS int*)(LDS_HWTAB + hw * 4));
    return w * 64 + (int)__builtin_amdgcn_mbcnt_hi(~0u, __builtin_amdgcn_mbcnt_lo(~0u, 0u));
}

constexpr size_t MiB = 1u << 20;
constexpr size_t OFF_CNT = 0, OFF_MOD = 4096, OFF_ROPE = 512 * 1024;
constexpr size_t OFF_WTIN = 1 * MiB, OFF_WTOUT = 4 * MiB, OFF_WD = 6 * MiB, OFF_LDST = 39 * MiB, OFF_ACT = 47 * MiB;
constexpr size_t OFF_SLOTS = 201 * MiB;
constexpr size_t OFF_WGU = 201 * MiB, OFF_H = 266 * MiB, OFF_LW = 330 * MiB;
constexpr size_t OFF_XN = 47 * MiB, OFF_Q = 119 * MiB, OFF_K = 167 * MiB;
constexpr size_t OFF_V = 338 * MiB, OFF_U = 356 * MiB, OFF_AO = 372 * MiB, OFF_STATS = 436 * MiB;
constexpr size_t OFF_WRH = 490 * MiB, OFF_WRL = OFF_WRH + 128 * 1024;
constexpr size_t WS_NEED = 491 * MiB;

struct Params {
    const float *x, *c, *ctx, *c_ctx, *w_mod, *b_mod, *w_in, *q_norm, *k_norm, *pool_w, *pool_scale, *w_out, *ln1_g, *ln1_b,
        *w_router, *router_bias, *w_gate, *w_up, *w_down, *ws_gate, *ws_up, *ws_down, *ln2_g, *ln2_b;
    float* out;
    unsigned char* ws;
};

__device__ __forceinline__ unsigned f2bf(float f) { unsigned u = __float_as_uint(f); return (u + 0x7fffu + ((u >> 16) & 1u)) >> 16; }
__device__ __forceinline__ unsigned pk2(float lo, float hi) { return f2bf(lo) | (f2bf(hi) << 16); }
__device__ __forceinline__ float bf2f(unsigned h) { return __uint_as_float(h << 16); }
__device__ __forceinline__ float bflo(unsigned w) { return __uint_as_float(w << 16); }
__device__ __forceinline__ float bfhi(unsigned w) { return __uint_as_float(w & 0xffff0000u); }

namespace pg8 {
constexpr int BM = 256, BK = 64, HALF = 128, HTB = HALF * BK * 2, STAGE_BYTES = 8 * HTB;
__host__ __device__ __forceinline__ int lds_byte(int r, int c) { const int st = (r >> 4) * 2 + (c >> 5), rr = r & 15, cc = c & 31, ob = rr * 64 + cc * 2; return st * 1024 + (ob ^ (((ob >> 9) & 1) << 5)); }
__host__ __device__ __forceinline__ void stage_rc(int b, int& R, int& C) { const int st = b / 1024, sb = b % 1024, swz = sb ^ (((sb >> 9) & 1) << 5); R = (st >> 1) * 16 + swz / 64; C = (st & 1) * 32 + (swz % 64) / 2; }
__host__ __device__ __forceinline__ int perm32(int rho) { const int n = rho >> 4, i = rho & 15; return 8 * (i >> 2) + 4 * n + (i & 3); }
struct Unit { int pm, pn, idx, e; };
struct Gemm { const bf16_t* A; const bf16_t* Bt; };
__device__ __forceinline__ unsigned cvt_pk_bf16(float lo, float hi) { unsigned r; asm volatile("v_cvt_pk_bf16_f32 %0, %1, %2" : "=v"(r) : "v"(lo), "v"(hi)); return r; }

template <int K, class Epi, class Sched, bool GATHER, bool ALIGN_EPI = true>
__device__ __forceinline__ void gemm_phase(LAS unsigned char* lds, const Gemm g, const Sched& S, const Epi& E) {
    const int tid = hw_tid(), wid = __builtin_amdgcn_readfirstlane(tid >> 6), lane = tid & 63, wr = wid >> 2, wc = wid & 3, fr = lane & 15, fq = lane >> 4;
    constexpr int nt = K / BK;
    unsigned voffA[2], voffB[2], colA = 0; int rowA = 0;
#pragma unroll
    for (int i = 0; i < 2; ++i) { int R, C; stage_rc(tid * 16 + i * 8192, R, C); const int Rb = Epi::PERM ? ((R & ~31) + perm32(R & 31)) : R;
        voffA[i] = (unsigned)(R * K + C) * 2u; voffB[i] = (unsigned)(Rb * K + C) * 2u; if (i == 0) { colA = (unsigned)C * 2u; rowA = R; } }
    const size_t kstep = (size_t)(BK * 2);
    const size_t hstep = (size_t)HALF * K * 2;
    const size_t tstep = 2 * hstep;
    const unsigned ldsw = (unsigned)wid * 1024u;
    const int aoff = lds_byte(wr * 64 + fr, fq * 8), boff = lds_byte(wc * 32 + fr, fq * 8);
#define PG8_SA(b, h) (((b) * 2 + (h)) * HTB)
#define PG8_SB(b, h) ((4 + (b) * 2 + (h)) * HTB)
#define PG8_STAGE(bufoff, gbase, voff) do { _Pragma("unroll") for (int _i = 0; _i < 2; ++_i) \
        __builtin_amdgcn_global_load_lds((const unsigned*)((const char*)(gbase) + (voff)[_i]), (LAS unsigned*)(lds + (bufoff) + ldsw + _i * 8192), 16, 0, 0); } while (0)
#define PG8_STAGE_A(bufoff, ptr, h, NX) do { if constexpr (GATHER) { unsigned _v[2]; \
            if (NX) { _v[0] = S.row_off(nidx, (h) * HALF + rowA) + colA; _v[1] = S.row_off(nidx, (h) * HALF + rowA + 64) + colA; } else { _v[0] = vA[h][0]; _v[1] = vA[h][1]; } PG8_STAGE(bufoff, ptr, _v); } \
        else { PG8_STAGE(bufoff, (ptr) + (h) * hstep, voffA); } } while (0)
#define PG8_LDA(dst, b, h) do { _Pragma("unroll") for (int m = 0; m < 4; ++m) _Pragma("unroll") for (int k = 0; k < 2; ++k) dst[m][k] = *(const LAS bf16x8*)(lds + PG8_SA(b, h) + aoff + m * 2048 + k * 1024); } while (0)
#define PG8_LDB(dst, b, h) do { _Pragma("unroll") for (int n = 0; n < 2; ++n) _Pragma("unroll") for (int k = 0; k < 2; ++k) dst[n][k] = *(const LAS bf16x8*)(lds + PG8_SB(b, h) + boff + n * 2048 + k * 1024); } while (0)
#define PG8_MMA(ai, bj, At, Bt) do { __builtin_amdgcn_s_setprio(1); _Pragma("unroll") for (int m = 0; m < 4; ++m) _Pragma("unroll") for (int n = 0; n < 2; ++n) _Pragma("unroll") for (int k = 0; k < 2; ++k) \
        acc[ai][bj][m][n] = __builtin_amdgcn_mfma_f32_16x16x32_bf16(Bt[n][k], At[m][k], acc[ai][bj][m][n], 0, 0, 0); __builtin_amdgcn_s_setprio(0); } while (0)
#define PG8_WAIT_V(n) asm volatile("s_waitcnt vmcnt(" #n ")" ::: "memory")
#define PG8_WAIT_L(n) asm volatile("s_waitcnt lgkmcnt(" #n ")" ::: "memory")
#define PG8_BAR __builtin_amdgcn_s_barrier()
#define PG8_SCHED __builtin_amdgcn_sched_barrier(0)
    Unit cur, nxt; int ui = 0;
    if (!S.next(0, cur)) return;
    f32x4 acc[2][2][4][2];
#pragma unroll
    for (int a = 0; a < 2; ++a)
#pragma unroll
        for (int b = 0; b < 2; ++b)
#pragma unroll
            for (int m = 0; m < 4; ++m)
#pragma unroll
                for (int n = 0; n < 2; ++n) acc[a][b][m][n] = (f32x4){0.f, 0.f, 0.f, 0.f};
    bf16x8 At[4][2], B0[2][2], B1[2][2];
    unsigned vA[2][2]; int nidx = 0;
    if constexpr (GATHER) {
#pragma unroll
        for (int h = 0; h < 2; ++h)
#pragma unroll
            for (int i = 0; i < 2; ++i) vA[h][i] = S.row_off(cur.idx, h * HALF + rowA + 64 * i) + colA;
    }
    const char* cA = GATHER ? (const char*)g.A : (const char*)g.A + (size_t)cur.pm * tstep; const char* cB = (const char*)g.Bt + (size_t)cur.pn * tstep;
    S.a_ready(cur);
    PG8_STAGE(PG8_SB(0, 0), cB, voffB); PG8_STAGE(PG8_SB(0, 1), cB + hstep, voffB); PG8_STAGE_A(PG8_SA(0, 0), cA, 0, false); PG8_STAGE_A(PG8_SA(0, 1), cA, 1, false);
    if (wr == 1) PG8_BAR;
    PG8_WAIT_V(2); PG8_BAR;
    PG8_STAGE(PG8_SB(1, 0), cB + kstep, voffB); PG8_STAGE_A(PG8_SA(1, 0), cA + kstep, 0, false); PG8_STAGE(PG8_SB(1, 1), cB + hstep + kstep, voffB);
    PG8_WAIT_V(6); PG8_BAR;
    for (;;) {
        const bool has_next = S.next(ui + 1, nxt);
        if constexpr (GATHER) nidx = has_next ? nxt.idx : cur.idx;
        const char* nA = GATHER ? (const char*)g.A : (has_next ? (const char*)g.A + (size_t)nxt.pm * tstep : cA); const char* nB = has_next ? (const char*)g.Bt + (size_t)nxt.pn * tstep : cB;
        for (int t = 0; t < nt; t += 2) {
            const bool last = (t == nt - 2);
            const char* a1 = cA + (size_t)(t + 1) * kstep;
            const char* a2 = last ? nA : cA + (size_t)(t + 2) * kstep; const char* b2 = last ? nB : cB + (size_t)(t + 2) * kstep;
            const char* a3 = a2 + kstep; const char* b3 = b2 + kstep;
            if (last && has_next) S.a_ready(nxt);
            PG8_LDB(B0, 0, 0); PG8_LDB(B1, 0, 1); PG8_SCHED; PG8_LDA(At, 0, 0); PG8_STAGE_A(PG8_SA(1, 1), a1, 1, false);
            PG8_WAIT_V(8); PG8_WAIT_L(0); PG8_BAR; PG8_MMA(0, 0, At, B0); PG8_MMA(0, 1, At, B1); PG8_BAR; PG8_SCHED;
            PG8_LDA(At, 0, 1); PG8_STAGE(PG8_SB(0, 0), b2, voffB); PG8_STAGE(PG8_SB(0, 1), b2 + hstep, voffB); PG8_STAGE_A(PG8_SA(0, 0), a2, 0, last);
            PG8_WAIT_V(8); PG8_WAIT_L(0); PG8_BAR; PG8_MMA(1, 0, At, B0); PG8_MMA(1, 1, At, B1); PG8_BAR; PG8_SCHED;
            PG8_LDB(B0, 1, 0); PG8_LDB(B1, 1, 1); PG8_SCHED; PG8_LDA(At, 1, 0); PG8_STAGE_A(PG8_SA(0, 1), a2, 1, last);
            PG8_WAIT_V(8); PG8_WAIT_L(0); PG8_BAR; PG8_MMA(0, 0, At, B0); PG8_MMA(0, 1, At, B1); PG8_BAR; PG8_SCHED;
            PG8_LDA(At, 1, 1); PG8_STAGE(PG8_SB(1, 0), b3, voffB); PG8_STAGE(PG8_SB(1, 1), b3 + hstep, voffB); PG8_STAGE_A(PG8_SA(1, 0), a3, 0, last);
            PG8_WAIT_V(8); PG8_WAIT_L(0); PG8_BAR; PG8_MMA(1, 0, At, B0); PG8_MMA(1, 1, At, B1); PG8_BAR; PG8_SCHED;
        }
        if constexpr (ALIGN_EPI) { if (wr == 0) PG8_BAR; }
        E(acc, cur, wr, wc, fr, fq); S.done(cur);
        if (!has_next) break;
#pragma unroll
        for (int a = 0; a < 2; ++a)
#pragma unroll
            for (int b = 0; b < 2; ++b)
#pragma unroll
                for (int m = 0; m < 4; ++m)
#pragma unroll
                    for (int n = 0; n < 2; ++n) acc[a][b][m][n] = (f32x4){0.f, 0.f, 0.f, 0.f};
        cur = nxt; cA = nA; cB = nB; ++ui;
        if constexpr (GATHER) {
#pragma unroll
            for (int h = 0; h < 2; ++h)
#pragma unroll
                for (int i = 0; i < 2; ++i) vA[h][i] = S.row_off(cur.idx, h * HALF + rowA + 64 * i) + colA;
        }
        if constexpr (ALIGN_EPI) { if (wr == 1) PG8_BAR; }
    }
    PG8_WAIT_V(0);
    if constexpr (!ALIGN_EPI) { if (wr == 0) PG8_BAR; }
    PG8_BAR;
#undef PG8_SA
#undef PG8_SB
#undef PG8_STAGE
#undef PG8_STAGE_A
#undef PG8_LDA
#undef PG8_LDB
#undef PG8_MMA
#undef PG8_WAIT_V
#undef PG8_WAIT_L
#undef PG8_BAR
#undef PG8_SCHED
}

struct DenseSched {
    int nN, n1, total, pn2lo, nN2, G, c;
    __device__ __forceinline__ bool next(int i, Unit& u) const {
        const int L = i * G + c; if (L >= total) return false;
        if (L < n1) { u.pm = L / nN; u.pn = L % nN; } else { const int r = L - n1; u.pm = n1 / nN + r / nN2; u.pn = pn2lo + r % nN2; }
        u.idx = i; u.e = 0; return true;
    }
    __device__ __forceinline__ void a_ready(const Unit&) const {}
    __device__ __forceinline__ void done(const Unit&) const {}
};
}

__device__ __forceinline__ int win_row(int n) { return (n & ~255) + 128 * ((n >> 5) & 1) + 32 * ((n >> 6) & 3) + (n & 31); }
__device__ __forceinline__ int gu_row(int j, int half) { return (j >> 7) * 256 + half * 128 + (j & 127); }

template <class RowMap>
__device__ __forceinline__ void transpose_tile(LAS float* tile, const float* src, int ld, int k0, int n0, bf16_t* dst, int Kdst, RowMap rowmap) {
    const int tid = TIDX;
#pragma unroll
    for (int pss = 0; pss < 4; ++pss) {
        const int k = pss * 16 + (tid >> 4), n4 = (tid & 15) * 4;
        const f32x4 v = *(const f32x4*)(src + (size_t)(k0 + k) * ld + n0 + n4);
        tile[k * 65 + n4 + 0] = v[0]; tile[k * 65 + n4 + 1] = v[1]; tile[k * 65 + n4 + 2] = v[2]; tile[k * 65 + n4 + 3] = v[3];
    }
    __syncthreads();
    {
        const int n = tid >> 2, kc = (tid & 3) * 16;
        unsigned w[8];
#pragma unroll
        for (int i = 0; i < 8; ++i) w[i] = pk2(tile[(kc + 2 * i) * 65 + n], tile[(kc + 2 * i + 1) * 65 + n]);
        bf16_t* dp = dst + (size_t)rowmap(n0 + n) * Kdst + k0 + kc;
        *(u32x4*)dp = (u32x4){w[0], w[1], w[2], w[3]};
        *(u32x4*)(dp + 8) = (u32x4){w[4], w[5], w[6], w[7]};
    }
    __syncthreads();
}

template <class RowMap>
__device__ __forceinline__ void wave_transpose(LAS float* scr, const float* src, int ld, int k0, int n0, bf16_t* dst, int Kdst, RowMap rowmap, int lane) {
#pragma unroll
    for (int i = 0; i < 8; ++i) {
        const int kk = 8 * i + (lane >> 3), n4 = (lane & 7) * 4;
        const f32x4 v = *(const f32x4*)(src + (size_t)(k0 + kk) * ld + n0 + n4);
        scr[kk * 33 + n4] = v[0]; scr[kk * 33 + n4 + 1] = v[1]; scr[kk * 33 + n4 + 2] = v[2]; scr[kk * 33 + n4 + 3] = v[3];
    }
    asm volatile("s_waitcnt lgkmcnt(0)" ::: "memory");
    const int c = lane & 7;
#pragma unroll
    for (int j = 0; j < 4; ++j) {
        const int n = (lane >> 3) + 8 * j; const LAS float* sp = scr + (8 * c) * 33 + n;
        u32x4 o; o.x = pk2(sp[0], sp[33]); o.y = pk2(sp[2 * 33], sp[3 * 33]); o.z = pk2(sp[4 * 33], sp[5 * 33]); o.w = pk2(sp[6 * 33], sp[7 * 33]);
        *(u32x4*)(dst + (size_t)rowmap(n0 + n) * Kdst + k0 + 8 * c) = o;
    }
    asm volatile("s_waitcnt lgkmcnt(0)" ::: "memory");
}

__device__ __forceinline__ void phase_prep(const Params& p, LAS unsigned char* lds) {
    const int tid = TIDX;
    int* gcnt = (int*)(p.ws + OFF_CNT);
    if (VBLK == 0 && tid < 128) gcnt[tid] = 0;
    float* mod = (float*)(p.ws + OFF_MOD);
    float* rope = (float*)(p.ws + OFF_ROPE);
    constexpr int N_MOD = 384, N_ROPE = 256, N_TR = 16;
    for (int it = VBLK; it < N_MOD + N_ROPE + N_TR; it += NVBLK) {
        if (it < N_MOD) {
            LAS float* sl = (LAS float*)lds;
            LAS float* red = (LAS float*)(lds + 10240);
            const int col = it * 16 + (tid & 15), kk = tid >> 4;
            float acc[17];
#pragma unroll
            for (int r = 0; r < 17; ++r) acc[r] = 0.f;
            for (int kc = 0; kc < 8; ++kc) {
                float wv[8];
#pragma unroll
                for (int i = 0; i < 8; ++i) wv[i] = p.w_mod[(size_t)(kc * 128 + kk + 16 * i) * MODW + col];
                __syncthreads();
                for (int o = tid; o < 17 * 128; o += 256) {
                    const int r = o >> 7, kl = o & 127;
                    const float cv = (r < 16) ? p.c[r * D + kc * 128 + kl] : p.c_ctx[kc * 128 + kl];
                    sl[kl * 20 + r] = cv / (1.f + expf(-cv));
                }
                __syncthreads();
#pragma unroll
                for (int i = 0; i < 8; ++i) {
                    const int kl = kk + 16 * i;
                    const f32x4 s0 = *(const LAS f32x4*)(sl + kl * 20), s1 = *(const LAS f32x4*)(sl + kl * 20 + 4), s2 = *(const LAS f32x4*)(sl + kl * 20 + 8), s3 = *(const LAS f32x4*)(sl + kl * 20 + 12);
                    const float s4 = sl[kl * 20 + 16];
#pragma unroll
                    for (int q = 0; q < 4; ++q) { acc[q] += s0[q] * wv[i]; acc[4 + q] += s1[q] * wv[i]; acc[8 + q] += s2[q] * wv[i]; acc[12 + q] += s3[q] * wv[i]; }
                    acc[16] += s4 * wv[i];
                }
            }
#pragma unroll
            for (int r = 0; r < 17; ++r) red[(kk * 17 + r) * 16 + (tid & 15)] = acc[r];
            __syncthreads();
            for (int o = tid; o < 17 * 16; o += 256) {
                const int r = o >> 4, j = o & 15;
                float sm = p.b_mod[it * 16 + j];
#pragma unroll
                for (int g = 0; g < 16; ++g) sm += red[(g * 17 + r) * 16 + j];
                mod[r * MODW + it * 16 + j] = sm;
            }
            __syncthreads();
        } else if (it < N_MOD + N_ROPE) {
            const int idx = (it - N_MOD) * 256 + tid, t = idx >> 5, i = idx & 31;
            const int pos = (i < 16) ? (t >> 6) : (t & 63);
            const float invf = (float)exp(-(double)(i & 15) / 16.0 * 9.210340371976184);
            const double ang = (double)((float)pos * invf);
            rope[idx * 2 + 0] = (float)cos(ang);
            rope[idx * 2 + 1] = (float)sin(ang);
        } else {
            LAS float* tile = (LAS float*)lds;
            const int idx = it - N_MOD - N_ROPE;
            {

                const int k0 = idx * 64;
#pragma unroll
                for (int pss = 0; pss < 4; ++pss) {
                    const int k = pss * 16 + (tid >> 4), n4 = (tid & 15) * 4;
                    const f32x4 v = *(const f32x4*)(p.w_router + (size_t)(k0 + k) * NE + n4);
                    tile[k * 65 + n4 + 0] = v[0]; tile[k * 65 + n4 + 1] = v[1]; tile[k * 65 + n4 + 2] = v[2]; tile[k * 65 + n4 + 3] = v[3];
                }
                __syncthreads();
                {
                    const int n = tid >> 2, kc = (tid & 3) * 16;
                    unsigned wh[8], wl[8];
#pragma unroll
                    for (int i = 0; i < 8; ++i) {
                        const float a = tile[(kc + 2 * i) * 65 + n], b = tile[(kc + 2 * i + 1) * 65 + n];
                        const unsigned ha = f2bf(a), hb = f2bf(b);
                        wh[i] = ha | (hb << 16);
                        wl[i] = pk2(a - bf2f(ha), b - bf2f(hb));
                    }
                    bf16_t* dh = (bf16_t*)(p.ws + OFF_WRH) + (size_t)n * D + k0 + kc;
                    bf16_t* dl = (bf16_t*)(p.ws + OFF_WRL) + (size_t)n * D + k0 + kc;
                    *(u32x4*)dh = (u32x4){wh[0], wh[1], wh[2], wh[3]}; *(u32x4*)(dh + 8) = (u32x4){wh[4], wh[5], wh[6], wh[7]};
                    *(u32x4*)dl = (u32x4){wl[0], wl[1], wl[2], wl[3]}; *(u32x4*)(dl + 8) = (u32x4){wl[4], wl[5], wl[6], wl[7]};
                }
                __syncthreads();
            }
        }
    }
    __syncthreads();
    {
        const int lane = hw_tid() & 63, wv = hw_tid() >> 6;
        LAS float* scr = (LAS float*)(lds - (hw_tid() >> 8) * 32768) + wv * (64 * 33);
        constexpr int I_IN = 16 * 48, I_OUT = 16 * 32, I_E = 384, NITEMS = I_IN + I_OUT + NEX * I_E;
        for (int it = blockIdx.x * 8 + wv; it < NITEMS; it += gridDim.x * 8) {
            int r = it;
            if (r < I_IN) { wave_transpose(scr, p.w_in, PW, (r / 48) * 64, (r % 48) * 32, (bf16_t*)(p.ws + OFF_WTIN), D, [](int n) { return win_row(n); }, lane); continue; }
            r -= I_IN;
            if (r < I_OUT) { wave_transpose(scr, p.w_out, D, (r / 32) * 64, (r % 32) * 32, (bf16_t*)(p.ws + OFF_WTOUT), D, [](int n) { return n; }, lane); continue; }
            r -= I_OUT;
            const int e = r / I_E, q = r % I_E;
            if (q < 256) {
                const int half = q >> 7, rr = q & 127;
                const float* src = half ? (e < NE ? p.w_up + (size_t)e * D * FF : p.ws_up) : (e < NE ? p.w_gate + (size_t)e * D * FF : p.ws_gate);
                wave_transpose(scr, src, FF, (rr / 8) * 64, (rr % 8) * 32, (bf16_t*)(p.ws + OFF_WGU) + (size_t)e * 512 * D, D, [half](int n) { return gu_row(n, half); }, lane);
            } else {
                const int rr = q - 256;
                const float* src = e < NE ? p.w_down + (size_t)e * FF * D : p.ws_down;
                wave_transpose(scr, src, D, (rr / 32) * 64, (rr % 32) * 32, (bf16_t*)(p.ws + OFF_WD) + (size_t)e * D * FF, FF, [](int n) { return n; }, lane);
            }
        }
    }
}

__device__ __forceinline__ void phase_xn(const Params& p) {
    const int lane = TIDX & 63, gw = VBLK * 4 + (TIDX >> 6), ngw = NVBLK * 4;
    const float* mod = (const float*)(p.ws + OFF_MOD);
    bf16_t* XN = (bf16_t*)(p.ws + OFF_XN);
    for (int row = gw; row < T + TC; row += ngw) {
        const float* src = row < T ? p.x + (size_t)row * D : p.ctx + (size_t)(row - T) * D;
        const float* mr = mod + (size_t)(row < T ? row / SEQ : 16) * MODW;
#pragma unroll
        for (int j = 0; j < 4; ++j) {
            const int c = 4 * lane + 256 * j;
            const f32x4 v = *(const f32x4*)(src + c), sh = *(const f32x4*)(mr + c), sc = *(const f32x4*)(mr + D + c);
            u32x2 o; o.x = pk2(v[0] * (1.f + sc[0]) + sh[0], v[1] * (1.f + sc[1]) + sh[1]); o.y = pk2(v[2] * (1.f + sc[2]) + sh[2], v[3] * (1.f + sc[3]) + sh[3]);
            *(u32x2*)(XN + (size_t)row * D + c) = o;
        }
    }
}

struct EpiIn {
    static constexpr bool PERM = true;
    const float *q_norm, *k_norm, *rope; bf16_t *Qb, *Kb, *Vb, *Ub;
    __device__ __forceinline__ void operator()(const f32x4 (&acc)[2][2][4][2], const pg8::Unit& u, int wr, int wc, int fr, int fq) const {
        const int grp = u.pn * 4 + wc;
        const bool is_ctx = u.pm >= T / 256;
        f32x4 gn[2][2];
        if (grp >= 4 && grp < 20) {
            const float* g = grp < 16 ? q_norm : k_norm;
#pragma unroll
            for (int bj = 0; bj < 2; ++bj)
#pragma unroll
                for (int n = 0; n < 2; ++n) gn[bj][n] = *(const f32x4*)(g + 32 * bj + 8 * fq + 4 * n);
        }
#pragma unroll
        for (int ai = 0; ai < 2; ++ai)
#pragma unroll
            for (int m = 0; m < 4; ++m) {
                const int row = u.pm * 256 + ai * 128 + wr * 64 + m * 16 + fr;
                f32x4 v[2][2];
#pragma unroll
                for (int bj = 0; bj < 2; ++bj)
#pragma unroll
                    for (int n = 0; n < 2; ++n) v[bj][n] = acc[ai][bj][m][n];
                bf16_t* dst;
                if (grp < 4) dst = Ub + (size_t)row * 256 + grp * 64;
                else if (grp < 16) dst = Qb + (size_t)row * 768 + (grp - 4) * 64;
                else {
                    const size_t krow = is_ctx ? (size_t)((row - T) >> 8) * KVL + ((row - T) & 255) : (size_t)(row >> 11) * KVL + CTXL + (row & (SEQ - 1));
                    dst = (grp < 20 ? Kb + (grp - 16) * 64 : Vb + (grp - 20) * 64) + krow * 256;
                }
                if (grp >= 4 && grp < 20) {
                    float ss = 0.f;
#pragma unroll
                    for (int bj = 0; bj < 2; ++bj)
#pragma unroll
                        for (int n = 0; n < 2; ++n) ss += (v[bj][n][0] * v[bj][n][0] + v[bj][n][1] * v[bj][n][1]) + (v[bj][n][2] * v[bj][n][2] + v[bj][n][3] * v[bj][n][3]);
                    ss += __shfl_xor(ss, 16); ss += __shfl_xor(ss, 32);
                    const float rs = 1.0f / sqrtf(ss * (1.f / 64.f) + 1e-6f);
#pragma unroll
                    for (int bj = 0; bj < 2; ++bj)
#pragma unroll
                        for (int n = 0; n < 2; ++n) v[bj][n] = v[bj][n] * rs * gn[bj][n];
                    if (!is_ctx) {
                        const int tpos = row & (SEQ - 1);
#pragma unroll
                        for (int bj = 0; bj < 2; ++bj)
#pragma unroll
                            for (int n = 0; n < 2; ++n) {
                                const f32x4 cs = *(const f32x4*)(rope + (size_t)(tpos * 32 + 16 * bj + 4 * fq + 2 * n) * 2);
                                const f32x4 x = v[bj][n];
                                v[bj][n] = (f32x4){x[0] * cs[0] - x[1] * cs[1], x[0] * cs[1] + x[1] * cs[0], x[2] * cs[2] - x[3] * cs[3], x[2] * cs[3] + x[3] * cs[2]};
                            }
                    }
                    if (grp < 16) {
#pragma unroll
                        for (int bj = 0; bj < 2; ++bj)
#pragma unroll
                            for (int n = 0; n < 2; ++n) v[bj][n] = v[bj][n] * C2;
                    }
                }
#pragma unroll
                for (int bj = 0; bj < 2; ++bj) {
                    u32x4 w; w.x = pk2(v[bj][0][0], v[bj][0][1]); w.y = pk2(v[bj][0][2], v[bj][0][3]); w.z = pk2(v[bj][1][0], v[bj][1][1]); w.w = pk2(v[bj][1][2], v[bj][1][3]);
                    *(u32x4*)(dst + 32 * bj + 8 * fq) = w;
                }
            }
    }
};
__device__ __forceinline__ int vcu_of_block() { const int G = gridDim.x, bx = blockIdx.x; return (G % 8 == 0) ? (bx % 8) * (G / 8) + bx / 8 : bx; }
__device__ __forceinline__ void phase_inproj(const Params& p, LAS unsigned char* lds) {
    pg8::Gemm g{(const bf16_t*)(p.ws + OFF_XN), (const bf16_t*)(p.ws + OFF_WTIN)};
    pg8::DenseSched S{6, 768, 800, 4, 2, (int)gridDim.x, vcu_of_block()};
    EpiIn E{p.q_norm, p.k_norm, (const float*)(p.ws + OFF_ROPE), (bf16_t*)(p.ws + OFF_Q), (bf16_t*)(p.ws + OFF_K), (bf16_t*)(p.ws + OFF_V), (bf16_t*)(p.ws + OFF_U)};
    pg8::gemm_phase<D, EpiIn, pg8::DenseSched, false>(lds, g, S, E);
}

namespace attn_body {
using bf16=unsigned short;
using bf16x8=__attribute__((ext_vector_type(8)))short;
using s16x4=__attribute__((ext_vector_type(4)))short;
using f32x16=__attribute__((ext_vector_type(16)))float;
using u32x4=__attribute__((ext_vector_type(4)))unsigned;
constexpr int D=64,QP=768,KP=256,OP=1024,SEQ=2048,KVLEN=2304;
constexpr int NW=8,QBLK=32,QB=QBLK*NW,KVBLK=64,NT=KVLEN/KVBLK;
__device__ __forceinline__ int crow(int r,int hi){return (r&3)+8*(r>>2)+4*hi;}
#define SBAR() __builtin_amdgcn_sched_barrier(0)
constexpr int NSLOT=3, SLOTB=8192;
constexpr int LDS_K=0, LDS_V=NSLOT*SLOTB, LDS_WS=2*NSLOT*SLOTB, LDS_OST=LDS_WS+NW*64*4, LDS_BYTES=LDS_OST+NW*4096;
constexpr float C2=0.125f*1.4426950408889634f;
__device__ __forceinline__ void glds16(const void*gsrc,unsigned lds_dst){unsigned keep;
  asm volatile("s_mov_b32 %0, m0\n\ts_mov_b32 m0, %2\n\ts_nop 0\n\tglobal_load_lds_dwordx4 %1, off\n\ts_mov_b32 m0, %0":"=&s"(keep):"v"(gsrc),"s"(lds_dst):"memory");}
__device__ __forceinline__ float max3f(float a,float b,float c){float r;asm("v_max3_f32 %0, %1, %2, %3":"=v"(r):"v"(a),"v"(b),"v"(c));return r;}
__device__ __forceinline__ float max2f(float a,float b){float r;asm("v_max_f32_e32 %0, %1, %2":"=v"(r):"v"(a),"v"(b));return r;}
__device__ __forceinline__ float fadd_s(float a,float b){float r;asm("v_add_f32_e32 %0, %1, %2":"=v"(r):"v"(a),"v"(b));return r;}
__device__ __forceinline__ float fsub_s(float a,float b){float r;asm("v_sub_f32_e32 %0, %1, %2":"=v"(r):"v"(a),"v"(b));return r;}
typedef float f32x2_t __attribute__((ext_vector_type(2))); typedef __bf16 bf16x2_t __attribute__((ext_vector_type(2)));
__device__ __forceinline__ unsigned cvtpk_s(float lo,float hi){f32x2_t v={lo,hi};bf16x2_t b=__builtin_convertvector(v,bf16x2_t);return __builtin_bit_cast(unsigned,b);}
#define WAIT_BAR(N) asm volatile("s_waitcnt vmcnt(" #N ") lgkmcnt(0)\n\ts_barrier":::"memory")

__device__ __forceinline__ void qkt(f32x16&p0,f32x16&p1,const char*Kslot,const bf16x8*qr,const f32x16&negm,int r32,int hi){
  const char*kb=Kslot+hi*1024+r32*16;
  #pragma unroll
  for(int d0=0;d0<4;++d0){
    const bf16x8 b0=*reinterpret_cast<const bf16x8*>(kb+d0*2048);
    const bf16x8 b1=*reinterpret_cast<const bf16x8*>(kb+d0*2048+512);
    if(d0==0){p0=__builtin_amdgcn_mfma_f32_32x32x16_bf16(b0,qr[0],negm,0,0,0);p1=__builtin_amdgcn_mfma_f32_32x32x16_bf16(b1,qr[0],negm,0,0,0);}
    else{p0=__builtin_amdgcn_mfma_f32_32x32x16_bf16(b0,qr[d0],p0,0,0,0);p1=__builtin_amdgcn_mfma_f32_32x32x16_bf16(b1,qr[d0],p1,0,0,0);}}
}
typedef __attribute__((address_space(3))) const char* lds_cptr;
typedef short v4i16_t __attribute__((ext_vector_type(4)));
__device__ __forceinline__ void kload8(bf16x8*kf,lds_cptr kp){
  kf[0]=*(const __attribute__((address_space(3))) bf16x8*)(kp);      kf[1]=*(const __attribute__((address_space(3))) bf16x8*)(kp+512);
  kf[2]=*(const __attribute__((address_space(3))) bf16x8*)(kp+2048); kf[3]=*(const __attribute__((address_space(3))) bf16x8*)(kp+2560);
  kf[4]=*(const __attribute__((address_space(3))) bf16x8*)(kp+4096); kf[5]=*(const __attribute__((address_space(3))) bf16x8*)(kp+4608);
  kf[6]=*(const __attribute__((address_space(3))) bf16x8*)(kp+6144); kf[7]=*(const __attribute__((address_space(3))) bf16x8*)(kp+6656);
}
__device__ __forceinline__ void kload2(bf16x8*kf,lds_cptr kp,int j){ kf[2*j]=*(const __attribute__((address_space(3))) bf16x8*)(kp+j*2048); kf[2*j+1]=*(const __attribute__((address_space(3))) bf16x8*)(kp+j*2048+512); }
__device__ __forceinline__ s16x4 vtr(lds_cptr p){ return __builtin_bit_cast(s16x4,__builtin_amdgcn_ds_read_tr16_b64_v4i16((__attribute__((address_space(3))) v4i16_t*)p)); }
__device__ __forceinline__ float rowmax(const f32x16&p0,const f32x16&p1){
  float a=max3f(p0[0],p0[1],p1[0]),b=max3f(p0[2],p0[3],p1[1]);a=max3f(a,p1[2],p1[3]);
  #pragma unroll
  for(int r=4;r<16;r+=4){a=max3f(a,p0[r],p0[r+1]);b=max3f(b,p0[r+2],p0[r+3]);a=max3f(a,p1[r],p1[r+1]);b=max3f(b,p1[r+2],p1[r+3]);}
  const float m=max2f(a,b);
  auto rr=__builtin_amdgcn_permlane32_swap(__float_as_uint(m),__float_as_uint(m),false,false);
  return max2f(__uint_as_float(rr[0]),__uint_as_float(rr[1]));
}
__device__ __forceinline__ void pv(f32x16*o,int vb,bf16x8 pa0,bf16x8 pa1,bf16x8 pa2,bf16x8 pa3){
  #pragma unroll
  for(int d0=0;d0<2;++d0){s16x4 lo[4],hi[4];
    #pragma unroll
    for(int ks=0;ks<4;++ks){
      asm volatile("ds_read_b64_tr_b16 %0,%1 offset:%c2":"=&v"(lo[ks]):"v"(vb),"i"(d0*4096+ks*1024):"memory");
      asm volatile("ds_read_b64_tr_b16 %0,%1 offset:%c2":"=&v"(hi[ks]):"v"(vb),"i"(d0*4096+ks*1024+512):"memory");}
    asm volatile("s_waitcnt lgkmcnt(0)":::"memory");SBAR();
    #define PK(k) (bf16x8){lo[k][0],lo[k][1],lo[k][2],lo[k][3],hi[k][0],hi[k][1],hi[k][2],hi[k][3]}
    o[d0]=__builtin_amdgcn_mfma_f32_32x32x16_bf16(pa0,PK(0),o[d0],0,0,0);
    o[d0]=__builtin_amdgcn_mfma_f32_32x32x16_bf16(pa1,PK(1),o[d0],0,0,0);
    o[d0]=__builtin_amdgcn_mfma_f32_32x32x16_bf16(pa2,PK(2),o[d0],0,0,0);
    o[d0]=__builtin_amdgcn_mfma_f32_32x32x16_bf16(pa3,PK(3),o[d0],0,0,0);
    #undef PK
  }
}

#ifndef ATTN_STORE16
#define ATTN_STORE16(p,v) (*(u32x4*)(p)=(v))
#endif
template<int THRL> __device__ __forceinline__ void attn_unit(int b,int h,int qb,const bf16*Q,const bf16*__restrict__ K,const bf16*__restrict__ V,bf16*O,char*shm){
  const int tid=hw_tid(),lane=tid&63,r32=lane&31,hi=lane>>5; const int wid=__builtin_amdgcn_readfirstlane(tid>>6);
  const long rowbase=(long)b*SEQ, kvbase=(long)b*KVLEN; const int q0=qb*QB, kh=h/3;
  const bf16*Qw=Q+(rowbase+q0+wid*QBLK)*QP+h*D;
  const bf16*Kh=K+kvbase*KP+kh*D,*Vh=V+kvbase*KP+kh*D;
  const unsigned lds0=(unsigned)(uintptr_t)shm;
  float*wsf=(float*)(shm+LDS_WS)+wid*64;
  const bf16*ksrc=Kh+(long)lane*KP+wid*8;
  const bf16*vsrc=Vh+(long)(16*(wid&3)+(lane>>2))*KP+(wid>>2)*32+(lane&3)*8;
  const unsigned kdst=lds0+LDS_K+wid*1024, vdst=lds0+LDS_V+wid*1024;
  #define DMA_K(t,slot) glds16(ksrc+(long)(t)*KVBLK*KP,(unsigned)__builtin_amdgcn_readfirstlane(kdst+(slot)))
  #define DMA_V(t,slot) glds16(vsrc+(long)(t)*KVBLK*KP,(unsigned)__builtin_amdgcn_readfirstlane(vdst+(slot)))
  const int vb0=(int)(lds0+LDS_V)+((lane>>4)&1)*32+(lane&3)*8+(4*hi+((lane&15)>>2))*64;
  const char*Kbase=shm+LDS_K; bf16x8 kf[8];
  const lds_cptr shm3=(lds_cptr)shm; const lds_cptr kp0=shm3+LDS_K+hi*1024+r32*16; const lds_cptr vp0=shm3+LDS_V+((lane>>4)&1)*32+(lane&3)*8+(4*hi+((lane&15)>>2))*64;
  DMA_K(0,0);DMA_V(0,0);DMA_K(1,SLOTB);
  bf16x8 qr[4];
  #pragma unroll
  for(int d0=0;d0<4;++d0)qr[d0]=*reinterpret_cast<const bf16x8*>(&Qw[(long)r32*QP+d0*16+hi*8]);
  float mhat=0.f,l_reg=0.f;f32x16 o[2];o[0]=f32x16{};o[1]=f32x16{};f32x16 negm=f32x16{};asm volatile("":"+v"(negm));
  #define CMASK(P0,P1,t) do{}while(0)
  bool resc=false;
  #define START(P0,P1) do{ const float rm=rowmax(P0,P1); resc=false; \
    { const float dl=rm; mhat=fadd_s(mhat,dl); \
      _Pragma("unroll") for(int r=0;r<16;++r){P0[r]=fsub_s(P0[r],dl);P1[r]=fsub_s(P1[r],dl);} \
      _Pragma("unroll") for(int r=0;r<16;++r)negm[r]=-mhat; asm volatile("":"+v"(negm)); } \
    _Pragma("unroll") for(int r=0;r<16;++r)P0[r]=__builtin_amdgcn_exp2f(P0[r]); }while(0)
  #define RESC() do{ if(resc){ asm volatile("s_waitcnt lgkmcnt(0)":::"memory"); \
      _Pragma("unroll") for(int d_=0;d_<2;++d_) _Pragma("unroll") for(int r=0;r<16;++r)o[d_][r]*=wsf[crow(r,hi)]; } }while(0)
  f32x16 pA0,pA1,pB0,pB1;
  int sl_prev=0,sl_cur=0,sl_next=SLOTB;
  #define ROT() do{sl_prev=sl_cur;sl_cur=sl_next;sl_next=(sl_next==(NSLOT-1)*SLOTB)?0:sl_next+SLOTB;}while(0)
  DMA_K(2,2*SLOTB);
  WAIT_BAR(3);
  qkt(pA0,pA1,Kbase,qr,negm,r32,hi);asm volatile("s_nop 15\n\ts_nop 7":"+v"(pA0),"+v"(pA1));CMASK(pA0,pA1,0);
  START(pA0,pA1);
  _Pragma("unroll") for(int r=0;r<16;++r)pA1[r]=__builtin_amdgcn_exp2f(pA1[r]);
  WAIT_BAR(0);
  DMA_K(3,0);DMA_V(1,SLOTB);
  ROT();
  kload8(kf,kp0+sl_cur);
  WAIT_BAR(2);
  s16x4 vlo[8],vhi[8]; u32x4 pw0,pw1,pw2,pw3;
  #define PKW(P,B) cvtpk_s(P[B],P[B+1])
  #define PAF(k) __builtin_bit_cast(bf16x8,pw##k)
  #define VFR(i) (bf16x8){vlo[i][0],vlo[i][1],vlo[i][2],vlo[i][3],vhi[i][0],vhi[i][1],vhi[i][2],vhi[i][3]}
  #define PIN(x) asm volatile("":"+v"(x))
  #define MX3(a,b,c) __builtin_fmaxf(__builtin_fmaxf((a),(b)),(c))
  #define GAPA(MF,A0,A1,A2,A3,W0,W1,PW) do{ MF; sacc+=A0; sacc+=A1; sacc+=A2; sacc+=A3; PIN(sacc); W0; W1; PIN(PW); SBAR(); }while(0)
  #define EX(v) __builtin_amdgcn_exp2f(v)
  #define GAPB(MF,X,B) do{ MF; X[B]=EX(X[B]); X[B+1]=EX(X[B+1]); X[B+2]=EX(X[B+2]); X[B+3]=EX(X[B+3]); PIN(X); SBAR(); }while(0)
  #define VRD(i) do{ vlo[i]=vtr(vp_+(((i)>>2)*4096+((i)&3)*1024)); vhi[i]=vtr(vp_+(((i)>>2)*4096+((i)&3)*1024+512)); }while(0)
  #define KRD(G,j) do{ if(G){ kload2(kf,kp0+sl_next,j); SBAR(); } }while(0)
  #define STEP(C0,C1,P0,P1,t,GK,GV,GL) do{ SBAR(); \
    const lds_cptr vp_=vp0+sl_prev; \
    VRD(0); SBAR(); float sacc=(P0[0]+P0[1]); \
    GAPA(C0=__builtin_amdgcn_mfma_f32_32x32x16_bf16(kf[0],qr[0],negm,0,0,0), P0[2],P0[3],P0[4],P0[5],     pw0[0]=PKW(P0,0), pw0[1]=PKW(P0,2), pw0); \
    VRD(4); SBAR(); GAPA(C1=__builtin_amdgcn_mfma_f32_32x32x16_bf16(kf[1],qr[0],negm,0,0,0), P0[6],P0[7],P0[8],P0[9],     pw0[2]=PKW(P0,4), pw0[3]=PKW(P0,6), pw0); \
    VRD(1); SBAR(); GAPA(C0=__builtin_amdgcn_mfma_f32_32x32x16_bf16(kf[2],qr[1],C0,0,0,0),   P0[10],P0[11],P0[12],P0[13], pw1[0]=PKW(P0,8), pw1[1]=PKW(P0,10), pw1); \
    VRD(5); SBAR(); GAPA(C1=__builtin_amdgcn_mfma_f32_32x32x16_bf16(kf[3],qr[1],C1,0,0,0),   P0[14],P0[15],P1[0],P1[1],   pw1[2]=PKW(P0,12),pw1[3]=PKW(P0,14), pw1); \
    VRD(2); SBAR(); GAPA(C0=__builtin_amdgcn_mfma_f32_32x32x16_bf16(kf[4],qr[2],C0,0,0,0),   P1[2],P1[3],P1[4],P1[5],     pw2[0]=PKW(P1,0), pw2[1]=PKW(P1,2), pw2); \
    VRD(6); SBAR(); GAPA(C1=__builtin_amdgcn_mfma_f32_32x32x16_bf16(kf[5],qr[2],C1,0,0,0),   P1[6],P1[7],P1[8],P1[9],     pw2[2]=PKW(P1,4), pw2[3]=PKW(P1,6), pw2); \
    VRD(3); SBAR(); GAPA(C0=__builtin_amdgcn_mfma_f32_32x32x16_bf16(kf[6],qr[3],C0,0,0,0),   P1[10],P1[11],P1[12],P1[13], pw3[0]=PKW(P1,8), pw3[1]=PKW(P1,10), pw3); \
    VRD(7); SBAR(); GAPA(C1=__builtin_amdgcn_mfma_f32_32x32x16_bf16(kf[7],qr[3],C1,0,0,0),   P1[14],P1[15],0.f,0.f,       pw3[2]=PKW(P1,12),pw3[3]=PKW(P1,14), pw3); \
    l_reg+=sacc; \
    if(GK){DMA_K((t)+3,sl_cur);} if(GV){DMA_V((t)+1,sl_next);} \
    CMASK(C0,C1,t); \
    { float a=MX3(C0[0],C0[1],C1[0]),b=MX3(C0[2],C0[3],C1[1]); a=MX3(a,C1[2],C1[3]); \
      _Pragma("unroll") for(int r=4;r<16;r+=4){a=MX3(a,C0[r],C0[r+1]);b=MX3(b,C0[r+2],C0[r+3]);a=MX3(a,C1[r],C1[r+1]);b=MX3(b,C1[r+2],C1[r+3]);} \
      float rm=__builtin_fmaxf(a,b); { auto rr=__builtin_amdgcn_permlane32_swap(__float_as_uint(rm),__float_as_uint(rm),false,false); rm=__builtin_fmaxf(__uint_as_float(rr[0]),__uint_as_float(rr[1])); } \
      resc=false; \
      if(__builtin_expect(__any(rm>(float)THRL),0)){ const float dl=__builtin_fmaxf(rm,0.f); mhat+=dl; \
        _Pragma("unroll") for(int r=0;r<16;++r){C0[r]-=dl;C1[r]-=dl;} \
        _Pragma("unroll") for(int r=0;r<16;++r)negm[r]=-mhat; asm volatile("":"+v"(negm)); \
        const float f=__builtin_amdgcn_exp2f(-dl); l_reg*=f; if(hi==0)wsf[r32]=f; resc=true; } } \
    SBAR(); \
    GAPB(o[0]=__builtin_amdgcn_mfma_f32_32x32x16_bf16(PAF(0),VFR(0),o[0],0,0,0), C0,0); \
    GAPB(o[1]=__builtin_amdgcn_mfma_f32_32x32x16_bf16(PAF(0),VFR(4),o[1],0,0,0), C0,4); \
    KRD(GL,0); GAPB(o[0]=__builtin_amdgcn_mfma_f32_32x32x16_bf16(PAF(1),VFR(1),o[0],0,0,0), C0,8); \
    KRD(GL,1); GAPB(o[1]=__builtin_amdgcn_mfma_f32_32x32x16_bf16(PAF(1),VFR(5),o[1],0,0,0), C0,12); \
    KRD(GL,2); GAPB(o[0]=__builtin_amdgcn_mfma_f32_32x32x16_bf16(PAF(2),VFR(2),o[0],0,0,0), C1,0); \
    KRD(GL,3); GAPB(o[1]=__builtin_amdgcn_mfma_f32_32x32x16_bf16(PAF(2),VFR(6),o[1],0,0,0), C1,4); \
    GAPB(o[0]=__builtin_amdgcn_mfma_f32_32x32x16_bf16(PAF(3),VFR(3),o[0],0,0,0), C1,8); \
    GAPB(o[1]=__builtin_amdgcn_mfma_f32_32x32x16_bf16(PAF(3),VFR(7),o[1],0,0,0), C1,12); \
    }while(0)
  int t=1;
  for(;t+5<NT;t+=2){
    STEP(pB0,pB1,pA0,pA1,t,true,true,true);     WAIT_BAR(2); RESC(); ROT();
    STEP(pA0,pA1,pB0,pB1,t+1,true,true,true);   WAIT_BAR(2); RESC(); ROT();
  }
  #define ENDW(tt) do{ if((tt)+3<NT){WAIT_BAR(2);} else if((tt)+2<NT){WAIT_BAR(1);} else {WAIT_BAR(0);} }while(0)
  for(;t+1<NT;t+=2){
    STEP(pB0,pB1,pA0,pA1,t,(t+3<NT),(t+1<NT),(t+1<NT));       ENDW(t);   RESC(); ROT();
    STEP(pA0,pA1,pB0,pB1,t+1,(t+4<NT),(t+2<NT),(t+2<NT));     ENDW(t+1); RESC(); ROT();
  }
  STEP(pB0,pB1,pA0,pA1,NT-1,false,false,false); RESC();
  { float sacc=pB0[0]+pB0[1]; _Pragma("unroll") for(int r=2;r<16;++r)sacc+=pB0[r]; _Pragma("unroll") for(int r=0;r<16;++r)sacc+=pB1[r]; l_reg+=sacc;
    pw0=(u32x4){PKW(pB0,0),PKW(pB0,2),PKW(pB0,4),PKW(pB0,6)};pw1=(u32x4){PKW(pB0,8),PKW(pB0,10),PKW(pB0,12),PKW(pB0,14)};pw2=(u32x4){PKW(pB1,0),PKW(pB1,2),PKW(pB1,4),PKW(pB1,6)};pw3=(u32x4){PKW(pB1,8),PKW(pB1,10),PKW(pB1,12),PKW(pB1,14)};
    SBAR(); pv(o,vb0+sl_cur,PAF(0),PAF(1),PAF(2),PAF(3)); }
  #undef PKW
  #undef PAF
  #undef VFR
  #undef PIN
  #undef MX3
  #undef GAPA
  #undef GAPB
  #undef EX
  #undef VRD
  #undef KRD
  #undef STEP
  #undef ENDW
  {auto rr=__builtin_amdgcn_permlane32_swap(__float_as_uint(l_reg),__float_as_uint(l_reg),false,false);l_reg=__uint_as_float(rr[0])+__uint_as_float(rr[1]);}
  if(hi==0)wsf[32+r32]=l_reg;asm volatile("s_waitcnt lgkmcnt(0)":::"memory");
  float rli[16];
  #pragma unroll
  for(int r=0;r<16;++r)rli[r]=__builtin_amdgcn_rcpf(wsf[32+crow(r,hi)]);
  bf16*Ow=O+(rowbase+q0+wid*QBLK)*OP+h*D;
  { bf16*stg=(bf16*)(shm+LDS_OST)+wid*2048;
    #pragma unroll
    for(int r=0;r<16;++r){const int orow=crow(r,hi);
      #pragma unroll
      for(int d0=0;d0<2;++d0)stg[orow*64+d0*32+r32]=(bf16)f2bf(o[d0][r]*rli[r]);}
    asm volatile("s_waitcnt lgkmcnt(0)":::"memory");
    #pragma unroll
    for(int i=0;i<4;++i){const int row=i*8+(lane>>3),ch=lane&7; const u32x4 v=*(const u32x4*)(stg+row*64+ch*8); ATTN_STORE16(Ow+(long)row*OP+ch*8,v);} }
  asm volatile("s_waitcnt lgkmcnt(0)\n\ts_barrier":::"memory");
  #undef DMA_K
  #undef DMA_V
  #undef CMASK
  #undef START
  #undef RESC
  #undef ROT
}
constexpr int ATTN_LDS_BYTES=LDS_BYTES;
struct AttnTensors { const bf16* Q; const bf16* K; const bf16* V; bf16* O; };
template<int THRL=8> __device__ __forceinline__ void attn_phase(char*lds,const AttnTensors&T){
  const int G=gridDim.x, bx=blockIdx.x, v=(G%8==0)?(bx%8)*(G/8)+bx/8:bx;
  for(int u=v;u<16*12*8;u+=G){
    const int pair=(u%256)/4, j=((u%256)%4)*6+u/256;
    const int b=pair>>2, kh=pair&3, g=j>>3, qb=j&7;
    attn_unit<THRL>(b,kh*3+g,qb,T.Q,T.K,T.V,T.O,lds);
  }
}
#undef SBAR
#undef WAIT_BAR
}

__device__ __forceinline__ void pool_item(const Params& p, LAS unsigned char* lds, int item, bool stage_w) {
    const int tid = TIDX, lane = tid & 63, wid = tid >> 6, r16 = lane & 15, q = lane >> 4;
    const int gi = item & 3, tile = item >> 2, t0 = tile * 64, b = t0 / SEQ, tl0 = t0 % SEQ, half = 1 << gi;
    const bf16_t* Ub = (const bf16_t*)(p.ws + OFF_U);
    bf16_t* AO = (bf16_t*)(p.ws + OFF_AO);
    LAS bf16_t* us = (LAS bf16_t*)lds;
    LAS bf16_t* dl = (LAS bf16_t*)(lds + 11520);
    LAS bf16_t* wt = (LAS bf16_t*)(lds + 11520 + 9216);
    __syncthreads();
    for (int i = tid; i < 80 * 8; i += 256) {
        const int r = i >> 3, ch = i & 7, tl = tl0 - 8 + r;
        u32x4 v = {0u, 0u, 0u, 0u};
        if (tl >= 0 && tl < SEQ) v = *(const u32x4*)(Ub + (size_t)(b * SEQ + tl) * 256 + gi * 64 + ch * 8);
        *(LAS u32x4*)(us + r * 72 + ch * 8) = v;
    }
    if (stage_w) {
#pragma unroll 4
        for (int k = 0; k < 16; ++k) {
            const int i = tid + 256 * k, c = i >> 6, dd = i & 63;
            wt[dd * 72 + c] = (bf16_t)f2bf(p.pool_w[gi * 4096 + i] * p.pool_scale[gi * 64 + dd]);
        }
    }
    __syncthreads();
    {
        const int c = tid & 63, seg = tid >> 6;
        int tl = tl0 + seg * 16;
        float sm = 0.f;
        for (int r = max(tl - half, 0); r < min(tl + half, SEQ); ++r) sm += bf2f(us[(r - tl0 + 8) * 72 + c]);
#pragma unroll
        for (int k = 0; k < 16; ++k, ++tl) {
            if (k > 0) {
                if (tl + half <= SEQ) sm += bf2f(us[(tl + half - 1 - tl0 + 8) * 72 + c]);
                if (tl - half > 0) sm -= bf2f(us[(tl - half - 1 - tl0 + 8) * 72 + c]);
            }
            const int cntw = min(tl + half, SEQ) - max(tl - half, 0);
            dl[(seg * 16 + k) * 72 + c] = (bf16_t)f2bf(sm / (float)cntw - bf2f(us[(tl - tl0 + 8) * 72 + c]));
        }
    }
    __syncthreads();
    {
        f32x4 acc[4];
#pragma unroll
        for (int nb = 0; nb < 4; ++nb) acc[nb] = (f32x4){0.f, 0.f, 0.f, 0.f};
#pragma unroll
        for (int ks = 0; ks < 2; ++ks) {
            const bf16x8 db = *(const LAS bf16x8*)(dl + (wid * 16 + r16) * 72 + ks * 32 + q * 8);
#pragma unroll
            for (int nb = 0; nb < 4; ++nb) {
                const bf16x8 wa = *(const LAS bf16x8*)(wt + (nb * 16 + r16) * 72 + ks * 32 + q * 8);
                acc[nb] = __builtin_amdgcn_mfma_f32_16x16x32_bf16(wa, db, acc[nb], 0, 0, 0);
            }
        }
        bf16_t* orow = AO + (size_t)(t0 + wid * 16 + r16) * D + gi * 64 + 4 * q;
#pragma unroll
        for (int nb = 0; nb < 4; ++nb) { u32x2 w; w.x = pk2(acc[nb][0], acc[nb][1]); w.y = pk2(acc[nb][2], acc[nb][3]); *(u32x2*)(orow + nb * 16) = w; }
    }
}

__device__ __forceinline__ void phase_attn_pool(const Params& p, LAS unsigned char* lds, char* smem) {
    const attn_body::AttnTensors AT{(const bf16_t*)(p.ws + OFF_Q), (const bf16_t*)(p.ws + OFF_K), (const bf16_t*)(p.ws + OFF_V), (bf16_t*)(p.ws + OFF_AO) + 256};
    attn_body::attn_phase<8>(smem, AT);
    __syncthreads();
    constexpr int N_POOL = (T / 64) * 4;
    { bool first = true; for (int it = VBLK; it < N_POOL; it += NVBLK) { pool_item(p, lds, it, first); first = false; } }
}

struct EpiOut {
    static constexpr bool PERM = false;
    const float* x; float* y; const float* mod; float* stats;
    __device__ __forceinline__ void operator()(const f32x4 (&acc)[2][2][4][2], const pg8::Unit& u, int wr, int wc, int fr, int fq) const {
        const float* g1 = mod + (size_t)(u.pm >> 3) * MODW + 2 * D;
        const int col0 = u.pn * 256 + wc * 32 + fq * 4;
        f32x4 gv[2][2];
#pragma unroll
        for (int bj = 0; bj < 2; ++bj)
#pragma unroll
            for (int n = 0; n < 2; ++n) gv[bj][n] = *(const f32x4*)(g1 + col0 + bj * 128 + n * 16);
#pragma unroll
        for (int ai = 0; ai < 2; ++ai)
#pragma unroll
            for (int m = 0; m < 4; ++m) {
                const int row = u.pm * 256 + ai * 128 + wr * 64 + m * 16 + fr;
                float s1 = 0.f, s2 = 0.f;
#pragma unroll
                for (int bj = 0; bj < 2; ++bj)
#pragma unroll
                    for (int n = 0; n < 2; ++n) {
                        const size_t off = (size_t)row * D + col0 + bj * 128 + n * 16;
                        const f32x4 xv = *(const f32x4*)(x + off);
                        const f32x4 yv = xv * ALPHA + gv[bj][n] * acc[ai][bj][m][n];
                        *(f32x4*)(y + off) = yv;
                        s1 += (yv[0] + yv[1]) + (yv[2] + yv[3]);
                        s2 += (yv[0] * yv[0] + yv[1] * yv[1]) + (yv[2] * yv[2] + yv[3] * yv[3]);
                    }
                s1 += __shfl_xor(s1, 16); s1 += __shfl_xor(s1, 32);
                s2 += __shfl_xor(s2, 16); s2 += __shfl_xor(s2, 32);
                if (fq == 0) { float* st = stats + ((size_t)row * 16 + u.pn * 4 + wc) * 2; st[0] = s1; st[1] = s2; }
            }
    }
};
__device__ __forceinline__ void phase_outproj(const Params& p, LAS unsigned char* lds) {
    pg8::Gemm g{(const bf16_t*)(p.ws + OFF_AO), (const bf16_t*)(p.ws + OFF_WTOUT)};
    pg8::DenseSched S{4, 512, 512, 0, 1, (int)gridDim.x, vcu_of_block()};
    EpiOut E{p.x, p.out, (const float*)(p.ws + OFF_MOD), (float*)(p.ws + OFF_STATS)};
    pg8::gemm_phase<D, EpiOut, pg8::DenseSched, false>(lds, g, S, E);
}

__device__ __forceinline__ void phase_router(const Params& p, LAS unsigned char* lds0) {
    const int tid = hw_tid(), lane = tid & 63, wid = tid >> 6, r16 = lane & 15, q = lane >> 4;
    const float* mod = (const float*)(p.ws + OFF_MOD);
    const float* stats = (const float*)(p.ws + OFF_STATS);
    bf16_t* H = (bf16_t*)(p.ws + OFF_H);
    const bf16_t* WRH = (const bf16_t*)(p.ws + OFF_WRH); const bf16_t* WRL = (const bf16_t*)(p.ws + OFF_WRL);
    int* gcnt = (int*)(p.ws + OFF_CNT);
    int* LDST = (int*)(p.ws + OFF_LDST);
    float* LWt = (float*)(p.ws + OFF_LW);
    LAS float* vec = (LAS float*)lds0;
    LAS float* lg = (LAS float*)(lds0 + 16384) + wid * 16 * 64;
    LAS int* lcnt = (LAS int*)(lds0 + 49152);
    LAS int* lbase = (LAS int*)(lds0 + 49152 + 256);
    LAS int* sel_ep = (LAS int*)(lds0 + 49152 + 512);
    LAS float* sel_w = (LAS float*)(lds0 + 49152 + 512 + 4096);
    for (int item = blockIdx.x; item < T / 128; item += gridDim.x) {
        const int t0 = item * 128, b = t0 / SEQ, tw0 = t0 + wid * 16;
        __syncthreads();
        if (tid < 64) lcnt[tid] = 0;
        for (int i = tid; i < 1024; i += 512) {
            vec[i] = p.ln1_g[i]; vec[1024 + i] = p.ln1_b[i];
            vec[2048 + i] = 1.f + mod[(size_t)b * MODW + 4 * D + i]; vec[3072 + i] = mod[(size_t)b * MODW + 3 * D + i];
        }
        float meanv = 0.f, rstdv = 0.f;
        if (lane < 16) {
            float s1 = 0.f, s2 = 0.f;
            const float* st = stats + (size_t)(tw0 + lane) * 32;
#pragma unroll
            for (int i = 0; i < 16; ++i) { s1 += st[2 * i]; s2 += st[2 * i + 1]; }
            meanv = s1 * (1.f / D);
            const float var = fmaxf(s2 * (1.f / D) - meanv * meanv, 0.f);
            rstdv = 1.0f / sqrtf(var + 1e-5f);
        }
        const float mu = __shfl(meanv, r16), rs = __shfl(rstdv, r16);
        __syncthreads();
        f32x4 acc[4];
#pragma unroll
        for (int nb = 0; nb < 4; ++nb) acc[nb] = (f32x4){0.f, 0.f, 0.f, 0.f};
        float* yrow = p.out + (size_t)(tw0 + r16) * D + q * 8;
        bf16_t* hrow = H + (size_t)(tw0 + r16) * D + q * 8;
        LAS unsigned char* wb = lds0 + 57856;
        f32x4 vn[4][2];
#pragma unroll
        for (int u = 0; u < 4; ++u) { vn[u][0] = *(const f32x4*)(yrow + u * 32); vn[u][1] = *(const f32x4*)(yrow + u * 32 + 4); }
        for (int ch = 0; ch < 4; ++ch) {
            __syncthreads();
#pragma unroll
            for (int i = 0; i < 8; ++i) {
                const int idx = tid + i * 512, part = idx >> 11, row = (idx >> 5) & 63, c16 = idx & 31;
                const u32x4 w = *(const u32x4*)((part ? WRL : WRH) + (size_t)row * D + ch * 256 + c16 * 8);
                *(LAS u32x4*)(wb + part * 33792 + row * 528 + c16 * 16) = w;
            }
            __syncthreads();
#pragma unroll
            for (int s4 = ch * 8; s4 < ch * 8 + 8; s4 += 4) {
                f32x4 vv[4][2];
#pragma unroll
                for (int u = 0; u < 4; ++u) { vv[u][0] = vn[u][0]; vv[u][1] = vn[u][1]; }
                if (s4 + 4 < 32) {
#pragma unroll
                    for (int u = 0; u < 4; ++u) { vn[u][0] = *(const f32x4*)(yrow + (s4 + 4 + u) * 32); vn[u][1] = *(const f32x4*)(yrow + (s4 + 4 + u) * 32 + 4); }
                }
#pragma unroll
                for (int u = 0; u < 4; ++u) {
                    const int s = s4 + u, k0 = s * 32 + q * 8;
                    float hv[8];
#pragma unroll
                    for (int hh = 0; hh < 2; ++hh) {
                        const f32x4 g = *(const LAS f32x4*)(vec + k0 + 4 * hh), bb = *(const LAS f32x4*)(vec + 1024 + k0 + 4 * hh);
                        const f32x4 sc = *(const LAS f32x4*)(vec + 2048 + k0 + 4 * hh), sh = *(const LAS f32x4*)(vec + 3072 + k0 + 4 * hh);
                        const f32x4 xm = (vv[u][hh] - mu) * rs * g + bb;
                        *(f32x4*)(yrow + s * 32 + 4 * hh) = xm;
                        const f32x4 h4 = xm * sc + sh;
                        hv[4 * hh + 0] = h4[0]; hv[4 * hh + 1] = h4[1]; hv[4 * hh + 2] = h4[2]; hv[4 * hh + 3] = h4[3];
                    }
                    unsigned wh[4], wl[4];
#pragma unroll
                    for (int i = 0; i < 4; ++i) {
                        const unsigned ha = f2bf(hv[2 * i]), hb = f2bf(hv[2 * i + 1]);
                        wh[i] = ha | (hb << 16);
                        wl[i] = pk2(hv[2 * i] - bf2f(ha), hv[2 * i + 1] - bf2f(hb));
                    }
                    *(u32x4*)(hrow + s * 32) = (u32x4){wh[0], wh[1], wh[2], wh[3]};
                    const bf16x8 ah = __builtin_bit_cast(bf16x8, (u32x4){wh[0], wh[1], wh[2], wh[3]}), al = __builtin_bit_cast(bf16x8, (u32x4){wl[0], wl[1], wl[2], wl[3]});
                    const int kb = ((s & 7) * 32 + q * 8) * 2;
#pragma unroll
                    for (int nb = 0; nb < 4; ++nb) {
                        const bf16x8 bh = *(const LAS bf16x8*)(wb + (nb * 16 + r16) * 528 + kb), bl = *(const LAS bf16x8*)(wb + 33792 + (nb * 16 + r16) * 528 + kb);
                        acc[nb] = __builtin_amdgcn_mfma_f32_16x16x32_bf16(ah, bh, acc[nb], 0, 0, 0);
                        acc[nb] = __builtin_amdgcn_mfma_f32_16x16x32_bf16(al, bh, acc[nb], 0, 0, 0);
                        acc[nb] = __builtin_amdgcn_mfma_f32_16x16x32_bf16(ah, bl, acc[nb], 0, 0, 0);
                    }
                }
            }
        }
#pragma unroll
        for (int nb = 0; nb < 4; ++nb)
#pragma unroll
            for (int j = 0; j < 4; ++j) lg[(4 * q + j) * 64 + nb * 16 + r16] = acc[nb][j];
        __syncthreads();
        const float bias = p.router_bias[lane];
        for (int r = 0; r < 16; ++r) {
            const float lgv = lg[r * 64 + lane];
            const float sg = 1.0f / (1.0f + expf(-lgv));
            const float sel = sg + bias;
            float m1 = fmaxf(sel, __shfl_xor(sel, 1)); m1 = fmaxf(m1, __shfl_xor(m1, 2)); m1 = fmaxf(m1, __shfl_xor(m1, 4));
            int cand = (sel == m1) ? lane : 64;
            cand = min(cand, __shfl_xor(cand, 1)); cand = min(cand, __shfl_xor(cand, 2)); cand = min(cand, __shfl_xor(cand, 4));
            const float sel2 = (lane == cand) ? -INFINITY : sel;
            float m2 = fmaxf(sel2, __shfl_xor(sel2, 1)); m2 = fmaxf(m2, __shfl_xor(m2, 2)); m2 = fmaxf(m2, __shfl_xor(m2, 4));
            const float gs = m1 + m2;
            const int g = lane >> 3;
            int cntg = 0;
#pragma unroll
            for (int gg = 0; gg < 8; ++gg) { const float v = __shfl(gs, gg * 8); cntg += (v > gs || (v == gs && gg < g)) ? 1 : 0; }
            const bool keep = cntg < 4;
            const float msel = keep ? sel : -INFINITY;
            lg[r * 64 + lane] = msel;
            int cnt = 0;
#pragma unroll 4
            for (int q4 = 0; q4 < 16; ++q4) {
                const f32x4 v = *(const LAS f32x4*)(lg + r * 64 + q4 * 4);
#pragma unroll
                for (int i = 0; i < 4; ++i) cnt += (v[i] > msel || (v[i] == msel && (q4 * 4 + i) < lane)) ? 1 : 0;
            }
            const bool chosen = keep && cnt < 8;
            float wsum = chosen ? sg : 0.f;
#pragma unroll
            for (int o = 1; o < 64; o <<= 1) wsum += __shfl_xor(wsum, o);
            if (chosen) {
                const int pos = atomicAdd((int*)&lcnt[lane], 1);
                sel_ep[(wid * 16 + r) * 8 + cnt] = lane | (pos << 8);
                sel_w[(wid * 16 + r) * 8 + cnt] = sg / wsum * 2.5f;
            }
        }
        __syncthreads();
        if (tid < 64) { int tt = tid; asm volatile("" : "+v"(tt)); lbase[tt] = atomicAdd(&gcnt[tt], lcnt[tt]); }
        __syncthreads();
        for (int idx = tid; idx < 1024; idx += 512) {
            const int ep = sel_ep[idx], e = ep & 0xff, pos = ep >> 8, gi = lbase[e] + pos;
            LDST[(size_t)e * T + gi] = (t0 + (idx >> 3)) * NSLOT + (idx & 7);
            LWt[(size_t)e * T + gi] = sel_w[idx];
        }
    }
}

constexpr int LDS_ROWTAB = LDS_TAB, LDS_AUX = LDS_TAB + 12288, MOE_MAX_UNITS = 20, LDS_UTAB = LDS_CTL + 256, LDS_TSTART = LDS_UTAB + MOE_MAX_UNITS * 32;
__device__ __forceinline__ int moe_setup(const Params& p, LAS unsigned char* lds0, int nN, int bmul, int badd) {
    LAS int* tstart = (LAS int*)(lds0 + LDS_TSTART); LAS int* utab = (LAS int*)(lds0 + LDS_UTAB);
    const int* gcnt = (const int*)(p.ws + OFF_CNT);
    __syncthreads();
    if (hw_tid() == 0) {
        int a = 0;
        for (int e = 0; e < NEX; ++e) { const int c = e < NE ? gcnt[e] : T; tstart[e] = a; a += (c + 255) >> 8; }
        tstart[NEX] = a;
    }
    __syncthreads();
    const int total = tstart[NEX] * nN, G = gridDim.x, c = vcu_of_block();
    if (hw_tid() < MOE_MAX_UNITS) {
        const int i = hw_tid(), L = i * G + c;
        int pm = 0, pn = 0, e = 0, i0 = 0, cnt = 0;
        if (L < total) {
            const int mt = L / nN, pl = L % nN;
            for (int j = 1; j < NEX; ++j) e += (mt >= tstart[j]) ? 1 : 0;
            pm = mt; pn = e * bmul + badd + pl; i0 = (mt - tstart[e]) * 256; cnt = e < NE ? gcnt[e] : T;
        }
        utab[i * 8 + 0] = pm; utab[i * 8 + 1] = pn; utab[i * 8 + 2] = e; utab[i * 8 + 3] = i0; utab[i * 8 + 4] = cnt;
    }
    __syncthreads();
    const int n = (total - c + G - 1) / G;
    return n < 0 ? 0 : (n > MOE_MAX_UNITS ? MOE_MAX_UNITS : n);
}
struct MoeSched {
    LAS const int* utab; LAS const unsigned* rowtab; int n;
    __device__ __forceinline__ bool next(int i, pg8::Unit& u) const {
        if (i >= n) return false;
        u.pm = __builtin_amdgcn_readfirstlane(utab[i * 8 + 0]); u.pn = __builtin_amdgcn_readfirstlane(utab[i * 8 + 1]); u.e = __builtin_amdgcn_readfirstlane(utab[i * 8 + 2]); u.idx = i; return true;
    }
    __device__ __forceinline__ unsigned row_off(int i, int r) const { return rowtab[i * 256 + r]; }
    __device__ __forceinline__ void a_ready(const pg8::Unit&) const {}
    __device__ __forceinline__ void done(const pg8::Unit&) const {}
};
struct EpiGU {
    static constexpr bool PERM = true;
    LAS const float* auxw; unsigned char* ws;
    __device__ __forceinline__ void operator()(const f32x4 (&acc)[2][2][4][2], const pg8::Unit& u, int wr, int wc, int fr, int fq) const {
        const int pl = u.pn & 1;
        bf16_t* ACT = (bf16_t*)(ws + OFF_ACT) + (size_t)u.pm * 256 * FF + pl * 128 + wc * 32 + 8 * fq;
#pragma unroll
        for (int ai = 0; ai < 2; ++ai)
#pragma unroll
            for (int m = 0; m < 4; ++m) {
                const int rl = ai * 128 + wr * 64 + m * 16 + fr;
                const float wrow = auxw[u.idx * 256 + rl];
                float a[8];
#pragma unroll
                for (int n = 0; n < 2; ++n)
#pragma unroll
                    for (int q = 0; q < 4; ++q) { const float g = acc[ai][0][m][n][q], uu = acc[ai][1][m][n][q]; a[n * 4 + q] = g / (1.f + __expf(-g)) * uu * wrow; }
                u32x4 w; w.x = pk2(a[0], a[1]); w.y = pk2(a[2], a[3]); w.z = pk2(a[4], a[5]); w.w = pk2(a[6], a[7]);
                *(u32x4*)(ACT + (size_t)rl * FF) = w;
            }
    }
};
__device__ __forceinline__ void phase_gateup(const Params& p, LAS unsigned char* lds0) {
    int n = moe_setup(p, lds0, 2, 2, 0); n = n > 12 ? 12 : n;
    LAS const int* utab = (LAS const int*)(lds0 + LDS_UTAB);
    LAS unsigned* rowtab = (LAS unsigned*)(lds0 + LDS_ROWTAB);
    LAS float* auxw = (LAS float*)(lds0 + LDS_AUX);
    const int* LDST = (const int*)(p.ws + OFF_LDST);
    const float* LWt = (const float*)(p.ws + OFF_LW);
    for (int i = 0; i < n; ++i) {
        const int e = utab[i * 8 + 2], i0 = utab[i * 8 + 3], cnt = utab[i * 8 + 4];
        if (hw_tid() < 256) {
            const int li = i0 + hw_tid(); int tok = 0; float w = 0.f;
            if (li < cnt) { if (e < NE) { tok = LDST[(size_t)e * T + li] / NSLOT; w = LWt[(size_t)e * T + li]; } else { tok = li; w = 1.f; } }
            rowtab[i * 256 + hw_tid()] = (unsigned)tok * (unsigned)(D * 2);
            auxw[i * 256 + hw_tid()] = w;
        }
    }
    __syncthreads();
    MoeSched S{utab, rowtab, n};
    pg8::Gemm g{(const bf16_t*)(p.ws + OFF_H), (const bf16_t*)(p.ws + OFF_WGU)};
    EpiGU E{auxw, p.ws};
    pg8::gemm_phase<D, EpiGU, MoeSched, true>(lds0, g, S, E);
}
constexpr float FP8S = 32.f, FP8I = 1.f / 32.f;
__device__ __forceinline__ unsigned pk4_fp8(float a, float b, float c, float d) {
    a = __builtin_amdgcn_fmed3f(a * FP8S, -440.f, 440.f); b = __builtin_amdgcn_fmed3f(b * FP8S, -440.f, 440.f);
    c = __builtin_amdgcn_fmed3f(c * FP8S, -440.f, 440.f); d = __builtin_amdgcn_fmed3f(d * FP8S, -440.f, 440.f);
    int w = __builtin_amdgcn_cvt_pk_fp8_f32(a, b, 0, false);
    w = __builtin_amdgcn_cvt_pk_fp8_f32(c, d, w, true);
    return (unsigned)w;
}
struct EpiDown {
    static constexpr bool PERM = true;
    LAS const int* auxd; unsigned char* ws;
    __device__ __forceinline__ void operator()(const f32x4 (&acc)[2][2][4][2], const pg8::Unit& u, int wr, int wc, int fr, int fq) const {
        const int pl = u.pn & 3;
        unsigned char* SL = ws + OFF_SLOTS + pl * 256 + wc * 64 + 16 * fq;
#pragma unroll
        for (int ai = 0; ai < 2; ++ai)
#pragma unroll
            for (int m = 0; m < 4; ++m) {
                const int d = auxd[u.idx * 256 + ai * 128 + wr * 64 + m * 16 + fr];
                u32x4 w;
                w.x = pk4_fp8(acc[ai][0][m][0][0], acc[ai][0][m][0][1], acc[ai][0][m][0][2], acc[ai][0][m][0][3]);
                w.y = pk4_fp8(acc[ai][0][m][1][0], acc[ai][0][m][1][1], acc[ai][0][m][1][2], acc[ai][0][m][1][3]);
                w.z = pk4_fp8(acc[ai][1][m][0][0], acc[ai][1][m][0][1], acc[ai][1][m][0][2], acc[ai][1][m][0][3]);
                w.w = pk4_fp8(acc[ai][1][m][1][0], acc[ai][1][m][1][1], acc[ai][1][m][1][2], acc[ai][1][m][1][3]);
                *(u32x4*)(SL + (size_t)d * 1024) = w;
            }
    }
};
__device__ __forceinline__ void phase_down(const Params& p, LAS unsigned char* lds0) {
    const int n = moe_setup(p, lds0, 4, 4, 0);
    LAS const int* utab = (LAS const int*)(lds0 + LDS_UTAB);
    LAS int* auxd = (LAS int*)(lds0 + LDS_TAB);
    const int* LDST = (const int*)(p.ws + OFF_LDST);
    for (int i = 0; i < n; ++i) {
        const int e = utab[i * 8 + 2], i0 = utab[i * 8 + 3], cnt = utab[i * 8 + 4];
        if (hw_tid() < 256) {
            const int li = i0 + hw_tid();
            auxd[i * 256 + hw_tid()] = li < cnt ? (e < NE ? LDST[(size_t)e * T + li] : li * NSLOT + 8) : T * NSLOT;
        }
    }
    __syncthreads();
    MoeSched S{utab, (LAS const unsigned*)(lds0 + LDS_ROWTAB), n};
    pg8::Gemm g{(const bf16_t*)(p.ws + OFF_ACT), (const bf16_t*)(p.ws + OFF_WD)};
    EpiDown E{auxd, p.ws};
    pg8::gemm_phase<FF, EpiDown, MoeSched, false>(lds0, g, S, E);
}

__device__ __forceinline__ void slot_sum16(const unsigned char* SL, int t, int cb, float (&s)[16]) {
#pragma unroll
    for (int i = 0; i < 16; ++i) s[i] = 0.f;
    u32x4 v[NSLOT];
#pragma unroll
    for (int k = 0; k < NSLOT; ++k) v[k] = *(const u32x4*)(SL + (size_t)(t * NSLOT + k) * 1024 + cb);
#pragma unroll
    for (int k = 0; k < NSLOT; ++k)
#pragma unroll
        for (int i = 0; i < 4; ++i) {
            typedef float f32x2 __attribute__((ext_vector_type(2)));
            const f32x2 lo = __builtin_amdgcn_cvt_pk_f32_fp8((int)v[k][i], false), hi = __builtin_amdgcn_cvt_pk_f32_fp8((int)v[k][i], true);
            s[4 * i] += lo.x; s[4 * i + 1] += lo.y; s[4 * i + 2] += hi.x; s[4 * i + 3] += hi.y;
        }
#pragma unroll
    for (int i = 0; i < 16; ++i) s[i] *= FP8I;
}
__device__ __forceinline__ int slot_col(int bb) { return (bb >> 4) * 256 + ((bb >> 2) & 3) * 32 + (bb & 3) * 8; }
__device__ __forceinline__ void phase_final(const Params& p) {
    const int lane = hw_tid() & 63, gw = blockIdx.x * 8 + (hw_tid() >> 6), ngw = gridDim.x * 8;
    const float* mod = (const float*)(p.ws + OFF_MOD);
    const unsigned char* SL = p.ws + OFF_SLOTS;
    const int c0 = slot_col(lane);
    for (int row = gw; row < T; row += ngw) {
        const float* g2 = mod + (size_t)(row / SEQ) * MODW + 5 * D;
        float f[16];
        slot_sum16(SL, row, lane * 16, f);
        f32x4 y[4]; float s = 0.f;
#pragma unroll
        for (int j = 0; j < 4; ++j) {
            const int cj = c0 + (j >> 1) * 128 + (j & 1) * 4;
            const f32x4 xm = *(const f32x4*)(p.out + (size_t)row * D + cj), gg = *(const f32x4*)(g2 + cj);
            y[j][0] = ALPHA * xm[0] + gg[0] * f[4 * j]; y[j][1] = ALPHA * xm[1] + gg[1] * f[4 * j + 1];
            y[j][2] = ALPHA * xm[2] + gg[2] * f[4 * j + 2]; y[j][3] = ALPHA * xm[3] + gg[3] * f[4 * j + 3];
            s += (y[j][0] + y[j][1]) + (y[j][2] + y[j][3]);
        }
#pragma unroll
        for (int o = 1; o < 64; o <<= 1) s += __shfl_xor(s, o);
        const float mean = s * (1.f / D);
        float qv = 0.f;
#pragma unroll
        for (int j = 0; j < 4; ++j) { y[j] = y[j] - mean; qv += (y[j][0] * y[j][0] + y[j][1] * y[j][1]) + (y[j][2] * y[j][2] + y[j][3] * y[j][3]); }
#pragma unroll
        for (int o = 1; o < 64; o <<= 1) qv += __shfl_xor(qv, o);
        const float rstd = 1.0f / sqrtf(qv * (1.f / D) + 1e-5f);
#pragma unroll
        for (int j = 0; j < 4; ++j) {
            const int cj = c0 + (j >> 1) * 128 + (j & 1) * 4;
            const f32x4 g = *(const f32x4*)(p.ln2_g + cj), bb4 = *(const f32x4*)(p.ln2_b + cj);
            *(f32x4*)(p.out + (size_t)row * D + cj) = y[j] * rstd * g + bb4;
        }
    }
}

#define XB_TMO      128
#define XB_XCNT(j)  (256  + 64 * (j))
#define XB_XSUB(j)  (1280 + 64 * (j))
#define XB_XGEN(j)  (2304 + 64 * (j))
#define XB_TOP      3328
#define XB_TOPGEN   3392
#define XCD_BAR_WORDS 3456
#define XB_SPIN_CAP (1u << 18)
__device__ __forceinline__ unsigned xb_ld(unsigned* p)              { return __hip_atomic_load(p, __ATOMIC_RELAXED, __HIP_MEMORY_SCOPE_AGENT); }
__device__ __forceinline__ unsigned xb_add(unsigned* p, unsigned v) { return __hip_atomic_fetch_add(p, v, __ATOMIC_RELAXED, __HIP_MEMORY_SCOPE_AGENT); }
__device__ __forceinline__ unsigned xb_xcc_id() { return (unsigned)__builtin_amdgcn_s_getreg((3 << 11) | 20) & 0xFu; }
#define XB_SPIN(cond, bar) do { unsigned _sp = 0; while (cond) { __builtin_amdgcn_s_sleep(1); \
    if ((++_sp & 255u) == 0u) { if (xb_ld(&(bar)[XB_TMO])) break; if (_sp > XB_SPIN_CAP) { atomicAdd(&(bar)[XB_TMO], 1u); break; } } } } while (0)
struct XcdBarrier { unsigned* bar; unsigned x; volatile LAS unsigned* st; };
__device__ __forceinline__ XcdBarrier xcd_barrier_post(unsigned* bar, volatile LAS unsigned* st) {
    XcdBarrier b; b.bar = bar; b.x = xb_xcc_id(); b.st = st;
    if (hw_tid() == 0) (void)xb_add(&bar[XB_XCNT(b.x)], 1u);
    return b;
}
__device__ __forceinline__ void xcd_barrier_complete(unsigned* bar, unsigned x, unsigned& nloc, unsigned& nx) {
    const unsigned G = gridDim.x * gridDim.y * gridDim.z;
    unsigned sum, cnt, mine, sp = 0u;
    for (;;) {
        sum = 0u; cnt = 0u; mine = 0u;
#pragma unroll
        for (unsigned j = 0; j < 16; ++j) { const unsigned c = xb_ld(&bar[XB_XCNT(j)]); sum += c; cnt += (c > 0u) ? 1u : 0u; mine = (j == x) ? c : mine; }
        if (sum == G) break;
        __builtin_amdgcn_s_sleep(1);
        if ((++sp & 255u) == 0u) { if (xb_ld(&bar[XB_TMO])) break; if (sp > XB_SPIN_CAP) { atomicAdd(&bar[XB_TMO], 1u); break; } }
    }
    nloc = mine > 0u ? mine : 1u; nx = cnt > 0u ? cnt : 1u;
}
__device__ __forceinline__ void xcd_barrier(const XcdBarrier& b) {
    asm volatile("s_waitcnt vmcnt(0)" ::: "memory");
    __syncthreads();
    if (hw_tid() == 0) {
        unsigned* bar = b.bar;
        __builtin_amdgcn_s_waitcnt(0);
        unsigned nloc = b.st[0], nx = b.st[1];
        if (nloc == 0u) { xcd_barrier_complete(bar, b.x, nloc, nx); b.st[0] = nloc; b.st[1] = nx; }
        const unsigned old = xb_add(&bar[XB_XSUB(b.x)], 1u);
        const unsigned gen = old / nloc;
        if (old + 1u == (gen + 1u) * nloc) {
            __builtin_amdgcn_fence(__ATOMIC_RELEASE, "agent");
            asm volatile("s_waitcnt vmcnt(0)" ::: "memory");
            const unsigned og = xb_add(&bar[XB_TOP], 1u);
            const unsigned tg = og / nx;
            if (og + 1u == (tg + 1u) * nx) xb_add(&bar[XB_TOPGEN], 1u);
            else XB_SPIN(xb_ld(&bar[XB_TOPGEN]) == tg, bar);
            __builtin_amdgcn_fence(__ATOMIC_ACQUIRE, "agent");
            xb_add(&bar[XB_XGEN(b.x)], 1u);
            asm volatile("s_waitcnt vmcnt(0)" ::: "memory");
        } else {
            XB_SPIN(xb_ld(&bar[XB_XGEN(b.x)]) == gen, bar);
            __builtin_amdgcn_fence(__ATOMIC_ACQUIRE, "agent");
            asm volatile("s_waitcnt vmcnt(0)" ::: "memory");
        }
    }
    __syncthreads();
}

constexpr size_t OFF_BAR = 448 * 1024;

__global__ void __launch_bounds__(512, 2) mk_fwd(Params p) {
    extern __shared__ __attribute__((aligned(16))) unsigned char smem[];
    LAS unsigned char* lds0 = (LAS unsigned char*)smem;
    {
        const unsigned hw = (unsigned)__builtin_amdgcn_s_getreg((5 << 11) | 4) & 63u;
        if ((threadIdx.x & 63) == 0) *(volatile LAS int*)(LDS_HWTAB + hw * 4) = (int)(threadIdx.x >> 6);
        if (threadIdx.x < 64) ((LAS unsigned*)(lds0 + LDS_CTL))[threadIdx.x] = 0u;
    }
    __syncthreads();
    XcdBarrier bar; bar.bar = (unsigned*)(p.ws + OFF_BAR); bar.x = 0; bar.st = nullptr;
    bar = xcd_barrier_post((unsigned*)(p.ws + OFF_BAR), (volatile LAS unsigned*)(lds0 + LDS_CTL));
#ifndef PROBE
#define PROBE -1
#endif
#ifndef PROBE_END
#define PROBE_END (PROBE + 1)
#endif
    unsigned long long pt0 = 0, pt1 = 0;
#define RUN_PHASE(k, call) { if ((k) > 0) xcd_barrier(bar); if (PROBE >= 0 && (k) == PROBE) pt0 = __builtin_amdgcn_s_memrealtime(); if (PROBE >= 0 && (k) == PROBE_END) pt1 = __builtin_amdgcn_s_memrealtime(); \
    int on_ = 1; asm volatile("" : "+s"(on_)); if (on_) { int grp_ = hw_tid() >> 8; asm volatile("" : "+v"(grp_)); LAS unsigned char* lds = lds0 + grp_ * 32768; (void)lds; call; } }
    RUN_PHASE(0, phase_prep(p, lds))
    RUN_PHASE(1, phase_xn(p))
    RUN_PHASE(2, phase_inproj(p, lds0))
    RUN_PHASE(3, phase_attn_pool(p, lds, (char*)smem))
    RUN_PHASE(4, phase_outproj(p, lds0))
    RUN_PHASE(5, phase_router(p, lds0))
    RUN_PHASE(6, phase_gateup(p, lds0))
    RUN_PHASE(7, phase_down(p, lds0))
    RUN_PHASE(8, phase_final(p))
    if (PROBE >= 0) {
        if (PROBE_END == 9) pt1 = __builtin_amdgcn_s_memrealtime();
        if (blockIdx.x == 0 && hw_tid() == 0) { const unsigned long long tend = __builtin_amdgcn_s_memrealtime() + 8ull * (pt1 - pt0); while (__builtin_amdgcn_s_memrealtime() < tend) __builtin_amdgcn_s_sleep(8); }
    }
}

extern "C" void kernel_launch(void* const* d_in, const int* in_sizes, int n_in, void* d_out, int out_size, void* d_ws, size_t ws_size, hipStream_t stream) {
    static int grid = 0;
    if (grid == 0) {
        int dev = 0, cus = 0, per_cu = 0;
        (void)hipGetDevice(&dev);
        (void)hipDeviceGetAttribute(&cus, hipDeviceAttributeMultiprocessorCount, dev);
        (void)hipFuncSetAttribute((const void*)mk_fwd, hipFuncAttributeMaxDynamicSharedMemorySize, LDS_BYTES);
        (void)hipOccupancyMaxActiveBlocksPerMultiprocessor(&per_cu, (const void*)mk_fwd, 512, LDS_BYTES);
        if (per_cu < 1) fprintf(stderr, "kernel_launch: occupancy query says %d blocks per CU\n", per_cu);
        (void)hipGetLastError();
        grid = cus;
        if (ws_size < WS_NEED) fprintf(stderr, "kernel_launch: workspace too small: %zu < %zu\n", ws_size, (size_t)WS_NEED);
    }
    Params p{};
    const float** pp = (const float**)&p;
    for (int i = 0; i < 24; ++i) pp[i] = (const float*)d_in[i];
    p.out = (float*)d_out; p.ws = (unsigned char*)d_ws;
    (void)hipMemsetAsync((char*)d_ws + OFF_BAR, 0, XCD_BAR_WORDS * 4, stream);
    hipLaunchKernelGGL(mk_fwd, dim3(grid), dim3(512), LDS_BYTES, stream, p);
}
```

```cpp
#include <hip/hip_runtime.h>
#include <stdint.h>
#include <stdio.h>


#define LAS __attribute__((address_space(3)))
#define TIDX ((int)(hw_tid() & 255))
#define VBLK ((int)(blockIdx.x * 2 + (hw_tid() >> 8)))
#define NVBLK ((int)(gridDim.x * 2))
typedef unsigned short bf16_t;
typedef short bf16x8 __attribute__((ext_vector_type(8)));
typedef float f32x4 __attribute__((ext_vector_type(4)));
typedef unsigned u32x4 __attribute__((ext_vector_type(4)));
typedef unsigned u32x2 __attribute__((ext_vector_type(2)));

constexpr int D = 1024, NB = 16, SEQ = 2048, T = NB * SEQ, CTXL = 256, TC = NB * CTXL, KVL = CTXL + SEQ;
constexpr int PW = 1536, NE = 64, NEX = 65, FF = 256, NSLOT = 9, MODW = 6 * D;
constexpr float ALPHA = 1.189207115002721f;
constexpr float C2 = 0.125f * 1.4426950408889634f;
constexpr int NPHASE = 9;
constexpr int LDS_BYTES = 163840, LDS_TAB = 131072, LDS_CTL = 155648;
constexpr int LDS_HWTAB = LDS_CTL + 2048;
__device__ __forceinline__ int hw_tid() {
    const unsigned hw = (unsigned)__builtin_amdgcn_s_getreg((5 << 11) | 4) & 63u;
    const int w = __builtin_amdgcn_readfirstlane(*(volatile LAS int*)(LDS_HWTAB + hw * 4));
    return w * 64 + (int)__builtin_amdgcn_mbcnt_hi(~0u, __builtin_amdgcn_mbcnt_lo(~0u, 0u));
}

constexpr size_t MiB = 1u << 20;
constexpr size_t OFF_CNT = 0, OFF_MOD = 4096, OFF_ROPE = 512 * 1024;
constexpr size_t OFF_WTIN = 1 * MiB, OFF_WTOUT = 4 * MiB, OFF_WD = 6 * MiB, OFF_LDST = 39 * MiB, OFF_ACT = 47 * MiB;
constexpr size_t OFF_SLOTS = 201 * MiB;
constexpr size_t OFF_WGU = 201 * MiB, OFF_H = 266 * MiB, OFF_LW = 330 * MiB;
constexpr size_t OFF_XN = 47 * MiB, OFF_Q = 119 * MiB, OFF_K = 167 * MiB;
constexpr size_t OFF_V = 338 * MiB, OFF_U = 356 * MiB, OFF_AO = 372 * MiB, OFF_STATS = 436 * MiB;
constexpr size_t OFF_WRH = 490 * MiB, OFF_WRL = OFF_WRH + 128 * 1024;
constexpr size_t WS_NEED = 491 * MiB;

struct Params {
    const float *x, *c, *ctx, *c_ctx, *w_mod, *b_mod, *w_in, *q_norm, *k_norm, *pool_w, *pool_scale, *w_out, *ln1_g, *ln1_b,
        *w_router, *router_bias, *w_gate, *w_up, *w_down, *ws_gate, *ws_up, *ws_down, *ln2_g, *ln2_b;
    float* out;
    unsigned char* ws;
};

__device__ __forceinline__ unsigned f2bf(float f) { unsigned u = __float_as_uint(f); return (u + 0x7fffu + ((u >> 16) & 1u)) >> 16; }
__device__ __forceinline__ unsigned pk2(float lo, float hi) { return f2bf(lo) | (f2bf(hi) << 16); }
__device__ __forceinline__ float bf2f(unsigned h) { return __uint_as_float(h << 16); }
__device__ __forceinline__ float bflo(unsigned w) { return __uint_as_float(w << 16); }
__device__ __forceinline__ float bfhi(unsigned w) { return __uint_as_float(w & 0xffff0000u); }

namespace pg8 {
constexpr int BM = 256, BK = 64, HALF = 128, HTB = HALF * BK * 2, STAGE_BYTES = 8 * HTB;
__host__ __device__ __forceinline__ int lds_byte(int r, int c) { const int st = (r >> 4) * 2 + (c >> 5), rr = r & 15, cc = c & 31, ob = rr * 64 + cc * 2; return st * 1024 + (ob ^ (((ob >> 9) & 1) << 5)); }
__host__ __device__ __forceinline__ void stage_rc(int b, int& R, int& C) { const int st = b / 1024, sb = b % 1024, swz = sb ^ (((sb >> 9) & 1) << 5); R = (st >> 1) * 16 + swz / 64; C = (st & 1) * 32 + (swz % 64) / 2; }
__host__ __device__ __forceinline__ int perm32(int rho) { const int n = rho >> 4, i = rho & 15; return 8 * (i >> 2) + 4 * n + (i & 3); }
struct Unit { int pm, pn, idx, e; };
struct Gemm { const bf16_t* A; const bf16_t* Bt; };
__device__ __forceinline__ unsigned cvt_pk_bf16(float lo, float hi) { unsigned r; asm volatile("v_cvt_pk_bf16_f32 %0, %1, %2" : "=v"(r) : "v"(lo), "v"(hi)); return r; }

template <int K, class Epi, class Sched, bool GATHER, bool ALIGN_EPI = true>
__device__ __forceinline__ void gemm_phase(LAS unsigned char* lds, const Gemm g, const Sched& S, const Epi& E) {
    const int tid = hw_tid(), wid = __builtin_amdgcn_readfirstlane(tid >> 6), lane = tid & 63, wr = wid >> 2, wc = wid & 3, fr = lane & 15, fq = lane >> 4;
    constexpr int nt = K / BK;
    unsigned voffA[2], voffB[2], colA = 0; int rowA = 0;
#pragma unroll
    for (int i = 0; i < 2; ++i) { int R, C; stage_rc(tid * 16 + i * 8192, R, C); const int Rb = Epi::PERM ? ((R & ~31) + perm32(R & 31)) : R;
        voffA[i] = (unsigned)(R * K + C) * 2u; voffB[i] = (unsigned)(Rb * K + C) * 2u; if (i == 0) { colA = (unsigned)C * 2u; rowA = R; } }
    const size_t kstep = (size_t)(BK * 2);
    const size_t hstep = (size_t)HALF * K * 2;
    const size_t tstep = 2 * hstep;
    const unsigned ldsw = (unsigned)wid * 1024u;
    const int aoff = lds_byte(wr * 64 + fr, fq * 8), boff = lds_byte(wc * 32 + fr, fq * 8);
#define PG8_SA(b, h) (((b) * 2 + (h)) * HTB)
#define PG8_SB(b, h) ((4 + (b) * 2 + (h)) * HTB)
#define PG8_STAGE(bufoff, gbase, voff) do { _Pragma("unroll") for (int _i = 0; _i < 2; ++_i) \
        __builtin_amdgcn_global_load_lds((const unsigned*)((const char*)(gbase) + (voff)[_i]), (LAS unsigned*)(lds + (bufoff) + ldsw + _i * 8192), 16, 0, 0); } while (0)
#define PG8_STAGE_A(bufoff, ptr, h, NX) do { if constexpr (GATHER) { unsigned _v[2]; \
            if (NX) { _v[0] = S.row_off(nidx, (h) * HALF + rowA) + colA; _v[1] = S.row_off(nidx, (h) * HALF + rowA + 64) + colA; } else { _v[0] = vA[h][0]; _v[1] = vA[h][1]; } PG8_STAGE(bufoff, ptr, _v); } \
        else { PG8_STAGE(bufoff, (ptr) + (h) * hstep, voffA); } } while (0)
#define PG8_LDA(dst, b, h) do { _Pragma("unroll") for (int m = 0; m < 4; ++m) _Pragma("unroll") for (int k = 0; k < 2; ++k) dst[m][k] = *(const LAS bf16x8*)(lds + PG8_SA(b, h) + aoff + m * 2048 + k * 1024); } while (0)
#define PG8_LDB(dst, b, h) do { _Pragma("unroll") for (int n = 0; n < 2; ++n) _Pragma("unroll") for (int k = 0; k < 2; ++k) dst[n][k] = *(const LAS bf16x8*)(lds + PG8_SB(b, h) + boff + n * 2048 + k * 1024); } while (0)
#define PG8_MMA(ai, bj, At, Bt) do { __builtin_amdgcn_s_setprio(1); _Pragma("unroll") for (int m = 0; m < 4; ++m) _Pragma("unroll") for (int n = 0; n < 2; ++n) _Pragma("unroll") for (int k = 0; k < 2; ++k) \
        acc[ai][bj][m][n] = __builtin_amdgcn_mfma_f32_16x16x32_bf16(Bt[n][k], At[m][k], acc[ai][bj][m][n], 0, 0, 0); __builtin_amdgcn_s_setprio(0); } while (0)
#define PG8_WAIT_V(n) asm volatile("s_waitcnt vmcnt(" #n ")" ::: "memory")
#define PG8_WAIT_L(n) asm volatile("s_waitcnt lgkmcnt(" #n ")" ::: "memory")
#define PG8_BAR __builtin_amdgcn_s_barrier()
#define PG8_SCHED __builtin_amdgcn_sched_barrier(0)
    Unit cur, nxt; int ui = 0;
    if (!S.next(0, cur)) return;
    f32x4 acc[2][2][4][2];
#pragma unroll
    for (int a = 0; a < 2; ++a)
#pragma unroll
        for (int b = 0; b < 2; ++b)
#pragma unroll
            for (int m = 0; m < 4; ++m)
#pragma unroll
                for (int n = 0; n < 2; ++n) acc[a][b][m][n] = (f32x4){0.f, 0.f, 0.f, 0.f};
    bf16x8 At[4][2], B0[2][2], B1[2][2];
    unsigned vA[2][2]; int nidx = 0;
    if constexpr (GATHER) {
#pragma unroll
        for (int h = 0; h < 2; ++h)
#pragma unroll
            for (int i = 0; i < 2; ++i) vA[h][i] = S.row_off(cur.idx, h * HALF + rowA + 64 * i) + colA;
    }
    const char* cA = GATHER ? (const char*)g.A : (const char*)g.A + (size_t)cur.pm * tstep; const char* cB = (const char*)g.Bt + (size_t)cur.pn * tstep;
    S.a_ready(cur);
    PG8_STAGE(PG8_SB(0, 0), cB, voffB); PG8_STAGE(PG8_SB(0, 1), cB + hstep, voffB); PG8_STAGE_A(PG8_SA(0, 0), cA, 0, false); PG8_STAGE_A(PG8_SA(0, 1), cA, 1, false);
    if (wr == 1) PG8_BAR;
    PG8_WAIT_V(2); PG8_BAR;
    PG8_STAGE(PG8_SB(1, 0), cB + kstep, voffB); PG8_STAGE_A(PG8_SA(1, 0), cA + kstep, 0, false); PG8_STAGE(PG8_SB(1, 1), cB + hstep + kstep, voffB);
    PG8_WAIT_V(6); PG8_BAR;
    for (;;) {
        const bool has_next = S.next(ui + 1, nxt);
        if constexpr (GATHER) nidx = has_next ? nxt.idx : cur.idx;
        const char* nA = GATHER ? (const char*)g.A : (has_next ? (const char*)g.A + (size_t)nxt.pm * tstep : cA); const char* nB = has_next ? (const char*)g.Bt + (size_t)nxt.pn * tstep : cB;
        for (int t = 0; t < nt; t += 2) {
            const bool last = (t == nt - 2);
            const char* a1 = cA + (size_t)(t + 1) * kstep;
            const char* a2 = last ? nA : cA + (size_t)(t + 2) * kstep; const char* b2 = last ? nB : cB + (size_t)(t + 2) * kstep;
            const char* a3 = a2 + kstep; const char* b3 = b2 + kstep;
            if (last && has_next) S.a_ready(nxt);
            PG8_LDB(B0, 0, 0); PG8_LDB(B1, 0, 1); PG8_SCHED; PG8_LDA(At, 0, 0); PG8_STAGE_A(PG8_SA(1, 1), a1, 1, false);
            PG8_WAIT_V(8); PG8_WAIT_L(0); PG8_BAR; PG8_MMA(0, 0, At, B0); PG8_MMA(0, 1, At, B1); PG8_BAR; PG8_SCHED;
            PG8_LDA(At, 0, 1); PG8_STAGE(PG8_SB(0, 0), b2, voffB); PG8_STAGE(PG8_SB(0, 1), b2 + hstep, voffB); PG8_STAGE_A(PG8_SA(0, 0), a2, 0, last);
            PG8_WAIT_V(8); PG8_WAIT_L(0); PG8_BAR; PG8_MMA(1, 0, At, B0); PG8_MMA(1, 1, At, B1); PG8_BAR; PG8_SCHED;
            PG8_LDB(B0, 1, 0); PG8_LDB(B1, 1, 1); PG8_SCHED; PG8_LDA(At, 1, 0); PG8_STAGE_A(PG8_SA(0, 1), a2, 1, last);
            PG8_WAIT_V(8); PG8_WAIT_L(0); PG8_BAR; PG8_MMA(0, 0, At, B0); PG8_MMA(0, 1, At, B1); PG8_BAR; PG8_SCHED;
            PG8_LDA(At, 1, 1); PG8_STAGE(PG8_SB(1, 0), b3, voffB); PG8_STAGE(PG8_SB(1, 1), b3 + hstep, voffB); PG8_STAGE_A(PG8_SA(1, 0), a3, 0, last);
            PG8_WAIT_V(8); PG8_WAIT_L(0); PG8_BAR; PG8_MMA(1, 0, At, B0); PG8_MMA(1, 1, At, B1); PG8_BAR; PG8_SCHED;
        }
        if constexpr (ALIGN_EPI) { if (wr == 0) PG8_BAR; }
        E(acc, cur, wr, wc, fr, fq); S.done(cur);
        if (!has_next) break;
#pragma unroll
        for (int a = 0; a < 2; ++a)
#pragma unroll
            for (int b = 0; b < 2; ++b)
#pragma unroll
                for (int m = 0; m < 4; ++m)
#pragma unroll
                    for (int n = 0; n < 2; ++n) acc[a][b][m][n] = (f32x4){0.f, 0.f, 0.f, 0.f};
        cur = nxt; cA = nA; cB = nB; ++ui;
        if constexpr (GATHER) {
#pragma unroll
            for (int h = 0; h < 2; ++h)
#pragma unroll
                for (int i = 0; i < 2; ++i) vA[h][i] = S.row_off(cur.idx, h * HALF + rowA + 64 * i) + colA;
        }
        if constexpr (ALIGN_EPI) { if (wr == 1) PG8_BAR; }
    }
    PG8_WAIT_V(0);
    if constexpr (!ALIGN_EPI) { if (wr == 0) PG8_BAR; }
    PG8_BAR;
#undef PG8_SA
#undef PG8_SB
#undef PG8_STAGE
#undef PG8_STAGE_A
#undef PG8_LDA
#undef PG8_LDB
#undef PG8_MMA
#undef PG8_WAIT_V
#undef PG8_WAIT_L
#undef PG8_BAR
#undef PG8_SCHED
}

struct DenseSched {
    int nN, n1, total, pn2lo, nN2, G, c;
    __device__ __forceinline__ bool next(int i, Unit& u) const {
        const int L = i * G + c; if (L >= total) return false;
        if (L < n1) { u.pm = L / nN; u.pn = L % nN; } else { const int r = L - n1; u.pm = n1 / nN + r / nN2; u.pn = pn2lo + r % nN2; }
        u.idx = i; u.e = 0; return true;
    }
    __device__ __forceinline__ void a_ready(const Unit&) const {}
    __device__ __forceinline__ void done(const Unit&) const {}
};
}

__device__ __forceinline__ int win_row(int n) { return (n & ~255) + 128 * ((n >> 5) & 1) + 32 * ((n >> 6) & 3) + (n & 31); }
__device__ __forceinline__ int gu_row(int j, int half) { return (j >> 7) * 256 + half * 128 + (j & 127); }

template <class RowMap>
__device__ __forceinline__ void transpose_tile(LAS float* tile, const float* src, int ld, int k0, int n0, bf16_t* dst, int Kdst, RowMap rowmap) {
    const int tid = TIDX;
#pragma unroll
    for (int pss = 0; pss < 4; ++pss) {
        const int k = pss * 16 + (tid >> 4), n4 = (tid & 15) * 4;
        const f32x4 v = *(const f32x4*)(src + (size_t)(k0 + k) * ld + n0 + n4);
        tile[k * 65 + n4 + 0] = v[0]; tile[k * 65 + n4 + 1] = v[1]; tile[k * 65 + n4 + 2] = v[2]; tile[k * 65 + n4 + 3] = v[3];
    }
    __syncthreads();
    {
        const int n = tid >> 2, kc = (tid & 3) * 16;
        unsigned w[8];
#pragma unroll
        for (int i = 0; i < 8; ++i) w[i] = pk2(tile[(kc + 2 * i) * 65 + n], tile[(kc + 2 * i + 1) * 65 + n]);
        bf16_t* dp = dst + (size_t)rowmap(n0 + n) * Kdst + k0 + kc;
        *(u32x4*)dp = (u32x4){w[0], w[1], w[2], w[3]};
        *(u32x4*)(dp + 8) = (u32x4){w[4], w[5], w[6], w[7]};
    }
    __syncthreads();
}

template <class RowMap>
__device__ __forceinline__ void wave_transpose(LAS float* scr, const float* src, int ld, int k0, int n0, bf16_t* dst, int Kdst, RowMap rowmap, int lane) {
#pragma unroll
    for (int i = 0; i < 8; ++i) {
        const int kk = 8 * i + (lane >> 3), n4 = (lane & 7) * 4;
        const f32x4 v = *(const f32x4*)(src + (size_t)(k0 + kk) * ld + n0 + n4);
        scr[kk * 33 + n4] = v[0]; scr[kk * 33 + n4 + 1] = v[1]; scr[kk * 33 + n4 + 2] = v[2]; scr[kk * 33 + n4 + 3] = v[3];
    }
    asm volatile("s_waitcnt lgkmcnt(0)" ::: "memory");
    const int c = lane & 7;
#pragma unroll
    for (int j = 0; j < 4; ++j) {
        const int n = (lane >> 3) + 8 * j; const LAS float* sp = scr + (8 * c) * 33 + n;
        u32x4 o; o.x = pk2(sp[0], sp[33]); o.y = pk2(sp[2 * 33], sp[3 * 33]); o.z = pk2(sp[4 * 33], sp[5 * 33]); o.w = pk2(sp[6 * 33], sp[7 * 33]);
        *(u32x4*)(dst + (size_t)rowmap(n0 + n) * Kdst + k0 + 8 * c) = o;
    }
    asm volatile("s_waitcnt lgkmcnt(0)" ::: "memory");
}

__device__ __forceinline__ void phase_prep(const Params& p, LAS unsigned char* lds) {
    const int tid = TIDX;
    int* gcnt = (int*)(p.ws + OFF_CNT);
    if (VBLK == 0 && tid < 128) gcnt[tid] = 0;
    float* mod = (float*)(p.ws + OFF_MOD);
    float* rope = (float*)(p.ws + OFF_ROPE);
    constexpr int N_MOD = 384, N_ROPE = 256, N_TR = 16;
    for (int it = VBLK; it < N_MOD + N_ROPE + N_TR; it += NVBLK) {
        if (it < N_MOD) {
            LAS float* sl = (LAS float*)lds;
            LAS float* red = (LAS float*)(lds + 10240);
            const int col = it * 16 + (tid & 15), kk = tid >> 4;
            float acc[17];
#pragma unroll
            for (int r = 0; r < 17; ++r) acc[r] = 0.f;
            for (int kc = 0; kc < 8; ++kc) {
                float wv[8];
#pragma unroll
                for (int i = 0; i < 8; ++i) wv[i] = p.w_mod[(size_t)(kc * 128 + kk + 16 * i) * MODW + col];
                __syncthreads();
                for (int o = tid; o < 17 * 128; o += 256) {
                    const int r = o >> 7, kl = o & 127;
                    const float cv = (r < 16) ? p.c[r * D + kc * 128 + kl] : p.c_ctx[kc * 128 + kl];
                    sl[kl * 20 + r] = cv / (1.f + expf(-cv));
                }
                __syncthreads();
#pragma unroll
                for (int i = 0; i < 8; ++i) {
                    const int kl = kk + 16 * i;
                    const f32x4 s0 = *(const LAS f32x4*)(sl + kl * 20), s1 = *(const LAS f32x4*)(sl + kl * 20 + 4), s2 = *(const LAS f32x4*)(sl + kl * 20 + 8), s3 = *(const LAS f32x4*)(sl + kl * 20 + 12);
                    const float s4 = sl[kl * 20 + 16];
#pragma unroll
                    for (int q = 0; q < 4; ++q) { acc[q] += s0[q] * wv[i]; acc[4 + q] += s1[q] * wv[i]; acc[8 + q] += s2[q] * wv[i]; acc[12 + q] += s3[q] * wv[i]; }
                    acc[16] += s4 * wv[i];
                }
            }
#pragma unroll
            for (int r = 0; r < 17; ++r) red[(kk * 17 + r) * 16 + (tid & 15)] = acc[r];
            __syncthreads();
            for (int o = tid; o < 17 * 16; o += 256) {
                const int r = o >> 4, j = o & 15;
                float sm = p.b_mod[it * 16 + j];
#pragma unroll
                for (int g = 0; g < 16; ++g) sm += red[(g * 17 + r) * 16 + j];
                mod[r * MODW + it * 16 + j] = sm;
            }
            __syncthreads();
        } else if (it < N_MOD + N_ROPE) {
            const int idx = (it - N_MOD) * 256 + tid, t = idx >> 5, i = idx & 31;
            const int pos = (i < 16) ? (t >> 6) : (t & 63);
            const float invf = (float)exp(-(double)(i & 15) / 16.0 * 9.210340371976184);
            const double ang = (double)((float)pos * invf);
            rope[idx * 2 + 0] = (float)cos(ang);
            rope[idx * 2 + 1] = (float)sin(ang);
        } else {
            LAS float* tile = (LAS float*)lds;
            const int idx = it - N_MOD - N_ROPE;
            {

                const int k0 = idx * 64;
#pragma unroll
                for (int pss = 0; pss < 4; ++pss) {
                    const int k = pss * 16 + (tid >> 4), n4 = (tid & 15) * 4;
                    const f32x4 v = *(const f32x4*)(p.w_router + (size_t)(k0 + k) * NE + n4);
                    tile[k * 65 + n4 + 0] = v[0]; tile[k * 65 + n4 + 1] = v[1]; tile[k * 65 + n4 + 2] = v[2]; tile[k * 65 + n4 + 3] = v[3];
                }
                __syncthreads();
                {
                    const int n = tid >> 2, kc = (tid & 3) * 16;
                    unsigned wh[8], wl[8];
#pragma unroll
                    for (int i = 0; i < 8; ++i) {
                        const float a = tile[(kc + 2 * i) * 65 + n], b = tile[(kc + 2 * i + 1) * 65 + n];
                        const unsigned ha = f2bf(a), hb = f2bf(b);
                        wh[i] = ha | (hb << 16);
                        wl[i] = pk2(a - bf2f(ha), b - bf2f(hb));
                    }
                    bf16_t* dh = (bf16_t*)(p.ws + OFF_WRH) + (size_t)n * D + k0 + kc;
                    bf16_t* dl = (bf16_t*)(p.ws + OFF_WRL) + (size_t)n * D + k0 + kc;
                    *(u32x4*)dh = (u32x4){wh[0], wh[1], wh[2], wh[3]}; *(u32x4*)(dh + 8) = (u32x4){wh[4], wh[5], wh[6], wh[7]};
                    *(u32x4*)dl = (u32x4){wl[0], wl[1], wl[2], wl[3]}; *(u32x4*)(dl + 8) = (u32x4){wl[4], wl[5], wl[6], wl[7]};
                }
                __syncthreads();
            }
        }
    }
    __syncthreads();
    {
        const int lane = hw_tid() & 63, wv = hw_tid() >> 6;
        LAS float* scr = (LAS float*)(lds - (hw_tid() >> 8) * 32768) + wv * (64 * 33);
        constexpr int I_IN = 16 * 48, I_OUT = 16 * 32, I_E = 384, NITEMS = I_IN + I_OUT + NEX * I_E;
        for (int it = blockIdx.x * 8 + wv; it < NITEMS; it += gridDim.x * 8) {
            int r = it;
            if (r < I_IN) { wave_transpose(scr, p.w_in, PW, (r / 48) * 64, (r % 48) * 32, (bf16_t*)(p.ws + OFF_WTIN), D, [](int n) { return win_row(n); }, lane); continue; }
            r -= I_IN;
            if (r < I_OUT) { wave_transpose(scr, p.w_out, D, (r / 32) * 64, (r % 32) * 32, (bf16_t*)(p.ws + OFF_WTOUT), D, [](int n) { return n; }, lane); continue; }
            r -= I_OUT;
            const int e = r / I_E, q = r % I_E;
            if (q < 256) {
                const int half = q >> 7, rr = q & 127;
                const float* src = half ? (e < NE ? p.w_up + (size_t)e * D * FF : p.ws_up) : (e < NE ? p.w_gate + (size_t)e * D * FF : p.ws_gate);
                wave_transpose(scr, src, FF, (rr / 8) * 64, (rr % 8) * 32, (bf16_t*)(p.ws + OFF_WGU) + (size_t)e * 512 * D, D, [half](int n) { return gu_row(n, half); }, lane);
            } else {
                const int rr = q - 256;
                const float* src = e < NE ? p.w_down + (size_t)e * FF * D : p.ws_down;
                wave_transpose(scr, src, D, (rr / 32) * 64, (rr % 32) * 32, (bf16_t*)(p.ws + OFF_WD) + (size_t)e * D * FF, FF, [](int n) { return n; }, lane);
            }
        }
    }
}

__device__ __forceinline__ void phase_xn(const Params& p) {
    const int lane = TIDX & 63, gw = VBLK * 4 + (TIDX >> 6), ngw = NVBLK * 4;
    const float* mod = (const float*)(p.ws + OFF_MOD);
    bf16_t* XN = (bf16_t*)(p.ws + OFF_XN);
    for (int row = gw; row < T + TC; row += ngw) {
        const float* src = row < T ? p.x + (size_t)row * D : p.ctx + (size_t)(row - T) * D;
        const float* mr = mod + (size_t)(row < T ? row / SEQ : 16) * MODW;
#pragma unroll
        for (int j = 0; j < 4; ++j) {
            const int c = 4 * lane + 256 * j;
            const f32x4 v = *(const f32x4*)(src + c), sh = *(const f32x4*)(mr + c), sc = *(const f32x4*)(mr + D + c);
            u32x2 o; o.x = pk2(v[0] * (1.f + sc[0]) + sh[0], v[1] * (1.f + sc[1]) + sh[1]); o.y = pk2(v[2] * (1.f + sc[2]) + sh[2], v[3] * (1.f + sc[3]) + sh[3]);
            *(u32x2*)(XN + (size_t)row * D + c) = o;
        }
    }
}

struct EpiIn {
    static constexpr bool PERM = true;
    const float *q_norm, *k_norm, *rope; bf16_t *Qb, *Kb, *Vb, *Ub;
    __device__ __forceinline__ void operator()(const f32x4 (&acc)[2][2][4][2], const pg8::Unit& u, int wr, int wc, int fr, int fq) const {
        const int grp = u.pn * 4 + wc;
        const bool is_ctx = u.pm >= T / 256;
        f32x4 gn[2][2];
        if (grp >= 4 && grp < 20) {
            const float* g = grp < 16 ? q_norm : k_norm;
#pragma unroll
            for (int bj = 0; bj < 2; ++bj)
#pragma unroll
                for (int n = 0; n < 2; ++n) gn[bj][n] = *(const f32x4*)(g + 32 * bj + 8 * fq + 4 * n);
        }
#pragma unroll
        for (int ai = 0; ai < 2; ++ai)
#pragma unroll
            for (int m = 0; m < 4; ++m) {
                const int row = u.pm * 256 + ai * 128 + wr * 64 + m * 16 + fr;
                f32x4 v[2][2];
#pragma unroll
                for (int bj = 0; bj < 2; ++bj)
#pragma unroll
                    for (int n = 0; n < 2; ++n) v[bj][n] = acc[ai][bj][m][n];
                bf16_t* dst;
                if (grp < 4) dst = Ub + (size_t)row * 256 + grp * 64;
                else if (grp < 16) dst = Qb + (size_t)row * 768 + (grp - 4) * 64;
                else {
                    const size_t krow = is_ctx ? (size_t)((row - T) >> 8) * KVL + ((row - T) & 255) : (size_t)(row >> 11) * KVL + CTXL + (row & (SEQ - 1));
                    dst = (grp < 20 ? Kb + (grp - 16) * 64 : Vb + (grp - 20) * 64) + krow * 256;
                }
                if (grp >= 4 && grp < 20) {
                    float ss = 0.f;
#pragma unroll
                    for (int bj = 0; bj < 2; ++bj)
#pragma unroll
                        for (int n = 0; n < 2; ++n) ss += (v[bj][n][0] * v[bj][n][0] + v[bj][n][1] * v[bj][n][1]) + (v[bj][n][2] * v[bj][n][2] + v[bj][n][3] * v[bj][n][3]);
                    ss += __shfl_xor(ss, 16); ss += __shfl_xor(ss, 32);
                    const float rs = 1.0f / sqrtf(ss * (1.f / 64.f) + 1e-6f);
#pragma unroll
                    for (int bj = 0; bj < 2; ++bj)
#pragma unroll
                        for (int n = 0; n < 2; ++n) v[bj][n] = v[bj][n] * rs * gn[bj][n];
                    if (!is_ctx) {
                        const int tpos = row & (SEQ - 1);
#pragma unroll
                        for (int bj = 0; bj < 2; ++bj)
#pragma unroll
                            for (int n = 0; n < 2; ++n) {
                                const f32x4 cs = *(const f32x4*)(rope + (size_t)(tpos * 32 + 16 * bj + 4 * fq + 2 * n) * 2);
                                const f32x4 x = v[bj][n];
                                v[bj][n] = (f32x4){x[0] * cs[0] - x[1] * cs[1], x[0] * cs[1] + x[1] * cs[0], x[2] * cs[2] - x[3] * cs[3], x[2] * cs[3] + x[3] * cs[2]};
                            }
                    }
                    if (grp < 16) {
#pragma unroll
                        for (int bj = 0; bj < 2; ++bj)
#pragma unroll
                            for (int n = 0; n < 2; ++n) v[bj][n] = v[bj][n] * C2;
                    }
                }
#pragma unroll
                for (int bj = 0; bj < 2; ++bj) {
                    u32x4 w; w.x = pk2(v[bj][0][0], v[bj][0][1]); w.y = pk2(v[bj][0][2], v[bj][0][3]); w.z = pk2(v[bj][1][0], v[bj][1][1]); w.w = pk2(v[bj][1][2], v[bj][1][3]);
                    *(u32x4*)(dst + 32 * bj + 8 * fq) = w;
                }
            }
    }
};
__device__ __forceinline__ int vcu_of_block() { const int G = gridDim.x, bx = blockIdx.x; return (G % 8 == 0) ? (bx % 8) * (G / 8) + bx / 8 : bx; }
__device__ __forceinline__ void phase_inproj(const Params& p, LAS unsigned char* lds) {
    pg8::Gemm g{(const bf16_t*)(p.ws + OFF_XN), (const bf16_t*)(p.ws + OFF_WTIN)};
    pg8::DenseSched S{6, 768, 800, 4, 2, (int)gridDim.x, vcu_of_block()};
    EpiIn E{p.q_norm, p.k_norm, (const float*)(p.ws + OFF_ROPE), (bf16_t*)(p.ws + OFF_Q), (bf16_t*)(p.ws + OFF_K), (bf16_t*)(p.ws + OFF_V), (bf16_t*)(p.ws + OFF_U)};
    pg8::gemm_phase<D, EpiIn, pg8::DenseSched, false>(lds, g, S, E);
}

namespace attn_body {
using bf16=unsigned short;
using bf16x8=__attribute__((ext_vector_type(8)))short;
using s16x4=__attribute__((ext_vector_type(4)))short;
using f32x16=__attribute__((ext_vector_type(16)))float;
using u32x4=__attribute__((ext_vector_type(4)))unsigned;
constexpr int D=64,QP=768,KP=256,OP=1024,SEQ=2048,KVLEN=2304;
constexpr int NW=8,QBLK=32,QB=QBLK*NW,KVBLK=64,NT=KVLEN/KVBLK;
__device__ __forceinline__ int crow(int r,int hi){return (r&3)+8*(r>>2)+4*hi;}
#define SBAR() __builtin_amdgcn_sched_barrier(0)
constexpr int NSLOT=3, SLOTB=8192;
constexpr int LDS_K=0, LDS_V=NSLOT*SLOTB, LDS_WS=2*NSLOT*SLOTB, LDS_OST=LDS_WS+NW*64*4, LDS_BYTES=LDS_OST+NW*4096;
constexpr float C2=0.125f*1.4426950408889634f;
__device__ __forceinline__ void glds16(const void*gsrc,unsigned lds_dst){unsigned keep;
  asm volatile("s_mov_b32 %0, m0\n\ts_mov_b32 m0, %2\n\ts_nop 0\n\tglobal_load_lds_dwordx4 %1, off\n\ts_mov_b32 m0, %0":"=&s"(keep):"v"(gsrc),"s"(lds_dst):"memory");}
__device__ __forceinline__ float max3f(float a,float b,float c){float r;asm("v_max3_f32 %0, %1, %2, %3":"=v"(r):"v"(a),"v"(b),"v"(c));return r;}
__device__ __forceinline__ float max2f(float a,float b){float r;asm("v_max_f32_e32 %0, %1, %2":"=v"(r):"v"(a),"v"(b));return r;}
__device__ __forceinline__ float fadd_s(float a,float b){float r;asm("v_add_f32_e32 %0, %1, %2":"=v"(r):"v"(a),"v"(b));return r;}
__device__ __forceinline__ float fsub_s(float a,float b){float r;asm("v_sub_f32_e32 %0, %1, %2":"=v"(r):"v"(a),"v"(b));return r;}
typedef float f32x2_t __attribute__((ext_vector_type(2))); typedef __bf16 bf16x2_t __attribute__((ext_vector_type(2)));
__device__ __forceinline__ unsigned cvtpk_s(float lo,float hi){f32x2_t v={lo,hi};bf16x2_t b=__builtin_convertvector(v,bf16x2_t);return __builtin_bit_cast(unsigned,b);}
#define WAIT_BAR(N) asm volatile("s_waitcnt vmcnt(" #N ") lgkmcnt(0)\n\ts_barrier":::"memory")

__device__ __forceinline__ void qkt(f32x16&p0,f32x16&p1,const char*Kslot,const bf16x8*qr,const f32x16&negm,int r32,int hi){
  const char*kb=Kslot+hi*1024+r32*16;
  #pragma unroll
  for(int d0=0;d0<4;++d0){
    const bf16x8 b0=*reinterpret_cast<const bf16x8*>(kb+d0*2048);
    const bf16x8 b1=*reinterpret_cast<const bf16x8*>(kb+d0*2048+512);
    if(d0==0){p0=__builtin_amdgcn_mfma_f32_32x32x16_bf16(b0,qr[0],negm,0,0,0);p1=__builtin_amdgcn_mfma_f32_32x32x16_bf16(b1,qr[0],negm,0,0,0);}
    else{p0=__builtin_amdgcn_mfma_f32_32x32x16_bf16(b0,qr[d0],p0,0,0,0);p1=__builtin_amdgcn_mfma_f32_32x32x16_bf16(b1,qr[d0],p1,0,0,0);}}
}
typedef __attribute__((address_space(3))) const char* lds_cptr;
typedef short v4i16_t __attribute__((ext_vector_type(4)));
__device__ __forceinline__ void kload8(bf16x8*kf,lds_cptr kp){
  kf[0]=*(const __attribute__((address_space(3))) bf16x8*)(kp);      kf[1]=*(const __attribute__((address_space(3))) bf16x8*)(kp+512);
  kf[2]=*(const __attribute__((address_space(3))) bf16x8*)(kp+2048); kf[3]=*(const __attribute__((address_space(3))) bf16x8*)(kp+2560);
  kf[4]=*(const __attribute__((address_space(3))) bf16x8*)(kp+4096); kf[5]=*(const __attribute__((address_space(3))) bf16x8*)(kp+4608);
  kf[6]=*(const __attribute__((address_space(3))) bf16x8*)(kp+6144); kf[7]=*(const __attribute__((address_space(3))) bf16x8*)(kp+6656);
}
__device__ __forceinline__ void kload2(bf16x8*kf,lds_cptr kp,int j){ kf[2*j]=*(const __attribute__((address_space(3))) bf16x8*)(kp+j*2048); kf[2*j+1]=*(const __attribute__((address_space(3))) bf16x8*)(kp+j*2048+512); }
__device__ __forceinline__ s16x4 vtr(lds_cptr p){ return __builtin_bit_cast(s16x4,__builtin_amdgcn_ds_read_tr16_b64_v4i16((__attribute__((address_space(3))) v4i16_t*)p)); }
__device__ __forceinline__ float rowmax(const f32x16&p0,const f32x16&p1){
  float a=max3f(p0[0],p0[1],p1[0]),b=max3f(p0[2],p0[3],p1[1]);a=max3f(a,p1[2],p1[3]);
  #pragma unroll
  for(int r=4;r<16;r+=4){a=max3f(a,p0[r],p0[r+1]);b=max3f(b,p0[r+2],p0[r+3]);a=max3f(a,p1[r],p1[r+1]);b=max3f(b,p1[r+2],p1[r+3]);}
  const float m=max2f(a,b);
  auto rr=__builtin_amdgcn_permlane32_swap(__float_as_uint(m),__float_as_uint(m),false,false);
  return max2f(__uint_as_float(rr[0]),__uint_as_float(rr[1]));
}
__device__ __forceinline__ void pv(f32x16*o,int vb,bf16x8 pa0,bf16x8 pa1,bf16x8 pa2,bf16x8 pa3){
  #pragma unroll
  for(int d0=0;d0<2;++d0){s16x4 lo[4],hi[4];
    #pragma unroll
    for(int ks=0;ks<4;++ks){
      asm volatile("ds_read_b64_tr_b16 %0,%1 offset:%c2":"=&v"(lo[ks]):"v"(vb),"i"(d0*4096+ks*1024):"memory");
      asm volatile("ds_read_b64_tr_b16 %0,%1 offset:%c2":"=&v"(hi[ks]):"v"(vb),"i"(d0*4096+ks*1024+512):"memory");}
    asm volatile("s_waitcnt lgkmcnt(0)":::"memory");SBAR();
    #define PK(k) (bf16x8){lo[k][0],lo[k][1],lo[k][2],lo[k][3],hi[k][0],hi[k][1],hi[k][2],hi[k][3]}
    o[d0]=__builtin_amdgcn_mfma_f32_32x32x16_bf16(pa0,PK(0),o[d0],0,0,0);
    o[d0]=__builtin_amdgcn_mfma_f32_32x32x16_bf16(pa1,PK(1),o[d0],0,0,0);
    o[d0]=__builtin_amdgcn_mfma_f32_32x32x16_bf16(pa2,PK(2),o[d0],0,0,0);
    o[d0]=__builtin_amdgcn_mfma_f32_32x32x16_bf16(pa3,PK(3),o[d0],0,0,0);
    #undef PK
  }
}

#ifndef ATTN_STORE16
#define ATTN_STORE16(p,v) (*(u32x4*)(p)=(v))
#endif
template<int THRL> __device__ __forceinline__ void attn_unit(int b,int h,int qb,const bf16*Q,const bf16*__restrict__ K,const bf16*__restrict__ V,bf16*O,char*shm){
  const int tid=hw_tid(),lane=tid&63,r32=lane&31,hi=lane>>5; const int wid=__builtin_amdgcn_readfirstlane(tid>>6);
  const long rowbase=(long)b*SEQ, kvbase=(long)b*KVLEN; const int q0=qb*QB, kh=h/3;
  const bf16*Qw=Q+(rowbase+q0+wid*QBLK)*QP+h*D;
  const bf16*Kh=K+kvbase*KP+kh*D,*Vh=V+kvbase*KP+kh*D;
  const unsigned lds0=(unsigned)(uintptr_t)shm;
  float*wsf=(float*)(shm+LDS_WS)+wid*64;
  const bf16*ksrc=Kh+(long)lane*KP+wid*8;
  const bf16*vsrc=Vh+(long)(16*(wid&3)+(lane>>2))*KP+(wid>>2)*32+(lane&3)*8;
  const unsigned kdst=lds0+LDS_K+wid*1024, vdst=lds0+LDS_V+wid*1024;
  #define DMA_K(t,slot) glds16(ksrc+(long)(t)*KVBLK*KP,(unsigned)__builtin_amdgcn_readfirstlane(kdst+(slot)))
  #define DMA_V(t,slot) glds16(vsrc+(long)(t)*KVBLK*KP,(unsigned)__builtin_amdgcn_readfirstlane(vdst+(slot)))
  const int vb0=(int)(lds0+LDS_V)+((lane>>4)&1)*32+(lane&3)*8+(4*hi+((lane&15)>>2))*64;
  const char*Kbase=shm+LDS_K; bf16x8 kf[8];
  const lds_cptr shm3=(lds_cptr)shm; const lds_cptr kp0=shm3+LDS_K+hi*1024+r32*16; const lds_cptr vp0=shm3+LDS_V+((lane>>4)&1)*32+(lane&3)*8+(4*hi+((lane&15)>>2))*64;
  DMA_K(0,0);DMA_V(0,0);DMA_K(1,SLOTB);
  bf16x8 qr[4];
  #pragma unroll
  for(int d0=0;d0<4;++d0)qr[d0]=*reinterpret_cast<const bf16x8*>(&Qw[(long)r32*QP+d0*16+hi*8]);
  float mhat=0.f,l_reg=0.f;f32x16 o[2];o[0]=f32x16{};o[1]=f32x16{};f32x16 negm=f32x16{};asm volatile("":"+v"(negm));
  #define CMASK(P0,P1,t) do{}while(0)
  bool resc=false;
  #define START(P0,P1) do{ const float rm=rowmax(P0,P1); resc=false; \
    { const float dl=rm; mhat=fadd_s(mhat,dl); \
      _Pragma("unroll") for(int r=0;r<16;++r){P0[r]=fsub_s(P0[r],dl);P1[r]=fsub_s(P1[r],dl);} \
      _Pragma("unroll") for(int r=0;r<16;++r)negm[r]=-mhat; asm volatile("":"+v"(negm)); } \
    _Pragma("unroll") for(int r=0;r<16;++r)P0[r]=__builtin_amdgcn_exp2f(P0[r]); }while(0)
  #define RESC() do{ if(resc){ asm volatile("s_waitcnt lgkmcnt(0)":::"memory"); \
      _Pragma("unroll") for(int d_=0;d_<2;++d_) _Pragma("unroll") for(int r=0;r<16;++r)o[d_][r]*=wsf[crow(r,hi)]; } }while(0)
  f32x16 pA0,pA1,pB0,pB1;
  int sl_prev=0,sl_cur=0,sl_next=SLOTB;
  #define ROT() do{sl_prev=sl_cur;sl_cur=sl_next;sl_next=(sl_next==(NSLOT-1)*SLOTB)?0:sl_next+SLOTB;}while(0)
  DMA_K(2,2*SLOTB);
  WAIT_BAR(3);
  qkt(pA0,pA1,Kbase,qr,negm,r32,hi);asm volatile("s_nop 15\n\ts_nop 7":"+v"(pA0),"+v"(pA1));CMASK(pA0,pA1,0);
  START(pA0,pA1);
  _Pragma("unroll") for(int r=0;r<16;++r)pA1[r]=__builtin_amdgcn_exp2f(pA1[r]);
  WAIT_BAR(0);
  DMA_K(3,0);DMA_V(1,SLOTB);
  ROT();
  kload8(kf,kp0+sl_cur);
  WAIT_BAR(2);
  s16x4 vlo[8],vhi[8]; u32x4 pw0,pw1,pw2,pw3;
  #define PKW(P,B) cvtpk_s(P[B],P[B+1])
  #define PAF(k) __builtin_bit_cast(bf16x8,pw##k)
  #define VFR(i) (bf16x8){vlo[i][0],vlo[i][1],vlo[i][2],vlo[i][3],vhi[i][0],vhi[i][1],vhi[i][2],vhi[i][3]}
  #define PIN(x) asm volatile("":"+v"(x))
  #define MX3(a,b,c) __builtin_fmaxf(__builtin_fmaxf((a),(b)),(c))
  #define GAPA(MF,A0,A1,A2,A3,W0,W1,PW) do{ MF; sacc+=A0; sacc+=A1; sacc+=A2; sacc+=A3; PIN(sacc); W0; W1; PIN(PW); SBAR(); }while(0)
  #define EX(v) __builtin_amdgcn_exp2f(v)
  #define GAPB(MF,X,B) do{ MF; X[B]=EX(X[B]); X[B+1]=EX(X[B+1]); X[B+2]=EX(X[B+2]); X[B+3]=EX(X[B+3]); PIN(X); SBAR(); }while(0)
  #define VRD(i) do{ vlo[i]=vtr(vp_+(((i)>>2)*4096+((i)&3)*1024)); vhi[i]=vtr(vp_+(((i)>>2)*4096+((i)&3)*1024+512)); }while(0)
  #define KRD(G,j) do{ if(G){ kload2(kf,kp0+sl_next,j); SBAR(); } }while(0)
  #define STEP(C0,C1,P0,P1,t,GK,GV,GL) do{ SBAR(); \
    const lds_cptr vp_=vp0+sl_prev; \
    VRD(0); SBAR(); float sacc=(P0[0]+P0[1]); \
    GAPA(C0=__builtin_amdgcn_mfma_f32_32x32x16_bf16(kf[0],qr[0],negm,0,0,0), P0[2],P0[3],P0[4],P0[5],     pw0[0]=PKW(P0,0), pw0[1]=PKW(P0,2), pw0); \
    VRD(4); SBAR(); GAPA(C1=__builtin_amdgcn_mfma_f32_32x32x16_bf16(kf[1],qr[0],negm,0,0,0), P0[6],P0[7],P0[8],P0[9],     pw0[2]=PKW(P0,4), pw0[3]=PKW(P0,6), pw0); \
    VRD(1); SBAR(); GAPA(C0=__builtin_amdgcn_mfma_f32_32x32x16_bf16(kf[2],qr[1],C0,0,0,0),   P0[10],P0[11],P0[12],P0[13], pw1[0]=PKW(P0,8), pw1[1]=PKW(P0,10), pw1); \
    VRD(5); SBAR(); GAPA(C1=__builtin_amdgcn_mfma_f32_32x32x16_bf16(kf[3],qr[1],C1,0,0,0),   P0[14],P0[15],P1[0],P1[1],   pw1[2]=PKW(P0,12),pw1[3]=PKW(P0,14), pw1); \
    VRD(2); SBAR(); GAPA(C0=__builtin_amdgcn_mfma_f32_32x32x16_bf16(kf[4],qr[2],C0,0,0,0),   P1[2],P1[3],P1[4],P1[5],     pw2[0]=PKW(P1,0), pw2[1]=PKW(P1,2), pw2); \
    VRD(6); SBAR(); GAPA(C1=__builtin_amdgcn_mfma_f32_32x32x16_bf16(kf[5],qr[2],C1,0,0,0),   P1[6],P1[7],P1[8],P1[9],     pw2[2]=PKW(P1,4), pw2[3]=PKW(P1,6), pw2); \
    VRD(3); SBAR(); GAPA(C0=__builtin_amdgcn_mfma_f32_32x32x16_bf16(kf[6],qr[3],C0,0,0,0),   P1[10],P1[11],P1[12],P1[13], pw3[0]=PKW(P1,8), pw3[1]=PKW(P1,10), pw3); \
    VRD(7); SBAR(); GAPA(C1=__builtin_amdgcn_mfma_f32_32x32x16_bf16(kf[7],qr[3],C1,0,0,0),   P1[14],P1[15],0.f,0.f,       pw3[2]=PKW(P1,12),pw3[3]=PKW(P1,14), pw3); \
    l_reg+=sacc; \
    if(GK){DMA_K((t)+3,sl_cur);} if(GV){DMA_V((t)+1,sl_next);} \
    CMASK(C0,C1,t); \
    { float a=MX3(C0[0],C0[1],C1[0]),b=MX3(C0[2],C0[3],C1[1]); a=MX3(a,C1[2],C1[3]); \
      _Pragma("unroll") for(int r=4;r<16;r+=4){a=MX3(a,C0[r],C0[r+1]);b=MX3(b,C0[r+2],C0[r+3]);a=MX3(a,C1[r],C1[r+1]);b=MX3(b,C1[r+2],C1[r+3]);} \
      float rm=__builtin_fmaxf(a,b); { auto rr=__builtin_amdgcn_permlane32_swap(__float_as_uint(rm),__float_as_uint(rm),false,false); rm=__builtin_fmaxf(__uint_as_float(rr[0]),__uint_as_float(rr[1])); } \
      resc=false; \
      if(__builtin_expect(__any(rm>(float)THRL),0)){ const float dl=__builtin_fmaxf(rm,0.f); mhat+=dl; \
        _Pragma("unroll") for(int r=0;r<16;++r){C0[r]-=dl;C1[r]-=dl;} \
        _Pragma("unroll") for(int r=0;r<16;++r)negm[r]=-mhat; asm volatile("":"+v"(negm)); \
        const float f=__builtin_amdgcn_exp2f(-dl); l_reg*=f; if(hi==0)wsf[r32]=f; resc=true; } } \
    SBAR(); \
    GAPB(o[0]=__builtin_amdgcn_mfma_f32_32x32x16_bf16(PAF(0),VFR(0),o[0],0,0,0), C0,0); \
    GAPB(o[1]=__builtin_amdgcn_mfma_f32_32x32x16_bf16(PAF(0),VFR(4),o[1],0,0,0), C0,4); \
    KRD(GL,0); GAPB(o[0]=__builtin_amdgcn_mfma_f32_32x32x16_bf16(PAF(1),VFR(1),o[0],0,0,0), C0,8); \
    KRD(GL,1); GAPB(o[1]=__builtin_amdgcn_mfma_f32_32x32x16_bf16(PAF(1),VFR(5),o[1],0,0,0), C0,12); \
    KRD(GL,2); GAPB(o[0]=__builtin_amdgcn_mfma_f32_32x32x16_bf16(PAF(2),VFR(2),o[0],0,0,0), C1,0); \
    KRD(GL,3); GAPB(o[1]=__builtin_amdgcn_mfma_f32_32x32x16_bf16(PAF(2),VFR(6),o[1],0,0,0), C1,4); \
    GAPB(o[0]=__builtin_amdgcn_mfma_f32_32x32x16_bf16(PAF(3),VFR(3),o[0],0,0,0), C1,8); \
    GAPB(o[1]=__builtin_amdgcn_mfma_f32_32x32x16_bf16(PAF(3),VFR(7),o[1],0,0,0), C1,12); \
    }while(0)
  int t=1;
  for(;t+5<NT;t+=2){
    STEP(pB0,pB1,pA0,pA1,t,true,true,true);     WAIT_BAR(2); RESC(); ROT();
    STEP(pA0,pA1,pB0,pB1,t+1,true,true,true);   WAIT_BAR(2); RESC(); ROT();
  }
  #define ENDW(tt) do{ if((tt)+3<NT){WAIT_BAR(2);} else if((tt)+2<NT){WAIT_BAR(1);} else {WAIT_BAR(0);} }while(0)
  for(;t+1<NT;t+=2){
    STEP(pB0,pB1,pA0,pA1,t,(t+3<NT),(t+1<NT),(t+1<NT));       ENDW(t);   RESC(); ROT();
    STEP(pA0,pA1,pB0,pB1,t+1,(t+4<NT),(t+2<NT),(t+2<NT));     ENDW(t+1); RESC(); ROT();
  }
  STEP(pB0,pB1,pA0,pA1,NT-1,false,false,false); RESC();
  { float sacc=pB0[0]+pB0[1]; _Pragma("unroll") for(int r=2;r<16;++r)sacc+=pB0[r]; _Pragma("unroll") for(int r=0;r<16;++r)sacc+=pB1[r]; l_reg+=sacc;
    pw0=(u32x4){PKW(pB0,0),PKW(pB0,2),PKW(pB0,4),PKW(pB0,6)};pw1=(u32x4){PKW(pB0,8),PKW(pB0,10),PKW(pB0,12),PKW(pB0,14)};pw2=(u32x4){PKW(pB1,0),PKW(pB1,2),PKW(pB1,4),PKW(pB1,6)};pw3=(u32x4){PKW(pB1,8),PKW(pB1,10),PKW(pB1,12),PKW(pB1,14)};
    SBAR(); pv(o,vb0+sl_cur,PAF(0),PAF(1),PAF(2),PAF(3)); }
  #undef PKW
  #undef PAF
  #undef VFR
  #undef PIN
  #undef MX3
  #undef GAPA
  #undef GAPB
  #undef EX
  #undef VRD
  #undef KRD
  #undef STEP
  #undef ENDW
  {auto rr=__builtin_amdgcn_permlane32_swap(__float_as_uint(l_reg),__float_as_uint(l_reg),false,false);l_reg=__uint_as_float(rr[0])+__uint_as_float(rr[1]);}
  if(hi==0)wsf[32+r32]=l_reg;asm volatile("s_waitcnt lgkmcnt(0)":::"memory");
  float rli[16];
  #pragma unroll
  for(int r=0;r<16;++r)rli[r]=__builtin_amdgcn_rcpf(wsf[32+crow(r,hi)]);
  bf16*Ow=O+(rowbase+q0+wid*QBLK)*OP+h*D;
  { bf16*stg=(bf16*)(shm+LDS_OST)+wid*2048;
    #pragma unroll
    for(int r=0;r<16;++r){const int orow=crow(r,hi);
      #pragma unroll
      for(int d0=0;d0<2;++d0)stg[orow*64+d0*32+r32]=(bf16)f2bf(o[d0][r]*rli[r]);}
    asm volatile("s_waitcnt lgkmcnt(0)":::"memory");
    #pragma unroll
    for(int i=0;i<4;++i){const int row=i*8+(lane>>3),ch=lane&7; const u32x4 v=*(const u32x4*)(stg+row*64+ch*8); ATTN_STORE16(Ow+(long)row*OP+ch*8,v);} }
  asm volatile("s_waitcnt lgkmcnt(0)\n\ts_barrier":::"memory");
  #undef DMA_K
  #undef DMA_V
  #undef CMASK
  #undef START
  #undef RESC
  #undef ROT
}
constexpr int ATTN_LDS_BYTES=LDS_BYTES;
struct AttnTensors { const bf16* Q; const bf16* K; const bf16* V; bf16* O; };
template<int THRL=8> __device__ __forceinline__ void attn_phase(char*lds,const AttnTensors&T){
  const int G=gridDim.x, bx=blockIdx.x, v=(G%8==0)?(bx%8)*(G/8)+bx/8:bx;
  for(int u=v;u<16*12*8;u+=G){
    const int pair=(u%256)/4, j=((u%256)%4)*6+u/256;
    const int b=pair>>2, kh=pair&3, g=j>>3, qb=j&7;
    attn_unit<THRL>(b,kh*3+g,qb,T.Q,T.K,T.V,T.O,lds);
  }
}
#undef SBAR
#undef WAIT_BAR
}

__device__ __forceinline__ void pool_item(const Params& p, LAS unsigned char* lds, int item, bool stage_w) {
    const int tid = TIDX, lane = tid & 63, wid = tid >> 6, r16 = lane & 15, q = lane >> 4;
    const int gi = item & 3, tile = item >> 2, t0 = tile * 64, b = t0 / SEQ, tl0 = t0 % SEQ, half = 1 << gi;
    const bf16_t* Ub = (const bf16_t*)(p.ws + OFF_U);
    bf16_t* AO = (bf16_t*)(p.ws + OFF_AO);
    LAS bf16_t* us = (LAS bf16_t*)lds;
    LAS bf16_t* dl = (LAS bf16_t*)(lds + 11520);
    LAS bf16_t* wt = (LAS bf16_t*)(lds + 11520 + 9216);
    __syncthreads();
    for (int i = tid; i < 80 * 8; i += 256) {
        const int r = i >> 3, ch = i & 7, tl = tl0 - 8 + r;
        u32x4 v = {0u, 0u, 0u, 0u};
        if (tl >= 0 && tl < SEQ) v = *(const u32x4*)(Ub + (size_t)(b * SEQ + tl) * 256 + gi * 64 + ch * 8);
        *(LAS u32x4*)(us + r * 72 + ch * 8) = v;
    }
    if (stage_w) {
#pragma unroll 4
        for (int k = 0; k < 16; ++k) {
            const int i = tid + 256 * k, c = i >> 6, dd = i & 63;
            wt[dd * 72 + c] = (bf16_t)f2bf(p.pool_w[gi * 4096 + i] * p.pool_scale[gi * 64 + dd]);
        }
    }
    __syncthreads();
    {
        const int c = tid & 63, seg = tid >> 6;
        int tl = tl0 + seg * 16;
        float sm = 0.f;
        for (int r = max(tl - half, 0); r < min(tl + half, SEQ); ++r) sm += bf2f(us[(r - tl0 + 8) * 72 + c]);
#pragma unroll
        for (int k = 0; k < 16; ++k, ++tl) {
            if (k > 0) {
                if (tl + half <= SEQ) sm += bf2f(us[(tl + half - 1 - tl0 + 8) * 72 + c]);
                if (tl - half > 0) sm -= bf2f(us[(tl - half - 1 - tl0 + 8) * 72 + c]);
            }
            const int cntw = min(tl + half, SEQ) - max(tl - half, 0);
            dl[(seg * 16 + k) * 72 + c] = (bf16_t)f2bf(sm / (float)cntw - bf2f(us[(tl - tl0 + 8) * 72 + c]));
        }
    }
    __syncthreads();
    {
        f32x4 acc[4];
#pragma unroll
        for (int nb = 0; nb < 4; ++nb) acc[nb] = (f32x4){0.f, 0.f, 0.f, 0.f};
#pragma unroll
        for (int ks = 0; ks < 2; ++ks) {
            const bf16x8 db = *(const LAS bf16x8*)(dl + (wid * 16 + r16) * 72 + ks * 32 + q * 8);
#pragma unroll
            for (int nb = 0; nb < 4; ++nb) {
                const bf16x8 wa = *(const LAS bf16x8*)(wt + (nb * 16 + r16) * 72 + ks * 32 + q * 8);
                acc[nb] = __builtin_amdgcn_mfma_f32_16x16x32_bf16(wa, db, acc[nb], 0, 0, 0);
            }
        }
        bf16_t* orow = AO + (size_t)(t0 + wid * 16 + r16) * D + gi * 64 + 4 * q;
#pragma unroll
        for (int nb = 0; nb < 4; ++nb) { u32x2 w; w.x = pk2(acc[nb][0], acc[nb][1]); w.y = pk2(acc[nb][2], acc[nb][3]); *(u32x2*)(orow + nb * 16) = w; }
    }
}

__device__ __forceinline__ void phase_attn_pool(const Params& p, LAS unsigned char* lds, char* smem) {
    const attn_body::AttnTensors AT{(const bf16_t*)(p.ws + OFF_Q), (const bf16_t*)(p.ws + OFF_K), (const bf16_t*)(p.ws + OFF_V), (bf16_t*)(p.ws + OFF_AO) + 256};
    attn_body::attn_phase<8>(smem, AT);
    __syncthreads();
    constexpr int N_POOL = (T / 64) * 4;
    { bool first = true; for (int it = VBLK; it < N_POOL; it += NVBLK) { pool_item(p, lds, it, first); first = false; } }
}

struct EpiOut {
    static constexpr bool PERM = false;
    const float* x; float* y; const float* mod; float* stats;
    __device__ __forceinline__ void operator()(const f32x4 (&acc)[2][2][4][2], const pg8::Unit& u, int wr, int wc, int fr, int fq) const {
        const float* g1 = mod + (size_t)(u.pm >> 3) * MODW + 2 * D;
        const int col0 = u.pn * 256 + wc * 32 + fq * 4;
        f32x4 gv[2][2];
#pragma unroll
        for (int bj = 0; bj < 2; ++bj)
#pragma unroll
            for (int n = 0; n < 2; ++n) gv[bj][n] = *(const f32x4*)(g1 + col0 + bj * 128 + n * 16);
#pragma unroll
        for (int ai = 0; ai < 2; ++ai)
#pragma unroll
            for (int m = 0; m < 4; ++m) {
                const int row = u.pm * 256 + ai * 128 + wr * 64 + m * 16 + fr;
                float s1 = 0.f, s2 = 0.f;
#pragma unroll
                for (int bj = 0; bj < 2; ++bj)
#pragma unroll
                    for (int n = 0; n < 2; ++n) {
                        const size_t off = (size_t)row * D + col0 + bj * 128 + n * 16;
                        const f32x4 xv = *(const f32x4*)(x + off);
                        const f32x4 yv = xv * ALPHA + gv[bj][n] * acc[ai][bj][m][n];
                        *(f32x4*)(y + off) = yv;
                        s1 += (yv[0] + yv[1]) + (yv[2] + yv[3]);
                        s2 += (yv[0] * yv[0] + yv[1] * yv[1]) + (yv[2] * yv[2] + yv[3] * yv[3]);
                    }
                s1 += __shfl_xor(s1, 16); s1 += __shfl_xor(s1, 32);
                s2 += __shfl_xor(s2, 16); s2 += __shfl_xor(s2, 32);
                if (fq == 0) { float* st = stats + ((size_t)row * 16 + u.pn * 4 + wc) * 2; st[0] = s1; st[1] = s2; }
            }
    }
};
__device__ __forceinline__ void phase_outproj(const Params& p, LAS unsigned char* lds) {
    pg8::Gemm g{(const bf16_t*)(p.ws + OFF_AO), (const bf16_t*)(p.ws + OFF_WTOUT)};
    pg8::DenseSched S{4, 512, 512, 0, 1, (int)gridDim.x, vcu_of_block()};
    EpiOut E{p.x, p.out, (const float*)(p.ws + OFF_MOD), (float*)(p.ws + OFF_STATS)};
    pg8::gemm_phase<D, EpiOut, pg8::DenseSched, false>(lds, g, S, E);
}

__device__ __forceinline__ void phase_router(const Params& p, LAS unsigned char* lds0) {
    const int tid = hw_tid(), lane = tid & 63, wid = tid >> 6, r16 = lane & 15, q = lane >> 4;
    const float* mod = (const float*)(p.ws + OFF_MOD);
    const float* stats = (const float*)(p.ws + OFF_STATS);
    bf16_t* H = (bf16_t*)(p.ws + OFF_H);
    const bf16_t* WRH = (const bf16_t*)(p.ws + OFF_WRH); const bf16_t* WRL = (const bf16_t*)(p.ws + OFF_WRL);
    int* gcnt = (int*)(p.ws + OFF_CNT);
    int* LDST = (int*)(p.ws + OFF_LDST);
    float* LWt = (float*)(p.ws + OFF_LW);
    LAS float* vec = (LAS float*)lds0;
    LAS float* lg = (LAS float*)(lds0 + 16384) + wid * 16 * 64;
    LAS int* lcnt = (LAS int*)(lds0 + 49152);
    LAS int* lbase = (LAS int*)(lds0 + 49152 + 256);
    LAS int* sel_ep = (LAS int*)(lds0 + 49152 + 512);
    LAS float* sel_w = (LAS float*)(lds0 + 49152 + 512 + 4096);
    for (int item = blockIdx.x; item < T / 128; item += gridDim.x) {
        const int t0 = item * 128, b = t0 / SEQ, tw0 = t0 + wid * 16;
        __syncthreads();
        if (tid < 64) lcnt[tid] = 0;
        for (int i = tid; i < 1024; i += 512) {
            vec[i] = p.ln1_g[i]; vec[1024 + i] = p.ln1_b[i];
            vec[2048 + i] = 1.f + mod[(size_t)b * MODW + 4 * D + i]; vec[3072 + i] = mod[(size_t)b * MODW + 3 * D + i];
        }
        float meanv = 0.f, rstdv = 0.f;
        if (lane < 16) {
            float s1 = 0.f, s2 = 0.f;
            const float* st = stats + (size_t)(tw0 + lane) * 32;
#pragma unroll
            for (int i = 0; i < 16; ++i) { s1 += st[2 * i]; s2 += st[2 * i + 1]; }
            meanv = s1 * (1.f / D);
            const float var = fmaxf(s2 * (1.f / D) - meanv * meanv, 0.f);
            rstdv = 1.0f / sqrtf(var + 1e-5f);
        }
        const float mu = __shfl(meanv, r16), rs = __shfl(rstdv, r16);
        __syncthreads();
        f32x4 acc[4];
#pragma unroll
        for (int nb = 0; nb < 4; ++nb) acc[nb] = (f32x4){0.f, 0.f, 0.f, 0.f};
        float* yrow = p.out + (size_t)(tw0 + r16) * D + q * 8;
        bf16_t* hrow = H + (size_t)(tw0 + r16) * D + q * 8;
        LAS unsigned char* wb = lds0 + 57856;
        f32x4 vn[4][2];
#pragma unroll
        for (int u = 0; u < 4; ++u) { vn[u][0] = *(const f32x4*)(yrow + u * 32); vn[u][1] = *(const f32x4*)(yrow + u * 32 + 4); }
        for (int ch = 0; ch < 4; ++ch) {
            __syncthreads();
#pragma unroll
            for (int i = 0; i < 8; ++i) {
                const int idx = tid + i * 512, part = idx >> 11, row = (idx >> 5) & 63, c16 = idx & 31;
                const u32x4 w = *(const u32x4*)((part ? WRL : WRH) + (size_t)row * D + ch * 256 + c16 * 8);
                *(LAS u32x4*)(wb + part * 33792 + row * 528 + c16 * 16) = w;
            }
            __syncthreads();
#pragma unroll
            for (int s4 = ch * 8; s4 < ch * 8 + 8; s4 += 4) {
                f32x4 vv[4][2];
#pragma unroll
                for (int u = 0; u < 4; ++u) { vv[u][0] = vn[u][0]; vv[u][1] = vn[u][1]; }
                if (s4 + 4 < 32) {
#pragma unroll
                    for (int u = 0; u < 4; ++u) { vn[u][0] = *(const f32x4*)(yrow + (s4 + 4 + u) * 32); vn[u][1] = *(const f32x4*)(yrow + (s4 + 4 + u) * 32 + 4); }
                }
#pragma unroll
                for (int u = 0; u < 4; ++u) {
                    const int s = s4 + u, k0 = s * 32 + q * 8;
                    float hv[8];
#pragma unroll
                    for (int hh = 0; hh < 2; ++hh) {
                        const f32x4 g = *(const LAS f32x4*)(vec + k0 + 4 * hh), bb = *(const LAS f32x4*)(vec + 1024 + k0 + 4 * hh);
                        const f32x4 sc = *(const LAS f32x4*)(vec + 2048 + k0 + 4 * hh), sh = *(const LAS f32x4*)(vec + 3072 + k0 + 4 * hh);
                        const f32x4 xm = (vv[u][hh] - mu) * rs * g + bb;
                        *(f32x4*)(yrow + s * 32 + 4 * hh) = xm;
                        const f32x4 h4 = xm * sc + sh;
                        hv[4 * hh + 0] = h4[0]; hv[4 * hh + 1] = h4[1]; hv[4 * hh + 2] = h4[2]; hv[4 * hh + 3] = h4[3];
                    }
                    unsigned wh[4], wl[4];
#pragma unroll
                    for (int i = 0; i < 4; ++i) {
                        const unsigned ha = f2bf(hv[2 * i]), hb = f2bf(hv[2 * i + 1]);
                        wh[i] = ha | (hb << 16);
                        wl[i] = pk2(hv[2 * i] - bf2f(ha), hv[2 * i + 1] - bf2f(hb));
                    }
                    *(u32x4*)(hrow + s * 32) = (u32x4){wh[0], wh[1], wh[2], wh[3]};
                    const bf16x8 ah = __builtin_bit_cast(bf16x8, (u32x4){wh[0], wh[1], wh[2], wh[3]}), al = __builtin_bit_cast(bf16x8, (u32x4){wl[0], wl[1], wl[2], wl[3]});
                    const int kb = ((s & 7) * 32 + q * 8) * 2;
#pragma unroll
                    for (int nb = 0; nb < 4; ++nb) {
                        const bf16x8 bh = *(const LAS bf16x8*)(wb + (nb * 16 + r16) * 528 + kb), bl = *(const LAS bf16x8*)(wb + 33792 + (nb * 16 + r16) * 528 + kb);
                        acc[nb] = __builtin_amdgcn_mfma_f32_16x16x32_bf16(ah, bh, acc[nb], 0, 0, 0);
                        acc[nb] = __builtin_amdgcn_mfma_f32_16x16x32_bf16(al, bh, acc[nb], 0, 0, 0);
                        acc[nb] = __builtin_amdgcn_mfma_f32_16x16x32_bf16(ah, bl, acc[nb], 0, 0, 0);
                    }
                }
            }
        }
#pragma unroll
        for (int nb = 0; nb < 4; ++nb)
#pragma unroll
            for (int j = 0; j < 4; ++j) lg[(4 * q + j) * 64 + nb * 16 + r16] = acc[nb][j];
        __syncthreads();
        const float bias = p.router_bias[lane];
        const int g = lane >> 3;
        for (int r0 = 0; r0 < 16; r0 += 4) {
            float sg[4], sel[4], msel[4]; bool keep[4];
#pragma unroll
            for (int u = 0; u < 4; ++u) {
                const float lgv = lg[(r0 + u) * 64 + lane];
                sg[u] = 1.0f / (1.0f + expf(-lgv));
                sel[u] = sg[u] + bias;
            }
            float m1[4], m2[4]; int cand[4];
#pragma unroll
            for (int u = 0; u < 4; ++u) { m1[u] = fmaxf(sel[u], __shfl_xor(sel[u], 1)); }
#pragma unroll
            for (int u = 0; u < 4; ++u) { m1[u] = fmaxf(m1[u], __shfl_xor(m1[u], 2)); }
#pragma unroll
            for (int u = 0; u < 4; ++u) { m1[u] = fmaxf(m1[u], __shfl_xor(m1[u], 4)); cand[u] = (sel[u] == m1[u]) ? lane : 64; }
#pragma unroll
            for (int u = 0; u < 4; ++u) { cand[u] = min(cand[u], __shfl_xor(cand[u], 1)); }
#pragma unroll
            for (int u = 0; u < 4; ++u) { cand[u] = min(cand[u], __shfl_xor(cand[u], 2)); }
#pragma unroll
            for (int u = 0; u < 4; ++u) { cand[u] = min(cand[u], __shfl_xor(cand[u], 4)); m2[u] = (lane == cand[u]) ? -INFINITY : sel[u]; }
#pragma unroll
            for (int u = 0; u < 4; ++u) { m2[u] = fmaxf(m2[u], __shfl_xor(m2[u], 1)); }
#pragma unroll
            for (int u = 0; u < 4; ++u) { m2[u] = fmaxf(m2[u], __shfl_xor(m2[u], 2)); }
#pragma unroll
            for (int u = 0; u < 4; ++u) { m2[u] = fmaxf(m2[u], __shfl_xor(m2[u], 4)); }
#pragma unroll
            for (int u = 0; u < 4; ++u) {
                const float gs = m1[u] + m2[u];
                int cntg = 0;
#pragma unroll
                for (int gg = 0; gg < 8; ++gg) { const float v = __shfl(gs, gg * 8); cntg += (v > gs || (v == gs && gg < g)) ? 1 : 0; }
                keep[u] = cntg < 4;
                msel[u] = keep[u] ? sel[u] : -INFINITY;
                lg[(r0 + u) * 64 + lane] = msel[u];
            }
            int cnt[4] = {0, 0, 0, 0};
#pragma unroll 4
            for (int q4 = 0; q4 < 16; ++q4) {
#pragma unroll
                for (int u = 0; u < 4; ++u) {
                    const f32x4 v = *(const LAS f32x4*)(lg + (r0 + u) * 64 + q4 * 4);
#pragma unroll
                    for (int i = 0; i < 4; ++i) cnt[u] += (v[i] > msel[u]) ? 1 : 0;
                }
            }
#pragma unroll
            for (int u = 0; u < 4; ++u) {
                bool ok = true;
#pragma unroll
                for (int k = 0; k < 8; ++k) ok = ok && (__ballot(keep[u] && cnt[u] == k) != 0ull);
                if (!ok) {
                    int c2 = 0;
                    for (int e2 = 0; e2 < 64; ++e2) { const float v = lg[(r0 + u) * 64 + e2]; c2 += (v > msel[u] || (v == msel[u] && e2 < lane)) ? 1 : 0; }
                    cnt[u] = c2;
                }
            }
            float wsum[4]; bool chosen[4];
#pragma unroll
            for (int u = 0; u < 4; ++u) { chosen[u] = keep[u] && cnt[u] < 8; wsum[u] = chosen[u] ? sg[u] : 0.f; }
#pragma unroll
            for (int o = 1; o < 64; o <<= 1) {
#pragma unroll
                for (int u = 0; u < 4; ++u) wsum[u] += __shfl_xor(wsum[u], o);
            }
#pragma unroll
            for (int u = 0; u < 4; ++u) {
                if (chosen[u]) {
                    const int pos = atomicAdd((int*)&lcnt[lane], 1);
                    sel_ep[(wid * 16 + r0 + u) * 8 + cnt[u]] = lane | (pos << 8);
                    sel_w[(wid * 16 + r0 + u) * 8 + cnt[u]] = sg[u] / wsum[u] * 2.5f;
                }
            }
        }
        __syncthreads();
        if (tid < 64) { int tt = tid; asm volatile("" : "+v"(tt)); lbase[tt] = atomicAdd(&gcnt[tt], lcnt[tt]); }
        __syncthreads();
        for (int idx = tid; idx < 1024; idx += 512) {
            const int ep = sel_ep[idx], e = ep & 0xff, pos = ep >> 8, gi = lbase[e] + pos;
            LDST[(size_t)e * T + gi] = (t0 + (idx >> 3)) * NSLOT + (idx & 7);
            LWt[(size_t)e * T + gi] = sel_w[idx];
        }
    }
}

constexpr int LDS_ROWTAB = LDS_TAB, LDS_AUX = LDS_TAB + 12288, MOE_MAX_UNITS = 20, LDS_UTAB = LDS_CTL + 256, LDS_TSTART = LDS_UTAB + MOE_MAX_UNITS * 32;
__device__ __forceinline__ int moe_setup(const Params& p, LAS unsigned char* lds0, int nN, int bmul, int badd) {
    LAS int* tstart = (LAS int*)(lds0 + LDS_TSTART); LAS int* utab = (LAS int*)(lds0 + LDS_UTAB);
    const int* gcnt = (const int*)(p.ws + OFF_CNT);
    __syncthreads();
    if (hw_tid() == 0) {
        int a = 0;
        for (int e = 0; e < NEX; ++e) { const int c = e < NE ? gcnt[e] : T; tstart[e] = a; a += (c + 255) >> 8; }
        tstart[NEX] = a;
    }
    __syncthreads();
    const int total = tstart[NEX] * nN, G = gridDim.x, c = vcu_of_block();
    if (hw_tid() < MOE_MAX_UNITS) {
        const int i = hw_tid(), L = i * G + c;
        int pm = 0, pn = 0, e = 0, i0 = 0, cnt = 0;
        if (L < total) {
            const int mt = L / nN, pl = L % nN;
            for (int j = 1; j < NEX; ++j) e += (mt >= tstart[j]) ? 1 : 0;
            pm = mt; pn = e * bmul + badd + pl; i0 = (mt - tstart[e]) * 256; cnt = e < NE ? gcnt[e] : T;
        }
        utab[i * 8 + 0] = pm; utab[i * 8 + 1] = pn; utab[i * 8 + 2] = e; utab[i * 8 + 3] = i0; utab[i * 8 + 4] = cnt;
    }
    __syncthreads();
    const int n = (total - c + G - 1) / G;
    return n < 0 ? 0 : (n > MOE_MAX_UNITS ? MOE_MAX_UNITS : n);
}
struct MoeSched {
    LAS const int* utab; LAS const unsigned* rowtab; int n;
    __device__ __forceinline__ bool next(int i, pg8::Unit& u) const {
        if (i >= n) return false;
        u.pm = __builtin_amdgcn_readfirstlane(utab[i * 8 + 0]); u.pn = __builtin_amdgcn_readfirstlane(utab[i * 8 + 1]); u.e = __builtin_amdgcn_readfirstlane(utab[i * 8 + 2]); u.idx = i; return true;
    }
    __device__ __forceinline__ unsigned row_off(int i, int r) const { return rowtab[i * 256 + r]; }
    __device__ __forceinline__ void a_ready(const pg8::Unit&) const {}
    __device__ __forceinline__ void done(const pg8::Unit&) const {}
};
struct EpiGU {
    static constexpr bool PERM = true;
    LAS const float* auxw; unsigned char* ws;
    __device__ __forceinline__ void operator()(const f32x4 (&acc)[2][2][4][2], const pg8::Unit& u, int wr, int wc, int fr, int fq) const {
        const int pl = u.pn & 1;
        bf16_t* ACT = (bf16_t*)(ws + OFF_ACT) + (size_t)u.pm * 256 * FF + pl * 128 + wc * 32 + 8 * fq;
#pragma unroll
        for (int ai = 0; ai < 2; ++ai)
#pragma unroll
            for (int m = 0; m < 4; ++m) {
                const int rl = ai * 128 + wr * 64 + m * 16 + fr;
                const float wrow = auxw[u.idx * 256 + rl];
                float a[8];
#pragma unroll
                for (int n = 0; n < 2; ++n)
#pragma unroll
                    for (int q = 0; q < 4; ++q) { const float g = acc[ai][0][m][n][q], uu = acc[ai][1][m][n][q]; a[n * 4 + q] = g / (1.f + __expf(-g)) * uu * wrow; }
                u32x4 w; w.x = pk2(a[0], a[1]); w.y = pk2(a[2], a[3]); w.z = pk2(a[4], a[5]); w.w = pk2(a[6], a[7]);
                *(u32x4*)(ACT + (size_t)rl * FF) = w;
            }
    }
};
__device__ __forceinline__ void phase_gateup(const Params& p, LAS unsigned char* lds0) {
    int n = moe_setup(p, lds0, 2, 2, 0); n = n > 12 ? 12 : n;
    LAS const int* utab = (LAS const int*)(lds0 + LDS_UTAB);
    LAS unsigned* rowtab = (LAS unsigned*)(lds0 + LDS_ROWTAB);
    LAS float* auxw = (LAS float*)(lds0 + LDS_AUX);
    const int* LDST = (const int*)(p.ws + OFF_LDST);
    const float* LWt = (const float*)(p.ws + OFF_LW);
    for (int i = 0; i < n; ++i) {
        const int e = utab[i * 8 + 2], i0 = utab[i * 8 + 3], cnt = utab[i * 8 + 4];
        if (hw_tid() < 256) {
            const int li = i0 + hw_tid(); int tok = 0; float w = 0.f;
            if (li < cnt) { if (e < NE) { tok = LDST[(size_t)e * T + li] / NSLOT; w = LWt[(size_t)e * T + li]; } else { tok = li; w = 1.f; } }
            rowtab[i * 256 + hw_tid()] = (unsigned)tok * (unsigned)(D * 2);
            auxw[i * 256 + hw_tid()] = w;
        }
    }
    __syncthreads();
    MoeSched S{utab, rowtab, n};
    pg8::Gemm g{(const bf16_t*)(p.ws + OFF_H), (const bf16_t*)(p.ws + OFF_WGU)};
    EpiGU E{auxw, p.ws};
    pg8::gemm_phase<D, EpiGU, MoeSched, true>(lds0, g, S, E);
}
constexpr float FP8S = 32.f, FP8I = 1.f / 32.f;
__device__ __forceinline__ unsigned pk4_fp8(float a, float b, float c, float d) {
    a = __builtin_amdgcn_fmed3f(a * FP8S, -440.f, 440.f); b = __builtin_amdgcn_fmed3f(b * FP8S, -440.f, 440.f);
    c = __builtin_amdgcn_fmed3f(c * FP8S, -440.f, 440.f); d = __builtin_amdgcn_fmed3f(d * FP8S, -440.f, 440.f);
    int w = __builtin_amdgcn_cvt_pk_fp8_f32(a, b, 0, false);
    w = __builtin_amdgcn_cvt_pk_fp8_f32(c, d, w, true);
    return (unsigned)w;
}
struct EpiDown {
    static constexpr bool PERM = true;
    LAS const int* auxd; unsigned char* ws;
    __device__ __forceinline__ void operator()(const f32x4 (&acc)[2][2][4][2], const pg8::Unit& u, int wr, int wc, int fr, int fq) const {
        const int pl = u.pn & 3;
        unsigned char* SL = ws + OFF_SLOTS + pl * 256 + wc * 64 + 16 * fq;
#pragma unroll
        for (int ai = 0; ai < 2; ++ai)
#pragma unroll
            for (int m = 0; m < 4; ++m) {
                const int d = auxd[u.idx * 256 + ai * 128 + wr * 64 + m * 16 + fr];
                u32x4 w;
                w.x = pk4_fp8(acc[ai][0][m][0][0], acc[ai][0][m][0][1], acc[ai][0][m][0][2], acc[ai][0][m][0][3]);
                w.y = pk4_fp8(acc[ai][0][m][1][0], acc[ai][0][m][1][1], acc[ai][0][m][1][2], acc[ai][0][m][1][3]);
                w.z = pk4_fp8(acc[ai][1][m][0][0], acc[ai][1][m][0][1], acc[ai][1][m][0][2], acc[ai][1][m][0][3]);
                w.w = pk4_fp8(acc[ai][1][m][1][0], acc[ai][1][m][1][1], acc[ai][1][m][1][2], acc[ai][1][m][1][3]);
                *(u32x4*)(SL + (size_t)d * 1024) = w;
            }
    }
};
__device__ __forceinline__ void phase_down(const Params& p, LAS unsigned char* lds0) {
    const int n = moe_setup(p, lds0, 4, 4, 0);
    LAS const int* utab = (LAS const int*)(lds0 + LDS_UTAB);
    LAS int* auxd = (LAS int*)(lds0 + LDS_TAB);
    const int* LDST = (const int*)(p.ws + OFF_LDST);
    for (int i = 0; i < n; ++i) {
        const int e = utab[i * 8 + 2], i0 = utab[i * 8 + 3], cnt = utab[i * 8 + 4];
        if (hw_tid() < 256) {
            const int li = i0 + hw_tid();
            auxd[i * 256 + hw_tid()] = li < cnt ? (e < NE ? LDST[(size_t)e * T + li] : li * NSLOT + 8) : T * NSLOT;
        }
    }
    __syncthreads();
    MoeSched S{utab, (LAS const unsigned*)(lds0 + LDS_ROWTAB), n};
    pg8::Gemm g{(const bf16_t*)(p.ws + OFF_ACT), (const bf16_t*)(p.ws + OFF_WD)};
    EpiDown E{auxd, p.ws};
    pg8::gemm_phase<FF, EpiDown, MoeSched, false>(lds0, g, S, E);
}

__device__ __forceinline__ void slot_sum16(const unsigned char* SL, int t, int cb, float (&s)[16]) {
#pragma unroll
    for (int i = 0; i < 16; ++i) s[i] = 0.f;
    u32x4 v[NSLOT];
#pragma unroll
    for (int k = 0; k < NSLOT; ++k) v[k] = *(const u32x4*)(SL + (size_t)(t * NSLOT + k) * 1024 + cb);
#pragma unroll
    for (int k = 0; k < NSLOT; ++k)
#pragma unroll
        for (int i = 0; i < 4; ++i) {
            typedef float f32x2 __attribute__((ext_vector_type(2)));
            const f32x2 lo = __builtin_amdgcn_cvt_pk_f32_fp8((int)v[k][i], false), hi = __builtin_amdgcn_cvt_pk_f32_fp8((int)v[k][i], true);
            s[4 * i] += lo.x; s[4 * i + 1] += lo.y; s[4 * i + 2] += hi.x; s[4 * i + 3] += hi.y;
        }
#pragma unroll
    for (int i = 0; i < 16; ++i) s[i] *= FP8I;
}
__device__ __forceinline__ int slot_col(int bb) { return (bb >> 4) * 256 + ((bb >> 2) & 3) * 32 + (bb & 3) * 8; }
__device__ __forceinline__ void phase_final(const Params& p) {
    const int lane = hw_tid() & 63, gw = blockIdx.x * 8 + (hw_tid() >> 6), ngw = gridDim.x * 8;
    const float* mod = (const float*)(p.ws + OFF_MOD);
    const unsigned char* SL = p.ws + OFF_SLOTS;
    const int c0 = slot_col(lane);
    for (int row = gw; row < T; row += ngw) {
        const float* g2 = mod + (size_t)(row / SEQ) * MODW + 5 * D;
        float f[16];
        slot_sum16(SL, row, lane * 16, f);
        f32x4 y[4]; float s = 0.f;
#pragma unroll
        for (int j = 0; j < 4; ++j) {
            const int cj = c0 + (j >> 1) * 128 + (j & 1) * 4;
            const f32x4 xm = *(const f32x4*)(p.out + (size_t)row * D + cj), gg = *(const f32x4*)(g2 + cj);
            y[j][0] = ALPHA * xm[0] + gg[0] * f[4 * j]; y[j][1] = ALPHA * xm[1] + gg[1] * f[4 * j + 1];
            y[j][2] = ALPHA * xm[2] + gg[2] * f[4 * j + 2]; y[j][3] = ALPHA * xm[3] + gg[3] * f[4 * j + 3];
            s += (y[j][0] + y[j][1]) + (y[j][2] + y[j][3]);
        }
#pragma unroll
        for (int o = 1; o < 64; o <<= 1) s += __shfl_xor(s, o);
        const float mean = s * (1.f / D);
        float qv = 0.f;
#pragma unroll
        for (int j = 0; j < 4; ++j) { y[j] = y[j] - mean; qv += (y[j][0] * y[j][0] + y[j][1] * y[j][1]) + (y[j][2] * y[j][2] + y[j][3] * y[j][3]); }
#pragma unroll
        for (int o = 1; o < 64; o <<= 1) qv += __shfl_xor(qv, o);
        const float rstd = 1.0f / sqrtf(qv * (1.f / D) + 1e-5f);
#pragma unroll
        for (int j = 0; j < 4; ++j) {
            const int cj = c0 + (j >> 1) * 128 + (j & 1) * 4;
            const f32x4 g = *(const f32x4*)(p.ln2_g + cj), bb4 = *(const f32x4*)(p.ln2_b + cj);
            *(f32x4*)(p.out + (size_t)row * D + cj) = y[j] * rstd * g + bb4;
        }
    }
}

#define XB_TMO      128
#define XB_XCNT(j)  (256  + 64 * (j))
#define XB_XSUB(j)  (1280 + 64 * (j))
#define XB_XGEN(j)  (2304 + 64 * (j))
#define XB_TOP      3328
#define XB_TOPGEN   3392
#define XCD_BAR_WORDS 3456
#define XB_SPIN_CAP (1u << 18)
__device__ __forceinline__ unsigned xb_ld(unsigned* p)              { return __hip_atomic_load(p, __ATOMIC_RELAXED, __HIP_MEMORY_SCOPE_AGENT); }
__device__ __forceinline__ unsigned xb_add(unsigned* p, unsigned v) { return __hip_atomic_fetch_add(p, v, __ATOMIC_RELAXED, __HIP_MEMORY_SCOPE_AGENT); }
__device__ __forceinline__ unsigned xb_xcc_id() { return (unsigned)__builtin_amdgcn_s_getreg((3 << 11) | 20) & 0xFu; }
#define XB_SPIN(cond, bar) do { unsigned _sp = 0; while (cond) { __builtin_amdgcn_s_sleep(1); \
    if ((++_sp & 255u) == 0u) { if (xb_ld(&(bar)[XB_TMO])) break; if (_sp > XB_SPIN_CAP) { atomicAdd(&(bar)[XB_TMO], 1u); break; } } } } while (0)
struct XcdBarrier { unsigned* bar; unsigned x; volatile LAS unsigned* st; };
__device__ __forceinline__ XcdBarrier xcd_barrier_post(unsigned* bar, volatile LAS unsigned* st) {
    XcdBarrier b; b.bar = bar; b.x = xb_xcc_id(); b.st = st;
    if (hw_tid() == 0) (void)xb_add(&bar[XB_XCNT(b.x)], 1u);
    return b;
}
__device__ __forceinline__ void xcd_barrier_complete(unsigned* bar, unsigned x, unsigned& nloc, unsigned& nx) {
    const unsigned G = gridDim.x * gridDim.y * gridDim.z;
    unsigned sum, cnt, mine, sp = 0u;
    for (;;) {
        sum = 0u; cnt = 0u; mine = 0u;
#pragma unroll
        for (unsigned j = 0; j < 16; ++j) { const unsigned c = xb_ld(&bar[XB_XCNT(j)]); sum += c; cnt += (c > 0u) ? 1u : 0u; mine = (j == x) ? c : mine; }
        if (sum == G) break;
        __builtin_amdgcn_s_sleep(1);
        if ((++sp & 255u) == 0u) { if (xb_ld(&bar[XB_TMO])) break; if (sp > XB_SPIN_CAP) { atomicAdd(&bar[XB_TMO], 1u); break; } }
    }
    nloc = mine > 0u ? mine : 1u; nx = cnt > 0u ? cnt : 1u;
}
__device__ __forceinline__ void xcd_barrier(const XcdBarrier& b) {
    asm volatile("s_waitcnt vmcnt(0)" ::: "memory");
    __syncthreads();
    if (hw_tid() == 0) {
        unsigned* bar = b.bar;
        __builtin_amdgcn_s_waitcnt(0);
        unsigned nloc = b.st[0], nx = b.st[1];
        if (nloc == 0u) { xcd_barrier_complete(bar, b.x, nloc, nx); b.st[0] = nloc; b.st[1] = nx; }
        const unsigned old = xb_add(&bar[XB_XSUB(b.x)], 1u);
        const unsigned gen = old / nloc;
        if (old + 1u == (gen + 1u) * nloc) {
            __builtin_amdgcn_fence(__ATOMIC_RELEASE, "agent");
            asm volatile("s_waitcnt vmcnt(0)" ::: "memory");
            const unsigned og = xb_add(&bar[XB_TOP], 1u);
            const unsigned tg = og / nx;
            if (og + 1u == (tg + 1u) * nx) xb_add(&bar[XB_TOPGEN], 1u);
            else XB_SPIN(xb_ld(&bar[XB_TOPGEN]) == tg, bar);
            __builtin_amdgcn_fence(__ATOMIC_ACQUIRE, "agent");
            xb_add(&bar[XB_XGEN(b.x)], 1u);
            asm volatile("s_waitcnt vmcnt(0)" ::: "memory");
        } else {
            XB_SPIN(xb_ld(&bar[XB_XGEN(b.x)]) == gen, bar);
            __builtin_amdgcn_fence(__ATOMIC_ACQUIRE, "agent");
            asm volatile("s_waitcnt vmcnt(0)" ::: "memory");
        }
    }
    __syncthreads();
}

constexpr size_t OFF_BAR = 448 * 1024;

__global__ void __launch_bounds__(512, 2) mk_fwd(Params p) {
    extern __shared__ __attribute__((aligned(16))) unsigned char smem[];
    LAS unsigned char* lds0 = (LAS unsigned char*)smem;
    {
        const unsigned hw = (unsigned)__builtin_amdgcn_s_getreg((5 << 11) | 4) & 63u;
        if ((threadIdx.x & 63) == 0) *(volatile LAS int*)(LDS_HWTAB + hw * 4) = (int)(threadIdx.x >> 6);
        if (threadIdx.x < 64) ((LAS unsigned*)(lds0 + LDS_CTL))[threadIdx.x] = 0u;
    }
    __syncthreads();
    XcdBarrier bar; bar.bar = (unsigned*)(p.ws + OFF_BAR); bar.x = 0; bar.st = nullptr;
    bar = xcd_barrier_post((unsigned*)(p.ws + OFF_BAR), (volatile LAS unsigned*)(lds0 + LDS_CTL));
#ifndef PROBE
#define PROBE -1
#endif
#ifndef PROBE_END
#define PROBE_END (PROBE + 1)
#endif
    unsigned long long pt0 = 0, pt1 = 0;
#define RUN_PHASE(k, call) { if ((k) > 0) xcd_barrier(bar); if (PROBE >= 0 && (k) == PROBE) pt0 = __builtin_amdgcn_s_memrealtime(); if (PROBE >= 0 && (k) == PROBE_END) pt1 = __builtin_amdgcn_s_memrealtime(); \
    int on_ = 1; asm volatile("" : "+s"(on_)); if (on_) { int grp_ = hw_tid() >> 8; asm volatile("" : "+v"(grp_)); LAS unsigned char* lds = lds0 + grp_ * 32768; (void)lds; call; } }
    RUN_PHASE(0, phase_prep(p, lds))
    RUN_PHASE(1, phase_xn(p))
    RUN_PHASE(2, phase_inproj(p, lds0))
    RUN_PHASE(3, phase_attn_pool(p, lds, (char*)smem))
    RUN_PHASE(4, phase_outproj(p, lds0))
    RUN_PHASE(5, phase_router(p, lds0))
    RUN_PHASE(6, phase_gateup(p, lds0))
    RUN_PHASE(7, phase_down(p, lds0))
    RUN_PHASE(8, phase_final(p))
    if (PROBE >= 0) {
        if (PROBE_END == 9) pt1 = __builtin_amdgcn_s_memrealtime();
        if (blockIdx.x == 0 && hw_tid() == 0) { const unsigned long long tend = __builtin_amdgcn_s_memrealtime() + 8ull * (pt1 - pt0); while (__builtin_amdgcn_s_memrealtime() < tend) __builtin_amdgcn_s_sleep(8); }
    }
}

extern "C" void kernel_launch(void* const* d_in, const int* in_sizes, int n_in, void* d_out, int out_size, void* d_ws, size_t ws_size, hipStream_t stream) {
    static int grid = 0;
    if (grid == 0) {
        int dev = 0, cus = 0, per_cu = 0;
        (void)hipGetDevice(&dev);
        (void)hipDeviceGetAttribute(&cus, hipDeviceAttributeMultiprocessorCount, dev);
        (void)hipFuncSetAttribute((const void*)mk_fwd, hipFuncAttributeMaxDynamicSharedMemorySize, LDS_BYTES);
        (void)hipOccupancyMaxActiveBlocksPerMultiprocessor(&per_cu, (const void*)mk_fwd, 512, LDS_BYTES);
        if (per_cu < 1) fprintf(stderr, "kernel_launch: occupancy query says %d blocks per CU\n", per_cu);
        (void)hipGetLastError();
        grid = cus;
        if (ws_size < WS_NEED) fprintf(stderr, "kernel_launch: workspace too small: %zu < %zu\n", ws_size, (size_t)WS_NEED);
    }
    Params p{};
    const float** pp = (const float**)&p;
    for (int i = 0; i < 24; ++i) pp[i] = (const float*)d_in[i];
    p.out = (float*)d_out; p.ws = (unsigned char*)d_ws;
    (void)hipMemsetAsync((char*)d_ws + OFF_BAR, 0, XCD_BAR_WORDS * 4, stream);
    hipLaunchKernelGGL(mk_fwd, dim3(grid), dim3(512), LDS_BYTES, stream, p);
}
```

```cpp
#include <hip/hip_runtime.h>
#include <stdint.h>
#include <stdio.h>


#define LAS __attribute__((address_space(3)))
#define TIDX ((int)(hw_tid() & 255))
#define VBLK ((int)(blockIdx.x * 2 + (hw_tid() >> 8)))
#define NVBLK ((int)(gridDim.x * 2))
typedef unsigned short bf16_t;
typedef short bf16x8 __attribute__((ext_vector_type(8)));
typedef float f32x4 __attribute__((ext_vector_type(4)));
typedef unsigned u32x4 __attribute__((ext_vector_type(4)));
typedef unsigned u32x2 __attribute__((ext_vector_type(2)));

constexpr int D = 1024, NB = 16, SEQ = 2048, T = NB * SEQ, CTXL = 256, TC = NB * CTXL, KVL = CTXL + SEQ;
constexpr int PW = 1536, NE = 64, NEX = 65, FF = 256, NSLOT = 9, MODW = 6 * D;
constexpr float ALPHA = 1.189207115002721f;
constexpr float C2 = 0.125f * 1.4426950408889634f;
constexpr int NPHASE = 9;
constexpr int LDS_BYTES = 163840, LDS_TAB = 131072, LDS_CTL = 155648;
constexpr int LDS_HWTAB = LDS_CTL + 2048;
__device__ __forceinline__ int hw_tid() {
    const unsigned hw = (unsigned)__builtin_amdgcn_s_getreg((5 << 11) | 4) & 63u;
    const int w = __builtin_amdgcn_readfirstlane(*(volatile LAS int*)(LDS_HWTAB + hw * 4));
    return w * 64 + (int)__builtin_amdgcn_mbcnt_hi(~0u, __builtin_amdgcn_mbcnt_lo(~0u, 0u));
}

constexpr size_t MiB = 1u << 20;
constexpr size_t OFF_CNT = 0, OFF_MOD = 4096, OFF_ROPE = 512 * 1024;
constexpr size_t OFF_WTIN = 1 * MiB, OFF_WTOUT = 4 * MiB, OFF_WD = 6 * MiB, OFF_LDST = 39 * MiB, OFF_ACT = 47 * MiB;
constexpr size_t OFF_SLOTS = 201 * MiB;
constexpr size_t OFF_WGU = 201 * MiB, OFF_H = 266 * MiB, OFF_LW = 330 * MiB;
constexpr size_t OFF_XN = 47 * MiB, OFF_Q = 119 * MiB, OFF_K = 167 * MiB;
constexpr size_t OFF_V = 338 * MiB, OFF_U = 356 * MiB, OFF_AO = 372 * MiB, OFF_STATS = 436 * MiB;
constexpr size_t OFF_WRH = 490 * MiB, OFF_WRL = OFF_WRH + 128 * 1024;
constexpr size_t WS_NEED = 491 * MiB;

struct Params {
    const float *x, *c, *ctx, *c_ctx, *w_mod, *b_mod, *w_in, *q_norm, *k_norm, *pool_w, *pool_scale, *w_out, *ln1_g, *ln1_b,
        *w_router, *router_bias, *w_gate, *w_up, *w_down, *ws_gate, *ws_up, *ws_down, *ln2_g, *ln2_b;
    float* out;
    unsigned char* ws;
};

__device__ __forceinline__ unsigned f2bf(float f) { unsigned u = __float_as_uint(f); return (u + 0x7fffu + ((u >> 16) & 1u)) >> 16; }
__device__ __forceinline__ unsigned pk2(float lo, float hi) { return f2bf(lo) | (f2bf(hi) << 16); }
__device__ __forceinline__ float bf2f(unsigned h) { return __uint_as_float(h << 16); }
__device__ __forceinline__ float bflo(unsigned w) { return __uint_as_float(w << 16); }
__device__ __forceinline__ float bfhi(unsigned w) { return __uint_as_float(w & 0xffff0000u); }

namespace pg8 {
constexpr int BM = 256, BK = 64, HALF = 128, HTB = HALF * BK * 2, STAGE_BYTES = 8 * HTB;
__host__ __device__ __forceinline__ int lds_byte(int r, int c) { const int st = (r >> 4) * 2 + (c >> 5), rr = r & 15, cc = c & 31, ob = rr * 64 + cc * 2; return st * 1024 + (ob ^ (((ob >> 9) & 1) << 5)); }
__host__ __device__ __forceinline__ void stage_rc(int b, int& R, int& C) { const int st = b / 1024, sb = b % 1024, swz = sb ^ (((sb >> 9) & 1) << 5); R = (st >> 1) * 16 + swz / 64; C = (st & 1) * 32 + (swz % 64) / 2; }
__host__ __device__ __forceinline__ int perm32(int rho) { const int n = rho >> 4, i = rho & 15; return 8 * (i >> 2) + 4 * n + (i & 3); }
struct Unit { int pm, pn, idx, e; };
struct Gemm { const bf16_t* A; const bf16_t* Bt; };
__device__ __forceinline__ unsigned cvt_pk_bf16(float lo, float hi) { unsigned r; asm volatile("v_cvt_pk_bf16_f32 %0, %1, %2" : "=v"(r) : "v"(lo), "v"(hi)); return r; }

template <int K, class Epi, class Sched, bool GATHER, bool ALIGN_EPI = true>
__device__ __forceinline__ void gemm_phase(LAS unsigned char* lds, const Gemm g, const Sched& S, const Epi& E) {
    const int tid = hw_tid(), wid = __builtin_amdgcn_readfirstlane(tid >> 6), lane = tid & 63, wr = wid >> 2, wc = wid & 3, fr = lane & 15, fq = lane >> 4;
    constexpr int nt = K / BK;
    unsigned voffA[2], voffB[2], colA = 0; int rowA = 0;
#pragma unroll
    for (int i = 0; i < 2; ++i) { int R, C; stage_rc(tid * 16 + i * 8192, R, C); const int Rb = Epi::PERM ? ((R & ~31) + perm32(R & 31)) : R;
        voffA[i] = (unsigned)(R * K + C) * 2u; voffB[i] = (unsigned)(Rb * K + C) * 2u; if (i == 0) { colA = (unsigned)C * 2u; rowA = R; } }
    const size_t kstep = (size_t)(BK * 2);
    const size_t hstep = (size_t)HALF * K * 2;
    const size_t tstep = 2 * hstep;
    const unsigned ldsw = (unsigned)wid * 1024u;
    const int aoff = lds_byte(wr * 64 + fr, fq * 8), boff = lds_byte(wc * 32 + fr, fq * 8);
#define PG8_SA(b, h) (((b) * 2 + (h)) * HTB)
#define PG8_SB(b, h) ((4 + (b) * 2 + (h)) * HTB)
#define PG8_STAGE(bufoff, gbase, voff) do { _Pragma("unroll") for (int _i = 0; _i < 2; ++_i) \
        __builtin_amdgcn_global_load_lds((const unsigned*)((const char*)(gbase) + (voff)[_i]), (LAS unsigned*)(lds + (bufoff) + ldsw + _i * 8192), 16, 0, 0); } while (0)
#define PG8_STAGE_A(bufoff, ptr, h, NX) do { if constexpr (GATHER) { unsigned _v[2]; \
            if (NX) { _v[0] = S.row_off(nidx, (h) * HALF + rowA) + colA; _v[1] = S.row_off(nidx, (h) * HALF + rowA + 64) + colA; } else { _v[0] = vA[h][0]; _v[1] = vA[h][1]; } PG8_STAGE(bufoff, ptr, _v); } \
        else { PG8_STAGE(bufoff, (ptr) + (h) * hstep, voffA); } } while (0)
#define PG8_LDA(dst, b, h) do { _Pragma("unroll") for (int m = 0; m < 4; ++m) _Pragma("unroll") for (int k = 0; k < 2; ++k) dst[m][k] = *(const LAS bf16x8*)(lds + PG8_SA(b, h) + aoff + m * 2048 + k * 1024); } while (0)
#define PG8_LDB(dst, b, h) do { _Pragma("unroll") for (int n = 0; n < 2; ++n) _Pragma("unroll") for (int k = 0; k < 2; ++k) dst[n][k] = *(const LAS bf16x8*)(lds + PG8_SB(b, h) + boff + n * 2048 + k * 1024); } while (0)
#define PG8_MMA(ai, bj, At, Bt) do { __builtin_amdgcn_s_setprio(1); _Pragma("unroll") for (int m = 0; m < 4; ++m) _Pragma("unroll") for (int n = 0; n < 2; ++n) _Pragma("unroll") for (int k = 0; k < 2; ++k) \
        acc[ai][bj][m][n] = __builtin_amdgcn_mfma_f32_16x16x32_bf16(Bt[n][k], At[m][k], acc[ai][bj][m][n], 0, 0, 0); __builtin_amdgcn_s_setprio(0); } while (0)
#define PG8_WAIT_V(n) asm volatile("s_waitcnt vmcnt(" #n ")" ::: "memory")
#define PG8_WAIT_L(n) asm volatile("s_waitcnt lgkmcnt(" #n ")" ::: "memory")
#define PG8_BAR __builtin_amdgcn_s_barrier()
#define PG8_SCHED __builtin_amdgcn_sched_barrier(0)
    Unit cur, nxt; int ui = 0;
    if (!S.next(0, cur)) return;
    f32x4 acc[2][2][4][2];
#pragma unroll
    for (int a = 0; a < 2; ++a)
#pragma unroll
        for (int b = 0; b < 2; ++b)
#pragma unroll
            for (int m = 0; m < 4; ++m)
#pragma unroll
                for (int n = 0; n < 2; ++n) acc[a][b][m][n] = (f32x4){0.f, 0.f, 0.f, 0.f};
    bf16x8 At[4][2], B0[2][2], B1[2][2];
    unsigned vA[2][2]; int nidx = 0;
    if constexpr (GATHER) {
#pragma unroll
        for (int h = 0; h < 2; ++h)
#pragma unroll
            for (int i = 0; i < 2; ++i) vA[h][i] = S.row_off(cur.idx, h * HALF + rowA + 64 * i) + colA;
    }
    const char* cA = GATHER ? (const char*)g.A : (const char*)g.A + (size_t)cur.pm * tstep; const char* cB = (const char*)g.Bt + (size_t)cur.pn * tstep;
    S.a_ready(cur);
    PG8_STAGE(PG8_SB(0, 0), cB, voffB); PG8_STAGE(PG8_SB(0, 1), cB + hstep, voffB); PG8_STAGE_A(PG8_SA(0, 0), cA, 0, false); PG8_STAGE_A(PG8_SA(0, 1), cA, 1, false);
    if (wr == 1) PG8_BAR;
    PG8_WAIT_V(2); PG8_BAR;
    PG8_STAGE(PG8_SB(1, 0), cB + kstep, voffB); PG8_STAGE_A(PG8_SA(1, 0), cA + kstep, 0, false); PG8_STAGE(PG8_SB(1, 1), cB + hstep + kstep, voffB);
    PG8_WAIT_V(6); PG8_BAR;
    for (;;) {
        const bool has_next = S.next(ui + 1, nxt);
        if constexpr (GATHER) nidx = has_next ? nxt.idx : cur.idx;
        const char* nA = GATHER ? (const char*)g.A : (has_next ? (const char*)g.A + (size_t)nxt.pm * tstep : cA); const char* nB = has_next ? (const char*)g.Bt + (size_t)nxt.pn * tstep : cB;
        for (int t = 0; t < nt; t += 2) {
            const bool last = (t == nt - 2);
            const char* a1 = cA + (size_t)(t + 1) * kstep;
            const char* a2 = last ? nA : cA + (size_t)(t + 2) * kstep; const char* b2 = last ? nB : cB + (size_t)(t + 2) * kstep;
            const char* a3 = a2 + kstep; const char* b3 = b2 + kstep;
            if (last && has_next) S.a_ready(nxt);
            PG8_LDB(B0, 0, 0); PG8_LDB(B1, 0, 1); PG8_SCHED; PG8_LDA(At, 0, 0); PG8_STAGE_A(PG8_SA(1, 1), a1, 1, false);
            PG8_WAIT_V(8); PG8_WAIT_L(0); PG8_BAR; PG8_MMA(0, 0, At, B0); PG8_MMA(0, 1, At, B1); PG8_BAR; PG8_SCHED;
            PG8_LDA(At, 0, 1); PG8_STAGE(PG8_SB(0, 0), b2, voffB); PG8_STAGE(PG8_SB(0, 1), b2 + hstep, voffB); PG8_STAGE_A(PG8_SA(0, 0), a2, 0, last);
            PG8_WAIT_V(8); PG8_WAIT_L(0); PG8_BAR; PG8_MMA(1, 0, At, B0); PG8_MMA(1, 1, At, B1); PG8_BAR; PG8_SCHED;
            PG8_LDB(B0, 1, 0); PG8_LDB(B1, 1, 1); PG8_SCHED; PG8_LDA(At, 1, 0); PG8_STAGE_A(PG8_SA(0, 1), a2, 1, last);
            PG8_WAIT_V(8); PG8_WAIT_L(0); PG8_BAR; PG8_MMA(0, 0, At, B0); PG8_MMA(0, 1, At, B1); PG8_BAR; PG8_SCHED;
            PG8_LDA(At, 1, 1); PG8_STAGE(PG8_SB(1, 0), b3, voffB); PG8_STAGE(PG8_SB(1, 1), b3 + hstep, voffB); PG8_STAGE_A(PG8_SA(1, 0), a3, 0, last);
            PG8_WAIT_V(8); PG8_WAIT_L(0); PG8_BAR; PG8_MMA(1, 0, At, B0); PG8_MMA(1, 1, At, B1); PG8_BAR; PG8_SCHED;
        }
        if constexpr (ALIGN_EPI) { if (wr == 0) PG8_BAR; }
        E(acc, cur, wr, wc, fr, fq); S.done(cur);
        if (!has_next) break;
#pragma unroll
        for (int a = 0; a < 2; ++a)
#pragma unroll
            for (int b = 0; b < 2; ++b)
#pragma unroll
                for (int m = 0; m < 4; ++m)
#pragma unroll
                    for (int n = 0; n < 2; ++n) acc[a][b][m][n] = (f32x4){0.f, 0.f, 0.f, 0.f};
        cur = nxt; cA = nA; cB = nB; ++ui;
        if constexpr (GATHER) {
#pragma unroll
            for (int h = 0; h < 2; ++h)
#pragma unroll
                for (int i = 0; i < 2; ++i) vA[h][i] = S.row_off(cur.idx, h * HALF + rowA + 64 * i) + colA;
        }
        if constexpr (ALIGN_EPI) { if (wr == 1) PG8_BAR; }
    }
    PG8_WAIT_V(0);
    if constexpr (!ALIGN_EPI) { if (wr == 0) PG8_BAR; }
    PG8_BAR;
#undef PG8_SA
#undef PG8_SB
#undef PG8_STAGE
#undef PG8_STAGE_A
#undef PG8_LDA
#undef PG8_LDB
#undef PG8_MMA
#undef PG8_WAIT_V
#undef PG8_WAIT_L
#undef PG8_BAR
#undef PG8_SCHED
}

struct DenseSched {
    int nN, n1, total, pn2lo, nN2, G, c;
    __device__ __forceinline__ bool next(int i, Unit& u) const {
        const int L = i * G + c; if (L >= total) return false;
        if (L < n1) { u.pm = L / nN; u.pn = L % nN; } else { const int r = L - n1; u.pm = n1 / nN + r / nN2; u.pn = pn2lo + r % nN2; }
        u.idx = i; u.e = 0; return true;
    }
    __device__ __forceinline__ void a_ready(const Unit&) const {}
    __device__ __forceinline__ void done(const Unit&) const {}
};
}

__device__ __forceinline__ int win_row(int n) { return (n & ~255) + 128 * ((n >> 5) & 1) + 32 * ((n >> 6) & 3) + (n & 31); }
__device__ __forceinline__ int gu_row(int j, int half) { return (j >> 7) * 256 + half * 128 + (j & 127); }

template <class RowMap>
__device__ __forceinline__ void transpose_tile(LAS float* tile, const float* src, int ld, int k0, int n0, bf16_t* dst, int Kdst, RowMap rowmap) {
    const int tid = TIDX;
#pragma unroll
    for (int pss = 0; pss < 4; ++pss) {
        const int k = pss * 16 + (tid >> 4), n4 = (tid & 15) * 4;
        const f32x4 v = *(const f32x4*)(src + (size_t)(k0 + k) * ld + n0 + n4);
        tile[k * 65 + n4 + 0] = v[0]; tile[k * 65 + n4 + 1] = v[1]; tile[k * 65 + n4 + 2] = v[2]; tile[k * 65 + n4 + 3] = v[3];
    }
    __syncthreads();
    {
        const int n = tid >> 2, kc = (tid & 3) * 16;
        unsigned w[8];
#pragma unroll
        for (int i = 0; i < 8; ++i) w[i] = pk2(tile[(kc + 2 * i) * 65 + n], tile[(kc + 2 * i + 1) * 65 + n]);
        bf16_t* dp = dst + (size_t)rowmap(n0 + n) * Kdst + k0 + kc;
        *(u32x4*)dp = (u32x4){w[0], w[1], w[2], w[3]};
        *(u32x4*)(dp + 8) = (u32x4){w[4], w[5], w[6], w[7]};
    }
    __syncthreads();
}

template <class RowMap>
__device__ __forceinline__ void wave_transpose(LAS float* scr, const float* src, int ld, int k0, int n0, bf16_t* dst, int Kdst, RowMap rowmap, int lane) {
#pragma unroll
    for (int i = 0; i < 8; ++i) {
        const int kk = 8 * i + (lane >> 3), n4 = (lane & 7) * 4;
        const f32x4 v = *(const f32x4*)(src + (size_t)(k0 + kk) * ld + n0 + n4);
        scr[kk * 33 + n4] = v[0]; scr[kk * 33 + n4 + 1] = v[1]; scr[kk * 33 + n4 + 2] = v[2]; scr[kk * 33 + n4 + 3] = v[3];
    }
    asm volatile("s_waitcnt lgkmcnt(0)" ::: "memory");
    const int c = lane & 7;
#pragma unroll
    for (int j = 0; j < 4; ++j) {
        const int n = (lane >> 3) + 8 * j; const LAS float* sp = scr + (8 * c) * 33 + n;
        u32x4 o; o.x = pk2(sp[0], sp[33]); o.y = pk2(sp[2 * 33], sp[3 * 33]); o.z = pk2(sp[4 * 33], sp[5 * 33]); o.w = pk2(sp[6 * 33], sp[7 * 33]);
        *(u32x4*)(dst + (size_t)rowmap(n0 + n) * Kdst + k0 + 8 * c) = o;
    }
    asm volatile("s_waitcnt lgkmcnt(0)" ::: "memory");
}

constexpr int TR_N_A = 16 * 48 + 16 * 32, TR_N_GU = NEX * 256, TR_N_D = NEX * 128;
constexpr int TR_GU_LATE = 224 * 8 * 6;
__device__ __forceinline__ void transpose_item(const Params& p, LAS float* scr, int id, int lane) {
    if (id < 16 * 48) { wave_transpose(scr, p.w_in, PW, (id / 48) * 64, (id % 48) * 32, (bf16_t*)(p.ws + OFF_WTIN), D, [](int n) { return win_row(n); }, lane); return; }
    id -= 16 * 48;
    if (id < 16 * 32) { wave_transpose(scr, p.w_out, D, (id / 32) * 64, (id % 32) * 32, (bf16_t*)(p.ws + OFF_WTOUT), D, [](int n) { return n; }, lane); return; }
    id -= 16 * 32;
    if (id < TR_N_GU) {
        const int e = id >> 8, q = id & 255, half = q >> 7, rr = q & 127;
        const float* src = half ? (e < NE ? p.w_up + (size_t)e * D * FF : p.ws_up) : (e < NE ? p.w_gate + (size_t)e * D * FF : p.ws_gate);
        wave_transpose(scr, src, FF, (rr / 8) * 64, (rr % 8) * 32, (bf16_t*)(p.ws + OFF_WGU) + (size_t)e * 512 * D, D, [half](int n) { return gu_row(n, half); }, lane);
        return;
    }
    id -= TR_N_GU;
    {
        const int e = id >> 7, rr = id & 127;
        const float* src = e < NE ? p.w_down + (size_t)e * FF * D : p.ws_down;
        wave_transpose(scr, src, D, (rr / 32) * 64, (rr % 32) * 32, (bf16_t*)(p.ws + OFF_WD) + (size_t)e * D * FF, FF, [](int n) { return n; }, lane);
    }
}

__device__ __forceinline__ void phase_prep(const Params& p, LAS unsigned char* lds) {
    const int tid = TIDX;
    int* gcnt = (int*)(p.ws + OFF_CNT);
    if (VBLK == 0 && tid < 128) gcnt[tid] = 0;
    float* mod = (float*)(p.ws + OFF_MOD);
    float* rope = (float*)(p.ws + OFF_ROPE);
    constexpr int N_MOD = 384, N_ROPE = 256, N_TR = 16;
    for (int it = VBLK; it < N_MOD + N_ROPE + N_TR; it += NVBLK) {
        if (it < N_MOD) {
            LAS float* sl = (LAS float*)lds;
            LAS float* red = (LAS float*)(lds + 10240);
            const int col = it * 16 + (tid & 15), kk = tid >> 4;
            float acc[17];
#pragma unroll
            for (int r = 0; r < 17; ++r) acc[r] = 0.f;
            for (int kc = 0; kc < 8; ++kc) {
                float wv[8];
#pragma unroll
                for (int i = 0; i < 8; ++i) wv[i] = p.w_mod[(size_t)(kc * 128 + kk + 16 * i) * MODW + col];
                __syncthreads();
                for (int o = tid; o < 17 * 128; o += 256) {
                    const int r = o >> 7, kl = o & 127;
                    const float cv = (r < 16) ? p.c[r * D + kc * 128 + kl] : p.c_ctx[kc * 128 + kl];
                    sl[kl * 20 + r] = cv / (1.f + expf(-cv));
                }
                __syncthreads();
#pragma unroll
                for (int i = 0; i < 8; ++i) {
                    const int kl = kk + 16 * i;
                    const f32x4 s0 = *(const LAS f32x4*)(sl + kl * 20), s1 = *(const LAS f32x4*)(sl + kl * 20 + 4), s2 = *(const LAS f32x4*)(sl + kl * 20 + 8), s3 = *(const LAS f32x4*)(sl + kl * 20 + 12);
                    const float s4 = sl[kl * 20 + 16];
#pragma unroll
                    for (int q = 0; q < 4; ++q) { acc[q] += s0[q] * wv[i]; acc[4 + q] += s1[q] * wv[i]; acc[8 + q] += s2[q] * wv[i]; acc[12 + q] += s3[q] * wv[i]; }
                    acc[16] += s4 * wv[i];
                }
            }
#pragma unroll
            for (int r = 0; r < 17; ++r) red[(kk * 17 + r) * 16 + (tid & 15)] = acc[r];
            __syncthreads();
            for (int o = tid; o < 17 * 16; o += 256) {
                const int r = o >> 4, j = o & 15;
                float sm = p.b_mod[it * 16 + j];
#pragma unroll
                for (int g = 0; g < 16; ++g) sm += red[(g * 17 + r) * 16 + j];
                mod[r * MODW + it * 16 + j] = sm;
            }
            __syncthreads();
        } else if (it < N_MOD + N_ROPE) {
            const int idx = (it - N_MOD) * 256 + tid, t = idx >> 5, i = idx & 31;
            const int pos = (i < 16) ? (t >> 6) : (t & 63);
            const float invf = (float)exp(-(double)(i & 15) / 16.0 * 9.210340371976184);
            const double ang = (double)((float)pos * invf);
            rope[idx * 2 + 0] = (float)cos(ang);
            rope[idx * 2 + 1] = (float)sin(ang);
        } else {
            LAS float* tile = (LAS float*)lds;
            const int idx = it - N_MOD - N_ROPE;
            {

                const int k0 = idx * 64;
#pragma unroll
                for (int pss = 0; pss < 4; ++pss) {
                    const int k = pss * 16 + (tid >> 4), n4 = (tid & 15) * 4;
                    const f32x4 v = *(const f32x4*)(p.w_router + (size_t)(k0 + k) * NE + n4);
                    tile[k * 65 + n4 + 0] = v[0]; tile[k * 65 + n4 + 1] = v[1]; tile[k * 65 + n4 + 2] = v[2]; tile[k * 65 + n4 + 3] = v[3];
                }
                __syncthreads();
                {
                    const int n = tid >> 2, kc = (tid & 3) * 16;
                    unsigned wh[8], wl[8];
#pragma unroll
                    for (int i = 0; i < 8; ++i) {
                        const float a = tile[(kc + 2 * i) * 65 + n], b = tile[(kc + 2 * i + 1) * 65 + n];
                        const unsigned ha = f2bf(a), hb = f2bf(b);
                        wh[i] = ha | (hb << 16);
                        wl[i] = pk2(a - bf2f(ha), b - bf2f(hb));
                    }
                    bf16_t* dh = (bf16_t*)(p.ws + OFF_WRH) + (size_t)n * D + k0 + kc;
                    bf16_t* dl = (bf16_t*)(p.ws + OFF_WRL) + (size_t)n * D + k0 + kc;
                    *(u32x4*)dh = (u32x4){wh[0], wh[1], wh[2], wh[3]}; *(u32x4*)(dh + 8) = (u32x4){wh[4], wh[5], wh[6], wh[7]};
                    *(u32x4*)dl = (u32x4){wl[0], wl[1], wl[2], wl[3]}; *(u32x4*)(dl + 8) = (u32x4){wl[4], wl[5], wl[6], wl[7]};
                }
                __syncthreads();
            }
        }
    }
    __syncthreads();
    {
        const int lane = hw_tid() & 63, wv = hw_tid() >> 6;
        LAS float* scr = (LAS float*)(lds - (hw_tid() >> 8) * 32768) + wv * (64 * 33);
        constexpr int NHERE = TR_N_A + (TR_N_GU - TR_GU_LATE);
        for (int it = blockIdx.x * 8 + wv; it < NHERE; it += gridDim.x * 8) transpose_item(p, scr, it < TR_N_A ? it : it + TR_GU_LATE, lane);
    }
}

__device__ __forceinline__ void phase_xn(const Params& p) {
    const int lane = TIDX & 63, gw = VBLK * 4 + (TIDX >> 6), ngw = NVBLK * 4;
    const float* mod = (const float*)(p.ws + OFF_MOD);
    bf16_t* XN = (bf16_t*)(p.ws + OFF_XN);
    for (int row = gw; row < T + TC; row += ngw) {
        const float* src = row < T ? p.x + (size_t)row * D : p.ctx + (size_t)(row - T) * D;
        const float* mr = mod + (size_t)(row < T ? row / SEQ : 16) * MODW;
#pragma unroll
        for (int j = 0; j < 4; ++j) {
            const int c = 4 * lane + 256 * j;
            const f32x4 v = *(const f32x4*)(src + c), sh = *(const f32x4*)(mr + c), sc = *(const f32x4*)(mr + D + c);
            u32x2 o; o.x = pk2(v[0] * (1.f + sc[0]) + sh[0], v[1] * (1.f + sc[1]) + sh[1]); o.y = pk2(v[2] * (1.f + sc[2]) + sh[2], v[3] * (1.f + sc[3]) + sh[3]);
            *(u32x2*)(XN + (size_t)row * D + c) = o;
        }
    }
}

struct EpiIn {
    static constexpr bool PERM = true;
    const float *q_norm, *k_norm, *rope; bf16_t *Qb, *Kb, *Vb, *Ub;
    __device__ __forceinline__ void operator()(const f32x4 (&acc)[2][2][4][2], const pg8::Unit& u, int wr, int wc, int fr, int fq) const {
        const int grp = u.pn * 4 + wc;
        const bool is_ctx = u.pm >= T / 256;
        f32x4 gn[2][2];
        if (grp >= 4 && grp < 20) {
            const float* g = grp < 16 ? q_norm : k_norm;
#pragma unroll
            for (int bj = 0; bj < 2; ++bj)
#pragma unroll
                for (int n = 0; n < 2; ++n) gn[bj][n] = *(const f32x4*)(g + 32 * bj + 8 * fq + 4 * n);
        }
#pragma unroll
        for (int ai = 0; ai < 2; ++ai)
#pragma unroll
            for (int m = 0; m < 4; ++m) {
                const int row = u.pm * 256 + ai * 128 + wr * 64 + m * 16 + fr;
                f32x4 v[2][2];
#pragma unroll
                for (int bj = 0; bj < 2; ++bj)
#pragma unroll
                    for (int n = 0; n < 2; ++n) v[bj][n] = acc[ai][bj][m][n];
                bf16_t* dst;
                if (grp < 4) dst = Ub + (size_t)row * 256 + grp * 64;
                else if (grp < 16) dst = Qb + (size_t)row * 768 + (grp - 4) * 64;
                else {
                    const size_t krow = is_ctx ? (size_t)((row - T) >> 8) * KVL + ((row - T) & 255) : (size_t)(row >> 11) * KVL + CTXL + (row & (SEQ - 1));
                    dst = (grp < 20 ? Kb + (grp - 16) * 64 : Vb + (grp - 20) * 64) + krow * 256;
                }
                if (grp >= 4 && grp < 20) {
                    float ss = 0.f;
#pragma unroll
                    for (int bj = 0; bj < 2; ++bj)
#pragma unroll
                        for (int n = 0; n < 2; ++n) ss += (v[bj][n][0] * v[bj][n][0] + v[bj][n][1] * v[bj][n][1]) + (v[bj][n][2] * v[bj][n][2] + v[bj][n][3] * v[bj][n][3]);
                    ss += __shfl_xor(ss, 16); ss += __shfl_xor(ss, 32);
                    const float rs = 1.0f / sqrtf(ss * (1.f / 64.f) + 1e-6f);
#pragma unroll
                    for (int bj = 0; bj < 2; ++bj)
#pragma unroll
                        for (int n = 0; n < 2; ++n) v[bj][n] = v[bj][n] * rs * gn[bj][n];
                    if (!is_ctx) {
                        const int tpos = row & (SEQ - 1);
#pragma unroll
                        for (int bj = 0; bj < 2; ++bj)
#pragma unroll
                            for (int n = 0; n < 2; ++n) {
                                const f32x4 cs = *(const f32x4*)(rope + (size_t)(tpos * 32 + 16 * bj + 4 * fq + 2 * n) * 2);
                                const f32x4 x = v[bj][n];
                                v[bj][n] = (f32x4){x[0] * cs[0] - x[1] * cs[1], x[0] * cs[1] + x[1] * cs[0], x[2] * cs[2] - x[3] * cs[3], x[2] * cs[3] + x[3] * cs[2]};
                            }
                    }
                    if (grp < 16) {
#pragma unroll
                        for (int bj = 0; bj < 2; ++bj)
#pragma unroll
                            for (int n = 0; n < 2; ++n) v[bj][n] = v[bj][n] * C2;
                    }
                }
#pragma unroll
                for (int bj = 0; bj < 2; ++bj) {
                    u32x4 w; w.x = pk2(v[bj][0][0], v[bj][0][1]); w.y = pk2(v[bj][0][2], v[bj][0][3]); w.z = pk2(v[bj][1][0], v[bj][1][1]); w.w = pk2(v[bj][1][2], v[bj][1][3]);
                    *(u32x4*)(dst + 32 * bj + 8 * fq) = w;
                }
            }
    }
};
__device__ __forceinline__ int vcu_of_block() { const int G = gridDim.x, bx = blockIdx.x; return (G % 8 == 0) ? (bx % 8) * (G / 8) + bx / 8 : bx; }
__device__ __forceinline__ void phase_inproj(const Params& p, LAS unsigned char* lds) {
    pg8::Gemm g{(const bf16_t*)(p.ws + OFF_XN), (const bf16_t*)(p.ws + OFF_WTIN)};
    pg8::DenseSched S{6, 768, 800, 4, 2, (int)gridDim.x, vcu_of_block()};
    EpiIn E{p.q_norm, p.k_norm, (const float*)(p.ws + OFF_ROPE), (bf16_t*)(p.ws + OFF_Q), (bf16_t*)(p.ws + OFF_K), (bf16_t*)(p.ws + OFF_V), (bf16_t*)(p.ws + OFF_U)};
    pg8::gemm_phase<D, EpiIn, pg8::DenseSched, false>(lds, g, S, E);
    {
        const int v = vcu_of_block(), G = gridDim.x, nbusy = 800 - 3 * G;
        if (G == 256 ? v >= nbusy : true) {
            const int lane = hw_tid() & 63, wv = hw_tid() >> 6, nw = (G == 256 ? G - nbusy : G) * 8, w = (G == 256 ? v - nbusy : v) * 8 + wv;
            LAS float* scr = (LAS float*)lds + wv * (64 * 33);
            for (int it = w; it < TR_GU_LATE; it += nw) transpose_item(p, scr, TR_N_A + it, lane);
        }
    }
}

namespace attn_body {
using bf16=unsigned short;
using bf16x8=__attribute__((ext_vector_type(8)))short;
using s16x4=__attribute__((ext_vector_type(4)))short;
using f32x16=__attribute__((ext_vector_type(16)))float;
using u32x4=__attribute__((ext_vector_type(4)))unsigned;
constexpr int D=64,QP=768,KP=256,OP=1024,SEQ=2048,KVLEN=2304;
constexpr int NW=8,QBLK=32,QB=QBLK*NW,KVBLK=64,NT=KVLEN/KVBLK;
__device__ __forceinline__ int crow(int r,int hi){return (r&3)+8*(r>>2)+4*hi;}
#define SBAR() __builtin_amdgcn_sched_barrier(0)
constexpr int NSLOT=3, SLOTB=8192;
constexpr int LDS_K=0, LDS_V=NSLOT*SLOTB, LDS_WS=2*NSLOT*SLOTB, LDS_OST=LDS_WS+NW*64*4, LDS_BYTES=LDS_OST+NW*4096;
constexpr float C2=0.125f*1.4426950408889634f;
__device__ __forceinline__ void glds16(const void*gsrc,unsigned lds_dst){unsigned keep;
  asm volatile("s_mov_b32 %0, m0\n\ts_mov_b32 m0, %2\n\ts_nop 0\n\tglobal_load_lds_dwordx4 %1, off\n\ts_mov_b32 m0, %0":"=&s"(keep):"v"(gsrc),"s"(lds_dst):"memory");}
__device__ __forceinline__ float max3f(float a,float b,float c){float r;asm("v_max3_f32 %0, %1, %2, %3":"=v"(r):"v"(a),"v"(b),"v"(c));return r;}
__device__ __forceinline__ float max2f(float a,float b){float r;asm("v_max_f32_e32 %0, %1, %2":"=v"(r):"v"(a),"v"(b));return r;}
__device__ __forceinline__ float fadd_s(float a,float b){float r;asm("v_add_f32_e32 %0, %1, %2":"=v"(r):"v"(a),"v"(b));return r;}
__device__ __forceinline__ float fsub_s(float a,float b){float r;asm("v_sub_f32_e32 %0, %1, %2":"=v"(r):"v"(a),"v"(b));return r;}
typedef float f32x2_t __attribute__((ext_vector_type(2))); typedef __bf16 bf16x2_t __attribute__((ext_vector_type(2)));
__device__ __forceinline__ unsigned cvtpk_s(float lo,float hi){f32x2_t v={lo,hi};bf16x2_t b=__builtin_convertvector(v,bf16x2_t);return __builtin_bit_cast(unsigned,b);}
#define WAIT_BAR(N) asm volatile("s_waitcnt vmcnt(" #N ") lgkmcnt(0)\n\ts_barrier":::"memory")

__device__ __forceinline__ void qkt(f32x16&p0,f32x16&p1,const char*Kslot,const bf16x8*qr,const f32x16&negm,int r32,int hi){
  const char*kb=Kslot+hi*1024+r32*16;
  #pragma unroll
  for(int d0=0;d0<4;++d0){
    const bf16x8 b0=*reinterpret_cast<const bf16x8*>(kb+d0*2048);
    const bf16x8 b1=*reinterpret_cast<const bf16x8*>(kb+d0*2048+512);
    if(d0==0){p0=__builtin_amdgcn_mfma_f32_32x32x16_bf16(b0,qr[0],negm,0,0,0);p1=__builtin_amdgcn_mfma_f32_32x32x16_bf16(b1,qr[0],negm,0,0,0);}
    else{p0=__builtin_amdgcn_mfma_f32_32x32x16_bf16(b0,qr[d0],p0,0,0,0);p1=__builtin_amdgcn_mfma_f32_32x32x16_bf16(b1,qr[d0],p1,0,0,0);}}
}
typedef __attribute__((address_space(3))) const char* lds_cptr;
typedef short v4i16_t __attribute__((ext_vector_type(4)));
__device__ __forceinline__ void kload8(bf16x8*kf,lds_cptr kp){
  kf[0]=*(const __attribute__((address_space(3))) bf16x8*)(kp);      kf[1]=*(const __attribute__((address_space(3))) bf16x8*)(kp+512);
  kf[2]=*(const __attribute__((address_space(3))) bf16x8*)(kp+2048); kf[3]=*(const __attribute__((address_space(3))) bf16x8*)(kp+2560);
  kf[4]=*(const __attribute__((address_space(3))) bf16x8*)(kp+4096); kf[5]=*(const __attribute__((address_space(3))) bf16x8*)(kp+4608);
  kf[6]=*(const __attribute__((address_space(3))) bf16x8*)(kp+6144); kf[7]=*(const __attribute__((address_space(3))) bf16x8*)(kp+6656);
}
__device__ __forceinline__ void kload2(bf16x8*kf,lds_cptr kp,int j){ kf[2*j]=*(const __attribute__((address_space(3))) bf16x8*)(kp+j*2048); kf[2*j+1]=*(const __attribute__((address_space(3))) bf16x8*)(kp+j*2048+512); }
__device__ __forceinline__ s16x4 vtr(lds_cptr p){ return __builtin_bit_cast(s16x4,__builtin_amdgcn_ds_read_tr16_b64_v4i16((__attribute__((address_space(3))) v4i16_t*)p)); }
__device__ __forceinline__ float rowmax(const f32x16&p0,const f32x16&p1){
  float a=max3f(p0[0],p0[1],p1[0]),b=max3f(p0[2],p0[3],p1[1]);a=max3f(a,p1[2],p1[3]);
  #pragma unroll
  for(int r=4;r<16;r+=4){a=max3f(a,p0[r],p0[r+1]);b=max3f(b,p0[r+2],p0[r+3]);a=max3f(a,p1[r],p1[r+1]);b=max3f(b,p1[r+2],p1[r+3]);}
  const float m=max2f(a,b);
  auto rr=__builtin_amdgcn_permlane32_swap(__float_as_uint(m),__float_as_uint(m),false,false);
  return max2f(__uint_as_float(rr[0]),__uint_as_float(rr[1]));
}
__device__ __forceinline__ void pv(f32x16*o,int vb,bf16x8 pa0,bf16x8 pa1,bf16x8 pa2,bf16x8 pa3){
  #pragma unroll
  for(int d0=0;d0<2;++d0){s16x4 lo[4],hi[4];
    #pragma unroll
    for(int ks=0;ks<4;++ks){
      asm volatile("ds_read_b64_tr_b16 %0,%1 offset:%c2":"=&v"(lo[ks]):"v"(vb),"i"(d0*4096+ks*1024):"memory");
      asm volatile("ds_read_b64_tr_b16 %0,%1 offset:%c2":"=&v"(hi[ks]):"v"(vb),"i"(d0*4096+ks*1024+512):"memory");}
    asm volatile("s_waitcnt lgkmcnt(0)":::"memory");SBAR();
    #define PK(k) (bf16x8){lo[k][0],lo[k][1],lo[k][2],lo[k][3],hi[k][0],hi[k][1],hi[k][2],hi[k][3]}
    o[d0]=__builtin_amdgcn_mfma_f32_32x32x16_bf16(pa0,PK(0),o[d0],0,0,0);
    o[d0]=__builtin_amdgcn_mfma_f32_32x32x16_bf16(pa1,PK(1),o[d0],0,0,0);
    o[d0]=__builtin_amdgcn_mfma_f32_32x32x16_bf16(pa2,PK(2),o[d0],0,0,0);
    o[d0]=__builtin_amdgcn_mfma_f32_32x32x16_bf16(pa3,PK(3),o[d0],0,0,0);
    #undef PK
  }
}

#ifndef ATTN_STORE16
#define ATTN_STORE16(p,v) (*(u32x4*)(p)=(v))
#endif
template<int THRL> __device__ __forceinline__ void attn_unit(int b,int h,int qb,const bf16*Q,const bf16*__restrict__ K,const bf16*__restrict__ V,bf16*O,char*shm){
  const int tid=hw_tid(),lane=tid&63,r32=lane&31,hi=lane>>5; const int wid=__builtin_amdgcn_readfirstlane(tid>>6);
  const long rowbase=(long)b*SEQ, kvbase=(long)b*KVLEN; const int q0=qb*QB, kh=h/3;
  const bf16*Qw=Q+(rowbase+q0+wid*QBLK)*QP+h*D;
  const bf16*Kh=K+kvbase*KP+kh*D,*Vh=V+kvbase*KP+kh*D;
  const unsigned lds0=(unsigned)(uintptr_t)shm;
  float*wsf=(float*)(shm+LDS_WS)+wid*64;
  const bf16*ksrc=Kh+(long)lane*KP+wid*8;
  const bf16*vsrc=Vh+(long)(16*(wid&3)+(lane>>2))*KP+(wid>>2)*32+(lane&3)*8;
  const unsigned kdst=lds0+LDS_K+wid*1024, vdst=lds0+LDS_V+wid*1024;
  #define DMA_K(t,slot) glds16(ksrc+(long)(t)*KVBLK*KP,(unsigned)__builtin_amdgcn_readfirstlane(kdst+(slot)))
  #define DMA_V(t,slot) glds16(vsrc+(long)(t)*KVBLK*KP,(unsigned)__builtin_amdgcn_readfirstlane(vdst+(slot)))
  const int vb0=(int)(lds0+LDS_V)+((lane>>4)&1)*32+(lane&3)*8+(4*hi+((lane&15)>>2))*64;
  const char*Kbase=shm+LDS_K; bf16x8 kf[8];
  const lds_cptr shm3=(lds_cptr)shm; const lds_cptr kp0=shm3+LDS_K+hi*1024+r32*16; const lds_cptr vp0=shm3+LDS_V+((lane>>4)&1)*32+(lane&3)*8+(4*hi+((lane&15)>>2))*64;
  DMA_K(0,0);DMA_V(0,0);DMA_K(1,SLOTB);
  bf16x8 qr[4];
  #pragma unroll
  for(int d0=0;d0<4;++d0)qr[d0]=*reinterpret_cast<const bf16x8*>(&Qw[(long)r32*QP+d0*16+hi*8]);
  float mhat=0.f,l_reg=0.f;f32x16 o[2];o[0]=f32x16{};o[1]=f32x16{};f32x16 negm=f32x16{};asm volatile("":"+v"(negm));
  #define CMASK(P0,P1,t) do{}while(0)
  bool resc=false;
  #define START(P0,P1) do{ const float rm=rowmax(P0,P1); resc=false; \
    { const float dl=rm; mhat=fadd_s(mhat,dl); \
      _Pragma("unroll") for(int r=0;r<16;++r){P0[r]=fsub_s(P0[r],dl);P1[r]=fsub_s(P1[r],dl);} \
      _Pragma("unroll") for(int r=0;r<16;++r)negm[r]=-mhat; asm volatile("":"+v"(negm)); } \
    _Pragma("unroll") for(int r=0;r<16;++r)P0[r]=__builtin_amdgcn_exp2f(P0[r]); }while(0)
  #define RESC() do{ if(resc){ asm volatile("s_waitcnt lgkmcnt(0)":::"memory"); \
      _Pragma("unroll") for(int d_=0;d_<2;++d_) _Pragma("unroll") for(int r=0;r<16;++r)o[d_][r]*=wsf[crow(r,hi)]; } }while(0)
  f32x16 pA0,pA1,pB0,pB1;
  int sl_prev=0,sl_cur=0,sl_next=SLOTB;
  #define ROT() do{sl_prev=sl_cur;sl_cur=sl_next;sl_next=(sl_next==(NSLOT-1)*SLOTB)?0:sl_next+SLOTB;}while(0)
  DMA_K(2,2*SLOTB);
  WAIT_BAR(3);
  qkt(pA0,pA1,Kbase,qr,negm,r32,hi);asm volatile("s_nop 15\n\ts_nop 7":"+v"(pA0),"+v"(pA1));CMASK(pA0,pA1,0);
  START(pA0,pA1);
  _Pragma("unroll") for(int r=0;r<16;++r)pA1[r]=__builtin_amdgcn_exp2f(pA1[r]);
  WAIT_BAR(0);
  DMA_K(3,0);DMA_V(1,SLOTB);
  ROT();
  kload8(kf,kp0+sl_cur);
  WAIT_BAR(2);
  s16x4 vlo[8],vhi[8]; u32x4 pw0,pw1,pw2,pw3;
  #define PKW(P,B) cvtpk_s(P[B],P[B+1])
  #define PAF(k) __builtin_bit_cast(bf16x8,pw##k)
  #define VFR(i) (bf16x8){vlo[i][0],vlo[i][1],vlo[i][2],vlo[i][3],vhi[i][0],vhi[i][1],vhi[i][2],vhi[i][3]}
  #define PIN(x) asm volatile("":"+v"(x))
  #define MX3(a,b,c) __builtin_fmaxf(__builtin_fmaxf((a),(b)),(c))
  #define GAPA(MF,A0,A1,A2,A3,W0,W1,PW) do{ MF; sacc+=A0; sacc+=A1; sacc+=A2; sacc+=A3; PIN(sacc); W0; W1; PIN(PW); SBAR(); }while(0)
  #define EX(v) __builtin_amdgcn_exp2f(v)
  #define GAPB(MF,X,B) do{ MF; X[B]=EX(X[B]); X[B+1]=EX(X[B+1]); X[B+2]=EX(X[B+2]); X[B+3]=EX(X[B+3]); PIN(X); SBAR(); }while(0)
  #define VRD(i) do{ vlo[i]=vtr(vp_+(((i)>>2)*4096+((i)&3)*1024)); vhi[i]=vtr(vp_+(((i)>>2)*4096+((i)&3)*1024+512)); }while(0)
  #define KRD(G,j) do{ if(G){ kload2(kf,kp0+sl_next,j); SBAR(); } }while(0)
  #define STEP(C0,C1,P0,P1,t,GK,GV,GL) do{ SBAR(); \
    const lds_cptr vp_=vp0+sl_prev; \
    VRD(0); SBAR(); float sacc=(P0[0]+P0[1]); \
    GAPA(C0=__builtin_amdgcn_mfma_f32_32x32x16_bf16(kf[0],qr[0],negm,0,0,0), P0[2],P0[3],P0[4],P0[5],     pw0[0]=PKW(P0,0), pw0[1]=PKW(P0,2), pw0); \
    VRD(4); SBAR(); GAPA(C1=__builtin_amdgcn_mfma_f32_32x32x16_bf16(kf[1],qr[0],negm,0,0,0), P0[6],P0[7],P0[8],P0[9],     pw0[2]=PKW(P0,4), pw0[3]=PKW(P0,6), pw0); \
    VRD(1); SBAR(); GAPA(C0=__builtin_amdgcn_mfma_f32_32x32x16_bf16(kf[2],qr[1],C0,0,0,0),   P0[10],P0[11],P0[12],P0[13], pw1[0]=PKW(P0,8), pw1[1]=PKW(P0,10), pw1); \
    VRD(5); SBAR(); GAPA(C1=__builtin_amdgcn_mfma_f32_32x32x16_bf16(kf[3],qr[1],C1,0,0,0),   P0[14],P0[15],P1[0],P1[1],   pw1[2]=PKW(P0,12),pw1[3]=PKW(P0,14), pw1); \
    VRD(2); SBAR(); GAPA(C0=__builtin_amdgcn_mfma_f32_32x32x16_bf16(kf[4],qr[2],C0,0,0,0),   P1[2],P1[3],P1[4],P1[5],     pw2[0]=PKW(P1,0), pw2[1]=PKW(P1,2), pw2); \
    VRD(6); SBAR(); GAPA(C1=__builtin_amdgcn_mfma_f32_32x32x16_bf16(kf[5],qr[2],C1,0,0,0),   P1[6],P1[7],P1[8],P1[9],     pw2[2]=PKW(P1,4), pw2[3]=PKW(P1,6), pw2); \
    VRD(3); SBAR(); GAPA(C0=__builtin_amdgcn_mfma_f32_32x32x16_bf16(kf[6],qr[3],C0,0,0,0),   P1[10],P1[11],P1[12],P1[13], pw3[0]=PKW(P1,8), pw3[1]=PKW(P1,10), pw3); \
    VRD(7); SBAR(); GAPA(C1=__builtin_amdgcn_mfma_f32_32x32x16_bf16(kf[7],qr[3],C1,0,0,0),   P1[14],P1[15],0.f,0.f,       pw3[2]=PKW(P1,12),pw3[3]=PKW(P1,14), pw3); \
    l_reg+=sacc; \
    if(GK){DMA_K((t)+3,sl_cur);} if(GV){DMA_V((t)+1,sl_next);} \
    CMASK(C0,C1,t); \
    { float a=MX3(C0[0],C0[1],C1[0]),b=MX3(C0[2],C0[3],C1[1]); a=MX3(a,C1[2],C1[3]); \
      _Pragma("unroll") for(int r=4;r<16;r+=4){a=MX3(a,C0[r],C0[r+1]);b=MX3(b,C0[r+2],C0[r+3]);a=MX3(a,C1[r],C1[r+1]);b=MX3(b,C1[r+2],C1[r+3]);} \
      float rm=__builtin_fmaxf(a,b); { auto rr=__builtin_amdgcn_permlane32_swap(__float_as_uint(rm),__float_as_uint(rm),false,false); rm=__builtin_fmaxf(__uint_as_float(rr[0]),__uint_as_float(rr[1])); } \
      resc=false; \
      if(__builtin_expect(__any(rm>(float)THRL),0)){ const float dl=__builtin_fmaxf(rm,0.f); mhat+=dl; \
        _Pragma("unroll") for(int r=0;r<16;++r){C0[r]-=dl;C1[r]-=dl;} \
        _Pragma("unroll") for(int r=0;r<16;++r)negm[r]=-mhat; asm volatile("":"+v"(negm)); \
        const float f=__builtin_amdgcn_exp2f(-dl); l_reg*=f; if(hi==0)wsf[r32]=f; resc=true; } } \
    SBAR(); \
    GAPB(o[0]=__builtin_amdgcn_mfma_f32_32x32x16_bf16(PAF(0),VFR(0),o[0],0,0,0), C0,0); \
    GAPB(o[1]=__builtin_amdgcn_mfma_f32_32x32x16_bf16(PAF(0),VFR(4),o[1],0,0,0), C0,4); \
    KRD(GL,0); GAPB(o[0]=__builtin_amdgcn_mfma_f32_32x32x16_bf16(PAF(1),VFR(1),o[0],0,0,0), C0,8); \
    KRD(GL,1); GAPB(o[1]=__builtin_amdgcn_mfma_f32_32x32x16_bf16(PAF(1),VFR(5),o[1],0,0,0), C0,12); \
    KRD(GL,2); GAPB(o[0]=__builtin_amdgcn_mfma_f32_32x32x16_bf16(PAF(2),VFR(2),o[0],0,0,0), C1,0); \
    KRD(GL,3); GAPB(o[1]=__builtin_amdgcn_mfma_f32_32x32x16_bf16(PAF(2),VFR(6),o[1],0,0,0), C1,4); \
    GAPB(o[0]=__builtin_amdgcn_mfma_f32_32x32x16_bf16(PAF(3),VFR(3),o[0],0,0,0), C1,8); \
    GAPB(o[1]=__builtin_amdgcn_mfma_f32_32x32x16_bf16(PAF(3),VFR(7),o[1],0,0,0), C1,12); \
    }while(0)
  int t=1;
  for(;t+5<NT;t+=2){
    STEP(pB0,pB1,pA0,pA1,t,true,true,true);     WAIT_BAR(2); RESC(); ROT();
    STEP(pA0,pA1,pB0,pB1,t+1,true,true,true);   WAIT_BAR(2); RESC(); ROT();
  }
  #define ENDW(tt) do{ if((tt)+3<NT){WAIT_BAR(2);} else if((tt)+2<NT){WAIT_BAR(1);} else {WAIT_BAR(0);} }while(0)
  for(;t+1<NT;t+=2){
    STEP(pB0,pB1,pA0,pA1,t,(t+3<NT),(t+1<NT),(t+1<NT));       ENDW(t);   RESC(); ROT();
    STEP(pA0,pA1,pB0,pB1,t+1,(t+4<NT),(t+2<NT),(t+2<NT));     ENDW(t+1); RESC(); ROT();
  }
  STEP(pB0,pB1,pA0,pA1,NT-1,false,false,false); RESC();
  { float sacc=pB0[0]+pB0[1]; _Pragma("unroll") for(int r=2;r<16;++r)sacc+=pB0[r]; _Pragma("unroll") for(int r=0;r<16;++r)sacc+=pB1[r]; l_reg+=sacc;
    pw0=(u32x4){PKW(pB0,0),PKW(pB0,2),PKW(pB0,4),PKW(pB0,6)};pw1=(u32x4){PKW(pB0,8),PKW(pB0,10),PKW(pB0,12),PKW(pB0,14)};pw2=(u32x4){PKW(pB1,0),PKW(pB1,2),PKW(pB1,4),PKW(pB1,6)};pw3=(u32x4){PKW(pB1,8),PKW(pB1,10),PKW(pB1,12),PKW(pB1,14)};
    SBAR(); pv(o,vb0+sl_cur,PAF(0),PAF(1),PAF(2),PAF(3)); }
  #undef PKW
  #undef PAF
  #undef VFR
  #undef PIN
  #undef MX3
  #undef GAPA
  #undef GAPB
  #undef EX
  #undef VRD
  #undef KRD
  #undef STEP
  #undef ENDW
  {auto rr=__builtin_amdgcn_permlane32_swap(__float_as_uint(l_reg),__float_as_uint(l_reg),false,false);l_reg=__uint_as_float(rr[0])+__uint_as_float(rr[1]);}
  if(hi==0)wsf[32+r32]=l_reg;asm volatile("s_waitcnt lgkmcnt(0)":::"memory");
  float rli[16];
  #pragma unroll
  for(int r=0;r<16;++r)rli[r]=__builtin_amdgcn_rcpf(wsf[32+crow(r,hi)]);
  bf16*Ow=O+(rowbase+q0+wid*QBLK)*OP+h*D;
  { bf16*stg=(bf16*)(shm+LDS_OST)+wid*2048;
    #pragma unroll
    for(int r=0;r<16;++r){const int orow=crow(r,hi);
      #pragma unroll
      for(int d0=0;d0<2;++d0)stg[orow*64+d0*32+r32]=(bf16)f2bf(o[d0][r]*rli[r]);}
    asm volatile("s_waitcnt lgkmcnt(0)":::"memory");
    #pragma unroll
    for(int i=0;i<4;++i){const int row=i*8+(lane>>3),ch=lane&7; const u32x4 v=*(const u32x4*)(stg+row*64+ch*8); ATTN_STORE16(Ow+(long)row*OP+ch*8,v);} }
  asm volatile("s_waitcnt lgkmcnt(0)\n\ts_barrier":::"memory");
  #undef DMA_K
  #undef DMA_V
  #undef CMASK
  #undef START
  #undef RESC
  #undef ROT
}
constexpr int ATTN_LDS_BYTES=LDS_BYTES;
struct AttnTensors { const bf16* Q; const bf16* K; const bf16* V; bf16* O; };
template<int THRL=8> __device__ __forceinline__ void attn_phase(char*lds,const AttnTensors&T){
  const int G=gridDim.x, bx=blockIdx.x, v=(G%8==0)?(bx%8)*(G/8)+bx/8:bx;
  for(int u=v;u<16*12*8;u+=G){
    const int pair=(u%256)/4, j=((u%256)%4)*6+u/256;
    const int b=pair>>2, kh=pair&3, g=j>>3, qb=j&7;
    attn_unit<THRL>(b,kh*3+g,qb,T.Q,T.K,T.V,T.O,lds);
  }
}
#undef SBAR
#undef WAIT_BAR
}

__device__ __forceinline__ void pool_item(const Params& p, LAS unsigned char* lds, int item, bool stage_w) {
    const int tid = TIDX, lane = tid & 63, wid = tid >> 6, r16 = lane & 15, q = lane >> 4;
    const int gi = item & 3, tile = item >> 2, t0 = tile * 64, b = t0 / SEQ, tl0 = t0 % SEQ, half = 1 << gi;
    const bf16_t* Ub = (const bf16_t*)(p.ws + OFF_U);
    bf16_t* AO = (bf16_t*)(p.ws + OFF_AO);
    LAS bf16_t* us = (LAS bf16_t*)lds;
    LAS bf16_t* dl = (LAS bf16_t*)(lds + 11520);
    LAS bf16_t* wt = (LAS bf16_t*)(lds + 11520 + 9216);
    __syncthreads();
    for (int i = tid; i < 80 * 8; i += 256) {
        const int r = i >> 3, ch = i & 7, tl = tl0 - 8 + r;
        u32x4 v = {0u, 0u, 0u, 0u};
        if (tl >= 0 && tl < SEQ) v = *(const u32x4*)(Ub + (size_t)(b * SEQ + tl) * 256 + gi * 64 + ch * 8);
        *(LAS u32x4*)(us + r * 72 + ch * 8) = v;
    }
    if (stage_w) {
#pragma unroll 4
        for (int k = 0; k < 16; ++k) {
            const int i = tid + 256 * k, c = i >> 6, dd = i & 63;
            wt[dd * 72 + c] = (bf16_t)f2bf(p.pool_w[gi * 4096 + i] * p.pool_scale[gi * 64 + dd]);
        }
    }
    __syncthreads();
    {
        const int c = tid & 63, seg = tid >> 6;
        int tl = tl0 + seg * 16;
        float sm = 0.f;
        for (int r = max(tl - half, 0); r < min(tl + half, SEQ); ++r) sm += bf2f(us[(r - tl0 + 8) * 72 + c]);
#pragma unroll
        for (int k = 0; k < 16; ++k, ++tl) {
            if (k > 0) {
                if (tl + half <= SEQ) sm += bf2f(us[(tl + half - 1 - tl0 + 8) * 72 + c]);
                if (tl - half > 0) sm -= bf2f(us[(tl - half - 1 - tl0 + 8) * 72 + c]);
            }
            const int cntw = min(tl + half, SEQ) - max(tl - half, 0);
            dl[(seg * 16 + k) * 72 + c] = (bf16_t)f2bf(sm / (float)cntw - bf2f(us[(tl - tl0 + 8) * 72 + c]));
        }
    }
    __syncthreads();
    {
        f32x4 acc[4];
#pragma unroll
        for (int nb = 0; nb < 4; ++nb) acc[nb] = (f32x4){0.f, 0.f, 0.f, 0.f};
#pragma unroll
        for (int ks = 0; ks < 2; ++ks) {
            const bf16x8 db = *(const LAS bf16x8*)(dl + (wid * 16 + r16) * 72 + ks * 32 + q * 8);
#pragma unroll
            for (int nb = 0; nb < 4; ++nb) {
                const bf16x8 wa = *(const LAS bf16x8*)(wt + (nb * 16 + r16) * 72 + ks * 32 + q * 8);
                acc[nb] = __builtin_amdgcn_mfma_f32_16x16x32_bf16(wa, db, acc[nb], 0, 0, 0);
            }
        }
        bf16_t* orow = AO + (size_t)(t0 + wid * 16 + r16) * D + gi * 64 + 4 * q;
#pragma unroll
        for (int nb = 0; nb < 4; ++nb) { u32x2 w; w.x = pk2(acc[nb][0], acc[nb][1]); w.y = pk2(acc[nb][2], acc[nb][3]); *(u32x2*)(orow + nb * 16) = w; }
    }
}

__device__ __forceinline__ void phase_attn_pool(const Params& p, LAS unsigned char* lds, char* smem) {
    const attn_body::AttnTensors AT{(const bf16_t*)(p.ws + OFF_Q), (const bf16_t*)(p.ws + OFF_K), (const bf16_t*)(p.ws + OFF_V), (bf16_t*)(p.ws + OFF_AO) + 256};
    attn_body::attn_phase<8>(smem, AT);
    __syncthreads();
    constexpr int N_POOL = (T / 64) * 4;
    { bool first = true; for (int it = VBLK; it < N_POOL; it += NVBLK) { pool_item(p, lds, it, first); first = false; } }
}

struct EpiOut {
    static constexpr bool PERM = false;
    const float* x; float* y; const float* mod; float* stats;
    __device__ __forceinline__ void operator()(const f32x4 (&acc)[2][2][4][2], const pg8::Unit& u, int wr, int wc, int fr, int fq) const {
        const float* g1 = mod + (size_t)(u.pm >> 3) * MODW + 2 * D;
        const int col0 = u.pn * 256 + wc * 32 + fq * 4;
        f32x4 gv[2][2];
#pragma unroll
        for (int bj = 0; bj < 2; ++bj)
#pragma unroll
            for (int n = 0; n < 2; ++n) gv[bj][n] = *(const f32x4*)(g1 + col0 + bj * 128 + n * 16);
#pragma unroll
        for (int ai = 0; ai < 2; ++ai)
#pragma unroll
            for (int m = 0; m < 4; ++m) {
                const int row = u.pm * 256 + ai * 128 + wr * 64 + m * 16 + fr;
                float s1 = 0.f, s2 = 0.f;
#pragma unroll
                for (int bj = 0; bj < 2; ++bj)
#pragma unroll
                    for (int n = 0; n < 2; ++n) {
                        const size_t off = (size_t)row * D + col0 + bj * 128 + n * 16;
                        const f32x4 xv = *(const f32x4*)(x + off);
                        const f32x4 yv = xv * ALPHA + gv[bj][n] * acc[ai][bj][m][n];
                        *(f32x4*)(y + off) = yv;
                        s1 += (yv[0] + yv[1]) + (yv[2] + yv[3]);
                        s2 += (yv[0] * yv[0] + yv[1] * yv[1]) + (yv[2] * yv[2] + yv[3] * yv[3]);
                    }
                s1 += __shfl_xor(s1, 16); s1 += __shfl_xor(s1, 32);
                s2 += __shfl_xor(s2, 16); s2 += __shfl_xor(s2, 32);
                if (fq == 0) { float* st = stats + ((size_t)row * 16 + u.pn * 4 + wc) * 2; st[0] = s1; st[1] = s2; }
            }
    }
};
__device__ __forceinline__ void phase_outproj(const Params& p, LAS unsigned char* lds) {
    pg8::Gemm g{(const bf16_t*)(p.ws + OFF_AO), (const bf16_t*)(p.ws + OFF_WTOUT)};
    pg8::DenseSched S{4, 512, 512, 0, 1, (int)gridDim.x, vcu_of_block()};
    EpiOut E{p.x, p.out, (const float*)(p.ws + OFF_MOD), (float*)(p.ws + OFF_STATS)};
    pg8::gemm_phase<D, EpiOut, pg8::DenseSched, false>(lds, g, S, E);
}

__device__ __forceinline__ void phase_router(const Params& p, LAS unsigned char* lds0) {
    const int tid = hw_tid(), lane = tid & 63, wid = tid >> 6, r16 = lane & 15, q = lane >> 4;
    const float* mod = (const float*)(p.ws + OFF_MOD);
    const float* stats = (const float*)(p.ws + OFF_STATS);
    bf16_t* H = (bf16_t*)(p.ws + OFF_H);
    const bf16_t* WRH = (const bf16_t*)(p.ws + OFF_WRH); const bf16_t* WRL = (const bf16_t*)(p.ws + OFF_WRL);
    int* gcnt = (int*)(p.ws + OFF_CNT);
    int* LDST = (int*)(p.ws + OFF_LDST);
    float* LWt = (float*)(p.ws + OFF_LW);
    LAS float* vec = (LAS float*)lds0;
    LAS float* lg = (LAS float*)(lds0 + 16384) + wid * 16 * 64;
    LAS int* lcnt = (LAS int*)(lds0 + 49152);
    LAS int* lbase = (LAS int*)(lds0 + 49152 + 256);
    LAS int* sel_ep = (LAS int*)(lds0 + 49152 + 512);
    LAS float* sel_w = (LAS float*)(lds0 + 49152 + 512 + 4096);
    for (int item = blockIdx.x; item < T / 128; item += gridDim.x) {
        const int t0 = item * 128, b = t0 / SEQ, tw0 = t0 + wid * 16;
        __syncthreads();
        if (tid < 64) lcnt[tid] = 0;
        for (int i = tid; i < 1024; i += 512) {
            vec[i] = p.ln1_g[i]; vec[1024 + i] = p.ln1_b[i];
            vec[2048 + i] = 1.f + mod[(size_t)b * MODW + 4 * D + i]; vec[3072 + i] = mod[(size_t)b * MODW + 3 * D + i];
        }
        float meanv = 0.f, rstdv = 0.f;
        if (lane < 16) {
            float s1 = 0.f, s2 = 0.f;
            const float* st = stats + (size_t)(tw0 + lane) * 32;
#pragma unroll
            for (int i = 0; i < 16; ++i) { s1 += st[2 * i]; s2 += st[2 * i + 1]; }
            meanv = s1 * (1.f / D);
            const float var = fmaxf(s2 * (1.f / D) - meanv * meanv, 0.f);
            rstdv = 1.0f / sqrtf(var + 1e-5f);
        }
        const float mu = __shfl(meanv, r16), rs = __shfl(rstdv, r16);
        __syncthreads();
        f32x4 acc[4];
#pragma unroll
        for (int nb = 0; nb < 4; ++nb) acc[nb] = (f32x4){0.f, 0.f, 0.f, 0.f};
        float* yrow = p.out + (size_t)(tw0 + r16) * D + q * 8;
        bf16_t* hrow = H + (size_t)(tw0 + r16) * D + q * 8;
        LAS unsigned char* wb = lds0 + 57856;
        f32x4 vn[4][2];
#pragma unroll
        for (int u = 0; u < 4; ++u) { vn[u][0] = *(const f32x4*)(yrow + u * 32); vn[u][1] = *(const f32x4*)(yrow + u * 32 + 4); }
        for (int ch = 0; ch < 4; ++ch) {
            __syncthreads();
#pragma unroll
            for (int i = 0; i < 8; ++i) {
                const int idx = tid + i * 512, part = idx >> 11, row = (idx >> 5) & 63, c16 = idx & 31;
                const u32x4 w = *(const u32x4*)((part ? WRL : WRH) + (size_t)row * D + ch * 256 + c16 * 8);
                *(LAS u32x4*)(wb + part * 33792 + row * 528 + c16 * 16) = w;
            }
            __syncthreads();
#pragma unroll
            for (int s4 = ch * 8; s4 < ch * 8 + 8; s4 += 4) {
                f32x4 vv[4][2];
#pragma unroll
                for (int u = 0; u < 4; ++u) { vv[u][0] = vn[u][0]; vv[u][1] = vn[u][1]; }
                if (s4 + 4 < 32) {
#pragma unroll
                    for (int u = 0; u < 4; ++u) { vn[u][0] = *(const f32x4*)(yrow + (s4 + 4 + u) * 32); vn[u][1] = *(const f32x4*)(yrow + (s4 + 4 + u) * 32 + 4); }
                }
#pragma unroll
                for (int u = 0; u < 4; ++u) {
                    const int s = s4 + u, k0 = s * 32 + q * 8;
                    float hv[8];
#pragma unroll
                    for (int hh = 0; hh < 2; ++hh) {
                        const f32x4 g = *(const LAS f32x4*)(vec + k0 + 4 * hh), bb = *(const LAS f32x4*)(vec + 1024 + k0 + 4 * hh);
                        const f32x4 sc = *(const LAS f32x4*)(vec + 2048 + k0 + 4 * hh), sh = *(const LAS f32x4*)(vec + 3072 + k0 + 4 * hh);
                        const f32x4 xm = (vv[u][hh] - mu) * rs * g + bb;
                        *(f32x4*)(yrow + s * 32 + 4 * hh) = xm;
                        const f32x4 h4 = xm * sc + sh;
                        hv[4 * hh + 0] = h4[0]; hv[4 * hh + 1] = h4[1]; hv[4 * hh + 2] = h4[2]; hv[4 * hh + 3] = h4[3];
                    }
                    unsigned wh[4], wl[4];
#pragma unroll
                    for (int i = 0; i < 4; ++i) {
                        const unsigned ha = f2bf(hv[2 * i]), hb = f2bf(hv[2 * i + 1]);
                        wh[i] = ha | (hb << 16);
                        wl[i] = pk2(hv[2 * i] - bf2f(ha), hv[2 * i + 1] - bf2f(hb));
                    }
                    *(u32x4*)(hrow + s * 32) = (u32x4){wh[0], wh[1], wh[2], wh[3]};
                    const bf16x8 ah = __builtin_bit_cast(bf16x8, (u32x4){wh[0], wh[1], wh[2], wh[3]}), al = __builtin_bit_cast(bf16x8, (u32x4){wl[0], wl[1], wl[2], wl[3]});
                    const int kb = ((s & 7) * 32 + q * 8) * 2;
#pragma unroll
                    for (int nb = 0; nb < 4; ++nb) {
                        const bf16x8 bh = *(const LAS bf16x8*)(wb + (nb * 16 + r16) * 528 + kb), bl = *(const LAS bf16x8*)(wb + 33792 + (nb * 16 + r16) * 528 + kb);
                        acc[nb] = __builtin_amdgcn_mfma_f32_16x16x32_bf16(ah, bh, acc[nb], 0, 0, 0);
                        acc[nb] = __builtin_amdgcn_mfma_f32_16x16x32_bf16(al, bh, acc[nb], 0, 0, 0);
                        acc[nb] = __builtin_amdgcn_mfma_f32_16x16x32_bf16(ah, bl, acc[nb], 0, 0, 0);
                    }
                }
            }
        }
#pragma unroll
        for (int nb = 0; nb < 4; ++nb)
#pragma unroll
            for (int j = 0; j < 4; ++j) lg[(4 * q + j) * 64 + nb * 16 + r16] = acc[nb][j];
        __syncthreads();
        const float bias = p.router_bias[lane];
        const int g = lane >> 3;
        for (int r0 = 0; r0 < 16; r0 += 4) {
            float sg[4], sel[4], msel[4]; bool keep[4];
#pragma unroll
            for (int u = 0; u < 4; ++u) {
                const float lgv = lg[(r0 + u) * 64 + lane];
                sg[u] = 1.0f / (1.0f + expf(-lgv));
                sel[u] = sg[u] + bias;
            }
            float m1[4], m2[4]; int cand[4];
#pragma unroll
            for (int u = 0; u < 4; ++u) { m1[u] = fmaxf(sel[u], __shfl_xor(sel[u], 1)); }
#pragma unroll
            for (int u = 0; u < 4; ++u) { m1[u] = fmaxf(m1[u], __shfl_xor(m1[u], 2)); }
#pragma unroll
            for (int u = 0; u < 4; ++u) { m1[u] = fmaxf(m1[u], __shfl_xor(m1[u], 4)); cand[u] = (sel[u] == m1[u]) ? lane : 64; }
#pragma unroll
            for (int u = 0; u < 4; ++u) { cand[u] = min(cand[u], __shfl_xor(cand[u], 1)); }
#pragma unroll
            for (int u = 0; u < 4; ++u) { cand[u] = min(cand[u], __shfl_xor(cand[u], 2)); }
#pragma unroll
            for (int u = 0; u < 4; ++u) { cand[u] = min(cand[u], __shfl_xor(cand[u], 4)); m2[u] = (lane == cand[u]) ? -INFINITY : sel[u]; }
#pragma unroll
            for (int u = 0; u < 4; ++u) { m2[u] = fmaxf(m2[u], __shfl_xor(m2[u], 1)); }
#pragma unroll
            for (int u = 0; u < 4; ++u) { m2[u] = fmaxf(m2[u], __shfl_xor(m2[u], 2)); }
#pragma unroll
            for (int u = 0; u < 4; ++u) { m2[u] = fmaxf(m2[u], __shfl_xor(m2[u], 4)); }
#pragma unroll
            for (int u = 0; u < 4; ++u) {
                const float gs = m1[u] + m2[u];
                int cntg = 0;
#pragma unroll
                for (int gg = 0; gg < 8; ++gg) { const float v = __shfl(gs, gg * 8); cntg += (v > gs || (v == gs && gg < g)) ? 1 : 0; }
                keep[u] = cntg < 4;
                msel[u] = keep[u] ? sel[u] : -INFINITY;
                lg[(r0 + u) * 64 + lane] = msel[u];
            }
            int cnt[4] = {0, 0, 0, 0};
#pragma unroll 4
            for (int q4 = 0; q4 < 16; ++q4) {
#pragma unroll
                for (int u = 0; u < 4; ++u) {
                    const f32x4 v = *(const LAS f32x4*)(lg + (r0 + u) * 64 + q4 * 4);
#pragma unroll
                    for (int i = 0; i < 4; ++i) cnt[u] += (v[i] > msel[u]) ? 1 : 0;
                }
            }
#pragma unroll
            for (int u = 0; u < 4; ++u) {
                bool ok = true;
#pragma unroll
                for (int k = 0; k < 8; ++k) ok = ok && (__ballot(keep[u] && cnt[u] == k) != 0ull);
                if (!ok) {
                    int c2 = 0;
                    for (int e2 = 0; e2 < 64; ++e2) { const float v = lg[(r0 + u) * 64 + e2]; c2 += (v > msel[u] || (v == msel[u] && e2 < lane)) ? 1 : 0; }
                    cnt[u] = c2;
                }
            }
            float wsum[4]; bool chosen[4];
#pragma unroll
            for (int u = 0; u < 4; ++u) { chosen[u] = keep[u] && cnt[u] < 8; wsum[u] = chosen[u] ? sg[u] : 0.f; }
#pragma unroll
            for (int o = 1; o < 64; o <<= 1) {
#pragma unroll
                for (int u = 0; u < 4; ++u) wsum[u] += __shfl_xor(wsum[u], o);
            }
#pragma unroll
            for (int u = 0; u < 4; ++u) {
                if (chosen[u]) {
                    const int pos = atomicAdd((int*)&lcnt[lane], 1);
                    sel_ep[(wid * 16 + r0 + u) * 8 + cnt[u]] = lane | (pos << 8);
                    sel_w[(wid * 16 + r0 + u) * 8 + cnt[u]] = sg[u] / wsum[u] * 2.5f;
                }
            }
        }
        __syncthreads();
        if (tid < 64) { int tt = tid; asm volatile("" : "+v"(tt)); lbase[tt] = atomicAdd(&gcnt[tt], lcnt[tt]); }
        __syncthreads();
        for (int idx = tid; idx < 1024; idx += 512) {
            const int ep = sel_ep[idx], e = ep & 0xff, pos = ep >> 8, gi = lbase[e] + pos;
            LDST[(size_t)e * T + gi] = (t0 + (idx >> 3)) * NSLOT + (idx & 7);
            LWt[(size_t)e * T + gi] = sel_w[idx];
        }
    }
}

constexpr int LDS_ROWTAB = LDS_TAB, LDS_AUX = LDS_TAB + 12288, MOE_MAX_UNITS = 20, LDS_UTAB = LDS_CTL + 256, LDS_TSTART = LDS_UTAB + MOE_MAX_UNITS * 32;
__device__ __forceinline__ int moe_setup(const Params& p, LAS unsigned char* lds0, int nN, int bmul, int badd) {
    LAS int* tstart = (LAS int*)(lds0 + LDS_TSTART); LAS int* utab = (LAS int*)(lds0 + LDS_UTAB);
    const int* gcnt = (const int*)(p.ws + OFF_CNT);
    __syncthreads();
    if (hw_tid() == 0) {
        int a = 0;
        for (int e = 0; e < NEX; ++e) { const int c = e < NE ? gcnt[e] : T; tstart[e] = a; a += (c + 255) >> 8; }
        tstart[NEX] = a;
    }
    __syncthreads();
    const int total = tstart[NEX] * nN, G = gridDim.x, c = vcu_of_block();
    if (hw_tid() < MOE_MAX_UNITS) {
        const int i = hw_tid(), L = i * G + c;
        int pm = 0, pn = 0, e = 0, i0 = 0, cnt = 0;
        if (L < total) {
            const int mt = L / nN, pl = L % nN;
            for (int j = 1; j < NEX; ++j) e += (mt >= tstart[j]) ? 1 : 0;
            pm = mt; pn = e * bmul + badd + pl; i0 = (mt - tstart[e]) * 256; cnt = e < NE ? gcnt[e] : T;
        }
        utab[i * 8 + 0] = pm; utab[i * 8 + 1] = pn; utab[i * 8 + 2] = e; utab[i * 8 + 3] = i0; utab[i * 8 + 4] = cnt;
    }
    __syncthreads();
    const int n = (total - c + G - 1) / G;
    return n < 0 ? 0 : (n > MOE_MAX_UNITS ? MOE_MAX_UNITS : n);
}
struct MoeSched {
    LAS const int* utab; LAS const unsigned* rowtab; int n;
    __device__ __forceinline__ bool next(int i, pg8::Unit& u) const {
        if (i >= n) return false;
        u.pm = __builtin_amdgcn_readfirstlane(utab[i * 8 + 0]); u.pn = __builtin_amdgcn_readfirstlane(utab[i * 8 + 1]); u.e = __builtin_amdgcn_readfirstlane(utab[i * 8 + 2]); u.idx = i; return true;
    }
    __device__ __forceinline__ unsigned row_off(int i, int r) const { return rowtab[i * 256 + r]; }
    __device__ __forceinline__ void a_ready(const pg8::Unit&) const {}
    __device__ __forceinline__ void done(const pg8::Unit&) const {}
};
struct EpiGU {
    static constexpr bool PERM = true;
    LAS const float* auxw; unsigned char* ws;
    __device__ __forceinline__ void operator()(const f32x4 (&acc)[2][2][4][2], const pg8::Unit& u, int wr, int wc, int fr, int fq) const {
        const int pl = u.pn & 1;
        bf16_t* ACT = (bf16_t*)(ws + OFF_ACT) + (size_t)u.pm * 256 * FF + pl * 128 + wc * 32 + 8 * fq;
#pragma unroll
        for (int ai = 0; ai < 2; ++ai)
#pragma unroll
            for (int m = 0; m < 4; ++m) {
                const int rl = ai * 128 + wr * 64 + m * 16 + fr;
                const float wrow = auxw[u.idx * 256 + rl];
                float a[8];
#pragma unroll
                for (int n = 0; n < 2; ++n)
#pragma unroll
                    for (int q = 0; q < 4; ++q) { const float g = acc[ai][0][m][n][q], uu = acc[ai][1][m][n][q]; a[n * 4 + q] = g / (1.f + __expf(-g)) * uu * wrow; }
                u32x4 w; w.x = pk2(a[0], a[1]); w.y = pk2(a[2], a[3]); w.z = pk2(a[4], a[5]); w.w = pk2(a[6], a[7]);
                *(u32x4*)(ACT + (size_t)rl * FF) = w;
            }
    }
};
__device__ __forceinline__ void phase_gateup(const Params& p, LAS unsigned char* lds0) {
    int n = moe_setup(p, lds0, 2, 2, 0); n = n > 12 ? 12 : n;
    LAS const int* utab = (LAS const int*)(lds0 + LDS_UTAB);
    LAS unsigned* rowtab = (LAS unsigned*)(lds0 + LDS_ROWTAB);
    LAS float* auxw = (LAS float*)(lds0 + LDS_AUX);
    const int* LDST = (const int*)(p.ws + OFF_LDST);
    const float* LWt = (const float*)(p.ws + OFF_LW);
    for (int i = 0; i < n; ++i) {
        const int e = utab[i * 8 + 2], i0 = utab[i * 8 + 3], cnt = utab[i * 8 + 4];
        if (hw_tid() < 256) {
            const int li = i0 + hw_tid(); int tok = 0; float w = 0.f;
            if (li < cnt) { if (e < NE) { tok = LDST[(size_t)e * T + li] / NSLOT; w = LWt[(size_t)e * T + li]; } else { tok = li; w = 1.f; } }
            rowtab[i * 256 + hw_tid()] = (unsigned)tok * (unsigned)(D * 2);
            auxw[i * 256 + hw_tid()] = w;
        }
    }
    __syncthreads();
    MoeSched S{utab, rowtab, n};
    pg8::Gemm g{(const bf16_t*)(p.ws + OFF_H), (const bf16_t*)(p.ws + OFF_WGU)};
    EpiGU E{auxw, p.ws};
    pg8::gemm_phase<D, EpiGU, MoeSched, true>(lds0, g, S, E);
    {
        LAS const int* tstart = (LAS const int*)(lds0 + LDS_TSTART);
        const int total = tstart[NEX] * 2, G = gridDim.x, v = vcu_of_block(), rem = total % G;
        if (v >= rem) {
            const int lane = hw_tid() & 63, wv = hw_tid() >> 6, nw = (G - rem) * 8, w = (v - rem) * 8 + wv;
            LAS float* scr = (LAS float*)lds0 + wv * (64 * 33);
            for (int it = w; it < TR_N_D; it += nw) transpose_item(p, scr, TR_N_A + TR_N_GU + it, lane);
        }
    }
}
constexpr float FP8S = 32.f, FP8I = 1.f / 32.f;
__device__ __forceinline__ unsigned pk4_fp8(float a, float b, float c, float d) {
    a = __builtin_amdgcn_fmed3f(a * FP8S, -440.f, 440.f); b = __builtin_amdgcn_fmed3f(b * FP8S, -440.f, 440.f);
    c = __builtin_amdgcn_fmed3f(c * FP8S, -440.f, 440.f); d = __builtin_amdgcn_fmed3f(d * FP8S, -440.f, 440.f);
    int w = __builtin_amdgcn_cvt_pk_fp8_f32(a, b, 0, false);
    w = __builtin_amdgcn_cvt_pk_fp8_f32(c, d, w, true);
    return (unsigned)w;
}
struct EpiDown {
    static constexpr bool PERM = true;
    LAS const int* auxd; unsigned char* ws;
    __device__ __forceinline__ void operator()(const f32x4 (&acc)[2][2][4][2], const pg8::Unit& u, int wr, int wc, int fr, int fq) const {
        const int pl = u.pn & 3;
        unsigned char* SL = ws + OFF_SLOTS + pl * 256 + wc * 64 + 16 * fq;
#pragma unroll
        for (int ai = 0; ai < 2; ++ai)
#pragma unroll
            for (int m = 0; m < 4; ++m) {
                const int d = auxd[u.idx * 256 + ai * 128 + wr * 64 + m * 16 + fr];
                u32x4 w;
                w.x = pk4_fp8(acc[ai][0][m][0][0], acc[ai][0][m][0][1], acc[ai][0][m][0][2], acc[ai][0][m][0][3]);
                w.y = pk4_fp8(acc[ai][0][m][1][0], acc[ai][0][m][1][1], acc[ai][0][m][1][2], acc[ai][0][m][1][3]);
                w.z = pk4_fp8(acc[ai][1][m][0][0], acc[ai][1][m][0][1], acc[ai][1][m][0][2], acc[ai][1][m][0][3]);
                w.w = pk4_fp8(acc[ai][1][m][1][0], acc[ai][1][m][1][1], acc[ai][1][m][1][2], acc[ai][1][m][1][3]);
                *(u32x4*)(SL + (size_t)d * 1024) = w;
            }
    }
};
__device__ __forceinline__ void phase_down(const Params& p, LAS unsigned char* lds0) {
    const int n = moe_setup(p, lds0, 4, 4, 0);
    LAS const int* utab = (LAS const int*)(lds0 + LDS_UTAB);
    LAS int* auxd = (LAS int*)(lds0 + LDS_TAB);
    const int* LDST = (const int*)(p.ws + OFF_LDST);
    for (int i = 0; i < n; ++i) {
        const int e = utab[i * 8 + 2], i0 = utab[i * 8 + 3], cnt = utab[i * 8 + 4];
        if (hw_tid() < 256) {
            const int li = i0 + hw_tid();
            auxd[i * 256 + hw_tid()] = li < cnt ? (e < NE ? LDST[(size_t)e * T + li] : li * NSLOT + 8) : T * NSLOT;
        }
    }
    __syncthreads();
    MoeSched S{utab, (LAS const unsigned*)(lds0 + LDS_ROWTAB), n};
    pg8::Gemm g{(const bf16_t*)(p.ws + OFF_ACT), (const bf16_t*)(p.ws + OFF_WD)};
    EpiDown E{auxd, p.ws};
    pg8::gemm_phase<FF, EpiDown, MoeSched, false>(lds0, g, S, E);
}

__device__ __forceinline__ void slot_sum16(const unsigned char* SL, int t, int cb, float (&s)[16]) {
#pragma unroll
    for (int i = 0; i < 16; ++i) s[i] = 0.f;
    u32x4 v[NSLOT];
#pragma unroll
    for (int k = 0; k < NSLOT; ++k) v[k] = *(const u32x4*)(SL + (size_t)(t * NSLOT + k) * 1024 + cb);
#pragma unroll
    for (int k = 0; k < NSLOT; ++k)
#pragma unroll
        for (int i = 0; i < 4; ++i) {
            typedef float f32x2 __attribute__((ext_vector_type(2)));
            const f32x2 lo = __builtin_amdgcn_cvt_pk_f32_fp8((int)v[k][i], false), hi = __builtin_amdgcn_cvt_pk_f32_fp8((int)v[k][i], true);
            s[4 * i] += lo.x; s[4 * i + 1] += lo.y; s[4 * i + 2] += hi.x; s[4 * i + 3] += hi.y;
        }
#pragma unroll
    for (int i = 0; i < 16; ++i) s[i] *= FP8I;
}
__device__ __forceinline__ int slot_col(int bb) { return (bb >> 4) * 256 + ((bb >> 2) & 3) * 32 + (bb & 3) * 8; }
__device__ __forceinline__ void phase_final(const Params& p) {
    const int lane = hw_tid() & 63, gw = blockIdx.x * 8 + (hw_tid() >> 6), ngw = gridDim.x * 8;
    const float* mod = (const float*)(p.ws + OFF_MOD);
    const unsigned char* SL = p.ws + OFF_SLOTS;
    const int c0 = slot_col(lane);
    for (int row = gw; row < T; row += ngw) {
        const float* g2 = mod + (size_t)(row / SEQ) * MODW + 5 * D;
        float f[16];
        slot_sum16(SL, row, lane * 16, f);
        f32x4 y[4]; float s = 0.f;
#pragma unroll
        for (int j = 0; j < 4; ++j) {
            const int cj = c0 + (j >> 1) * 128 + (j & 1) * 4;
            const f32x4 xm = *(const f32x4*)(p.out + (size_t)row * D + cj), gg = *(const f32x4*)(g2 + cj);
            y[j][0] = ALPHA * xm[0] + gg[0] * f[4 * j]; y[j][1] = ALPHA * xm[1] + gg[1] * f[4 * j + 1];
            y[j][2] = ALPHA * xm[2] + gg[2] * f[4 * j + 2]; y[j][3] = ALPHA * xm[3] + gg[3] * f[4 * j + 3];
            s += (y[j][0] + y[j][1]) + (y[j][2] + y[j][3]);
        }
#pragma unroll
        for (int o = 1; o < 64; o <<= 1) s += __shfl_xor(s, o);
        const float mean = s * (1.f / D);
        float qv = 0.f;
#pragma unroll
        for (int j = 0; j < 4; ++j) { y[j] = y[j] - mean; qv += (y[j][0] * y[j][0] + y[j][1] * y[j][1]) + (y[j][2] * y[j][2] + y[j][3] * y[j][3]); }
#pragma unroll
        for (int o = 1; o < 64; o <<= 1) qv += __shfl_xor(qv, o);
        const float rstd = 1.0f / sqrtf(qv * (1.f / D) + 1e-5f);
#pragma unroll
        for (int j = 0; j < 4; ++j) {
            const int cj = c0 + (j >> 1) * 128 + (j & 1) * 4;
            const f32x4 g = *(const f32x4*)(p.ln2_g + cj), bb4 = *(const f32x4*)(p.ln2_b + cj);
            *(f32x4*)(p.out + (size_t)row * D + cj) = y[j] * rstd * g + bb4;
        }
    }
}

#define XB_TMO      128
#define XB_XCNT(j)  (256  + 64 * (j))
#define XB_XSUB(j)  (1280 + 64 * (j))
#define XB_XGEN(j)  (2304 + 64 * (j))
#define XB_TOP      3328
#define XB_TOPGEN   3392
#define XCD_BAR_WORDS 3456
#define XB_SPIN_CAP (1u << 18)
__device__ __forceinline__ unsigned xb_ld(unsigned* p)              { return __hip_atomic_load(p, __ATOMIC_RELAXED, __HIP_MEMORY_SCOPE_AGENT); }
__device__ __forceinline__ unsigned xb_add(unsigned* p, unsigned v) { return __hip_atomic_fetch_add(p, v, __ATOMIC_RELAXED, __HIP_MEMORY_SCOPE_AGENT); }
__device__ __forceinline__ unsigned xb_xcc_id() { return (unsigned)__builtin_amdgcn_s_getreg((3 << 11) | 20) & 0xFu; }
#define XB_SPIN(cond, bar) do { unsigned _sp = 0; while (cond) { __builtin_amdgcn_s_sleep(1); \
    if ((++_sp & 255u) == 0u) { if (xb_ld(&(bar)[XB_TMO])) break; if (_sp > XB_SPIN_CAP) { atomicAdd(&(bar)[XB_TMO], 1u); break; } } } } while (0)
struct XcdBarrier { unsigned* bar; unsigned x; volatile LAS unsigned* st; };
__device__ __forceinline__ XcdBarrier xcd_barrier_post(unsigned* bar, volatile LAS unsigned* st) {
    XcdBarrier b; b.bar = bar; b.x = xb_xcc_id(); b.st = st;
    if (hw_tid() == 0) (void)xb_add(&bar[XB_XCNT(b.x)], 1u);
    return b;
}
__device__ __forceinline__ void xcd_barrier_complete(unsigned* bar, unsigned x, unsigned& nloc, unsigned& nx) {
    const unsigned G = gridDim.x * gridDim.y * gridDim.z;
    unsigned sum, cnt, mine, sp = 0u;
    for (;;) {
        sum = 0u; cnt = 0u; mine = 0u;
#pragma unroll
        for (unsigned j = 0; j < 16; ++j) { const unsigned c = xb_ld(&bar[XB_XCNT(j)]); sum += c; cnt += (c > 0u) ? 1u : 0u; mine = (j == x) ? c : mine; }
        if (sum == G) break;
        __builtin_amdgcn_s_sleep(1);
        if ((++sp & 255u) == 0u) { if (xb_ld(&bar[XB_TMO])) break; if (sp > XB_SPIN_CAP) { atomicAdd(&bar[XB_TMO], 1u); break; } }
    }
    nloc = mine > 0u ? mine : 1u; nx = cnt > 0u ? cnt : 1u;
}
__device__ __forceinline__ void xcd_barrier(const XcdBarrier& b) {
    asm volatile("s_waitcnt vmcnt(0)" ::: "memory");
    __syncthreads();
    if (hw_tid() == 0) {
        unsigned* bar = b.bar;
        __builtin_amdgcn_s_waitcnt(0);
        unsigned nloc = b.st[0], nx = b.st[1];
        if (nloc == 0u) { xcd_barrier_complete(bar, b.x, nloc, nx); b.st[0] = nloc; b.st[1] = nx; }
        const unsigned old = xb_add(&bar[XB_XSUB(b.x)], 1u);
        const unsigned gen = old / nloc;
        if (old + 1u == (gen + 1u) * nloc) {
            __builtin_amdgcn_fence(__ATOMIC_RELEASE, "agent");
            asm volatile("s_waitcnt vmcnt(0)" ::: "memory");
            const unsigned og = xb_add(&bar[XB_TOP], 1u);
            const unsigned tg = og / nx;
            if (og + 1u == (tg + 1u) * nx) xb_add(&bar[XB_TOPGEN], 1u);
            else XB_SPIN(xb_ld(&bar[XB_TOPGEN]) == tg, bar);
            __builtin_amdgcn_fence(__ATOMIC_ACQUIRE, "agent");
            xb_add(&bar[XB_XGEN(b.x)], 1u);
            asm volatile("s_waitcnt vmcnt(0)" ::: "memory");
        } else {
            XB_SPIN(xb_ld(&bar[XB_XGEN(b.x)]) == gen, bar);
            __builtin_amdgcn_fence(__ATOMIC_ACQUIRE, "agent");
            asm volatile("s_waitcnt vmcnt(0)" ::: "memory");
        }
    }
    __syncthreads();
}

constexpr size_t OFF_BAR = 448 * 1024;

__global__ void __launch_bounds__(512, 2) mk_fwd(Params p) {
    extern __shared__ __attribute__((aligned(16))) unsigned char smem[];
    LAS unsigned char* lds0 = (LAS unsigned char*)smem;
    {
        const unsigned hw = (unsigned)__builtin_amdgcn_s_getreg((5 << 11) | 4) & 63u;
        if ((threadIdx.x & 63) == 0) *(volatile LAS int*)(LDS_HWTAB + hw * 4) = (int)(threadIdx.x >> 6);
        if (threadIdx.x < 64) ((LAS unsigned*)(lds0 + LDS_CTL))[threadIdx.x] = 0u;
    }
    __syncthreads();
    XcdBarrier bar; bar.bar = (unsigned*)(p.ws + OFF_BAR); bar.x = 0; bar.st = nullptr;
    bar = xcd_barrier_post((unsigned*)(p.ws + OFF_BAR), (volatile LAS unsigned*)(lds0 + LDS_CTL));
#ifndef PROBE
#define PROBE -1
#endif
#ifndef PROBE_END
#define PROBE_END (PROBE + 1)
#endif
    unsigned long long pt0 = 0, pt1 = 0;
#define RUN_PHASE(k, call) { if ((k) > 0) xcd_barrier(bar); if (PROBE >= 0 && (k) == PROBE) pt0 = __builtin_amdgcn_s_memrealtime(); if (PROBE >= 0 && (k) == PROBE_END) pt1 = __builtin_amdgcn_s_memrealtime(); \
    int on_ = 1; asm volatile("" : "+s"(on_)); if (on_) { int grp_ = hw_tid() >> 8; asm volatile("" : "+v"(grp_)); LAS unsigned char* lds = lds0 + grp_ * 32768; (void)lds; call; } }
    RUN_PHASE(0, phase_prep(p, lds))
    RUN_PHASE(1, phase_xn(p))
    RUN_PHASE(2, phase_inproj(p, lds0))
    RUN_PHASE(3, phase_attn_pool(p, lds, (char*)smem))
    RUN_PHASE(4, phase_outproj(p, lds0))
    RUN_PHASE(5, phase_router(p, lds0))
    RUN_PHASE(6, phase_gateup(p, lds0))
    RUN_PHASE(7, phase_down(p, lds0))
    RUN_PHASE(8, phase_final(p))
    if (PROBE >= 0) {
        if (PROBE_END == 9) pt1 = __builtin_amdgcn_s_memrealtime();
        if (blockIdx.x == 0 && hw_tid() == 0) { const unsigned long long tend = __builtin_amdgcn_s_memrealtime() + 8ull * (pt1 - pt0); while (__builtin_amdgcn_s_memrealtime() < tend) __builtin_amdgcn_s_sleep(8); }
    }
}

extern "C" void kernel_launch(void* const* d_in, const int* in_sizes, int n_in, void* d_out, int out_size, void* d_ws, size_t ws_size, hipStream_t stream) {
    static int grid = 0;
    if (grid == 0) {
        int dev = 0, cus = 0, per_cu = 0;
        (void)hipGetDevice(&dev);
        (void)hipDeviceGetAttribute(&cus, hipDeviceAttributeMultiprocessorCount, dev);
        (void)hipFuncSetAttribute((const void*)mk_fwd, hipFuncAttributeMaxDynamicSharedMemorySize, LDS_BYTES);
        (void)hipOccupancyMaxActiveBlocksPerMultiprocessor(&per_cu, (const void*)mk_fwd, 512, LDS_BYTES);
        if (per_cu < 1) fprintf(stderr, "kernel_launch: occupancy query says %d blocks per CU\n", per_cu);
        (void)hipGetLastError();
        grid = cus;
        if (ws_size < WS_NEED) fprintf(stderr, "kernel_launch: workspace too small: %zu < %zu\n", ws_size, (size_t)WS_NEED);
    }
    Params p{};
    const float** pp = (const float**)&p;
    for (int i = 0; i < 24; ++i) pp[i] = (const float*)d_in[i];
    p.out = (float*)d_out; p.ws = (unsigned char*)d_ws;
    (void)hipMemsetAsync((char*)d_ws + OFF_BAR, 0, XCD_BAR_WORDS * 4, stream);
    hipLaunchKernelGGL(mk_fwd, dim3(grid), dim3(512), LDS_BYTES, stream, p);
}
```

```cpp
#include <hip/hip_runtime.h>
#include <stdint.h>
#include <stdio.h>


#ifdef PROBE_ACC
#ifndef PROBE_BLK
#define PROBE_BLK 0
#endif
#ifndef PROBE_MUL
#define PROBE_MUL 8ull
#endif
#define TS_ADD(k, sgn) do { if (blockIdx.x == PROBE_BLK && hw_tid() == 0) { const unsigned long long t_ = __builtin_amdgcn_s_memrealtime(); \
    __hip_atomic_fetch_add((unsigned long long*)(g_probe_ws + 448 * 1024 + 16384) + (k), (sgn) ? t_ : (0ull - t_), __ATOMIC_RELAXED, __HIP_MEMORY_SCOPE_AGENT); } } while (0)
#define TS_BEGIN(k) TS_ADD(k, false)
#define TS_END(k) TS_ADD(k, true)
#else
#define TS_BEGIN(k) do {} while (0)
#define TS_END(k) do {} while (0)
#endif
#define LAS __attribute__((address_space(3)))
#define TIDX ((int)(hw_tid() & 255))
#define VBLK ((int)(blockIdx.x * 2 + (hw_tid() >> 8)))
#define NVBLK ((int)(gridDim.x * 2))
typedef unsigned short bf16_t;
typedef short bf16x8 __attribute__((ext_vector_type(8)));
typedef float f32x4 __attribute__((ext_vector_type(4)));
typedef unsigned u32x4 __attribute__((ext_vector_type(4)));
typedef unsigned u32x2 __attribute__((ext_vector_type(2)));

constexpr int D = 1024, NB = 16, SEQ = 2048, T = NB * SEQ, CTXL = 256, TC = NB * CTXL, KVL = CTXL + SEQ;
constexpr int PW = 1536, NE = 64, NEX = 65, FF = 256, NSLOT = 9, MODW = 6 * D;
constexpr float ALPHA = 1.189207115002721f;
constexpr float C2 = 0.125f * 1.4426950408889634f;
constexpr int NPHASE = 9;
constexpr int LDS_BYTES = 163840, LDS_TAB = 131072, LDS_CTL = 155648;
constexpr int LDS_HWTAB = LDS_CTL + 2048;
__device__ __forceinline__ int hw_tid() {
    const unsigned hw = (unsigned)__builtin_amdgcn_s_getreg((5 << 11) | 4) & 63u;
    const int w = __builtin_amdgcn_readfirstlane(*(volatile LAS int*)(LDS_HWTAB + hw * 4));
    return w * 64 + (int)__builtin_amdgcn_mbcnt_hi(~0u, __builtin_amdgcn_mbcnt_lo(~0u, 0u));
}

constexpr size_t MiB = 1u << 20;
constexpr size_t OFF_CNT = 0, OFF_MOD = 4096, OFF_ROPE = 512 * 1024;
constexpr size_t OFF_WTIN = 1 * MiB, OFF_WTOUT = 4 * MiB, OFF_WD = 6 * MiB, OFF_LDST = 39 * MiB, OFF_ACT = 47 * MiB;
constexpr size_t OFF_SLOTS = 201 * MiB;
constexpr size_t OFF_WGU = 201 * MiB, OFF_H = 266 * MiB, OFF_LW = 330 * MiB;
constexpr size_t OFF_XN = 47 * MiB, OFF_Q = 119 * MiB, OFF_K = 167 * MiB;
constexpr size_t OFF_V = 338 * MiB, OFF_U = 356 * MiB, OFF_AO = 372 * MiB, OFF_STATS = 436 * MiB;
constexpr size_t OFF_WRH = 490 * MiB, OFF_WRL = OFF_WRH + 128 * 1024;
constexpr size_t WS_NEED = 491 * MiB;

struct Params {
    const float *x, *c, *ctx, *c_ctx, *w_mod, *b_mod, *w_in, *q_norm, *k_norm, *pool_w, *pool_scale, *w_out, *ln1_g, *ln1_b,
        *w_router, *router_bias, *w_gate, *w_up, *w_down, *ws_gate, *ws_up, *ws_down, *ln2_g, *ln2_b;
    float* out;
    unsigned char* ws;
};

__device__ __forceinline__ unsigned f2bf(float f) { unsigned u = __float_as_uint(f); return (u + 0x7fffu + ((u >> 16) & 1u)) >> 16; }
__device__ __forceinline__ unsigned pk2(float lo, float hi) { return f2bf(lo) | (f2bf(hi) << 16); }
__device__ __forceinline__ float bf2f(unsigned h) { return __uint_as_float(h << 16); }
__device__ __forceinline__ float bflo(unsigned w) { return __uint_as_float(w << 16); }
__device__ __forceinline__ float bfhi(unsigned w) { return __uint_as_float(w & 0xffff0000u); }

namespace pg8 {
constexpr int BM = 256, BK = 64, HALF = 128, HTB = HALF * BK * 2, STAGE_BYTES = 8 * HTB;
__host__ __device__ __forceinline__ int lds_byte(int r, int c) { const int st = (r >> 4) * 2 + (c >> 5), rr = r & 15, cc = c & 31, ob = rr * 64 + cc * 2; return st * 1024 + (ob ^ (((ob >> 9) & 1) << 5)); }
__host__ __device__ __forceinline__ void stage_rc(int b, int& R, int& C) { const int st = b / 1024, sb = b % 1024, swz = sb ^ (((sb >> 9) & 1) << 5); R = (st >> 1) * 16 + swz / 64; C = (st & 1) * 32 + (swz % 64) / 2; }
__host__ __device__ __forceinline__ int perm32(int rho) { const int n = rho >> 4, i = rho & 15; return 8 * (i >> 2) + 4 * n + (i & 3); }
struct Unit { int pm, pn, idx, e; };
struct Gemm { const bf16_t* A; const bf16_t* Bt; unsigned char* pws; int tsid; };
__device__ __forceinline__ unsigned cvt_pk_bf16(float lo, float hi) { unsigned r; asm volatile("v_cvt_pk_bf16_f32 %0, %1, %2" : "=v"(r) : "v"(lo), "v"(hi)); return r; }

template <int K, class Epi, class Sched, bool GATHER, bool ALIGN_EPI = true>
__device__ __forceinline__ void gemm_phase(LAS unsigned char* lds, const Gemm g, const Sched& S, const Epi& E) {
    const int tid = hw_tid(), wid = __builtin_amdgcn_readfirstlane(tid >> 6), lane = tid & 63, wr = wid >> 2, wc = wid & 3, fr = lane & 15, fq = lane >> 4;
    constexpr int nt = K / BK;
    unsigned voffA[2], voffB[2], colA = 0; int rowA = 0;
#pragma unroll
    for (int i = 0; i < 2; ++i) { int R, C; stage_rc(tid * 16 + i * 8192, R, C); const int Rb = Epi::PERM ? ((R & ~31) + perm32(R & 31)) : R;
        voffA[i] = (unsigned)(R * K + C) * 2u; voffB[i] = (unsigned)(Rb * K + C) * 2u; if (i == 0) { colA = (unsigned)C * 2u; rowA = R; } }
    const size_t kstep = (size_t)(BK * 2);
    const size_t hstep = (size_t)HALF * K * 2;
    const size_t tstep = 2 * hstep;
    const unsigned ldsw = (unsigned)wid * 1024u;
    const int aoff = lds_byte(wr * 64 + fr, fq * 8), boff = lds_byte(wc * 32 + fr, fq * 8);
#define PG8_SA(b, h) (((b) * 2 + (h)) * HTB)
#define PG8_SB(b, h) ((4 + (b) * 2 + (h)) * HTB)
#define PG8_STAGE(bufoff, gbase, voff) do { _Pragma("unroll") for (int _i = 0; _i < 2; ++_i) \
        __builtin_amdgcn_global_load_lds((const unsigned*)((const char*)(gbase) + (voff)[_i]), (LAS unsigned*)(lds + (bufoff) + ldsw + _i * 8192), 16, 0, 0); } while (0)
#define PG8_STAGE_A(bufoff, ptr, h, NX) do { if constexpr (GATHER) { unsigned _v[2]; \
            if (NX) { _v[0] = S.row_off(nidx, (h) * HALF + rowA) + colA; _v[1] = S.row_off(nidx, (h) * HALF + rowA + 64) + colA; } else { _v[0] = vA[h][0]; _v[1] = vA[h][1]; } PG8_STAGE(bufoff, ptr, _v); } \
        else { PG8_STAGE(bufoff, (ptr) + (h) * hstep, voffA); } } while (0)
#define PG8_LDA(dst, b, h) do { _Pragma("unroll") for (int m = 0; m < 4; ++m) _Pragma("unroll") for (int k = 0; k < 2; ++k) dst[m][k] = *(const LAS bf16x8*)(lds + PG8_SA(b, h) + aoff + m * 2048 + k * 1024); } while (0)
#define PG8_LDB(dst, b, h) do { _Pragma("unroll") for (int n = 0; n < 2; ++n) _Pragma("unroll") for (int k = 0; k < 2; ++k) dst[n][k] = *(const LAS bf16x8*)(lds + PG8_SB(b, h) + boff + n * 2048 + k * 1024); } while (0)
#define PG8_MMA(ai, bj, At, Bt) do { __builtin_amdgcn_s_setprio(1); _Pragma("unroll") for (int m = 0; m < 4; ++m) _Pragma("unroll") for (int n = 0; n < 2; ++n) _Pragma("unroll") for (int k = 0; k < 2; ++k) \
        acc[ai][bj][m][n] = __builtin_amdgcn_mfma_f32_16x16x32_bf16(Bt[n][k], At[m][k], acc[ai][bj][m][n], 0, 0, 0); __builtin_amdgcn_s_setprio(0); } while (0)
#define PG8_WAIT_V(n) asm volatile("s_waitcnt vmcnt(" #n ")" ::: "memory")
#define PG8_WAIT_L(n) asm volatile("s_waitcnt lgkmcnt(" #n ")" ::: "memory")
#define PG8_BAR __builtin_amdgcn_s_barrier()
#define PG8_SCHED __builtin_amdgcn_sched_barrier(0)
    unsigned char* const g_probe_ws = g.pws; (void)g_probe_ws;
    Unit cur, nxt; int ui = 0;
    if (!S.next(0, cur)) return;
    f32x4 acc[2][2][4][2];
#pragma unroll
    for (int a = 0; a < 2; ++a)
#pragma unroll
        for (int b = 0; b < 2; ++b)
#pragma unroll
            for (int m = 0; m < 4; ++m)
#pragma unroll
                for (int n = 0; n < 2; ++n) acc[a][b][m][n] = (f32x4){0.f, 0.f, 0.f, 0.f};
    bf16x8 At[4][2], B0[2][2], B1[2][2];
    unsigned vA[2][2]; int nidx = 0;
    if constexpr (GATHER) {
#pragma unroll
        for (int h = 0; h < 2; ++h)
#pragma unroll
            for (int i = 0; i < 2; ++i) vA[h][i] = S.row_off(cur.idx, h * HALF + rowA + 64 * i) + colA;
    }
    const char* cA = GATHER ? (const char*)g.A : (const char*)g.A + (size_t)cur.pm * tstep; const char* cB = (const char*)g.Bt + (size_t)cur.pn * tstep;
    S.a_ready(cur);
    PG8_STAGE(PG8_SB(0, 0), cB, voffB); PG8_STAGE(PG8_SB(0, 1), cB + hstep, voffB); PG8_STAGE_A(PG8_SA(0, 0), cA, 0, false); PG8_STAGE_A(PG8_SA(0, 1), cA, 1, false);
    if (wr == 1) PG8_BAR;
    PG8_WAIT_V(2); PG8_BAR;
    PG8_STAGE(PG8_SB(1, 0), cB + kstep, voffB); PG8_STAGE_A(PG8_SA(1, 0), cA + kstep, 0, false); PG8_STAGE(PG8_SB(1, 1), cB + hstep + kstep, voffB);
    PG8_WAIT_V(6); PG8_BAR;
    for (;;) {
        const bool has_next = S.next(ui + 1, nxt);
        if constexpr (GATHER) nidx = has_next ? nxt.idx : cur.idx;
        const char* nA = GATHER ? (const char*)g.A : (has_next ? (const char*)g.A + (size_t)nxt.pm * tstep : cA); const char* nB = has_next ? (const char*)g.Bt + (size_t)nxt.pn * tstep : cB;
        TS_BEGIN(33 + 2 * g.tsid);
        for (int t = 0; t < nt; t += 2) {
            const bool last = (t == nt - 2);
            const char* a1 = cA + (size_t)(t + 1) * kstep;
            const char* a2 = last ? nA : cA + (size_t)(t + 2) * kstep; const char* b2 = last ? nB : cB + (size_t)(t + 2) * kstep;
            const char* a3 = a2 + kstep; const char* b3 = b2 + kstep;
            if (last && has_next) S.a_ready(nxt);
            PG8_LDB(B0, 0, 0); PG8_LDB(B1, 0, 1); PG8_SCHED; PG8_LDA(At, 0, 0); PG8_STAGE_A(PG8_SA(1, 1), a1, 1, false);
            PG8_WAIT_V(8); PG8_WAIT_L(0); PG8_BAR; PG8_MMA(0, 0, At, B0); PG8_MMA(0, 1, At, B1); PG8_BAR; PG8_SCHED;
            PG8_LDA(At, 0, 1); PG8_STAGE(PG8_SB(0, 0), b2, voffB); PG8_STAGE(PG8_SB(0, 1), b2 + hstep, voffB); PG8_STAGE_A(PG8_SA(0, 0), a2, 0, last);
            PG8_WAIT_V(8); PG8_WAIT_L(0); PG8_BAR; PG8_MMA(1, 0, At, B0); PG8_MMA(1, 1, At, B1); PG8_BAR; PG8_SCHED;
            PG8_LDB(B0, 1, 0); PG8_LDB(B1, 1, 1); PG8_SCHED; PG8_LDA(At, 1, 0); PG8_STAGE_A(PG8_SA(0, 1), a2, 1, last);
            PG8_WAIT_V(8); PG8_WAIT_L(0); PG8_BAR; PG8_MMA(0, 0, At, B0); PG8_MMA(0, 1, At, B1); PG8_BAR; PG8_SCHED;
            PG8_LDA(At, 1, 1); PG8_STAGE(PG8_SB(1, 0), b3, voffB); PG8_STAGE(PG8_SB(1, 1), b3 + hstep, voffB); PG8_STAGE_A(PG8_SA(1, 0), a3, 0, last);
            PG8_WAIT_V(8); PG8_WAIT_L(0); PG8_BAR; PG8_MMA(1, 0, At, B0); PG8_MMA(1, 1, At, B1); PG8_BAR; PG8_SCHED;
        }
        TS_END(33 + 2 * g.tsid);
        if constexpr (ALIGN_EPI) { if (wr == 0) PG8_BAR; }
        TS_BEGIN(32 + 2 * g.tsid); E(acc, cur, wr, wc, fr, fq); S.done(cur); TS_END(32 + 2 * g.tsid);
        if (!has_next) break;
#pragma unroll
        for (int a = 0; a < 2; ++a)
#pragma unroll
            for (int b = 0; b < 2; ++b)
#pragma unroll
                for (int m = 0; m < 4; ++m)
#pragma unroll
                    for (int n = 0; n < 2; ++n) acc[a][b][m][n] = (f32x4){0.f, 0.f, 0.f, 0.f};
        cur = nxt; cA = nA; cB = nB; ++ui;
        if constexpr (GATHER) {
#pragma unroll
            for (int h = 0; h < 2; ++h)
#pragma unroll
                for (int i = 0; i < 2; ++i) vA[h][i] = S.row_off(cur.idx, h * HALF + rowA + 64 * i) + colA;
        }
        if constexpr (ALIGN_EPI) { if (wr == 1) PG8_BAR; }
    }
    PG8_WAIT_V(0);
    if constexpr (!ALIGN_EPI) { if (wr == 0) PG8_BAR; }
    PG8_BAR;
#undef PG8_SA
#undef PG8_SB
#undef PG8_STAGE
#undef PG8_STAGE_A
#undef PG8_LDA
#undef PG8_LDB
#undef PG8_MMA
#undef PG8_WAIT_V
#undef PG8_WAIT_L
#undef PG8_BAR
#undef PG8_SCHED
}

struct DenseSched {
    int nN, n1, total, pn2lo, nN2, G, c;
    __device__ __forceinline__ bool next(int i, Unit& u) const {
        const int L = i * G + c; if (L >= total) return false;
        if (L < n1) { u.pm = L / nN; u.pn = L % nN; } else { const int r = L - n1; u.pm = n1 / nN + r / nN2; u.pn = pn2lo + r % nN2; }
        u.idx = i; u.e = 0; return true;
    }
    __device__ __forceinline__ void a_ready(const Unit&) const {}
    __device__ __forceinline__ void done(const Unit&) const {}
};
}

__device__ __forceinline__ int win_row(int n) { return (n & ~255) + 128 * ((n >> 5) & 1) + 32 * ((n >> 6) & 3) + (n & 31); }
__device__ __forceinline__ int gu_row(int j, int half) { return (j >> 7) * 256 + half * 128 + (j & 127); }

template <class RowMap>
__device__ __forceinline__ void transpose_tile(LAS float* tile, const float* src, int ld, int k0, int n0, bf16_t* dst, int Kdst, RowMap rowmap) {
    const int tid = TIDX;
#pragma unroll
    for (int pss = 0; pss < 4; ++pss) {
        const int k = pss * 16 + (tid >> 4), n4 = (tid & 15) * 4;
        const f32x4 v = *(const f32x4*)(src + (size_t)(k0 + k) * ld + n0 + n4);
        tile[k * 65 + n4 + 0] = v[0]; tile[k * 65 + n4 + 1] = v[1]; tile[k * 65 + n4 + 2] = v[2]; tile[k * 65 + n4 + 3] = v[3];
    }
    __syncthreads();
    {
        const int n = tid >> 2, kc = (tid & 3) * 16;
        unsigned w[8];
#pragma unroll
        for (int i = 0; i < 8; ++i) w[i] = pk2(tile[(kc + 2 * i) * 65 + n], tile[(kc + 2 * i + 1) * 65 + n]);
        bf16_t* dp = dst + (size_t)rowmap(n0 + n) * Kdst + k0 + kc;
        *(u32x4*)dp = (u32x4){w[0], w[1], w[2], w[3]};
        *(u32x4*)(dp + 8) = (u32x4){w[4], w[5], w[6], w[7]};
    }
    __syncthreads();
}

template <class RowMap>
__device__ __forceinline__ void wave_transpose(LAS float* scr, const float* src, int ld, int k0, int n0, bf16_t* dst, int Kdst, RowMap rowmap, int lane) {
#pragma unroll
    for (int i = 0; i < 8; ++i) {
        const int kk = 8 * i + (lane >> 3), n4 = (lane & 7) * 4;
        const f32x4 v = *(const f32x4*)(src + (size_t)(k0 + kk) * ld + n0 + n4);
        scr[kk * 33 + n4] = v[0]; scr[kk * 33 + n4 + 1] = v[1]; scr[kk * 33 + n4 + 2] = v[2]; scr[kk * 33 + n4 + 3] = v[3];
    }
    asm volatile("s_waitcnt lgkmcnt(0)" ::: "memory");
    const int c = lane & 7;
#pragma unroll
    for (int j = 0; j < 4; ++j) {
        const int n = (lane >> 3) + 8 * j; const LAS float* sp = scr + (8 * c) * 33 + n;
        u32x4 o; o.x = pk2(sp[0], sp[33]); o.y = pk2(sp[2 * 33], sp[3 * 33]); o.z = pk2(sp[4 * 33], sp[5 * 33]); o.w = pk2(sp[6 * 33], sp[7 * 33]);
        *(u32x4*)(dst + (size_t)rowmap(n0 + n) * Kdst + k0 + 8 * c) = o;
    }
    asm volatile("s_waitcnt lgkmcnt(0)" ::: "memory");
}

constexpr int TR_N_A = 16 * 48 + 16 * 32, TR_N_GU = NEX * 256, TR_N_D = NEX * 128;
constexpr int TR_GU_LATE = 224 * 8 * 6;
__device__ __forceinline__ void transpose_item(const Params& p, LAS float* scr, int id, int lane) {
    if (id < 16 * 48) { wave_transpose(scr, p.w_in, PW, (id / 48) * 64, (id % 48) * 32, (bf16_t*)(p.ws + OFF_WTIN), D, [](int n) { return win_row(n); }, lane); return; }
    id -= 16 * 48;
    if (id < 16 * 32) { wave_transpose(scr, p.w_out, D, (id / 32) * 64, (id % 32) * 32, (bf16_t*)(p.ws + OFF_WTOUT), D, [](int n) { return n; }, lane); return; }
    id -= 16 * 32;
    if (id < TR_N_GU) {
        const int e = id >> 8, q = id & 255, half = q >> 7, rr = q & 127;
        const float* src = half ? (e < NE ? p.w_up + (size_t)e * D * FF : p.ws_up) : (e < NE ? p.w_gate + (size_t)e * D * FF : p.ws_gate);
        wave_transpose(scr, src, FF, (rr / 8) * 64, (rr % 8) * 32, (bf16_t*)(p.ws + OFF_WGU) + (size_t)e * 512 * D, D, [half](int n) { return gu_row(n, half); }, lane);
        return;
    }
    id -= TR_N_GU;
    {
        const int e = id >> 7, rr = id & 127;
        const float* src = e < NE ? p.w_down + (size_t)e * FF * D : p.ws_down;
        wave_transpose(scr, src, D, (rr / 32) * 64, (rr % 32) * 32, (bf16_t*)(p.ws + OFF_WD) + (size_t)e * D * FF, FF, [](int n) { return n; }, lane);
    }
}

__device__ __forceinline__ void phase_prep(const Params& p, LAS unsigned char* lds) {
    const int tid = TIDX;
    int* gcnt = (int*)(p.ws + OFF_CNT);
    if (VBLK == 0 && tid < 128) gcnt[tid] = 0;
    float* mod = (float*)(p.ws + OFF_MOD);
    float* rope = (float*)(p.ws + OFF_ROPE);
    constexpr int N_MOD = 384, N_ROPE = 256, N_TR = 16;
    for (int it = VBLK; it < N_MOD + N_ROPE + N_TR; it += NVBLK) {
        if (it < N_MOD) {
            LAS float* sl = (LAS float*)lds;
            LAS float* red = (LAS float*)(lds + 10240);
            const int col = it * 16 + (tid & 15), kk = tid >> 4;
            float acc[17];
#pragma unroll
            for (int r = 0; r < 17; ++r) acc[r] = 0.f;
            for (int kc = 0; kc < 8; ++kc) {
                float wv[8];
#pragma unroll
                for (int i = 0; i < 8; ++i) wv[i] = p.w_mod[(size_t)(kc * 128 + kk + 16 * i) * MODW + col];
                __syncthreads();
                for (int o = tid; o < 17 * 128; o += 256) {
                    const int r = o >> 7, kl = o & 127;
                    const float cv = (r < 16) ? p.c[r * D + kc * 128 + kl] : p.c_ctx[kc * 128 + kl];
                    sl[kl * 20 + r] = cv / (1.f + expf(-cv));
                }
                __syncthreads();
#pragma unroll
                for (int i = 0; i < 8; ++i) {
                    const int kl = kk + 16 * i;
                    const f32x4 s0 = *(const LAS f32x4*)(sl + kl * 20), s1 = *(const LAS f32x4*)(sl + kl * 20 + 4), s2 = *(const LAS f32x4*)(sl + kl * 20 + 8), s3 = *(const LAS f32x4*)(sl + kl * 20 + 12);
                    const float s4 = sl[kl * 20 + 16];
#pragma unroll
                    for (int q = 0; q < 4; ++q) { acc[q] += s0[q] * wv[i]; acc[4 + q] += s1[q] * wv[i]; acc[8 + q] += s2[q] * wv[i]; acc[12 + q] += s3[q] * wv[i]; }
                    acc[16] += s4 * wv[i];
                }
            }
#pragma unroll
            for (int r = 0; r < 17; ++r) red[(kk * 17 + r) * 16 + (tid & 15)] = acc[r];
            __syncthreads();
            for (int o = tid; o < 17 * 16; o += 256) {
                const int r = o >> 4, j = o & 15;
                float sm = p.b_mod[it * 16 + j];
#pragma unroll
                for (int g = 0; g < 16; ++g) sm += red[(g * 17 + r) * 16 + j];
                mod[r * MODW + it * 16 + j] = sm;
            }
            __syncthreads();
        } else if (it < N_MOD + N_ROPE) {
            const int idx = (it - N_MOD) * 256 + tid, t = idx >> 5, i = idx & 31;
            const int pos = (i < 16) ? (t >> 6) : (t & 63);
            const float invf = (float)exp(-(double)(i & 15) / 16.0 * 9.210340371976184);
            const double ang = (double)((float)pos * invf);
            rope[idx * 2 + 0] = (float)cos(ang);
            rope[idx * 2 + 1] = (float)sin(ang);
        } else {
            LAS float* tile = (LAS float*)lds;
            const int idx = it - N_MOD - N_ROPE;
            {

                const int k0 = idx * 64;
#pragma unroll
                for (int pss = 0; pss < 4; ++pss) {
                    const int k = pss * 16 + (tid >> 4), n4 = (tid & 15) * 4;
                    const f32x4 v = *(const f32x4*)(p.w_router + (size_t)(k0 + k) * NE + n4);
                    tile[k * 65 + n4 + 0] = v[0]; tile[k * 65 + n4 + 1] = v[1]; tile[k * 65 + n4 + 2] = v[2]; tile[k * 65 + n4 + 3] = v[3];
                }
                __syncthreads();
                {
                    const int n = tid >> 2, kc = (tid & 3) * 16;
                    unsigned wh[8], wl[8];
#pragma unroll
                    for (int i = 0; i < 8; ++i) {
                        const float a = tile[(kc + 2 * i) * 65 + n], b = tile[(kc + 2 * i + 1) * 65 + n];
                        const unsigned ha = f2bf(a), hb = f2bf(b);
                        wh[i] = ha | (hb << 16);
                        wl[i] = pk2(a - bf2f(ha), b - bf2f(hb));
                    }
                    bf16_t* dh = (bf16_t*)(p.ws + OFF_WRH) + (size_t)n * D + k0 + kc;
                    bf16_t* dl = (bf16_t*)(p.ws + OFF_WRL) + (size_t)n * D + k0 + kc;
                    *(u32x4*)dh = (u32x4){wh[0], wh[1], wh[2], wh[3]}; *(u32x4*)(dh + 8) = (u32x4){wh[4], wh[5], wh[6], wh[7]};
                    *(u32x4*)dl = (u32x4){wl[0], wl[1], wl[2], wl[3]}; *(u32x4*)(dl + 8) = (u32x4){wl[4], wl[5], wl[6], wl[7]};
                }
                __syncthreads();
            }
        }
    }
    __syncthreads();
    {
        const int lane = hw_tid() & 63, wv = hw_tid() >> 6;
        LAS float* scr = (LAS float*)(lds - (hw_tid() >> 8) * 32768) + wv * (64 * 33);
        constexpr int NHERE = TR_N_A + (TR_N_GU - TR_GU_LATE);
        for (int it = blockIdx.x * 8 + wv; it < NHERE; it += gridDim.x * 8) transpose_item(p, scr, it < TR_N_A ? it : it + TR_GU_LATE, lane);
    }
}

__device__ __forceinline__ void phase_xn(const Params& p) {
    const int lane = TIDX & 63, gw = VBLK * 4 + (TIDX >> 6), ngw = NVBLK * 4;
    const float* mod = (const float*)(p.ws + OFF_MOD);
    bf16_t* XN = (bf16_t*)(p.ws + OFF_XN);
    for (int row = gw; row < T + TC; row += ngw) {
        const float* src = row < T ? p.x + (size_t)row * D : p.ctx + (size_t)(row - T) * D;
        const float* mr = mod + (size_t)(row < T ? row / SEQ : 16) * MODW;
#pragma unroll
        for (int j = 0; j < 4; ++j) {
            const int c = 4 * lane + 256 * j;
            const f32x4 v = *(const f32x4*)(src + c), sh = *(const f32x4*)(mr + c), sc = *(const f32x4*)(mr + D + c);
            u32x2 o; o.x = pk2(v[0] * (1.f + sc[0]) + sh[0], v[1] * (1.f + sc[1]) + sh[1]); o.y = pk2(v[2] * (1.f + sc[2]) + sh[2], v[3] * (1.f + sc[3]) + sh[3]);
            *(u32x2*)(XN + (size_t)row * D + c) = o;
        }
    }
}

struct EpiIn {
    static constexpr bool PERM = true;
    const float *q_norm, *k_norm, *rope; bf16_t *Qb, *Kb, *Vb, *Ub;
    __device__ __forceinline__ void operator()(const f32x4 (&acc)[2][2][4][2], const pg8::Unit& u, int wr, int wc, int fr, int fq) const {
        const int grp = u.pn * 4 + wc;
        const bool is_ctx = u.pm >= T / 256;
        f32x4 gn[2][2];
        if (grp >= 4 && grp < 20) {
            const float* g = grp < 16 ? q_norm : k_norm;
#pragma unroll
            for (int bj = 0; bj < 2; ++bj)
#pragma unroll
                for (int n = 0; n < 2; ++n) gn[bj][n] = *(const f32x4*)(g + 32 * bj + 8 * fq + 4 * n);
        }
#pragma unroll
        for (int ai = 0; ai < 2; ++ai)
#pragma unroll
            for (int m = 0; m < 4; ++m) {
                const int row = u.pm * 256 + ai * 128 + wr * 64 + m * 16 + fr;
                f32x4 v[2][2];
#pragma unroll
                for (int bj = 0; bj < 2; ++bj)
#pragma unroll
                    for (int n = 0; n < 2; ++n) v[bj][n] = acc[ai][bj][m][n];
                bf16_t* dst;
                if (grp < 4) dst = Ub + (size_t)row * 256 + grp * 64;
                else if (grp < 16) dst = Qb + (size_t)row * 768 + (grp - 4) * 64;
                else {
                    const size_t krow = is_ctx ? (size_t)((row - T) >> 8) * KVL + ((row - T) & 255) : (size_t)(row >> 11) * KVL + CTXL + (row & (SEQ - 1));
                    dst = (grp < 20 ? Kb + (grp - 16) * 64 : Vb + (grp - 20) * 64) + krow * 256;
                }
                if (grp >= 4 && grp < 20) {
                    float ss = 0.f;
#pragma unroll
                    for (int bj = 0; bj < 2; ++bj)
#pragma unroll
                        for (int n = 0; n < 2; ++n) ss += (v[bj][n][0] * v[bj][n][0] + v[bj][n][1] * v[bj][n][1]) + (v[bj][n][2] * v[bj][n][2] + v[bj][n][3] * v[bj][n][3]);
                    ss += __shfl_xor(ss, 16); ss += __shfl_xor(ss, 32);
                    const float rs = 1.0f / sqrtf(ss * (1.f / 64.f) + 1e-6f);
#pragma unroll
                    for (int bj = 0; bj < 2; ++bj)
#pragma unroll
                        for (int n = 0; n < 2; ++n) v[bj][n] = v[bj][n] * rs * gn[bj][n];
                    if (!is_ctx) {
                        const int tpos = row & (SEQ - 1);
#pragma unroll
                        for (int bj = 0; bj < 2; ++bj)
#pragma unroll
                            for (int n = 0; n < 2; ++n) {
                                const f32x4 cs = *(const f32x4*)(rope + (size_t)(tpos * 32 + 16 * bj + 4 * fq + 2 * n) * 2);
                                const f32x4 x = v[bj][n];
                                v[bj][n] = (f32x4){x[0] * cs[0] - x[1] * cs[1], x[0] * cs[1] + x[1] * cs[0], x[2] * cs[2] - x[3] * cs[3], x[2] * cs[3] + x[3] * cs[2]};
                            }
                    }
                    if (grp < 16) {
#pragma unroll
                        for (int bj = 0; bj < 2; ++bj)
#pragma unroll
                            for (int n = 0; n < 2; ++n) v[bj][n] = v[bj][n] * C2;
                    }
                }
#pragma unroll
                for (int bj = 0; bj < 2; ++bj) {
                    u32x4 w; w.x = pk2(v[bj][0][0], v[bj][0][1]); w.y = pk2(v[bj][0][2], v[bj][0][3]); w.z = pk2(v[bj][1][0], v[bj][1][1]); w.w = pk2(v[bj][1][2], v[bj][1][3]);
                    *(u32x4*)(dst + 32 * bj + 8 * fq) = w;
                }
            }
    }
};
__device__ __forceinline__ int vcu_of_block() { const int G = gridDim.x, bx = blockIdx.x; return (G % 8 == 0) ? (bx % 8) * (G / 8) + bx / 8 : bx; }
__device__ __forceinline__ void phase_inproj(const Params& p, LAS unsigned char* lds) {
    pg8::Gemm g{(const bf16_t*)(p.ws + OFF_XN), (const bf16_t*)(p.ws + OFF_WTIN), p.ws, 0};
    pg8::DenseSched S{6, 768, 800, 4, 2, (int)gridDim.x, vcu_of_block()};
    EpiIn E{p.q_norm, p.k_norm, (const float*)(p.ws + OFF_ROPE), (bf16_t*)(p.ws + OFF_Q), (bf16_t*)(p.ws + OFF_K), (bf16_t*)(p.ws + OFF_V), (bf16_t*)(p.ws + OFF_U)};
    pg8::gemm_phase<D, EpiIn, pg8::DenseSched, false>(lds, g, S, E);
    {
        const int v = vcu_of_block(), G = gridDim.x, nbusy = 800 - 3 * G;
        if (G == 256 ? v >= nbusy : true) {
            const int lane = hw_tid() & 63, wv = hw_tid() >> 6, nw = (G == 256 ? G - nbusy : G) * 8, w = (G == 256 ? v - nbusy : v) * 8 + wv;
            LAS float* scr = (LAS float*)lds + wv * (64 * 33);
            for (int it = w; it < TR_GU_LATE; it += nw) transpose_item(p, scr, TR_N_A + it, lane);
        }
    }
}

namespace attn_body {
using bf16=unsigned short;
using bf16x8=__attribute__((ext_vector_type(8)))short;
using s16x4=__attribute__((ext_vector_type(4)))short;
using f32x16=__attribute__((ext_vector_type(16)))float;
using u32x4=__attribute__((ext_vector_type(4)))unsigned;
constexpr int D=64,QP=768,KP=256,OP=1024,SEQ=2048,KVLEN=2304;
constexpr int NW=8,QBLK=32,QB=QBLK*NW,KVBLK=64,NT=KVLEN/KVBLK;
__device__ __forceinline__ int crow(int r,int hi){return (r&3)+8*(r>>2)+4*hi;}
#define SBAR() __builtin_amdgcn_sched_barrier(0)
constexpr int NSLOT=3, SLOTB=8192;
constexpr int LDS_K=0, LDS_V=NSLOT*SLOTB, LDS_WS=2*NSLOT*SLOTB, LDS_OST=LDS_WS+NW*64*4, LDS_BYTES=LDS_OST+NW*4096;
constexpr float C2=0.125f*1.4426950408889634f;
__device__ __forceinline__ void glds16(const void*gsrc,unsigned lds_dst){unsigned keep;
  asm volatile("s_mov_b32 %0, m0\n\ts_mov_b32 m0, %2\n\ts_nop 0\n\tglobal_load_lds_dwordx4 %1, off\n\ts_mov_b32 m0, %0":"=&s"(keep):"v"(gsrc),"s"(lds_dst):"memory");}
__device__ __forceinline__ float max3f(float a,float b,float c){float r;asm("v_max3_f32 %0, %1, %2, %3":"=v"(r):"v"(a),"v"(b),"v"(c));return r;}
__device__ __forceinline__ float max2f(float a,float b){float r;asm("v_max_f32_e32 %0, %1, %2":"=v"(r):"v"(a),"v"(b));return r;}
__device__ __forceinline__ float fadd_s(float a,float b){float r;asm("v_add_f32_e32 %0, %1, %2":"=v"(r):"v"(a),"v"(b));return r;}
__device__ __forceinline__ float fsub_s(float a,float b){float r;asm("v_sub_f32_e32 %0, %1, %2":"=v"(r):"v"(a),"v"(b));return r;}
typedef float f32x2_t __attribute__((ext_vector_type(2))); typedef __bf16 bf16x2_t __attribute__((ext_vector_type(2)));
__device__ __forceinline__ unsigned cvtpk_s(float lo,float hi){f32x2_t v={lo,hi};bf16x2_t b=__builtin_convertvector(v,bf16x2_t);return __builtin_bit_cast(unsigned,b);}
#define WAIT_BAR(N) asm volatile("s_waitcnt vmcnt(" #N ") lgkmcnt(0)\n\ts_barrier":::"memory")

__device__ __forceinline__ void qkt(f32x16&p0,f32x16&p1,const char*Kslot,const bf16x8*qr,const f32x16&negm,int r32,int hi){
  const char*kb=Kslot+hi*1024+r32*16;
  #pragma unroll
  for(int d0=0;d0<4;++d0){
    const bf16x8 b0=*reinterpret_cast<const bf16x8*>(kb+d0*2048);
    const bf16x8 b1=*reinterpret_cast<const bf16x8*>(kb+d0*2048+512);
    if(d0==0){p0=__builtin_amdgcn_mfma_f32_32x32x16_bf16(b0,qr[0],negm,0,0,0);p1=__builtin_amdgcn_mfma_f32_32x32x16_bf16(b1,qr[0],negm,0,0,0);}
    else{p0=__builtin_amdgcn_mfma_f32_32x32x16_bf16(b0,qr[d0],p0,0,0,0);p1=__builtin_amdgcn_mfma_f32_32x32x16_bf16(b1,qr[d0],p1,0,0,0);}}
}
typedef __attribute__((address_space(3))) const char* lds_cptr;
typedef short v4i16_t __attribute__((ext_vector_type(4)));
__device__ __forceinline__ void kload8(bf16x8*kf,lds_cptr kp){
  kf[0]=*(const __attribute__((address_space(3))) bf16x8*)(kp);      kf[1]=*(const __attribute__((address_space(3))) bf16x8*)(kp+512);
  kf[2]=*(const __attribute__((address_space(3))) bf16x8*)(kp+2048); kf[3]=*(const __attribute__((address_space(3))) bf16x8*)(kp+2560);
  kf[4]=*(const __attribute__((address_space(3))) bf16x8*)(kp+4096); kf[5]=*(const __attribute__((address_space(3))) bf16x8*)(kp+4608);
  kf[6]=*(const __attribute__((address_space(3))) bf16x8*)(kp+6144); kf[7]=*(const __attribute__((address_space(3))) bf16x8*)(kp+6656);
}
__device__ __forceinline__ void kload2(bf16x8*kf,lds_cptr kp,int j){ kf[2*j]=*(const __attribute__((address_space(3))) bf16x8*)(kp+j*2048); kf[2*j+1]=*(const __attribute__((address_space(3))) bf16x8*)(kp+j*2048+512); }
__device__ __forceinline__ s16x4 vtr(lds_cptr p){ return __builtin_bit_cast(s16x4,__builtin_amdgcn_ds_read_tr16_b64_v4i16((__attribute__((address_space(3))) v4i16_t*)p)); }
__device__ __forceinline__ float rowmax(const f32x16&p0,const f32x16&p1){
  float a=max3f(p0[0],p0[1],p1[0]),b=max3f(p0[2],p0[3],p1[1]);a=max3f(a,p1[2],p1[3]);
  #pragma unroll
  for(int r=4;r<16;r+=4){a=max3f(a,p0[r],p0[r+1]);b=max3f(b,p0[r+2],p0[r+3]);a=max3f(a,p1[r],p1[r+1]);b=max3f(b,p1[r+2],p1[r+3]);}
  const float m=max2f(a,b);
  auto rr=__builtin_amdgcn_permlane32_swap(__float_as_uint(m),__float_as_uint(m),false,false);
  return max2f(__uint_as_float(rr[0]),__uint_as_float(rr[1]));
}
__device__ __forceinline__ void pv(f32x16*o,int vb,bf16x8 pa0,bf16x8 pa1,bf16x8 pa2,bf16x8 pa3){
  #pragma unroll
  for(int d0=0;d0<2;++d0){s16x4 lo[4],hi[4];
    #pragma unroll
    for(int ks=0;ks<4;++ks){
      asm volatile("ds_read_b64_tr_b16 %0,%1 offset:%c2":"=&v"(lo[ks]):"v"(vb),"i"(d0*4096+ks*1024):"memory");
      asm volatile("ds_read_b64_tr_b16 %0,%1 offset:%c2":"=&v"(hi[ks]):"v"(vb),"i"(d0*4096+ks*1024+512):"memory");}
    asm volatile("s_waitcnt lgkmcnt(0)":::"memory");SBAR();
    #define PK(k) (bf16x8){lo[k][0],lo[k][1],lo[k][2],lo[k][3],hi[k][0],hi[k][1],hi[k][2],hi[k][3]}
    o[d0]=__builtin_amdgcn_mfma_f32_32x32x16_bf16(pa0,PK(0),o[d0],0,0,0);
    o[d0]=__builtin_amdgcn_mfma_f32_32x32x16_bf16(pa1,PK(1),o[d0],0,0,0);
    o[d0]=__builtin_amdgcn_mfma_f32_32x32x16_bf16(pa2,PK(2),o[d0],0,0,0);
    o[d0]=__builtin_amdgcn_mfma_f32_32x32x16_bf16(pa3,PK(3),o[d0],0,0,0);
    #undef PK
  }
}

#ifndef ATTN_STORE16
#define ATTN_STORE16(p,v) (*(u32x4*)(p)=(v))
#endif
template<int THRL> __device__ __forceinline__ void attn_unit(int b,int h,int qb,const bf16*Q,const bf16*__restrict__ K,const bf16*__restrict__ V,bf16*O,char*shm){
  const int tid=hw_tid(),lane=tid&63,r32=lane&31,hi=lane>>5; const int wid=__builtin_amdgcn_readfirstlane(tid>>6);
  const long rowbase=(long)b*SEQ, kvbase=(long)b*KVLEN; const int q0=qb*QB, kh=h/3;
  const bf16*Qw=Q+(rowbase+q0+wid*QBLK)*QP+h*D;
  const bf16*Kh=K+kvbase*KP+kh*D,*Vh=V+kvbase*KP+kh*D;
  const unsigned lds0=(unsigned)(uintptr_t)shm;
  float*wsf=(float*)(shm+LDS_WS)+wid*64;
  const bf16*ksrc=Kh+(long)lane*KP+wid*8;
  const bf16*vsrc=Vh+(long)(16*(wid&3)+(lane>>2))*KP+(wid>>2)*32+(lane&3)*8;
  const unsigned kdst=lds0+LDS_K+wid*1024, vdst=lds0+LDS_V+wid*1024;
  #define DMA_K(t,slot) glds16(ksrc+(long)(t)*KVBLK*KP,(unsigned)__builtin_amdgcn_readfirstlane(kdst+(slot)))
  #define DMA_V(t,slot) glds16(vsrc+(long)(t)*KVBLK*KP,(unsigned)__builtin_amdgcn_readfirstlane(vdst+(slot)))
  const int vb0=(int)(lds0+LDS_V)+((lane>>4)&1)*32+(lane&3)*8+(4*hi+((lane&15)>>2))*64;
  const char*Kbase=shm+LDS_K; bf16x8 kf[8];
  const lds_cptr shm3=(lds_cptr)shm; const lds_cptr kp0=shm3+LDS_K+hi*1024+r32*16; const lds_cptr vp0=shm3+LDS_V+((lane>>4)&1)*32+(lane&3)*8+(4*hi+((lane&15)>>2))*64;
  DMA_K(0,0);DMA_V(0,0);DMA_K(1,SLOTB);
  bf16x8 qr[4];
  #pragma unroll
  for(int d0=0;d0<4;++d0)qr[d0]=*reinterpret_cast<const bf16x8*>(&Qw[(long)r32*QP+d0*16+hi*8]);
  float mhat=0.f,l_reg=0.f;f32x16 o[2];o[0]=f32x16{};o[1]=f32x16{};f32x16 negm=f32x16{};asm volatile("":"+v"(negm));
  #define CMASK(P0,P1,t) do{}while(0)
  bool resc=false;
  #define START(P0,P1) do{ const float rm=rowmax(P0,P1); resc=false; \
    { const float dl=rm; mhat=fadd_s(mhat,dl); \
      _Pragma("unroll") for(int r=0;r<16;++r){P0[r]=fsub_s(P0[r],dl);P1[r]=fsub_s(P1[r],dl);} \
      _Pragma("unroll") for(int r=0;r<16;++r)negm[r]=-mhat; asm volatile("":"+v"(negm)); } \
    _Pragma("unroll") for(int r=0;r<16;++r)P0[r]=__builtin_amdgcn_exp2f(P0[r]); }while(0)
  #define RESC() do{ if(resc){ asm volatile("s_waitcnt lgkmcnt(0)":::"memory"); \
      _Pragma("unroll") for(int d_=0;d_<2;++d_) _Pragma("unroll") for(int r=0;r<16;++r)o[d_][r]*=wsf[crow(r,hi)]; } }while(0)
  f32x16 pA0,pA1,pB0,pB1;
  int sl_prev=0,sl_cur=0,sl_next=SLOTB;
  #define ROT() do{sl_prev=sl_cur;sl_cur=sl_next;sl_next=(sl_next==(NSLOT-1)*SLOTB)?0:sl_next+SLOTB;}while(0)
  DMA_K(2,2*SLOTB);
  WAIT_BAR(3);
  qkt(pA0,pA1,Kbase,qr,negm,r32,hi);asm volatile("s_nop 15\n\ts_nop 7":"+v"(pA0),"+v"(pA1));CMASK(pA0,pA1,0);
  START(pA0,pA1);
  _Pragma("unroll") for(int r=0;r<16;++r)pA1[r]=__builtin_amdgcn_exp2f(pA1[r]);
  WAIT_BAR(0);
  DMA_K(3,0);DMA_V(1,SLOTB);
  ROT();
  kload8(kf,kp0+sl_cur);
  WAIT_BAR(2);
  s16x4 vlo[8],vhi[8]; u32x4 pw0,pw1,pw2,pw3;
  #define PKW(P,B) cvtpk_s(P[B],P[B+1])
  #define PAF(k) __builtin_bit_cast(bf16x8,pw##k)
  #define VFR(i) (bf16x8){vlo[i][0],vlo[i][1],vlo[i][2],vlo[i][3],vhi[i][0],vhi[i][1],vhi[i][2],vhi[i][3]}
  #define PIN(x) asm volatile("":"+v"(x))
  #define MX3(a,b,c) __builtin_fmaxf(__builtin_fmaxf((a),(b)),(c))
  #define GAPA(MF,A0,A1,A2,A3,W0,W1,PW) do{ MF; sacc+=A0; sacc+=A1; sacc+=A2; sacc+=A3; PIN(sacc); W0; W1; PIN(PW); SBAR(); }while(0)
  #define EX(v) __builtin_amdgcn_exp2f(v)
  #define GAPB(MF,X,B) do{ MF; X[B]=EX(X[B]); X[B+1]=EX(X[B+1]); X[B+2]=EX(X[B+2]); X[B+3]=EX(X[B+3]); PIN(X); SBAR(); }while(0)
  #define VRD(i) do{ vlo[i]=vtr(vp_+(((i)>>2)*4096+((i)&3)*1024)); vhi[i]=vtr(vp_+(((i)>>2)*4096+((i)&3)*1024+512)); }while(0)
  #define KRD(G,j) do{ if(G){ kload2(kf,kp0+sl_next,j); SBAR(); } }while(0)
  #define STEP(C0,C1,P0,P1,t,GK,GV,GL) do{ SBAR(); \
    const lds_cptr vp_=vp0+sl_prev; \
    VRD(0); SBAR(); float sacc=(P0[0]+P0[1]); \
    GAPA(C0=__builtin_amdgcn_mfma_f32_32x32x16_bf16(kf[0],qr[0],negm,0,0,0), P0[2],P0[3],P0[4],P0[5],     pw0[0]=PKW(P0,0), pw0[1]=PKW(P0,2), pw0); \
    VRD(4); SBAR(); GAPA(C1=__builtin_amdgcn_mfma_f32_32x32x16_bf16(kf[1],qr[0],negm,0,0,0), P0[6],P0[7],P0[8],P0[9],     pw0[2]=PKW(P0,4), pw0[3]=PKW(P0,6), pw0); \
    VRD(1); SBAR(); GAPA(C0=__builtin_amdgcn_mfma_f32_32x32x16_bf16(kf[2],qr[1],C0,0,0,0),   P0[10],P0[11],P0[12],P0[13], pw1[0]=PKW(P0,8), pw1[1]=PKW(P0,10), pw1); \
    VRD(5); SBAR(); GAPA(C1=__builtin_amdgcn_mfma_f32_32x32x16_bf16(kf[3],qr[1],C1,0,0,0),   P0[14],P0[15],P1[0],P1[1],   pw1[2]=PKW(P0,12),pw1[3]=PKW(P0,14), pw1); \
    VRD(2); SBAR(); GAPA(C0=__builtin_amdgcn_mfma_f32_32x32x16_bf16(kf[4],qr[2],C0,0,0,0),   P1[2],P1[3],P1[4],P1[5],     pw2[0]=PKW(P1,0), pw2[1]=PKW(P1,2), pw2); \
    VRD(6); SBAR(); GAPA(C1=__builtin_amdgcn_mfma_f32_32x32x16_bf16(kf[5],qr[2],C1,0,0,0),   P1[6],P1[7],P1[8],P1[9],     pw2[2]=PKW(P1,4), pw2[3]=PKW(P1,6), pw2); \
    VRD(3); SBAR(); GAPA(C0=__builtin_amdgcn_mfma_f32_32x32x16_bf16(kf[6],qr[3],C0,0,0,0),   P1[10],P1[11],P1[12],P1[13], pw3[0]=PKW(P1,8), pw3[1]=PKW(P1,10), pw3); \
    VRD(7); SBAR(); GAPA(C1=__builtin_amdgcn_mfma_f32_32x32x16_bf16(kf[7],qr[3],C1,0,0,0),   P1[14],P1[15],0.f,0.f,       pw3[2]=PKW(P1,12),pw3[3]=PKW(P1,14), pw3); \
    l_reg+=sacc; \
    if(GK){DMA_K((t)+3,sl_cur);} if(GV){DMA_V((t)+1,sl_next);} \
    CMASK(C0,C1,t); \
    { float a=MX3(C0[0],C0[1],C1[0]),b=MX3(C0[2],C0[3],C1[1]); a=MX3(a,C1[2],C1[3]); \
      _Pragma("unroll") for(int r=4;r<16;r+=4){a=MX3(a,C0[r],C0[r+1]);b=MX3(b,C0[r+2],C0[r+3]);a=MX3(a,C1[r],C1[r+1]);b=MX3(b,C1[r+2],C1[r+3]);} \
      float rm=__builtin_fmaxf(a,b); { auto rr=__builtin_amdgcn_permlane32_swap(__float_as_uint(rm),__float_as_uint(rm),false,false); rm=__builtin_fmaxf(__uint_as_float(rr[0]),__uint_as_float(rr[1])); } \
      resc=false; \
      if(__builtin_expect(__any(rm>(float)THRL),0)){ const float dl=__builtin_fmaxf(rm,0.f); mhat+=dl; \
        _Pragma("unroll") for(int r=0;r<16;++r){C0[r]-=dl;C1[r]-=dl;} \
        _Pragma("unroll") for(int r=0;r<16;++r)negm[r]=-mhat; asm volatile("":"+v"(negm)); \
        const float f=__builtin_amdgcn_exp2f(-dl); l_reg*=f; if(hi==0)wsf[r32]=f; resc=true; } } \
    SBAR(); \
    GAPB(o[0]=__builtin_amdgcn_mfma_f32_32x32x16_bf16(PAF(0),VFR(0),o[0],0,0,0), C0,0); \
    GAPB(o[1]=__builtin_amdgcn_mfma_f32_32x32x16_bf16(PAF(0),VFR(4),o[1],0,0,0), C0,4); \
    KRD(GL,0); GAPB(o[0]=__builtin_amdgcn_mfma_f32_32x32x16_bf16(PAF(1),VFR(1),o[0],0,0,0), C0,8); \
    KRD(GL,1); GAPB(o[1]=__builtin_amdgcn_mfma_f32_32x32x16_bf16(PAF(1),VFR(5),o[1],0,0,0), C0,12); \
    KRD(GL,2); GAPB(o[0]=__builtin_amdgcn_mfma_f32_32x32x16_bf16(PAF(2),VFR(2),o[0],0,0,0), C1,0); \
    KRD(GL,3); GAPB(o[1]=__builtin_amdgcn_mfma_f32_32x32x16_bf16(PAF(2),VFR(6),o[1],0,0,0), C1,4); \
    GAPB(o[0]=__builtin_amdgcn_mfma_f32_32x32x16_bf16(PAF(3),VFR(3),o[0],0,0,0), C1,8); \
    GAPB(o[1]=__builtin_amdgcn_mfma_f32_32x32x16_bf16(PAF(3),VFR(7),o[1],0,0,0), C1,12); \
    }while(0)
  int t=1;
  for(;t+5<NT;t+=2){
    STEP(pB0,pB1,pA0,pA1,t,true,true,true);     WAIT_BAR(2); RESC(); ROT();
    STEP(pA0,pA1,pB0,pB1,t+1,true,true,true);   WAIT_BAR(2); RESC(); ROT();
  }
  #define ENDW(tt) do{ if((tt)+3<NT){WAIT_BAR(2);} else if((tt)+2<NT){WAIT_BAR(1);} else {WAIT_BAR(0);} }while(0)
  for(;t+1<NT;t+=2){
    STEP(pB0,pB1,pA0,pA1,t,(t+3<NT),(t+1<NT),(t+1<NT));       ENDW(t);   RESC(); ROT();
    STEP(pA0,pA1,pB0,pB1,t+1,(t+4<NT),(t+2<NT),(t+2<NT));     ENDW(t+1); RESC(); ROT();
  }
  STEP(pB0,pB1,pA0,pA1,NT-1,false,false,false); RESC();
  { float sacc=pB0[0]+pB0[1]; _Pragma("unroll") for(int r=2;r<16;++r)sacc+=pB0[r]; _Pragma("unroll") for(int r=0;r<16;++r)sacc+=pB1[r]; l_reg+=sacc;
    pw0=(u32x4){PKW(pB0,0),PKW(pB0,2),PKW(pB0,4),PKW(pB0,6)};pw1=(u32x4){PKW(pB0,8),PKW(pB0,10),PKW(pB0,12),PKW(pB0,14)};pw2=(u32x4){PKW(pB1,0),PKW(pB1,2),PKW(pB1,4),PKW(pB1,6)};pw3=(u32x4){PKW(pB1,8),PKW(pB1,10),PKW(pB1,12),PKW(pB1,14)};
    SBAR(); pv(o,vb0+sl_cur,PAF(0),PAF(1),PAF(2),PAF(3)); }
  #undef PKW
  #undef PAF
  #undef VFR
  #undef PIN
  #undef MX3
  #undef GAPA
  #undef GAPB
  #undef EX
  #undef VRD
  #undef KRD
  #undef STEP
  #undef ENDW
  {auto rr=__builtin_amdgcn_permlane32_swap(__float_as_uint(l_reg),__float_as_uint(l_reg),false,false);l_reg=__uint_as_float(rr[0])+__uint_as_float(rr[1]);}
  if(hi==0)wsf[32+r32]=l_reg;asm volatile("s_waitcnt lgkmcnt(0)":::"memory");
  float rli[16];
  #pragma unroll
  for(int r=0;r<16;++r)rli[r]=__builtin_amdgcn_rcpf(wsf[32+crow(r,hi)]);
  bf16*Ow=O+(rowbase+q0+wid*QBLK)*OP+h*D;
  { bf16*stg=(bf16*)(shm+LDS_OST)+wid*2048;
    #pragma unroll
    for(int r=0;r<16;++r){const int orow=crow(r,hi);
      #pragma unroll
      for(int d0=0;d0<2;++d0)stg[orow*64+d0*32+r32]=(bf16)f2bf(o[d0][r]*rli[r]);}
    asm volatile("s_waitcnt lgkmcnt(0)":::"memory");
    #pragma unroll
    for(int i=0;i<4;++i){const int row=i*8+(lane>>3),ch=lane&7; const u32x4 v=*(const u32x4*)(stg+row*64+ch*8); ATTN_STORE16(Ow+(long)row*OP+ch*8,v);} }
  asm volatile("s_waitcnt lgkmcnt(0)\n\ts_barrier":::"memory");
  #undef DMA_K
  #undef DMA_V
  #undef CMASK
  #undef START
  #undef RESC
  #undef ROT
}
constexpr int ATTN_LDS_BYTES=LDS_BYTES;
struct AttnTensors { const bf16* Q; const bf16* K; const bf16* V; bf16* O; };
template<int THRL=8> __device__ __forceinline__ void attn_phase(char*lds,const AttnTensors&T){
  const int G=gridDim.x, bx=blockIdx.x, v=(G%8==0)?(bx%8)*(G/8)+bx/8:bx;
  for(int u=v;u<16*12*8;u+=G){
    const int pair=(u%256)/4, j=((u%256)%4)*6+u/256;
    const int b=pair>>2, kh=pair&3, g=j>>3, qb=j&7;
    attn_unit<THRL>(b,kh*3+g,qb,T.Q,T.K,T.V,T.O,lds);
  }
}
#undef SBAR
#undef WAIT_BAR
}

__device__ __forceinline__ void pool_item(const Params& p, LAS unsigned char* lds, int item, bool stage_w) {
    const int tid = TIDX, lane = tid & 63, wid = tid >> 6, r16 = lane & 15, q = lane >> 4;
    const int gi = item & 3, tile = item >> 2, t0 = tile * 64, b = t0 / SEQ, tl0 = t0 % SEQ, half = 1 << gi;
    const bf16_t* Ub = (const bf16_t*)(p.ws + OFF_U);
    bf16_t* AO = (bf16_t*)(p.ws + OFF_AO);
    LAS bf16_t* us = (LAS bf16_t*)lds;
    LAS bf16_t* dl = (LAS bf16_t*)(lds + 11520);
    LAS bf16_t* wt = (LAS bf16_t*)(lds + 11520 + 9216);
    __syncthreads();
    for (int i = tid; i < 80 * 8; i += 256) {
        const int r = i >> 3, ch = i & 7, tl = tl0 - 8 + r;
        u32x4 v = {0u, 0u, 0u, 0u};
        if (tl >= 0 && tl < SEQ) v = *(const u32x4*)(Ub + (size_t)(b * SEQ + tl) * 256 + gi * 64 + ch * 8);
        *(LAS u32x4*)(us + r * 72 + ch * 8) = v;
    }
    if (stage_w) {
#pragma unroll 4
        for (int k = 0; k < 16; ++k) {
            const int i = tid + 256 * k, c = i >> 6, dd = i & 63;
            wt[dd * 72 + c] = (bf16_t)f2bf(p.pool_w[gi * 4096 + i] * p.pool_scale[gi * 64 + dd]);
        }
    }
    __syncthreads();
    {
        const int c = tid & 63, seg = tid >> 6;
        int tl = tl0 + seg * 16;
        float sm = 0.f;
        for (int r = max(tl - half, 0); r < min(tl + half, SEQ); ++r) sm += bf2f(us[(r - tl0 + 8) * 72 + c]);
#pragma unroll
        for (int k = 0; k < 16; ++k, ++tl) {
            if (k > 0) {
                if (tl + half <= SEQ) sm += bf2f(us[(tl + half - 1 - tl0 + 8) * 72 + c]);
                if (tl - half > 0) sm -= bf2f(us[(tl - half - 1 - tl0 + 8) * 72 + c]);
            }
            const int cntw = min(tl + half, SEQ) - max(tl - half, 0);
            dl[(seg * 16 + k) * 72 + c] = (bf16_t)f2bf(sm / (float)cntw - bf2f(us[(tl - tl0 + 8) * 72 + c]));
        }
    }
    __syncthreads();
    {
        f32x4 acc[4];
#pragma unroll
        for (int nb = 0; nb < 4; ++nb) acc[nb] = (f32x4){0.f, 0.f, 0.f, 0.f};
#pragma unroll
        for (int ks = 0; ks < 2; ++ks) {
            const bf16x8 db = *(const LAS bf16x8*)(dl + (wid * 16 + r16) * 72 + ks * 32 + q * 8);
#pragma unroll
            for (int nb = 0; nb < 4; ++nb) {
                const bf16x8 wa = *(const LAS bf16x8*)(wt + (nb * 16 + r16) * 72 + ks * 32 + q * 8);
                acc[nb] = __builtin_amdgcn_mfma_f32_16x16x32_bf16(wa, db, acc[nb], 0, 0, 0);
            }
        }
        bf16_t* orow = AO + (size_t)(t0 + wid * 16 + r16) * D + gi * 64 + 4 * q;
#pragma unroll
        for (int nb = 0; nb < 4; ++nb) { u32x2 w; w.x = pk2(acc[nb][0], acc[nb][1]); w.y = pk2(acc[nb][2], acc[nb][3]); *(u32x2*)(orow + nb * 16) = w; }
    }
}

__device__ __forceinline__ void phase_attn_pool(const Params& p, LAS unsigned char* lds, char* smem) {
    const attn_body::AttnTensors AT{(const bf16_t*)(p.ws + OFF_Q), (const bf16_t*)(p.ws + OFF_K), (const bf16_t*)(p.ws + OFF_V), (bf16_t*)(p.ws + OFF_AO) + 256};
    attn_body::attn_phase<8>(smem, AT);
    __syncthreads();
    constexpr int N_POOL = (T / 64) * 4;
    { bool first = true; for (int it = VBLK; it < N_POOL; it += NVBLK) { pool_item(p, lds, it, first); first = false; } }
}

struct EpiOut {
    static constexpr bool PERM = false;
    const float* x; float* y; const float* mod; float* stats;
    __device__ __forceinline__ void operator()(const f32x4 (&acc)[2][2][4][2], const pg8::Unit& u, int wr, int wc, int fr, int fq) const {
        const float* g1 = mod + (size_t)(u.pm >> 3) * MODW + 2 * D;
        const int col0 = u.pn * 256 + wc * 32 + fq * 4;
        f32x4 gv[2][2];
#pragma unroll
        for (int bj = 0; bj < 2; ++bj)
#pragma unroll
            for (int n = 0; n < 2; ++n) gv[bj][n] = *(const f32x4*)(g1 + col0 + bj * 128 + n * 16);
        f32x4 xv[2][2][2];
        const size_t rstride = (size_t)16 * D;
        const float* xb = x + (size_t)(u.pm * 256 + wr * 64 + fr) * D + col0;
        float* yb = y + (size_t)(u.pm * 256 + wr * 64 + fr) * D + col0;
#pragma unroll
        for (int bj = 0; bj < 2; ++bj)
#pragma unroll
            for (int n = 0; n < 2; ++n) xv[0][bj][n] = *(const f32x4*)(xb + bj * 128 + n * 16);
#pragma unroll
        for (int k = 0; k < 8; ++k) {
            const int ai = k >> 2, m = k & 3;
            const size_t roff = (size_t)ai * 128 * D + (size_t)m * rstride;
            if (k < 7) {
                const size_t noff = (size_t)((k + 1) >> 2) * 128 * D + (size_t)((k + 1) & 3) * rstride;
#pragma unroll
                for (int bj = 0; bj < 2; ++bj)
#pragma unroll
                    for (int n = 0; n < 2; ++n) xv[(k + 1) & 1][bj][n] = *(const f32x4*)(xb + noff + bj * 128 + n * 16);
            }
            const int row = u.pm * 256 + ai * 128 + wr * 64 + m * 16 + fr;
            float s1 = 0.f, s2 = 0.f;
#pragma unroll
            for (int bj = 0; bj < 2; ++bj)
#pragma unroll
                for (int n = 0; n < 2; ++n) {
                    const f32x4 yv = xv[k & 1][bj][n] * ALPHA + gv[bj][n] * acc[ai][bj][m][n];
                    *(f32x4*)(yb + roff + bj * 128 + n * 16) = yv;
                    s1 += (yv[0] + yv[1]) + (yv[2] + yv[3]);
                    s2 += (yv[0] * yv[0] + yv[1] * yv[1]) + (yv[2] * yv[2] + yv[3] * yv[3]);
                }
            s1 += __shfl_xor(s1, 16); s1 += __shfl_xor(s1, 32);
            s2 += __shfl_xor(s2, 16); s2 += __shfl_xor(s2, 32);
            if (fq == 0) { float* st = stats + ((size_t)row * 16 + u.pn * 4 + wc) * 2; st[0] = s1; st[1] = s2; }
        }
    }
};
__device__ __forceinline__ void phase_outproj(const Params& p, LAS unsigned char* lds) {
    pg8::Gemm g{(const bf16_t*)(p.ws + OFF_AO), (const bf16_t*)(p.ws + OFF_WTOUT), p.ws, 1};
    pg8::DenseSched S{4, 512, 512, 0, 1, (int)gridDim.x, vcu_of_block()};
    EpiOut E{p.x, p.out, (const float*)(p.ws + OFF_MOD), (float*)(p.ws + OFF_STATS)};
    pg8::gemm_phase<D, EpiOut, pg8::DenseSched, false>(lds, g, S, E);
}

__device__ __forceinline__ void phase_router(const Params& p, LAS unsigned char* lds0) {
    const int tid = hw_tid(), lane = tid & 63, wid = tid >> 6, r16 = lane & 15, q = lane >> 4;
    const float* mod = (const float*)(p.ws + OFF_MOD);
    const float* stats = (const float*)(p.ws + OFF_STATS);
    bf16_t* H = (bf16_t*)(p.ws + OFF_H);
    const bf16_t* WRH = (const bf16_t*)(p.ws + OFF_WRH); const bf16_t* WRL = (const bf16_t*)(p.ws + OFF_WRL);
    int* gcnt = (int*)(p.ws + OFF_CNT);
    int* LDST = (int*)(p.ws + OFF_LDST);
    float* LWt = (float*)(p.ws + OFF_LW);
    LAS float* vec = (LAS float*)lds0;
    LAS float* lg = (LAS float*)(lds0 + 16384) + wid * 16 * 64;
    LAS int* lcnt = (LAS int*)(lds0 + 49152);
    LAS int* lbase = (LAS int*)(lds0 + 49152 + 256);
    LAS int* sel_ep = (LAS int*)(lds0 + 49152 + 512);
    LAS float* sel_w = (LAS float*)(lds0 + 49152 + 512 + 4096);
    for (int item = blockIdx.x; item < T / 128; item += gridDim.x) {
        const int t0 = item * 128, b = t0 / SEQ, tw0 = t0 + wid * 16;
        __syncthreads();
        if (tid < 64) lcnt[tid] = 0;
        for (int i = tid; i < 1024; i += 512) {
            vec[i] = p.ln1_g[i]; vec[1024 + i] = p.ln1_b[i];
            vec[2048 + i] = 1.f + mod[(size_t)b * MODW + 4 * D + i]; vec[3072 + i] = mod[(size_t)b * MODW + 3 * D + i];
        }
        float meanv = 0.f, rstdv = 0.f;
        if (lane < 16) {
            float s1 = 0.f, s2 = 0.f;
            const float* st = stats + (size_t)(tw0 + lane) * 32;
#pragma unroll
            for (int i = 0; i < 16; ++i) { s1 += st[2 * i]; s2 += st[2 * i + 1]; }
            meanv = s1 * (1.f / D);
            const float var = fmaxf(s2 * (1.f / D) - meanv * meanv, 0.f);
            rstdv = 1.0f / sqrtf(var + 1e-5f);
        }
        const float mu = __shfl(meanv, r16), rs = __shfl(rstdv, r16);
        __syncthreads();
        f32x4 acc[4];
#pragma unroll
        for (int nb = 0; nb < 4; ++nb) acc[nb] = (f32x4){0.f, 0.f, 0.f, 0.f};
        float* yrow = p.out + (size_t)(tw0 + r16) * D + q * 8;
        bf16_t* hrow = H + (size_t)(tw0 + r16) * D + q * 8;
        LAS unsigned char* wb = lds0 + 57856;
        f32x4 vn[4][2];
#pragma unroll
        for (int u = 0; u < 4; ++u) { vn[u][0] = *(const f32x4*)(yrow + u * 32); vn[u][1] = *(const f32x4*)(yrow + u * 32 + 4); }
        for (int ch = 0; ch < 4; ++ch) {
            __syncthreads();
#pragma unroll
            for (int i = 0; i < 8; ++i) {
                const int idx = tid + i * 512, part = idx >> 11, row = (idx >> 5) & 63, c16 = idx & 31;
                const u32x4 w = *(const u32x4*)((part ? WRL : WRH) + (size_t)row * D + ch * 256 + c16 * 8);
                *(LAS u32x4*)(wb + part * 33792 + row * 528 + c16 * 16) = w;
            }
            __syncthreads();
#pragma unroll
            for (int s4 = ch * 8; s4 < ch * 8 + 8; s4 += 4) {
                f32x4 vv[4][2];
#pragma unroll
                for (int u = 0; u < 4; ++u) { vv[u][0] = vn[u][0]; vv[u][1] = vn[u][1]; }
                if (s4 + 4 < 32) {
#pragma unroll
                    for (int u = 0; u < 4; ++u) { vn[u][0] = *(const f32x4*)(yrow + (s4 + 4 + u) * 32); vn[u][1] = *(const f32x4*)(yrow + (s4 + 4 + u) * 32 + 4); }
                }
#pragma unroll
                for (int u = 0; u < 4; ++u) {
                    const int s = s4 + u, k0 = s * 32 + q * 8;
                    float hv[8];
#pragma unroll
                    for (int hh = 0; hh < 2; ++hh) {
                        const f32x4 g = *(const LAS f32x4*)(vec + k0 + 4 * hh), bb = *(const LAS f32x4*)(vec + 1024 + k0 + 4 * hh);
                        const f32x4 sc = *(const LAS f32x4*)(vec + 2048 + k0 + 4 * hh), sh = *(const LAS f32x4*)(vec + 3072 + k0 + 4 * hh);
                        const f32x4 xm = (vv[u][hh] - mu) * rs * g + bb;
                        *(f32x4*)(yrow + s * 32 + 4 * hh) = xm;
                        const f32x4 h4 = xm * sc + sh;
                        hv[4 * hh + 0] = h4[0]; hv[4 * hh + 1] = h4[1]; hv[4 * hh + 2] = h4[2]; hv[4 * hh + 3] = h4[3];
                    }
                    unsigned wh[4], wl[4];
#pragma unroll
                    for (int i = 0; i < 4; ++i) {
                        const unsigned ha = f2bf(hv[2 * i]), hb = f2bf(hv[2 * i + 1]);
                        wh[i] = ha | (hb << 16);
                        wl[i] = pk2(hv[2 * i] - bf2f(ha), hv[2 * i + 1] - bf2f(hb));
                    }
                    *(u32x4*)(hrow + s * 32) = (u32x4){wh[0], wh[1], wh[2], wh[3]};
                    const bf16x8 ah = __builtin_bit_cast(bf16x8, (u32x4){wh[0], wh[1], wh[2], wh[3]}), al = __builtin_bit_cast(bf16x8, (u32x4){wl[0], wl[1], wl[2], wl[3]});
                    const int kb = ((s & 7) * 32 + q * 8) * 2;
#pragma unroll
                    for (int nb = 0; nb < 4; ++nb) {
                        const bf16x8 bh = *(const LAS bf16x8*)(wb + (nb * 16 + r16) * 528 + kb), bl = *(const LAS bf16x8*)(wb + 33792 + (nb * 16 + r16) * 528 + kb);
                        acc[nb] = __builtin_amdgcn_mfma_f32_16x16x32_bf16(ah, bh, acc[nb], 0, 0, 0);
                        acc[nb] = __builtin_amdgcn_mfma_f32_16x16x32_bf16(al, bh, acc[nb], 0, 0, 0);
                        acc[nb] = __builtin_amdgcn_mfma_f32_16x16x32_bf16(ah, bl, acc[nb], 0, 0, 0);
                    }
                }
            }
        }
#pragma unroll
        for (int nb = 0; nb < 4; ++nb)
#pragma unroll
            for (int j = 0; j < 4; ++j) lg[(4 * q + j) * 64 + nb * 16 + r16] = acc[nb][j];
        __syncthreads();
        const float bias = p.router_bias[lane];
        const int g = lane >> 3;
        for (int r0 = 0; r0 < 16; r0 += 4) {
            float sg[4], sel[4], msel[4]; bool keep[4];
#pragma unroll
            for (int u = 0; u < 4; ++u) {
                const float lgv = lg[(r0 + u) * 64 + lane];
                sg[u] = 1.0f / (1.0f + expf(-lgv));
                sel[u] = sg[u] + bias;
            }
            float m1[4], m2[4]; int cand[4];
#pragma unroll
            for (int u = 0; u < 4; ++u) { m1[u] = fmaxf(sel[u], __shfl_xor(sel[u], 1)); }
#pragma unroll
            for (int u = 0; u < 4; ++u) { m1[u] = fmaxf(m1[u], __shfl_xor(m1[u], 2)); }
#pragma unroll
            for (int u = 0; u < 4; ++u) { m1[u] = fmaxf(m1[u], __shfl_xor(m1[u], 4)); cand[u] = (sel[u] == m1[u]) ? lane : 64; }
#pragma unroll
            for (int u = 0; u < 4; ++u) { cand[u] = min(cand[u], __shfl_xor(cand[u], 1)); }
#pragma unroll
            for (int u = 0; u < 4; ++u) { cand[u] = min(cand[u], __shfl_xor(cand[u], 2)); }
#pragma unroll
            for (int u = 0; u < 4; ++u) { cand[u] = min(cand[u], __shfl_xor(cand[u], 4)); m2[u] = (lane == cand[u]) ? -INFINITY : sel[u]; }
#pragma unroll
            for (int u = 0; u < 4; ++u) { m2[u] = fmaxf(m2[u], __shfl_xor(m2[u], 1)); }
#pragma unroll
            for (int u = 0; u < 4; ++u) { m2[u] = fmaxf(m2[u], __shfl_xor(m2[u], 2)); }
#pragma unroll
            for (int u = 0; u < 4; ++u) { m2[u] = fmaxf(m2[u], __shfl_xor(m2[u], 4)); }
#pragma unroll
            for (int u = 0; u < 4; ++u) {
                const float gs = m1[u] + m2[u];
                int cntg = 0;
#pragma unroll
                for (int gg = 0; gg < 8; ++gg) { const float v = __shfl(gs, gg * 8); cntg += (v > gs || (v == gs && gg < g)) ? 1 : 0; }
                keep[u] = cntg < 4;
                msel[u] = keep[u] ? sel[u] : -INFINITY;
                lg[(r0 + u) * 64 + lane] = msel[u];
            }
            int cnt[4] = {0, 0, 0, 0};
#pragma unroll 4
            for (int q4 = 0; q4 < 16; ++q4) {
#pragma unroll
                for (int u = 0; u < 4; ++u) {
                    const f32x4 v = *(const LAS f32x4*)(lg + (r0 + u) * 64 + q4 * 4);
#pragma unroll
                    for (int i = 0; i < 4; ++i) cnt[u] += (v[i] > msel[u]) ? 1 : 0;
                }
            }
#pragma unroll
            for (int u = 0; u < 4; ++u) {
                bool ok = true;
#pragma unroll
                for (int k = 0; k < 8; ++k) ok = ok && (__ballot(keep[u] && cnt[u] == k) != 0ull);
                if (!ok) {
                    int c2 = 0;
                    for (int e2 = 0; e2 < 64; ++e2) { const float v = lg[(r0 + u) * 64 + e2]; c2 += (v > msel[u] || (v == msel[u] && e2 < lane)) ? 1 : 0; }
                    cnt[u] = c2;
                }
            }
            float wsum[4]; bool chosen[4];
#pragma unroll
            for (int u = 0; u < 4; ++u) { chosen[u] = keep[u] && cnt[u] < 8; wsum[u] = chosen[u] ? sg[u] : 0.f; }
#pragma unroll
            for (int o = 1; o < 64; o <<= 1) {
#pragma unroll
                for (int u = 0; u < 4; ++u) wsum[u] += __shfl_xor(wsum[u], o);
            }
#pragma unroll
            for (int u = 0; u < 4; ++u) {
                if (chosen[u]) {
                    const int pos = atomicAdd((int*)&lcnt[lane], 1);
                    sel_ep[(wid * 16 + r0 + u) * 8 + cnt[u]] = lane | (pos << 8);
                    sel_w[(wid * 16 + r0 + u) * 8 + cnt[u]] = sg[u] / wsum[u] * 2.5f;
                }
            }
        }
        __syncthreads();
        if (tid < 64) { int tt = tid; asm volatile("" : "+v"(tt)); lbase[tt] = atomicAdd(&gcnt[tt], lcnt[tt]); }
        __syncthreads();
        for (int idx = tid; idx < 1024; idx += 512) {
            const int ep = sel_ep[idx], e = ep & 0xff, pos = ep >> 8, gi = lbase[e] + pos;
            LDST[(size_t)e * T + gi] = (t0 + (idx >> 3)) * NSLOT + (idx & 7);
            LWt[(size_t)e * T + gi] = sel_w[idx];
        }
    }
}

constexpr int LDS_ROWTAB = LDS_TAB, LDS_AUX = LDS_TAB + 12288, MOE_MAX_UNITS = 20, LDS_UTAB = LDS_CTL + 256, LDS_TSTART = LDS_UTAB + MOE_MAX_UNITS * 32;
__device__ __forceinline__ int moe_setup(const Params& p, LAS unsigned char* lds0, int nN, int bmul, int badd) {
    LAS int* tstart = (LAS int*)(lds0 + LDS_TSTART); LAS int* utab = (LAS int*)(lds0 + LDS_UTAB);
    const int* gcnt = (const int*)(p.ws + OFF_CNT);
    __syncthreads();
    if (hw_tid() == 0) {
        int a = 0;
        for (int e = 0; e < NEX; ++e) { const int c = e < NE ? gcnt[e] : T; tstart[e] = a; a += (c + 255) >> 8; }
        tstart[NEX] = a;
    }
    __syncthreads();
    const int total = tstart[NEX] * nN, G = gridDim.x, c = vcu_of_block();
    if (hw_tid() < MOE_MAX_UNITS) {
        const int i = hw_tid(), L = i * G + c;
        int pm = 0, pn = 0, e = 0, i0 = 0, cnt = 0;
        if (L < total) {
            const int mt = L / nN, pl = L % nN;
            for (int j = 1; j < NEX; ++j) e += (mt >= tstart[j]) ? 1 : 0;
            pm = mt; pn = e * bmul + badd + pl; i0 = (mt - tstart[e]) * 256; cnt = e < NE ? gcnt[e] : T;
        }
        utab[i * 8 + 0] = pm; utab[i * 8 + 1] = pn; utab[i * 8 + 2] = e; utab[i * 8 + 3] = i0; utab[i * 8 + 4] = cnt;
    }
    __syncthreads();
    const int n = (total - c + G - 1) / G;
    return n < 0 ? 0 : (n > MOE_MAX_UNITS ? MOE_MAX_UNITS : n);
}
struct MoeSched {
    LAS const int* utab; LAS const unsigned* rowtab; int n;
    __device__ __forceinline__ bool next(int i, pg8::Unit& u) const {
        if (i >= n) return false;
        u.pm = __builtin_amdgcn_readfirstlane(utab[i * 8 + 0]); u.pn = __builtin_amdgcn_readfirstlane(utab[i * 8 + 1]); u.e = __builtin_amdgcn_readfirstlane(utab[i * 8 + 2]); u.idx = i; return true;
    }
    __device__ __forceinline__ unsigned row_off(int i, int r) const { return rowtab[i * 256 + r]; }
    __device__ __forceinline__ void a_ready(const pg8::Unit&) const {}
    __device__ __forceinline__ void done(const pg8::Unit&) const {}
};
struct EpiGU {
    static constexpr bool PERM = true;
    LAS const float* auxw; unsigned char* ws;
    __device__ __forceinline__ void operator()(const f32x4 (&acc)[2][2][4][2], const pg8::Unit& u, int wr, int wc, int fr, int fq) const {
        const int pl = u.pn & 1;
        bf16_t* ACT = (bf16_t*)(ws + OFF_ACT) + (size_t)u.pm * 256 * FF + pl * 128 + wc * 32 + 8 * fq;
#pragma unroll
        for (int ai = 0; ai < 2; ++ai)
#pragma unroll
            for (int m = 0; m < 4; ++m) {
                const int rl = ai * 128 + wr * 64 + m * 16 + fr;
                const float wrow = auxw[u.idx * 256 + rl];
                float a[8];
#pragma unroll
                for (int n = 0; n < 2; ++n)
#pragma unroll
                    for (int q = 0; q < 4; ++q) { const float g = acc[ai][0][m][n][q], uu = acc[ai][1][m][n][q]; a[n * 4 + q] = g * __builtin_amdgcn_rcpf(1.f + __builtin_amdgcn_exp2f(g * -1.4426950408889634f)) * uu * wrow; }
                u32x4 w; w.x = pk2(a[0], a[1]); w.y = pk2(a[2], a[3]); w.z = pk2(a[4], a[5]); w.w = pk2(a[6], a[7]);
                *(u32x4*)(ACT + (size_t)rl * FF) = w;
            }
    }
};
__device__ __forceinline__ void phase_gateup(const Params& p, LAS unsigned char* lds0) {
    int n = moe_setup(p, lds0, 2, 2, 0); n = n > 12 ? 12 : n;
    LAS const int* utab = (LAS const int*)(lds0 + LDS_UTAB);
    LAS unsigned* rowtab = (LAS unsigned*)(lds0 + LDS_ROWTAB);
    LAS float* auxw = (LAS float*)(lds0 + LDS_AUX);
    const int* LDST = (const int*)(p.ws + OFF_LDST);
    const float* LWt = (const float*)(p.ws + OFF_LW);
    for (int i = 0; i < n; ++i) {
        const int e = utab[i * 8 + 2], i0 = utab[i * 8 + 3], cnt = utab[i * 8 + 4];
        if (hw_tid() < 256) {
            const int li = i0 + hw_tid(); int tok = 0; float w = 0.f;
            if (li < cnt) { if (e < NE) { tok = LDST[(size_t)e * T + li] / NSLOT; w = LWt[(size_t)e * T + li]; } else { tok = li; w = 1.f; } }
            rowtab[i * 256 + hw_tid()] = (unsigned)tok * (unsigned)(D * 2);
            auxw[i * 256 + hw_tid()] = w;
        }
    }
    __syncthreads();
    MoeSched S{utab, rowtab, n};
    pg8::Gemm g{(const bf16_t*)(p.ws + OFF_H), (const bf16_t*)(p.ws + OFF_WGU), p.ws, 2};
    EpiGU E{auxw, p.ws};
    pg8::gemm_phase<D, EpiGU, MoeSched, true>(lds0, g, S, E);
    {
        LAS const int* tstart = (LAS const int*)(lds0 + LDS_TSTART);
        const int total = tstart[NEX] * 2, G = gridDim.x, v = vcu_of_block(), rem = total % G;
        if (v >= rem) {
            const int lane = hw_tid() & 63, wv = hw_tid() >> 6, nw = (G - rem) * 8, w = (v - rem) * 8 + wv;
            LAS float* scr = (LAS float*)lds0 + wv * (64 * 33);
            for (int it = w; it < TR_N_D; it += nw) transpose_item(p, scr, TR_N_A + TR_N_GU + it, lane);
        }
    }
}
constexpr float FP8S = 32.f, FP8I = 1.f / 32.f;
__device__ __forceinline__ unsigned pk4_fp8(float a, float b, float c, float d) {
    a = __builtin_amdgcn_fmed3f(a * FP8S, -440.f, 440.f); b = __builtin_amdgcn_fmed3f(b * FP8S, -440.f, 440.f);
    c = __builtin_amdgcn_fmed3f(c * FP8S, -440.f, 440.f); d = __builtin_amdgcn_fmed3f(d * FP8S, -440.f, 440.f);
    int w = __builtin_amdgcn_cvt_pk_fp8_f32(a, b, 0, false);
    w = __builtin_amdgcn_cvt_pk_fp8_f32(c, d, w, true);
    return (unsigned)w;
}
struct EpiDown {
    static constexpr bool PERM = true;
    LAS const int* auxd; unsigned char* ws;
    __device__ __forceinline__ void operator()(const f32x4 (&acc)[2][2][4][2], const pg8::Unit& u, int wr, int wc, int fr, int fq) const {
        const int pl = u.pn & 3;
        unsigned char* SL = ws + OFF_SLOTS + pl * 256 + wc * 64 + 16 * fq;
#pragma unroll
        for (int ai = 0; ai < 2; ++ai)
#pragma unroll
            for (int m = 0; m < 4; ++m) {
                const int d = auxd[u.idx * 256 + ai * 128 + wr * 64 + m * 16 + fr];
                u32x4 w;
                w.x = pk4_fp8(acc[ai][0][m][0][0], acc[ai][0][m][0][1], acc[ai][0][m][0][2], acc[ai][0][m][0][3]);
                w.y = pk4_fp8(acc[ai][0][m][1][0], acc[ai][0][m][1][1], acc[ai][0][m][1][2], acc[ai][0][m][1][3]);
                w.z = pk4_fp8(acc[ai][1][m][0][0], acc[ai][1][m][0][1], acc[ai][1][m][0][2], acc[ai][1][m][0][3]);
                w.w = pk4_fp8(acc[ai][1][m][1][0], acc[ai][1][m][1][1], acc[ai][1][m][1][2], acc[ai][1][m][1][3]);
                *(u32x4*)(SL + (size_t)d * 1024) = w;
            }
    }
};
__device__ __forceinline__ void phase_down(const Params& p, LAS unsigned char* lds0) {
    const int n = moe_setup(p, lds0, 4, 4, 0);
    LAS const int* utab = (LAS const int*)(lds0 + LDS_UTAB);
    LAS int* auxd = (LAS int*)(lds0 + LDS_TAB);
    const int* LDST = (const int*)(p.ws + OFF_LDST);
    for (int i = 0; i < n; ++i) {
        const int e = utab[i * 8 + 2], i0 = utab[i * 8 + 3], cnt = utab[i * 8 + 4];
        if (hw_tid() < 256) {
            const int li = i0 + hw_tid();
            auxd[i * 256 + hw_tid()] = li < cnt ? (e < NE ? LDST[(size_t)e * T + li] : li * NSLOT + 8) : T * NSLOT;
        }
    }
    __syncthreads();
    MoeSched S{utab, (LAS const unsigned*)(lds0 + LDS_ROWTAB), n};
    pg8::Gemm g{(const bf16_t*)(p.ws + OFF_ACT), (const bf16_t*)(p.ws + OFF_WD), p.ws, 3};
    EpiDown E{auxd, p.ws};
    pg8::gemm_phase<FF, EpiDown, MoeSched, false>(lds0, g, S, E);
}

__device__ __forceinline__ void slot_sum16(const unsigned char* SL, int t, int cb, float (&s)[16]) {
#pragma unroll
    for (int i = 0; i < 16; ++i) s[i] = 0.f;
    u32x4 v[NSLOT];
#pragma unroll
    for (int k = 0; k < NSLOT; ++k) v[k] = *(const u32x4*)(SL + (size_t)(t * NSLOT + k) * 1024 + cb);
#pragma unroll
    for (int k = 0; k < NSLOT; ++k)
#pragma unroll
        for (int i = 0; i < 4; ++i) {
            typedef float f32x2 __attribute__((ext_vector_type(2)));
            const f32x2 lo = __builtin_amdgcn_cvt_pk_f32_fp8((int)v[k][i], false), hi = __builtin_amdgcn_cvt_pk_f32_fp8((int)v[k][i], true);
            s[4 * i] += lo.x; s[4 * i + 1] += lo.y; s[4 * i + 2] += hi.x; s[4 * i + 3] += hi.y;
        }
#pragma unroll
    for (int i = 0; i < 16; ++i) s[i] *= FP8I;
}
__device__ __forceinline__ int slot_col(int bb) { return (bb >> 4) * 256 + ((bb >> 2) & 3) * 32 + (bb & 3) * 8; }
__device__ __forceinline__ void phase_final(const Params& p) {
    const int lane = hw_tid() & 63, gw = blockIdx.x * 8 + (hw_tid() >> 6), ngw = gridDim.x * 8;
    const float* mod = (const float*)(p.ws + OFF_MOD);
    const unsigned char* SL = p.ws + OFF_SLOTS;
    const int c0 = slot_col(lane);
    for (int row = gw; row < T; row += ngw) {
        const float* g2 = mod + (size_t)(row / SEQ) * MODW + 5 * D;
        float f[16];
        slot_sum16(SL, row, lane * 16, f);
        f32x4 y[4]; float s = 0.f;
#pragma unroll
        for (int j = 0; j < 4; ++j) {
            const int cj = c0 + (j >> 1) * 128 + (j & 1) * 4;
            const f32x4 xm = *(const f32x4*)(p.out + (size_t)row * D + cj), gg = *(const f32x4*)(g2 + cj);
            y[j][0] = ALPHA * xm[0] + gg[0] * f[4 * j]; y[j][1] = ALPHA * xm[1] + gg[1] * f[4 * j + 1];
            y[j][2] = ALPHA * xm[2] + gg[2] * f[4 * j + 2]; y[j][3] = ALPHA * xm[3] + gg[3] * f[4 * j + 3];
            s += (y[j][0] + y[j][1]) + (y[j][2] + y[j][3]);
        }
#pragma unroll
        for (int o = 1; o < 64; o <<= 1) s += __shfl_xor(s, o);
        const float mean = s * (1.f / D);
        float qv = 0.f;
#pragma unroll
        for (int j = 0; j < 4; ++j) { y[j] = y[j] - mean; qv += (y[j][0] * y[j][0] + y[j][1] * y[j][1]) + (y[j][2] * y[j][2] + y[j][3] * y[j][3]); }
#pragma unroll
        for (int o = 1; o < 64; o <<= 1) qv += __shfl_xor(qv, o);
        const float rstd = 1.0f / sqrtf(qv * (1.f / D) + 1e-5f);
#pragma unroll
        for (int j = 0; j < 4; ++j) {
            const int cj = c0 + (j >> 1) * 128 + (j & 1) * 4;
            const f32x4 g = *(const f32x4*)(p.ln2_g + cj), bb4 = *(const f32x4*)(p.ln2_b + cj);
            *(f32x4*)(p.out + (size_t)row * D + cj) = y[j] * rstd * g + bb4;
        }
    }
}

#define XB_TMO      128
#define XB_XCNT(j)  (256  + 64 * (j))
#define XB_XSUB(j)  (1280 + 64 * (j))
#define XB_XGEN(j)  (2304 + 64 * (j))
#define XB_TOP      3328
#define XB_TOPGEN   3392
#define XCD_BAR_WORDS 3456
#define XB_SPIN_CAP (1u << 18)
__device__ __forceinline__ unsigned xb_ld(unsigned* p)              { return __hip_atomic_load(p, __ATOMIC_RELAXED, __HIP_MEMORY_SCOPE_AGENT); }
__device__ __forceinline__ unsigned xb_add(unsigned* p, unsigned v) { return __hip_atomic_fetch_add(p, v, __ATOMIC_RELAXED, __HIP_MEMORY_SCOPE_AGENT); }
__device__ __forceinline__ unsigned xb_xcc_id() { return (unsigned)__builtin_amdgcn_s_getreg((3 << 11) | 20) & 0xFu; }
#define XB_SPIN(cond, bar) do { unsigned _sp = 0; while (cond) { __builtin_amdgcn_s_sleep(1); \
    if ((++_sp & 255u) == 0u) { if (xb_ld(&(bar)[XB_TMO])) break; if (_sp > XB_SPIN_CAP) { atomicAdd(&(bar)[XB_TMO], 1u); break; } } } } while (0)
struct XcdBarrier { unsigned* bar; unsigned x; volatile LAS unsigned* st; };
__device__ __forceinline__ XcdBarrier xcd_barrier_post(unsigned* bar, volatile LAS unsigned* st) {
    XcdBarrier b; b.bar = bar; b.x = xb_xcc_id(); b.st = st;
    if (hw_tid() == 0) (void)xb_add(&bar[XB_XCNT(b.x)], 1u);
    return b;
}
__device__ __forceinline__ void xcd_barrier_complete(unsigned* bar, unsigned x, unsigned& nloc, unsigned& nx) {
    const unsigned G = gridDim.x * gridDim.y * gridDim.z;
    unsigned sum, cnt, mine, sp = 0u;
    for (;;) {
        sum = 0u; cnt = 0u; mine = 0u;
#pragma unroll
        for (unsigned j = 0; j < 16; ++j) { const unsigned c = xb_ld(&bar[XB_XCNT(j)]); sum += c; cnt += (c > 0u) ? 1u : 0u; mine = (j == x) ? c : mine; }
        if (sum == G) break;
        __builtin_amdgcn_s_sleep(1);
        if ((++sp & 255u) == 0u) { if (xb_ld(&bar[XB_TMO])) break; if (sp > XB_SPIN_CAP) { atomicAdd(&bar[XB_TMO], 1u); break; } }
    }
    nloc = mine > 0u ? mine : 1u; nx = cnt > 0u ? cnt : 1u;
}
__device__ __forceinline__ void xcd_barrier(const XcdBarrier& b) {
    asm volatile("s_waitcnt vmcnt(0)" ::: "memory");
    __syncthreads();
    if (hw_tid() == 0) {
        unsigned* bar = b.bar;
        __builtin_amdgcn_s_waitcnt(0);
        unsigned nloc = b.st[0], nx = b.st[1];
        if (nloc == 0u) { xcd_barrier_complete(bar, b.x, nloc, nx); b.st[0] = nloc; b.st[1] = nx; }
        const unsigned old = xb_add(&bar[XB_XSUB(b.x)], 1u);
        const unsigned gen = old / nloc;
        if (old + 1u == (gen + 1u) * nloc) {
            __builtin_amdgcn_fence(__ATOMIC_RELEASE, "agent");
            asm volatile("s_waitcnt vmcnt(0)" ::: "memory");
            const unsigned og = xb_add(&bar[XB_TOP], 1u);
            const unsigned tg = og / nx;
            if (og + 1u == (tg + 1u) * nx) xb_add(&bar[XB_TOPGEN], 1u);
            else XB_SPIN(xb_ld(&bar[XB_TOPGEN]) == tg, bar);
            __builtin_amdgcn_fence(__ATOMIC_ACQUIRE, "agent");
            xb_add(&bar[XB_XGEN(b.x)], 1u);
            asm volatile("s_waitcnt vmcnt(0)" ::: "memory");
        } else {
            XB_SPIN(xb_ld(&bar[XB_XGEN(b.x)]) == gen, bar);
            __builtin_amdgcn_fence(__ATOMIC_ACQUIRE, "agent");
            asm volatile("s_waitcnt vmcnt(0)" ::: "memory");
        }
    }
    __syncthreads();
}

constexpr size_t OFF_BAR = 448 * 1024;

__global__ void __launch_bounds__(512, 2) mk_fwd(Params p) {
    extern __shared__ __attribute__((aligned(16))) unsigned char smem[];
    LAS unsigned char* lds0 = (LAS unsigned char*)smem;
    {
        const unsigned hw = (unsigned)__builtin_amdgcn_s_getreg((5 << 11) | 4) & 63u;
        if ((threadIdx.x & 63) == 0) *(volatile LAS int*)(LDS_HWTAB + hw * 4) = (int)(threadIdx.x >> 6);
        if (threadIdx.x < 64) ((LAS unsigned*)(lds0 + LDS_CTL))[threadIdx.x] = 0u;
    }
    __syncthreads();
    unsigned char* const g_probe_ws = p.ws; (void)g_probe_ws;
    XcdBarrier bar; bar.bar = (unsigned*)(p.ws + OFF_BAR); bar.x = 0; bar.st = nullptr;
    bar = xcd_barrier_post((unsigned*)(p.ws + OFF_BAR), (volatile LAS unsigned*)(lds0 + LDS_CTL));
#define RUN_PHASE(k, call) { if ((k) > 0) xcd_barrier(bar); TS_BEGIN(16 + (k)); int on_ = 1; asm volatile("" : "+s"(on_)); if (on_) { int grp_ = hw_tid() >> 8; asm volatile("" : "+v"(grp_)); LAS unsigned char* lds = lds0 + grp_ * 32768; (void)lds; call; } TS_END(16 + (k)); }
    RUN_PHASE(0, phase_prep(p, lds))
    RUN_PHASE(1, phase_xn(p))
    RUN_PHASE(2, phase_inproj(p, lds0))
    RUN_PHASE(3, phase_attn_pool(p, lds, (char*)smem))
    RUN_PHASE(4, phase_outproj(p, lds0))
    RUN_PHASE(5, phase_router(p, lds0))
    RUN_PHASE(6, phase_gateup(p, lds0))
    RUN_PHASE(7, phase_down(p, lds0))
    RUN_PHASE(8, phase_final(p))
#ifdef PROBE_ACC
    if (blockIdx.x == PROBE_BLK && hw_tid() == 0) {
        __builtin_amdgcn_s_waitcnt(0);
        const unsigned long long span = __hip_atomic_load((unsigned long long*)(p.ws + 448 * 1024 + 16384) + PROBE_ACC, __ATOMIC_RELAXED, __HIP_MEMORY_SCOPE_AGENT);
        const unsigned long long tend = __builtin_amdgcn_s_memrealtime() + PROBE_MUL * span; while (__builtin_amdgcn_s_memrealtime() < tend) __builtin_amdgcn_s_sleep(8);
    }
#endif
}

extern "C" void kernel_launch(void* const* d_in, const int* in_sizes, int n_in, void* d_out, int out_size, void* d_ws, size_t ws_size, hipStream_t stream) {
    static int grid = 0;
    if (grid == 0) {
        int dev = 0, cus = 0, per_cu = 0;
        (void)hipGetDevice(&dev);
        (void)hipDeviceGetAttribute(&cus, hipDeviceAttributeMultiprocessorCount, dev);
        (void)hipFuncSetAttribute((const void*)mk_fwd, hipFuncAttributeMaxDynamicSharedMemorySize, LDS_BYTES);
        (void)hipOccupancyMaxActiveBlocksPerMultiprocessor(&per_cu, (const void*)mk_fwd, 512, LDS_BYTES);
        if (per_cu < 1) fprintf(stderr, "kernel_launch: occupancy query says %d blocks per CU\n", per_cu);
        (void)hipGetLastError();
        grid = cus;
        if (ws_size < WS_NEED) fprintf(stderr, "kernel_launch: workspace too small: %zu < %zu\n", ws_size, (size_t)WS_NEED);
    }
    Params p{};
    const float** pp = (const float**)&p;
    for (int i = 0; i < 24; ++i) pp[i] = (const float*)d_in[i];
    p.out = (float*)d_out; p.ws = (unsigned char*)d_ws;
    (void)hipMemsetAsync((char*)d_ws + OFF_BAR, 0, 16384 + 512, stream);
    hipLaunchKernelGGL(mk_fwd, dim3(grid), dim3(512), LDS_BYTES, stream, p);
}
```

```cpp
#include <hip/hip_runtime.h>
#include <stdint.h>
#include <stdio.h>


#ifdef PROBE_ACC
#ifndef PROBE_BLK
#define PROBE_BLK 0
#endif
#ifndef PROBE_MUL
#define PROBE_MUL 8ull
#endif
#define TS_ADD(k, sgn) do { if (blockIdx.x == PROBE_BLK && hw_tid() == 0) { const unsigned long long t_ = __builtin_amdgcn_s_memrealtime(); \
    __hip_atomic_fetch_add((unsigned long long*)(g_probe_ws + 448 * 1024 + 16384) + (k), (sgn) ? t_ : (0ull - t_), __ATOMIC_RELAXED, __HIP_MEMORY_SCOPE_AGENT); } } while (0)
#define TS_BEGIN(k) TS_ADD(k, false)
#define TS_END(k) TS_ADD(k, true)
#else
#define TS_BEGIN(k) do {} while (0)
#define TS_END(k) do {} while (0)
#endif
#define LAS __attribute__((address_space(3)))
#define TIDX ((int)(hw_tid() & 255))
#define VBLK ((int)(blockIdx.x * 2 + (hw_tid() >> 8)))
#define NVBLK ((int)(gridDim.x * 2))
typedef unsigned short bf16_t;
typedef short bf16x8 __attribute__((ext_vector_type(8)));
typedef float f32x4 __attribute__((ext_vector_type(4)));
typedef unsigned u32x4 __attribute__((ext_vector_type(4)));
typedef unsigned u32x2 __attribute__((ext_vector_type(2)));

constexpr int D = 1024, NB = 16, SEQ = 2048, T = NB * SEQ, CTXL = 256, TC = NB * CTXL, KVL = CTXL + SEQ;
constexpr int PW = 1536, NE = 64, NEX = 65, FF = 256, NSLOT = 9, MODW = 6 * D;
constexpr float ALPHA = 1.189207115002721f;
constexpr float C2 = 0.125f * 1.4426950408889634f;
constexpr int NPHASE = 9;
constexpr int LDS_BYTES = 163840, LDS_TAB = 131072, LDS_CTL = 155648;
constexpr int LDS_HWTAB = LDS_CTL + 2048;
__device__ __forceinline__ int hw_tid() {
    const unsigned hw = (unsigned)__builtin_amdgcn_s_getreg((5 << 11) | 4) & 63u;
    const int w = __builtin_amdgcn_readfirstlane(*(volatile LAS int*)(LDS_HWTAB + hw * 4));
    return w * 64 + (int)__builtin_amdgcn_mbcnt_hi(~0u, __builtin_amdgcn_mbcnt_lo(~0u, 0u));
}

constexpr size_t MiB = 1u << 20;
constexpr size_t OFF_CNT = 0, OFF_MOD = 4096, OFF_ROPE = 512 * 1024;
constexpr size_t OFF_WTIN = 1 * MiB, OFF_WTOUT = 4 * MiB, OFF_WD = 6 * MiB, OFF_LDST = 39 * MiB, OFF_ACT = 47 * MiB;
constexpr size_t OFF_SLOTS = 201 * MiB;
constexpr size_t OFF_WGU = 201 * MiB, OFF_H = 266 * MiB, OFF_LW = 330 * MiB;
constexpr size_t OFF_XN = 47 * MiB, OFF_Q = 119 * MiB, OFF_K = 167 * MiB;
constexpr size_t OFF_V = 338 * MiB, OFF_U = 356 * MiB, OFF_AO = 372 * MiB, OFF_STATS = 436 * MiB;
constexpr size_t OFF_WRH = 490 * MiB, OFF_WRL = OFF_WRH + 128 * 1024;
constexpr size_t WS_NEED = 491 * MiB;

struct Params {
    const float *x, *c, *ctx, *c_ctx, *w_mod, *b_mod, *w_in, *q_norm, *k_norm, *pool_w, *pool_scale, *w_out, *ln1_g, *ln1_b,
        *w_router, *router_bias, *w_gate, *w_up, *w_down, *ws_gate, *ws_up, *ws_down, *ln2_g, *ln2_b;
    float* out;
    unsigned char* ws;
};

__device__ __forceinline__ unsigned f2bf(float f) { unsigned u = __float_as_uint(f); return (u + 0x7fffu + ((u >> 16) & 1u)) >> 16; }
__device__ __forceinline__ unsigned pk2(float lo, float hi) { return f2bf(lo) | (f2bf(hi) << 16); }
__device__ __forceinline__ float bf2f(unsigned h) { return __uint_as_float(h << 16); }
__device__ __forceinline__ float bflo(unsigned w) { return __uint_as_float(w << 16); }
__device__ __forceinline__ float bfhi(unsigned w) { return __uint_as_float(w & 0xffff0000u); }

namespace pg8 {
constexpr int BM = 256, BK = 64, HALF = 128, HTB = HALF * BK * 2, STAGE_BYTES = 8 * HTB;
__host__ __device__ __forceinline__ int lds_byte(int r, int c) { const int st = (r >> 4) * 2 + (c >> 5), rr = r & 15, cc = c & 31, ob = rr * 64 + cc * 2; return st * 1024 + (ob ^ (((ob >> 9) & 1) << 5)); }
__host__ __device__ __forceinline__ void stage_rc(int b, int& R, int& C) { const int st = b / 1024, sb = b % 1024, swz = sb ^ (((sb >> 9) & 1) << 5); R = (st >> 1) * 16 + swz / 64; C = (st & 1) * 32 + (swz % 64) / 2; }
__host__ __device__ __forceinline__ int perm32(int rho) { const int n = rho >> 4, i = rho & 15; return 8 * (i >> 2) + 4 * n + (i & 3); }
struct Unit { int pm, pn, idx, e; };
struct Gemm { const bf16_t* A; const bf16_t* Bt; unsigned char* pws; int tsid; };
__device__ __forceinline__ unsigned cvt_pk_bf16(float lo, float hi) { unsigned r; asm volatile("v_cvt_pk_bf16_f32 %0, %1, %2" : "=v"(r) : "v"(lo), "v"(hi)); return r; }

template <int K, class Epi, class Sched, bool GATHER, bool ALIGN_EPI = true>
__device__ __forceinline__ void gemm_phase(LAS unsigned char* lds, const Gemm g, const Sched& S, const Epi& E) {
    const int tid = hw_tid(), wid = __builtin_amdgcn_readfirstlane(tid >> 6), lane = tid & 63, wr = wid >> 2, wc = wid & 3, fr = lane & 15, fq = lane >> 4;
    constexpr int nt = K / BK;
    unsigned voffA[2], voffB[2], colA = 0; int rowA = 0;
#pragma unroll
    for (int i = 0; i < 2; ++i) { int R, C; stage_rc(tid * 16 + i * 8192, R, C); const int Rb = Epi::PERM ? ((R & ~31) + perm32(R & 31)) : R;
        voffA[i] = (unsigned)(R * K + C) * 2u; voffB[i] = (unsigned)(Rb * K + C) * 2u; if (i == 0) { colA = (unsigned)C * 2u; rowA = R; } }
    const size_t kstep = (size_t)(BK * 2);
    const size_t hstep = (size_t)HALF * K * 2;
    const size_t tstep = 2 * hstep;
    const unsigned ldsw = (unsigned)wid * 1024u;
    const int aoff = lds_byte(wr * 64 + fr, fq * 8), boff = lds_byte(wc * 32 + fr, fq * 8);
#define PG8_SA(b, h) (((b) * 2 + (h)) * HTB)
#define PG8_SB(b, h) ((4 + (b) * 2 + (h)) * HTB)
#define PG8_STAGE(bufoff, gbase, voff) do { _Pragma("unroll") for (int _i = 0; _i < 2; ++_i) \
        __builtin_amdgcn_global_load_lds((const unsigned*)((const char*)(gbase) + (voff)[_i]), (LAS unsigned*)(lds + (bufoff) + ldsw + _i * 8192), 16, 0, 0); } while (0)
#define PG8_STAGE_A(bufoff, ptr, h, NX) do { if constexpr (GATHER) { unsigned _v[2]; \
            if (NX) { _v[0] = S.row_off(nidx, (h) * HALF + rowA) + colA; _v[1] = S.row_off(nidx, (h) * HALF + rowA + 64) + colA; } else { _v[0] = vA[h][0]; _v[1] = vA[h][1]; } PG8_STAGE(bufoff, ptr, _v); } \
        else { PG8_STAGE(bufoff, (ptr) + (h) * hstep, voffA); } } while (0)
#define PG8_LDA(dst, b, h) do { _Pragma("unroll") for (int m = 0; m < 4; ++m) _Pragma("unroll") for (int k = 0; k < 2; ++k) dst[m][k] = *(const LAS bf16x8*)(lds + PG8_SA(b, h) + aoff + m * 2048 + k * 1024); } while (0)
#define PG8_LDB(dst, b, h) do { _Pragma("unroll") for (int n = 0; n < 2; ++n) _Pragma("unroll") for (int k = 0; k < 2; ++k) dst[n][k] = *(const LAS bf16x8*)(lds + PG8_SB(b, h) + boff + n * 2048 + k * 1024); } while (0)
#define PG8_MMA(ai, bj, At, Bt) do { __builtin_amdgcn_s_setprio(1); _Pragma("unroll") for (int m = 0; m < 4; ++m) _Pragma("unroll") for (int n = 0; n < 2; ++n) _Pragma("unroll") for (int k = 0; k < 2; ++k) \
        acc[ai][bj][m][n] = __builtin_amdgcn_mfma_f32_16x16x32_bf16(Bt[n][k], At[m][k], acc[ai][bj][m][n], 0, 0, 0); __builtin_amdgcn_s_setprio(0); } while (0)
#define PG8_WAIT_V(n) asm volatile("s_waitcnt vmcnt(" #n ")" ::: "memory")
#define PG8_WAIT_L(n) asm volatile("s_waitcnt lgkmcnt(" #n ")" ::: "memory")
#define PG8_BAR __builtin_amdgcn_s_barrier()
#define PG8_SCHED __builtin_amdgcn_sched_barrier(0)
    unsigned char* const g_probe_ws = g.pws; (void)g_probe_ws;
    Unit cur, nxt; int ui = 0;
    if (!S.next(0, cur)) return;
    f32x4 acc[2][2][4][2];
#pragma unroll
    for (int a = 0; a < 2; ++a)
#pragma unroll
        for (int b = 0; b < 2; ++b)
#pragma unroll
            for (int m = 0; m < 4; ++m)
#pragma unroll
                for (int n = 0; n < 2; ++n) acc[a][b][m][n] = (f32x4){0.f, 0.f, 0.f, 0.f};
    bf16x8 At[4][2], B0[2][2], B1[2][2];
    unsigned vA[2][2]; int nidx = 0;
    if constexpr (GATHER) {
#pragma unroll
        for (int h = 0; h < 2; ++h)
#pragma unroll
            for (int i = 0; i < 2; ++i) vA[h][i] = S.row_off(cur.idx, h * HALF + rowA + 64 * i) + colA;
    }
    const char* cA = GATHER ? (const char*)g.A : (const char*)g.A + (size_t)cur.pm * tstep; const char* cB = (const char*)g.Bt + (size_t)cur.pn * tstep;
    S.a_ready(cur);
    PG8_STAGE(PG8_SB(0, 0), cB, voffB); PG8_STAGE(PG8_SB(0, 1), cB + hstep, voffB); PG8_STAGE_A(PG8_SA(0, 0), cA, 0, false); PG8_STAGE_A(PG8_SA(0, 1), cA, 1, false);
    if (wr == 1) PG8_BAR;
    PG8_WAIT_V(2); PG8_BAR;
    PG8_STAGE(PG8_SB(1, 0), cB + kstep, voffB); PG8_STAGE_A(PG8_SA(1, 0), cA + kstep, 0, false); PG8_STAGE(PG8_SB(1, 1), cB + hstep + kstep, voffB);
    PG8_WAIT_V(6); PG8_BAR;
    for (;;) {
        const bool has_next = S.next(ui + 1, nxt);
        if constexpr (GATHER) nidx = has_next ? nxt.idx : cur.idx;
        const char* nA = GATHER ? (const char*)g.A : (has_next ? (const char*)g.A + (size_t)nxt.pm * tstep : cA); const char* nB = has_next ? (const char*)g.Bt + (size_t)nxt.pn * tstep : cB;
        TS_BEGIN(33 + 2 * g.tsid);
        for (int t = 0; t < nt; t += 2) {
            const bool last = (t == nt - 2);
            const char* a1 = cA + (size_t)(t + 1) * kstep;
            const char* a2 = last ? nA : cA + (size_t)(t + 2) * kstep; const char* b2 = last ? nB : cB + (size_t)(t + 2) * kstep;
            const char* a3 = a2 + kstep; const char* b3 = b2 + kstep;
            if (last && has_next) S.a_ready(nxt);
            PG8_LDB(B0, 0, 0); PG8_LDB(B1, 0, 1); PG8_SCHED; PG8_LDA(At, 0, 0); PG8_STAGE_A(PG8_SA(1, 1), a1, 1, false);
            PG8_WAIT_V(8); PG8_WAIT_L(0); PG8_BAR; PG8_MMA(0, 0, At, B0); PG8_MMA(0, 1, At, B1); PG8_BAR; PG8_SCHED;
            PG8_LDA(At, 0, 1); PG8_STAGE(PG8_SB(0, 0), b2, voffB); PG8_STAGE(PG8_SB(0, 1), b2 + hstep, voffB); PG8_STAGE_A(PG8_SA(0, 0), a2, 0, last);
            PG8_WAIT_V(8); PG8_WAIT_L(0); PG8_BAR; PG8_MMA(1, 0, At, B0); PG8_MMA(1, 1, At, B1); PG8_BAR; PG8_SCHED;
            PG8_LDB(B0, 1, 0); PG8_LDB(B1, 1, 1); PG8_SCHED; PG8_LDA(At, 1, 0); PG8_STAGE_A(PG8_SA(0, 1), a2, 1, last);
            PG8_WAIT_V(8); PG8_WAIT_L(0); PG8_BAR; PG8_MMA(0, 0, At, B0); PG8_MMA(0, 1, At, B1); PG8_BAR; PG8_SCHED;
            PG8_LDA(At, 1, 1); PG8_STAGE(PG8_SB(1, 0), b3, voffB); PG8_STAGE(PG8_SB(1, 1), b3 + hstep, voffB); PG8_STAGE_A(PG8_SA(1, 0), a3, 0, last);
            PG8_WAIT_V(8); PG8_WAIT_L(0); PG8_BAR; PG8_MMA(1, 0, At, B0); PG8_MMA(1, 1, At, B1); PG8_BAR; PG8_SCHED;
        }
        TS_END(33 + 2 * g.tsid);
        if constexpr (ALIGN_EPI) { if (wr == 0) PG8_BAR; }
        TS_BEGIN(32 + 2 * g.tsid); E(acc, cur, wr, wc, fr, fq); S.done(cur); TS_END(32 + 2 * g.tsid);
        if (!has_next) break;
#pragma unroll
        for (int a = 0; a < 2; ++a)
#pragma unroll
            for (int b = 0; b < 2; ++b)
#pragma unroll
                for (int m = 0; m < 4; ++m)
#pragma unroll
                    for (int n = 0; n < 2; ++n) acc[a][b][m][n] = (f32x4){0.f, 0.f, 0.f, 0.f};
        cur = nxt; cA = nA; cB = nB; ++ui;
        if constexpr (GATHER) {
#pragma unroll
            for (int h = 0; h < 2; ++h)
#pragma unroll
                for (int i = 0; i < 2; ++i) vA[h][i] = S.row_off(cur.idx, h * HALF + rowA + 64 * i) + colA;
        }
        if constexpr (ALIGN_EPI) { if (wr == 1) PG8_BAR; }
    }
    PG8_WAIT_V(0);
    if constexpr (!ALIGN_EPI) { if (wr == 0) PG8_BAR; }
    PG8_BAR;
#undef PG8_SA
#undef PG8_SB
#undef PG8_STAGE
#undef PG8_STAGE_A
#undef PG8_LDA
#undef PG8_LDB
#undef PG8_MMA
#undef PG8_WAIT_V
#undef PG8_WAIT_L
#undef PG8_BAR
#undef PG8_SCHED
}

struct DenseSched {
    int nN, n1, total, pn2lo, nN2, G, c;
    __device__ __forceinline__ bool next(int i, Unit& u) const {
        const int L = i * G + c; if (L >= total) return false;
        if (L < n1) { u.pm = L / nN; u.pn = L % nN; } else { const int r = L - n1; u.pm = n1 / nN + r / nN2; u.pn = pn2lo + r % nN2; }
        u.idx = i; u.e = 0; return true;
    }
    __device__ __forceinline__ void a_ready(const Unit&) const {}
    __device__ __forceinline__ void done(const Unit&) const {}
};
}

__device__ __forceinline__ int win_row(int n) { return (n & ~255) + 128 * ((n >> 5) & 1) + 32 * ((n >> 6) & 3) + (n & 31); }
__device__ __forceinline__ int gu_row(int j, int half) { return (j >> 7) * 256 + half * 128 + (j & 127); }

template <class RowMap>
__device__ __forceinline__ void transpose_tile(LAS float* tile, const float* src, int ld, int k0, int n0, bf16_t* dst, int Kdst, RowMap rowmap) {
    const int tid = TIDX;
#pragma unroll
    for (int pss = 0; pss < 4; ++pss) {
        const int k = pss * 16 + (tid >> 4), n4 = (tid & 15) * 4;
        const f32x4 v = *(const f32x4*)(src + (size_t)(k0 + k) * ld + n0 + n4);
        tile[k * 65 + n4 + 0] = v[0]; tile[k * 65 + n4 + 1] = v[1]; tile[k * 65 + n4 + 2] = v[2]; tile[k * 65 + n4 + 3] = v[3];
    }
    __syncthreads();
    {
        const int n = tid >> 2, kc = (tid & 3) * 16;
        unsigned w[8];
#pragma unroll
        for (int i = 0; i < 8; ++i) w[i] = pk2(tile[(kc + 2 * i) * 65 + n], tile[(kc + 2 * i + 1) * 65 + n]);
        bf16_t* dp = dst + (size_t)rowmap(n0 + n) * Kdst + k0 + kc;
        *(u32x4*)dp = (u32x4){w[0], w[1], w[2], w[3]};
        *(u32x4*)(dp + 8) = (u32x4){w[4], w[5], w[6], w[7]};
    }
    __syncthreads();
}

template <class RowMap>
__device__ __forceinline__ void wave_transpose(LAS float* scr, const float* src, int ld, int k0, int n0, bf16_t* dst, int Kdst, RowMap rowmap, int lane) {
#pragma unroll
    for (int i = 0; i < 8; ++i) {
        const int kk = 8 * i + (lane >> 3), n4 = (lane & 7) * 4;
        const f32x4 v = *(const f32x4*)(src + (size_t)(k0 + kk) * ld + n0 + n4);
        scr[kk * 33 + n4] = v[0]; scr[kk * 33 + n4 + 1] = v[1]; scr[kk * 33 + n4 + 2] = v[2]; scr[kk * 33 + n4 + 3] = v[3];
    }
    asm volatile("s_waitcnt lgkmcnt(0)" ::: "memory");
    const int c = lane & 7;
#pragma unroll
    for (int j = 0; j < 4; ++j) {
        const int n = (lane >> 3) + 8 * j; const LAS float* sp = scr + (8 * c) * 33 + n;
        u32x4 o; o.x = pk2(sp[0], sp[33]); o.y = pk2(sp[2 * 33], sp[3 * 33]); o.z = pk2(sp[4 * 33], sp[5 * 33]); o.w = pk2(sp[6 * 33], sp[7 * 33]);
        *(u32x4*)(dst + (size_t)rowmap(n0 + n) * Kdst + k0 + 8 * c) = o;
    }
    asm volatile("s_waitcnt lgkmcnt(0)" ::: "memory");
}

constexpr int TR_N_A = 16 * 48 + 16 * 32, TR_N_GU = NEX * 256, TR_N_D = NEX * 128;
constexpr int TR_GU_LATE = 224 * 8 * 6;
struct TrItem { const float* src; bf16_t* dst; int ld, Kdst, k0, n0, kind, half; };
__device__ __forceinline__ TrItem tr_decode(const Params& p, int id) {
    TrItem t;
    if (id < 16 * 48) { t.src = p.w_in; t.dst = (bf16_t*)(p.ws + OFF_WTIN); t.ld = PW; t.Kdst = D; t.k0 = (id / 48) * 64; t.n0 = (id % 48) * 32; t.kind = 1; t.half = 0; return t; }
    id -= 16 * 48;
    if (id < 16 * 32) { t.src = p.w_out; t.dst = (bf16_t*)(p.ws + OFF_WTOUT); t.ld = D; t.Kdst = D; t.k0 = (id / 32) * 64; t.n0 = (id % 32) * 32; t.kind = 0; t.half = 0; return t; }
    id -= 16 * 32;
    if (id < TR_N_GU) {
        const int e = id >> 8, q = id & 255, half = q >> 7, rr = q & 127;
        t.src = half ? (e < NE ? p.w_up + (size_t)e * D * FF : p.ws_up) : (e < NE ? p.w_gate + (size_t)e * D * FF : p.ws_gate);
        t.dst = (bf16_t*)(p.ws + OFF_WGU) + (size_t)e * 512 * D; t.ld = FF; t.Kdst = D; t.k0 = (rr / 8) * 64; t.n0 = (rr % 8) * 32; t.kind = 2; t.half = half; return t;
    }
    id -= TR_N_GU;
    {
        const int e = id >> 7, rr = id & 127;
        t.src = e < NE ? p.w_down + (size_t)e * FF * D : p.ws_down;
        t.dst = (bf16_t*)(p.ws + OFF_WD) + (size_t)e * D * FF; t.ld = D; t.Kdst = FF; t.k0 = (rr / 32) * 64; t.n0 = (rr % 32) * 32; t.kind = 0; t.half = 0; return t;
    }
}
__device__ __forceinline__ void tr_load(const TrItem& t, int lane, f32x4 (&v)[8]) {
#pragma unroll
    for (int i = 0; i < 8; ++i) v[i] = *(const f32x4*)(t.src + (size_t)(t.k0 + 8 * i + (lane >> 3)) * t.ld + t.n0 + (lane & 7) * 4);
}
template <class IdFn>
__device__ __forceinline__ void transpose_run(const Params& p, LAS float* scr, int lane, int n, IdFn idfn) {
    if (n <= 0) return;
    TrItem cur = tr_decode(p, idfn(0));
    f32x4 v[8];
    tr_load(cur, lane, v);
    for (int k = 0; k < n; ++k) {
#pragma unroll
        for (int i = 0; i < 8; ++i) { const int kk = 8 * i + (lane >> 3), n4 = (lane & 7) * 4; scr[kk * 33 + n4] = v[i][0]; scr[kk * 33 + n4 + 1] = v[i][1]; scr[kk * 33 + n4 + 2] = v[i][2]; scr[kk * 33 + n4 + 3] = v[i][3]; }
        TrItem nxt = cur;
        if (k + 1 < n) { nxt = tr_decode(p, idfn(k + 1)); tr_load(nxt, lane, v); }
        asm volatile("s_waitcnt lgkmcnt(0)" ::: "memory");
        const int c = lane & 7;
#pragma unroll
        for (int j = 0; j < 4; ++j) {
            const int nn = (lane >> 3) + 8 * j; const LAS float* sp = scr + (8 * c) * 33 + nn;
            u32x4 o; o.x = pk2(sp[0], sp[33]); o.y = pk2(sp[2 * 33], sp[3 * 33]); o.z = pk2(sp[4 * 33], sp[5 * 33]); o.w = pk2(sp[6 * 33], sp[7 * 33]);
            const int gn = cur.n0 + nn, row = cur.kind == 0 ? gn : (cur.kind == 1 ? win_row(gn) : gu_row(gn, cur.half));
            *(u32x4*)(cur.dst + (size_t)row * cur.Kdst + cur.k0 + 8 * c) = o;
        }
        asm volatile("s_waitcnt lgkmcnt(0)" ::: "memory");
        cur = nxt;
    }
}

__device__ __forceinline__ void phase_prep(const Params& p, LAS unsigned char* lds) {
    const int tid = TIDX;
    int* gcnt = (int*)(p.ws + OFF_CNT);
    if (VBLK == 0 && tid < 128) gcnt[tid] = 0;
    float* mod = (float*)(p.ws + OFF_MOD);
    float* rope = (float*)(p.ws + OFF_ROPE);
    constexpr int N_MOD = 384, N_ROPE = 256, N_TR = 16;
    for (int it = VBLK; it < N_MOD + N_ROPE + N_TR; it += NVBLK) {
        if (it < N_MOD) {
            LAS float* sl = (LAS float*)lds;
            LAS float* red = (LAS float*)(lds + 10240);
            const int col = it * 16 + (tid & 15), kk = tid >> 4;
            float acc[17];
#pragma unroll
            for (int r = 0; r < 17; ++r) acc[r] = 0.f;
            for (int kc = 0; kc < 8; ++kc) {
                float wv[8];
#pragma unroll
                for (int i = 0; i < 8; ++i) wv[i] = p.w_mod[(size_t)(kc * 128 + kk + 16 * i) * MODW + col];
                __syncthreads();
                for (int o = tid; o < 17 * 128; o += 256) {
                    const int r = o >> 7, kl = o & 127;
                    const float cv = (r < 16) ? p.c[r * D + kc * 128 + kl] : p.c_ctx[kc * 128 + kl];
                    sl[kl * 20 + r] = cv / (1.f + expf(-cv));
                }
                __syncthreads();
#pragma unroll
                for (int i = 0; i < 8; ++i) {
                    const int kl = kk + 16 * i;
                    const f32x4 s0 = *(const LAS f32x4*)(sl + kl * 20), s1 = *(const LAS f32x4*)(sl + kl * 20 + 4), s2 = *(const LAS f32x4*)(sl + kl * 20 + 8), s3 = *(const LAS f32x4*)(sl + kl * 20 + 12);
                    const float s4 = sl[kl * 20 + 16];
#pragma unroll
                    for (int q = 0; q < 4; ++q) { acc[q] += s0[q] * wv[i]; acc[4 + q] += s1[q] * wv[i]; acc[8 + q] += s2[q] * wv[i]; acc[12 + q] += s3[q] * wv[i]; }
                    acc[16] += s4 * wv[i];
                }
            }
#pragma unroll
            for (int r = 0; r < 17; ++r) red[(kk * 17 + r) * 16 + (tid & 15)] = acc[r];
            __syncthreads();
            for (int o = tid; o < 17 * 16; o += 256) {
                const int r = o >> 4, j = o & 15;
                float sm = p.b_mod[it * 16 + j];
#pragma unroll
                for (int g = 0; g < 16; ++g) sm += red[(g * 17 + r) * 16 + j];
                mod[r * MODW + it * 16 + j] = sm;
            }
            __syncthreads();
        } else if (it < N_MOD + N_ROPE) {
            const int idx = (it - N_MOD) * 256 + tid, t = idx >> 5, i = idx & 31;
            const int pos = (i < 16) ? (t >> 6) : (t & 63);
            const float invf = (float)exp(-(double)(i & 15) / 16.0 * 9.210340371976184);
            const double ang = (double)((float)pos * invf);
            rope[idx * 2 + 0] = (float)cos(ang);
            rope[idx * 2 + 1] = (float)sin(ang);
        } else {
            LAS float* tile = (LAS float*)lds;
            const int idx = it - N_MOD - N_ROPE;
            {

                const int k0 = idx * 64;
#pragma unroll
                for (int pss = 0; pss < 4; ++pss) {
                    const int k = pss * 16 + (tid >> 4), n4 = (tid & 15) * 4;
                    const f32x4 v = *(const f32x4*)(p.w_router + (size_t)(k0 + k) * NE + n4);
                    tile[k * 65 + n4 + 0] = v[0]; tile[k * 65 + n4 + 1] = v[1]; tile[k * 65 + n4 + 2] = v[2]; tile[k * 65 + n4 + 3] = v[3];
                }
                __syncthreads();
                {
                    const int n = tid >> 2, kc = (tid & 3) * 16;
                    unsigned wh[8], wl[8];
#pragma unroll
                    for (int i = 0; i < 8; ++i) {
                        const float a = tile[(kc + 2 * i) * 65 + n], b = tile[(kc + 2 * i + 1) * 65 + n];
                        const unsigned ha = f2bf(a), hb = f2bf(b);
                        wh[i] = ha | (hb << 16);
                        wl[i] = pk2(a - bf2f(ha), b - bf2f(hb));
                    }
                    bf16_t* dh = (bf16_t*)(p.ws + OFF_WRH) + (size_t)n * D + k0 + kc;
                    bf16_t* dl = (bf16_t*)(p.ws + OFF_WRL) + (size_t)n * D + k0 + kc;
                    *(u32x4*)dh = (u32x4){wh[0], wh[1], wh[2], wh[3]}; *(u32x4*)(dh + 8) = (u32x4){wh[4], wh[5], wh[6], wh[7]};
                    *(u32x4*)dl = (u32x4){wl[0], wl[1], wl[2], wl[3]}; *(u32x4*)(dl + 8) = (u32x4){wl[4], wl[5], wl[6], wl[7]};
                }
                __syncthreads();
            }
        }
    }
    __syncthreads();
    {
        const int lane = hw_tid() & 63, wv = hw_tid() >> 6;
        LAS float* scr = (LAS float*)(lds - (hw_tid() >> 8) * 32768) + wv * (64 * 33);
        constexpr int NHERE = TR_N_A + (TR_N_GU - TR_GU_LATE);
        { const int w0 = blockIdx.x * 8 + wv, nw = gridDim.x * 8; transpose_run(p, scr, lane, w0 < NHERE ? (NHERE - w0 + nw - 1) / nw : 0, [=](int k) { const int it = w0 + k * nw; return it < TR_N_A ? it : it + TR_GU_LATE; }); }
    }
}

__device__ __forceinline__ void phase_xn(const Params& p) {
    const int lane = TIDX & 63, gw = VBLK * 4 + (TIDX >> 6), ngw = NVBLK * 4;
    const float* mod = (const float*)(p.ws + OFF_MOD);
    bf16_t* XN = (bf16_t*)(p.ws + OFF_XN);
    for (int row = gw; row < T + TC; row += ngw) {
        const float* src = row < T ? p.x + (size_t)row * D : p.ctx + (size_t)(row - T) * D;
        const float* mr = mod + (size_t)(row < T ? row / SEQ : 16) * MODW;
#pragma unroll
        for (int j = 0; j < 4; ++j) {
            const int c = 4 * lane + 256 * j;
            const f32x4 v = *(const f32x4*)(src + c), sh = *(const f32x4*)(mr + c), sc = *(const f32x4*)(mr + D + c);
            u32x2 o; o.x = pk2(v[0] * (1.f + sc[0]) + sh[0], v[1] * (1.f + sc[1]) + sh[1]); o.y = pk2(v[2] * (1.f + sc[2]) + sh[2], v[3] * (1.f + sc[3]) + sh[3]);
            *(u32x2*)(XN + (size_t)row * D + c) = o;
        }
    }
}

struct EpiIn {
    static constexpr bool PERM = true;
    const float *q_norm, *k_norm, *rope; bf16_t *Qb, *Kb, *Vb, *Ub;
    __device__ __forceinline__ void operator()(const f32x4 (&acc)[2][2][4][2], const pg8::Unit& u, int wr, int wc, int fr, int fq) const {
        const int grp = u.pn * 4 + wc;
        const bool is_ctx = u.pm >= T / 256;
        f32x4 gn[2][2];
        if (grp >= 4 && grp < 20) {
            const float* g = grp < 16 ? q_norm : k_norm;
#pragma unroll
            for (int bj = 0; bj < 2; ++bj)
#pragma unroll
                for (int n = 0; n < 2; ++n) gn[bj][n] = *(const f32x4*)(g + 32 * bj + 8 * fq + 4 * n);
        }
#pragma unroll
        for (int ai = 0; ai < 2; ++ai)
#pragma unroll
            for (int m = 0; m < 4; ++m) {
                const int row = u.pm * 256 + ai * 128 + wr * 64 + m * 16 + fr;
                f32x4 v[2][2];
#pragma unroll
                for (int bj = 0; bj < 2; ++bj)
#pragma unroll
                    for (int n = 0; n < 2; ++n) v[bj][n] = acc[ai][bj][m][n];
                bf16_t* dst;
                if (grp < 4) dst = Ub + (size_t)row * 256 + grp * 64;
                else if (grp < 16) dst = Qb + (size_t)row * 768 + (grp - 4) * 64;
                else {
                    const size_t krow = is_ctx ? (size_t)((row - T) >> 8) * KVL + ((row - T) & 255) : (size_t)(row >> 11) * KVL + CTXL + (row & (SEQ - 1));
                    dst = (grp < 20 ? Kb + (grp - 16) * 64 : Vb + (grp - 20) * 64) + krow * 256;
                }
                if (grp >= 4 && grp < 20) {
                    float ss = 0.f;
#pragma unroll
                    for (int bj = 0; bj < 2; ++bj)
#pragma unroll
                        for (int n = 0; n < 2; ++n) ss += (v[bj][n][0] * v[bj][n][0] + v[bj][n][1] * v[bj][n][1]) + (v[bj][n][2] * v[bj][n][2] + v[bj][n][3] * v[bj][n][3]);
                    ss += __shfl_xor(ss, 16); ss += __shfl_xor(ss, 32);
                    const float rs = 1.0f / sqrtf(ss * (1.f / 64.f) + 1e-6f);
#pragma unroll
                    for (int bj = 0; bj < 2; ++bj)
#pragma unroll
                        for (int n = 0; n < 2; ++n) v[bj][n] = v[bj][n] * rs * gn[bj][n];
                    if (!is_ctx) {
                        const int tpos = row & (SEQ - 1);
#pragma unroll
                        for (int bj = 0; bj < 2; ++bj)
#pragma unroll
                            for (int n = 0; n < 2; ++n) {
                                const f32x4 cs = *(const f32x4*)(rope + (size_t)(tpos * 32 + 16 * bj + 4 * fq + 2 * n) * 2);
                                const f32x4 x = v[bj][n];
                                v[bj][n] = (f32x4){x[0] * cs[0] - x[1] * cs[1], x[0] * cs[1] + x[1] * cs[0], x[2] * cs[2] - x[3] * cs[3], x[2] * cs[3] + x[3] * cs[2]};
                            }
                    }
                    if (grp < 16) {
#pragma unroll
                        for (int bj = 0; bj < 2; ++bj)
#pragma unroll
                            for (int n = 0; n < 2; ++n) v[bj][n] = v[bj][n] * C2;
                    }
                }
#pragma unroll
                for (int bj = 0; bj < 2; ++bj) {
                    u32x4 w; w.x = pk2(v[bj][0][0], v[bj][0][1]); w.y = pk2(v[bj][0][2], v[bj][0][3]); w.z = pk2(v[bj][1][0], v[bj][1][1]); w.w = pk2(v[bj][1][2], v[bj][1][3]);
                    *(u32x4*)(dst + 32 * bj + 8 * fq) = w;
                }
            }
    }
};
__device__ __forceinline__ int vcu_of_block() { const int G = gridDim.x, bx = blockIdx.x; return (G % 8 == 0) ? (bx % 8) * (G / 8) + bx / 8 : bx; }
__device__ __forceinline__ void phase_inproj(const Params& p, LAS unsigned char* lds) {
    pg8::Gemm g{(const bf16_t*)(p.ws + OFF_XN), (const bf16_t*)(p.ws + OFF_WTIN), p.ws, 0};
    pg8::DenseSched S{6, 768, 800, 4, 2, (int)gridDim.x, vcu_of_block()};
    EpiIn E{p.q_norm, p.k_norm, (const float*)(p.ws + OFF_ROPE), (bf16_t*)(p.ws + OFF_Q), (bf16_t*)(p.ws + OFF_K), (bf16_t*)(p.ws + OFF_V), (bf16_t*)(p.ws + OFF_U)};
    pg8::gemm_phase<D, EpiIn, pg8::DenseSched, false>(lds, g, S, E);
    {
        const int v = vcu_of_block(), G = gridDim.x, nbusy = 800 - 3 * G;
        if (G == 256 ? v >= nbusy : true) {
            const int lane = hw_tid() & 63, wv = hw_tid() >> 6, nw = (G == 256 ? G - nbusy : G) * 8, w = (G == 256 ? v - nbusy : v) * 8 + wv;
            LAS float* scr = (LAS float*)lds + wv * (64 * 33);
            transpose_run(p, scr, lane, w < TR_GU_LATE ? (TR_GU_LATE - w + nw - 1) / nw : 0, [=](int k) { return TR_N_A + w + k * nw; });
        }
    }
}

namespace attn_body {
using bf16=unsigned short;
using bf16x8=__attribute__((ext_vector_type(8)))short;
using s16x4=__attribute__((ext_vector_type(4)))short;
using f32x16=__attribute__((ext_vector_type(16)))float;
using u32x4=__attribute__((ext_vector_type(4)))unsigned;
constexpr int D=64,QP=768,KP=256,OP=1024,SEQ=2048,KVLEN=2304;
constexpr int NW=8,QBLK=32,QB=QBLK*NW,KVBLK=64,NT=KVLEN/KVBLK;
__device__ __forceinline__ int crow(int r,int hi){return (r&3)+8*(r>>2)+4*hi;}
#define SBAR() __builtin_amdgcn_sched_barrier(0)
constexpr int NSLOT=3, SLOTB=8192;
constexpr int LDS_K=0, LDS_V=NSLOT*SLOTB, LDS_WS=2*NSLOT*SLOTB, LDS_OST=LDS_WS+NW*64*4, LDS_BYTES=LDS_OST+NW*4096;
constexpr float C2=0.125f*1.4426950408889634f;
__device__ __forceinline__ void glds16(const void*gsrc,unsigned lds_dst){unsigned keep;
  asm volatile("s_mov_b32 %0, m0\n\ts_mov_b32 m0, %2\n\ts_nop 0\n\tglobal_load_lds_dwordx4 %1, off\n\ts_mov_b32 m0, %0":"=&s"(keep):"v"(gsrc),"s"(lds_dst):"memory");}
__device__ __forceinline__ float max3f(float a,float b,float c){float r;asm("v_max3_f32 %0, %1, %2, %3":"=v"(r):"v"(a),"v"(b),"v"(c));return r;}
__device__ __forceinline__ float max2f(float a,float b){float r;asm("v_max_f32_e32 %0, %1, %2":"=v"(r):"v"(a),"v"(b));return r;}
__device__ __forceinline__ float fadd_s(float a,float b){float r;asm("v_add_f32_e32 %0, %1, %2":"=v"(r):"v"(a),"v"(b));return r;}
__device__ __forceinline__ float fsub_s(float a,float b){float r;asm("v_sub_f32_e32 %0, %1, %2":"=v"(r):"v"(a),"v"(b));return r;}
typedef float f32x2_t __attribute__((ext_vector_type(2))); typedef __bf16 bf16x2_t __attribute__((ext_vector_type(2)));
__device__ __forceinline__ unsigned cvtpk_s(float lo,float hi){f32x2_t v={lo,hi};bf16x2_t b=__builtin_convertvector(v,bf16x2_t);return __builtin_bit_cast(unsigned,b);}
#define WAIT_BAR(N) asm volatile("s_waitcnt vmcnt(" #N ") lgkmcnt(0)\n\ts_barrier":::"memory")

__device__ __forceinline__ void qkt(f32x16&p0,f32x16&p1,const char*Kslot,const bf16x8*qr,const f32x16&negm,int r32,int hi){
  const char*kb=Kslot+hi*1024+r32*16;
  #pragma unroll
  for(int d0=0;d0<4;++d0){
    const bf16x8 b0=*reinterpret_cast<const bf16x8*>(kb+d0*2048);
    const bf16x8 b1=*reinterpret_cast<const bf16x8*>(kb+d0*2048+512);
    if(d0==0){p0=__builtin_amdgcn_mfma_f32_32x32x16_bf16(b0,qr[0],negm,0,0,0);p1=__builtin_amdgcn_mfma_f32_32x32x16_bf16(b1,qr[0],negm,0,0,0);}
    else{p0=__builtin_amdgcn_mfma_f32_32x32x16_bf16(b0,qr[d0],p0,0,0,0);p1=__builtin_amdgcn_mfma_f32_32x32x16_bf16(b1,qr[d0],p1,0,0,0);}}
}
typedef __attribute__((address_space(3))) const char* lds_cptr;
typedef short v4i16_t __attribute__((ext_vector_type(4)));
__device__ __forceinline__ void kload8(bf16x8*kf,lds_cptr kp){
  kf[0]=*(const __attribute__((address_space(3))) bf16x8*)(kp);      kf[1]=*(const __attribute__((address_space(3))) bf16x8*)(kp+512);
  kf[2]=*(const __attribute__((address_space(3))) bf16x8*)(kp+2048); kf[3]=*(const __attribute__((address_space(3))) bf16x8*)(kp+2560);
  kf[4]=*(const __attribute__((address_space(3))) bf16x8*)(kp+4096); kf[5]=*(const __attribute__((address_space(3))) bf16x8*)(kp+4608);
  kf[6]=*(const __attribute__((address_space(3))) bf16x8*)(kp+6144); kf[7]=*(const __attribute__((address_space(3))) bf16x8*)(kp+6656);
}
__device__ __forceinline__ void kload2(bf16x8*kf,lds_cptr kp,int j){ kf[2*j]=*(const __attribute__((address_space(3))) bf16x8*)(kp+j*2048); kf[2*j+1]=*(const __attribute__((address_space(3))) bf16x8*)(kp+j*2048+512); }
__device__ __forceinline__ s16x4 vtr(lds_cptr p){ return __builtin_bit_cast(s16x4,__builtin_amdgcn_ds_read_tr16_b64_v4i16((__attribute__((address_space(3))) v4i16_t*)p)); }
__device__ __forceinline__ float rowmax(const f32x16&p0,const f32x16&p1){
  float a=max3f(p0[0],p0[1],p1[0]),b=max3f(p0[2],p0[3],p1[1]);a=max3f(a,p1[2],p1[3]);
  #pragma unroll
  for(int r=4;r<16;r+=4){a=max3f(a,p0[r],p0[r+1]);b=max3f(b,p0[r+2],p0[r+3]);a=max3f(a,p1[r],p1[r+1]);b=max3f(b,p1[r+2],p1[r+3]);}
  const float m=max2f(a,b);
  auto rr=__builtin_amdgcn_permlane32_swap(__float_as_uint(m),__float_as_uint(m),false,false);
  return max2f(__uint_as_float(rr[0]),__uint_as_float(rr[1]));
}
__device__ __forceinline__ void pv(f32x16*o,int vb,bf16x8 pa0,bf16x8 pa1,bf16x8 pa2,bf16x8 pa3){
  #pragma unroll
  for(int d0=0;d0<2;++d0){s16x4 lo[4],hi[4];
    #pragma unroll
    for(int ks=0;ks<4;++ks){
      asm volatile("ds_read_b64_tr_b16 %0,%1 offset:%c2":"=&v"(lo[ks]):"v"(vb),"i"(d0*4096+ks*1024):"memory");
      asm volatile("ds_read_b64_tr_b16 %0,%1 offset:%c2":"=&v"(hi[ks]):"v"(vb),"i"(d0*4096+ks*1024+512):"memory");}
    asm volatile("s_waitcnt lgkmcnt(0)":::"memory");SBAR();
    #define PK(k) (bf16x8){lo[k][0],lo[k][1],lo[k][2],lo[k][3],hi[k][0],hi[k][1],hi[k][2],hi[k][3]}
    o[d0]=__builtin_amdgcn_mfma_f32_32x32x16_bf16(pa0,PK(0),o[d0],0,0,0);
    o[d0]=__builtin_amdgcn_mfma_f32_32x32x16_bf16(pa1,PK(1),o[d0],0,0,0);
    o[d0]=__builtin_amdgcn_mfma_f32_32x32x16_bf16(pa2,PK(2),o[d0],0,0,0);
    o[d0]=__builtin_amdgcn_mfma_f32_32x32x16_bf16(pa3,PK(3),o[d0],0,0,0);
    #undef PK
  }
}

#ifndef ATTN_STORE16
#define ATTN_STORE16(p,v) (*(u32x4*)(p)=(v))
#endif
template<int THRL> __device__ __forceinline__ void attn_unit(int b,int h,int qb,const bf16*Q,const bf16*__restrict__ K,const bf16*__restrict__ V,bf16*O,char*shm){
  const int tid=hw_tid(),lane=tid&63,r32=lane&31,hi=lane>>5; const int wid=__builtin_amdgcn_readfirstlane(tid>>6);
  const long rowbase=(long)b*SEQ, kvbase=(long)b*KVLEN; const int q0=qb*QB, kh=h/3;
  const bf16*Qw=Q+(rowbase+q0+wid*QBLK)*QP+h*D;
  const bf16*Kh=K+kvbase*KP+kh*D,*Vh=V+kvbase*KP+kh*D;
  const unsigned lds0=(unsigned)(uintptr_t)shm;
  float*wsf=(float*)(shm+LDS_WS)+wid*64;
  const bf16*ksrc=Kh+(long)lane*KP+wid*8;
  const bf16*vsrc=Vh+(long)(16*(wid&3)+(lane>>2))*KP+(wid>>2)*32+(lane&3)*8;
  const unsigned kdst=lds0+LDS_K+wid*1024, vdst=lds0+LDS_V+wid*1024;
  #define DMA_K(t,slot) glds16(ksrc+(long)(t)*KVBLK*KP,(unsigned)__builtin_amdgcn_readfirstlane(kdst+(slot)))
  #define DMA_V(t,slot) glds16(vsrc+(long)(t)*KVBLK*KP,(unsigned)__builtin_amdgcn_readfirstlane(vdst+(slot)))
  const int vb0=(int)(lds0+LDS_V)+((lane>>4)&1)*32+(lane&3)*8+(4*hi+((lane&15)>>2))*64;
  const char*Kbase=shm+LDS_K; bf16x8 kf[8];
  const lds_cptr shm3=(lds_cptr)shm; const lds_cptr kp0=shm3+LDS_K+hi*1024+r32*16; const lds_cptr vp0=shm3+LDS_V+((lane>>4)&1)*32+(lane&3)*8+(4*hi+((lane&15)>>2))*64;
  DMA_K(0,0);DMA_V(0,0);DMA_K(1,SLOTB);
  bf16x8 qr[4];
  #pragma unroll
  for(int d0=0;d0<4;++d0)qr[d0]=*reinterpret_cast<const bf16x8*>(&Qw[(long)r32*QP+d0*16+hi*8]);
  float mhat=0.f,l_reg=0.f;f32x16 o[2];o[0]=f32x16{};o[1]=f32x16{};f32x16 negm=f32x16{};asm volatile("":"+v"(negm));
  #define CMASK(P0,P1,t) do{}while(0)
  bool resc=false;
  #define START(P0,P1) do{ const float rm=rowmax(P0,P1); resc=false; \
    { const float dl=rm; mhat=fadd_s(mhat,dl); \
      _Pragma("unroll") for(int r=0;r<16;++r){P0[r]=fsub_s(P0[r],dl);P1[r]=fsub_s(P1[r],dl);} \
      _Pragma("unroll") for(int r=0;r<16;++r)negm[r]=-mhat; asm volatile("":"+v"(negm)); } \
    _Pragma("unroll") for(int r=0;r<16;++r)P0[r]=__builtin_amdgcn_exp2f(P0[r]); }while(0)
  #define RESC() do{ if(resc){ asm volatile("s_waitcnt lgkmcnt(0)":::"memory"); \
      _Pragma("unroll") for(int d_=0;d_<2;++d_) _Pragma("unroll") for(int r=0;r<16;++r)o[d_][r]*=wsf[crow(r,hi)]; } }while(0)
  f32x16 pA0,pA1,pB0,pB1;
  int sl_prev=0,sl_cur=0,sl_next=SLOTB;
  #define ROT() do{sl_prev=sl_cur;sl_cur=sl_next;sl_next=(sl_next==(NSLOT-1)*SLOTB)?0:sl_next+SLOTB;}while(0)
  DMA_K(2,2*SLOTB);
  WAIT_BAR(3);
  qkt(pA0,pA1,Kbase,qr,negm,r32,hi);asm volatile("s_nop 15\n\ts_nop 7":"+v"(pA0),"+v"(pA1));CMASK(pA0,pA1,0);
  START(pA0,pA1);
  _Pragma("unroll") for(int r=0;r<16;++r)pA1[r]=__builtin_amdgcn_exp2f(pA1[r]);
  WAIT_BAR(0);
  DMA_K(3,0);DMA_V(1,SLOTB);
  ROT();
  kload8(kf,kp0+sl_cur);
  WAIT_BAR(2);
  s16x4 vlo[8],vhi[8]; u32x4 pw0,pw1,pw2,pw3;
  #define PKW(P,B) cvtpk_s(P[B],P[B+1])
  #define PAF(k) __builtin_bit_cast(bf16x8,pw##k)
  #define VFR(i) (bf16x8){vlo[i][0],vlo[i][1],vlo[i][2],vlo[i][3],vhi[i][0],vhi[i][1],vhi[i][2],vhi[i][3]}
  #define PIN(x) asm volatile("":"+v"(x))
  #define MX3(a,b,c) __builtin_fmaxf(__builtin_fmaxf((a),(b)),(c))
  #define GAPA(MF,A0,A1,A2,A3,W0,W1,PW) do{ MF; sacc+=A0; sacc+=A1; sacc+=A2; sacc+=A3; PIN(sacc); W0; W1; PIN(PW); SBAR(); }while(0)
  #define EX(v) __builtin_amdgcn_exp2f(v)
  #define GAPB(MF,X,B) do{ MF; X[B]=EX(X[B]); X[B+1]=EX(X[B+1]); X[B+2]=EX(X[B+2]); X[B+3]=EX(X[B+3]); PIN(X); SBAR(); }while(0)
  #define VRD(i) do{ vlo[i]=vtr(vp_+(((i)>>2)*4096+((i)&3)*1024)); vhi[i]=vtr(vp_+(((i)>>2)*4096+((i)&3)*1024+512)); }while(0)
  #define KRD(G,j) do{ if(G){ kload2(kf,kp0+sl_next,j); SBAR(); } }while(0)
  #define STEP(C0,C1,P0,P1,t,GK,GV,GL) do{ SBAR(); \
    const lds_cptr vp_=vp0+sl_prev; \
    VRD(0); SBAR(); float sacc=(P0[0]+P0[1]); \
    GAPA(C0=__builtin_amdgcn_mfma_f32_32x32x16_bf16(kf[0],qr[0],negm,0,0,0), P0[2],P0[3],P0[4],P0[5],     pw0[0]=PKW(P0,0), pw0[1]=PKW(P0,2), pw0); \
    VRD(4); SBAR(); GAPA(C1=__builtin_amdgcn_mfma_f32_32x32x16_bf16(kf[1],qr[0],negm,0,0,0), P0[6],P0[7],P0[8],P0[9],     pw0[2]=PKW(P0,4), pw0[3]=PKW(P0,6), pw0); \
    VRD(1); SBAR(); GAPA(C0=__builtin_amdgcn_mfma_f32_32x32x16_bf16(kf[2],qr[1],C0,0,0,0),   P0[10],P0[11],P0[12],P0[13], pw1[0]=PKW(P0,8), pw1[1]=PKW(P0,10), pw1); \
    VRD(5); SBAR(); GAPA(C1=__builtin_amdgcn_mfma_f32_32x32x16_bf16(kf[3],qr[1],C1,0,0,0),   P0[14],P0[15],P1[0],P1[1],   pw1[2]=PKW(P0,12),pw1[3]=PKW(P0,14), pw1); \
    VRD(2); SBAR(); GAPA(C0=__builtin_amdgcn_mfma_f32_32x32x16_bf16(kf[4],qr[2],C0,0,0,0),   P1[2],P1[3],P1[4],P1[5],     pw2[0]=PKW(P1,0), pw2[1]=PKW(P1,2), pw2); \
    VRD(6); SBAR(); GAPA(C1=__builtin_amdgcn_mfma_f32_32x32x16_bf16(kf[5],qr[2],C1,0,0,0),   P1[6],P1[7],P1[8],P1[9],     pw2[2]=PKW(P1,4), pw2[3]=PKW(P1,6), pw2); \
    VRD(3); SBAR(); GAPA(C0=__builtin_amdgcn_mfma_f32_32x32x16_bf16(kf[6],qr[3],C0,0,0,0),   P1[10],P1[11],P1[12],P1[13], pw3[0]=PKW(P1,8), pw3[1]=PKW(P1,10), pw3); \
    VRD(7); SBAR(); GAPA(C1=__builtin_amdgcn_mfma_f32_32x32x16_bf16(kf[7],qr[3],C1,0,0,0),   P1[14],P1[15],0.f,0.f,       pw3[2]=PKW(P1,12),pw3[3]=PKW(P1,14), pw3); \
    l_reg+=sacc; \
    if(GK){DMA_K((t)+3,sl_cur);} if(GV){DMA_V((t)+1,sl_next);} \
    CMASK(C0,C1,t); \
    { float a=MX3(C0[0],C0[1],C1[0]),b=MX3(C0[2],C0[3],C1[1]); a=MX3(a,C1[2],C1[3]); \
      _Pragma("unroll") for(int r=4;r<16;r+=4){a=MX3(a,C0[r],C0[r+1]);b=MX3(b,C0[r+2],C0[r+3]);a=MX3(a,C1[r],C1[r+1]);b=MX3(b,C1[r+2],C1[r+3]);} \
      float rm=__builtin_fmaxf(a,b); { auto rr=__builtin_amdgcn_permlane32_swap(__float_as_uint(rm),__float_as_uint(rm),false,false); rm=__builtin_fmaxf(__uint_as_float(rr[0]),__uint_as_float(rr[1])); } \
      resc=false; \
      if(__builtin_expect(__any(rm>(float)THRL),0)){ const float dl=__builtin_fmaxf(rm,0.f); mhat+=dl; \
        _Pragma("unroll") for(int r=0;r<16;++r){C0[r]-=dl;C1[r]-=dl;} \
        _Pragma("unroll") for(int r=0;r<16;++r)negm[r]=-mhat; asm volatile("":"+v"(negm)); \
        const float f=__builtin_amdgcn_exp2f(-dl); l_reg*=f; if(hi==0)wsf[r32]=f; resc=true; } } \
    SBAR(); \
    GAPB(o[0]=__builtin_amdgcn_mfma_f32_32x32x16_bf16(PAF(0),VFR(0),o[0],0,0,0), C0,0); \
    GAPB(o[1]=__builtin_amdgcn_mfma_f32_32x32x16_bf16(PAF(0),VFR(4),o[1],0,0,0), C0,4); \
    KRD(GL,0); GAPB(o[0]=__builtin_amdgcn_mfma_f32_32x32x16_bf16(PAF(1),VFR(1),o[0],0,0,0), C0,8); \
    KRD(GL,1); GAPB(o[1]=__builtin_amdgcn_mfma_f32_32x32x16_bf16(PAF(1),VFR(5),o[1],0,0,0), C0,12); \
    KRD(GL,2); GAPB(o[0]=__builtin_amdgcn_mfma_f32_32x32x16_bf16(PAF(2),VFR(2),o[0],0,0,0), C1,0); \
    KRD(GL,3); GAPB(o[1]=__builtin_amdgcn_mfma_f32_32x32x16_bf16(PAF(2),VFR(6),o[1],0,0,0), C1,4); \
    GAPB(o[0]=__builtin_amdgcn_mfma_f32_32x32x16_bf16(PAF(3),VFR(3),o[0],0,0,0), C1,8); \
    GAPB(o[1]=__builtin_amdgcn_mfma_f32_32x32x16_bf16(PAF(3),VFR(7),o[1],0,0,0), C1,12); \
    }while(0)
  int t=1;
  for(;t+5<NT;t+=2){
    STEP(pB0,pB1,pA0,pA1,t,true,true,true);     WAIT_BAR(2); RESC(); ROT();
    STEP(pA0,pA1,pB0,pB1,t+1,true,true,true);   WAIT_BAR(2); RESC(); ROT();
  }
  #define ENDW(tt) do{ if((tt)+3<NT){WAIT_BAR(2);} else if((tt)+2<NT){WAIT_BAR(1);} else {WAIT_BAR(0);} }while(0)
  for(;t+1<NT;t+=2){
    STEP(pB0,pB1,pA0,pA1,t,(t+3<NT),(t+1<NT),(t+1<NT));       ENDW(t);   RESC(); ROT();
    STEP(pA0,pA1,pB0,pB1,t+1,(t+4<NT),(t+2<NT),(t+2<NT));     ENDW(t+1); RESC(); ROT();
  }
  STEP(pB0,pB1,pA0,pA1,NT-1,false,false,false); RESC();
  { float sacc=pB0[0]+pB0[1]; _Pragma("unroll") for(int r=2;r<16;++r)sacc+=pB0[r]; _Pragma("unroll") for(int r=0;r<16;++r)sacc+=pB1[r]; l_reg+=sacc;
    pw0=(u32x4){PKW(pB0,0),PKW(pB0,2),PKW(pB0,4),PKW(pB0,6)};pw1=(u32x4){PKW(pB0,8),PKW(pB0,10),PKW(pB0,12),PKW(pB0,14)};pw2=(u32x4){PKW(pB1,0),PKW(pB1,2),PKW(pB1,4),PKW(pB1,6)};pw3=(u32x4){PKW(pB1,8),PKW(pB1,10),PKW(pB1,12),PKW(pB1,14)};
    SBAR(); pv(o,vb0+sl_cur,PAF(0),PAF(1),PAF(2),PAF(3)); }
  #undef PKW
  #undef PAF
  #undef VFR
  #undef PIN
  #undef MX3
  #undef GAPA
  #undef GAPB
  #undef EX
  #undef VRD
  #undef KRD
  #undef STEP
  #undef ENDW
  {auto rr=__builtin_amdgcn_permlane32_swap(__float_as_uint(l_reg),__float_as_uint(l_reg),false,false);l_reg=__uint_as_float(rr[0])+__uint_as_float(rr[1]);}
  if(hi==0)wsf[32+r32]=l_reg;asm volatile("s_waitcnt lgkmcnt(0)":::"memory");
  float rli[16];
  #pragma unroll
  for(int r=0;r<16;++r)rli[r]=__builtin_amdgcn_rcpf(wsf[32+crow(r,hi)]);
  bf16*Ow=O+(rowbase+q0+wid*QBLK)*OP+h*D;
  { bf16*stg=(bf16*)(shm+LDS_OST)+wid*2048;
    #pragma unroll
    for(int r=0;r<16;++r){const int orow=crow(r,hi);
      #pragma unroll
      for(int d0=0;d0<2;++d0)stg[orow*64+d0*32+r32]=(bf16)f2bf(o[d0][r]*rli[r]);}
    asm volatile("s_waitcnt lgkmcnt(0)":::"memory");
    #pragma unroll
    for(int i=0;i<4;++i){const int row=i*8+(lane>>3),ch=lane&7; const u32x4 v=*(const u32x4*)(stg+row*64+ch*8); ATTN_STORE16(Ow+(long)row*OP+ch*8,v);} }
  asm volatile("s_waitcnt lgkmcnt(0)\n\ts_barrier":::"memory");
  #undef DMA_K
  #undef DMA_V
  #undef CMASK
  #undef START
  #undef RESC
  #undef ROT
}
constexpr int ATTN_LDS_BYTES=LDS_BYTES;
struct AttnTensors { const bf16* Q; const bf16* K; const bf16* V; bf16* O; };
template<int THRL=8> __device__ __forceinline__ void attn_phase(char*lds,const AttnTensors&T){
  const int G=gridDim.x, bx=blockIdx.x, v=(G%8==0)?(bx%8)*(G/8)+bx/8:bx;
  for(int u=v;u<16*12*8;u+=G){
    const int pair=(u%256)/4, j=((u%256)%4)*6+u/256;
    const int b=pair>>2, kh=pair&3, g=j>>3, qb=j&7;
    attn_unit<THRL>(b,kh*3+g,qb,T.Q,T.K,T.V,T.O,lds);
  }
}
#undef SBAR
#undef WAIT_BAR
}

__device__ __forceinline__ void pool_item(const Params& p, LAS unsigned char* lds, int item, bool stage_w) {
    const int tid = TIDX, lane = tid & 63, wid = tid >> 6, r16 = lane & 15, q = lane >> 4;
    const int gi = item & 3, tile = item >> 2, t0 = tile * 64, b = t0 / SEQ, tl0 = t0 % SEQ, half = 1 << gi;
    const bf16_t* Ub = (const bf16_t*)(p.ws + OFF_U);
    bf16_t* AO = (bf16_t*)(p.ws + OFF_AO);
    LAS bf16_t* us = (LAS bf16_t*)lds;
    LAS bf16_t* dl = (LAS bf16_t*)(lds + 11520);
    LAS bf16_t* wt = (LAS bf16_t*)(lds + 11520 + 9216);
    __syncthreads();
    for (int i = tid; i < 80 * 8; i += 256) {
        const int r = i >> 3, ch = i & 7, tl = tl0 - 8 + r;
        u32x4 v = {0u, 0u, 0u, 0u};
        if (tl >= 0 && tl < SEQ) v = *(const u32x4*)(Ub + (size_t)(b * SEQ + tl) * 256 + gi * 64 + ch * 8);
        *(LAS u32x4*)(us + r * 72 + ch * 8) = v;
    }
    if (stage_w) {
#pragma unroll 4
        for (int k = 0; k < 16; ++k) {
            const int i = tid + 256 * k, c = i >> 6, dd = i & 63;
            wt[dd * 72 + c] = (bf16_t)f2bf(p.pool_w[gi * 4096 + i] * p.pool_scale[gi * 64 + dd]);
        }
    }
    __syncthreads();
    {
        const int c = tid & 63, seg = tid >> 6;
        int tl = tl0 + seg * 16;
        float sm = 0.f;
        for (int r = max(tl - half, 0); r < min(tl + half, SEQ); ++r) sm += bf2f(us[(r - tl0 + 8) * 72 + c]);
#pragma unroll
        for (int k = 0; k < 16; ++k, ++tl) {
            if (k > 0) {
                if (tl + half <= SEQ) sm += bf2f(us[(tl + half - 1 - tl0 + 8) * 72 + c]);
                if (tl - half > 0) sm -= bf2f(us[(tl - half - 1 - tl0 + 8) * 72 + c]);
            }
            const int cntw = min(tl + half, SEQ) - max(tl - half, 0);
            dl[(seg * 16 + k) * 72 + c] = (bf16_t)f2bf(sm / (float)cntw - bf2f(us[(tl - tl0 + 8) * 72 + c]));
        }
    }
    __syncthreads();
    {
        f32x4 acc[4];
#pragma unroll
        for (int nb = 0; nb < 4; ++nb) acc[nb] = (f32x4){0.f, 0.f, 0.f, 0.f};
#pragma unroll
        for (int ks = 0; ks < 2; ++ks) {
            const bf16x8 db = *(const LAS bf16x8*)(dl + (wid * 16 + r16) * 72 + ks * 32 + q * 8);
#pragma unroll
            for (int nb = 0; nb < 4; ++nb) {
                const bf16x8 wa = *(const LAS bf16x8*)(wt + (nb * 16 + r16) * 72 + ks * 32 + q * 8);
                acc[nb] = __builtin_amdgcn_mfma_f32_16x16x32_bf16(wa, db, acc[nb], 0, 0, 0);
            }
        }
        bf16_t* orow = AO + (size_t)(t0 + wid * 16 + r16) * D + gi * 64 + 4 * q;
#pragma unroll
        for (int nb = 0; nb < 4; ++nb) { u32x2 w; w.x = pk2(acc[nb][0], acc[nb][1]); w.y = pk2(acc[nb][2], acc[nb][3]); *(u32x2*)(orow + nb * 16) = w; }
    }
}

__device__ __forceinline__ void phase_attn_pool(const Params& p, LAS unsigned char* lds, char* smem) {
    const attn_body::AttnTensors AT{(const bf16_t*)(p.ws + OFF_Q), (const bf16_t*)(p.ws + OFF_K), (const bf16_t*)(p.ws + OFF_V), (bf16_t*)(p.ws + OFF_AO) + 256};
    attn_body::attn_phase<8>(smem, AT);
    __syncthreads();
    constexpr int N_POOL = (T / 64) * 4;
    { bool first = true; for (int it = VBLK; it < N_POOL; it += NVBLK) { pool_item(p, lds, it, first); first = false; } }
}

struct EpiOut {
    static constexpr bool PERM = false;
    const float* x; float* y; const float* mod; float* stats;
    __device__ __forceinline__ void operator()(const f32x4 (&acc)[2][2][4][2], const pg8::Unit& u, int wr, int wc, int fr, int fq) const {
        const float* g1 = mod + (size_t)(u.pm >> 3) * MODW + 2 * D;
        const int col0 = u.pn * 256 + wc * 32 + fq * 4;
        f32x4 gv[2][2];
#pragma unroll
        for (int bj = 0; bj < 2; ++bj)
#pragma unroll
            for (int n = 0; n < 2; ++n) gv[bj][n] = *(const f32x4*)(g1 + col0 + bj * 128 + n * 16);
        f32x4 xv[2][2][2];
        const size_t rstride = (size_t)16 * D;
        const float* xb = x + (size_t)(u.pm * 256 + wr * 64 + fr) * D + col0;
        float* yb = y + (size_t)(u.pm * 256 + wr * 64 + fr) * D + col0;
#pragma unroll
        for (int bj = 0; bj < 2; ++bj)
#pragma unroll
            for (int n = 0; n < 2; ++n) xv[0][bj][n] = *(const f32x4*)(xb + bj * 128 + n * 16);
#pragma unroll
        for (int k = 0; k < 8; ++k) {
            const int ai = k >> 2, m = k & 3;
            const size_t roff = (size_t)ai * 128 * D + (size_t)m * rstride;
            if (k < 7) {
                const size_t noff = (size_t)((k + 1) >> 2) * 128 * D + (size_t)((k + 1) & 3) * rstride;
#pragma unroll
                for (int bj = 0; bj < 2; ++bj)
#pragma unroll
                    for (int n = 0; n < 2; ++n) xv[(k + 1) & 1][bj][n] = *(const f32x4*)(xb + noff + bj * 128 + n * 16);
            }
            const int row = u.pm * 256 + ai * 128 + wr * 64 + m * 16 + fr;
            float s1 = 0.f, s2 = 0.f;
#pragma unroll
            for (int bj = 0; bj < 2; ++bj)
#pragma unroll
                for (int n = 0; n < 2; ++n) {
                    const f32x4 yv = xv[k & 1][bj][n] * ALPHA + gv[bj][n] * acc[ai][bj][m][n];
                    *(f32x4*)(yb + roff + bj * 128 + n * 16) = yv;
                    s1 += (yv[0] + yv[1]) + (yv[2] + yv[3]);
                    s2 += (yv[0] * yv[0] + yv[1] * yv[1]) + (yv[2] * yv[2] + yv[3] * yv[3]);
                }
            s1 += __shfl_xor(s1, 16); s1 += __shfl_xor(s1, 32);
            s2 += __shfl_xor(s2, 16); s2 += __shfl_xor(s2, 32);
            if (fq == 0) { float* st = stats + ((size_t)row * 16 + u.pn * 4 + wc) * 2; st[0] = s1; st[1] = s2; }
        }
    }
};
__device__ __forceinline__ void phase_outproj(const Params& p, LAS unsigned char* lds) {
    pg8::Gemm g{(const bf16_t*)(p.ws + OFF_AO), (const bf16_t*)(p.ws + OFF_WTOUT), p.ws, 1};
    pg8::DenseSched S{4, 512, 512, 0, 1, (int)gridDim.x, vcu_of_block()};
    EpiOut E{p.x, p.out, (const float*)(p.ws + OFF_MOD), (float*)(p.ws + OFF_STATS)};
    pg8::gemm_phase<D, EpiOut, pg8::DenseSched, false>(lds, g, S, E);
}

__device__ __forceinline__ void phase_router(const Params& p, LAS unsigned char* lds0) {
    const int tid = hw_tid(), lane = tid & 63, wid = tid >> 6, r16 = lane & 15, q = lane >> 4;
    const float* mod = (const float*)(p.ws + OFF_MOD);
    const float* stats = (const float*)(p.ws + OFF_STATS);
    bf16_t* H = (bf16_t*)(p.ws + OFF_H);
    const bf16_t* WRH = (const bf16_t*)(p.ws + OFF_WRH); const bf16_t* WRL = (const bf16_t*)(p.ws + OFF_WRL);
    int* gcnt = (int*)(p.ws + OFF_CNT);
    int* LDST = (int*)(p.ws + OFF_LDST);
    float* LWt = (float*)(p.ws + OFF_LW);
    LAS float* vec = (LAS float*)lds0;
    LAS float* lg = (LAS float*)(lds0 + 16384) + wid * 16 * 64;
    LAS int* lcnt = (LAS int*)(lds0 + 49152);
    LAS int* lbase = (LAS int*)(lds0 + 49152 + 256);
    LAS int* sel_ep = (LAS int*)(lds0 + 49152 + 512);
    LAS float* sel_w = (LAS float*)(lds0 + 49152 + 512 + 4096);
    for (int item = blockIdx.x; item < T / 128; item += gridDim.x) {
        const int t0 = item * 128, b = t0 / SEQ, tw0 = t0 + wid * 16;
        __syncthreads();
        if (tid < 64) lcnt[tid] = 0;
        for (int i = tid; i < 1024; i += 512) {
            vec[i] = p.ln1_g[i]; vec[1024 + i] = p.ln1_b[i];
            vec[2048 + i] = 1.f + mod[(size_t)b * MODW + 4 * D + i]; vec[3072 + i] = mod[(size_t)b * MODW + 3 * D + i];
        }
        float meanv = 0.f, rstdv = 0.f;
        if (lane < 16) {
            float s1 = 0.f, s2 = 0.f;
            const float* st = stats + (size_t)(tw0 + lane) * 32;
#pragma unroll
            for (int i = 0; i < 16; ++i) { s1 += st[2 * i]; s2 += st[2 * i + 1]; }
            meanv = s1 * (1.f / D);
            const float var = fmaxf(s2 * (1.f / D) - meanv * meanv, 0.f);
            rstdv = 1.0f / sqrtf(var + 1e-5f);
        }
        const float mu = __shfl(meanv, r16), rs = __shfl(rstdv, r16);
        __syncthreads();
        f32x4 acc[4];
#pragma unroll
        for (int nb = 0; nb < 4; ++nb) acc[nb] = (f32x4){0.f, 0.f, 0.f, 0.f};
        float* yrow = p.out + (size_t)(tw0 + r16) * D + q * 8;
        bf16_t* hrow = H + (size_t)(tw0 + r16) * D + q * 8;
        LAS unsigned char* wb = lds0 + 57856;
        f32x4 vn[4][2];
#pragma unroll
        for (int u = 0; u < 4; ++u) { vn[u][0] = *(const f32x4*)(yrow + u * 32); vn[u][1] = *(const f32x4*)(yrow + u * 32 + 4); }
        for (int ch = 0; ch < 4; ++ch) {
            __syncthreads();
#pragma unroll
            for (int i = 0; i < 8; ++i) {
                const int idx = tid + i * 512, part = idx >> 11, row = (idx >> 5) & 63, c16 = idx & 31;
                const u32x4 w = *(const u32x4*)((part ? WRL : WRH) + (size_t)row * D + ch * 256 + c16 * 8);
                *(LAS u32x4*)(wb + part * 33792 + row * 528 + c16 * 16) = w;
            }
            __syncthreads();
#pragma unroll
            for (int s4 = ch * 8; s4 < ch * 8 + 8; s4 += 4) {
                f32x4 vv[4][2];
#pragma unroll
                for (int u = 0; u < 4; ++u) { vv[u][0] = vn[u][0]; vv[u][1] = vn[u][1]; }
                if (s4 + 4 < 32) {
#pragma unroll
                    for (int u = 0; u < 4; ++u) { vn[u][0] = *(const f32x4*)(yrow + (s4 + 4 + u) * 32); vn[u][1] = *(const f32x4*)(yrow + (s4 + 4 + u) * 32 + 4); }
                }
#pragma unroll
                for (int u = 0; u < 4; ++u) {
                    const int s = s4 + u, k0 = s * 32 + q * 8;
                    float hv[8];
#pragma unroll
                    for (int hh = 0; hh < 2; ++hh) {
                        const f32x4 g = *(const LAS f32x4*)(vec + k0 + 4 * hh), bb = *(const LAS f32x4*)(vec + 1024 + k0 + 4 * hh);
                        const f32x4 sc = *(const LAS f32x4*)(vec + 2048 + k0 + 4 * hh), sh = *(const LAS f32x4*)(vec + 3072 + k0 + 4 * hh);
                        const f32x4 xm = (vv[u][hh] - mu) * rs * g + bb;
                        *(f32x4*)(yrow + s * 32 + 4 * hh) = xm;
                        const f32x4 h4 = xm * sc + sh;
                        hv[4 * hh + 0] = h4[0]; hv[4 * hh + 1] = h4[1]; hv[4 * hh + 2] = h4[2]; hv[4 * hh + 3] = h4[3];
                    }
                    unsigned wh[4], wl[4];
#pragma unroll
                    for (int i = 0; i < 4; ++i) {
                        const unsigned ha = f2bf(hv[2 * i]), hb = f2bf(hv[2 * i + 1]);
                        wh[i] = ha | (hb << 16);
                        wl[i] = pk2(hv[2 * i] - bf2f(ha), hv[2 * i + 1] - bf2f(hb));
                    }
                    *(u32x4*)(hrow + s * 32) = (u32x4){wh[0], wh[1], wh[2], wh[3]};
                    const bf16x8 ah = __builtin_bit_cast(bf16x8, (u32x4){wh[0], wh[1], wh[2], wh[3]}), al = __builtin_bit_cast(bf16x8, (u32x4){wl[0], wl[1], wl[2], wl[3]});
                    const int kb = ((s & 7) * 32 + q * 8) * 2;
#pragma unroll
                    for (int nb = 0; nb < 4; ++nb) {
                        const bf16x8 bh = *(const LAS bf16x8*)(wb + (nb * 16 + r16) * 528 + kb), bl = *(const LAS bf16x8*)(wb + 33792 + (nb * 16 + r16) * 528 + kb);
                        acc[nb] = __builtin_amdgcn_mfma_f32_16x16x32_bf16(ah, bh, acc[nb], 0, 0, 0);
                        acc[nb] = __builtin_amdgcn_mfma_f32_16x16x32_bf16(al, bh, acc[nb], 0, 0, 0);
                        acc[nb] = __builtin_amdgcn_mfma_f32_16x16x32_bf16(ah, bl, acc[nb], 0, 0, 0);
                    }
                }
            }
        }
#pragma unroll
        for (int nb = 0; nb < 4; ++nb)
#pragma unroll
            for (int j = 0; j < 4; ++j) lg[(4 * q + j) * 64 + nb * 16 + r16] = acc[nb][j];
        __syncthreads();
        const float bias = p.router_bias[lane];
        const int g = lane >> 3;
        for (int r0 = 0; r0 < 16; r0 += 4) {
            float sg[4], sel[4], msel[4]; bool keep[4];
#pragma unroll
            for (int u = 0; u < 4; ++u) {
                const float lgv = lg[(r0 + u) * 64 + lane];
                sg[u] = 1.0f / (1.0f + expf(-lgv));
                sel[u] = sg[u] + bias;
            }
            float m1[4], m2[4]; int cand[4];
#pragma unroll
            for (int u = 0; u < 4; ++u) { m1[u] = fmaxf(sel[u], __shfl_xor(sel[u], 1)); }
#pragma unroll
            for (int u = 0; u < 4; ++u) { m1[u] = fmaxf(m1[u], __shfl_xor(m1[u], 2)); }
#pragma unroll
            for (int u = 0; u < 4; ++u) { m1[u] = fmaxf(m1[u], __shfl_xor(m1[u], 4)); cand[u] = (sel[u] == m1[u]) ? lane : 64; }
#pragma unroll
            for (int u = 0; u < 4; ++u) { cand[u] = min(cand[u], __shfl_xor(cand[u], 1)); }
#pragma unroll
            for (int u = 0; u < 4; ++u) { cand[u] = min(cand[u], __shfl_xor(cand[u], 2)); }
#pragma unroll
            for (int u = 0; u < 4; ++u) { cand[u] = min(cand[u], __shfl_xor(cand[u], 4)); m2[u] = (lane == cand[u]) ? -INFINITY : sel[u]; }
#pragma unroll
            for (int u = 0; u < 4; ++u) { m2[u] = fmaxf(m2[u], __shfl_xor(m2[u], 1)); }
#pragma unroll
            for (int u = 0; u < 4; ++u) { m2[u] = fmaxf(m2[u], __shfl_xor(m2[u], 2)); }
#pragma unroll
            for (int u = 0; u < 4; ++u) { m2[u] = fmaxf(m2[u], __shfl_xor(m2[u], 4)); }
#pragma unroll
            for (int u = 0; u < 4; ++u) {
                const float gs = m1[u] + m2[u];
                int cntg = 0;
#pragma unroll
                for (int gg = 0; gg < 8; ++gg) { const float v = __shfl(gs, gg * 8); cntg += (v > gs || (v == gs && gg < g)) ? 1 : 0; }
                keep[u] = cntg < 4;
                msel[u] = keep[u] ? sel[u] : -INFINITY;
                lg[(r0 + u) * 64 + lane] = msel[u];
            }
            int cnt[4] = {0, 0, 0, 0};
#pragma unroll 4
            for (int q4 = 0; q4 < 16; ++q4) {
#pragma unroll
                for (int u = 0; u < 4; ++u) {
                    const f32x4 v = *(const LAS f32x4*)(lg + (r0 + u) * 64 + q4 * 4);
#pragma unroll
                    for (int i = 0; i < 4; ++i) cnt[u] += (v[i] > msel[u]) ? 1 : 0;
                }
            }
#pragma unroll
            for (int u = 0; u < 4; ++u) {
                bool ok = __popcll(__ballot(keep[u] && cnt[u] < 8)) == 8;
#pragma unroll
                for (int k = 0; k < 8; ++k) ok = ok && (__ballot(keep[u] && cnt[u] == k) != 0ull);
                if (!ok) {
                    int c2 = 0;
                    for (int e2 = 0; e2 < 64; ++e2) { const float v = lg[(r0 + u) * 64 + e2]; c2 += (v > msel[u] || (v == msel[u] && e2 < lane)) ? 1 : 0; }
                    cnt[u] = c2;
                }
            }
            float wsum[4]; bool chosen[4];
#pragma unroll
            for (int u = 0; u < 4; ++u) { chosen[u] = keep[u] && cnt[u] < 8; wsum[u] = chosen[u] ? sg[u] : 0.f; }
#pragma unroll
            for (int o = 1; o < 64; o <<= 1) {
#pragma unroll
                for (int u = 0; u < 4; ++u) wsum[u] += __shfl_xor(wsum[u], o);
            }
#pragma unroll
            for (int u = 0; u < 4; ++u) {
                if (chosen[u]) {
                    const int pos = atomicAdd((int*)&lcnt[lane], 1);
                    sel_ep[(wid * 16 + r0 + u) * 8 + cnt[u]] = lane | (pos << 8);
                    sel_w[(wid * 16 + r0 + u) * 8 + cnt[u]] = sg[u] / wsum[u] * 2.5f;
                }
            }
        }
        __syncthreads();
        if (tid < 64) { int tt = tid; asm volatile("" : "+v"(tt)); lbase[tt] = atomicAdd(&gcnt[tt], lcnt[tt]); }
        __syncthreads();
        for (int idx = tid; idx < 1024; idx += 512) {
            const int ep = sel_ep[idx], e = ep & 0xff, pos = ep >> 8, gi = lbase[e] + pos;
            LDST[(size_t)e * T + gi] = (t0 + (idx >> 3)) * NSLOT + (idx & 7);
            LWt[(size_t)e * T + gi] = sel_w[idx];
        }
    }
}

constexpr int LDS_ROWTAB = LDS_TAB, LDS_AUX = LDS_TAB + 12288, MOE_MAX_UNITS = 20, LDS_UTAB = LDS_CTL + 256, LDS_TSTART = LDS_UTAB + MOE_MAX_UNITS * 32;
__device__ __forceinline__ int moe_setup(const Params& p, LAS unsigned char* lds0, int nN, int bmul, int badd) {
    LAS int* tstart = (LAS int*)(lds0 + LDS_TSTART); LAS int* utab = (LAS int*)(lds0 + LDS_UTAB);
    const int* gcnt = (const int*)(p.ws + OFF_CNT);
    __syncthreads();
    if (hw_tid() == 0) {
        int a = 0;
        for (int e = 0; e < NEX; ++e) { const int c = e < NE ? gcnt[e] : T; tstart[e] = a; a += (c + 255) >> 8; }
        tstart[NEX] = a;
    }
    __syncthreads();
    const int total = tstart[NEX] * nN, G = gridDim.x, c = vcu_of_block();
    if (hw_tid() < MOE_MAX_UNITS) {
        const int i = hw_tid(), L = i * G + c;
        int pm = 0, pn = 0, e = 0, i0 = 0, cnt = 0;
        if (L < total) {
            const int mt = L / nN, pl = L % nN;
            for (int j = 1; j < NEX; ++j) e += (mt >= tstart[j]) ? 1 : 0;
            pm = mt; pn = e * bmul + badd + pl; i0 = (mt - tstart[e]) * 256; cnt = e < NE ? gcnt[e] : T;
        }
        utab[i * 8 + 0] = pm; utab[i * 8 + 1] = pn; utab[i * 8 + 2] = e; utab[i * 8 + 3] = i0; utab[i * 8 + 4] = cnt;
    }
    __syncthreads();
    const int n = (total - c + G - 1) / G;
    return n < 0 ? 0 : (n > MOE_MAX_UNITS ? MOE_MAX_UNITS : n);
}
struct MoeSched {
    LAS const int* utab; LAS const unsigned* rowtab; int n;
    __device__ __forceinline__ bool next(int i, pg8::Unit& u) const {
        if (i >= n) return false;
        u.pm = __builtin_amdgcn_readfirstlane(utab[i * 8 + 0]); u.pn = __builtin_amdgcn_readfirstlane(utab[i * 8 + 1]); u.e = __builtin_amdgcn_readfirstlane(utab[i * 8 + 2]); u.idx = i; return true;
    }
    __device__ __forceinline__ unsigned row_off(int i, int r) const { return rowtab[i * 256 + r]; }
    __device__ __forceinline__ void a_ready(const pg8::Unit&) const {}
    __device__ __forceinline__ void done(const pg8::Unit&) const {}
};
struct EpiGU {
    static constexpr bool PERM = true;
    LAS const float* auxw; unsigned char* ws;
    __device__ __forceinline__ void operator()(const f32x4 (&acc)[2][2][4][2], const pg8::Unit& u, int wr, int wc, int fr, int fq) const {
        const int pl = u.pn & 1;
        bf16_t* ACT = (bf16_t*)(ws + OFF_ACT) + (size_t)u.pm * 256 * FF + pl * 128 + wc * 32 + 8 * fq;
#pragma unroll
        for (int ai = 0; ai < 2; ++ai)
#pragma unroll
            for (int m = 0; m < 4; ++m) {
                const int rl = ai * 128 + wr * 64 + m * 16 + fr;
                const float wrow = auxw[u.idx * 256 + rl];
                float a[8];
#pragma unroll
                for (int n = 0; n < 2; ++n)
#pragma unroll
                    for (int q = 0; q < 4; ++q) { const float g = acc[ai][0][m][n][q], uu = acc[ai][1][m][n][q]; a[n * 4 + q] = g * __builtin_amdgcn_rcpf(1.f + __builtin_amdgcn_exp2f(g * -1.4426950408889634f)) * uu * wrow; }
                u32x4 w; w.x = pk2(a[0], a[1]); w.y = pk2(a[2], a[3]); w.z = pk2(a[4], a[5]); w.w = pk2(a[6], a[7]);
                *(u32x4*)(ACT + (size_t)rl * FF) = w;
            }
    }
};
__device__ __forceinline__ void phase_gateup(const Params& p, LAS unsigned char* lds0) {
    int n = moe_setup(p, lds0, 2, 2, 0); n = n > 12 ? 12 : n;
    LAS const int* utab = (LAS const int*)(lds0 + LDS_UTAB);
    LAS unsigned* rowtab = (LAS unsigned*)(lds0 + LDS_ROWTAB);
    LAS float* auxw = (LAS float*)(lds0 + LDS_AUX);
    const int* LDST = (const int*)(p.ws + OFF_LDST);
    const float* LWt = (const float*)(p.ws + OFF_LW);
    for (int i = 0; i < n; ++i) {
        const int e = utab[i * 8 + 2], i0 = utab[i * 8 + 3], cnt = utab[i * 8 + 4];
        if (hw_tid() < 256) {
            const int li = i0 + hw_tid(); int tok = 0; float w = 0.f;
            if (li < cnt) { if (e < NE) { tok = LDST[(size_t)e * T + li] / NSLOT; w = LWt[(size_t)e * T + li]; } else { tok = li; w = 1.f; } }
            rowtab[i * 256 + hw_tid()] = (unsigned)tok * (unsigned)(D * 2);
            auxw[i * 256 + hw_tid()] = w;
        }
    }
    __syncthreads();
    MoeSched S{utab, rowtab, n};
    pg8::Gemm g{(const bf16_t*)(p.ws + OFF_H), (const bf16_t*)(p.ws + OFF_WGU), p.ws, 2};
    EpiGU E{auxw, p.ws};
    pg8::gemm_phase<D, EpiGU, MoeSched, true>(lds0, g, S, E);
    {
        LAS const int* tstart = (LAS const int*)(lds0 + LDS_TSTART);
        const int total = tstart[NEX] * 2, G = gridDim.x, v = vcu_of_block(), rem = total % G;
        if (v >= rem) {
            const int lane = hw_tid() & 63, wv = hw_tid() >> 6, nw = (G - rem) * 8, w = (v - rem) * 8 + wv;
            LAS float* scr = (LAS float*)lds0 + wv * (64 * 33);
            transpose_run(p, scr, lane, w < TR_N_D ? (TR_N_D - w + nw - 1) / nw : 0, [=](int k) { return TR_N_A + TR_N_GU + w + k * nw; });
        }
    }
}
constexpr float FP8S = 32.f, FP8I = 1.f / 32.f;
__device__ __forceinline__ unsigned pk4_fp8(float a, float b, float c, float d) {
    a = __builtin_amdgcn_fmed3f(a * FP8S, -440.f, 440.f); b = __builtin_amdgcn_fmed3f(b * FP8S, -440.f, 440.f);
    c = __builtin_amdgcn_fmed3f(c * FP8S, -440.f, 440.f); d = __builtin_amdgcn_fmed3f(d * FP8S, -440.f, 440.f);
    int w = __builtin_amdgcn_cvt_pk_fp8_f32(a, b, 0, false);
    w = __builtin_amdgcn_cvt_pk_fp8_f32(c, d, w, true);
    return (unsigned)w;
}
struct EpiDown {
    static constexpr bool PERM = true;
    LAS const int* auxd; unsigned char* ws;
    __device__ __forceinline__ void operator()(const f32x4 (&acc)[2][2][4][2], const pg8::Unit& u, int wr, int wc, int fr, int fq) const {
        const int pl = u.pn & 3;
        unsigned char* SL = ws + OFF_SLOTS + pl * 256 + wc * 64 + 16 * fq;
#pragma unroll
        for (int ai = 0; ai < 2; ++ai)
#pragma unroll
            for (int m = 0; m < 4; ++m) {
                const int d = auxd[u.idx * 256 + ai * 128 + wr * 64 + m * 16 + fr];
                u32x4 w;
                w.x = pk4_fp8(acc[ai][0][m][0][0], acc[ai][0][m][0][1], acc[ai][0][m][0][2], acc[ai][0][m][0][3]);
                w.y = pk4_fp8(acc[ai][0][m][1][0], acc[ai][0][m][1][1], acc[ai][0][m][1][2], acc[ai][0][m][1][3]);
                w.z = pk4_fp8(acc[ai][1][m][0][0], acc[ai][1][m][0][1], acc[ai][1][m][0][2], acc[ai][1][m][0][3]);
                w.w = pk4_fp8(acc[ai][1][m][1][0], acc[ai][1][m][1][1], acc[ai][1][m][1][2], acc[ai][1][m][1][3]);
                *(u32x4*)(SL + (size_t)d * 1024) = w;
            }
    }
};
__device__ __forceinline__ void phase_down(const Params& p, LAS unsigned char* lds0) {
    const int n = moe_setup(p, lds0, 4, 4, 0);
    LAS const int* utab = (LAS const int*)(lds0 + LDS_UTAB);
    LAS int* auxd = (LAS int*)(lds0 + LDS_TAB);
    const int* LDST = (const int*)(p.ws + OFF_LDST);
    for (int i = 0; i < n; ++i) {
        const int e = utab[i * 8 + 2], i0 = utab[i * 8 + 3], cnt = utab[i * 8 + 4];
        if (hw_tid() < 256) {
            const int li = i0 + hw_tid();
            auxd[i * 256 + hw_tid()] = li < cnt ? (e < NE ? LDST[(size_t)e * T + li] : li * NSLOT + 8) : T * NSLOT;
        }
    }
    __syncthreads();
    MoeSched S{utab, (LAS const unsigned*)(lds0 + LDS_ROWTAB), n};
    pg8::Gemm g{(const bf16_t*)(p.ws + OFF_ACT), (const bf16_t*)(p.ws + OFF_WD), p.ws, 3};
    EpiDown E{auxd, p.ws};
    pg8::gemm_phase<FF, EpiDown, MoeSched, false>(lds0, g, S, E);
}

__device__ __forceinline__ void slot_sum16(const unsigned char* SL, int t, int cb, float (&s)[16]) {
#pragma unroll
    for (int i = 0; i < 16; ++i) s[i] = 0.f;
    u32x4 v[NSLOT];
#pragma unroll
    for (int k = 0; k < NSLOT; ++k) v[k] = *(const u32x4*)(SL + (size_t)(t * NSLOT + k) * 1024 + cb);
#pragma unroll
    for (int k = 0; k < NSLOT; ++k)
#pragma unroll
        for (int i = 0; i < 4; ++i) {
            typedef float f32x2 __attribute__((ext_vector_type(2)));
            const f32x2 lo = __builtin_amdgcn_cvt_pk_f32_fp8((int)v[k][i], false), hi = __builtin_amdgcn_cvt_pk_f32_fp8((int)v[k][i], true);
            s[4 * i] += lo.x; s[4 * i + 1] += lo.y; s[4 * i + 2] += hi.x; s[4 * i + 3] += hi.y;
        }
#pragma unroll
    for (int i = 0; i < 16; ++i) s[i] *= FP8I;
}
__device__ __forceinline__ int slot_col(int bb) { return (bb >> 4) * 256 + ((bb >> 2) & 3) * 32 + (bb & 3) * 8; }
__device__ __forceinline__ void phase_final(const Params& p) {
    const int lane = hw_tid() & 63, gw = blockIdx.x * 8 + (hw_tid() >> 6), ngw = gridDim.x * 8;
    const float* mod = (const float*)(p.ws + OFF_MOD);
    const unsigned char* SL = p.ws + OFF_SLOTS;
    const int c0 = slot_col(lane);
    for (int row = gw; row < T; row += ngw) {
        const float* g2 = mod + (size_t)(row / SEQ) * MODW + 5 * D;
        float f[16];
        slot_sum16(SL, row, lane * 16, f);
        f32x4 y[4]; float s = 0.f;
#pragma unroll
        for (int j = 0; j < 4; ++j) {
            const int cj = c0 + (j >> 1) * 128 + (j & 1) * 4;
            const f32x4 xm = *(const f32x4*)(p.out + (size_t)row * D + cj), gg = *(const f32x4*)(g2 + cj);
            y[j][0] = ALPHA * xm[0] + gg[0] * f[4 * j]; y[j][1] = ALPHA * xm[1] + gg[1] * f[4 * j + 1];
            y[j][2] = ALPHA * xm[2] + gg[2] * f[4 * j + 2]; y[j][3] = ALPHA * xm[3] + gg[3] * f[4 * j + 3];
            s += (y[j][0] + y[j][1]) + (y[j][2] + y[j][3]);
        }
#pragma unroll
        for (int o = 1; o < 64; o <<= 1) s += __shfl_xor(s, o);
        const float mean = s * (1.f / D);
        float qv = 0.f;
#pragma unroll
        for (int j = 0; j < 4; ++j) { y[j] = y[j] - mean; qv += (y[j][0] * y[j][0] + y[j][1] * y[j][1]) + (y[j][2] * y[j][2] + y[j][3] * y[j][3]); }
#pragma unroll
        for (int o = 1; o < 64; o <<= 1) qv += __shfl_xor(qv, o);
        const float rstd = 1.0f / sqrtf(qv * (1.f / D) + 1e-5f);
#pragma unroll
        for (int j = 0; j < 4; ++j) {
            const int cj = c0 + (j >> 1) * 128 + (j & 1) * 4;
            const f32x4 g = *(const f32x4*)(p.ln2_g + cj), bb4 = *(const f32x4*)(p.ln2_b + cj);
            *(f32x4*)(p.out + (size_t)row * D + cj) = y[j] * rstd * g + bb4;
        }
    }
}

#define XB_TMO      128
#define XB_XCNT(j)  (256  + 64 * (j))
#define XB_XSUB(j)  (1280 + 64 * (j))
#define XB_XGEN(j)  (2304 + 64 * (j))
#define XB_TOP      3328
#define XB_TOPGEN   3392
#define XCD_BAR_WORDS 3456
#define XB_SPIN_CAP (1u << 18)
__device__ __forceinline__ unsigned xb_ld(unsigned* p)              { return __hip_atomic_load(p, __ATOMIC_RELAXED, __HIP_MEMORY_SCOPE_AGENT); }
__device__ __forceinline__ unsigned xb_add(unsigned* p, unsigned v) { return __hip_atomic_fetch_add(p, v, __ATOMIC_RELAXED, __HIP_MEMORY_SCOPE_AGENT); }
__device__ __forceinline__ unsigned xb_xcc_id() { return (unsigned)__builtin_amdgcn_s_getreg((3 << 11) | 20) & 0xFu; }
#define XB_SPIN(cond, bar) do { unsigned _sp = 0; while (cond) { __builtin_amdgcn_s_sleep(1); \
    if ((++_sp & 255u) == 0u) { if (xb_ld(&(bar)[XB_TMO])) break; if (_sp > XB_SPIN_CAP) { atomicAdd(&(bar)[XB_TMO], 1u); break; } } } } while (0)
struct XcdBarrier { unsigned* bar; unsigned x; volatile LAS unsigned* st; };
__device__ __forceinline__ XcdBarrier xcd_barrier_post(unsigned* bar, volatile LAS unsigned* st) {
    XcdBarrier b; b.bar = bar; b.x = xb_xcc_id(); b.st = st;
    if (hw_tid() == 0) (void)xb_add(&bar[XB_XCNT(b.x)], 1u);
    return b;
}
__device__ __forceinline__ void xcd_barrier_complete(unsigned* bar, unsigned x, unsigned& nloc, unsigned& nx) {
    const unsigned G = gridDim.x * gridDim.y * gridDim.z;
    unsigned sum, cnt, mine, sp = 0u;
    for (;;) {
        sum = 0u; cnt = 0u; mine = 0u;
#pragma unroll
        for (unsigned j = 0; j < 16; ++j) { const unsigned c = xb_ld(&bar[XB_XCNT(j)]); sum += c; cnt += (c > 0u) ? 1u : 0u; mine = (j == x) ? c : mine; }
        if (sum == G) break;
        __builtin_amdgcn_s_sleep(1);
        if ((++sp & 255u) == 0u) { if (xb_ld(&bar[XB_TMO])) break; if (sp > XB_SPIN_CAP) { atomicAdd(&bar[XB_TMO], 1u); break; } }
    }
    nloc = mine > 0u ? mine : 1u; nx = cnt > 0u ? cnt : 1u;
}
__device__ __forceinline__ void xcd_barrier(const XcdBarrier& b) {
    asm volatile("s_waitcnt vmcnt(0)" ::: "memory");
    __syncthreads();
    if (hw_tid() == 0) {
        unsigned* bar = b.bar;
        __builtin_amdgcn_s_waitcnt(0);
        unsigned nloc = b.st[0], nx = b.st[1];
        if (nloc == 0u) { xcd_barrier_complete(bar, b.x, nloc, nx); b.st[0] = nloc; b.st[1] = nx; }
        const unsigned old = xb_add(&bar[XB_XSUB(b.x)], 1u);
        const unsigned gen = old / nloc;
        if (old + 1u == (gen + 1u) * nloc) {
            __builtin_amdgcn_fence(__ATOMIC_RELEASE, "agent");
            asm volatile("s_waitcnt vmcnt(0)" ::: "memory");
            const unsigned og = xb_add(&bar[XB_TOP], 1u);
            const unsigned tg = og / nx;
            if (og + 1u == (tg + 1u) * nx) xb_add(&bar[XB_TOPGEN], 1u);
            else XB_SPIN(xb_ld(&bar[XB_TOPGEN]) == tg, bar);
            __builtin_amdgcn_fence(__ATOMIC_ACQUIRE, "agent");
            xb_add(&bar[XB_XGEN(b.x)], 1u);
            asm volatile("s_waitcnt vmcnt(0)" ::: "memory");
        } else {
            XB_SPIN(xb_ld(&bar[XB_XGEN(b.x)]) == gen, bar);
            __builtin_amdgcn_fence(__ATOMIC_ACQUIRE, "agent");
            asm volatile("s_waitcnt vmcnt(0)" ::: "memory");
        }
    }
    __syncthreads();
}

constexpr size_t OFF_BAR = 448 * 1024;

__global__ void __launch_bounds__(512, 2) mk_fwd(Params p) {
    extern __shared__ __attribute__((aligned(16))) unsigned char smem[];
    LAS unsigned char* lds0 = (LAS unsigned char*)smem;
    {
        const unsigned hw = (unsigned)__builtin_amdgcn_s_getreg((5 << 11) | 4) & 63u;
        if ((threadIdx.x & 63) == 0) *(volatile LAS int*)(LDS_HWTAB + hw * 4) = (int)(threadIdx.x >> 6);
        if (threadIdx.x < 64) ((LAS unsigned*)(lds0 + LDS_CTL))[threadIdx.x] = 0u;
    }
    __syncthreads();
    unsigned char* const g_probe_ws = p.ws; (void)g_probe_ws;
    XcdBarrier bar; bar.bar = (unsigned*)(p.ws + OFF_BAR); bar.x = 0; bar.st = nullptr;
    bar = xcd_barrier_post((unsigned*)(p.ws + OFF_BAR), (volatile LAS unsigned*)(lds0 + LDS_CTL));
#define RUN_PHASE(k, call) { if ((k) > 0) { TS_BEGIN(50); xcd_barrier(bar); TS_END(50); } TS_BEGIN(16 + (k)); int on_ = 1; asm volatile("" : "+s"(on_)); if (on_) { int grp_ = hw_tid() >> 8; asm volatile("" : "+v"(grp_)); LAS unsigned char* lds = lds0 + grp_ * 32768; (void)lds; call; } TS_END(16 + (k)); }
    RUN_PHASE(0, phase_prep(p, lds))
    RUN_PHASE(1, phase_xn(p))
    RUN_PHASE(2, phase_inproj(p, lds0))
    RUN_PHASE(3, phase_attn_pool(p, lds, (char*)smem))
    RUN_PHASE(4, phase_outproj(p, lds0))
    RUN_PHASE(5, phase_router(p, lds0))
    RUN_PHASE(6, phase_gateup(p, lds0))
    RUN_PHASE(7, phase_down(p, lds0))
    RUN_PHASE(8, phase_final(p))
#ifdef PROBE_ACC
    if (blockIdx.x == PROBE_BLK && hw_tid() == 0) {
        __builtin_amdgcn_s_waitcnt(0);
        const unsigned long long span = __hip_atomic_load((unsigned long long*)(p.ws + 448 * 1024 + 16384) + PROBE_ACC, __ATOMIC_RELAXED, __HIP_MEMORY_SCOPE_AGENT);
        const unsigned long long tend = __builtin_amdgcn_s_memrealtime() + PROBE_MUL * span; while (__builtin_amdgcn_s_memrealtime() < tend) __builtin_amdgcn_s_sleep(8);
    }
#endif
}

extern "C" void kernel_launch(void* const* d_in, const int* in_sizes, int n_in, void* d_out, int out_size, void* d_ws, size_t ws_size, hipStream_t stream) {
    static int grid = 0;
    if (grid == 0) {
        int dev = 0, cus = 0, per_cu = 0;
        (void)hipGetDevice(&dev);
        (void)hipDeviceGetAttribute(&cus, hipDeviceAttributeMultiprocessorCount, dev);
        (void)hipFuncSetAttribute((const void*)mk_fwd, hipFuncAttributeMaxDynamicSharedMemorySize, LDS_BYTES);
        (void)hipOccupancyMaxActiveBlocksPerMultiprocessor(&per_cu, (const void*)mk_fwd, 512, LDS_BYTES);
        if (per_cu < 1) fprintf(stderr, "kernel_launch: occupancy query says %d blocks per CU\n", per_cu);
        (void)hipGetLastError();
        grid = cus;
        if (ws_size < WS_NEED) fprintf(stderr, "kernel_launch: workspace too small: %zu < %zu\n", ws_size, (size_t)WS_NEED);
    }
    Params p{};
    const float** pp = (const float**)&p;
    for (int i = 0; i < 24; ++i) pp[i] = (const float*)d_in[i];
    p.out = (float*)d_out; p.ws = (unsigned char*)d_ws;
    (void)hipMemsetAsync((char*)d_ws + OFF_BAR, 0, 16384 + 512, stream);
    hipLaunchKernelGGL(mk_fwd, dim3(grid), dim3(512), LDS_BYTES, stream, p);
}
```

```cpp
#include <hip/hip_runtime.h>
#include <stdint.h>
#include <stdio.h>


#ifdef PROBE_ACC
#ifndef PROBE_BLK
#define PROBE_BLK 0
#endif
#ifndef PROBE_MUL
#define PROBE_MUL 8ull
#endif
#define TS_ADD(k, sgn) do { if (blockIdx.x == PROBE_BLK && hw_tid() == 0) { const unsigned long long t_ = __builtin_amdgcn_s_memrealtime(); \
    __hip_atomic_fetch_add((unsigned long long*)(g_probe_ws + 448 * 1024 + 16384) + (k), (sgn) ? t_ : (0ull - t_), __ATOMIC_RELAXED, __HIP_MEMORY_SCOPE_AGENT); } } while (0)
#define TS_BEGIN(k) TS_ADD(k, false)
#define TS_END(k) TS_ADD(k, true)
#else
#define TS_BEGIN(k) do {} while (0)
#define TS_END(k) do {} while (0)
#endif
#define LAS __attribute__((address_space(3)))
#define TIDX ((int)(hw_tid() & 255))
#define VBLK ((int)(blockIdx.x * 2 + (hw_tid() >> 8)))
#define NVBLK ((int)(gridDim.x * 2))
typedef unsigned short bf16_t;
typedef short bf16x8 __attribute__((ext_vector_type(8)));
typedef float f32x4 __attribute__((ext_vector_type(4)));
typedef unsigned u32x4 __attribute__((ext_vector_type(4)));
typedef unsigned u32x2 __attribute__((ext_vector_type(2)));

constexpr int D = 1024, NB = 16, SEQ = 2048, T = NB * SEQ, CTXL = 256, TC = NB * CTXL, KVL = CTXL + SEQ;
constexpr int PW = 1536, NE = 64, NEX = 65, FF = 256, NSLOT = 9, MODW = 6 * D;
constexpr float ALPHA = 1.189207115002721f;
constexpr float C2 = 0.125f * 1.4426950408889634f;
constexpr int NPHASE = 9;
constexpr int LDS_BYTES = 163840, LDS_TAB = 131072, LDS_CTL = 155648;
constexpr int LDS_HWTAB = LDS_CTL + 2048;
__device__ __forceinline__ int hw_tid() {
    const unsigned hw = (unsigned)__builtin_amdgcn_s_getreg((5 << 11) | 4) & 63u;
    const int w = __builtin_amdgcn_readfirstlane(*(volatile LAS int*)(LDS_HWTAB + hw * 4));
    return w * 64 + (int)__builtin_amdgcn_mbcnt_hi(~0u, __builtin_amdgcn_mbcnt_lo(~0u, 0u));
}

constexpr size_t MiB = 1u << 20;
constexpr size_t OFF_CNT = 0, OFF_MOD = 4096, OFF_ROPE = 512 * 1024;
constexpr size_t OFF_WTIN = 1 * MiB, OFF_WTOUT = 4 * MiB, OFF_WD = 6 * MiB, OFF_LDST = 39 * MiB, OFF_ACT = 47 * MiB;
constexpr size_t OFF_SLOTS = 201 * MiB;
constexpr size_t OFF_WGU = 201 * MiB, OFF_H = 266 * MiB, OFF_LW = 330 * MiB;
constexpr size_t OFF_XN = 47 * MiB, OFF_Q = 119 * MiB, OFF_K = 167 * MiB;
constexpr size_t OFF_V = 338 * MiB, OFF_U = 356 * MiB, OFF_AO = 372 * MiB, OFF_STATS = 436 * MiB;
constexpr size_t OFF_WRH = 490 * MiB, OFF_WRL = OFF_WRH + 128 * 1024;
constexpr size_t WS_NEED = 491 * MiB;

struct Params {
    const float *x, *c, *ctx, *c_ctx, *w_mod, *b_mod, *w_in, *q_norm, *k_norm, *pool_w, *pool_scale, *w_out, *ln1_g, *ln1_b,
        *w_router, *router_bias, *w_gate, *w_up, *w_down, *ws_gate, *ws_up, *ws_down, *ln2_g, *ln2_b;
    float* out;
    unsigned char* ws;
};

__device__ __forceinline__ unsigned f2bf(float f) { unsigned u = __float_as_uint(f); return (u + 0x7fffu + ((u >> 16) & 1u)) >> 16; }
__device__ __forceinline__ unsigned pk2(float lo, float hi) { return f2bf(lo) | (f2bf(hi) << 16); }
__device__ __forceinline__ float bf2f(unsigned h) { return __uint_as_float(h << 16); }
__device__ __forceinline__ float bflo(unsigned w) { return __uint_as_float(w << 16); }
__device__ __forceinline__ float bfhi(unsigned w) { return __uint_as_float(w & 0xffff0000u); }

namespace pg8 {
constexpr int BM = 256, BK = 64, HALF = 128, HTB = HALF * BK * 2, STAGE_BYTES = 8 * HTB;
__host__ __device__ __forceinline__ int lds_byte(int r, int c) { const int st = (r >> 4) * 2 + (c >> 5), rr = r & 15, cc = c & 31, ob = rr * 64 + cc * 2; return st * 1024 + (ob ^ (((ob >> 9) & 1) << 5)); }
__host__ __device__ __forceinline__ void stage_rc(int b, int& R, int& C) { const int st = b / 1024, sb = b % 1024, swz = sb ^ (((sb >> 9) & 1) << 5); R = (st >> 1) * 16 + swz / 64; C = (st & 1) * 32 + (swz % 64) / 2; }
__host__ __device__ __forceinline__ int perm32(int rho) { const int n = rho >> 4, i = rho & 15; return 8 * (i >> 2) + 4 * n + (i & 3); }
struct Unit { int pm, pn, idx, e; };
struct Gemm { const bf16_t* A; const bf16_t* Bt; unsigned char* pws; int tsid; };
__device__ __forceinline__ unsigned cvt_pk_bf16(float lo, float hi) { unsigned r; asm volatile("v_cvt_pk_bf16_f32 %0, %1, %2" : "=v"(r) : "v"(lo), "v"(hi)); return r; }

template <int K, class Epi, class Sched, bool GATHER, bool ALIGN_EPI = true>
__device__ __forceinline__ void gemm_phase(LAS unsigned char* lds, const Gemm g, const Sched& S, const Epi& E) {
    const int tid = hw_tid(), wid = __builtin_amdgcn_readfirstlane(tid >> 6), lane = tid & 63, wr = wid >> 2, wc = wid & 3, fr = lane & 15, fq = lane >> 4;
    constexpr int nt = K / BK;
    unsigned voffA[2], voffB[2], colA = 0; int rowA = 0;
#pragma unroll
    for (int i = 0; i < 2; ++i) { int R, C; stage_rc(tid * 16 + i * 8192, R, C); const int Rb = Epi::PERM ? ((R & ~31) + perm32(R & 31)) : R;
        voffA[i] = (unsigned)(R * K + C) * 2u; voffB[i] = (unsigned)(Rb * K + C) * 2u; if (i == 0) { colA = (unsigned)C * 2u; rowA = R; } }
    const size_t kstep = (size_t)(BK * 2);
    const size_t hstep = (size_t)HALF * K * 2;
    const size_t tstep = 2 * hstep;
    const unsigned ldsw = (unsigned)wid * 1024u;
    const int aoff = lds_byte(wr * 64 + fr, fq * 8), boff = lds_byte(wc * 32 + fr, fq * 8);
#define PG8_SA(b, h) (((b) * 2 + (h)) * HTB)
#define PG8_SB(b, h) ((4 + (b) * 2 + (h)) * HTB)
#define PG8_STAGE(bufoff, gbase, voff) do { _Pragma("unroll") for (int _i = 0; _i < 2; ++_i) \
        __builtin_amdgcn_global_load_lds((const unsigned*)((const char*)(gbase) + (voff)[_i]), (LAS unsigned*)(lds + (bufoff) + ldsw + _i * 8192), 16, 0, 0); } while (0)
#define PG8_STAGE_A(bufoff, ptr, h, NX) do { if constexpr (GATHER) { unsigned _v[2]; \
            if (NX) { _v[0] = S.row_off(nidx, (h) * HALF + rowA) + colA; _v[1] = S.row_off(nidx, (h) * HALF + rowA + 64) + colA; } else { _v[0] = vA[h][0]; _v[1] = vA[h][1]; } PG8_STAGE(bufoff, ptr, _v); } \
        else { PG8_STAGE(bufoff, (ptr) + (h) * hstep, voffA); } } while (0)
#define PG8_LDA(dst, b, h) do { _Pragma("unroll") for (int m = 0; m < 4; ++m) _Pragma("unroll") for (int k = 0; k < 2; ++k) dst[m][k] = *(const LAS bf16x8*)(lds + PG8_SA(b, h) + aoff + m * 2048 + k * 1024); } while (0)
#define PG8_LDB(dst, b, h) do { _Pragma("unroll") for (int n = 0; n < 2; ++n) _Pragma("unroll") for (int k = 0; k < 2; ++k) dst[n][k] = *(const LAS bf16x8*)(lds + PG8_SB(b, h) + boff + n * 2048 + k * 1024); } while (0)
#define PG8_MMA(ai, bj, At, Bt) do { __builtin_amdgcn_s_setprio(1); _Pragma("unroll") for (int m = 0; m < 4; ++m) _Pragma("unroll") for (int n = 0; n < 2; ++n) _Pragma("unroll") for (int k = 0; k < 2; ++k) \
        acc[ai][bj][m][n] = __builtin_amdgcn_mfma_f32_16x16x32_bf16(Bt[n][k], At[m][k], acc[ai][bj][m][n], 0, 0, 0); __builtin_amdgcn_s_setprio(0); } while (0)
#define PG8_WAIT_V(n) asm volatile("s_waitcnt vmcnt(" #n ")" ::: "memory")
#define PG8_WAIT_L(n) asm volatile("s_waitcnt lgkmcnt(" #n ")" ::: "memory")
#define PG8_BAR __builtin_amdgcn_s_barrier()
#define PG8_SCHED __builtin_amdgcn_sched_barrier(0)
    unsigned char* const g_probe_ws = g.pws; (void)g_probe_ws;
    Unit cur, nxt; int ui = 0;
    if (!S.next(0, cur)) return;
    f32x4 acc[2][2][4][2];
#pragma unroll
    for (int a = 0; a < 2; ++a)
#pragma unroll
        for (int b = 0; b < 2; ++b)
#pragma unroll
            for (int m = 0; m < 4; ++m)
#pragma unroll
                for (int n = 0; n < 2; ++n) acc[a][b][m][n] = (f32x4){0.f, 0.f, 0.f, 0.f};
    bf16x8 At[4][2], B0[2][2], B1[2][2];
    unsigned vA[2][2]; int nidx = 0;
    if constexpr (GATHER) {
#pragma unroll
        for (int h = 0; h < 2; ++h)
#pragma unroll
            for (int i = 0; i < 2; ++i) vA[h][i] = S.row_off(cur.idx, h * HALF + rowA + 64 * i) + colA;
    }
    const char* cA = GATHER ? (const char*)g.A : (const char*)g.A + (size_t)cur.pm * tstep; const char* cB = (const char*)g.Bt + (size_t)cur.pn * tstep;
    S.a_ready(cur);
    PG8_STAGE(PG8_SB(0, 0), cB, voffB); PG8_STAGE(PG8_SB(0, 1), cB + hstep, voffB); PG8_STAGE_A(PG8_SA(0, 0), cA, 0, false); PG8_STAGE_A(PG8_SA(0, 1), cA, 1, false);
    if (wr == 1) PG8_BAR;
    PG8_WAIT_V(2); PG8_BAR;
    PG8_STAGE(PG8_SB(1, 0), cB + kstep, voffB); PG8_STAGE_A(PG8_SA(1, 0), cA + kstep, 0, false); PG8_STAGE(PG8_SB(1, 1), cB + hstep + kstep, voffB);
    PG8_WAIT_V(6); PG8_BAR;
    for (;;) {
        const bool has_next = S.next(ui + 1, nxt);
        if constexpr (GATHER) nidx = has_next ? nxt.idx : cur.idx;
        const char* nA = GATHER ? (const char*)g.A : (has_next ? (const char*)g.A + (size_t)nxt.pm * tstep : cA); const char* nB = has_next ? (const char*)g.Bt + (size_t)nxt.pn * tstep : cB;
        TS_BEGIN(33 + 2 * g.tsid);
        for (int t = 0; t < nt; t += 2) {
            const bool last = (t == nt - 2);
            const char* a1 = cA + (size_t)(t + 1) * kstep;
            const char* a2 = last ? nA : cA + (size_t)(t + 2) * kstep; const char* b2 = last ? nB : cB + (size_t)(t + 2) * kstep;
            const char* a3 = a2 + kstep; const char* b3 = b2 + kstep;
            if (last && has_next) S.a_ready(nxt);
            PG8_LDB(B0, 0, 0); PG8_LDB(B1, 0, 1); PG8_SCHED; PG8_LDA(At, 0, 0); PG8_STAGE_A(PG8_SA(1, 1), a1, 1, false);
            PG8_WAIT_V(8); PG8_WAIT_L(0); PG8_BAR; PG8_MMA(0, 0, At, B0); PG8_MMA(0, 1, At, B1); PG8_BAR; PG8_SCHED;
            PG8_LDA(At, 0, 1); PG8_STAGE(PG8_SB(0, 0), b2, voffB); PG8_STAGE(PG8_SB(0, 1), b2 + hstep, voffB); PG8_STAGE_A(PG8_SA(0, 0), a2, 0, last);
            PG8_WAIT_V(8); PG8_WAIT_L(0); PG8_BAR; PG8_MMA(1, 0, At, B0); PG8_MMA(1, 1, At, B1); PG8_BAR; PG8_SCHED;
            PG8_LDB(B0, 1, 0); PG8_LDB(B1, 1, 1); PG8_SCHED; PG8_LDA(At, 1, 0); PG8_STAGE_A(PG8_SA(0, 1), a2, 1, last);
            PG8_WAIT_V(8); PG8_WAIT_L(0); PG8_BAR; PG8_MMA(0, 0, At, B0); PG8_MMA(0, 1, At, B1); PG8_BAR; PG8_SCHED;
            PG8_LDA(At, 1, 1); PG8_STAGE(PG8_SB(1, 0), b3, voffB); PG8_STAGE(PG8_SB(1, 1), b3 + hstep, voffB); PG8_STAGE_A(PG8_SA(1, 0), a3, 0, last);
            PG8_WAIT_V(8); PG8_WAIT_L(0); PG8_BAR; PG8_MMA(1, 0, At, B0); PG8_MMA(1, 1, At, B1); PG8_BAR; PG8_SCHED;
        }
        TS_END(33 + 2 * g.tsid);
        if constexpr (ALIGN_EPI) { if (wr == 0) PG8_BAR; }
        TS_BEGIN(32 + 2 * g.tsid); E(acc, cur, wr, wc, fr, fq); S.done(cur); TS_END(32 + 2 * g.tsid);
        if (!has_next) break;
#pragma unroll
        for (int a = 0; a < 2; ++a)
#pragma unroll
            for (int b = 0; b < 2; ++b)
#pragma unroll
                for (int m = 0; m < 4; ++m)
#pragma unroll
                    for (int n = 0; n < 2; ++n) acc[a][b][m][n] = (f32x4){0.f, 0.f, 0.f, 0.f};
        cur = nxt; cA = nA; cB = nB; ++ui;
        if constexpr (GATHER) {
#pragma unroll
            for (int h = 0; h < 2; ++h)
#pragma unroll
                for (int i = 0; i < 2; ++i) vA[h][i] = S.row_off(cur.idx, h * HALF + rowA + 64 * i) + colA;
        }
        if constexpr (ALIGN_EPI) { if (wr == 1) PG8_BAR; }
    }
    PG8_WAIT_V(0);
    if constexpr (!ALIGN_EPI) { if (wr == 0) PG8_BAR; }
    PG8_BAR;
#undef PG8_SA
#undef PG8_SB
#undef PG8_STAGE
#undef PG8_STAGE_A
#undef PG8_LDA
#undef PG8_LDB
#undef PG8_MMA
#undef PG8_WAIT_V
#undef PG8_WAIT_L
#undef PG8_BAR
#undef PG8_SCHED
}

struct DenseSched {
    int nN, n1, total, pn2lo, nN2, G, c;
    __device__ __forceinline__ bool next(int i, Unit& u) const {
        const int L = i * G + c; if (L >= total) return false;
        if (L < n1) { u.pm = L / nN; u.pn = L % nN; } else { const int r = L - n1; u.pm = n1 / nN + r / nN2; u.pn = pn2lo + r % nN2; }
        u.idx = i; u.e = 0; return true;
    }
    __device__ __forceinline__ void a_ready(const Unit&) const {}
    __device__ __forceinline__ void done(const Unit&) const {}
};
}

__device__ __forceinline__ int win_row(int n) { return (n & ~255) + 128 * ((n >> 5) & 1) + 32 * ((n >> 6) & 3) + (n & 31); }
__device__ __forceinline__ int gu_row(int j, int half) { return (j >> 7) * 256 + half * 128 + (j & 127); }

template <class RowMap>
__device__ __forceinline__ void transpose_tile(LAS float* tile, const float* src, int ld, int k0, int n0, bf16_t* dst, int Kdst, RowMap rowmap) {
    const int tid = TIDX;
#pragma unroll
    for (int pss = 0; pss < 4; ++pss) {
        const int k = pss * 16 + (tid >> 4), n4 = (tid & 15) * 4;
        const f32x4 v = *(const f32x4*)(src + (size_t)(k0 + k) * ld + n0 + n4);
        tile[k * 65 + n4 + 0] = v[0]; tile[k * 65 + n4 + 1] = v[1]; tile[k * 65 + n4 + 2] = v[2]; tile[k * 65 + n4 + 3] = v[3];
    }
    __syncthreads();
    {
        const int n = tid >> 2, kc = (tid & 3) * 16;
        unsigned w[8];
#pragma unroll
        for (int i = 0; i < 8; ++i) w[i] = pk2(tile[(kc + 2 * i) * 65 + n], tile[(kc + 2 * i + 1) * 65 + n]);
        bf16_t* dp = dst + (size_t)rowmap(n0 + n) * Kdst + k0 + kc;
        *(u32x4*)dp = (u32x4){w[0], w[1], w[2], w[3]};
        *(u32x4*)(dp + 8) = (u32x4){w[4], w[5], w[6], w[7]};
    }
    __syncthreads();
}

template <class RowMap>
__device__ __forceinline__ void wave_transpose(LAS float* scr, const float* src, int ld, int k0, int n0, bf16_t* dst, int Kdst, RowMap rowmap, int lane) {
#pragma unroll
    for (int i = 0; i < 8; ++i) {
        const int kk = 8 * i + (lane >> 3), n4 = (lane & 7) * 4;
        const f32x4 v = *(const f32x4*)(src + (size_t)(k0 + kk) * ld + n0 + n4);
        scr[kk * 33 + n4] = v[0]; scr[kk * 33 + n4 + 1] = v[1]; scr[kk * 33 + n4 + 2] = v[2]; scr[kk * 33 + n4 + 3] = v[3];
    }
    asm volatile("s_waitcnt lgkmcnt(0)" ::: "memory");
    const int c = lane & 7;
#pragma unroll
    for (int j = 0; j < 4; ++j) {
        const int n = (lane >> 3) + 8 * j; const LAS float* sp = scr + (8 * c) * 33 + n;
        u32x4 o; o.x = pk2(sp[0], sp[33]); o.y = pk2(sp[2 * 33], sp[3 * 33]); o.z = pk2(sp[4 * 33], sp[5 * 33]); o.w = pk2(sp[6 * 33], sp[7 * 33]);
        *(u32x4*)(dst + (size_t)rowmap(n0 + n) * Kdst + k0 + 8 * c) = o;
    }
    asm volatile("s_waitcnt lgkmcnt(0)" ::: "memory");
}

constexpr int TR_N_A = 16 * 48 + 16 * 32, TR_N_GU = NEX * 256, TR_N_D = NEX * 128;
constexpr int TR_GU_LATE = 224 * 8 * 6;
__device__ __forceinline__ void transpose_item(const Params& p, LAS float* scr, int id, int lane) {
    if (id < 16 * 48) { wave_transpose(scr, p.w_in, PW, (id / 48) * 64, (id % 48) * 32, (bf16_t*)(p.ws + OFF_WTIN), D, [](int n) { return win_row(n); }, lane); return; }
    id -= 16 * 48;
    if (id < 16 * 32) { wave_transpose(scr, p.w_out, D, (id / 32) * 64, (id % 32) * 32, (bf16_t*)(p.ws + OFF_WTOUT), D, [](int n) { return n; }, lane); return; }
    id -= 16 * 32;
    if (id < TR_N_GU) {
        const int e = id >> 8, q = id & 255, half = q >> 7, rr = q & 127;
        const float* src = half ? (e < NE ? p.w_up + (size_t)e * D * FF : p.ws_up) : (e < NE ? p.w_gate + (size_t)e * D * FF : p.ws_gate);
        wave_transpose(scr, src, FF, (rr / 8) * 64, (rr % 8) * 32, (bf16_t*)(p.ws + OFF_WGU) + (size_t)e * 512 * D, D, [half](int n) { return gu_row(n, half); }, lane);
        return;
    }
    id -= TR_N_GU;
    {
        const int e = id >> 7, rr = id & 127;
        const float* src = e < NE ? p.w_down + (size_t)e * FF * D : p.ws_down;
        wave_transpose(scr, src, D, (rr / 32) * 64, (rr % 32) * 32, (bf16_t*)(p.ws + OFF_WD) + (size_t)e * D * FF, FF, [](int n) { return n; }, lane);
    }
}

__device__ __forceinline__ void phase_prep(const Params& p, LAS unsigned char* lds) {
    const int tid = TIDX;
    int* gcnt = (int*)(p.ws + OFF_CNT);
    if (VBLK == 0 && tid < 128) gcnt[tid] = 0;
    float* mod = (float*)(p.ws + OFF_MOD);
    float* rope = (float*)(p.ws + OFF_ROPE);
    constexpr int N_MOD = 384, N_ROPE = 256, N_TR = 16;
    for (int it = VBLK; it < N_MOD + N_ROPE + N_TR; it += NVBLK) {
        if (it < N_MOD) {
            LAS float* sl = (LAS float*)lds;
            LAS float* red = (LAS float*)(lds + 10240);
            const int col = it * 16 + (tid & 15), kk = tid >> 4;
            float acc[17];
#pragma unroll
            for (int r = 0; r < 17; ++r) acc[r] = 0.f;
            for (int kc = 0; kc < 8; ++kc) {
                float wv[8];
#pragma unroll
                for (int i = 0; i < 8; ++i) wv[i] = p.w_mod[(size_t)(kc * 128 + kk + 16 * i) * MODW + col];
                __syncthreads();
                for (int o = tid; o < 17 * 128; o += 256) {
                    const int r = o >> 7, kl = o & 127;
                    const float cv = (r < 16) ? p.c[r * D + kc * 128 + kl] : p.c_ctx[kc * 128 + kl];
                    sl[kl * 20 + r] = cv / (1.f + expf(-cv));
                }
                __syncthreads();
#pragma unroll
                for (int i = 0; i < 8; ++i) {
                    const int kl = kk + 16 * i;
                    const f32x4 s0 = *(const LAS f32x4*)(sl + kl * 20), s1 = *(const LAS f32x4*)(sl + kl * 20 + 4), s2 = *(const LAS f32x4*)(sl + kl * 20 + 8), s3 = *(const LAS f32x4*)(sl + kl * 20 + 12);
                    const float s4 = sl[kl * 20 + 16];
#pragma unroll
                    for (int q = 0; q < 4; ++q) { acc[q] += s0[q] * wv[i]; acc[4 + q] += s1[q] * wv[i]; acc[8 + q] += s2[q] * wv[i]; acc[12 + q] += s3[q] * wv[i]; }
                    acc[16] += s4 * wv[i];
                }
            }
#pragma unroll
            for (int r = 0; r < 17; ++r) red[(kk * 17 + r) * 16 + (tid & 15)] = acc[r];
            __syncthreads();
            for (int o = tid; o < 17 * 16; o += 256) {
                const int r = o >> 4, j = o & 15;
                float sm = p.b_mod[it * 16 + j];
#pragma unroll
                for (int g = 0; g < 16; ++g) sm += red[(g * 17 + r) * 16 + j];
                mod[r * MODW + it * 16 + j] = sm;
            }
            __syncthreads();
        } else if (it < N_MOD + N_ROPE) {
            const int idx = (it - N_MOD) * 256 + tid, t = idx >> 5, i = idx & 31;
            const int pos = (i < 16) ? (t >> 6) : (t & 63);
            const float invf = (float)exp(-(double)(i & 15) / 16.0 * 9.210340371976184);
            const double ang = (double)((float)pos * invf);
            rope[idx * 2 + 0] = (float)cos(ang);
            rope[idx * 2 + 1] = (float)sin(ang);
        } else {
            LAS float* tile = (LAS float*)lds;
            const int idx = it - N_MOD - N_ROPE;
            {

                const int k0 = idx * 64;
#pragma unroll
                for (int pss = 0; pss < 4; ++pss) {
                    const int k = pss * 16 + (tid >> 4), n4 = (tid & 15) * 4;
                    const f32x4 v = *(const f32x4*)(p.w_router + (size_t)(k0 + k) * NE + n4);
                    tile[k * 65 + n4 + 0] = v[0]; tile[k * 65 + n4 + 1] = v[1]; tile[k * 65 + n4 + 2] = v[2]; tile[k * 65 + n4 + 3] = v[3];
                }
                __syncthreads();
                {
                    const int n = tid >> 2, kc = (tid & 3) * 16;
                    unsigned wh[8], wl[8];
#pragma unroll
                    for (int i = 0; i < 8; ++i) {
                        const float a = tile[(kc + 2 * i) * 65 + n], b = tile[(kc + 2 * i + 1) * 65 + n];
                        const unsigned ha = f2bf(a), hb = f2bf(b);
                        wh[i] = ha | (hb << 16);
                        wl[i] = pk2(a - bf2f(ha), b - bf2f(hb));
                    }
                    bf16_t* dh = (bf16_t*)(p.ws + OFF_WRH) + (size_t)n * D + k0 + kc;
                    bf16_t* dl = (bf16_t*)(p.ws + OFF_WRL) + (size_t)n * D + k0 + kc;
                    *(u32x4*)dh = (u32x4){wh[0], wh[1], wh[2], wh[3]}; *(u32x4*)(dh + 8) = (u32x4){wh[4], wh[5], wh[6], wh[7]};
                    *(u32x4*)dl = (u32x4){wl[0], wl[1], wl[2], wl[3]}; *(u32x4*)(dl + 8) = (u32x4){wl[4], wl[5], wl[6], wl[7]};
                }
                __syncthreads();
            }
        }
    }
}

__device__ __forceinline__ void phase_xn(const Params& p, LAS unsigned char* lds) {
    const int lane = TIDX & 63, gw = VBLK * 4 + (TIDX >> 6), ngw = NVBLK * 4;
    const float* mod = (const float*)(p.ws + OFF_MOD);
    bf16_t* XN = (bf16_t*)(p.ws + OFF_XN);
    for (int row = gw; row < T + TC; row += ngw) {
        const float* src = row < T ? p.x + (size_t)row * D : p.ctx + (size_t)(row - T) * D;
        const float* mr = mod + (size_t)(row < T ? row / SEQ : 16) * MODW;
#pragma unroll
        for (int j = 0; j < 4; ++j) {
            const int c = 4 * lane + 256 * j;
            const f32x4 v = *(const f32x4*)(src + c), sh = *(const f32x4*)(mr + c), sc = *(const f32x4*)(mr + D + c);
            u32x2 o; o.x = pk2(v[0] * (1.f + sc[0]) + sh[0], v[1] * (1.f + sc[1]) + sh[1]); o.y = pk2(v[2] * (1.f + sc[2]) + sh[2], v[3] * (1.f + sc[3]) + sh[3]);
            *(u32x2*)(XN + (size_t)row * D + c) = o;
        }
    }
    {
        const int lane = hw_tid() & 63, wv = hw_tid() >> 6;
        LAS float* scr = (LAS float*)(lds - (hw_tid() >> 8) * 32768) + wv * (64 * 33);
        constexpr int NHERE = TR_N_A + (TR_N_GU - TR_GU_LATE);
        for (int it = blockIdx.x * 8 + wv; it < NHERE; it += gridDim.x * 8) transpose_item(p, scr, it < TR_N_A ? it : it + TR_GU_LATE, lane);
    }
}

struct EpiIn {
    static constexpr bool PERM = true;
    const float *q_norm, *k_norm, *rope; bf16_t *Qb, *Kb, *Vb, *Ub;
    __device__ __forceinline__ void operator()(const f32x4 (&acc)[2][2][4][2], const pg8::Unit& u, int wr, int wc, int fr, int fq) const {
        const int grp = u.pn * 4 + wc;
        const bool is_ctx = u.pm >= T / 256;
        f32x4 gn[2][2];
        if (grp >= 4 && grp < 20) {
            const float* g = grp < 16 ? q_norm : k_norm;
#pragma unroll
            for (int bj = 0; bj < 2; ++bj)
#pragma unroll
                for (int n = 0; n < 2; ++n) gn[bj][n] = *(const f32x4*)(g + 32 * bj + 8 * fq + 4 * n);
        }
#pragma unroll
        for (int ai = 0; ai < 2; ++ai)
#pragma unroll
            for (int m = 0; m < 4; ++m) {
                const int row = u.pm * 256 + ai * 128 + wr * 64 + m * 16 + fr;
                f32x4 v[2][2];
#pragma unroll
                for (int bj = 0; bj < 2; ++bj)
#pragma unroll
                    for (int n = 0; n < 2; ++n) v[bj][n] = acc[ai][bj][m][n];
                bf16_t* dst;
                if (grp < 4) dst = Ub + (size_t)row * 256 + grp * 64;
                else if (grp < 16) dst = Qb + (size_t)row * 768 + (grp - 4) * 64;
                else {
                    const size_t krow = is_ctx ? (size_t)((row - T) >> 8) * KVL + ((row - T) & 255) : (size_t)(row >> 11) * KVL + CTXL + (row & (SEQ - 1));
                    dst = (grp < 20 ? Kb + (grp - 16) * 64 : Vb + (grp - 20) * 64) + krow * 256;
                }
                if (grp >= 4 && grp < 20) {
                    float ss = 0.f;
#pragma unroll
                    for (int bj = 0; bj < 2; ++bj)
#pragma unroll
                        for (int n = 0; n < 2; ++n) ss += (v[bj][n][0] * v[bj][n][0] + v[bj][n][1] * v[bj][n][1]) + (v[bj][n][2] * v[bj][n][2] + v[bj][n][3] * v[bj][n][3]);
                    ss += __shfl_xor(ss, 16); ss += __shfl_xor(ss, 32);
                    const float rs = 1.0f / sqrtf(ss * (1.f / 64.f) + 1e-6f);
#pragma unroll
                    for (int bj = 0; bj < 2; ++bj)
#pragma unroll
                        for (int n = 0; n < 2; ++n) v[bj][n] = v[bj][n] * rs * gn[bj][n];
                    if (!is_ctx) {
                        const int tpos = row & (SEQ - 1);
#pragma unroll
                        for (int bj = 0; bj < 2; ++bj)
#pragma unroll
                            for (int n = 0; n < 2; ++n) {
                                const f32x4 cs = *(const f32x4*)(rope + (size_t)(tpos * 32 + 16 * bj + 4 * fq + 2 * n) * 2);
                                const f32x4 x = v[bj][n];
                                v[bj][n] = (f32x4){x[0] * cs[0] - x[1] * cs[1], x[0] * cs[1] + x[1] * cs[0], x[2] * cs[2] - x[3] * cs[3], x[2] * cs[3] + x[3] * cs[2]};
                            }
                    }
                    if (grp < 16) {
#pragma unroll
                        for (int bj = 0; bj < 2; ++bj)
#pragma unroll
                            for (int n = 0; n < 2; ++n) v[bj][n] = v[bj][n] * C2;
                    }
                }
#pragma unroll
                for (int bj = 0; bj < 2; ++bj) {
                    u32x4 w; w.x = pk2(v[bj][0][0], v[bj][0][1]); w.y = pk2(v[bj][0][2], v[bj][0][3]); w.z = pk2(v[bj][1][0], v[bj][1][1]); w.w = pk2(v[bj][1][2], v[bj][1][3]);
                    *(u32x4*)(dst + 32 * bj + 8 * fq) = w;
                }
            }
    }
};
__device__ __forceinline__ int vcu_of_block() { const int G = gridDim.x, bx = blockIdx.x; return (G % 8 == 0) ? (bx % 8) * (G / 8) + bx / 8 : bx; }
__device__ __forceinline__ void phase_inproj(const Params& p, LAS unsigned char* lds) {
    pg8::Gemm g{(const bf16_t*)(p.ws + OFF_XN), (const bf16_t*)(p.ws + OFF_WTIN), p.ws, 0};
    pg8::DenseSched S{6, 768, 800, 4, 2, (int)gridDim.x, vcu_of_block()};
    EpiIn E{p.q_norm, p.k_norm, (const float*)(p.ws + OFF_ROPE), (bf16_t*)(p.ws + OFF_Q), (bf16_t*)(p.ws + OFF_K), (bf16_t*)(p.ws + OFF_V), (bf16_t*)(p.ws + OFF_U)};
    pg8::gemm_phase<D, EpiIn, pg8::DenseSched, false>(lds, g, S, E);
    {
        const int v = vcu_of_block(), G = gridDim.x, nbusy = 800 - 3 * G;
        if (G == 256 ? v >= nbusy : true) {
            const int lane = hw_tid() & 63, wv = hw_tid() >> 6, nw = (G == 256 ? G - nbusy : G) * 8, w = (G == 256 ? v - nbusy : v) * 8 + wv;
            LAS float* scr = (LAS float*)lds + wv * (64 * 33);
            for (int it = w; it < TR_GU_LATE; it += nw) transpose_item(p, scr, TR_N_A + it, lane);
        }
    }
}

namespace attn_body {
using bf16=unsigned short;
using bf16x8=__attribute__((ext_vector_type(8)))short;
using s16x4=__attribute__((ext_vector_type(4)))short;
using f32x16=__attribute__((ext_vector_type(16)))float;
using u32x4=__attribute__((ext_vector_type(4)))unsigned;
constexpr int D=64,QP=768,KP=256,OP=1024,SEQ=2048,KVLEN=2304;
constexpr int NW=8,QBLK=32,QB=QBLK*NW,KVBLK=64,NT=KVLEN/KVBLK;
__device__ __forceinline__ int crow(int r,int hi){return (r&3)+8*(r>>2)+4*hi;}
#define SBAR() __builtin_amdgcn_sched_barrier(0)
constexpr int NSLOT=3, SLOTB=8192;
constexpr int LDS_K=0, LDS_V=NSLOT*SLOTB, LDS_WS=2*NSLOT*SLOTB, LDS_OST=LDS_WS+NW*64*4, LDS_BYTES=LDS_OST+NW*4096;
constexpr float C2=0.125f*1.4426950408889634f;
__device__ __forceinline__ void glds16(const void*gsrc,unsigned lds_dst){unsigned keep;
  asm volatile("s_mov_b32 %0, m0\n\ts_mov_b32 m0, %2\n\ts_nop 0\n\tglobal_load_lds_dwordx4 %1, off\n\ts_mov_b32 m0, %0":"=&s"(keep):"v"(gsrc),"s"(lds_dst):"memory");}
__device__ __forceinline__ float max3f(float a,float b,float c){float r;asm("v_max3_f32 %0, %1, %2, %3":"=v"(r):"v"(a),"v"(b),"v"(c));return r;}
__device__ __forceinline__ float max2f(float a,float b){float r;asm("v_max_f32_e32 %0, %1, %2":"=v"(r):"v"(a),"v"(b));return r;}
__device__ __forceinline__ float fadd_s(float a,float b){float r;asm("v_add_f32_e32 %0, %1, %2":"=v"(r):"v"(a),"v"(b));return r;}
__device__ __forceinline__ float fsub_s(float a,float b){float r;asm("v_sub_f32_e32 %0, %1, %2":"=v"(r):"v"(a),"v"(b));return r;}
typedef float f32x2_t __attribute__((ext_vector_type(2))); typedef __bf16 bf16x2_t __attribute__((ext_vector_type(2)));
__device__ __forceinline__ unsigned cvtpk_s(float lo,float hi){f32x2_t v={lo,hi};bf16x2_t b=__builtin_convertvector(v,bf16x2_t);return __builtin_bit_cast(unsigned,b);}
#define WAIT_BAR(N) asm volatile("s_waitcnt vmcnt(" #N ") lgkmcnt(0)\n\ts_barrier":::"memory")

__device__ __forceinline__ void qkt(f32x16&p0,f32x16&p1,const char*Kslot,const bf16x8*qr,const f32x16&negm,int r32,int hi){
  const char*kb=Kslot+hi*1024+r32*16;
  #pragma unroll
  for(int d0=0;d0<4;++d0){
    const bf16x8 b0=*reinterpret_cast<const bf16x8*>(kb+d0*2048);
    const bf16x8 b1=*reinterpret_cast<const bf16x8*>(kb+d0*2048+512);
    if(d0==0){p0=__builtin_amdgcn_mfma_f32_32x32x16_bf16(b0,qr[0],negm,0,0,0);p1=__builtin_amdgcn_mfma_f32_32x32x16_bf16(b1,qr[0],negm,0,0,0);}
    else{p0=__builtin_amdgcn_mfma_f32_32x32x16_bf16(b0,qr[d0],p0,0,0,0);p1=__builtin_amdgcn_mfma_f32_32x32x16_bf16(b1,qr[d0],p1,0,0,0);}}
}
typedef __attribute__((address_space(3))) const char* lds_cptr;
typedef short v4i16_t __attribute__((ext_vector_type(4)));
__device__ __forceinline__ void kload8(bf16x8*kf,lds_cptr kp){
  kf[0]=*(const __attribute__((address_space(3))) bf16x8*)(kp);      kf[1]=*(const __attribute__((address_space(3))) bf16x8*)(kp+512);
  kf[2]=*(const __attribute__((address_space(3))) bf16x8*)(kp+2048); kf[3]=*(const __attribute__((address_space(3))) bf16x8*)(kp+2560);
  kf[4]=*(const __attribute__((address_space(3))) bf16x8*)(kp+4096); kf[5]=*(const __attribute__((address_space(3))) bf16x8*)(kp+4608);
  kf[6]=*(const __attribute__((address_space(3))) bf16x8*)(kp+6144); kf[7]=*(const __attribute__((address_space(3))) bf16x8*)(kp+6656);
}
__device__ __forceinline__ void kload2(bf16x8*kf,lds_cptr kp,int j){ kf[2*j]=*(const __attribute__((address_space(3))) bf16x8*)(kp+j*2048); kf[2*j+1]=*(const __attribute__((address_space(3))) bf16x8*)(kp+j*2048+512); }
__device__ __forceinline__ s16x4 vtr(lds_cptr p){ return __builtin_bit_cast(s16x4,__builtin_amdgcn_ds_read_tr16_b64_v4i16((__attribute__((address_space(3))) v4i16_t*)p)); }
__device__ __forceinline__ float rowmax(const f32x16&p0,const f32x16&p1){
  float a=max3f(p0[0],p0[1],p1[0]),b=max3f(p0[2],p0[3],p1[1]);a=max3f(a,p1[2],p1[3]);
  #pragma unroll
  for(int r=4;r<16;r+=4){a=max3f(a,p0[r],p0[r+1]);b=max3f(b,p0[r+2],p0[r+3]);a=max3f(a,p1[r],p1[r+1]);b=max3f(b,p1[r+2],p1[r+3]);}
  const float m=max2f(a,b);
  auto rr=__builtin_amdgcn_permlane32_swap(__float_as_uint(m),__float_as_uint(m),false,false);
  return max2f(__uint_as_float(rr[0]),__uint_as_float(rr[1]));
}
__device__ __forceinline__ void pv(f32x16*o,int vb,bf16x8 pa0,bf16x8 pa1,bf16x8 pa2,bf16x8 pa3){
  #pragma unroll
  for(int d0=0;d0<2;++d0){s16x4 lo[4],hi[4];
    #pragma unroll
    for(int ks=0;ks<4;++ks){
      asm volatile("ds_read_b64_tr_b16 %0,%1 offset:%c2":"=&v"(lo[ks]):"v"(vb),"i"(d0*4096+ks*1024):"memory");
      asm volatile("ds_read_b64_tr_b16 %0,%1 offset:%c2":"=&v"(hi[ks]):"v"(vb),"i"(d0*4096+ks*1024+512):"memory");}
    asm volatile("s_waitcnt lgkmcnt(0)":::"memory");SBAR();
    #define PK(k) (bf16x8){lo[k][0],lo[k][1],lo[k][2],lo[k][3],hi[k][0],hi[k][1],hi[k][2],hi[k][3]}
    o[d0]=__builtin_amdgcn_mfma_f32_32x32x16_bf16(pa0,PK(0),o[d0],0,0,0);
    o[d0]=__builtin_amdgcn_mfma_f32_32x32x16_bf16(pa1,PK(1),o[d0],0,0,0);
    o[d0]=__builtin_amdgcn_mfma_f32_32x32x16_bf16(pa2,PK(2),o[d0],0,0,0);
    o[d0]=__builtin_amdgcn_mfma_f32_32x32x16_bf16(pa3,PK(3),o[d0],0,0,0);
    #undef PK
  }
}

#ifndef ATTN_STORE16
#define ATTN_STORE16(p,v) (*(u32x4*)(p)=(v))
#endif
template<int THRL> __device__ __forceinline__ void attn_unit(int b,int h,int qb,const bf16*Q,const bf16*__restrict__ K,const bf16*__restrict__ V,bf16*O,char*shm){
  const int tid=hw_tid(),lane=tid&63,r32=lane&31,hi=lane>>5; const int wid=__builtin_amdgcn_readfirstlane(tid>>6);
  const long rowbase=(long)b*SEQ, kvbase=(long)b*KVLEN; const int q0=qb*QB, kh=h/3;
  const bf16*Qw=Q+(rowbase+q0+wid*QBLK)*QP+h*D;
  const bf16*Kh=K+kvbase*KP+kh*D,*Vh=V+kvbase*KP+kh*D;
  const unsigned lds0=(unsigned)(uintptr_t)shm;
  float*wsf=(float*)(shm+LDS_WS)+wid*64;
  const bf16*ksrc=Kh+(long)lane*KP+wid*8;
  const bf16*vsrc=Vh+(long)(16*(wid&3)+(lane>>2))*KP+(wid>>2)*32+(lane&3)*8;
  const unsigned kdst=lds0+LDS_K+wid*1024, vdst=lds0+LDS_V+wid*1024;
  #define DMA_K(t,slot) glds16(ksrc+(long)(t)*KVBLK*KP,(unsigned)__builtin_amdgcn_readfirstlane(kdst+(slot)))
  #define DMA_V(t,slot) glds16(vsrc+(long)(t)*KVBLK*KP,(unsigned)__builtin_amdgcn_readfirstlane(vdst+(slot)))
  const int vb0=(int)(lds0+LDS_V)+((lane>>4)&1)*32+(lane&3)*8+(4*hi+((lane&15)>>2))*64;
  const char*Kbase=shm+LDS_K; bf16x8 kf[8];
  const lds_cptr shm3=(lds_cptr)shm; const lds_cptr kp0=shm3+LDS_K+hi*1024+r32*16; const lds_cptr vp0=shm3+LDS_V+((lane>>4)&1)*32+(lane&3)*8+(4*hi+((lane&15)>>2))*64;
  DMA_K(0,0);DMA_V(0,0);DMA_K(1,SLOTB);
  bf16x8 qr[4];
  #pragma unroll
  for(int d0=0;d0<4;++d0)qr[d0]=*reinterpret_cast<const bf16x8*>(&Qw[(long)r32*QP+d0*16+hi*8]);
  float mhat=0.f,l_reg=0.f;f32x16 o[2];o[0]=f32x16{};o[1]=f32x16{};f32x16 negm=f32x16{};asm volatile("":"+v"(negm));
  #define CMASK(P0,P1,t) do{}while(0)
  bool resc=false;
  #define START(P0,P1) do{ const float rm=rowmax(P0,P1); resc=false; \
    { const float dl=rm; mhat=fadd_s(mhat,dl); \
      _Pragma("unroll") for(int r=0;r<16;++r){P0[r]=fsub_s(P0[r],dl);P1[r]=fsub_s(P1[r],dl);} \
      _Pragma("unroll") for(int r=0;r<16;++r)negm[r]=-mhat; asm volatile("":"+v"(negm)); } \
    _Pragma("unroll") for(int r=0;r<16;++r)P0[r]=__builtin_amdgcn_exp2f(P0[r]); }while(0)
  #define RESC() do{ if(resc){ asm volatile("s_waitcnt lgkmcnt(0)":::"memory"); \
      _Pragma("unroll") for(int d_=0;d_<2;++d_) _Pragma("unroll") for(int r=0;r<16;++r)o[d_][r]*=wsf[crow(r,hi)]; } }while(0)
  f32x16 pA0,pA1,pB0,pB1;
  int sl_prev=0,sl_cur=0,sl_next=SLOTB;
  #define ROT() do{sl_prev=sl_cur;sl_cur=sl_next;sl_next=(sl_next==(NSLOT-1)*SLOTB)?0:sl_next+SLOTB;}while(0)
  DMA_K(2,2*SLOTB);
  WAIT_BAR(3);
  qkt(pA0,pA1,Kbase,qr,negm,r32,hi);asm volatile("s_nop 15\n\ts_nop 7":"+v"(pA0),"+v"(pA1));CMASK(pA0,pA1,0);
  START(pA0,pA1);
  _Pragma("unroll") for(int r=0;r<16;++r)pA1[r]=__builtin_amdgcn_exp2f(pA1[r]);
  WAIT_BAR(0);
  DMA_K(3,0);DMA_V(1,SLOTB);
  ROT();
  kload8(kf,kp0+sl_cur);
  WAIT_BAR(2);
  s16x4 vlo[8],vhi[8]; u32x4 pw0,pw1,pw2,pw3;
  #define PKW(P,B) cvtpk_s(P[B],P[B+1])
  #define PAF(k) __builtin_bit_cast(bf16x8,pw##k)
  #define VFR(i) (bf16x8){vlo[i][0],vlo[i][1],vlo[i][2],vlo[i][3],vhi[i][0],vhi[i][1],vhi[i][2],vhi[i][3]}
  #define PIN(x) asm volatile("":"+v"(x))
  #define MX3(a,b,c) __builtin_fmaxf(__builtin_fmaxf((a),(b)),(c))
  #define GAPA(MF,A0,A1,A2,A3,W0,W1,PW) do{ MF; sacc+=A0; sacc+=A1; sacc+=A2; sacc+=A3; PIN(sacc); W0; W1; PIN(PW); SBAR(); }while(0)
  #define EX(v) __builtin_amdgcn_exp2f(v)
  #define GAPB(MF,X,B) do{ MF; X[B]=EX(X[B]); X[B+1]=EX(X[B+1]); X[B+2]=EX(X[B+2]); X[B+3]=EX(X[B+3]); PIN(X); SBAR(); }while(0)
  #define VRD(i) do{ vlo[i]=vtr(vp_+(((i)>>2)*4096+((i)&3)*1024)); vhi[i]=vtr(vp_+(((i)>>2)*4096+((i)&3)*1024+512)); }while(0)
  #define KRD(G,j) do{ if(G){ kload2(kf,kp0+sl_next,j); SBAR(); } }while(0)
  #define STEP(C0,C1,P0,P1,t,GK,GV,GL) do{ SBAR(); \
    const lds_cptr vp_=vp0+sl_prev; \
    VRD(0); SBAR(); float sacc=(P0[0]+P0[1]); \
    GAPA(C0=__builtin_amdgcn_mfma_f32_32x32x16_bf16(kf[0],qr[0],negm,0,0,0), P0[2],P0[3],P0[4],P0[5],     pw0[0]=PKW(P0,0), pw0[1]=PKW(P0,2), pw0); \
    VRD(4); SBAR(); GAPA(C1=__builtin_amdgcn_mfma_f32_32x32x16_bf16(kf[1],qr[0],negm,0,0,0), P0[6],P0[7],P0[8],P0[9],     pw0[2]=PKW(P0,4), pw0[3]=PKW(P0,6), pw0); \
    VRD(1); SBAR(); GAPA(C0=__builtin_amdgcn_mfma_f32_32x32x16_bf16(kf[2],qr[1],C0,0,0,0),   P0[10],P0[11],P0[12],P0[13], pw1[0]=PKW(P0,8), pw1[1]=PKW(P0,10), pw1); \
    VRD(5); SBAR(); GAPA(C1=__builtin_amdgcn_mfma_f32_32x32x16_bf16(kf[3],qr[1],C1,0,0,0),   P0[14],P0[15],P1[0],P1[1],   pw1[2]=PKW(P0,12),pw1[3]=PKW(P0,14), pw1); \
    VRD(2); SBAR(); GAPA(C0=__builtin_amdgcn_mfma_f32_32x32x16_bf16(kf[4],qr[2],C0,0,0,0),   P1[2],P1[3],P1[4],P1[5],     pw2[0]=PKW(P1,0), pw2[1]=PKW(P1,2), pw2); \
    VRD(6); SBAR(); GAPA(C1=__builtin_amdgcn_mfma_f32_32x32x16_bf16(kf[5],qr[2],C1,0,0,0),   P1[6],P1[7],P1[8],P1[9],     pw2[2]=PKW(P1,4), pw2[3]=PKW(P1,6), pw2); \
    VRD(3); SBAR(); GAPA(C0=__builtin_amdgcn_mfma_f32_32x32x16_bf16(kf[6],qr[3],C0,0,0,0),   P1[10],P1[11],P1[12],P1[13], pw3[0]=PKW(P1,8), pw3[1]=PKW(P1,10), pw3); \
    VRD(7); SBAR(); GAPA(C1=__builtin_amdgcn_mfma_f32_32x32x16_bf16(kf[7],qr[3],C1,0,0,0),   P1[14],P1[15],0.f,0.f,       pw3[2]=PKW(P1,12),pw3[3]=PKW(P1,14), pw3); \
    l_reg+=sacc; \
    if(GK){DMA_K((t)+3,sl_cur);} if(GV){DMA_V((t)+1,sl_next);} \
    CMASK(C0,C1,t); \
    { float a=MX3(C0[0],C0[1],C1[0]),b=MX3(C0[2],C0[3],C1[1]); a=MX3(a,C1[2],C1[3]); \
      _Pragma("unroll") for(int r=4;r<16;r+=4){a=MX3(a,C0[r],C0[r+1]);b=MX3(b,C0[r+2],C0[r+3]);a=MX3(a,C1[r],C1[r+1]);b=MX3(b,C1[r+2],C1[r+3]);} \
      float rm=__builtin_fmaxf(a,b); { auto rr=__builtin_amdgcn_permlane32_swap(__float_as_uint(rm),__float_as_uint(rm),false,false); rm=__builtin_fmaxf(__uint_as_float(rr[0]),__uint_as_float(rr[1])); } \
      resc=false; \
      if(__builtin_expect(__any(rm>(float)THRL),0)){ const float dl=__builtin_fmaxf(rm,0.f); mhat+=dl; \
        _Pragma("unroll") for(int r=0;r<16;++r){C0[r]-=dl;C1[r]-=dl;} \
        _Pragma("unroll") for(int r=0;r<16;++r)negm[r]=-mhat; asm volatile("":"+v"(negm)); \
        const float f=__builtin_amdgcn_exp2f(-dl); l_reg*=f; if(hi==0)wsf[r32]=f; resc=true; } } \
    SBAR(); \
    GAPB(o[0]=__builtin_amdgcn_mfma_f32_32x32x16_bf16(PAF(0),VFR(0),o[0],0,0,0), C0,0); \
    GAPB(o[1]=__builtin_amdgcn_mfma_f32_32x32x16_bf16(PAF(0),VFR(4),o[1],0,0,0), C0,4); \
    KRD(GL,0); GAPB(o[0]=__builtin_amdgcn_mfma_f32_32x32x16_bf16(PAF(1),VFR(1),o[0],0,0,0), C0,8); \
    KRD(GL,1); GAPB(o[1]=__builtin_amdgcn_mfma_f32_32x32x16_bf16(PAF(1),VFR(5),o[1],0,0,0), C0,12); \
    KRD(GL,2); GAPB(o[0]=__builtin_amdgcn_mfma_f32_32x32x16_bf16(PAF(2),VFR(2),o[0],0,0,0), C1,0); \
    KRD(GL,3); GAPB(o[1]=__builtin_amdgcn_mfma_f32_32x32x16_bf16(PAF(2),VFR(6),o[1],0,0,0), C1,4); \
    GAPB(o[0]=__builtin_amdgcn_mfma_f32_32x32x16_bf16(PAF(3),VFR(3),o[0],0,0,0), C1,8); \
    GAPB(o[1]=__builtin_amdgcn_mfma_f32_32x32x16_bf16(PAF(3),VFR(7),o[1],0,0,0), C1,12); \
    }while(0)
  int t=1;
  for(;t+5<NT;t+=2){
    STEP(pB0,pB1,pA0,pA1,t,true,true,true);     WAIT_BAR(2); RESC(); ROT();
    STEP(pA0,pA1,pB0,pB1,t+1,true,true,true);   WAIT_BAR(2); RESC(); ROT();
  }
  #define ENDW(tt) do{ if((tt)+3<NT){WAIT_BAR(2);} else if((tt)+2<NT){WAIT_BAR(1);} else {WAIT_BAR(0);} }while(0)
  for(;t+1<NT;t+=2){
    STEP(pB0,pB1,pA0,pA1,t,(t+3<NT),(t+1<NT),(t+1<NT));       ENDW(t);   RESC(); ROT();
    STEP(pA0,pA1,pB0,pB1,t+1,(t+4<NT),(t+2<NT),(t+2<NT));     ENDW(t+1); RESC(); ROT();
  }
  STEP(pB0,pB1,pA0,pA1,NT-1,false,false,false); RESC();
  { float sacc=pB0[0]+pB0[1]; _Pragma("unroll") for(int r=2;r<16;++r)sacc+=pB0[r]; _Pragma("unroll") for(int r=0;r<16;++r)sacc+=pB1[r]; l_reg+=sacc;
    pw0=(u32x4){PKW(pB0,0),PKW(pB0,2),PKW(pB0,4),PKW(pB0,6)};pw1=(u32x4){PKW(pB0,8),PKW(pB0,10),PKW(pB0,12),PKW(pB0,14)};pw2=(u32x4){PKW(pB1,0),PKW(pB1,2),PKW(pB1,4),PKW(pB1,6)};pw3=(u32x4){PKW(pB1,8),PKW(pB1,10),PKW(pB1,12),PKW(pB1,14)};
    SBAR(); pv(o,vb0+sl_cur,PAF(0),PAF(1),PAF(2),PAF(3)); }
  #undef PKW
  #undef PAF
  #undef VFR
  #undef PIN
  #undef MX3
  #undef GAPA
  #undef GAPB
  #undef EX
  #undef VRD
  #undef KRD
  #undef STEP
  #undef ENDW
  {auto rr=__builtin_amdgcn_permlane32_swap(__float_as_uint(l_reg),__float_as_uint(l_reg),false,false);l_reg=__uint_as_float(rr[0])+__uint_as_float(rr[1]);}
  if(hi==0)wsf[32+r32]=l_reg;asm volatile("s_waitcnt lgkmcnt(0)":::"memory");
  float rli[16];
  #pragma unroll
  for(int r=0;r<16;++r)rli[r]=__builtin_amdgcn_rcpf(wsf[32+crow(r,hi)]);
  bf16*Ow=O+(rowbase+q0+wid*QBLK)*OP+h*D;
  { bf16*stg=(bf16*)(shm+LDS_OST)+wid*2048;
    #pragma unroll
    for(int r=0;r<16;++r){const int orow=crow(r,hi);
      #pragma unroll
      for(int d0=0;d0<2;++d0)stg[orow*64+d0*32+r32]=(bf16)f2bf(o[d0][r]*rli[r]);}
    asm volatile("s_waitcnt lgkmcnt(0)":::"memory");
    #pragma unroll
    for(int i=0;i<4;++i){const int row=i*8+(lane>>3),ch=lane&7; const u32x4 v=*(const u32x4*)(stg+row*64+ch*8); ATTN_STORE16(Ow+(long)row*OP+ch*8,v);} }
  asm volatile("s_waitcnt lgkmcnt(0)\n\ts_barrier":::"memory");
  #undef DMA_K
  #undef DMA_V
  #undef CMASK
  #undef START
  #undef RESC
  #undef ROT
}
constexpr int ATTN_LDS_BYTES=LDS_BYTES;
struct AttnTensors { const bf16* Q; const bf16* K; const bf16* V; bf16* O; };
template<int THRL=8> __device__ __forceinline__ void attn_phase(char*lds,const AttnTensors&T){
  const int G=gridDim.x, bx=blockIdx.x, v=(G%8==0)?(bx%8)*(G/8)+bx/8:bx;
  for(int u=v;u<16*12*8;u+=G){
    const int pair=(u%256)/4, j=((u%256)%4)*6+u/256;
    const int b=pair>>2, kh=pair&3, g=j>>3, qb=j&7;
    attn_unit<THRL>(b,kh*3+g,qb,T.Q,T.K,T.V,T.O,lds);
  }
}
#undef SBAR
#undef WAIT_BAR
}

__device__ __forceinline__ void pool_item(const Params& p, LAS unsigned char* lds, int item, bool stage_w) {
    const int tid = TIDX, lane = tid & 63, wid = tid >> 6, r16 = lane & 15, q = lane >> 4;
    const int gi = item & 3, tile = item >> 2, t0 = tile * 64, b = t0 / SEQ, tl0 = t0 % SEQ, half = 1 << gi;
    const bf16_t* Ub = (const bf16_t*)(p.ws + OFF_U);
    bf16_t* AO = (bf16_t*)(p.ws + OFF_AO);
    LAS bf16_t* us = (LAS bf16_t*)lds;
    LAS bf16_t* dl = (LAS bf16_t*)(lds + 11520);
    LAS bf16_t* wt = (LAS bf16_t*)(lds + 11520 + 9216);
    __syncthreads();
    for (int i = tid; i < 80 * 8; i += 256) {
        const int r = i >> 3, ch = i & 7, tl = tl0 - 8 + r;
        u32x4 v = {0u, 0u, 0u, 0u};
        if (tl >= 0 && tl < SEQ) v = *(const u32x4*)(Ub + (size_t)(b * SEQ + tl) * 256 + gi * 64 + ch * 8);
        *(LAS u32x4*)(us + r * 72 + ch * 8) = v;
    }
    if (stage_w) {
#pragma unroll 4
        for (int k = 0; k < 16; ++k) {
            const int i = tid + 256 * k, c = i >> 6, dd = i & 63;
            wt[dd * 72 + c] = (bf16_t)f2bf(p.pool_w[gi * 4096 + i] * p.pool_scale[gi * 64 + dd]);
        }
    }
    __syncthreads();
    {
        const int c = tid & 63, seg = tid >> 6;
        int tl = tl0 + seg * 16;
        float sm = 0.f;
        for (int r = max(tl - half, 0); r < min(tl + half, SEQ); ++r) sm += bf2f(us[(r - tl0 + 8) * 72 + c]);
#pragma unroll
        for (int k = 0; k < 16; ++k, ++tl) {
            if (k > 0) {
                if (tl + half <= SEQ) sm += bf2f(us[(tl + half - 1 - tl0 + 8) * 72 + c]);
                if (tl - half > 0) sm -= bf2f(us[(tl - half - 1 - tl0 + 8) * 72 + c]);
            }
            const int cntw = min(tl + half, SEQ) - max(tl - half, 0);
            dl[(seg * 16 + k) * 72 + c] = (bf16_t)f2bf(sm / (float)cntw - bf2f(us[(tl - tl0 + 8) * 72 + c]));
        }
    }
    __syncthreads();
    {
        f32x4 acc[4];
#pragma unroll
        for (int nb = 0; nb < 4; ++nb) acc[nb] = (f32x4){0.f, 0.f, 0.f, 0.f};
#pragma unroll
        for (int ks = 0; ks < 2; ++ks) {
            const bf16x8 db = *(const LAS bf16x8*)(dl + (wid * 16 + r16) * 72 + ks * 32 + q * 8);
#pragma unroll
            for (int nb = 0; nb < 4; ++nb) {
                const bf16x8 wa = *(const LAS bf16x8*)(wt + (nb * 16 + r16) * 72 + ks * 32 + q * 8);
                acc[nb] = __builtin_amdgcn_mfma_f32_16x16x32_bf16(wa, db, acc[nb], 0, 0, 0);
            }
        }
        bf16_t* orow = AO + (size_t)(t0 + wid * 16 + r16) * D + gi * 64 + 4 * q;
#pragma unroll
        for (int nb = 0; nb < 4; ++nb) { u32x2 w; w.x = pk2(acc[nb][0], acc[nb][1]); w.y = pk2(acc[nb][2], acc[nb][3]); *(u32x2*)(orow + nb * 16) = w; }
    }
}

__device__ __forceinline__ void phase_attn_pool(const Params& p, LAS unsigned char* lds, char* smem) {
    const attn_body::AttnTensors AT{(const bf16_t*)(p.ws + OFF_Q), (const bf16_t*)(p.ws + OFF_K), (const bf16_t*)(p.ws + OFF_V), (bf16_t*)(p.ws + OFF_AO) + 256};
    attn_body::attn_phase<8>(smem, AT);
    __syncthreads();
    constexpr int N_POOL = (T / 64) * 4;
    { bool first = true; for (int it = VBLK; it < N_POOL; it += NVBLK) { pool_item(p, lds, it, first); first = false; } }
}

struct EpiOut {
    static constexpr bool PERM = false;
    const float* x; float* y; const float* mod; float* stats;
    __device__ __forceinline__ void operator()(const f32x4 (&acc)[2][2][4][2], const pg8::Unit& u, int wr, int wc, int fr, int fq) const {
        const float* g1 = mod + (size_t)(u.pm >> 3) * MODW + 2 * D;
        const int col0 = u.pn * 256 + wc * 32 + fq * 4;
        f32x4 gv[2][2];
#pragma unroll
        for (int bj = 0; bj < 2; ++bj)
#pragma unroll
            for (int n = 0; n < 2; ++n) gv[bj][n] = *(const f32x4*)(g1 + col0 + bj * 128 + n * 16);
        f32x4 xv[2][2][2];
        const size_t rstride = (size_t)16 * D;
        const float* xb = x + (size_t)(u.pm * 256 + wr * 64 + fr) * D + col0;
        float* yb = y + (size_t)(u.pm * 256 + wr * 64 + fr) * D + col0;
#pragma unroll
        for (int bj = 0; bj < 2; ++bj)
#pragma unroll
            for (int n = 0; n < 2; ++n) xv[0][bj][n] = *(const f32x4*)(xb + bj * 128 + n * 16);
#pragma unroll
        for (int k = 0; k < 8; ++k) {
            const int ai = k >> 2, m = k & 3;
            const size_t roff = (size_t)ai * 128 * D + (size_t)m * rstride;
            if (k < 7) {
                const size_t noff = (size_t)((k + 1) >> 2) * 128 * D + (size_t)((k + 1) & 3) * rstride;
#pragma unroll
                for (int bj = 0; bj < 2; ++bj)
#pragma unroll
                    for (int n = 0; n < 2; ++n) xv[(k + 1) & 1][bj][n] = *(const f32x4*)(xb + noff + bj * 128 + n * 16);
            }
            const int row = u.pm * 256 + ai * 128 + wr * 64 + m * 16 + fr;
            float s1 = 0.f, s2 = 0.f;
#pragma unroll
            for (int bj = 0; bj < 2; ++bj)
#pragma unroll
                for (int n = 0; n < 2; ++n) {
                    const f32x4 yv = xv[k & 1][bj][n] * ALPHA + gv[bj][n] * acc[ai][bj][m][n];
                    *(f32x4*)(yb + roff + bj * 128 + n * 16) = yv;
                    s1 += (yv[0] + yv[1]) + (yv[2] + yv[3]);
                    s2 += (yv[0] * yv[0] + yv[1] * yv[1]) + (yv[2] * yv[2] + yv[3] * yv[3]);
                }
            s1 += __shfl_xor(s1, 16); s1 += __shfl_xor(s1, 32);
            s2 += __shfl_xor(s2, 16); s2 += __shfl_xor(s2, 32);
            if (fq == 0) { float* st = stats + ((size_t)row * 16 + u.pn * 4 + wc) * 2; st[0] = s1; st[1] = s2; }
        }
    }
};
__device__ __forceinline__ void phase_outproj(const Params& p, LAS unsigned char* lds) {
    pg8::Gemm g{(const bf16_t*)(p.ws + OFF_AO), (const bf16_t*)(p.ws + OFF_WTOUT), p.ws, 1};
    pg8::DenseSched S{4, 512, 512, 0, 1, (int)gridDim.x, vcu_of_block()};
    EpiOut E{p.x, p.out, (const float*)(p.ws + OFF_MOD), (float*)(p.ws + OFF_STATS)};
    pg8::gemm_phase<D, EpiOut, pg8::DenseSched, false>(lds, g, S, E);
}

__device__ __forceinline__ void phase_router(const Params& p, LAS unsigned char* lds0) {
    const int tid = hw_tid(), lane = tid & 63, wid = tid >> 6, r16 = lane & 15, q = lane >> 4;
    const float* mod = (const float*)(p.ws + OFF_MOD);
    const float* stats = (const float*)(p.ws + OFF_STATS);
    bf16_t* H = (bf16_t*)(p.ws + OFF_H);
    const bf16_t* WRH = (const bf16_t*)(p.ws + OFF_WRH); const bf16_t* WRL = (const bf16_t*)(p.ws + OFF_WRL);
    int* gcnt = (int*)(p.ws + OFF_CNT);
    int* LDST = (int*)(p.ws + OFF_LDST);
    float* LWt = (float*)(p.ws + OFF_LW);
    LAS float* vec = (LAS float*)lds0;
    LAS float* lg = (LAS float*)(lds0 + 16384) + wid * 16 * 64;
    LAS int* lcnt = (LAS int*)(lds0 + 49152);
    LAS int* lbase = (LAS int*)(lds0 + 49152 + 256);
    LAS int* sel_ep = (LAS int*)(lds0 + 49152 + 512);
    LAS float* sel_w = (LAS float*)(lds0 + 49152 + 512 + 4096);
    for (int item = blockIdx.x; item < T / 128; item += gridDim.x) {
        const int t0 = item * 128, b = t0 / SEQ, tw0 = t0 + wid * 16;
        __syncthreads();
        if (tid < 64) lcnt[tid] = 0;
        for (int i = tid; i < 1024; i += 512) {
            vec[i] = p.ln1_g[i]; vec[1024 + i] = p.ln1_b[i];
            vec[2048 + i] = 1.f + mod[(size_t)b * MODW + 4 * D + i]; vec[3072 + i] = mod[(size_t)b * MODW + 3 * D + i];
        }
        float meanv = 0.f, rstdv = 0.f;
        if (lane < 16) {
            float s1 = 0.f, s2 = 0.f;
            const float* st = stats + (size_t)(tw0 + lane) * 32;
#pragma unroll
            for (int i = 0; i < 16; ++i) { s1 += st[2 * i]; s2 += st[2 * i + 1]; }
            meanv = s1 * (1.f / D);
            const float var = fmaxf(s2 * (1.f / D) - meanv * meanv, 0.f);
            rstdv = 1.0f / sqrtf(var + 1e-5f);
        }
        const float mu = __shfl(meanv, r16), rs = __shfl(rstdv, r16);
        __syncthreads();
        f32x4 acc[4];
#pragma unroll
        for (int nb = 0; nb < 4; ++nb) acc[nb] = (f32x4){0.f, 0.f, 0.f, 0.f};
        float* yrow = p.out + (size_t)(tw0 + r16) * D + q * 8;
        bf16_t* hrow = H + (size_t)(tw0 + r16) * D + q * 8;
        LAS unsigned char* wb = lds0 + 57856;
        f32x4 vn[4][2];
#pragma unroll
        for (int u = 0; u < 4; ++u) { vn[u][0] = *(const f32x4*)(yrow + u * 32); vn[u][1] = *(const f32x4*)(yrow + u * 32 + 4); }
        for (int ch = 0; ch < 4; ++ch) {
            __syncthreads();
#pragma unroll
            for (int i = 0; i < 8; ++i) {
                const int idx = tid + i * 512, part = idx >> 11, row = (idx >> 5) & 63, c16 = idx & 31;
                const u32x4 w = *(const u32x4*)((part ? WRL : WRH) + (size_t)row * D + ch * 256 + c16 * 8);
                *(LAS u32x4*)(wb + part * 33792 + row * 528 + c16 * 16) = w;
            }
            __syncthreads();
#pragma unroll
            for (int s4 = ch * 8; s4 < ch * 8 + 8; s4 += 4) {
                f32x4 vv[4][2];
#pragma unroll
                for (int u = 0; u < 4; ++u) { vv[u][0] = vn[u][0]; vv[u][1] = vn[u][1]; }
                if (s4 + 4 < 32) {
#pragma unroll
                    for (int u = 0; u < 4; ++u) { vn[u][0] = *(const f32x4*)(yrow + (s4 + 4 + u) * 32); vn[u][1] = *(const f32x4*)(yrow + (s4 + 4 + u) * 32 + 4); }
                }
#pragma unroll
                for (int u = 0; u < 4; ++u) {
                    const int s = s4 + u, k0 = s * 32 + q * 8;
                    float hv[8];
#pragma unroll
                    for (int hh = 0; hh < 2; ++hh) {
                        const f32x4 g = *(const LAS f32x4*)(vec + k0 + 4 * hh), bb = *(const LAS f32x4*)(vec + 1024 + k0 + 4 * hh);
                        const f32x4 sc = *(const LAS f32x4*)(vec + 2048 + k0 + 4 * hh), sh = *(const LAS f32x4*)(vec + 3072 + k0 + 4 * hh);
                        const f32x4 xm = (vv[u][hh] - mu) * rs * g + bb;
                        *(f32x4*)(yrow + s * 32 + 4 * hh) = xm;
                        const f32x4 h4 = xm * sc + sh;
                        hv[4 * hh + 0] = h4[0]; hv[4 * hh + 1] = h4[1]; hv[4 * hh + 2] = h4[2]; hv[4 * hh + 3] = h4[3];
                    }
                    unsigned wh[4], wl[4];
#pragma unroll
                    for (int i = 0; i < 4; ++i) {
                        const unsigned ha = f2bf(hv[2 * i]), hb = f2bf(hv[2 * i + 1]);
                        wh[i] = ha | (hb << 16);
                        wl[i] = pk2(hv[2 * i] - bf2f(ha), hv[2 * i + 1] - bf2f(hb));
                    }
                    *(u32x4*)(hrow + s * 32) = (u32x4){wh[0], wh[1], wh[2], wh[3]};
                    const bf16x8 ah = __builtin_bit_cast(bf16x8, (u32x4){wh[0], wh[1], wh[2], wh[3]}), al = __builtin_bit_cast(bf16x8, (u32x4){wl[0], wl[1], wl[2], wl[3]});
                    const int kb = ((s & 7) * 32 + q * 8) * 2;
#pragma unroll
                    for (int nb = 0; nb < 4; ++nb) {
                        const bf16x8 bh = *(const LAS bf16x8*)(wb + (nb * 16 + r16) * 528 + kb), bl = *(const LAS bf16x8*)(wb + 33792 + (nb * 16 + r16) * 528 + kb);
                        acc[nb] = __builtin_amdgcn_mfma_f32_16x16x32_bf16(ah, bh, acc[nb], 0, 0, 0);
                        acc[nb] = __builtin_amdgcn_mfma_f32_16x16x32_bf16(al, bh, acc[nb], 0, 0, 0);
                        acc[nb] = __builtin_amdgcn_mfma_f32_16x16x32_bf16(ah, bl, acc[nb], 0, 0, 0);
                    }
                }
            }
        }
#pragma unroll
        for (int nb = 0; nb < 4; ++nb)
#pragma unroll
            for (int j = 0; j < 4; ++j) lg[(4 * q + j) * 64 + nb * 16 + r16] = acc[nb][j];
        __syncthreads();
        const float bias = p.router_bias[lane];
        const int g = lane >> 3;
        for (int r0 = 0; r0 < 16; r0 += 4) {
            float sg[4], sel[4], msel[4]; bool keep[4];
#pragma unroll
            for (int u = 0; u < 4; ++u) {
                const float lgv = lg[(r0 + u) * 64 + lane];
                sg[u] = 1.0f / (1.0f + expf(-lgv));
                sel[u] = sg[u] + bias;
            }
            float m1[4], m2[4]; int cand[4];
#pragma unroll
            for (int u = 0; u < 4; ++u) { m1[u] = fmaxf(sel[u], __shfl_xor(sel[u], 1)); }
#pragma unroll
            for (int u = 0; u < 4; ++u) { m1[u] = fmaxf(m1[u], __shfl_xor(m1[u], 2)); }
#pragma unroll
            for (int u = 0; u < 4; ++u) { m1[u] = fmaxf(m1[u], __shfl_xor(m1[u], 4)); cand[u] = (sel[u] == m1[u]) ? lane : 64; }
#pragma unroll
            for (int u = 0; u < 4; ++u) { cand[u] = min(cand[u], __shfl_xor(cand[u], 1)); }
#pragma unroll
            for (int u = 0; u < 4; ++u) { cand[u] = min(cand[u], __shfl_xor(cand[u], 2)); }
#pragma unroll
            for (int u = 0; u < 4; ++u) { cand[u] = min(cand[u], __shfl_xor(cand[u], 4)); m2[u] = (lane == cand[u]) ? -INFINITY : sel[u]; }
#pragma unroll
            for (int u = 0; u < 4; ++u) { m2[u] = fmaxf(m2[u], __shfl_xor(m2[u], 1)); }
#pragma unroll
            for (int u = 0; u < 4; ++u) { m2[u] = fmaxf(m2[u], __shfl_xor(m2[u], 2)); }
#pragma unroll
            for (int u = 0; u < 4; ++u) { m2[u] = fmaxf(m2[u], __shfl_xor(m2[u], 4)); }
#pragma unroll
            for (int u = 0; u < 4; ++u) {
                const float gs = m1[u] + m2[u];
                int cntg = 0;
#pragma unroll
                for (int gg = 0; gg < 8; ++gg) { const float v = __shfl(gs, gg * 8); cntg += (v > gs || (v == gs && gg < g)) ? 1 : 0; }
                keep[u] = cntg < 4;
                msel[u] = keep[u] ? sel[u] : -INFINITY;
                lg[(r0 + u) * 64 + lane] = msel[u];
            }
            int cnt[4] = {0, 0, 0, 0};
#pragma unroll 4
            for (int q4 = 0; q4 < 16; ++q4) {
#pragma unroll
                for (int u = 0; u < 4; ++u) {
                    const f32x4 v = *(const LAS f32x4*)(lg + (r0 + u) * 64 + q4 * 4);
#pragma unroll
                    for (int i = 0; i < 4; ++i) cnt[u] += (v[i] > msel[u]) ? 1 : 0;
                }
            }
#pragma unroll
            for (int u = 0; u < 4; ++u) {
                bool ok = __popcll(__ballot(keep[u] && cnt[u] < 8)) == 8;
#pragma unroll
                for (int k = 0; k < 8; ++k) ok = ok && (__ballot(keep[u] && cnt[u] == k) != 0ull);
                if (!ok) {
                    int c2 = 0;
                    for (int e2 = 0; e2 < 64; ++e2) { const float v = lg[(r0 + u) * 64 + e2]; c2 += (v > msel[u] || (v == msel[u] && e2 < lane)) ? 1 : 0; }
                    cnt[u] = c2;
                }
            }
            float wsum[4]; bool chosen[4];
#pragma unroll
            for (int u = 0; u < 4; ++u) { chosen[u] = keep[u] && cnt[u] < 8; wsum[u] = chosen[u] ? sg[u] : 0.f; }
#pragma unroll
            for (int o = 1; o < 64; o <<= 1) {
#pragma unroll
                for (int u = 0; u < 4; ++u) wsum[u] += __shfl_xor(wsum[u], o);
            }
#pragma unroll
            for (int u = 0; u < 4; ++u) {
                if (chosen[u]) {
                    const int pos = atomicAdd((int*)&lcnt[lane], 1);
                    sel_ep[(wid * 16 + r0 + u) * 8 + cnt[u]] = lane | (pos << 8);
                    sel_w[(wid * 16 + r0 + u) * 8 + cnt[u]] = sg[u] / wsum[u] * 2.5f;
                }
            }
        }
        __syncthreads();
        if (tid < 64) { int tt = tid; asm volatile("" : "+v"(tt)); lbase[tt] = atomicAdd(&gcnt[tt], lcnt[tt]); }
        __syncthreads();
        for (int idx = tid; idx < 1024; idx += 512) {
            const int ep = sel_ep[idx], e = ep & 0xff, pos = ep >> 8, gi = lbase[e] + pos;
            LDST[(size_t)e * T + gi] = (t0 + (idx >> 3)) * NSLOT + (idx & 7);
            LWt[(size_t)e * T + gi] = sel_w[idx];
        }
    }
}

constexpr int LDS_ROWTAB = LDS_TAB, LDS_AUX = LDS_TAB + 12288, MOE_MAX_UNITS = 20, LDS_UTAB = LDS_CTL + 256, LDS_TSTART = LDS_UTAB + MOE_MAX_UNITS * 32;
__device__ __forceinline__ int moe_setup(const Params& p, LAS unsigned char* lds0, int nN, int bmul, int badd) {
    LAS int* tstart = (LAS int*)(lds0 + LDS_TSTART); LAS int* utab = (LAS int*)(lds0 + LDS_UTAB);
    const int* gcnt = (const int*)(p.ws + OFF_CNT);
    __syncthreads();
    if (hw_tid() == 0) {
        int a = 0;
        for (int e = 0; e < NEX; ++e) { const int c = e < NE ? gcnt[e] : T; tstart[e] = a; a += (c + 255) >> 8; }
        tstart[NEX] = a;
    }
    __syncthreads();
    const int total = tstart[NEX] * nN, G = gridDim.x, c = vcu_of_block();
    if (hw_tid() < MOE_MAX_UNITS) {
        const int i = hw_tid(), L = i * G + c;
        int pm = 0, pn = 0, e = 0, i0 = 0, cnt = 0;
        if (L < total) {
            const int mt = L / nN, pl = L % nN;
            for (int j = 1; j < NEX; ++j) e += (mt >= tstart[j]) ? 1 : 0;
            pm = mt; pn = e * bmul + badd + pl; i0 = (mt - tstart[e]) * 256; cnt = e < NE ? gcnt[e] : T;
        }
        utab[i * 8 + 0] = pm; utab[i * 8 + 1] = pn; utab[i * 8 + 2] = e; utab[i * 8 + 3] = i0; utab[i * 8 + 4] = cnt;
    }
    __syncthreads();
    const int n = (total - c + G - 1) / G;
    return n < 0 ? 0 : (n > MOE_MAX_UNITS ? MOE_MAX_UNITS : n);
}
struct MoeSched {
    LAS const int* utab; LAS const unsigned* rowtab; int n;
    __device__ __forceinline__ bool next(int i, pg8::Unit& u) const {
        if (i >= n) return false;
        u.pm = __builtin_amdgcn_readfirstlane(utab[i * 8 + 0]); u.pn = __builtin_amdgcn_readfirstlane(utab[i * 8 + 1]); u.e = __builtin_amdgcn_readfirstlane(utab[i * 8 + 2]); u.idx = i; return true;
    }
    __device__ __forceinline__ unsigned row_off(int i, int r) const { return rowtab[i * 256 + r]; }
    __device__ __forceinline__ void a_ready(const pg8::Unit&) const {}
    __device__ __forceinline__ void done(const pg8::Unit&) const {}
};
struct EpiGU {
    static constexpr bool PERM = true;
    LAS const float* auxw; unsigned char* ws;
    __device__ __forceinline__ void operator()(const f32x4 (&acc)[2][2][4][2], const pg8::Unit& u, int wr, int wc, int fr, int fq) const {
        const int pl = u.pn & 1;
        bf16_t* ACT = (bf16_t*)(ws + OFF_ACT) + (size_t)u.pm * 256 * FF + pl * 128 + wc * 32 + 8 * fq;
#pragma unroll
        for (int ai = 0; ai < 2; ++ai)
#pragma unroll
            for (int m = 0; m < 4; ++m) {
                const int rl = ai * 128 + wr * 64 + m * 16 + fr;
                const float wrow = auxw[u.idx * 256 + rl];
                float a[8];
#pragma unroll
                for (int n = 0; n < 2; ++n)
#pragma unroll
                    for (int q = 0; q < 4; ++q) { const float g = acc[ai][0][m][n][q], uu = acc[ai][1][m][n][q]; a[n * 4 + q] = g * __builtin_amdgcn_rcpf(1.f + __builtin_amdgcn_exp2f(g * -1.4426950408889634f)) * uu * wrow; }
                u32x4 w; w.x = pk2(a[0], a[1]); w.y = pk2(a[2], a[3]); w.z = pk2(a[4], a[5]); w.w = pk2(a[6], a[7]);
                *(u32x4*)(ACT + (size_t)rl * FF) = w;
            }
    }
};
__device__ __forceinline__ void phase_gateup(const Params& p, LAS unsigned char* lds0) {
    int n = moe_setup(p, lds0, 2, 2, 0); n = n > 12 ? 12 : n;
    LAS const int* utab = (LAS const int*)(lds0 + LDS_UTAB);
    LAS unsigned* rowtab = (LAS unsigned*)(lds0 + LDS_ROWTAB);
    LAS float* auxw = (LAS float*)(lds0 + LDS_AUX);
    const int* LDST = (const int*)(p.ws + OFF_LDST);
    const float* LWt = (const float*)(p.ws + OFF_LW);
    for (int i = 0; i < n; ++i) {
        const int e = utab[i * 8 + 2], i0 = utab[i * 8 + 3], cnt = utab[i * 8 + 4];
        if (hw_tid() < 256) {
            const int li = i0 + hw_tid(); int tok = 0; float w = 0.f;
            if (li < cnt) { if (e < NE) { tok = LDST[(size_t)e * T + li] / NSLOT; w = LWt[(size_t)e * T + li]; } else { tok = li; w = 1.f; } }
            rowtab[i * 256 + hw_tid()] = (unsigned)tok * (unsigned)(D * 2);
            auxw[i * 256 + hw_tid()] = w;
        }
    }
    __syncthreads();
    MoeSched S{utab, rowtab, n};
    pg8::Gemm g{(const bf16_t*)(p.ws + OFF_H), (const bf16_t*)(p.ws + OFF_WGU), p.ws, 2};
    EpiGU E{auxw, p.ws};
    pg8::gemm_phase<D, EpiGU, MoeSched, true>(lds0, g, S, E);
    {
        LAS const int* tstart = (LAS const int*)(lds0 + LDS_TSTART);
        const int total = tstart[NEX] * 2, G = gridDim.x, v = vcu_of_block(), rem = total % G;
        if (v >= rem) {
            const int lane = hw_tid() & 63, wv = hw_tid() >> 6, nw = (G - rem) * 8, w = (v - rem) * 8 + wv;
            LAS float* scr = (LAS float*)lds0 + wv * (64 * 33);
            for (int it = w; it < TR_N_D; it += nw) transpose_item(p, scr, TR_N_A + TR_N_GU + it, lane);
        }
    }
}
constexpr float FP8S = 32.f, FP8I = 1.f / 32.f;
__device__ __forceinline__ unsigned pk4_fp8(float a, float b, float c, float d) {
    a = __builtin_amdgcn_fmed3f(a * FP8S, -440.f, 440.f); b = __builtin_amdgcn_fmed3f(b * FP8S, -440.f, 440.f);
    c = __builtin_amdgcn_fmed3f(c * FP8S, -440.f, 440.f); d = __builtin_amdgcn_fmed3f(d * FP8S, -440.f, 440.f);
    int w = __builtin_amdgcn_cvt_pk_fp8_f32(a, b, 0, false);
    w = __builtin_amdgcn_cvt_pk_fp8_f32(c, d, w, true);
    return (unsigned)w;
}
struct EpiDown {
    static constexpr bool PERM = true;
    LAS const int* auxd; unsigned char* ws;
    __device__ __forceinline__ void operator()(const f32x4 (&acc)[2][2][4][2], const pg8::Unit& u, int wr, int wc, int fr, int fq) const {
        const int pl = u.pn & 3;
        unsigned char* SL = ws + OFF_SLOTS + pl * 256 + wc * 64 + 16 * fq;
#pragma unroll
        for (int ai = 0; ai < 2; ++ai)
#pragma unroll
            for (int m = 0; m < 4; ++m) {
                const int d = auxd[u.idx * 256 + ai * 128 + wr * 64 + m * 16 + fr];
                u32x4 w;
                w.x = pk4_fp8(acc[ai][0][m][0][0], acc[ai][0][m][0][1], acc[ai][0][m][0][2], acc[ai][0][m][0][3]);
                w.y = pk4_fp8(acc[ai][0][m][1][0], acc[ai][0][m][1][1], acc[ai][0][m][1][2], acc[ai][0][m][1][3]);
                w.z = pk4_fp8(acc[ai][1][m][0][0], acc[ai][1][m][0][1], acc[ai][1][m][0][2], acc[ai][1][m][0][3]);
                w.w = pk4_fp8(acc[ai][1][m][1][0], acc[ai][1][m][1][1], acc[ai][1][m][1][2], acc[ai][1][m][1][3]);
                *(u32x4*)(SL + (size_t)d * 1024) = w;
            }
    }
};
__device__ __forceinline__ void phase_down(const Params& p, LAS unsigned char* lds0) {
    const int n = moe_setup(p, lds0, 4, 4, 0);
    LAS const int* utab = (LAS const int*)(lds0 + LDS_UTAB);
    LAS int* auxd = (LAS int*)(lds0 + LDS_TAB);
    const int* LDST = (const int*)(p.ws + OFF_LDST);
    for (int i = 0; i < n; ++i) {
        const int e = utab[i * 8 + 2], i0 = utab[i * 8 + 3], cnt = utab[i * 8 + 4];
        if (hw_tid() < 256) {
            const int li = i0 + hw_tid();
            auxd[i * 256 + hw_tid()] = li < cnt ? (e < NE ? LDST[(size_t)e * T + li] : li * NSLOT + 8) : T * NSLOT;
        }
    }
    __syncthreads();
    MoeSched S{utab, (LAS const unsigned*)(lds0 + LDS_ROWTAB), n};
    pg8::Gemm g{(const bf16_t*)(p.ws + OFF_ACT), (const bf16_t*)(p.ws + OFF_WD), p.ws, 3};
    EpiDown E{auxd, p.ws};
    pg8::gemm_phase<FF, EpiDown, MoeSched, false>(lds0, g, S, E);
}

__device__ __forceinline__ void slot_sum16(const unsigned char* SL, int t, int cb, float (&s)[16]) {
#pragma unroll
    for (int i = 0; i < 16; ++i) s[i] = 0.f;
    u32x4 v[NSLOT];
#pragma unroll
    for (int k = 0; k < NSLOT; ++k) v[k] = *(const u32x4*)(SL + (size_t)(t * NSLOT + k) * 1024 + cb);
#pragma unroll
    for (int k = 0; k < NSLOT; ++k)
#pragma unroll
        for (int i = 0; i < 4; ++i) {
            typedef float f32x2 __attribute__((ext_vector_type(2)));
            const f32x2 lo = __builtin_amdgcn_cvt_pk_f32_fp8((int)v[k][i], false), hi = __builtin_amdgcn_cvt_pk_f32_fp8((int)v[k][i], true);
            s[4 * i] += lo.x; s[4 * i + 1] += lo.y; s[4 * i + 2] += hi.x; s[4 * i + 3] += hi.y;
        }
#pragma unroll
    for (int i = 0; i < 16; ++i) s[i] *= FP8I;
}
__device__ __forceinline__ int slot_col(int bb) { return (bb >> 4) * 256 + ((bb >> 2) & 3) * 32 + (bb & 3) * 8; }
__device__ __forceinline__ void phase_final(const Params& p) {
    const int lane = hw_tid() & 63, gw = blockIdx.x * 8 + (hw_tid() >> 6), ngw = gridDim.x * 8;
    const float* mod = (const float*)(p.ws + OFF_MOD);
    const unsigned char* SL = p.ws + OFF_SLOTS;
    const int c0 = slot_col(lane);
    for (int row = gw; row < T; row += ngw) {
        const float* g2 = mod + (size_t)(row / SEQ) * MODW + 5 * D;
        float f[16];
        slot_sum16(SL, row, lane * 16, f);
        f32x4 y[4]; float s = 0.f;
#pragma unroll
        for (int j = 0; j < 4; ++j) {
            const int cj = c0 + (j >> 1) * 128 + (j & 1) * 4;
            const f32x4 xm = *(const f32x4*)(p.out + (size_t)row * D + cj), gg = *(const f32x4*)(g2 + cj);
            y[j][0] = ALPHA * xm[0] + gg[0] * f[4 * j]; y[j][1] = ALPHA * xm[1] + gg[1] * f[4 * j + 1];
            y[j][2] = ALPHA * xm[2] + gg[2] * f[4 * j + 2]; y[j][3] = ALPHA * xm[3] + gg[3] * f[4 * j + 3];
            s += (y[j][0] + y[j][1]) + (y[j][2] + y[j][3]);
        }
#pragma unroll
        for (int o = 1; o < 64; o <<= 1) s += __shfl_xor(s, o);
        const float mean = s * (1.f / D);
        float qv = 0.f;
#pragma unroll
        for (int j = 0; j < 4; ++j) { y[j] = y[j] - mean; qv += (y[j][0] * y[j][0] + y[j][1] * y[j][1]) + (y[j][2] * y[j][2] + y[j][3] * y[j][3]); }
#pragma unroll
        for (int o = 1; o < 64; o <<= 1) qv += __shfl_xor(qv, o);
        const float rstd = 1.0f / sqrtf(qv * (1.f / D) + 1e-5f);
#pragma unroll
        for (int j = 0; j < 4; ++j) {
            const int cj = c0 + (j >> 1) * 128 + (j & 1) * 4;
            const f32x4 g = *(const f32x4*)(p.ln2_g + cj), bb4 = *(const f32x4*)(p.ln2_b + cj);
            *(f32x4*)(p.out + (size_t)row * D + cj) = y[j] * rstd * g + bb4;
        }
    }
}

#define XB_TMO      128
#define XB_XCNT(j)  (256  + 64 * (j))
#define XB_XSUB(j)  (1280 + 64 * (j))
#define XB_XGEN(j)  (2304 + 64 * (j))
#define XB_TOP      3328
#define XB_TOPGEN   3392
#define XCD_BAR_WORDS 3456
#define XB_SPIN_CAP (1u << 18)
__device__ __forceinline__ unsigned xb_ld(unsigned* p)              { return __hip_atomic_load(p, __ATOMIC_RELAXED, __HIP_MEMORY_SCOPE_AGENT); }
__device__ __forceinline__ unsigned xb_add(unsigned* p, unsigned v) { return __hip_atomic_fetch_add(p, v, __ATOMIC_RELAXED, __HIP_MEMORY_SCOPE_AGENT); }
__device__ __forceinline__ unsigned xb_xcc_id() { return (unsigned)__builtin_amdgcn_s_getreg((3 << 11) | 20) & 0xFu; }
#define XB_SPIN(cond, bar) do { unsigned _sp = 0; while (cond) { __builtin_amdgcn_s_sleep(1); \
    if ((++_sp & 255u) == 0u) { if (xb_ld(&(bar)[XB_TMO])) break; if (_sp > XB_SPIN_CAP) { atomicAdd(&(bar)[XB_TMO], 1u); break; } } } } while (0)
struct XcdBarrier { unsigned* bar; unsigned x; volatile LAS unsigned* st; };
__device__ __forceinline__ XcdBarrier xcd_barrier_post(unsigned* bar, volatile LAS unsigned* st) {
    XcdBarrier b; b.bar = bar; b.x = xb_xcc_id(); b.st = st;
    if (hw_tid() == 0) (void)xb_add(&bar[XB_XCNT(b.x)], 1u);
    return b;
}
__device__ __forceinline__ void xcd_barrier_complete(unsigned* bar, unsigned x, unsigned& nloc, unsigned& nx) {
    const unsigned G = gridDim.x * gridDim.y * gridDim.z;
    unsigned sum, cnt, mine, sp = 0u;
    for (;;) {
        sum = 0u; cnt = 0u; mine = 0u;
#pragma unroll
        for (unsigned j = 0; j < 16; ++j) { const unsigned c = xb_ld(&bar[XB_XCNT(j)]); sum += c; cnt += (c > 0u) ? 1u : 0u; mine = (j == x) ? c : mine; }
        if (sum == G) break;
        __builtin_amdgcn_s_sleep(1);
        if ((++sp & 255u) == 0u) { if (xb_ld(&bar[XB_TMO])) break; if (sp > XB_SPIN_CAP) { atomicAdd(&bar[XB_TMO], 1u); break; } }
    }
    nloc = mine > 0u ? mine : 1u; nx = cnt > 0u ? cnt : 1u;
}
__device__ __forceinline__ void xcd_barrier(const XcdBarrier& b) {
    asm volatile("s_waitcnt vmcnt(0)" ::: "memory");
    __syncthreads();
    if (hw_tid() == 0) {
        unsigned* bar = b.bar;
        __builtin_amdgcn_s_waitcnt(0);
        unsigned nloc = b.st[0], nx = b.st[1];
        if (nloc == 0u) { xcd_barrier_complete(bar, b.x, nloc, nx); b.st[0] = nloc; b.st[1] = nx; }
        const unsigned old = xb_add(&bar[XB_XSUB(b.x)], 1u);
        const unsigned gen = old / nloc;
        if (old + 1u == (gen + 1u) * nloc) {
            __builtin_amdgcn_fence(__ATOMIC_RELEASE, "agent");
            asm volatile("s_waitcnt vmcnt(0)" ::: "memory");
            const unsigned og = xb_add(&bar[XB_TOP], 1u);
            const unsigned tg = og / nx;
            if (og + 1u == (tg + 1u) * nx) xb_add(&bar[XB_TOPGEN], 1u);
            else XB_SPIN(xb_ld(&bar[XB_TOPGEN]) == tg, bar);
            __builtin_amdgcn_fence(__ATOMIC_ACQUIRE, "agent");
            xb_add(&bar[XB_XGEN(b.x)], 1u);
            asm volatile("s_waitcnt vmcnt(0)" ::: "memory");
        } else {
            XB_SPIN(xb_ld(&bar[XB_XGEN(b.x)]) == gen, bar);
            __builtin_amdgcn_fence(__ATOMIC_ACQUIRE, "agent");
            asm volatile("s_waitcnt vmcnt(0)" ::: "memory");
        }
    }
    __syncthreads();
}

constexpr size_t OFF_BAR = 448 * 1024;

__global__ void __launch_bounds__(512, 2) mk_fwd(Params p) {
    extern __shared__ __attribute__((aligned(16))) unsigned char smem[];
    LAS unsigned char* lds0 = (LAS unsigned char*)smem;
    {
        const unsigned hw = (unsigned)__builtin_amdgcn_s_getreg((5 << 11) | 4) & 63u;
        if ((threadIdx.x & 63) == 0) *(volatile LAS int*)(LDS_HWTAB + hw * 4) = (int)(threadIdx.x >> 6);
        if (threadIdx.x < 64) ((LAS unsigned*)(lds0 + LDS_CTL))[threadIdx.x] = 0u;
    }
    __syncthreads();
    unsigned char* const g_probe_ws = p.ws; (void)g_probe_ws;
    XcdBarrier bar; bar.bar = (unsigned*)(p.ws + OFF_BAR); bar.x = 0; bar.st = nullptr;
    bar = xcd_barrier_post((unsigned*)(p.ws + OFF_BAR), (volatile LAS unsigned*)(lds0 + LDS_CTL));
#define RUN_PHASE(k, call) { if ((k) > 0) xcd_barrier(bar); TS_BEGIN(16 + (k)); int on_ = 1; asm volatile("" : "+s"(on_)); if (on_) { int grp_ = hw_tid() >> 8; asm volatile("" : "+v"(grp_)); LAS unsigned char* lds = lds0 + grp_ * 32768; (void)lds; call; } TS_END(16 + (k)); }
    RUN_PHASE(0, phase_prep(p, lds))
    RUN_PHASE(1, phase_xn(p, lds))
    RUN_PHASE(2, phase_inproj(p, lds0))
    RUN_PHASE(3, phase_attn_pool(p, lds, (char*)smem))
    RUN_PHASE(4, phase_outproj(p, lds0))
    RUN_PHASE(5, phase_router(p, lds0))
    RUN_PHASE(6, phase_gateup(p, lds0))
    RUN_PHASE(7, phase_down(p, lds0))
    RUN_PHASE(8, phase_final(p))
#ifdef PROBE_ACC
    if (blockIdx.x == PROBE_BLK && hw_tid() == 0) {
        __builtin_amdgcn_s_waitcnt(0);
        const unsigned long long span = __hip_atomic_load((unsigned long long*)(p.ws + 448 * 1024 + 16384) + PROBE_ACC, __ATOMIC_RELAXED, __HIP_MEMORY_SCOPE_AGENT);
        const unsigned long long tend = __builtin_amdgcn_s_memrealtime() + PROBE_MUL * span; while (__builtin_amdgcn_s_memrealtime() < tend) __builtin_amdgcn_s_sleep(8);
    }
#endif
}

extern "C" void kernel_launch(void* const* d_in, const int* in_sizes, int n_in, void* d_out, int out_size, void* d_ws, size_t ws_size, hipStream_t stream) {
    static int grid = 0;
    if (grid == 0) {
        int dev = 0, cus = 0, per_cu = 0;
        (void)hipGetDevice(&dev);
        (void)hipDeviceGetAttribute(&cus, hipDeviceAttributeMultiprocessorCount, dev);
        (void)hipFuncSetAttribute((const void*)mk_fwd, hipFuncAttributeMaxDynamicSharedMemorySize, LDS_BYTES);
        (void)hipOccupancyMaxActiveBlocksPerMultiprocessor(&per_cu, (const void*)mk_fwd, 512, LDS_BYTES);
        if (per_cu < 1) fprintf(stderr, "kernel_launch: occupancy query says %d blocks per CU\n", per_cu);
        (void)hipGetLastError();
        grid = cus;
        if (ws_size < WS_NEED) fprintf(stderr, "kernel_launch: workspace too small: %zu < %zu\n", ws_size, (size_t)WS_NEED);
    }
    Params p{};
    const float** pp = (const float**)&p;
    for (int i = 0; i < 24; ++i) pp[i] = (const float*)d_in[i];
    p.out = (float*)d_out; p.ws = (unsigned char*)d_ws;
    (void)hipMemsetAsync((char*)d_ws + OFF_BAR, 0, 16384 + 512, stream);
    hipLaunchKernelGGL(mk_fwd, dim3(grid), dim3(512), LDS_BYTES, stream, p);
}
```

```cpp
#include <hip/hip_runtime.h>
#include <stdint.h>
#include <stdio.h>


#ifdef PROBE_ACC
#ifndef PROBE_BLK
#define PROBE_BLK 0
#endif
#ifndef PROBE_MUL
#define PROBE_MUL 8ull
#endif
#define TS_ADD(k, sgn) do { if (blockIdx.x == PROBE_BLK && hw_tid() == 0) { const unsigned long long t_ = __builtin_amdgcn_s_memrealtime(); \
    __hip_atomic_fetch_add((unsigned long long*)(g_probe_ws + 448 * 1024 + 16384) + (k), (sgn) ? t_ : (0ull - t_), __ATOMIC_RELAXED, __HIP_MEMORY_SCOPE_AGENT); } } while (0)
#define TS_BEGIN(k) TS_ADD(k, false)
#define TS_END(k) TS_ADD(k, true)
#else
#define TS_BEGIN(k) do {} while (0)
#define TS_END(k) do {} while (0)
#endif
#define LAS __attribute__((address_space(3)))
#define TIDX ((int)(hw_tid() & 255))
#define VBLK ((int)(blockIdx.x * 2 + (hw_tid() >> 8)))
#define NVBLK ((int)(gridDim.x * 2))
typedef unsigned short bf16_t;
typedef short bf16x8 __attribute__((ext_vector_type(8)));
typedef float f32x4 __attribute__((ext_vector_type(4)));
typedef unsigned u32x4 __attribute__((ext_vector_type(4)));
typedef unsigned u32x2 __attribute__((ext_vector_type(2)));

constexpr int D = 1024, NB = 16, SEQ = 2048, T = NB * SEQ, CTXL = 256, TC = NB * CTXL, KVL = CTXL + SEQ;
constexpr int PW = 1536, NE = 64, NEX = 65, FF = 256, NSLOT = 9, MODW = 6 * D;
constexpr float ALPHA = 1.189207115002721f;
constexpr float C2 = 0.125f * 1.4426950408889634f;
constexpr int NPHASE = 9;
constexpr int LDS_BYTES = 163840, LDS_TAB = 131072, LDS_CTL = 155648;
constexpr int LDS_HWTAB = LDS_CTL + 2048;
__device__ __forceinline__ int hw_tid() {
    const unsigned hw = (unsigned)__builtin_amdgcn_s_getreg((5 << 11) | 4) & 63u;
    const int w = __builtin_amdgcn_readfirstlane(*(volatile LAS int*)(LDS_HWTAB + hw * 4));
    return w * 64 + (int)__builtin_amdgcn_mbcnt_hi(~0u, __builtin_amdgcn_mbcnt_lo(~0u, 0u));
}

constexpr size_t MiB = 1u << 20;
constexpr size_t OFF_CNT = 0, OFF_MOD = 4096, OFF_ROPE = 512 * 1024;
constexpr size_t OFF_WTIN = 1 * MiB, OFF_WTOUT = 4 * MiB, OFF_WD = 6 * MiB, OFF_LDST = 39 * MiB, OFF_ACT = 47 * MiB;
constexpr size_t OFF_SLOTS = 201 * MiB;
constexpr size_t OFF_WGU = 201 * MiB, OFF_H = 266 * MiB, OFF_LW = 330 * MiB;
constexpr size_t OFF_XN = 47 * MiB, OFF_Q = 119 * MiB, OFF_K = 167 * MiB;
constexpr size_t OFF_V = 338 * MiB, OFF_U = 356 * MiB, OFF_AO = 372 * MiB, OFF_STATS = 436 * MiB;
constexpr size_t OFF_WRH = 490 * MiB, OFF_WRL = OFF_WRH + 128 * 1024;
constexpr size_t WS_NEED = 491 * MiB;

struct Params {
    const float *x, *c, *ctx, *c_ctx, *w_mod, *b_mod, *w_in, *q_norm, *k_norm, *pool_w, *pool_scale, *w_out, *ln1_g, *ln1_b,
        *w_router, *router_bias, *w_gate, *w_up, *w_down, *ws_gate, *ws_up, *ws_down, *ln2_g, *ln2_b;
    float* out;
    unsigned char* ws;
};

__device__ __forceinline__ unsigned f2bf(float f) { unsigned u = __float_as_uint(f); return (u + 0x7fffu + ((u >> 16) & 1u)) >> 16; }
__device__ __forceinline__ unsigned pk2(float lo, float hi) { return f2bf(lo) | (f2bf(hi) << 16); }
__device__ __forceinline__ float bf2f(unsigned h) { return __uint_as_float(h << 16); }
__device__ __forceinline__ float bflo(unsigned w) { return __uint_as_float(w << 16); }
__device__ __forceinline__ float bfhi(unsigned w) { return __uint_as_float(w & 0xffff0000u); }

namespace pg8 {
constexpr int BM = 256, BK = 64, HALF = 128, HTB = HALF * BK * 2, STAGE_BYTES = 8 * HTB;
__host__ __device__ __forceinline__ int lds_byte(int r, int c) { const int st = (r >> 4) * 2 + (c >> 5), rr = r & 15, cc = c & 31, ob = rr * 64 + cc * 2; return st * 1024 + (ob ^ (((ob >> 9) & 1) << 5)); }
__host__ __device__ __forceinline__ void stage_rc(int b, int& R, int& C) { const int st = b / 1024, sb = b % 1024, swz = sb ^ (((sb >> 9) & 1) << 5); R = (st >> 1) * 16 + swz / 64; C = (st & 1) * 32 + (swz % 64) / 2; }
__host__ __device__ __forceinline__ int perm32(int rho) { const int n = rho >> 4, i = rho & 15; return 8 * (i >> 2) + 4 * n + (i & 3); }
struct Unit { int pm, pn, idx, e; };
struct Gemm { const bf16_t* A; const bf16_t* Bt; unsigned char* pws; int tsid; };
__device__ __forceinline__ unsigned cvt_pk_bf16(float lo, float hi) { unsigned r; asm volatile("v_cvt_pk_bf16_f32 %0, %1, %2" : "=v"(r) : "v"(lo), "v"(hi)); return r; }

template <int K, class Epi, class Sched, bool GATHER, bool ALIGN_EPI = true>
__device__ __forceinline__ void gemm_phase(LAS unsigned char* lds, const Gemm g, const Sched& S, const Epi& E) {
    const int tid = hw_tid(), wid = __builtin_amdgcn_readfirstlane(tid >> 6), lane = tid & 63, wr = wid >> 2, wc = wid & 3, fr = lane & 15, fq = lane >> 4;
    constexpr int nt = K / BK;
    unsigned voffA[2], voffB[2], colA = 0; int rowA = 0;
#pragma unroll
    for (int i = 0; i < 2; ++i) { int R, C; stage_rc(tid * 16 + i * 8192, R, C); const int Rb = Epi::PERM ? ((R & ~31) + perm32(R & 31)) : R;
        voffA[i] = (unsigned)(R * K + C) * 2u; voffB[i] = (unsigned)(Rb * K + C) * 2u; if (i == 0) { colA = (unsigned)C * 2u; rowA = R; } }
    const size_t kstep = (size_t)(BK * 2);
    const size_t hstep = (size_t)HALF * K * 2;
    const size_t tstep = 2 * hstep;
    const unsigned ldsw = (unsigned)wid * 1024u;
    const int aoff = lds_byte(wr * 64 + fr, fq * 8), boff = lds_byte(wc * 32 + fr, fq * 8);
#define PG8_SA(b, h) (((b) * 2 + (h)) * HTB)
#define PG8_SB(b, h) ((4 + (b) * 2 + (h)) * HTB)
#define PG8_STAGE(bufoff, gbase, voff) do { _Pragma("unroll") for (int _i = 0; _i < 2; ++_i) \
        __builtin_amdgcn_global_load_lds((const unsigned*)((const char*)(gbase) + (voff)[_i]), (LAS unsigned*)(lds + (bufoff) + ldsw + _i * 8192), 16, 0, 0); } while (0)
#define PG8_STAGE_A(bufoff, ptr, h, NX) do { if constexpr (GATHER) { unsigned _v[2]; \
            if (NX) { _v[0] = S.row_off(nidx, (h) * HALF + rowA) + colA; _v[1] = S.row_off(nidx, (h) * HALF + rowA + 64) + colA; } else { _v[0] = vA[h][0]; _v[1] = vA[h][1]; } PG8_STAGE(bufoff, ptr, _v); } \
        else { PG8_STAGE(bufoff, (ptr) + (h) * hstep, voffA); } } while (0)
#define PG8_LDA(dst, b, h) do { _Pragma("unroll") for (int m = 0; m < 4; ++m) _Pragma("unroll") for (int k = 0; k < 2; ++k) dst[m][k] = *(const LAS bf16x8*)(lds + PG8_SA(b, h) + aoff + m * 2048 + k * 1024); } while (0)
#define PG8_LDB(dst, b, h) do { _Pragma("unroll") for (int n = 0; n < 2; ++n) _Pragma("unroll") for (int k = 0; k < 2; ++k) dst[n][k] = *(const LAS bf16x8*)(lds + PG8_SB(b, h) + boff + n * 2048 + k * 1024); } while (0)
#define PG8_MMA(ai, bj, At, Bt) do { __builtin_amdgcn_s_setprio(1); _Pragma("unroll") for (int m = 0; m < 4; ++m) _Pragma("unroll") for (int n = 0; n < 2; ++n) _Pragma("unroll") for (int k = 0; k < 2; ++k) \
        acc[ai][bj][m][n] = __builtin_amdgcn_mfma_f32_16x16x32_bf16(Bt[n][k], At[m][k], acc[ai][bj][m][n], 0, 0, 0); __builtin_amdgcn_s_setprio(0); } while (0)
#define PG8_WAIT_V(n) asm volatile("s_waitcnt vmcnt(" #n ")" ::: "memory")
#define PG8_WAIT_L(n) asm volatile("s_waitcnt lgkmcnt(" #n ")" ::: "memory")
#define PG8_BAR __builtin_amdgcn_s_barrier()
#define PG8_SCHED __builtin_amdgcn_sched_barrier(0)
    unsigned char* const g_probe_ws = g.pws; (void)g_probe_ws;
    Unit cur, nxt; int ui = 0;
    if (!S.next(0, cur)) return;
    f32x4 acc[2][2][4][2];
#pragma unroll
    for (int a = 0; a < 2; ++a)
#pragma unroll
        for (int b = 0; b < 2; ++b)
#pragma unroll
            for (int m = 0; m < 4; ++m)
#pragma unroll
                for (int n = 0; n < 2; ++n) acc[a][b][m][n] = (f32x4){0.f, 0.f, 0.f, 0.f};
    bf16x8 At[4][2], B0[2][2], B1[2][2];
    unsigned vA[2][2]; int nidx = 0;
    if constexpr (GATHER) {
#pragma unroll
        for (int h = 0; h < 2; ++h)
#pragma unroll
            for (int i = 0; i < 2; ++i) vA[h][i] = S.row_off(cur.idx, h * HALF + rowA + 64 * i) + colA;
    }
    const char* cA = GATHER ? (const char*)g.A : (const char*)g.A + (size_t)cur.pm * tstep; const char* cB = (const char*)g.Bt + (size_t)cur.pn * tstep;
    S.a_ready(cur);
    PG8_STAGE(PG8_SB(0, 0), cB, voffB); PG8_STAGE(PG8_SB(0, 1), cB + hstep, voffB); PG8_STAGE_A(PG8_SA(0, 0), cA, 0, false); PG8_STAGE_A(PG8_SA(0, 1), cA, 1, false);
    if (wr == 1) PG8_BAR;
    PG8_WAIT_V(2); PG8_BAR;
    PG8_STAGE(PG8_SB(1, 0), cB + kstep, voffB); PG8_STAGE_A(PG8_SA(1, 0), cA + kstep, 0, false); PG8_STAGE(PG8_SB(1, 1), cB + hstep + kstep, voffB);
    PG8_WAIT_V(6); PG8_BAR;
    for (;;) {
        const bool has_next = S.next(ui + 1, nxt);
        if constexpr (GATHER) nidx = has_next ? nxt.idx : cur.idx;
        const char* nA = GATHER ? (const char*)g.A : (has_next ? (const char*)g.A + (size_t)nxt.pm * tstep : cA); const char* nB = has_next ? (const char*)g.Bt + (size_t)nxt.pn * tstep : cB;
        TS_BEGIN(33 + 2 * g.tsid);
        for (int t = 0; t < nt; t += 2) {
            const bool last = (t == nt - 2);
            const char* a1 = cA + (size_t)(t + 1) * kstep;
            const char* a2 = last ? nA : cA + (size_t)(t + 2) * kstep; const char* b2 = last ? nB : cB + (size_t)(t + 2) * kstep;
            const char* a3 = a2 + kstep; const char* b3 = b2 + kstep;
            if (last && has_next) S.a_ready(nxt);
            PG8_LDB(B0, 0, 0); PG8_LDB(B1, 0, 1); PG8_SCHED; PG8_LDA(At, 0, 0); PG8_STAGE_A(PG8_SA(1, 1), a1, 1, false);
            PG8_WAIT_V(8); PG8_WAIT_L(0); PG8_BAR; PG8_MMA(0, 0, At, B0); PG8_MMA(0, 1, At, B1); PG8_BAR; PG8_SCHED;
            PG8_LDA(At, 0, 1); PG8_STAGE(PG8_SB(0, 0), b2, voffB); PG8_STAGE(PG8_SB(0, 1), b2 + hstep, voffB); PG8_STAGE_A(PG8_SA(0, 0), a2, 0, last);
            PG8_WAIT_V(8); PG8_WAIT_L(0); PG8_BAR; PG8_MMA(1, 0, At, B0); PG8_MMA(1, 1, At, B1); PG8_BAR; PG8_SCHED;
            PG8_LDB(B0, 1, 0); PG8_LDB(B1, 1, 1); PG8_SCHED; PG8_LDA(At, 1, 0); PG8_STAGE_A(PG8_SA(0, 1), a2, 1, last);
            PG8_WAIT_V(8); PG8_WAIT_L(0); PG8_BAR; PG8_MMA(0, 0, At, B0); PG8_MMA(0, 1, At, B1); PG8_BAR; PG8_SCHED;
            PG8_LDA(At, 1, 1); PG8_STAGE(PG8_SB(1, 0), b3, voffB); PG8_STAGE(PG8_SB(1, 1), b3 + hstep, voffB); PG8_STAGE_A(PG8_SA(1, 0), a3, 0, last);
            PG8_WAIT_V(8); PG8_WAIT_L(0); PG8_BAR; PG8_MMA(1, 0, At, B0); PG8_MMA(1, 1, At, B1); PG8_BAR; PG8_SCHED;
        }
        TS_END(33 + 2 * g.tsid);
        if constexpr (ALIGN_EPI) { if (wr == 0) PG8_BAR; }
        TS_BEGIN(32 + 2 * g.tsid); E(acc, cur, wr, wc, fr, fq); S.done(cur); TS_END(32 + 2 * g.tsid);
        if (!has_next) break;
#pragma unroll
        for (int a = 0; a < 2; ++a)
#pragma unroll
            for (int b = 0; b < 2; ++b)
#pragma unroll
                for (int m = 0; m < 4; ++m)
#pragma unroll
                    for (int n = 0; n < 2; ++n) acc[a][b][m][n] = (f32x4){0.f, 0.f, 0.f, 0.f};
        cur = nxt; cA = nA; cB = nB; ++ui;
        if constexpr (GATHER) {
#pragma unroll
            for (int h = 0; h < 2; ++h)
#pragma unroll
                for (int i = 0; i < 2; ++i) vA[h][i] = S.row_off(cur.idx, h * HALF + rowA + 64 * i) + colA;
        }
        if constexpr (ALIGN_EPI) { if (wr == 1) PG8_BAR; }
    }
    PG8_WAIT_V(0);
    if constexpr (!ALIGN_EPI) { if (wr == 0) PG8_BAR; }
    PG8_BAR;
#undef PG8_SA
#undef PG8_SB
#undef PG8_STAGE
#undef PG8_STAGE_A
#undef PG8_LDA
#undef PG8_LDB
#undef PG8_MMA
#undef PG8_WAIT_V
#undef PG8_WAIT_L
#undef PG8_BAR
#undef PG8_SCHED
}

struct DenseSched {
    int nN, n1, total, pn2lo, nN2, G, c;
    __device__ __forceinline__ bool next(int i, Unit& u) const {
        const int L = i * G + c; if (L >= total) return false;
        if (L < n1) { u.pm = L / nN; u.pn = L % nN; } else { const int r = L - n1; u.pm = n1 / nN + r / nN2; u.pn = pn2lo + r % nN2; }
        u.idx = i; u.e = 0; return true;
    }
    __device__ __forceinline__ void a_ready(const Unit&) const {}
    __device__ __forceinline__ void done(const Unit&) const {}
};
}

__device__ __forceinline__ int win_row(int n) { return (n & ~255) + 128 * ((n >> 5) & 1) + 32 * ((n >> 6) & 3) + (n & 31); }
__device__ __forceinline__ int gu_row(int j, int half) { return (j >> 7) * 256 + half * 128 + (j & 127); }

template <class RowMap>
__device__ __forceinline__ void transpose_tile(LAS float* tile, const float* src, int ld, int k0, int n0, bf16_t* dst, int Kdst, RowMap rowmap) {
    const int tid = TIDX;
#pragma unroll
    for (int pss = 0; pss < 4; ++pss) {
        const int k = pss * 16 + (tid >> 4), n4 = (tid & 15) * 4;
        const f32x4 v = *(const f32x4*)(src + (size_t)(k0 + k) * ld + n0 + n4);
        tile[k * 65 + n4 + 0] = v[0]; tile[k * 65 + n4 + 1] = v[1]; tile[k * 65 + n4 + 2] = v[2]; tile[k * 65 + n4 + 3] = v[3];
    }
    __syncthreads();
    {
        const int n = tid >> 2, kc = (tid & 3) * 16;
        unsigned w[8];
#pragma unroll
        for (int i = 0; i < 8; ++i) w[i] = pk2(tile[(kc + 2 * i) * 65 + n], tile[(kc + 2 * i + 1) * 65 + n]);
        bf16_t* dp = dst + (size_t)rowmap(n0 + n) * Kdst + k0 + kc;
        *(u32x4*)dp = (u32x4){w[0], w[1], w[2], w[3]};
        *(u32x4*)(dp + 8) = (u32x4){w[4], w[5], w[6], w[7]};
    }
    __syncthreads();
}

template <class RowMap>
__device__ __forceinline__ void wave_transpose(LAS float* scr, const float* src, int ld, int k0, int n0, bf16_t* dst, int Kdst, RowMap rowmap, int lane) {
#pragma unroll
    for (int i = 0; i < 8; ++i) {
        const int kk = 8 * i + (lane >> 3), n4 = (lane & 7) * 4;
        const f32x4 v = *(const f32x4*)(src + (size_t)(k0 + kk) * ld + n0 + n4);
        scr[kk * 33 + n4] = v[0]; scr[kk * 33 + n4 + 1] = v[1]; scr[kk * 33 + n4 + 2] = v[2]; scr[kk * 33 + n4 + 3] = v[3];
    }
    asm volatile("s_waitcnt lgkmcnt(0)" ::: "memory");
    const int c = lane & 7;
#pragma unroll
    for (int j = 0; j < 4; ++j) {
        const int n = (lane >> 3) + 8 * j; const LAS float* sp = scr + (8 * c) * 33 + n;
        u32x4 o; o.x = pk2(sp[0], sp[33]); o.y = pk2(sp[2 * 33], sp[3 * 33]); o.z = pk2(sp[4 * 33], sp[5 * 33]); o.w = pk2(sp[6 * 33], sp[7 * 33]);
        *(u32x4*)(dst + (size_t)rowmap(n0 + n) * Kdst + k0 + 8 * c) = o;
    }
    asm volatile("s_waitcnt lgkmcnt(0)" ::: "memory");
}

constexpr int TR_N_A = 16 * 48 + 16 * 32, TR_N_GU = NEX * 256, TR_N_D = NEX * 128;
constexpr int TR_GU_LATE = 224 * 8 * 6;
__device__ __forceinline__ void transpose_item(const Params& p, LAS float* scr, int id, int lane) {
    if (id < 16 * 48) { wave_transpose(scr, p.w_in, PW, (id / 48) * 64, (id % 48) * 32, (bf16_t*)(p.ws + OFF_WTIN), D, [](int n) { return win_row(n); }, lane); return; }
    id -= 16 * 48;
    if (id < 16 * 32) { wave_transpose(scr, p.w_out, D, (id / 32) * 64, (id % 32) * 32, (bf16_t*)(p.ws + OFF_WTOUT), D, [](int n) { return n; }, lane); return; }
    id -= 16 * 32;
    if (id < TR_N_GU) {
        const int e = id >> 8, q = id & 255, half = q >> 7, rr = q & 127;
        const float* src = half ? (e < NE ? p.w_up + (size_t)e * D * FF : p.ws_up) : (e < NE ? p.w_gate + (size_t)e * D * FF : p.ws_gate);
        wave_transpose(scr, src, FF, (rr / 8) * 64, (rr % 8) * 32, (bf16_t*)(p.ws + OFF_WGU) + (size_t)e * 512 * D, D, [half](int n) { return gu_row(n, half); }, lane);
        return;
    }
    id -= TR_N_GU;
    {
        const int e = id >> 7, rr = id & 127;
        const float* src = e < NE ? p.w_down + (size_t)e * FF * D : p.ws_down;
        wave_transpose(scr, src, D, (rr / 32) * 64, (rr % 32) * 32, (bf16_t*)(p.ws + OFF_WD) + (size_t)e * D * FF, FF, [](int n) { return n; }, lane);
    }
}

__device__ __forceinline__ void phase_prep(const Params& p, LAS unsigned char* lds) {
    const int tid = TIDX;
    int* gcnt = (int*)(p.ws + OFF_CNT);
    if (VBLK == 0 && tid < 128) gcnt[tid] = 0;
    float* mod = (float*)(p.ws + OFF_MOD);
    float* rope = (float*)(p.ws + OFF_ROPE);
    constexpr int N_MOD = 384, N_ROPE = 256, N_TR = 16;
    for (int it = VBLK; it < N_MOD + N_ROPE + N_TR; it += NVBLK) {
        if (it < N_MOD) {
            LAS float* sl = (LAS float*)lds;
            LAS float* red = (LAS float*)(lds + 10240);
            const int col = it * 16 + (tid & 15), kk = tid >> 4;
            float acc[17];
#pragma unroll
            for (int r = 0; r < 17; ++r) acc[r] = 0.f;
            for (int kc = 0; kc < 8; ++kc) {
                float wv[8];
#pragma unroll
                for (int i = 0; i < 8; ++i) wv[i] = p.w_mod[(size_t)(kc * 128 + kk + 16 * i) * MODW + col];
                __syncthreads();
                for (int o = tid; o < 17 * 128; o += 256) {
                    const int r = o >> 7, kl = o & 127;
                    const float cv = (r < 16) ? p.c[r * D + kc * 128 + kl] : p.c_ctx[kc * 128 + kl];
                    sl[kl * 20 + r] = cv / (1.f + expf(-cv));
                }
                __syncthreads();
#pragma unroll
                for (int i = 0; i < 8; ++i) {
                    const int kl = kk + 16 * i;
                    const f32x4 s0 = *(const LAS f32x4*)(sl + kl * 20), s1 = *(const LAS f32x4*)(sl + kl * 20 + 4), s2 = *(const LAS f32x4*)(sl + kl * 20 + 8), s3 = *(const LAS f32x4*)(sl + kl * 20 + 12);
                    const float s4 = sl[kl * 20 + 16];
#pragma unroll
                    for (int q = 0; q < 4; ++q) { acc[q] += s0[q] * wv[i]; acc[4 + q] += s1[q] * wv[i]; acc[8 + q] += s2[q] * wv[i]; acc[12 + q] += s3[q] * wv[i]; }
                    acc[16] += s4 * wv[i];
                }
            }
#pragma unroll
            for (int r = 0; r < 17; ++r) red[(kk * 17 + r) * 16 + (tid & 15)] = acc[r];
            __syncthreads();
            for (int o = tid; o < 17 * 16; o += 256) {
                const int r = o >> 4, j = o & 15;
                float sm = p.b_mod[it * 16 + j];
#pragma unroll
                for (int g = 0; g < 16; ++g) sm += red[(g * 17 + r) * 16 + j];
                mod[r * MODW + it * 16 + j] = sm;
            }
            __syncthreads();
        } else if (it < N_MOD + N_ROPE) {
            const int idx = (it - N_MOD) * 256 + tid, t = idx >> 5, i = idx & 31;
            const int pos = (i < 16) ? (t >> 6) : (t & 63);
            const float invf = (float)exp(-(double)(i & 15) / 16.0 * 9.210340371976184);
            const double ang = (double)((float)pos * invf);
            rope[idx * 2 + 0] = (float)cos(ang);
            rope[idx * 2 + 1] = (float)sin(ang);
        } else {
            LAS float* tile = (LAS float*)lds;
            const int idx = it - N_MOD - N_ROPE;
            {

                const int k0 = idx * 64;
#pragma unroll
                for (int pss = 0; pss < 4; ++pss) {
                    const int k = pss * 16 + (tid >> 4), n4 = (tid & 15) * 4;
                    const f32x4 v = *(const f32x4*)(p.w_router + (size_t)(k0 + k) * NE + n4);
                    tile[k * 65 + n4 + 0] = v[0]; tile[k * 65 + n4 + 1] = v[1]; tile[k * 65 + n4 + 2] = v[2]; tile[k * 65 + n4 + 3] = v[3];
                }
                __syncthreads();
                {
                    const int n = tid >> 2, kc = (tid & 3) * 16;
                    unsigned wh[8], wl[8];
#pragma unroll
                    for (int i = 0; i < 8; ++i) {
                        const float a = tile[(kc + 2 * i) * 65 + n], b = tile[(kc + 2 * i + 1) * 65 + n];
                        const unsigned ha = f2bf(a), hb = f2bf(b);
                        wh[i] = ha | (hb << 16);
                        wl[i] = pk2(a - bf2f(ha), b - bf2f(hb));
                    }
                    bf16_t* dh = (bf16_t*)(p.ws + OFF_WRH) + (size_t)n * D + k0 + kc;
                    bf16_t* dl = (bf16_t*)(p.ws + OFF_WRL) + (size_t)n * D + k0 + kc;
                    *(u32x4*)dh = (u32x4){wh[0], wh[1], wh[2], wh[3]}; *(u32x4*)(dh + 8) = (u32x4){wh[4], wh[5], wh[6], wh[7]};
                    *(u32x4*)dl = (u32x4){wl[0], wl[1], wl[2], wl[3]}; *(u32x4*)(dl + 8) = (u32x4){wl[4], wl[5], wl[6], wl[7]};
                }
                __syncthreads();
            }
        }
    }
    __syncthreads();
    {
        const int lane = hw_tid() & 63, wv = hw_tid() >> 6;
        LAS float* scr = (LAS float*)(lds - (hw_tid() >> 8) * 32768) + wv * (64 * 33);
        constexpr int NHERE = TR_N_A + (TR_N_GU - TR_GU_LATE);
        for (int it = blockIdx.x * 8 + wv; it < NHERE; it += gridDim.x * 8) transpose_item(p, scr, it < TR_N_A ? it : it + TR_GU_LATE, lane);
    }
}

__device__ __forceinline__ void phase_xn(const Params& p) {
    const int lane = hw_tid() & 63, gw = blockIdx.x * 8 + (hw_tid() >> 6), ngw = gridDim.x * 8;
    const float* mod = (const float*)(p.ws + OFF_MOD);
    bf16_t* XN = (bf16_t*)(p.ws + OFF_XN);
    for (int qd = gw; qd < (T + TC) / 4; qd += ngw) {
        const int row = qd * 4;
        const float* src = row < T ? p.x + (size_t)row * D : p.ctx + (size_t)(row - T) * D;
        const float* mr = mod + (size_t)(row < T ? row / SEQ : 16) * MODW;
        f32x4 v[4][4], sh[4], sc[4];
#pragma unroll
        for (int r = 0; r < 4; ++r)
#pragma unroll
            for (int j = 0; j < 4; ++j) v[r][j] = *(const f32x4*)(src + (size_t)r * D + 4 * lane + 256 * j);
#pragma unroll
        for (int j = 0; j < 4; ++j) { sh[j] = *(const f32x4*)(mr + 4 * lane + 256 * j); sc[j] = *(const f32x4*)(mr + D + 4 * lane + 256 * j) + 1.f; }
#pragma unroll
        for (int r = 0; r < 4; ++r)
#pragma unroll
            for (int j = 0; j < 4; ++j) {
                const f32x4 y = v[r][j] * sc[j] + sh[j];
                u32x2 o; o.x = pk2(y[0], y[1]); o.y = pk2(y[2], y[3]);
                *(u32x2*)(XN + (size_t)(row + r) * D + 4 * lane + 256 * j) = o;
            }
    }
}

struct EpiIn {
    static constexpr bool PERM = true;
    const float *q_norm, *k_norm, *rope; bf16_t *Qb, *Kb, *Vb, *Ub;
    __device__ __forceinline__ void operator()(const f32x4 (&acc)[2][2][4][2], const pg8::Unit& u, int wr, int wc, int fr, int fq) const {
        const int grp = u.pn * 4 + wc;
        const bool is_ctx = u.pm >= T / 256;
        f32x4 gn[2][2];
        if (grp >= 4 && grp < 20) {
            const float* g = grp < 16 ? q_norm : k_norm;
#pragma unroll
            for (int bj = 0; bj < 2; ++bj)
#pragma unroll
                for (int n = 0; n < 2; ++n) gn[bj][n] = *(const f32x4*)(g + 32 * bj + 8 * fq + 4 * n);
        }
#pragma unroll
        for (int ai = 0; ai < 2; ++ai)
#pragma unroll
            for (int m = 0; m < 4; ++m) {
                const int row = u.pm * 256 + ai * 128 + wr * 64 + m * 16 + fr;
                f32x4 v[2][2];
#pragma unroll
                for (int bj = 0; bj < 2; ++bj)
#pragma unroll
                    for (int n = 0; n < 2; ++n) v[bj][n] = acc[ai][bj][m][n];
                bf16_t* dst;
                if (grp < 4) dst = Ub + (size_t)row * 256 + grp * 64;
                else if (grp < 16) dst = Qb + (size_t)row * 768 + (grp - 4) * 64;
                else {
                    const size_t krow = is_ctx ? (size_t)((row - T) >> 8) * KVL + ((row - T) & 255) : (size_t)(row >> 11) * KVL + CTXL + (row & (SEQ - 1));
                    dst = (grp < 20 ? Kb + (grp - 16) * 64 : Vb + (grp - 20) * 64) + krow * 256;
                }
                if (grp >= 4 && grp < 20) {
                    float ss = 0.f;
#pragma unroll
                    for (int bj = 0; bj < 2; ++bj)
#pragma unroll
                        for (int n = 0; n < 2; ++n) ss += (v[bj][n][0] * v[bj][n][0] + v[bj][n][1] * v[bj][n][1]) + (v[bj][n][2] * v[bj][n][2] + v[bj][n][3] * v[bj][n][3]);
                    ss += __shfl_xor(ss, 16); ss += __shfl_xor(ss, 32);
                    const float rs = 1.0f / sqrtf(ss * (1.f / 64.f) + 1e-6f);
#pragma unroll
                    for (int bj = 0; bj < 2; ++bj)
#pragma unroll
                        for (int n = 0; n < 2; ++n) v[bj][n] = v[bj][n] * rs * gn[bj][n];
                    if (!is_ctx) {
                        const int tpos = row & (SEQ - 1);
#pragma unroll
                        for (int bj = 0; bj < 2; ++bj)
#pragma unroll
                            for (int n = 0; n < 2; ++n) {
                                const f32x4 cs = *(const f32x4*)(rope + (size_t)(tpos * 32 + 16 * bj + 4 * fq + 2 * n) * 2);
                                const f32x4 x = v[bj][n];
                                v[bj][n] = (f32x4){x[0] * cs[0] - x[1] * cs[1], x[0] * cs[1] + x[1] * cs[0], x[2] * cs[2] - x[3] * cs[3], x[2] * cs[3] + x[3] * cs[2]};
                            }
                    }
                    if (grp < 16) {
#pragma unroll
                        for (int bj = 0; bj < 2; ++bj)
#pragma unroll
                            for (int n = 0; n < 2; ++n) v[bj][n] = v[bj][n] * C2;
                    }
                }
#pragma unroll
                for (int bj = 0; bj < 2; ++bj) {
                    u32x4 w; w.x = pk2(v[bj][0][0], v[bj][0][1]); w.y = pk2(v[bj][0][2], v[bj][0][3]); w.z = pk2(v[bj][1][0], v[bj][1][1]); w.w = pk2(v[bj][1][2], v[bj][1][3]);
                    *(u32x4*)(dst + 32 * bj + 8 * fq) = w;
                }
            }
    }
};
__device__ __forceinline__ int vcu_of_block() { const int G = gridDim.x, bx = blockIdx.x; return (G % 8 == 0) ? (bx % 8) * (G / 8) + bx / 8 : bx; }
__device__ __forceinline__ void phase_inproj(const Params& p, LAS unsigned char* lds) {
    pg8::Gemm g{(const bf16_t*)(p.ws + OFF_XN), (const bf16_t*)(p.ws + OFF_WTIN), p.ws, 0};
    pg8::DenseSched S{6, 768, 800, 4, 2, (int)gridDim.x, vcu_of_block()};
    EpiIn E{p.q_norm, p.k_norm, (const float*)(p.ws + OFF_ROPE), (bf16_t*)(p.ws + OFF_Q), (bf16_t*)(p.ws + OFF_K), (bf16_t*)(p.ws + OFF_V), (bf16_t*)(p.ws + OFF_U)};
    pg8::gemm_phase<D, EpiIn, pg8::DenseSched, false>(lds, g, S, E);
    {
        const int v = vcu_of_block(), G = gridDim.x, nbusy = 800 - 3 * G;
        if (G == 256 ? v >= nbusy : true) {
            const int lane = hw_tid() & 63, wv = hw_tid() >> 6, nw = (G == 256 ? G - nbusy : G) * 8, w = (G == 256 ? v - nbusy : v) * 8 + wv;
            LAS float* scr = (LAS float*)lds + wv * (64 * 33);
            for (int it = w; it < TR_GU_LATE; it += nw) transpose_item(p, scr, TR_N_A + it, lane);
        }
    }
}

namespace attn_body {
using bf16=unsigned short;
using bf16x8=__attribute__((ext_vector_type(8)))short;
using s16x4=__attribute__((ext_vector_type(4)))short;
using f32x16=__attribute__((ext_vector_type(16)))float;
using u32x4=__attribute__((ext_vector_type(4)))unsigned;
constexpr int D=64,QP=768,KP=256,OP=1024,SEQ=2048,KVLEN=2304;
constexpr int NW=8,QBLK=32,QB=QBLK*NW,KVBLK=64,NT=KVLEN/KVBLK;
__device__ __forceinline__ int crow(int r,int hi){return (r&3)+8*(r>>2)+4*hi;}
#define SBAR() __builtin_amdgcn_sched_barrier(0)
constexpr int NSLOT=3, SLOTB=8192;
constexpr int LDS_K=0, LDS_V=NSLOT*SLOTB, LDS_WS=2*NSLOT*SLOTB, LDS_OST=LDS_WS+NW*64*4, LDS_BYTES=LDS_OST+NW*4096;
constexpr float C2=0.125f*1.4426950408889634f;
__device__ __forceinline__ void glds16(const void*gsrc,unsigned lds_dst){unsigned keep;
  asm volatile("s_mov_b32 %0, m0\n\ts_mov_b32 m0, %2\n\ts_nop 0\n\tglobal_load_lds_dwordx4 %1, off\n\ts_mov_b32 m0, %0":"=&s"(keep):"v"(gsrc),"s"(lds_dst):"memory");}
__device__ __forceinline__ float max3f(float a,float b,float c){float r;asm("v_max3_f32 %0, %1, %2, %3":"=v"(r):"v"(a),"v"(b),"v"(c));return r;}
__device__ __forceinline__ float max2f(float a,float b){float r;asm("v_max_f32_e32 %0, %1, %2":"=v"(r):"v"(a),"v"(b));return r;}
__device__ __forceinline__ float fadd_s(float a,float b){float r;asm("v_add_f32_e32 %0, %1, %2":"=v"(r):"v"(a),"v"(b));return r;}
__device__ __forceinline__ float fsub_s(float a,float b){float r;asm("v_sub_f32_e32 %0, %1, %2":"=v"(r):"v"(a),"v"(b));return r;}
typedef float f32x2_t __attribute__((ext_vector_type(2))); typedef __bf16 bf16x2_t __attribute__((ext_vector_type(2)));
__device__ __forceinline__ unsigned cvtpk_s(float lo,float hi){f32x2_t v={lo,hi};bf16x2_t b=__builtin_convertvector(v,bf16x2_t);return __builtin_bit_cast(unsigned,b);}
#define WAIT_BAR(N) asm volatile("s_waitcnt vmcnt(" #N ") lgkmcnt(0)\n\ts_barrier":::"memory")

__device__ __forceinline__ void qkt(f32x16&p0,f32x16&p1,const char*Kslot,const bf16x8*qr,const f32x16&negm,int r32,int hi){
  const char*kb=Kslot+hi*1024+r32*16;
  #pragma unroll
  for(int d0=0;d0<4;++d0){
    const bf16x8 b0=*reinterpret_cast<const bf16x8*>(kb+d0*2048);
    const bf16x8 b1=*reinterpret_cast<const bf16x8*>(kb+d0*2048+512);
    if(d0==0){p0=__builtin_amdgcn_mfma_f32_32x32x16_bf16(b0,qr[0],negm,0,0,0);p1=__builtin_amdgcn_mfma_f32_32x32x16_bf16(b1,qr[0],negm,0,0,0);}
    else{p0=__builtin_amdgcn_mfma_f32_32x32x16_bf16(b0,qr[d0],p0,0,0,0);p1=__builtin_amdgcn_mfma_f32_32x32x16_bf16(b1,qr[d0],p1,0,0,0);}}
}
typedef __attribute__((address_space(3))) const char* lds_cptr;
typedef short v4i16_t __attribute__((ext_vector_type(4)));
__device__ __forceinline__ void kload8(bf16x8*kf,lds_cptr kp){
  kf[0]=*(const __attribute__((address_space(3))) bf16x8*)(kp);      kf[1]=*(const __attribute__((address_space(3))) bf16x8*)(kp+512);
  kf[2]=*(const __attribute__((address_space(3))) bf16x8*)(kp+2048); kf[3]=*(const __attribute__((address_space(3))) bf16x8*)(kp+2560);
  kf[4]=*(const __attribute__((address_space(3))) bf16x8*)(kp+4096); kf[5]=*(const __attribute__((address_space(3))) bf16x8*)(kp+4608);
  kf[6]=*(const __attribute__((address_space(3))) bf16x8*)(kp+6144); kf[7]=*(const __attribute__((address_space(3))) bf16x8*)(kp+6656);
}
__device__ __forceinline__ void kload2(bf16x8*kf,lds_cptr kp,int j){ kf[2*j]=*(const __attribute__((address_space(3))) bf16x8*)(kp+j*2048); kf[2*j+1]=*(const __attribute__((address_space(3))) bf16x8*)(kp+j*2048+512); }
__device__ __forceinline__ s16x4 vtr(lds_cptr p){ return __builtin_bit_cast(s16x4,__builtin_amdgcn_ds_read_tr16_b64_v4i16((__attribute__((address_space(3))) v4i16_t*)p)); }
__device__ __forceinline__ float rowmax(const f32x16&p0,const f32x16&p1){
  float a=max3f(p0[0],p0[1],p1[0]),b=max3f(p0[2],p0[3],p1[1]);a=max3f(a,p1[2],p1[3]);
  #pragma unroll
  for(int r=4;r<16;r+=4){a=max3f(a,p0[r],p0[r+1]);b=max3f(b,p0[r+2],p0[r+3]);a=max3f(a,p1[r],p1[r+1]);b=max3f(b,p1[r+2],p1[r+3]);}
  const float m=max2f(a,b);
  auto rr=__builtin_amdgcn_permlane32_swap(__float_as_uint(m),__float_as_uint(m),false,false);
  return max2f(__uint_as_float(rr[0]),__uint_as_float(rr[1]));
}
__device__ __forceinline__ void pv(f32x16*o,int vb,bf16x8 pa0,bf16x8 pa1,bf16x8 pa2,bf16x8 pa3){
  #pragma unroll
  for(int d0=0;d0<2;++d0){s16x4 lo[4],hi[4];
    #pragma unroll
    for(int ks=0;ks<4;++ks){
      asm volatile("ds_read_b64_tr_b16 %0,%1 offset:%c2":"=&v"(lo[ks]):"v"(vb),"i"(d0*4096+ks*1024):"memory");
      asm volatile("ds_read_b64_tr_b16 %0,%1 offset:%c2":"=&v"(hi[ks]):"v"(vb),"i"(d0*4096+ks*1024+512):"memory");}
    asm volatile("s_waitcnt lgkmcnt(0)":::"memory");SBAR();
    #define PK(k) (bf16x8){lo[k][0],lo[k][1],lo[k][2],lo[k][3],hi[k][0],hi[k][1],hi[k][2],hi[k][3]}
    o[d0]=__builtin_amdgcn_mfma_f32_32x32x16_bf16(pa0,PK(0),o[d0],0,0,0);
    o[d0]=__builtin_amdgcn_mfma_f32_32x32x16_bf16(pa1,PK(1),o[d0],0,0,0);
    o[d0]=__builtin_amdgcn_mfma_f32_32x32x16_bf16(pa2,PK(2),o[d0],0,0,0);
    o[d0]=__builtin_amdgcn_mfma_f32_32x32x16_bf16(pa3,PK(3),o[d0],0,0,0);
    #undef PK
  }
}

#ifndef ATTN_STORE16
#define ATTN_STORE16(p,v) (*(u32x4*)(p)=(v))
#endif
template<int THRL> __device__ __forceinline__ void attn_unit(int b,int h,int qb,const bf16*Q,const bf16*__restrict__ K,const bf16*__restrict__ V,bf16*O,char*shm){
  const int tid=hw_tid(),lane=tid&63,r32=lane&31,hi=lane>>5; const int wid=__builtin_amdgcn_readfirstlane(tid>>6);
  const long rowbase=(long)b*SEQ, kvbase=(long)b*KVLEN; const int q0=qb*QB, kh=h/3;
  const bf16*Qw=Q+(rowbase+q0+wid*QBLK)*QP+h*D;
  const bf16*Kh=K+kvbase*KP+kh*D,*Vh=V+kvbase*KP+kh*D;
  const unsigned lds0=(unsigned)(uintptr_t)shm;
  float*wsf=(float*)(shm+LDS_WS)+wid*64;
  const bf16*ksrc=Kh+(long)lane*KP+wid*8;
  const bf16*vsrc=Vh+(long)(16*(wid&3)+(lane>>2))*KP+(wid>>2)*32+(lane&3)*8;
  const unsigned kdst=lds0+LDS_K+wid*1024, vdst=lds0+LDS_V+wid*1024;
  #define DMA_K(t,slot) glds16(ksrc+(long)(t)*KVBLK*KP,(unsigned)__builtin_amdgcn_readfirstlane(kdst+(slot)))
  #define DMA_V(t,slot) glds16(vsrc+(long)(t)*KVBLK*KP,(unsigned)__builtin_amdgcn_readfirstlane(vdst+(slot)))
  const int vb0=(int)(lds0+LDS_V)+((lane>>4)&1)*32+(lane&3)*8+(4*hi+((lane&15)>>2))*64;
  const char*Kbase=shm+LDS_K; bf16x8 kf[8];
  const lds_cptr shm3=(lds_cptr)shm; const lds_cptr kp0=shm3+LDS_K+hi*1024+r32*16; const lds_cptr vp0=shm3+LDS_V+((lane>>4)&1)*32+(lane&3)*8+(4*hi+((lane&15)>>2))*64;
  DMA_K(0,0);DMA_V(0,0);DMA_K(1,SLOTB);
  bf16x8 qr[4];
  #pragma unroll
  for(int d0=0;d0<4;++d0)qr[d0]=*reinterpret_cast<const bf16x8*>(&Qw[(long)r32*QP+d0*16+hi*8]);
  float mhat=0.f,l_reg=0.f;f32x16 o[2];o[0]=f32x16{};o[1]=f32x16{};f32x16 negm=f32x16{};asm volatile("":"+v"(negm));
  #define CMASK(P0,P1,t) do{}while(0)
  bool resc=false;
  #define START(P0,P1) do{ const float rm=rowmax(P0,P1); resc=false; \
    { const float dl=rm; mhat=fadd_s(mhat,dl); \
      _Pragma("unroll") for(int r=0;r<16;++r){P0[r]=fsub_s(P0[r],dl);P1[r]=fsub_s(P1[r],dl);} \
      _Pragma("unroll") for(int r=0;r<16;++r)negm[r]=-mhat; asm volatile("":"+v"(negm)); } \
    _Pragma("unroll") for(int r=0;r<16;++r)P0[r]=__builtin_amdgcn_exp2f(P0[r]); }while(0)
  #define RESC() do{ if(resc){ asm volatile("s_waitcnt lgkmcnt(0)":::"memory"); \
      _Pragma("unroll") for(int d_=0;d_<2;++d_) _Pragma("unroll") for(int r=0;r<16;++r)o[d_][r]*=wsf[crow(r,hi)]; } }while(0)
  f32x16 pA0,pA1,pB0,pB1;
  int sl_prev=0,sl_cur=0,sl_next=SLOTB;
  #define ROT() do{sl_prev=sl_cur;sl_cur=sl_next;sl_next=(sl_next==(NSLOT-1)*SLOTB)?0:sl_next+SLOTB;}while(0)
  DMA_K(2,2*SLOTB);
  WAIT_BAR(3);
  qkt(pA0,pA1,Kbase,qr,negm,r32,hi);asm volatile("s_nop 15\n\ts_nop 7":"+v"(pA0),"+v"(pA1));CMASK(pA0,pA1,0);
  START(pA0,pA1);
  _Pragma("unroll") for(int r=0;r<16;++r)pA1[r]=__builtin_amdgcn_exp2f(pA1[r]);
  WAIT_BAR(0);
  DMA_K(3,0);DMA_V(1,SLOTB);
  ROT();
  kload8(kf,kp0+sl_cur);
  WAIT_BAR(2);
  s16x4 vlo[8],vhi[8]; u32x4 pw0,pw1,pw2,pw3;
  #define PKW(P,B) cvtpk_s(P[B],P[B+1])
  #define PAF(k) __builtin_bit_cast(bf16x8,pw##k)
  #define VFR(i) (bf16x8){vlo[i][0],vlo[i][1],vlo[i][2],vlo[i][3],vhi[i][0],vhi[i][1],vhi[i][2],vhi[i][3]}
  #define PIN(x) asm volatile("":"+v"(x))
  #define MX3(a,b,c) __builtin_fmaxf(__builtin_fmaxf((a),(b)),(c))
  #define GAPA(MF,A0,A1,A2,A3,W0,W1,PW) do{ MF; sacc+=A0; sacc+=A1; sacc+=A2; sacc+=A3; PIN(sacc); W0; W1; PIN(PW); SBAR(); }while(0)
  #define EX(v) __builtin_amdgcn_exp2f(v)
  #define GAPB(MF,X,B) do{ MF; X[B]=EX(X[B]); X[B+1]=EX(X[B+1]); X[B+2]=EX(X[B+2]); X[B+3]=EX(X[B+3]); PIN(X); SBAR(); }while(0)
  #define VRD(i) do{ vlo[i]=vtr(vp_+(((i)>>2)*4096+((i)&3)*1024)); vhi[i]=vtr(vp_+(((i)>>2)*4096+((i)&3)*1024+512)); }while(0)
  #define KRD(G,j) do{ if(G){ kload2(kf,kp0+sl_next,j); SBAR(); } }while(0)
  #define STEP(C0,C1,P0,P1,t,GK,GV,GL) do{ SBAR(); \
    const lds_cptr vp_=vp0+sl_prev; \
    VRD(0); SBAR(); float sacc=(P0[0]+P0[1]); \
    GAPA(C0=__builtin_amdgcn_mfma_f32_32x32x16_bf16(kf[0],qr[0],negm,0,0,0), P0[2],P0[3],P0[4],P0[5],     pw0[0]=PKW(P0,0), pw0[1]=PKW(P0,2), pw0); \
    VRD(4); SBAR(); GAPA(C1=__builtin_amdgcn_mfma_f32_32x32x16_bf16(kf[1],qr[0],negm,0,0,0), P0[6],P0[7],P0[8],P0[9],     pw0[2]=PKW(P0,4), pw0[3]=PKW(P0,6), pw0); \
    VRD(1); SBAR(); GAPA(C0=__builtin_amdgcn_mfma_f32_32x32x16_bf16(kf[2],qr[1],C0,0,0,0),   P0[10],P0[11],P0[12],P0[13], pw1[0]=PKW(P0,8), pw1[1]=PKW(P0,10), pw1); \
    VRD(5); SBAR(); GAPA(C1=__builtin_amdgcn_mfma_f32_32x32x16_bf16(kf[3],qr[1],C1,0,0,0),   P0[14],P0[15],P1[0],P1[1],   pw1[2]=PKW(P0,12),pw1[3]=PKW(P0,14), pw1); \
    VRD(2); SBAR(); GAPA(C0=__builtin_amdgcn_mfma_f32_32x32x16_bf16(kf[4],qr[2],C0,0,0,0),   P1[2],P1[3],P1[4],P1[5],     pw2[0]=PKW(P1,0), pw2[1]=PKW(P1,2), pw2); \
    VRD(6); SBAR(); GAPA(C1=__builtin_amdgcn_mfma_f32_32x32x16_bf16(kf[5],qr[2],C1,0,0,0),   P1[6],P1[7],P1[8],P1[9],     pw2[2]=PKW(P1,4), pw2[3]=PKW(P1,6), pw2); \
    VRD(3); SBAR(); GAPA(C0=__builtin_amdgcn_mfma_f32_32x32x16_bf16(kf[6],qr[3],C0,0,0,0),   P1[10],P1[11],P1[12],P1[13], pw3[0]=PKW(P1,8), pw3[1]=PKW(P1,10), pw3); \
    VRD(7); SBAR(); GAPA(C1=__builtin_amdgcn_mfma_f32_32x32x16_bf16(kf[7],qr[3],C1,0,0,0),   P1[14],P1[15],0.f,0.f,       pw3[2]=PKW(P1,12),pw3[3]=PKW(P1,14), pw3); \
    l_reg+=sacc; \
    if(GK){DMA_K((t)+3,sl_cur);} if(GV){DMA_V((t)+1,sl_next);} \
    CMASK(C0,C1,t); \
    { float a=MX3(C0[0],C0[1],C1[0]),b=MX3(C0[2],C0[3],C1[1]); a=MX3(a,C1[2],C1[3]); \
      _Pragma("unroll") for(int r=4;r<16;r+=4){a=MX3(a,C0[r],C0[r+1]);b=MX3(b,C0[r+2],C0[r+3]);a=MX3(a,C1[r],C1[r+1]);b=MX3(b,C1[r+2],C1[r+3]);} \
      float rm=__builtin_fmaxf(a,b); { auto rr=__builtin_amdgcn_permlane32_swap(__float_as_uint(rm),__float_as_uint(rm),false,false); rm=__builtin_fmaxf(__uint_as_float(rr[0]),__uint_as_float(rr[1])); } \
      resc=false; \
      if(__builtin_expect(__any(rm>(float)THRL),0)){ const float dl=__builtin_fmaxf(rm,0.f); mhat+=dl; \
        _Pragma("unroll") for(int r=0;r<16;++r){C0[r]-=dl;C1[r]-=dl;} \
        _Pragma("unroll") for(int r=0;r<16;++r)negm[r]=-mhat; asm volatile("":"+v"(negm)); \
        const float f=__builtin_amdgcn_exp2f(-dl); l_reg*=f; if(hi==0)wsf[r32]=f; resc=true; } } \
    SBAR(); \
    GAPB(o[0]=__builtin_amdgcn_mfma_f32_32x32x16_bf16(PAF(0),VFR(0),o[0],0,0,0), C0,0); \
    GAPB(o[1]=__builtin_amdgcn_mfma_f32_32x32x16_bf16(PAF(0),VFR(4),o[1],0,0,0), C0,4); \
    KRD(GL,0); GAPB(o[0]=__builtin_amdgcn_mfma_f32_32x32x16_bf16(PAF(1),VFR(1),o[0],0,0,0), C0,8); \
    KRD(GL,1); GAPB(o[1]=__builtin_amdgcn_mfma_f32_32x32x16_bf16(PAF(1),VFR(5),o[1],0,0,0), C0,12); \
    KRD(GL,2); GAPB(o[0]=__builtin_amdgcn_mfma_f32_32x32x16_bf16(PAF(2),VFR(2),o[0],0,0,0), C1,0); \
    KRD(GL,3); GAPB(o[1]=__builtin_amdgcn_mfma_f32_32x32x16_bf16(PAF(2),VFR(6),o[1],0,0,0), C1,4); \
    GAPB(o[0]=__builtin_amdgcn_mfma_f32_32x32x16_bf16(PAF(3),VFR(3),o[0],0,0,0), C1,8); \
    GAPB(o[1]=__builtin_amdgcn_mfma_f32_32x32x16_bf16(PAF(3),VFR(7),o[1],0,0,0), C1,12); \
    }while(0)
  int t=1;
  for(;t+5<NT;t+=2){
    STEP(pB0,pB1,pA0,pA1,t,true,true,true);     WAIT_BAR(2); RESC(); ROT();
    STEP(pA0,pA1,pB0,pB1,t+1,true,true,true);   WAIT_BAR(2); RESC(); ROT();
  }
  #define ENDW(tt) do{ if((tt)+3<NT){WAIT_BAR(2);} else if((tt)+2<NT){WAIT_BAR(1);} else {WAIT_BAR(0);} }while(0)
  for(;t+1<NT;t+=2){
    STEP(pB0,pB1,pA0,pA1,t,(t+3<NT),(t+1<NT),(t+1<NT));       ENDW(t);   RESC(); ROT();
    STEP(pA0,pA1,pB0,pB1,t+1,(t+4<NT),(t+2<NT),(t+2<NT));     ENDW(t+1); RESC(); ROT();
  }
  STEP(pB0,pB1,pA0,pA1,NT-1,false,false,false); RESC();
  { float sacc=pB0[0]+pB0[1]; _Pragma("unroll") for(int r=2;r<16;++r)sacc+=pB0[r]; _Pragma("unroll") for(int r=0;r<16;++r)sacc+=pB1[r]; l_reg+=sacc;
    pw0=(u32x4){PKW(pB0,0),PKW(pB0,2),PKW(pB0,4),PKW(pB0,6)};pw1=(u32x4){PKW(pB0,8),PKW(pB0,10),PKW(pB0,12),PKW(pB0,14)};pw2=(u32x4){PKW(pB1,0),PKW(pB1,2),PKW(pB1,4),PKW(pB1,6)};pw3=(u32x4){PKW(pB1,8),PKW(pB1,10),PKW(pB1,12),PKW(pB1,14)};
    SBAR(); pv(o,vb0+sl_cur,PAF(0),PAF(1),PAF(2),PAF(3)); }
  #undef PKW
  #undef PAF
  #undef VFR
  #undef PIN
  #undef MX3
  #undef GAPA
  #undef GAPB
  #undef EX
  #undef VRD
  #undef KRD
  #undef STEP
  #undef ENDW
  {auto rr=__builtin_amdgcn_permlane32_swap(__float_as_uint(l_reg),__float_as_uint(l_reg),false,false);l_reg=__uint_as_float(rr[0])+__uint_as_float(rr[1]);}
  if(hi==0)wsf[32+r32]=l_reg;asm volatile("s_waitcnt lgkmcnt(0)":::"memory");
  float rli[16];
  #pragma unroll
  for(int r=0;r<16;++r)rli[r]=__builtin_amdgcn_rcpf(wsf[32+crow(r,hi)]);
  bf16*Ow=O+(rowbase+q0+wid*QBLK)*OP+h*D;
  { bf16*stg=(bf16*)(shm+LDS_OST)+wid*2048;
    #pragma unroll
    for(int r=0;r<16;++r){const int orow=crow(r,hi);
      #pragma unroll
      for(int d0=0;d0<2;++d0)stg[orow*64+d0*32+r32]=(bf16)f2bf(o[d0][r]*rli[r]);}
    asm volatile("s_waitcnt lgkmcnt(0)":::"memory");
    #pragma unroll
    for(int i=0;i<4;++i){const int row=i*8+(lane>>3),ch=lane&7; const u32x4 v=*(const u32x4*)(stg+row*64+ch*8); ATTN_STORE16(Ow+(long)row*OP+ch*8,v);} }
  asm volatile("s_waitcnt lgkmcnt(0)\n\ts_barrier":::"memory");
  #undef DMA_K
  #undef DMA_V
  #undef CMASK
  #undef START
  #undef RESC
  #undef ROT
}
constexpr int ATTN_LDS_BYTES=LDS_BYTES;
struct AttnTensors { const bf16* Q; const bf16* K; const bf16* V; bf16* O; };
template<int THRL=8> __device__ __forceinline__ void attn_phase(char*lds,const AttnTensors&T){
  const int G=gridDim.x, bx=blockIdx.x, v=(G%8==0)?(bx%8)*(G/8)+bx/8:bx;
  for(int u=v;u<16*12*8;u+=G){
    const int pair=(u%256)/4, j=((u%256)%4)*6+u/256;
    const int b=pair>>2, kh=pair&3, g=j>>3, qb=j&7;
    attn_unit<THRL>(b,kh*3+g,qb,T.Q,T.K,T.V,T.O,lds);
  }
}
#undef SBAR
#undef WAIT_BAR
}

__device__ __forceinline__ void pool_item(const Params& p, LAS unsigned char* lds, int item, bool stage_w) {
    const int tid = TIDX, lane = tid & 63, wid = tid >> 6, r16 = lane & 15, q = lane >> 4;
    const int gi = item & 3, tile = item >> 2, t0 = tile * 64, b = t0 / SEQ, tl0 = t0 % SEQ, half = 1 << gi;
    const bf16_t* Ub = (const bf16_t*)(p.ws + OFF_U);
    bf16_t* AO = (bf16_t*)(p.ws + OFF_AO);
    LAS bf16_t* us = (LAS bf16_t*)lds;
    LAS bf16_t* dl = (LAS bf16_t*)(lds + 11520);
    LAS bf16_t* wt = (LAS bf16_t*)(lds + 11520 + 9216);
    __syncthreads();
    for (int i = tid; i < 80 * 8; i += 256) {
        const int r = i >> 3, ch = i & 7, tl = tl0 - 8 + r;
        u32x4 v = {0u, 0u, 0u, 0u};
        if (tl >= 0 && tl < SEQ) v = *(const u32x4*)(Ub + (size_t)(b * SEQ + tl) * 256 + gi * 64 + ch * 8);
        *(LAS u32x4*)(us + r * 72 + ch * 8) = v;
    }
    if (stage_w) {
#pragma unroll 4
        for (int k = 0; k < 16; ++k) {
            const int i = tid + 256 * k, c = i >> 6, dd = i & 63;
            wt[dd * 72 + c] = (bf16_t)f2bf(p.pool_w[gi * 4096 + i] * p.pool_scale[gi * 64 + dd]);
        }
    }
    __syncthreads();
    {
        const int c = tid & 63, seg = tid >> 6;
        int tl = tl0 + seg * 16;
        float sm = 0.f;
        for (int r = max(tl - half, 0); r < min(tl + half, SEQ); ++r) sm += bf2f(us[(r - tl0 + 8) * 72 + c]);
#pragma unroll
        for (int k = 0; k < 16; ++k, ++tl) {
            if (k > 0) {
                if (tl + half <= SEQ) sm += bf2f(us[(tl + half - 1 - tl0 + 8) * 72 + c]);
                if (tl - half > 0) sm -= bf2f(us[(tl - half - 1 - tl0 + 8) * 72 + c]);
            }
            const int cntw = min(tl + half, SEQ) - max(tl - half, 0);
            dl[(seg * 16 + k) * 72 + c] = (bf16_t)f2bf(sm / (float)cntw - bf2f(us[(tl - tl0 + 8) * 72 + c]));
        }
    }
    __syncthreads();
    {
        f32x4 acc[4];
#pragma unroll
        for (int nb = 0; nb < 4; ++nb) acc[nb] = (f32x4){0.f, 0.f, 0.f, 0.f};
#pragma unroll
        for (int ks = 0; ks < 2; ++ks) {
            const bf16x8 db = *(const LAS bf16x8*)(dl + (wid * 16 + r16) * 72 + ks * 32 + q * 8);
#pragma unroll
            for (int nb = 0; nb < 4; ++nb) {
                const bf16x8 wa = *(const LAS bf16x8*)(wt + (nb * 16 + r16) * 72 + ks * 32 + q * 8);
                acc[nb] = __builtin_amdgcn_mfma_f32_16x16x32_bf16(wa, db, acc[nb], 0, 0, 0);
            }
        }
        bf16_t* orow = AO + (size_t)(t0 + wid * 16 + r16) * D + gi * 64 + 4 * q;
#pragma unroll
        for (int nb = 0; nb < 4; ++nb) { u32x2 w; w.x = pk2(acc[nb][0], acc[nb][1]); w.y = pk2(acc[nb][2], acc[nb][3]); *(u32x2*)(orow + nb * 16) = w; }
    }
}

__device__ __forceinline__ void phase_attn_pool(const Params& p, LAS unsigned char* lds, char* smem) {
    const attn_body::AttnTensors AT{(const bf16_t*)(p.ws + OFF_Q), (const bf16_t*)(p.ws + OFF_K), (const bf16_t*)(p.ws + OFF_V), (bf16_t*)(p.ws + OFF_AO) + 256};
    attn_body::attn_phase<8>(smem, AT);
    __syncthreads();
    constexpr int N_POOL = (T / 64) * 4;
    { bool first = true; for (int it = VBLK; it < N_POOL; it += NVBLK) { pool_item(p, lds, it, first); first = false; } }
}

struct EpiOut {
    static constexpr bool PERM = false;
    const float* x; float* y; const float* mod; float* stats;
    __device__ __forceinline__ void operator()(const f32x4 (&acc)[2][2][4][2], const pg8::Unit& u, int wr, int wc, int fr, int fq) const {
        const float* g1 = mod + (size_t)(u.pm >> 3) * MODW + 2 * D;
        const int col0 = u.pn * 256 + wc * 32 + fq * 4;
        f32x4 gv[2][2];
#pragma unroll
        for (int bj = 0; bj < 2; ++bj)
#pragma unroll
            for (int n = 0; n < 2; ++n) gv[bj][n] = *(const f32x4*)(g1 + col0 + bj * 128 + n * 16);
        f32x4 xv[2][2][2];
        const size_t rstride = (size_t)16 * D;
        const float* xb = x + (size_t)(u.pm * 256 + wr * 64 + fr) * D + col0;
        float* yb = y + (size_t)(u.pm * 256 + wr * 64 + fr) * D + col0;
#pragma unroll
        for (int bj = 0; bj < 2; ++bj)
#pragma unroll
            for (int n = 0; n < 2; ++n) xv[0][bj][n] = *(const f32x4*)(xb + bj * 128 + n * 16);
#pragma unroll
        for (int k = 0; k < 8; ++k) {
            const int ai = k >> 2, m = k & 3;
            const size_t roff = (size_t)ai * 128 * D + (size_t)m * rstride;
            if (k < 7) {
                const size_t noff = (size_t)((k + 1) >> 2) * 128 * D + (size_t)((k + 1) & 3) * rstride;
#pragma unroll
                for (int bj = 0; bj < 2; ++bj)
#pragma unroll
                    for (int n = 0; n < 2; ++n) xv[(k + 1) & 1][bj][n] = *(const f32x4*)(xb + noff + bj * 128 + n * 16);
            }
            const int row = u.pm * 256 + ai * 128 + wr * 64 + m * 16 + fr;
            float s1 = 0.f, s2 = 0.f;
#pragma unroll
            for (int bj = 0; bj < 2; ++bj)
#pragma unroll
                for (int n = 0; n < 2; ++n) {
                    const f32x4 yv = xv[k & 1][bj][n] * ALPHA + gv[bj][n] * acc[ai][bj][m][n];
                    *(f32x4*)(yb + roff + bj * 128 + n * 16) = yv;
                    s1 += (yv[0] + yv[1]) + (yv[2] + yv[3]);
                    s2 += (yv[0] * yv[0] + yv[1] * yv[1]) + (yv[2] * yv[2] + yv[3] * yv[3]);
                }
            s1 += __shfl_xor(s1, 16); s1 += __shfl_xor(s1, 32);
            s2 += __shfl_xor(s2, 16); s2 += __shfl_xor(s2, 32);
            if (fq == 0) { float* st = stats + ((size_t)row * 16 + u.pn * 4 + wc) * 2; st[0] = s1; st[1] = s2; }
        }
    }
};
__device__ __forceinline__ void phase_outproj(const Params& p, LAS unsigned char* lds) {
    pg8::Gemm g{(const bf16_t*)(p.ws + OFF_AO), (const bf16_t*)(p.ws + OFF_WTOUT), p.ws, 1};
    pg8::DenseSched S{4, 512, 512, 0, 1, (int)gridDim.x, vcu_of_block()};
    EpiOut E{p.x, p.out, (const float*)(p.ws + OFF_MOD), (float*)(p.ws + OFF_STATS)};
    pg8::gemm_phase<D, EpiOut, pg8::DenseSched, false>(lds, g, S, E);
}

__device__ __forceinline__ void phase_router(const Params& p, LAS unsigned char* lds0) {
    const int tid = hw_tid(), lane = tid & 63, wid = tid >> 6, r16 = lane & 15, q = lane >> 4;
    const float* mod = (const float*)(p.ws + OFF_MOD);
    const float* stats = (const float*)(p.ws + OFF_STATS);
    bf16_t* H = (bf16_t*)(p.ws + OFF_H);
    const bf16_t* WRH = (const bf16_t*)(p.ws + OFF_WRH); const bf16_t* WRL = (const bf16_t*)(p.ws + OFF_WRL);
    int* gcnt = (int*)(p.ws + OFF_CNT);
    int* LDST = (int*)(p.ws + OFF_LDST);
    float* LWt = (float*)(p.ws + OFF_LW);
    LAS float* vec = (LAS float*)lds0;
    LAS float* lg = (LAS float*)(lds0 + 16384) + wid * 16 * 64;
    LAS int* lcnt = (LAS int*)(lds0 + 49152);
    LAS int* lbase = (LAS int*)(lds0 + 49152 + 256);
    LAS int* sel_ep = (LAS int*)(lds0 + 49152 + 512);
    LAS float* sel_w = (LAS float*)(lds0 + 49152 + 512 + 4096);
    for (int item = blockIdx.x; item < T / 128; item += gridDim.x) {
        const int t0 = item * 128, b = t0 / SEQ, tw0 = t0 + wid * 16;
        __syncthreads();
        if (tid < 64) lcnt[tid] = 0;
        for (int i = tid; i < 1024; i += 512) {
            vec[i] = p.ln1_g[i]; vec[1024 + i] = p.ln1_b[i];
            vec[2048 + i] = 1.f + mod[(size_t)b * MODW + 4 * D + i]; vec[3072 + i] = mod[(size_t)b * MODW + 3 * D + i];
        }
        float meanv = 0.f, rstdv = 0.f;
        if (lane < 16) {
            float s1 = 0.f, s2 = 0.f;
            const float* st = stats + (size_t)(tw0 + lane) * 32;
#pragma unroll
            for (int i = 0; i < 16; ++i) { s1 += st[2 * i]; s2 += st[2 * i + 1]; }
            meanv = s1 * (1.f / D);
            const float var = fmaxf(s2 * (1.f / D) - meanv * meanv, 0.f);
            rstdv = 1.0f / sqrtf(var + 1e-5f);
        }
        const float mu = __shfl(meanv, r16), rs = __shfl(rstdv, r16);
        __syncthreads();
        f32x4 acc[4];
#pragma unroll
        for (int nb = 0; nb < 4; ++nb) acc[nb] = (f32x4){0.f, 0.f, 0.f, 0.f};
        float* yrow = p.out + (size_t)(tw0 + r16) * D + q * 8;
        bf16_t* hrow = H + (size_t)(tw0 + r16) * D + q * 8;
        LAS unsigned char* wb = lds0 + 57856;
        f32x4 vn[4][2];
#pragma unroll
        for (int u = 0; u < 4; ++u) { vn[u][0] = *(const f32x4*)(yrow + u * 32); vn[u][1] = *(const f32x4*)(yrow + u * 32 + 4); }
        for (int ch = 0; ch < 4; ++ch) {
            __syncthreads();
#pragma unroll
            for (int i = 0; i < 8; ++i) {
                const int idx = tid + i * 512, part = idx >> 11, row = (idx >> 5) & 63, c16 = idx & 31;
                const u32x4 w = *(const u32x4*)((part ? WRL : WRH) + (size_t)row * D + ch * 256 + c16 * 8);
                *(LAS u32x4*)(wb + part * 33792 + row * 528 + c16 * 16) = w;
            }
            __syncthreads();
#pragma unroll
            for (int s4 = ch * 8; s4 < ch * 8 + 8; s4 += 4) {
                f32x4 vv[4][2];
#pragma unroll
                for (int u = 0; u < 4; ++u) { vv[u][0] = vn[u][0]; vv[u][1] = vn[u][1]; }
                if (s4 + 4 < 32) {
#pragma unroll
                    for (int u = 0; u < 4; ++u) { vn[u][0] = *(const f32x4*)(yrow + (s4 + 4 + u) * 32); vn[u][1] = *(const f32x4*)(yrow + (s4 + 4 + u) * 32 + 4); }
                }
#pragma unroll
                for (int u = 0; u < 4; ++u) {
                    const int s = s4 + u, k0 = s * 32 + q * 8;
                    float hv[8];
#pragma unroll
                    for (int hh = 0; hh < 2; ++hh) {
                        const f32x4 g = *(const LAS f32x4*)(vec + k0 + 4 * hh), bb = *(const LAS f32x4*)(vec + 1024 + k0 + 4 * hh);
                        const f32x4 sc = *(const LAS f32x4*)(vec + 2048 + k0 + 4 * hh), sh = *(const LAS f32x4*)(vec + 3072 + k0 + 4 * hh);
                        const f32x4 xm = (vv[u][hh] - mu) * rs * g + bb;
                        *(f32x4*)(yrow + s * 32 + 4 * hh) = xm;
                        const f32x4 h4 = xm * sc + sh;
                        hv[4 * hh + 0] = h4[0]; hv[4 * hh + 1] = h4[1]; hv[4 * hh + 2] = h4[2]; hv[4 * hh + 3] = h4[3];
                    }
                    unsigned wh[4], wl[4];
#pragma unroll
                    for (int i = 0; i < 4; ++i) {
                        const unsigned ha = f2bf(hv[2 * i]), hb = f2bf(hv[2 * i + 1]);
                        wh[i] = ha | (hb << 16);
                        wl[i] = pk2(hv[2 * i] - bf2f(ha), hv[2 * i + 1] - bf2f(hb));
                    }
                    *(u32x4*)(hrow + s * 32) = (u32x4){wh[0], wh[1], wh[2], wh[3]};
                    const bf16x8 ah = __builtin_bit_cast(bf16x8, (u32x4){wh[0], wh[1], wh[2], wh[3]}), al = __builtin_bit_cast(bf16x8, (u32x4){wl[0], wl[1], wl[2], wl[3]});
                    const int kb = ((s & 7) * 32 + q * 8) * 2;
#pragma unroll
                    for (int nb = 0; nb < 4; ++nb) {
                        const bf16x8 bh = *(const LAS bf16x8*)(wb + (nb * 16 + r16) * 528 + kb), bl = *(const LAS bf16x8*)(wb + 33792 + (nb * 16 + r16) * 528 + kb);
                        acc[nb] = __builtin_amdgcn_mfma_f32_16x16x32_bf16(ah, bh, acc[nb], 0, 0, 0);
                        acc[nb] = __builtin_amdgcn_mfma_f32_16x16x32_bf16(al, bh, acc[nb], 0, 0, 0);
                        acc[nb] = __builtin_amdgcn_mfma_f32_16x16x32_bf16(ah, bl, acc[nb], 0, 0, 0);
                    }
                }
            }
        }
#pragma unroll
        for (int nb = 0; nb < 4; ++nb)
#pragma unroll
            for (int j = 0; j < 4; ++j) lg[(4 * q + j) * 64 + nb * 16 + r16] = acc[nb][j];
        __syncthreads();
        const float bias = p.router_bias[lane];
        const int g = lane >> 3;
        for (int r0 = 0; r0 < 16; r0 += 4) {
            float sg[4], sel[4], msel[4]; bool keep[4];
#pragma unroll
            for (int u = 0; u < 4; ++u) {
                const float lgv = lg[(r0 + u) * 64 + lane];
                sg[u] = 1.0f / (1.0f + expf(-lgv));
                sel[u] = sg[u] + bias;
            }
            float m1[4], m2[4]; int cand[4];
#pragma unroll
            for (int u = 0; u < 4; ++u) { m1[u] = fmaxf(sel[u], __shfl_xor(sel[u], 1)); }
#pragma unroll
            for (int u = 0; u < 4; ++u) { m1[u] = fmaxf(m1[u], __shfl_xor(m1[u], 2)); }
#pragma unroll
            for (int u = 0; u < 4; ++u) { m1[u] = fmaxf(m1[u], __shfl_xor(m1[u], 4)); cand[u] = (sel[u] == m1[u]) ? lane : 64; }
#pragma unroll
            for (int u = 0; u < 4; ++u) { cand[u] = min(cand[u], __shfl_xor(cand[u], 1)); }
#pragma unroll
            for (int u = 0; u < 4; ++u) { cand[u] = min(cand[u], __shfl_xor(cand[u], 2)); }
#pragma unroll
            for (int u = 0; u < 4; ++u) { cand[u] = min(cand[u], __shfl_xor(cand[u], 4)); m2[u] = (lane == cand[u]) ? -INFINITY : sel[u]; }
#pragma unroll
            for (int u = 0; u < 4; ++u) { m2[u] = fmaxf(m2[u], __shfl_xor(m2[u], 1)); }
#pragma unroll
            for (int u = 0; u < 4; ++u) { m2[u] = fmaxf(m2[u], __shfl_xor(m2[u], 2)); }
#pragma unroll
            for (int u = 0; u < 4; ++u) { m2[u] = fmaxf(m2[u], __shfl_xor(m2[u], 4)); }
#pragma unroll
            for (int u = 0; u < 4; ++u) {
                const float gs = m1[u] + m2[u];
                int cntg = 0;
#pragma unroll
                for (int gg = 0; gg < 8; ++gg) { const float v = __shfl(gs, gg * 8); cntg += (v > gs || (v == gs && gg < g)) ? 1 : 0; }
                keep[u] = cntg < 4;
                msel[u] = keep[u] ? sel[u] : -INFINITY;
                lg[(r0 + u) * 64 + lane] = msel[u];
            }
            int cnt[4] = {0, 0, 0, 0};
#pragma unroll 4
            for (int q4 = 0; q4 < 16; ++q4) {
#pragma unroll
                for (int u = 0; u < 4; ++u) {
                    const f32x4 v = *(const LAS f32x4*)(lg + (r0 + u) * 64 + q4 * 4);
#pragma unroll
                    for (int i = 0; i < 4; ++i) cnt[u] += (v[i] > msel[u]) ? 1 : 0;
                }
            }
#pragma unroll
            for (int u = 0; u < 4; ++u) {
                bool ok = __popcll(__ballot(keep[u] && cnt[u] < 8)) == 8;
#pragma unroll
                for (int k = 0; k < 8; ++k) ok = ok && (__ballot(keep[u] && cnt[u] == k) != 0ull);
                if (!ok) {
                    int c2 = 0;
                    for (int e2 = 0; e2 < 64; ++e2) { const float v = lg[(r0 + u) * 64 + e2]; c2 += (v > msel[u] || (v == msel[u] && e2 < lane)) ? 1 : 0; }
                    cnt[u] = c2;
                }
            }
            float wsum[4]; bool chosen[4];
#pragma unroll
            for (int u = 0; u < 4; ++u) { chosen[u] = keep[u] && cnt[u] < 8; wsum[u] = chosen[u] ? sg[u] : 0.f; }
#pragma unroll
            for (int o = 1; o < 64; o <<= 1) {
#pragma unroll
                for (int u = 0; u < 4; ++u) wsum[u] += __shfl_xor(wsum[u], o);
            }
#pragma unroll
            for (int u = 0; u < 4; ++u) {
                if (chosen[u]) {
                    const int pos = atomicAdd((int*)&lcnt[lane], 1);
                    sel_ep[(wid * 16 + r0 + u) * 8 + cnt[u]] = lane | (pos << 8);
                    sel_w[(wid * 16 + r0 + u) * 8 + cnt[u]] = sg[u] / wsum[u] * 2.5f;
                }
            }
        }
        __syncthreads();
        if (tid < 64) { int tt = tid; asm volatile("" : "+v"(tt)); lbase[tt] = atomicAdd(&gcnt[tt], lcnt[tt]); }
        __syncthreads();
        for (int idx = tid; idx < 1024; idx += 512) {
            const int ep = sel_ep[idx], e = ep & 0xff, pos = ep >> 8, gi = lbase[e] + pos;
            LDST[(size_t)e * T + gi] = (t0 + (idx >> 3)) * NSLOT + (idx & 7);
            LWt[(size_t)e * T + gi] = sel_w[idx];
        }
    }
}

constexpr int LDS_ROWTAB = LDS_TAB, LDS_AUX = LDS_TAB + 12288, MOE_MAX_UNITS = 20, LDS_UTAB = LDS_CTL + 256, LDS_TSTART = LDS_UTAB + MOE_MAX_UNITS * 32;
__device__ __forceinline__ int moe_setup(const Params& p, LAS unsigned char* lds0, int nN, int bmul, int badd) {
    LAS int* tstart = (LAS int*)(lds0 + LDS_TSTART); LAS int* utab = (LAS int*)(lds0 + LDS_UTAB);
    const int* gcnt = (const int*)(p.ws + OFF_CNT);
    __syncthreads();
    if (hw_tid() == 0) {
        int a = 0;
        for (int e = 0; e < NEX; ++e) { const int c = e < NE ? gcnt[e] : T; tstart[e] = a; a += (c + 255) >> 8; }
        tstart[NEX] = a;
    }
    __syncthreads();
    const int total = tstart[NEX] * nN, G = gridDim.x, c = vcu_of_block();
    if (hw_tid() < MOE_MAX_UNITS) {
        const int i = hw_tid(), L = i * G + c;
        int pm = 0, pn = 0, e = 0, i0 = 0, cnt = 0;
        if (L < total) {
            const int mt = L / nN, pl = L % nN;
            for (int j = 1; j < NEX; ++j) e += (mt >= tstart[j]) ? 1 : 0;
            pm = mt; pn = e * bmul + badd + pl; i0 = (mt - tstart[e]) * 256; cnt = e < NE ? gcnt[e] : T;
        }
        utab[i * 8 + 0] = pm; utab[i * 8 + 1] = pn; utab[i * 8 + 2] = e; utab[i * 8 + 3] = i0; utab[i * 8 + 4] = cnt;
    }
    __syncthreads();
    const int n = (total - c + G - 1) / G;
    return n < 0 ? 0 : (n > MOE_MAX_UNITS ? MOE_MAX_UNITS : n);
}
struct MoeSched {
    LAS const int* utab; LAS const unsigned* rowtab; int n;
    __device__ __forceinline__ bool next(int i, pg8::Unit& u) const {
        if (i >= n) return false;
        u.pm = __builtin_amdgcn_readfirstlane(utab[i * 8 + 0]); u.pn = __builtin_amdgcn_readfirstlane(utab[i * 8 + 1]); u.e = __builtin_amdgcn_readfirstlane(utab[i * 8 + 2]); u.idx = i; return true;
    }
    __device__ __forceinline__ unsigned row_off(int i, int r) const { return rowtab[i * 256 + r]; }
    __device__ __forceinline__ void a_ready(const pg8::Unit&) const {}
    __device__ __forceinline__ void done(const pg8::Unit&) const {}
};
struct EpiGU {
    static constexpr bool PERM = true;
    LAS const float* auxw; unsigned char* ws;
    __device__ __forceinline__ void operator()(const f32x4 (&acc)[2][2][4][2], const pg8::Unit& u, int wr, int wc, int fr, int fq) const {
        const int pl = u.pn & 1;
        bf16_t* ACT = (bf16_t*)(ws + OFF_ACT) + (size_t)u.pm * 256 * FF + pl * 128 + wc * 32 + 8 * fq;
#pragma unroll
        for (int ai = 0; ai < 2; ++ai)
#pragma unroll
            for (int m = 0; m < 4; ++m) {
                const int rl = ai * 128 + wr * 64 + m * 16 + fr;
                const float wrow = auxw[u.idx * 256 + rl];
                float a[8];
#pragma unroll
                for (int n = 0; n < 2; ++n)
#pragma unroll
                    for (int q = 0; q < 4; ++q) { const float g = acc[ai][0][m][n][q], uu = acc[ai][1][m][n][q]; a[n * 4 + q] = g * __builtin_amdgcn_rcpf(1.f + __builtin_amdgcn_exp2f(g * -1.4426950408889634f)) * uu * wrow; }
                u32x4 w; w.x = pk2(a[0], a[1]); w.y = pk2(a[2], a[3]); w.z = pk2(a[4], a[5]); w.w = pk2(a[6], a[7]);
                *(u32x4*)(ACT + (size_t)rl * FF) = w;
            }
    }
};
__device__ __forceinline__ void phase_gateup(const Params& p, LAS unsigned char* lds0) {
    int n = moe_setup(p, lds0, 2, 2, 0); n = n > 12 ? 12 : n;
    LAS const int* utab = (LAS const int*)(lds0 + LDS_UTAB);
    LAS unsigned* rowtab = (LAS unsigned*)(lds0 + LDS_ROWTAB);
    LAS float* auxw = (LAS float*)(lds0 + LDS_AUX);
    const int* LDST = (const int*)(p.ws + OFF_LDST);
    const float* LWt = (const float*)(p.ws + OFF_LW);
    for (int i = 0; i < n; ++i) {
        const int e = utab[i * 8 + 2], i0 = utab[i * 8 + 3], cnt = utab[i * 8 + 4];
        if (hw_tid() < 256) {
            const int li = i0 + hw_tid(); int tok = 0; float w = 0.f;
            if (li < cnt) { if (e < NE) { tok = LDST[(size_t)e * T + li] / NSLOT; w = LWt[(size_t)e * T + li]; } else { tok = li; w = 1.f; } }
            rowtab[i * 256 + hw_tid()] = (unsigned)tok * (unsigned)(D * 2);
            auxw[i * 256 + hw_tid()] = w;
        }
    }
    __syncthreads();
    MoeSched S{utab, rowtab, n};
    pg8::Gemm g{(const bf16_t*)(p.ws + OFF_H), (const bf16_t*)(p.ws + OFF_WGU), p.ws, 2};
    EpiGU E{auxw, p.ws};
    pg8::gemm_phase<D, EpiGU, MoeSched, true>(lds0, g, S, E);
    {
        LAS const int* tstart = (LAS const int*)(lds0 + LDS_TSTART);
        const int total = tstart[NEX] * 2, G = gridDim.x, v = vcu_of_block(), rem = total % G;
        if (v >= rem) {
            const int lane = hw_tid() & 63, wv = hw_tid() >> 6, nw = (G - rem) * 8, w = (v - rem) * 8 + wv;
            LAS float* scr = (LAS float*)lds0 + wv * (64 * 33);
            for (int it = w; it < TR_N_D; it += nw) transpose_item(p, scr, TR_N_A + TR_N_GU + it, lane);
        }
    }
}
constexpr float FP8S = 32.f, FP8I = 1.f / 32.f;
__device__ __forceinline__ unsigned pk4_fp8(float a, float b, float c, float d) {
    a = __builtin_amdgcn_fmed3f(a * FP8S, -440.f, 440.f); b = __builtin_amdgcn_fmed3f(b * FP8S, -440.f, 440.f);
    c = __builtin_amdgcn_fmed3f(c * FP8S, -440.f, 440.f); d = __builtin_amdgcn_fmed3f(d * FP8S, -440.f, 440.f);
    int w = __builtin_amdgcn_cvt_pk_fp8_f32(a, b, 0, false);
    w = __builtin_amdgcn_cvt_pk_fp8_f32(c, d, w, true);
    return (unsigned)w;
}
struct EpiDown {
    static constexpr bool PERM = true;
    LAS const int* auxd; unsigned char* ws;
    __device__ __forceinline__ void operator()(const f32x4 (&acc)[2][2][4][2], const pg8::Unit& u, int wr, int wc, int fr, int fq) const {
        const int pl = u.pn & 3;
        unsigned char* SL = ws + OFF_SLOTS + pl * 256 + wc * 64 + 16 * fq;
#pragma unroll
        for (int ai = 0; ai < 2; ++ai)
#pragma unroll
            for (int m = 0; m < 4; ++m) {
                const int d = auxd[u.idx * 256 + ai * 128 + wr * 64 + m * 16 + fr];
                u32x4 w;
                w.x = pk4_fp8(acc[ai][0][m][0][0], acc[ai][0][m][0][1], acc[ai][0][m][0][2], acc[ai][0][m][0][3]);
                w.y = pk4_fp8(acc[ai][0][m][1][0], acc[ai][0][m][1][1], acc[ai][0][m][1][2], acc[ai][0][m][1][3]);
                w.z = pk4_fp8(acc[ai][1][m][0][0], acc[ai][1][m][0][1], acc[ai][1][m][0][2], acc[ai][1][m][0][3]);
                w.w = pk4_fp8(acc[ai][1][m][1][0], acc[ai][1][m][1][1], acc[ai][1][m][1][2], acc[ai][1][m][1][3]);
                *(u32x4*)(SL + (size_t)d * 1024) = w;
            }
    }
};
__device__ __forceinline__ void phase_down(const Params& p, LAS unsigned char* lds0) {
    const int n = moe_setup(p, lds0, 4, 4, 0);
    LAS const int* utab = (LAS const int*)(lds0 + LDS_UTAB);
    LAS int* auxd = (LAS int*)(lds0 + LDS_TAB);
    const int* LDST = (const int*)(p.ws + OFF_LDST);
    for (int i = 0; i < n; ++i) {
        const int e = utab[i * 8 + 2], i0 = utab[i * 8 + 3], cnt = utab[i * 8 + 4];
        if (hw_tid() < 256) {
            const int li = i0 + hw_tid();
            auxd[i * 256 + hw_tid()] = li < cnt ? (e < NE ? LDST[(size_t)e * T + li] : li * NSLOT + 8) : T * NSLOT;
        }
    }
    __syncthreads();
    MoeSched S{utab, (LAS const unsigned*)(lds0 + LDS_ROWTAB), n};
    pg8::Gemm g{(const bf16_t*)(p.ws + OFF_ACT), (const bf16_t*)(p.ws + OFF_WD), p.ws, 3};
    EpiDown E{auxd, p.ws};
    pg8::gemm_phase<FF, EpiDown, MoeSched, false>(lds0, g, S, E);
}

__device__ __forceinline__ void slot_sum16(const unsigned char* SL, int t, int cb, float (&s)[16]) {
#pragma unroll
    for (int i = 0; i < 16; ++i) s[i] = 0.f;
    u32x4 v[NSLOT];
#pragma unroll
    for (int k = 0; k < NSLOT; ++k) v[k] = *(const u32x4*)(SL + (size_t)(t * NSLOT + k) * 1024 + cb);
#pragma unroll
    for (int k = 0; k < NSLOT; ++k)
#pragma unroll
        for (int i = 0; i < 4; ++i) {
            typedef float f32x2 __attribute__((ext_vector_type(2)));
            const f32x2 lo = __builtin_amdgcn_cvt_pk_f32_fp8((int)v[k][i], false), hi = __builtin_amdgcn_cvt_pk_f32_fp8((int)v[k][i], true);
            s[4 * i] += lo.x; s[4 * i + 1] += lo.y; s[4 * i + 2] += hi.x; s[4 * i + 3] += hi.y;
        }
#pragma unroll
    for (int i = 0; i < 16; ++i) s[i] *= FP8I;
}
__device__ __forceinline__ int slot_col(int bb) { return (bb >> 4) * 256 + ((bb >> 2) & 3) * 32 + (bb & 3) * 8; }
__device__ __forceinline__ void phase_final(const Params& p) {
    const int lane = hw_tid() & 63, gw = blockIdx.x * 8 + (hw_tid() >> 6), ngw = gridDim.x * 8;
    const float* mod = (const float*)(p.ws + OFF_MOD);
    const unsigned char* SL = p.ws + OFF_SLOTS;
    const int c0 = slot_col(lane);
    for (int row = gw; row < T; row += ngw) {
        const float* g2 = mod + (size_t)(row / SEQ) * MODW + 5 * D;
        float f[16];
        slot_sum16(SL, row, lane * 16, f);
        f32x4 y[4]; float s = 0.f;
#pragma unroll
        for (int j = 0; j < 4; ++j) {
            const int cj = c0 + (j >> 1) * 128 + (j & 1) * 4;
            const f32x4 xm = *(const f32x4*)(p.out + (size_t)row * D + cj), gg = *(const f32x4*)(g2 + cj);
            y[j][0] = ALPHA * xm[0] + gg[0] * f[4 * j]; y[j][1] = ALPHA * xm[1] + gg[1] * f[4 * j + 1];
            y[j][2] = ALPHA * xm[2] + gg[2] * f[4 * j + 2]; y[j][3] = ALPHA * xm[3] + gg[3] * f[4 * j + 3];
            s += (y[j][0] + y[j][1]) + (y[j][2] + y[j][3]);
        }
#pragma unroll
        for (int o = 1; o < 64; o <<= 1) s += __shfl_xor(s, o);
        const float mean = s * (1.f / D);
        float qv = 0.f;
#pragma unroll
        for (int j = 0; j < 4; ++j) { y[j] = y[j] - mean; qv += (y[j][0] * y[j][0] + y[j][1] * y[j][1]) + (y[j][2] * y[j][2] + y[j][3] * y[j][3]); }
#pragma unroll
        for (int o = 1; o < 64; o <<= 1) qv += __shfl_xor(qv, o);
        const float rstd = 1.0f / sqrtf(qv * (1.f / D) + 1e-5f);
#pragma unroll
        for (int j = 0; j < 4; ++j) {
            const int cj = c0 + (j >> 1) * 128 + (j & 1) * 4;
            const f32x4 g = *(const f32x4*)(p.ln2_g + cj), bb4 = *(const f32x4*)(p.ln2_b + cj);
            *(f32x4*)(p.out + (size_t)row * D + cj) = y[j] * rstd * g + bb4;
        }
    }
}

#define XB_TMO      128
#define XB_XCNT(j)  (256  + 64 * (j))
#define XB_XSUB(j)  (1280 + 64 * (j))
#define XB_XGEN(j)  (2304 + 64 * (j))
#define XB_TOP      3328
#define XB_TOPGEN   3392
#define XCD_BAR_WORDS 3456
#define XB_SPIN_CAP (1u << 18)
__device__ __forceinline__ unsigned xb_ld(unsigned* p)              { return __hip_atomic_load(p, __ATOMIC_RELAXED, __HIP_MEMORY_SCOPE_AGENT); }
__device__ __forceinline__ unsigned xb_add(unsigned* p, unsigned v) { return __hip_atomic_fetch_add(p, v, __ATOMIC_RELAXED, __HIP_MEMORY_SCOPE_AGENT); }
__device__ __forceinline__ unsigned xb_xcc_id() { return (unsigned)__builtin_amdgcn_s_getreg((3 << 11) | 20) & 0xFu; }
#define XB_SPIN(cond, bar) do { unsigned _sp = 0; while (cond) { __builtin_amdgcn_s_sleep(1); \
    if ((++_sp & 255u) == 0u) { if (xb_ld(&(bar)[XB_TMO])) break; if (_sp > XB_SPIN_CAP) { atomicAdd(&(bar)[XB_TMO], 1u); break; } } } } while (0)
struct XcdBarrier { unsigned* bar; unsigned x; volatile LAS unsigned* st; };
__device__ __forceinline__ XcdBarrier xcd_barrier_post(unsigned* bar, volatile LAS unsigned* st) {
    XcdBarrier b; b.bar = bar; b.x = xb_xcc_id(); b.st = st;
    if (hw_tid() == 0) (void)xb_add(&bar[XB_XCNT(b.x)], 1u);
    return b;
}
__device__ __forceinline__ void xcd_barrier_complete(unsigned* bar, unsigned x, unsigned& nloc, unsigned& nx) {
    const unsigned G = gridDim.x * gridDim.y * gridDim.z;
    unsigned sum, cnt, mine, sp = 0u;
    for (;;) {
        sum = 0u; cnt = 0u; mine = 0u;
#pragma unroll
        for (unsigned j = 0; j < 16; ++j) { const unsigned c = xb_ld(&bar[XB_XCNT(j)]); sum += c; cnt += (c > 0u) ? 1u : 0u; mine = (j == x) ? c : mine; }
        if (sum == G) break;
        __builtin_amdgcn_s_sleep(1);
        if ((++sp & 255u) == 0u) { if (xb_ld(&bar[XB_TMO])) break; if (sp > XB_SPIN_CAP) { atomicAdd(&bar[XB_TMO], 1u); break; } }
    }
    nloc = mine > 0u ? mine : 1u; nx = cnt > 0u ? cnt : 1u;
}
__device__ __forceinline__ void xcd_barrier(const XcdBarrier& b) {
    asm volatile("s_waitcnt vmcnt(0)" ::: "memory");
    __syncthreads();
    if (hw_tid() == 0) {
        unsigned* bar = b.bar;
        __builtin_amdgcn_s_waitcnt(0);
        unsigned nloc = b.st[0], nx = b.st[1];
        if (nloc == 0u) { xcd_barrier_complete(bar, b.x, nloc, nx); b.st[0] = nloc; b.st[1] = nx; }
        const unsigned old = xb_add(&bar[XB_XSUB(b.x)], 1u);
        const unsigned gen = old / nloc;
        if (old + 1u == (gen + 1u) * nloc) {
            __builtin_amdgcn_fence(__ATOMIC_RELEASE, "agent");
            asm volatile("s_waitcnt vmcnt(0)" ::: "memory");
            const unsigned og = xb_add(&bar[XB_TOP], 1u);
            const unsigned tg = og / nx;
            if (og + 1u == (tg + 1u) * nx) xb_add(&bar[XB_TOPGEN], 1u);
            else XB_SPIN(xb_ld(&bar[XB_TOPGEN]) == tg, bar);
            __builtin_amdgcn_fence(__ATOMIC_ACQUIRE, "agent");
            xb_add(&bar[XB_XGEN(b.x)], 1u);
            asm volatile("s_waitcnt vmcnt(0)" ::: "memory");
        } else {
            XB_SPIN(xb_ld(&bar[XB_XGEN(b.x)]) == gen, bar);
            __builtin_amdgcn_fence(__ATOMIC_ACQUIRE, "agent");
            asm volatile("s_waitcnt vmcnt(0)" ::: "memory");
        }
    }
    __syncthreads();
}

constexpr size_t OFF_BAR = 448 * 1024;

__global__ void __launch_bounds__(512, 2) mk_fwd(Params p) {
    extern __shared__ __attribute__((aligned(16))) unsigned char smem[];
    LAS unsigned char* lds0 = (LAS unsigned char*)smem;
    {
        const unsigned hw = (unsigned)__builtin_amdgcn_s_getreg((5 << 11) | 4) & 63u;
        if ((threadIdx.x & 63) == 0) *(volatile LAS int*)(LDS_HWTAB + hw * 4) = (int)(threadIdx.x >> 6);
        if (threadIdx.x < 64) ((LAS unsigned*)(lds0 + LDS_CTL))[threadIdx.x] = 0u;
    }
    __syncthreads();
    unsigned char* const g_probe_ws = p.ws; (void)g_probe_ws;
    XcdBarrier bar; bar.bar = (unsigned*)(p.ws + OFF_BAR); bar.x = 0; bar.st = nullptr;
    bar = xcd_barrier_post((unsigned*)(p.ws + OFF_BAR), (volatile LAS unsigned*)(lds0 + LDS_CTL));
#define RUN_PHASE(k, call) { if ((k) > 0) xcd_barrier(bar); TS_BEGIN(16 + (k)); int on_ = 1; asm volatile("" : "+s"(on_)); if (on_) { int grp_ = hw_tid() >> 8; asm volatile("" : "+v"(grp_)); LAS unsigned char* lds = lds0 + grp_ * 32768; (void)lds; call; } TS_END(16 + (k)); }
    RUN_PHASE(0, phase_prep(p, lds))
    RUN_PHASE(1, phase_xn(p))
    RUN_PHASE(2, phase_inproj(p, lds0))
    RUN_PHASE(3, phase_attn_pool(p, lds, (char*)smem))
    RUN_PHASE(4, phase_outproj(p, lds0))
    RUN_PHASE(5, phase_router(p, lds0))
    RUN_PHASE(6, phase_gateup(p, lds0))
    RUN_PHASE(7, phase_down(p, lds0))
    RUN_PHASE(8, phase_final(p))
#ifdef PROBE_ACC
    if (blockIdx.x == PROBE_BLK && hw_tid() == 0) {
        __builtin_amdgcn_s_waitcnt(0);
        const unsigned long long span = __hip_atomic_load((unsigned long long*)(p.ws + 448 * 1024 + 16384) + PROBE_ACC, __ATOMIC_RELAXED, __HIP_MEMORY_SCOPE_AGENT);
        const unsigned long long tend = __builtin_amdgcn_s_memrealtime() + PROBE_MUL * span; while (__builtin_amdgcn_s_memrealtime() < tend) __builtin_amdgcn_s_sleep(8);
    }
#endif
}

extern "C" void kernel_launch(void* const* d_in, const int* in_sizes, int n_in, void* d_out, int out_size, void* d_ws, size_t ws_size, hipStream_t stream) {
    static int grid = 0;
    if (grid == 0) {
        int dev = 0, cus = 0, per_cu = 0;
        (void)hipGetDevice(&dev);
        (void)hipDeviceGetAttribute(&cus, hipDeviceAttributeMultiprocessorCount, dev);
        (void)hipFuncSetAttribute((const void*)mk_fwd, hipFuncAttributeMaxDynamicSharedMemorySize, LDS_BYTES);
        (void)hipOccupancyMaxActiveBlocksPerMultiprocessor(&per_cu, (const void*)mk_fwd, 512, LDS_BYTES);
        if (per_cu < 1) fprintf(stderr, "kernel_launch: occupancy query says %d blocks per CU\n", per_cu);
        (void)hipGetLastError();
        grid = cus;
        if (ws_size < WS_NEED) fprintf(stderr, "kernel_launch: workspace too small: %zu < %zu\n", ws_size, (size_t)WS_NEED);
    }
    Params p{};
    const float** pp = (const float**)&p;
    for (int i = 0; i < 24; ++i) pp[i] = (const float*)d_in[i];
    p.out = (float*)d_out; p.ws = (unsigned char*)d_ws;
    (void)hipMemsetAsync((char*)d_ws + OFF_BAR, 0, 16384 + 512, stream);
    hipLaunchKernelGGL(mk_fwd, dim3(grid), dim3(512), LDS_BYTES, stream, p);
}
```
